# Optimizing an MI355X kernel written in HIP

```python
import jax, jax.numpy as jnp
from jax import lax
import numpy as np

D_MODEL = 1024
BATCH = 2
SEQ = 8192
DEPTH = 2

GRID_W = 64
CTX_LEN = 256
D_MIX = D_MODEL
EPS = 1e-6
LB_FLOOR = 1e-30
NEG_BIG = -1e4
A_HEADS = 4
A_HD = 64
A_WIDTH = A_HEADS * A_HD
CHUNK = 64
B_GROUPS = 4
B_WIDTH = D_MIX // 4
B_GW = B_WIDTH // B_GROUPS
POOL_WINDOWS = (2, 4, 8, 16)
C_HEADS = 8
C_KV_HEADS = 2
C_HD = 64
C_WIDTH = C_HEADS * C_HD
C_KV_WIDTH = C_KV_HEADS * C_HD
Q_BLOCK = 128
ROPE_THETA = 10000.0
N_EXPERTS = 16
N_GROUPS = 4
E_PER_GROUP = N_EXPERTS // N_GROUPS
TOP_K = 2
D_EXPERT = D_MODEL // 2
IN_SIZES = (A_WIDTH, A_WIDTH, A_WIDTH, A_WIDTH, A_WIDTH, B_WIDTH, C_WIDTH, C_KV_WIDTH, C_KV_WIDTH)
IN_COLS = 5 * A_WIDTH + B_WIDTH + C_WIDTH + 2 * C_KV_WIDTH

kernel_name = "hybrid_hgrn2_pool_gqa_grouped_moe_dit"


def rms_norm(x, g):
    xf = x.astype(jnp.float32)
    y = xf * lax.rsqrt(jnp.mean(xf * xf, axis=-1, keepdims=True) + EPS)
    return (y * g.astype(jnp.float32)).astype(x.dtype)


def modulate(h, shift, scale):
    return h * (1 + scale) + shift


def split_in(a):
    outs, off = [], 0
    for s in IN_SIZES:
        outs.append(a[..., off:off + s])
        off += s
    return outs


def axial_rope_tables(T):
    rows_n = T // GRID_W
    row = jnp.repeat(jnp.arange(rows_n), GRID_W).astype(jnp.float32)
    col = jnp.tile(jnp.arange(GRID_W), rows_n).astype(jnp.float32)
    n_freq = C_HD // 4
    inv = ROPE_THETA ** (-jnp.arange(n_freq, dtype=jnp.float32) / n_freq)
    ang = jnp.concatenate([row[:, None] * inv, col[:, None] * inv], axis=-1)
    return jnp.cos(ang), jnp.sin(ang)


def apply_rope(x, cos, sin):
    xf = x.astype(jnp.float32).reshape(*x.shape[:-1], C_HD // 2, 2)
    x1, x2 = xf[..., 0], xf[..., 1]
    cs, sn = cos[None, :, None, :], sin[None, :, None, :]
    out = jnp.stack([x1 * cs - x2 * sn, x1 * sn + x2 * cs], axis=-1)
    return out.reshape(x.shape).astype(x.dtype)


def to_heads(a):
    B, T, _ = a.shape
    return a.astype(jnp.float32).reshape(B, T, A_HEADS, A_HD).transpose(0, 2, 1, 3)


def log_forget(z, lb):
    lbf = jnp.maximum(lb, LB_FLOOR)
    return jnp.logaddexp(jnp.log(lbf), jnp.log1p(-lbf) + jax.nn.log_sigmoid(z))


def gated_chunk_scan(q, k, v, logf, s0):
    B, H, T, dk = q.shape
    n = T // CHUNK

    def chunks(a):
        return a.reshape(B, H, n, CHUNK, a.shape[-1]).transpose(2, 0, 1, 3, 4)

    causal_in_chunk = jnp.tril(jnp.ones((CHUNK, CHUNK), dtype=bool))[:, :, None]
    causal_f = causal_in_chunk.astype(jnp.float32)

    def step(S, inp):
        qc, kc, vc, lc = inp
        b = jnp.cumsum(lc, axis=2)
        o_inter = jnp.einsum('bhtk,bhkv->bhtv', qc * jnp.exp(b), S)
        diff = b[:, :, :, None, :] - b[:, :, None, :, :]
        decay = jnp.exp(jnp.where(causal_in_chunk, diff, 0.0)) * causal_f
        att = jnp.einsum('bhtk,bhtsk,bhsk->bhts', qc, decay, kc)
        o = o_inter + jnp.einsum('bhts,bhsv->bhtv', att, vc)
        b_last = b[:, :, -1:, :]
        S_new = jnp.exp(b_last[:, :, 0, :])[..., None] * S + jnp.einsum(
            'bhsk,bhsv->bhkv', kc * jnp.exp(b_last - b), vc)
        return S_new, o

    S, o = lax.scan(step, s0, (chunks(q), chunks(k), chunks(v), chunks(logf)))
    return o.transpose(1, 2, 0, 3, 4).reshape(B, H, T, v.shape[-1]), S


def flip_seq(a, rev):
    return a[:, :, ::-1] if rev else a


def hgrn2_mixer(lat, ctx, lb, norm_g, need_ctx):
    def prep(qz, ffz, fbz, iz):
        q = jax.nn.silu(to_heads(qz))
        v = to_heads(iz)
        logfs = [log_forget(to_heads(fz), lb[d].reshape(A_HEADS, 1, A_HD))
                 for d, fz in enumerate((ffz, fbz))]
        return q, v, logfs

    q, v, logfs = prep(*lat[:4])
    qc, vc, logfcs = prep(*ctx[:4])
    B, H, L, _ = qc.shape
    o, oc = 0.0, 0.0
    for d, rev in enumerate((False, True)):
        lf, lfc = logfs[d], logfcs[d]
        s0 = jnp.zeros((B, H, A_HD, A_HD), jnp.float32)
        oc_d, s_ctx = gated_chunk_scan(flip_seq(qc, rev), flip_seq(-jnp.expm1(lfc), rev),
                                       flip_seq(vc, rev), flip_seq(lfc, rev), s0)
        o_d, _ = gated_chunk_scan(flip_seq(q, rev), flip_seq(-jnp.expm1(lf), rev),
                                  flip_seq(v, rev), flip_seq(lf, rev), s_ctx)
        o = o + flip_seq(o_d, rev)
        oc = oc + flip_seq(oc_d, rev)

    def readout(o_, gz):
        Bq, T, _ = gz.shape
        g = jax.nn.silu(gz.astype(jnp.float32)).reshape(Bq, T, A_HEADS, A_HD)
        return (rms_norm(o_.transpose(0, 2, 1, 3), norm_g) * g).reshape(Bq, T, A_WIDTH).astype(gz.dtype)

    return readout(o, lat[4]), (readout(oc, ctx[4]) if need_ctx else None)


def pool_mixer(h, w, scale):
    B, T, _ = h.shape
    hf = h.astype(jnp.float32).reshape(B, T, B_GROUPS, B_GW)
    P = jnp.concatenate([jnp.zeros((B, 1, B_GROUPS, B_GW), jnp.float32), jnp.cumsum(hf, axis=1)], axis=1)
    t = jnp.arange(T)
    outs = []
    for gi, win in enumerate(POOL_WINDOWS):
        lo = jnp.maximum(t - win // 2, 0)
        hi = jnp.minimum(t + win // 2, T)
        cnt = (hi - lo).astype(jnp.float32)
        mean = (P[:, hi, gi] - P[:, lo, gi]) / cnt[None, :, None]
        outs.append(mean - hf[:, :, gi])
    d = jnp.stack(outs, axis=2)
    y = jnp.einsum('btgc,gce->btge', d, w.astype(jnp.float32)).reshape(B, T, B_WIDTH)
    return (y * scale.astype(jnp.float32)).astype(h.dtype)


def attend(qg, k, v):
    s = jnp.einsum('bhgqd,bhsd->bhgqs', qg, k).astype(jnp.float32) * (C_HD ** -0.5)
    p = jax.nn.softmax(s, axis=-1).astype(v.dtype)
    return jnp.einsum('bhgqs,bhsd->bhgqd', p, v)


def gqa_mixer(q, k, v, qc, kc, vc, qn, kn, cos, sin, need_ctx):
    B, T, _ = q.shape
    L = qc.shape[1]
    G = C_HEADS // C_KV_HEADS

    def heads(a, h):
        return a.reshape(a.shape[0], a.shape[1], h, C_HD)

    q = apply_rope(rms_norm(heads(q, C_HEADS), qn), cos, sin)
    k = apply_rope(rms_norm(heads(k, C_KV_HEADS), kn), cos, sin)
    v = heads(v, C_KV_HEADS)
    kc = rms_norm(heads(kc, C_KV_HEADS), kn)
    vc = heads(vc, C_KV_HEADS)
    keys = jnp.concatenate([kc, k], axis=1).transpose(0, 2, 1, 3)
    vals = jnp.concatenate([vc, v], axis=1).transpose(0, 2, 1, 3)
    nb = T // Q_BLOCK
    qb = q.reshape(B, nb, Q_BLOCK, C_KV_HEADS, G, C_HD).transpose(1, 0, 3, 4, 2, 5)
    ob = lax.map(lambda blk: attend(blk, keys, vals), qb)
    o = ob.transpose(1, 0, 4, 2, 3, 5).reshape(B, T, C_WIDTH)
    oc = None
    if need_ctx:
        qcg = rms_norm(heads(qc, C_HEADS), qn).reshape(B, L, C_KV_HEADS, G, C_HD).transpose(0, 2, 3, 1, 4)
        oc = attend(qcg, kc.transpose(0, 2, 1, 3), vc.transpose(0, 2, 1, 3))
        oc = oc.transpose(0, 3, 1, 2, 4).reshape(B, L, C_WIDTH)
    return o, oc


def grouped_moe(h, router_w, router_b, wg, wu, wd):
    N = h.shape[0]
    scores = jax.nn.sigmoid((h @ router_w).astype(jnp.float32))
    sel = scores + router_b.astype(jnp.float32)
    grp_score = lax.top_k(sel.reshape(N, N_GROUPS, E_PER_GROUP), 2)[0].sum(-1)
    best = jnp.argmax(grp_score, axis=-1)
    in_grp = (jnp.arange(N_EXPERTS) // E_PER_GROUP)[None, :] == best[:, None]
    _, idx = lax.top_k(jnp.where(in_grp, sel, NEG_BIG), TOP_K)
    w = jnp.take_along_axis(scores, idx, axis=-1)
    w = w / jnp.sum(w, axis=-1, keepdims=True)
    combine = jnp.sum(jax.nn.one_hot(idx, N_EXPERTS, dtype=jnp.float32) * w[..., None], axis=1)
    y = jnp.zeros((N, h.shape[1]), jnp.float32)
    for e in range(N_EXPERTS):
        a = jax.nn.silu(h @ wg[e]) * (h @ wu[e])
        y = y + combine[:, e:e + 1] * (a @ wd[e]).astype(jnp.float32)
    return y.astype(h.dtype)


def setup_inputs(seed: int = 0) -> dict:
    key = jax.random.key(seed)
    ks = jax.random.split(key, 21)

    def nrm(k, shape, s):
        return jax.random.normal(k, shape, jnp.float32) * s

    return {
        "x": nrm(ks[0], (BATCH, SEQ, D_MODEL), 1.0),
        "c": nrm(ks[1], (BATCH, D_MODEL), 1.0),
        "ctx": nrm(ks[2], (BATCH, CTX_LEN, D_MODEL), 1.0),
        "c_ctx": nrm(ks[3], (D_MODEL,), 1.0),
        "w_mod": nrm(ks[4], (DEPTH, D_MODEL, 6 * D_MODEL), 0.5 * D_MODEL ** -0.5),
        "b_mod": nrm(ks[5], (DEPTH, 6 * D_MODEL), 0.02),
        "norm1_g": 1.0 + nrm(ks[6], (DEPTH, D_MODEL), 0.05),
        "norm2_g": 1.0 + nrm(ks[7], (DEPTH, D_MODEL), 0.05),
        "w_in": nrm(ks[8], (DEPTH, D_MODEL, IN_COLS), D_MODEL ** -0.5),
        "w_out": nrm(ks[9], (DEPTH, D_MIX, D_MODEL), D_MIX ** -0.5),
        "hgrn_lb": nrm(ks[10], (DEPTH, 2, A_WIDTH), 1.0),
        "hgrn_norm_g": 1.0 + nrm(ks[11], (DEPTH, A_HD), 0.05),
        "pool_w": nrm(ks[12], (DEPTH, B_GROUPS, B_GW, B_GW), B_GW ** -0.5),
        "pool_scale": 1.0 + nrm(ks[13], (DEPTH, B_WIDTH), 0.05),
        "q_norm_g": 1.0 + nrm(ks[14], (DEPTH, C_HD), 0.05),
        "k_norm_g": 1.0 + nrm(ks[15], (DEPTH, C_HD), 0.05),
        "router_w": nrm(ks[16], (D_MODEL, N_EXPERTS), D_MODEL ** -0.5),
        "router_b": nrm(ks[17], (N_EXPERTS,), 0.01),
        "moe_w_gate": nrm(ks[18], (DEPTH, N_EXPERTS, D_MODEL, D_EXPERT), D_MODEL ** -0.5),
        "moe_w_up": nrm(ks[19], (DEPTH, N_EXPERTS, D_MODEL, D_EXPERT), D_MODEL ** -0.5),
        "moe_w_down": nrm(ks[20], (DEPTH, N_EXPERTS, D_EXPERT, D_MODEL), D_EXPERT ** -0.5),
    }


def reference(x, c, ctx, c_ctx, w_mod, b_mod, norm1_g, norm2_g, w_in, w_out, hgrn_lb, hgrn_norm_g,
              pool_w, pool_scale, q_norm_g, k_norm_g, router_w, router_b, moe_w_gate, moe_w_up, moe_w_down):
    B, T, D = x.shape
    L = ctx.shape[1]
    cos, sin = axial_rope_tables(T)
    c_act = jax.nn.silu(c)
    cc_act = jax.nn.silu(c_ctx)
    sm = jax.nn.softmax(hgrn_lb.astype(jnp.float32), axis=0)
    lower = jnp.cumsum(sm, axis=0) - sm[0:1]

    xl, xc = x, ctx
    for l in range(DEPTH):
        need_ctx = l < DEPTH - 1
        mod = c_act @ w_mod[l] + b_mod[l]
        sh1, sc1, ga1, sh2, sc2, ga2 = jnp.split(mod[:, None, :], 6, axis=-1)
        sh1c, sc1c, ga1c, sh2c, sc2c, ga2c = jnp.split(cc_act @ w_mod[l] + b_mod[l], 6)

        h = modulate(rms_norm(xl, norm1_g[l]), sh1, sc1)
        hc = modulate(rms_norm(xc, norm1_g[l]), sh1c, sc1c)
        aq, aff, afb, ai, ag, bp, cq, ck, cv = split_in(h @ w_in[l])
        aqc, affc, afbc, aic, agc, bpc, cqc, ckc, cvc = split_in(hc @ w_in[l])

        oa, oac = hgrn2_mixer((aq, aff, afb, ai, ag), (aqc, affc, afbc, aic, agc),
                              lower[l], hgrn_norm_g[l], need_ctx)
        ob = pool_mixer(bp, pool_w[l], pool_scale[l])
        oc, occ = gqa_mixer(cq, ck, cv, cqc, ckc, cvc, q_norm_g[l], k_norm_g[l], cos, sin, need_ctx)
        xl = xl + ga1 * (jnp.concatenate([oa, ob, oc], axis=-1) @ w_out[l])

        h2 = modulate(rms_norm(xl, norm2_g[l]), sh2, sc2)
        if need_ctx:
            obc = pool_mixer(bpc, pool_w[l], pool_scale[l])
            xc = xc + ga1c * (jnp.concatenate([oac, obc, occ], axis=-1) @ w_out[l])
            h2c = modulate(rms_norm(xc, norm2_g[l]), sh2c, sc2c)
            m = grouped_moe(jnp.concatenate([h2.reshape(B * T, D), h2c.reshape(B * L, D)], axis=0),
                            router_w, router_b, moe_w_gate[l], moe_w_up[l], moe_w_down[l])
            xl = xl + ga2 * m[:B * T].reshape(B, T, D)
            xc = xc + ga2c * m[B * T:].reshape(B, L, D)
        else:
            m = grouped_moe(h2.reshape(B * T, D), router_w, router_b,
                            moe_w_gate[l], moe_w_up[l], moe_w_down[l])
            xl = xl + ga2 * m.reshape(B, T, D)
    return xl
```

```cpp
#include <hip/hip_runtime.h>
#include <cstdio>
#include <cstdint>
#include <cstring>

namespace cfg {
constexpr int D = 1024, BATCH = 2, SEQ = 8192, CTXL = 256, DEPTH = 2;
constexpr int PB = SEQ + CTXL;
constexpr int MT = BATCH * PB;
constexpr int TPB = PB / 256;
constexpr int NIN = 2304;
constexpr int NE = 16, DE = 512;
constexpr int C_AQ = 0, C_AFF = 256, C_AFB = 512, C_AI = 768, C_AG = 1024, C_BP = 1280, C_CQ = 1536, C_CK = 2048, C_CV = 2176;
constexpr float EPS = 1e-6f;
constexpr float C2 = 0.125f * 1.4426950408889634f;
}

namespace pg8 {
#define PG8_LAS __attribute__((address_space(3)))
typedef unsigned short bf16_t;
typedef short bf16x8 __attribute__((ext_vector_type(8)));
typedef float f32x4 __attribute__((ext_vector_type(4)));
typedef unsigned u32x4 __attribute__((ext_vector_type(4)));
constexpr int BM = 256, BK = 64, HALF = 128, HTB = HALF * BK * 2  , STAGE_BYTES = 8 * HTB, NXCD = 8, WGM = 8;

__host__ __device__ __forceinline__ int lds_byte(int r, int c) { const int st = (r >> 4) * 2 + (c >> 5), rr = r & 15, cc = c & 31, ob = rr * 64 + cc * 2; return st * 1024 + (ob ^ (((ob >> 9) & 1) << 5)); }
__host__ __device__ __forceinline__ void stage_rc(int b, int& R, int& C) { const int st = b / 1024, sb = b % 1024, swz = sb ^ (((sb >> 9) & 1) << 5); R = (st >> 1) * 16 + swz / 64; C = (st & 1) * 32 + (swz % 64) / 2; }
__host__ __device__ __forceinline__ int perm32(int rho) { const int n = rho >> 4, i = rho & 15; return 8 * (i >> 2) + 4 * n + (i & 3); }

struct Unit { int pm, pn; };
struct Gemm { const bf16_t* A; const bf16_t* Bt; int M, N, K, pad; };

struct StaticOrder {
    int nM, nN, nwg, G, c;
    __host__ __device__ void init(int M, int N, int G_, int c_) { nM = M / BM; nN = N / BM; nwg = nM * nN; G = G_; c = c_; }
    __host__ __device__ bool next(int i, Unit& u) const {
        const long L = (long)i * G + c; if (L >= nwg) return false;
        int wgid = (int)L; { const int q = nwg / NXCD, r = nwg % NXCD, xcd = wgid % NXCD, off = wgid / NXCD; wgid = (xcd < r ? xcd * (q + 1) : r * (q + 1) + (xcd - r) * q) + off; }
        const int nig = WGM * nN, gid = wgid / nig, fm = gid * WGM, gsz = (nM - fm) < WGM ? (nM - fm) : WGM;
        u.pm = fm + ((wgid % nig) % gsz); u.pn = (wgid % nig) / gsz; return true;
    }
    __device__ __forceinline__ void a_ready(const Unit&) const {}
    __device__ __forceinline__ void done(const Unit&) const {}
};

__device__ __forceinline__ unsigned cvt_pk_bf16(float lo, float hi) { unsigned r; asm volatile("v_cvt_pk_bf16_f32 %0, %1, %2" : "=v"(r) : "v"(lo), "v"(hi)); return r; }
typedef float f32x2 __attribute__((ext_vector_type(2)));
__device__ __forceinline__ f32x2 gelu_pk(f32x2 v) {
    const f32x2 av = __builtin_elementwise_abs(v), d = av * 0.2316418882f + 1.0f;
    f32x2 t; t.x = __builtin_amdgcn_rcpf(d.x); t.y = __builtin_amdgcn_rcpf(d.y);
    f32x2 q = t * 0.5307027145f + (-0.7265760135f); q = q * t + 0.7107068705f; q = q * t + (-0.142248368f); q = q * t + 0.127414796f; q = q * t;
    const f32x2 s = (v * v) * (-0.72134752044f);
    f32x2 e; e.x = __builtin_amdgcn_exp2f(s.x); e.y = __builtin_amdgcn_exp2f(s.y);
    const f32x2 m = v * (q * e), r = v - m;
    f32x2 o; o.x = v.x < 0.f ? m.x : r.x; o.y = v.y < 0.f ? m.y : r.y; return o;
}

template <int ACT  > struct EpiBf16 {
    static constexpr bool PERM = true, AFTER_DRAIN = false; static_assert(ACT == 0 || ACT == 1, "EpiBf16: ACT is 0 (none) or 1 (gelu_pk)");
    bf16_t* O; int ldc; const float* bias; int split_cols; size_t split_stride; float scale0;
    __device__ __forceinline__ void operator()(const f32x4 (&acc)[2][2][4][2], const Unit& u, int wr, int wc, int fr, int fq) const {
        const int row0 = u.pm * BM + wr * 64 + fr; int colt = u.pn * BM; bf16_t* base = O;
        float sc = 1.f; if (split_cols) { const int t = colt / split_cols; base += (size_t)t * split_stride; colt -= t * split_cols; if (t == 0) sc = scale0; }
        const int col0 = colt + wc * 32 + 8 * fq, bcol0 = u.pn * BM + wc * 32 + 8 * fq;
        f32x4 bv[2][2];
#pragma unroll
        for (int bj = 0; bj < 2; ++bj)
#pragma unroll
            for (int n = 0; n < 2; ++n) bv[bj][n] = bias ? *(const f32x4*)(bias + bcol0 + bj * HALF + 4 * n) : (f32x4){0.f, 0.f, 0.f, 0.f};
#pragma unroll
        for (int ai = 0; ai < 2; ++ai)
#pragma unroll
            for (int m = 0; m < 4; ++m) { bf16_t* rowp = base + (size_t)(row0 + ai * HALF + m * 16) * ldc + col0;
#pragma unroll
                for (int bj = 0; bj < 2; ++bj) { f32x4 v0 = acc[ai][bj][m][0] + bv[bj][0], v1 = acc[ai][bj][m][1] + bv[bj][1];
                    if (ACT == 1) { f32x2 a = gelu_pk((f32x2){v0[0], v0[1]}), b = gelu_pk((f32x2){v0[2], v0[3]}), c = gelu_pk((f32x2){v1[0], v1[1]}), d = gelu_pk((f32x2){v1[2], v1[3]});
                        v0 = (f32x4){a.x, a.y, b.x, b.y}; v1 = (f32x4){c.x, c.y, d.x, d.y}; }
                    v0 = v0 * sc; v1 = v1 * sc; u32x4 w; w.x = cvt_pk_bf16(v0[0], v0[1]); w.y = cvt_pk_bf16(v0[2], v0[3]); w.z = cvt_pk_bf16(v1[0], v1[1]); w.w = cvt_pk_bf16(v1[2], v1[3]);
                    *(u32x4*)(rowp + bj * HALF) = w; } }
    }
};

template <class Epi, class Sched, bool ALIGN_EPI = false, bool SP2 = false>
__device__ __forceinline__ void gemm_phase(PG8_LAS unsigned char* lds, const Gemm g, const Sched& S, const Epi& E) {
    const int tid = threadIdx.x, wid = __builtin_amdgcn_readfirstlane(tid >> 6), lane = tid & 63, wr = wid >> 2, wc = wid & 3, fr = lane & 15, fq = lane >> 4;
    const int K = g.K, nt = K / BK;
    unsigned voffA[2], voffB[2];
#pragma unroll
    for (int i = 0; i < 2; ++i) { int R, C; stage_rc(tid * 16 + i * 8192, R, C); const int Rb = Epi::PERM ? ((R & ~31) + perm32(R & 31)) : R;
        voffA[i] = (unsigned)(R * K + C) * 2u; voffB[i] = (unsigned)(Rb * K + C) * 2u; }
    const size_t kstep = (size_t)(BK * 2);
    const size_t hstep = (size_t)HALF * K * 2;
    const size_t tstep = 2 * hstep;
    const unsigned ldsw = (unsigned)wid * 1024u;
    const int aoff = lds_byte(wr * 64 + fr, fq * 8), boff = lds_byte(wc * 32 + fr, fq * 8);
#define PG8_SA(b, h) (((b) * 2 + (h)) * HTB)
#define PG8_SB(b, h) ((4 + (b) * 2 + (h)) * HTB)
#define PG8_STAGE(bufoff, gbase, voff) do { _Pragma("unroll") for (int _i = 0; _i < 2; ++_i) \
        __builtin_amdgcn_global_load_lds((const unsigned*)((const char*)(gbase) + (voff)[_i]), (PG8_LAS unsigned*)(lds + (bufoff) + ldsw + _i * 8192), 16, 0, 0); } while (0)
#define PG8_LDA(dst, b, h) do { _Pragma("unroll") for (int m = 0; m < 4; ++m) _Pragma("unroll") for (int k = 0; k < 2; ++k) dst[m][k] = *(const PG8_LAS bf16x8*)(lds + PG8_SA(b, h) + aoff + m * 2048 + k * 1024); } while (0)
#define PG8_LDB(dst, b, h) do { _Pragma("unroll") for (int n = 0; n < 2; ++n) _Pragma("unroll") for (int k = 0; k < 2; ++k) dst[n][k] = *(const PG8_LAS bf16x8*)(lds + PG8_SB(b, h) + boff + n * 2048 + k * 1024); } while (0)
#define PG8_MMA(ai, bj, At, Bt) do { __builtin_amdgcn_s_setprio(1); _Pragma("unroll") for (int m = 0; m < 4; ++m) _Pragma("unroll") for (int n = 0; n < 2; ++n) _Pragma("unroll") for (int k = 0; k < 2; ++k) \
        acc[ai][bj][m][n] = __builtin_amdgcn_mfma_f32_16x16x32_bf16(Bt[n][k], At[m][k], acc[ai][bj][m][n], 0, 0, 0); __builtin_amdgcn_s_setprio(0); } while (0)
#define PG8_WAIT_V(n) asm volatile("s_waitcnt vmcnt(" #n ")" ::: "memory")
#define PG8_WAIT_L(n) asm volatile("s_waitcnt lgkmcnt(" #n ")" ::: "memory")
#define PG8_BAR __builtin_amdgcn_s_barrier()
#define PG8_SCHED __builtin_amdgcn_sched_barrier(0)
    Unit cur, nxt; int ui = 0;
    if (!S.next(0, cur)) return;
    f32x4 acc[2][2][4][2];
#pragma unroll
    for (int a = 0; a < 2; ++a)
#pragma unroll
        for (int b = 0; b < 2; ++b)
#pragma unroll
            for (int m = 0; m < 4; ++m)
#pragma unroll
                for (int n = 0; n < 2; ++n) acc[a][b][m][n] = (f32x4){0.f, 0.f, 0.f, 0.f};
    bf16x8 At[4][2], B0[2][2], B1[2][2];
    const char* cA = (const char*)g.A + (size_t)cur.pm * tstep; const char* cB = (const char*)g.Bt + (size_t)cur.pn * tstep;
    S.a_ready(cur);
    if constexpr (SP2) {
        PG8_STAGE(PG8_SB(0, 0), cB, voffB); PG8_STAGE(PG8_SB(0, 1), cB + hstep, voffB); PG8_STAGE(PG8_SA(0, 0), cA, voffA); PG8_STAGE(PG8_SA(0, 1), cA + hstep, voffA);
        if (wr == 1) PG8_BAR;
        PG8_WAIT_V(2); PG8_BAR;
        PG8_STAGE(PG8_SB(1, 0), cB + kstep, voffB); PG8_STAGE(PG8_SA(1, 0), cA + kstep, voffA); PG8_STAGE(PG8_SB(1, 1), cB + hstep + kstep, voffB);
        PG8_WAIT_V(6); PG8_BAR;
    } else {
        PG8_STAGE(PG8_SB(0, 0), cB, voffB); PG8_STAGE(PG8_SA(0, 0), cA, voffA); PG8_STAGE(PG8_SB(0, 1), cB + hstep, voffB); PG8_STAGE(PG8_SA(0, 1), cA + hstep, voffA);
        if (wr == 1) PG8_BAR;
        PG8_WAIT_V(4); PG8_BAR;
        PG8_STAGE(PG8_SB(1, 0), cB + kstep, voffB); PG8_STAGE(PG8_SA(1, 0), cA + kstep, voffA); PG8_STAGE(PG8_SB(1, 1), cB + hstep + kstep, voffB);
        PG8_WAIT_V(6); PG8_BAR;
    }
    for (;;) {
        const bool has_next = S.next(ui + 1, nxt);
        const char* nA = has_next ? (const char*)g.A + (size_t)nxt.pm * tstep : cA; const char* nB = has_next ? (const char*)g.Bt + (size_t)nxt.pn * tstep : cB;
        for (int t = 0; t < nt; t += 2) {
            const bool last = (t == nt - 2);
            const char* a1 = cA + (size_t)(t + 1) * kstep;
            const char* a2 = last ? nA : cA + (size_t)(t + 2) * kstep; const char* b2 = last ? nB : cB + (size_t)(t + 2) * kstep;
            const char* a3 = a2 + kstep; const char* b3 = b2 + kstep;
            if (last && has_next) S.a_ready(nxt);
            if constexpr (SP2) {
            PG8_LDB(B0, 0, 0); PG8_LDB(B1, 0, 1); PG8_SCHED; PG8_LDA(At, 0, 0); PG8_STAGE(PG8_SA(1, 1), a1 + hstep, voffA);
            PG8_WAIT_V(8); PG8_WAIT_L(0); PG8_BAR; PG8_MMA(0, 0, At, B0); PG8_MMA(0, 1, At, B1); PG8_BAR; PG8_SCHED;
            PG8_LDA(At, 0, 1); PG8_STAGE(PG8_SB(0, 0), b2, voffB); PG8_STAGE(PG8_SB(0, 1), b2 + hstep, voffB); PG8_STAGE(PG8_SA(0, 0), a2, voffA);
            PG8_WAIT_V(8); PG8_WAIT_L(0); PG8_BAR; PG8_MMA(1, 0, At, B0); PG8_MMA(1, 1, At, B1); PG8_BAR; PG8_SCHED;
            PG8_LDB(B0, 1, 0); PG8_LDB(B1, 1, 1); PG8_SCHED; PG8_LDA(At, 1, 0); PG8_STAGE(PG8_SA(0, 1), a2 + hstep, voffA);
            PG8_WAIT_V(8); PG8_WAIT_L(0); PG8_BAR; PG8_MMA(0, 0, At, B0); PG8_MMA(0, 1, At, B1); PG8_BAR; PG8_SCHED;
            PG8_LDA(At, 1, 1); PG8_STAGE(PG8_SB(1, 0), b3, voffB); PG8_STAGE(PG8_SB(1, 1), b3 + hstep, voffB); PG8_STAGE(PG8_SA(1, 0), a3, voffA);
            PG8_WAIT_V(8); PG8_WAIT_L(0); PG8_BAR; PG8_MMA(1, 0, At, B0); PG8_MMA(1, 1, At, B1); PG8_BAR; PG8_SCHED;
            } else {
            PG8_LDB(B0, 0, 0); PG8_SCHED; PG8_LDA(At, 0, 0); PG8_STAGE(PG8_SA(1, 1), a1 + hstep, voffA);
            PG8_WAIT_L(8); PG8_BAR; PG8_WAIT_L(0); PG8_MMA(0, 0, At, B0); PG8_BAR; PG8_SCHED;
            PG8_LDB(B1, 0, 1); PG8_STAGE(PG8_SB(0, 0), b2, voffB);
            PG8_BAR; PG8_WAIT_L(0); PG8_MMA(0, 1, At, B1); PG8_BAR;
            PG8_LDA(At, 0, 1); PG8_STAGE(PG8_SA(0, 0), a2, voffA);
            PG8_BAR; PG8_WAIT_L(0); PG8_MMA(1, 0, At, B0); PG8_BAR; PG8_SCHED;
            PG8_STAGE(PG8_SB(0, 1), b2 + hstep, voffB);
            PG8_WAIT_V(6); PG8_BAR; PG8_MMA(1, 1, At, B1); PG8_BAR;
            PG8_LDB(B0, 1, 0); PG8_SCHED; PG8_LDA(At, 1, 0); PG8_STAGE(PG8_SA(0, 1), a2 + hstep, voffA);
            PG8_WAIT_L(8); PG8_BAR; PG8_WAIT_L(0); PG8_MMA(0, 0, At, B0); PG8_BAR; PG8_SCHED;
            PG8_LDB(B1, 1, 1); PG8_STAGE(PG8_SB(1, 0), b3, voffB);
            PG8_BAR; PG8_WAIT_L(0); PG8_MMA(0, 1, At, B1); PG8_BAR;
            PG8_LDA(At, 1, 1); PG8_STAGE(PG8_SA(1, 0), a3, voffA);
            PG8_BAR; PG8_WAIT_L(0); PG8_MMA(1, 0, At, B0); PG8_BAR; PG8_SCHED;
            PG8_STAGE(PG8_SB(1, 1), b3 + hstep, voffB);
            PG8_WAIT_V(6); PG8_BAR; PG8_MMA(1, 1, At, B1); PG8_BAR;
            }
        }
        if constexpr (ALIGN_EPI) { if (wr == 0) PG8_BAR; }
        if constexpr (!Epi::AFTER_DRAIN) { E(acc, cur, wr, wc, fr, fq); S.done(cur); }
        if (!has_next) break;
#pragma unroll
        for (int a = 0; a < 2; ++a)
#pragma unroll
            for (int b = 0; b < 2; ++b)
#pragma unroll
                for (int m = 0; m < 4; ++m)
#pragma unroll
                    for (int n = 0; n < 2; ++n) acc[a][b][m][n] = (f32x4){0.f, 0.f, 0.f, 0.f};
        cur = nxt; cA = nA; cB = nB; ++ui;
        if constexpr (ALIGN_EPI) { if (wr == 1) PG8_BAR; }
    }
    PG8_WAIT_V(0);
    if constexpr (!ALIGN_EPI) { if (wr == 0) PG8_BAR; }
    PG8_BAR;
    if constexpr (Epi::AFTER_DRAIN) { E.fused(acc, cur, wr, wc, fr, fq, lds, wid, lane); S.done(cur); }
#undef PG8_SA
#undef PG8_SB
#undef PG8_STAGE
#undef PG8_LDA
#undef PG8_LDB
#undef PG8_MMA
#undef PG8_WAIT_V
#undef PG8_WAIT_L
#undef PG8_BAR
#undef PG8_SCHED
}
}


using namespace cfg;
typedef unsigned short bf16_t;
typedef float f32x4 __attribute__((ext_vector_type(4)));
typedef unsigned u32x4 __attribute__((ext_vector_type(4)));
typedef unsigned u32x2 __attribute__((ext_vector_type(2)));

__device__ __forceinline__ float bf2f(unsigned v) { return __uint_as_float(v << 16); }
__device__ __forceinline__ float bflo(unsigned w) { return __uint_as_float(w << 16); }
__device__ __forceinline__ float bfhi(unsigned w) { return __uint_as_float(w & 0xffff0000u); }
__device__ __forceinline__ unsigned f2bf(float f) { unsigned u = __float_as_uint(f); return (u + 0x7fffu + ((u >> 16) & 1u)) >> 16; }
__device__ __forceinline__ unsigned pk2(float lo, float hi) { return f2bf(lo) | (f2bf(hi) << 16); }
__device__ __forceinline__ float sigm(float x) { return 1.f / (1.f + __expf(-x)); }
__device__ __forceinline__ float silu(float x) { return x / (1.f + __expf(-x)); }
__device__ __forceinline__ float wave_sum(float v) {
#pragma unroll
    for (int o = 1; o < 64; o <<= 1) v += __shfl_xor(v, o);
    return v;
}
__device__ __forceinline__ size_t stream_off(int row, bool& is_ctx) { const int b = row / PB, p = row - b * PB; is_ctx = p < CTXL; return is_ctx ? ((size_t)b * CTXL + p) * D : ((size_t)b * SEQ + (p - CTXL)) * D; }

constexpr size_t MiB = 1u << 20;
constexpr size_t WS_CTL = 0;
constexpr size_t WS_MODV = 1 * MiB;
constexpr size_t WS_LBF = WS_MODV + 256 * 1024;
constexpr size_t WS_COS = 2 * MiB, WS_SIN = 3 * MiB;
constexpr size_t WS_WIN = 4 * MiB;
constexpr size_t WS_WOUT = 13 * MiB;
constexpr size_t WS_WGU = 17 * MiB;
constexpr size_t WS_WD = 49 * MiB;
constexpr size_t WS_XC = 65 * MiB;
constexpr size_t WS_XN = 67 * MiB;
constexpr size_t WS_PROJ = 100 * MiB;
constexpr size_t WS_QN = 175 * MiB;
constexpr size_t WS_KN = 192 * MiB;
constexpr size_t WS_MIX = 197 * MiB;
constexpr size_t WS_HO = 230 * MiB;
constexpr size_t WS_ACT = 263 * MiB;
constexpr size_t WS_COMB = 280 * MiB;
constexpr size_t WS_SEL = 282 * MiB;
constexpr size_t WS_END = 283 * MiB;

__global__ __launch_bounds__(256) void k_modvec(const float* __restrict__ c, const float* __restrict__ cctx, const float* __restrict__ w_mod, const float* __restrict__ b_mod, float* __restrict__ MODV) {
    __shared__ float act[3][1024];
    for (int i = threadIdx.x; i < 3072; i += 256) { const int r = i >> 10, k = i & 1023; const float v = r < 2 ? c[r * 1024 + k] : cctx[k]; act[r][k] = silu(v); }
    __syncthreads();
    const int gid = blockIdx.x * 256 + threadIdx.x, l = gid / 6144, n = gid - l * 6144;
    const float* w = w_mod + (size_t)l * 1024 * 6144 + n;
    float a0 = 0.f, a1 = 0.f, a2 = 0.f;
#pragma unroll 8
    for (int k = 0; k < 1024; ++k) { const float wv = w[(size_t)k * 6144]; a0 += act[0][k] * wv; a1 += act[1][k] * wv; a2 += act[2][k] * wv; }
    const float bm = b_mod[l * 6144 + n];
    MODV[(l * 3 + 0) * 6144 + n] = a0 + bm; MODV[(l * 3 + 1) * 6144 + n] = a1 + bm; MODV[(l * 3 + 2) * 6144 + n] = a2 + bm;
}

__device__ const float ROPE_INV[16] = {1.0f, 0.5623413251903491f, 0.31622776601683794f, 0.1778279410038923f, 0.1f, 0.05623413251903491f, 0.03162277660168379f, 0.01778279410038923f,
                                       0.01f, 0.005623413251903491f, 0.0031622776601683794f, 0.0017782794100389228f, 0.001f, 0.0005623413251903491f, 0.00031622776601683794f, 0.00017782794100389227f};
__device__ __forceinline__ void sincos_d(double a, double& s, double& c) {
    const double k = rint(a * 0.63661977236758134308);
    double r = fma(-k, 1.57079632679489655800e+00, a);
    r = fma(-k, 6.12323399573676603587e-17, r);
    const double r2 = r * r;
    double sp = -7.6471637318198164759e-13;
    sp = fma(sp, r2, 1.6059043836821614599e-10);
    sp = fma(sp, r2, -2.5052108385441718775e-08);
    sp = fma(sp, r2, 2.7557319223985890653e-06);
    sp = fma(sp, r2, -1.9841269841269841270e-04);
    sp = fma(sp, r2, 8.3333333333333333333e-03);
    sp = fma(sp, r2, -1.6666666666666666667e-01);
    const double sr = fma(sp * r2, r, r);
    double cp = 4.7794773323873852974e-14;
    cp = fma(cp, r2, -1.1470745597729724714e-11);
    cp = fma(cp, r2, 2.0876756987868098979e-09);
    cp = fma(cp, r2, -2.7557319223985890653e-07);
    cp = fma(cp, r2, 2.4801587301587301587e-05);
    cp = fma(cp, r2, -1.3888888888888888889e-03);
    cp = fma(cp, r2, 4.1666666666666666667e-02);
    cp = fma(cp, r2, -0.5);
    const double cr = fma(cp, r2, 1.0);
    const int q = ((int)k) & 3;
    s = (q == 0) ? sr : (q == 1) ? cr : (q == 2) ? -sr : -cr;
    c = (q == 0) ? cr : (q == 1) ? -sr : (q == 2) ? -cr : sr;
}
__global__ __launch_bounds__(256) void k_tables(const float* __restrict__ hgrn_lb, float* __restrict__ COS, float* __restrict__ SIN, float* __restrict__ LBF) {
    const int gid = blockIdx.x * 256 + threadIdx.x;
    if (gid < SEQ * 32) {
        const int t = gid >> 5, j = gid & 31;
        const float pos = (float)(j < 16 ? (t >> 6) : (t & 63));
        const float ang = pos * ROPE_INV[j & 15];
        double s, c; sincos_d((double)ang, s, c);
        COS[gid] = (float)c; SIN[gid] = (float)s;
    }
    if (gid < 1024) {
        const int l = gid >> 9, r = gid & 511;
        float v = 0.f;
        if (l == 1) v = 1.f / (1.f + expf(hgrn_lb[r] - hgrn_lb[512 + r]));
        LBF[gid] = fmaxf(v, 1e-30f);
    }
}

__global__ __launch_bounds__(256) void k_transpose(const float* __restrict__ W, int K, int N, bf16_t* __restrict__ WT, int mode, size_t src_stride, size_t dst_stride) {
    __shared__ float scr_all[4][64 * 33];
    const int lane = threadIdx.x & 63, wave = threadIdx.x >> 6;
    float* scr = scr_all[wave];
    W += (size_t)blockIdx.y * src_stride; WT += (size_t)blockIdx.y * dst_stride;
    const int nblk = N / 32, nitems = (K / 64) * nblk;
    for (int item = blockIdx.x * 4 + wave; item < nitems; item += gridDim.x * 4) {
        const int kb = item / nblk, nb = item - kb * nblk, k0 = 64 * kb, n0 = 32 * nb;
#pragma unroll 8
        for (int i = 0; i < 32; ++i) { const int kk = 2 * i + (lane >> 5); scr[kk * 33 + (lane & 31)] = W[(size_t)(k0 + kk) * N + n0 + (lane & 31)]; }
        asm volatile("s_waitcnt lgkmcnt(0)" ::: "memory");
        const int rbase = (mode == 0) ? n0 : ((n0 >> 7) * 256 + (mode == 2 ? 128 : 0) + (n0 & 127));
        const int cch = lane & 7;
#pragma unroll
        for (int j = 0; j < 4; ++j) { const int n = (lane >> 3) + 8 * j; const float* s = scr + (8 * cch) * 33 + n;
            u32x4 o; o.x = pk2(s[0 * 33], s[1 * 33]); o.y = pk2(s[2 * 33], s[3 * 33]); o.z = pk2(s[4 * 33], s[5 * 33]); o.w = pk2(s[6 * 33], s[7 * 33]);
            *(u32x4*)(WT + (size_t)(rbase + n) * K + k0 + 8 * cch) = o; }
        asm volatile("s_waitcnt lgkmcnt(0)" ::: "memory");
    }
}

__global__ __launch_bounds__(512) void k_norm1(const float* __restrict__ lat, const float* __restrict__ cx, const float* __restrict__ g, const float* __restrict__ modv, int sh_off, bf16_t* __restrict__ XN) {
    const int lane = threadIdx.x & 63, gw = blockIdx.x * 8 + (threadIdx.x >> 6), NGW = gridDim.x * 8;
    for (int row = gw; row < MT; row += NGW) {
        bool is_ctx; const size_t off = stream_off(row, is_ctx);
        const int r = is_ctx ? 2 : row / PB;
        const f32x4* xr = (const f32x4*)((is_ctx ? cx : lat) + off) + lane;
        f32x4 v[4]; float ss = 0.f;
#pragma unroll
        for (int j = 0; j < 4; ++j) { v[j] = xr[64 * j]; ss += (v[j].x * v[j].x + v[j].y * v[j].y) + (v[j].z * v[j].z + v[j].w * v[j].w); }
        const float rstd = 1.f / sqrtf(wave_sum(ss) * (1.f / D) + EPS);
        const float* mv = modv + r * 6144 + sh_off;
#pragma unroll
        for (int j = 0; j < 4; ++j) { const int col = 4 * lane + 256 * j;
            const f32x4 gg = *(const f32x4*)(g + col), sh = *(const f32x4*)(mv + col), sc = *(const f32x4*)(mv + 1024 + col);
            const f32x4 o = v[j] * rstd * gg * (sc + 1.f) + sh;
            u32x2 w; w.x = pk2(o.x, o.y); w.y = pk2(o.z, o.w);
            *(u32x2*)(XN + (size_t)row * D + col) = w; }
    }
}

__global__ __launch_bounds__(512) void k_norm2_router(const float* __restrict__ lat, const float* __restrict__ cx, const float* __restrict__ g, const float* __restrict__ modv, int sh_off,
                                                      const float* __restrict__ router_w, const float* __restrict__ router_b, bf16_t* __restrict__ XN, float* __restrict__ COMB, u32x4* __restrict__ SEL) {
    const int lane = threadIdx.x & 63, gw = blockIdx.x * 8 + (threadIdx.x >> 6), NGW = gridDim.x * 8;
    for (int row = gw; row < MT; row += NGW) {
        bool is_ctx; const size_t off = stream_off(row, is_ctx);
        const int r = is_ctx ? 2 : row / PB;
        const f32x4* xr = (const f32x4*)((is_ctx ? cx : lat) + off) + lane;
        f32x4 v[4]; float ss = 0.f;
#pragma unroll
        for (int j = 0; j < 4; ++j) { v[j] = xr[64 * j]; ss += (v[j].x * v[j].x + v[j].y * v[j].y) + (v[j].z * v[j].z + v[j].w * v[j].w); }
        const float rstd = 1.f / sqrtf(wave_sum(ss) * (1.f / D) + EPS);
        const float* mv = modv + r * 6144 + sh_off;
        float lg[16];
#pragma unroll
        for (int e = 0; e < 16; ++e) lg[e] = 0.f;
#pragma unroll
        for (int j = 0; j < 4; ++j) { const int col = 4 * lane + 256 * j;
            const f32x4 gg = *(const f32x4*)(g + col), sh = *(const f32x4*)(mv + col), sc = *(const f32x4*)(mv + 1024 + col);
            const f32x4 o = v[j] * rstd * gg * (sc + 1.f) + sh;
            u32x2 w; w.x = pk2(o.x, o.y); w.y = pk2(o.z, o.w);
            *(u32x2*)(XN + (size_t)row * D + col) = w;
#pragma unroll
            for (int i = 0; i < 4; ++i) { const float ov = o[i]; const f32x4* rw = (const f32x4*)(router_w + (size_t)(col + i) * 16);
#pragma unroll
                for (int q = 0; q < 4; ++q) { const f32x4 w4 = rw[q]; lg[4 * q + 0] += ov * w4.x; lg[4 * q + 1] += ov * w4.y; lg[4 * q + 2] += ov * w4.z; lg[4 * q + 3] += ov * w4.w; }
                asm volatile("" ::: "memory"); } }
        float sc_[16], sel[16];
#pragma unroll
        for (int e = 0; e < 16; ++e) { lg[e] = wave_sum(lg[e]); sc_[e] = 1.f / (1.f + expf(-lg[e])); sel[e] = sc_[e] + router_b[e]; }
        float gs[4]; int gi1[4], gi2[4]; float gw1[4], gw2[4];
#pragma unroll
        for (int q = 0; q < 4; ++q) { float v1 = -INFINITY, v2 = -INFINITY; int i1 = 0, i2 = 0; float s1 = 0.f, s2 = 0.f;
#pragma unroll
            for (int k = 0; k < 4; ++k) { const float x = sel[4 * q + k], sx = sc_[4 * q + k];
                if (x > v1) { v2 = v1; i2 = i1; s2 = s1; v1 = x; i1 = 4 * q + k; s1 = sx; } else if (x > v2) { v2 = x; i2 = 4 * q + k; s2 = sx; } }
            gs[q] = v1 + v2; gi1[q] = i1; gi2[q] = i2; gw1[q] = s1; gw2[q] = s2; }
        float bv = gs[0]; int e0 = gi1[0], e1 = gi2[0]; float w0 = gw1[0], w1 = gw2[0];
#pragma unroll
        for (int q = 1; q < 4; ++q) if (gs[q] > bv) { bv = gs[q]; e0 = gi1[q]; e1 = gi2[q]; w0 = gw1[q]; w1 = gw2[q]; }
        const float ws = w0 + w1; w0 /= ws; w1 /= ws;
        if (lane < 16) COMB[(size_t)row * 16 + lane] = (lane == e0) ? w0 : (lane == e1) ? w1 : 0.f;
        if (lane == 0) { u32x4 sv; sv.x = (unsigned)e0; sv.y = (unsigned)e1; sv.z = __float_as_uint(w0); sv.w = __float_as_uint(w1); SEL[row] = sv; }
    }
}

__global__ __launch_bounds__(512) void k_post(const bf16_t* __restrict__ PROJ, const float* __restrict__ qg, const float* __restrict__ kg, const float* __restrict__ COS, const float* __restrict__ SIN,
                                              bf16_t* __restrict__ QN, bf16_t* __restrict__ KN) {
    const int lane = threadIdx.x & 63, gw = blockIdx.x * 8 + (threadIdx.x >> 6), NGW = gridDim.x * 8;
    for (int row = gw; row < MT; row += NGW) {
        const int b = row / PB, p = row - b * PB; const bool is_ctx = p < CTXL; const int t = is_ctx ? 0 : p - CTXL;
        const bf16_t* pr = PROJ + (size_t)row * NIN;
        {
            const u32x4 w = *(const u32x4*)(pr + C_CQ + lane * 8);
            float x[8] = {bflo(w.x), bfhi(w.x), bflo(w.y), bfhi(w.y), bflo(w.z), bfhi(w.z), bflo(w.w), bfhi(w.w)};
            float ss = 0.f;
#pragma unroll
            for (int i = 0; i < 8; ++i) ss += x[i] * x[i];
            ss += __shfl_xor(ss, 1); ss += __shfl_xor(ss, 2); ss += __shfl_xor(ss, 4);
            const float rstd = 1.f / sqrtf(ss * (1.f / 64.f) + EPS);
            const int d0 = (lane & 7) * 8;
#pragma unroll
            for (int i = 0; i < 8; ++i) x[i] = x[i] * rstd * qg[d0 + i];
            if (!is_ctx) {
#pragma unroll
                for (int i = 0; i < 4; ++i) { const int j = (d0 >> 1) + i; const float cs = COS[t * 32 + j], sn = SIN[t * 32 + j];
                    const float x1 = x[2 * i], x2 = x[2 * i + 1]; x[2 * i] = x1 * cs - x2 * sn; x[2 * i + 1] = x1 * sn + x2 * cs; } }
            u32x4 o; o.x = pk2(x[0] * C2, x[1] * C2); o.y = pk2(x[2] * C2, x[3] * C2); o.z = pk2(x[4] * C2, x[5] * C2); o.w = pk2(x[6] * C2, x[7] * C2);
            *(u32x4*)(QN + (size_t)row * 512 + lane * 8) = o;
        }
        {
            const unsigned w = *(const unsigned*)(pr + C_CK + lane * 2);
            float x1 = bflo(w), x2 = bfhi(w);
            float ss = x1 * x1 + x2 * x2;
            ss += __shfl_xor(ss, 1); ss += __shfl_xor(ss, 2); ss += __shfl_xor(ss, 4); ss += __shfl_xor(ss, 8); ss += __shfl_xor(ss, 16);
            const float rstd = 1.f / sqrtf(ss * (1.f / 64.f) + EPS);
            const int j = lane & 31;
            x1 = x1 * rstd * kg[2 * j]; x2 = x2 * rstd * kg[2 * j + 1];
            if (!is_ctx) { const float cs = COS[t * 32 + j], sn = SIN[t * 32 + j]; const float a = x1 * cs - x2 * sn, c = x1 * sn + x2 * cs; x1 = a; x2 = c; }
            *(unsigned*)(KN + (size_t)row * 128 + lane * 2) = pk2(x1, x2);
        }
    }
}

__global__ __launch_bounds__(256) void k_pool(const bf16_t* __restrict__ PROJ, const float* __restrict__ pw, const float* __restrict__ pscale, bf16_t* __restrict__ MIX) {
    __shared__ float dsh[16][256];
    const int tid = threadIdx.x, g = tid >> 6, row0 = blockIdx.x * 16;
    const int win = 2 << g;
    for (int r = 0; r < 16; ++r) {
        const int row = row0 + r, b = row / PB, p = row - b * PB; const bool is_ctx = p < CTXL;
        const int seg0 = b * PB + (is_ctx ? 0 : CTXL), len = is_ctx ? CTXL : SEQ, t = is_ctx ? p : p - CTXL;
        int lo = t - win / 2; if (lo < 0) lo = 0; int hi = t + win / 2; if (hi > len) hi = len;
        float s = 0.f;
        for (int q = lo; q < hi; ++q) s += bf2f(PROJ[(size_t)(seg0 + q) * NIN + C_BP + tid]);
        const float own = bf2f(PROJ[(size_t)row * NIN + C_BP + tid]);
        dsh[r][tid] = s / (float)(hi - lo) - own;
    }
    __syncthreads();
    float acc[16];
#pragma unroll
    for (int r = 0; r < 16; ++r) acc[r] = 0.f;
    const int e = tid & 63;
    for (int c = 0; c < 64; ++c) { const float wv = pw[(g * 64 + c) * 64 + e];
#pragma unroll
        for (int r = 0; r < 16; ++r) acc[r] += dsh[r][g * 64 + c] * wv; }
    const float sc = pscale[tid];
#pragma unroll
    for (int r = 0; r < 16; ++r) MIX[(size_t)(row0 + r) * D + 256 + tid] = (bf16_t)f2bf(acc[r] * sc);
}

__device__ __forceinline__ int hg_row(int b, int dir, int step) { const int p = dir == 0 ? step : (step < CTXL ? CTXL - 1 - step : PB - 1 - (step - CTXL)); return b * PB + p; }
__global__ __launch_bounds__(1024) void k_hgrn_naive(const bf16_t* __restrict__ PROJ, const float* __restrict__ LBF, float* __restrict__ HO) {
    const int chain = blockIdx.x, b = chain >> 3, h = (chain >> 1) & 3, dir = chain & 1;
    const int tid = threadIdx.x, j = tid & 63, ig = tid >> 6, i0 = ig * 4;
    __shared__ float sq[64], sf[64], sk[64], sv[64], part[16][64];
    float S0 = 0.f, S1 = 0.f, S2 = 0.f, S3 = 0.f;
    float lbf = 0.f, oml = 0.f;
    unsigned zq = 0, zf = 0, zi = 0;
    const int cf = (dir ? C_AFB : C_AFF) + h * 64 + (tid & 63);
    if (tid < 64) { lbf = LBF[dir * 256 + h * 64 + tid]; oml = 1.f - lbf;
        const bf16_t* pr = PROJ + (size_t)hg_row(b, dir, 0) * NIN; zq = pr[C_AQ + h * 64 + tid]; zf = pr[cf]; zi = pr[C_AI + h * 64 + tid]; }
    for (int step = 0; step < PB; ++step) {
        const int row = hg_row(b, dir, step);
        if (tid < 64) {
            const float q = bf2f(zq), z = bf2f(zf), v = bf2f(zi);
            const float sg = sigm(z);
            sq[tid] = silu(q); sf[tid] = lbf + oml * sg; sk[tid] = oml * (1.f - sg); sv[tid] = v;
            if (step + 1 < PB) { const bf16_t* pr = PROJ + (size_t)hg_row(b, dir, step + 1) * NIN; zq = pr[C_AQ + h * 64 + tid]; zf = pr[cf]; zi = pr[C_AI + h * 64 + tid]; }
        }
        __syncthreads();
        const float vj = sv[j];
        S0 = sf[i0 + 0] * S0 + sk[i0 + 0] * vj; S1 = sf[i0 + 1] * S1 + sk[i0 + 1] * vj; S2 = sf[i0 + 2] * S2 + sk[i0 + 2] * vj; S3 = sf[i0 + 3] * S3 + sk[i0 + 3] * vj;
        part[ig][j] = (S0 * sq[i0 + 0] + S1 * sq[i0 + 1]) + (S2 * sq[i0 + 2] + S3 * sq[i0 + 3]);
        __syncthreads();
        if (tid < 64) { float o = 0.f;
#pragma unroll
            for (int q = 0; q < 16; ++q) o += part[q][tid];
            HO[((size_t)dir * MT + row) * 256 + h * 64 + tid] = o; }
    }
}
__global__ __launch_bounds__(512) void k_hgrn_readout(const float* __restrict__ HO, const bf16_t* __restrict__ PROJ, const float* __restrict__ ng, bf16_t* __restrict__ MIX) {
    const int lane = threadIdx.x & 63, gw = blockIdx.x * 8 + (threadIdx.x >> 6), NGW = gridDim.x * 8;
    for (int row = gw; row < MT; row += NGW) {
        const f32x4 a = *(const f32x4*)(HO + (size_t)row * 256 + lane * 4), c = *(const f32x4*)(HO + ((size_t)MT + row) * 256 + lane * 4);
        const f32x4 o = a + c;
        float ss = (o.x * o.x + o.y * o.y) + (o.z * o.z + o.w * o.w);
        ss += __shfl_xor(ss, 1); ss += __shfl_xor(ss, 2); ss += __shfl_xor(ss, 4); ss += __shfl_xor(ss, 8);
        const float rstd = 1.f / sqrtf(ss * (1.f / 64.f) + EPS);
        const u32x2 gz = *(const u32x2*)(PROJ + (size_t)row * NIN + C_AG + lane * 4);
        const f32x4 n4 = *(const f32x4*)(ng + (lane & 15) * 4);
        const float y0 = o.x * rstd * n4.x * silu(bflo(gz.x)), y1 = o.y * rstd * n4.y * silu(bfhi(gz.x)), y2 = o.z * rstd * n4.z * silu(bflo(gz.y)), y3 = o.w * rstd * n4.w * silu(bfhi(gz.y));
        u32x2 w; w.x = pk2(y0, y1); w.y = pk2(y2, y3);
        *(u32x2*)(MIX + (size_t)row * D + lane * 4) = w;
    }
}

__global__ __launch_bounds__(256) void k_attn_naive(const bf16_t* __restrict__ QN, const bf16_t* __restrict__ KN, const bf16_t* __restrict__ PROJ, bf16_t* __restrict__ MIX) {
    __shared__ float Ks[64][64], Vs[64][64];
    const int u = blockIdx.x, tid = threadIdx.x;
    int b, h, qrow, nkeys;
    if (u < 512) { b = u >> 8; h = (u >> 5) & 7; qrow = b * PB + CTXL + (u & 31) * 256 + tid; nkeys = PB; }
    else { const int v = u - 512; b = v >> 3; h = v & 7; qrow = b * PB + tid; nkeys = CTXL; }
    const int kvh = h >> 2;
    float q[64], o[64]; float m = -1e30f, l = 0.f;
#pragma unroll
    for (int i = 0; i < 8; ++i) { const u32x4 w = *(const u32x4*)(QN + (size_t)qrow * 512 + h * 64 + i * 8);
        q[8 * i + 0] = bflo(w.x); q[8 * i + 1] = bfhi(w.x); q[8 * i + 2] = bflo(w.y); q[8 * i + 3] = bfhi(w.y); q[8 * i + 4] = bflo(w.z); q[8 * i + 5] = bfhi(w.z); q[8 * i + 6] = bflo(w.w); q[8 * i + 7] = bfhi(w.w); }
#pragma unroll
    for (int d = 0; d < 64; ++d) o[d] = 0.f;
    for (int kt = 0; kt < nkeys; kt += 64) {
        __syncthreads();
        { const int key = tid >> 2, d0 = (tid & 3) * 16; const size_t krow = (size_t)b * PB + kt + key;
          const u32x4* kp = (const u32x4*)(KN + krow * 128 + kvh * 64 + d0); const u32x4* vp = (const u32x4*)(PROJ + krow * NIN + C_CV + kvh * 64 + d0);
#pragma unroll
          for (int i = 0; i < 2; ++i) { const u32x4 kw = kp[i], vw = vp[i]; float* kd = &Ks[key][d0 + 8 * i]; float* vd = &Vs[key][d0 + 8 * i];
              kd[0] = bflo(kw.x); kd[1] = bfhi(kw.x); kd[2] = bflo(kw.y); kd[3] = bfhi(kw.y); kd[4] = bflo(kw.z); kd[5] = bfhi(kw.z); kd[6] = bflo(kw.w); kd[7] = bfhi(kw.w);
              vd[0] = bflo(vw.x); vd[1] = bfhi(vw.x); vd[2] = bflo(vw.y); vd[3] = bfhi(vw.y); vd[4] = bflo(vw.z); vd[5] = bfhi(vw.z); vd[6] = bflo(vw.w); vd[7] = bfhi(vw.w); } }
        __syncthreads();
        for (int k0 = 0; k0 < 64; k0 += 16) {
            float s[16]; float mx = -1e30f;
#pragma unroll
            for (int kk = 0; kk < 16; ++kk) { float a = 0.f;
#pragma unroll
                for (int d = 0; d < 64; d += 4) { const f32x4 kv = *(const f32x4*)&Ks[k0 + kk][d]; a += q[d] * kv.x + q[d + 1] * kv.y + q[d + 2] * kv.z + q[d + 3] * kv.w; }
                s[kk] = a; mx = fmaxf(mx, a); }
            const float mnew = fmaxf(m, mx), scl = exp2f(m - mnew); m = mnew; l *= scl;
#pragma unroll
            for (int d = 0; d < 64; ++d) o[d] *= scl;
#pragma unroll
            for (int kk = 0; kk < 16; ++kk) { const float pp = exp2f(s[kk] - m); l += pp;
#pragma unroll
                for (int d = 0; d < 64; d += 4) { const f32x4 vv = *(const f32x4*)&Vs[k0 + kk][d]; o[d] += pp * vv.x; o[d + 1] += pp * vv.y; o[d + 2] += pp * vv.z; o[d + 3] += pp * vv.w; } }
        }
    }
    const float rl = 1.f / l;
#pragma unroll
    for (int i = 0; i < 8; ++i) { u32x4 w; w.x = pk2(o[8 * i] * rl, o[8 * i + 1] * rl); w.y = pk2(o[8 * i + 2] * rl, o[8 * i + 3] * rl); w.z = pk2(o[8 * i + 4] * rl, o[8 * i + 5] * rl); w.w = pk2(o[8 * i + 6] * rl, o[8 * i + 7] * rl);
        *(u32x4*)(MIX + (size_t)qrow * D + 512 + h * 64 + i * 8) = w; }
}

namespace pg8 {
struct EpiResid {
    static constexpr bool PERM = false, AFTER_DRAIN = false;
    const float* src_lat; const float* src_ctx; float* dst_lat; float* dst_ctx; const float* modv; int ga_off; int pad;
    __device__ __forceinline__ void operator()(const f32x4 (&acc)[2][2][4][2], const Unit& u, int wr, int wc, int fr, int fq) const {
        const int b = u.pm / TPB, w = u.pm - b * TPB;
        const size_t base = (w == 0) ? (size_t)b * CTXL * D : ((size_t)b * SEQ + (size_t)(w - 1) * 256) * D;
        const float* s = ((w == 0) ? src_ctx : src_lat) + base; float* d = ((w == 0) ? dst_ctx : dst_lat) + base;
        const float* ga = modv + ((w == 0) ? 2 : b) * 6144 + ga_off;
        const int row0 = wr * 64 + fr, col0 = u.pn * BM + wc * 32 + 4 * fq;
        f32x4 gv[2][2];
#pragma unroll
        for (int bj = 0; bj < 2; ++bj)
#pragma unroll
            for (int n = 0; n < 2; ++n) gv[bj][n] = *(const f32x4*)(ga + col0 + bj * HALF + n * 16);
#pragma unroll
        for (int ai = 0; ai < 2; ++ai)
#pragma unroll
            for (int m = 0; m < 4; ++m) { const size_t off = (size_t)(row0 + ai * HALF + m * 16) * D + col0;
#pragma unroll
                for (int bj = 0; bj < 2; ++bj)
#pragma unroll
                    for (int n = 0; n < 2; ++n) *(f32x4*)(d + off + bj * HALF + n * 16) = *(const f32x4*)(s + off + bj * HALF + n * 16) + gv[bj][n] * acc[ai][bj][m][n]; }
    }
};
struct EpiGateUp {
    static constexpr bool PERM = true, AFTER_DRAIN = false;
    bf16_t* ACT; const float* comb; int e; int pad;
    __device__ __forceinline__ void operator()(const f32x4 (&acc)[2][2][4][2], const Unit& u, int wr, int wc, int fr, int fq) const {
        const int row0 = u.pm * BM + wr * 64 + fr, colA = u.pn * HALF + wc * 32 + 8 * fq;
#pragma unroll
        for (int ai = 0; ai < 2; ++ai)
#pragma unroll
            for (int m = 0; m < 4; ++m) { const int row = row0 + ai * HALF + m * 16; const float cw = comb[(size_t)row * 16 + e];
                const f32x4 g0 = acc[ai][0][m][0], g1 = acc[ai][0][m][1], u0 = acc[ai][1][m][0], u1 = acc[ai][1][m][1];
                u32x4 w;
                w.x = cvt_pk_bf16(silu(g0[0]) * u0[0] * cw, silu(g0[1]) * u0[1] * cw); w.y = cvt_pk_bf16(silu(g0[2]) * u0[2] * cw, silu(g0[3]) * u0[3] * cw);
                w.z = cvt_pk_bf16(silu(g1[0]) * u1[0] * cw, silu(g1[1]) * u1[1] * cw); w.w = cvt_pk_bf16(silu(g1[2]) * u1[2] * cw, silu(g1[3]) * u1[3] * cw);
                *(u32x4*)(ACT + (size_t)row * DE + colA) = w; }
    }
};
}

template <class Epi> __global__ void __launch_bounds__(512, 2) k_gemm(pg8::Gemm g, Epi E) {
    extern __shared__ __attribute__((aligned(16))) unsigned char lds[];
    pg8::StaticOrder S; S.init(g.M, g.N, (int)gridDim.x, (int)blockIdx.x);
    pg8::gemm_phase<Epi, pg8::StaticOrder, true, true>((PG8_LAS unsigned char*)lds, g, S, E);
}

constexpr int GEMM_LDS = 147456;
template <class Epi> static void launch_gemm(const pg8::Gemm& g, const Epi& E, int G, hipStream_t stream) { hipLaunchKernelGGL(k_gemm<Epi>, dim3(G), dim3(512), GEMM_LDS, stream, g, E); }
template <class T> static T zeroed() { T t; memset((void*)&t, 0, sizeof(T)); return t; }
extern "C" void kernel_launch(void* const* d_in, const int* in_sizes, int n_in, void* d_out, int out_size, void* d_ws, size_t ws_size, hipStream_t stream) {
    static int ok = 0;
    if (ok == 0) {
        if (n_in != 21 || in_sizes[0] != BATCH * SEQ * D || out_size != BATCH * SEQ * D || ws_size < WS_END) {
            fprintf(stderr, "kernel_launch: unexpected sizes: n_in %d in0 %d out %d ws %zu (need %zu)\n", n_in, n_in > 0 ? in_sizes[0] : -1, out_size, ws_size, (size_t)WS_END); ok = -1; return; }
        hipFuncSetAttribute((const void*)k_gemm<pg8::EpiBf16<0>>, hipFuncAttributeMaxDynamicSharedMemorySize, GEMM_LDS);
        hipFuncSetAttribute((const void*)k_gemm<pg8::EpiResid>, hipFuncAttributeMaxDynamicSharedMemorySize, GEMM_LDS);
        hipFuncSetAttribute((const void*)k_gemm<pg8::EpiGateUp>, hipFuncAttributeMaxDynamicSharedMemorySize, GEMM_LDS);
        ok = 1;
    }
    if (ok < 0) return;
    const float* x = (const float*)d_in[0]; const float* c = (const float*)d_in[1]; const float* ctx = (const float*)d_in[2]; const float* c_ctx = (const float*)d_in[3];
    const float* w_mod = (const float*)d_in[4]; const float* b_mod = (const float*)d_in[5]; const float* norm1_g = (const float*)d_in[6]; const float* norm2_g = (const float*)d_in[7];
    const float* w_in = (const float*)d_in[8]; const float* w_out = (const float*)d_in[9]; const float* hgrn_lb = (const float*)d_in[10]; const float* hgrn_norm_g = (const float*)d_in[11];
    const float* pool_w = (const float*)d_in[12]; const float* pool_scale = (const float*)d_in[13]; const float* q_norm_g = (const float*)d_in[14]; const float* k_norm_g = (const float*)d_in[15];
    const float* router_w = (const float*)d_in[16]; const float* router_b = (const float*)d_in[17]; const float* moe_w_gate = (const float*)d_in[18]; const float* moe_w_up = (const float*)d_in[19];
    const float* moe_w_down = (const float*)d_in[20];
    unsigned char* ws = (unsigned char*)d_ws; float* out = (float*)d_out;
    float* MODV = (float*)(ws + WS_MODV); float* LBF = (float*)(ws + WS_LBF); float* COS = (float*)(ws + WS_COS); float* SIN = (float*)(ws + WS_SIN);
    bf16_t* WIN = (bf16_t*)(ws + WS_WIN); bf16_t* WOUT = (bf16_t*)(ws + WS_WOUT); bf16_t* WGU = (bf16_t*)(ws + WS_WGU); bf16_t* WD = (bf16_t*)(ws + WS_WD);
    float* XC = (float*)(ws + WS_XC); bf16_t* XN = (bf16_t*)(ws + WS_XN); bf16_t* PROJ = (bf16_t*)(ws + WS_PROJ); bf16_t* QN = (bf16_t*)(ws + WS_QN); bf16_t* KN = (bf16_t*)(ws + WS_KN);
    bf16_t* MIX = (bf16_t*)(ws + WS_MIX); float* HO = (float*)(ws + WS_HO); bf16_t* ACT = (bf16_t*)(ws + WS_ACT); float* COMB = (float*)(ws + WS_COMB); u32x4* SEL = (u32x4*)(ws + WS_SEL);
    const int G = 256;

    k_modvec<<<48, 256, 0, stream>>>(c, c_ctx, w_mod, b_mod, MODV);
    k_tables<<<(SEQ * 32) / 256, 256, 0, stream>>>(hgrn_lb, COS, SIN, LBF);
    k_transpose<<<dim3(256, 2), 256, 0, stream>>>(w_in, D, NIN, WIN, 0, (size_t)D * NIN, (size_t)NIN * D);
    k_transpose<<<dim3(128, 2), 256, 0, stream>>>(w_out, D, D, WOUT, 0, (size_t)D * D, (size_t)D * D);
    for (int l = 0; l < DEPTH; ++l) {
        k_transpose<<<dim3(64, 16), 256, 0, stream>>>(moe_w_gate + (size_t)l * NE * D * DE, D, DE, WGU, 1, (size_t)D * DE, (size_t)1024 * D);
        k_transpose<<<dim3(64, 16), 256, 0, stream>>>(moe_w_up + (size_t)l * NE * D * DE, D, DE, WGU, 2, (size_t)D * DE, (size_t)1024 * D);
        k_transpose<<<dim3(64, 16), 256, 0, stream>>>(moe_w_down + (size_t)l * NE * DE * D, DE, D, WD, 0, (size_t)DE * D, (size_t)D * DE);
        const float* slat = (l == 0) ? x : out; const float* sctx = (l == 0) ? ctx : XC;
        const float* modv = MODV + (size_t)l * 3 * 6144;
        k_norm1<<<G, 512, 0, stream>>>(slat, sctx, norm1_g + l * D, modv, 0, XN);
        { pg8::Gemm g = zeroed<pg8::Gemm>(); g.A = XN; g.Bt = WIN + (size_t)l * NIN * D; g.M = MT; g.N = NIN; g.K = D; pg8::EpiBf16<0> E = zeroed<pg8::EpiBf16<0>>(); E.O = PROJ; E.ldc = NIN; E.scale0 = 1.f;
          launch_gemm(g, E, G, stream); }
        k_post<<<G, 512, 0, stream>>>(PROJ, q_norm_g + l * 64, k_norm_g + l * 64, COS, SIN, QN, KN);
        k_pool<<<MT / 16, 256, 0, stream>>>(PROJ, pool_w + (size_t)l * 4 * 64 * 64, pool_scale + l * 256, MIX);
        k_hgrn_naive<<<16, 1024, 0, stream>>>(PROJ, LBF + l * 512, HO);
        k_hgrn_readout<<<G, 512, 0, stream>>>(HO, PROJ, hgrn_norm_g + l * 64, MIX);
        k_attn_naive<<<512 + 16, 256, 0, stream>>>(QN, KN, PROJ, MIX);
        { pg8::Gemm g = zeroed<pg8::Gemm>(); g.A = MIX; g.Bt = WOUT + (size_t)l * D * D; g.M = MT; g.N = D; g.K = D; pg8::EpiResid E = zeroed<pg8::EpiResid>(); E.src_lat = slat; E.src_ctx = sctx; E.dst_lat = out; E.dst_ctx = XC; E.modv = modv; E.ga_off = 2048; E.pad = 0;
          launch_gemm(g, E, G, stream); }
        k_norm2_router<<<G, 512, 0, stream>>>(out, XC, norm2_g + l * D, modv, 3072, router_w, router_b, XN, COMB, SEL);
        for (int e = 0; e < NE; ++e) {
            { pg8::Gemm g = zeroed<pg8::Gemm>(); g.A = XN; g.Bt = WGU + (size_t)e * 1024 * D; g.M = MT; g.N = 1024; g.K = D; pg8::EpiGateUp E = zeroed<pg8::EpiGateUp>(); E.ACT = ACT; E.comb = COMB; E.e = e; E.pad = 0;
              launch_gemm(g, E, G, stream); }
            { pg8::Gemm g = zeroed<pg8::Gemm>(); g.A = ACT; g.Bt = WD + (size_t)e * D * DE; g.M = MT; g.N = D; g.K = DE; pg8::EpiResid E = zeroed<pg8::EpiResid>(); E.src_lat = out; E.src_ctx = XC; E.dst_lat = out; E.dst_ctx = XC; E.modv = modv; E.ga_off = 5120; E.pad = 0;
              launch_gemm(g, E, G, stream); }
        }
    }
}
```

```cpp
#include <hip/hip_runtime.h>
#include <cstdio>
#include <cstdint>
#include <cstring>

namespace cfg {
constexpr int D = 1024, BATCH = 2, SEQ = 8192, CTXL = 256, DEPTH = 2;
constexpr int PB = SEQ + CTXL;
constexpr int MT = BATCH * PB;
constexpr int TPB = PB / 256;
constexpr int NIN = 2304;
constexpr int NE = 16, DE = 512;
constexpr int C_AQ = 0, C_AFF = 256, C_AFB = 512, C_AI = 768, C_AG = 1024, C_BP = 1280, C_CQ = 1536, C_CK = 2048, C_CV = 2176;
constexpr float EPS = 1e-6f;
constexpr float C2 = 0.125f * 1.4426950408889634f;
}

__device__ __forceinline__ int otid() { int t = threadIdx.x; asm volatile("" : "+v"(t)); return t; }

namespace pg8 {
#define PG8_LAS __attribute__((address_space(3)))
typedef unsigned short bf16_t;
typedef short bf16x8 __attribute__((ext_vector_type(8)));
typedef float f32x4 __attribute__((ext_vector_type(4)));
typedef unsigned u32x4 __attribute__((ext_vector_type(4)));
constexpr int BM = 256, BK = 64, HALF = 128, HTB = HALF * BK * 2  , STAGE_BYTES = 8 * HTB, NXCD = 8, WGM = 8;

__host__ __device__ __forceinline__ int lds_byte(int r, int c) { const int st = (r >> 4) * 2 + (c >> 5), rr = r & 15, cc = c & 31, ob = rr * 64 + cc * 2; return st * 1024 + (ob ^ (((ob >> 9) & 1) << 5)); }
__host__ __device__ __forceinline__ void stage_rc(int b, int& R, int& C) { const int st = b / 1024, sb = b % 1024, swz = sb ^ (((sb >> 9) & 1) << 5); R = (st >> 1) * 16 + swz / 64; C = (st & 1) * 32 + (swz % 64) / 2; }
__host__ __device__ __forceinline__ int perm32(int rho) { const int n = rho >> 4, i = rho & 15; return 8 * (i >> 2) + 4 * n + (i & 3); }

struct Unit { int pm, pn; };
struct Gemm { const bf16_t* A; const bf16_t* Bt; int M, N, K, pad; };

struct StaticOrder {
    int nM, nN, nwg, G, c;
    __host__ __device__ void init(int M, int N, int G_, int c_) { nM = M / BM; nN = N / BM; nwg = nM * nN; G = G_; c = c_; }
    __host__ __device__ bool next(int i, Unit& u) const {
        const long L = (long)i * G + c; if (L >= nwg) return false;
        int wgid = (int)L; { const int q = nwg / NXCD, r = nwg % NXCD, xcd = wgid % NXCD, off = wgid / NXCD; wgid = (xcd < r ? xcd * (q + 1) : r * (q + 1) + (xcd - r) * q) + off; }
        const int nig = WGM * nN, gid = wgid / nig, fm = gid * WGM, gsz = (nM - fm) < WGM ? (nM - fm) : WGM;
        u.pm = fm + ((wgid % nig) % gsz); u.pn = (wgid % nig) / gsz; return true;
    }
    __device__ __forceinline__ void a_ready(const Unit&) const {}
    __device__ __forceinline__ void done(const Unit&) const {}
};

__device__ __forceinline__ unsigned cvt_pk_bf16(float lo, float hi) { unsigned r; asm volatile("v_cvt_pk_bf16_f32 %0, %1, %2" : "=v"(r) : "v"(lo), "v"(hi)); return r; }
typedef float f32x2 __attribute__((ext_vector_type(2)));
__device__ __forceinline__ f32x2 gelu_pk(f32x2 v) {
    const f32x2 av = __builtin_elementwise_abs(v), d = av * 0.2316418882f + 1.0f;
    f32x2 t; t.x = __builtin_amdgcn_rcpf(d.x); t.y = __builtin_amdgcn_rcpf(d.y);
    f32x2 q = t * 0.5307027145f + (-0.7265760135f); q = q * t + 0.7107068705f; q = q * t + (-0.142248368f); q = q * t + 0.127414796f; q = q * t;
    const f32x2 s = (v * v) * (-0.72134752044f);
    f32x2 e; e.x = __builtin_amdgcn_exp2f(s.x); e.y = __builtin_amdgcn_exp2f(s.y);
    const f32x2 m = v * (q * e), r = v - m;
    f32x2 o; o.x = v.x < 0.f ? m.x : r.x; o.y = v.y < 0.f ? m.y : r.y; return o;
}

template <int ACT  > struct EpiBf16 {
    static constexpr bool PERM = true, AFTER_DRAIN = false; static_assert(ACT == 0 || ACT == 1, "EpiBf16: ACT is 0 (none) or 1 (gelu_pk)");
    bf16_t* O; int ldc; const float* bias; int split_cols; size_t split_stride; float scale0;
    __device__ __forceinline__ void operator()(const f32x4 (&acc)[2][2][4][2], const Unit& u, int wr, int wc, int fr, int fq) const {
        asm volatile("" : "+v"(fr), "+v"(fq));
        const int row0 = u.pm * BM + wr * 64 + fr; int colt = u.pn * BM; bf16_t* base = O;
        float sc = 1.f; if (split_cols) { const int t = colt / split_cols; base += (size_t)t * split_stride; colt -= t * split_cols; if (t == 0) sc = scale0; }
        const int col0 = colt + wc * 32 + 8 * fq, bcol0 = u.pn * BM + wc * 32 + 8 * fq;
        f32x4 bv[2][2];
#pragma unroll
        for (int bj = 0; bj < 2; ++bj)
#pragma unroll
            for (int n = 0; n < 2; ++n) bv[bj][n] = bias ? *(const f32x4*)(bias + bcol0 + bj * HALF + 4 * n) : (f32x4){0.f, 0.f, 0.f, 0.f};
#pragma unroll
        for (int ai = 0; ai < 2; ++ai)
#pragma unroll
            for (int m = 0; m < 4; ++m) { bf16_t* rowp = base + (size_t)(row0 + ai * HALF + m * 16) * ldc + col0;
#pragma unroll
                for (int bj = 0; bj < 2; ++bj) { f32x4 v0 = acc[ai][bj][m][0] + bv[bj][0], v1 = acc[ai][bj][m][1] + bv[bj][1];
                    if (ACT == 1) { f32x2 a = gelu_pk((f32x2){v0[0], v0[1]}), b = gelu_pk((f32x2){v0[2], v0[3]}), c = gelu_pk((f32x2){v1[0], v1[1]}), d = gelu_pk((f32x2){v1[2], v1[3]});
                        v0 = (f32x4){a.x, a.y, b.x, b.y}; v1 = (f32x4){c.x, c.y, d.x, d.y}; }
                    v0 = v0 * sc; v1 = v1 * sc; u32x4 w; w.x = cvt_pk_bf16(v0[0], v0[1]); w.y = cvt_pk_bf16(v0[2], v0[3]); w.z = cvt_pk_bf16(v1[0], v1[1]); w.w = cvt_pk_bf16(v1[2], v1[3]);
                    *(u32x4*)(rowp + bj * HALF) = w; } }
    }
};

template <class Epi, class Sched, bool ALIGN_EPI = false, bool SP2 = false>
__device__ __forceinline__ void gemm_phase(PG8_LAS unsigned char* lds, const Gemm g, const Sched& S, const Epi& E) {
    const int tid = otid(), wid = __builtin_amdgcn_readfirstlane(tid >> 6), lane = tid & 63, wr = wid >> 2, wc = wid & 3, fr = lane & 15, fq = lane >> 4;
    const int K = g.K, nt = K / BK;
    unsigned voffA[2], voffB[2];
#pragma unroll
    for (int i = 0; i < 2; ++i) { int R, C; stage_rc(tid * 16 + i * 8192, R, C); const int Rb = Epi::PERM ? ((R & ~31) + perm32(R & 31)) : R;
        voffA[i] = (unsigned)(R * K + C) * 2u; voffB[i] = (unsigned)(Rb * K + C) * 2u; }
    const size_t kstep = (size_t)(BK * 2);
    const size_t hstep = (size_t)HALF * K * 2;
    const size_t tstep = 2 * hstep;
    const unsigned ldsw = (unsigned)wid * 1024u;
    const int aoff = lds_byte(wr * 64 + fr, fq * 8), boff = lds_byte(wc * 32 + fr, fq * 8);
#define PG8_SA(b, h) (((b) * 2 + (h)) * HTB)
#define PG8_SB(b, h) ((4 + (b) * 2 + (h)) * HTB)
#define PG8_STAGE(bufoff, gbase, voff) do { _Pragma("unroll") for (int _i = 0; _i < 2; ++_i) \
        __builtin_amdgcn_global_load_lds((const unsigned*)((const char*)(gbase) + (voff)[_i]), (PG8_LAS unsigned*)(lds + (bufoff) + ldsw + _i * 8192), 16, 0, 0); } while (0)
#define PG8_LDA(dst, b, h) do { _Pragma("unroll") for (int m = 0; m < 4; ++m) _Pragma("unroll") for (int k = 0; k < 2; ++k) dst[m][k] = *(const PG8_LAS bf16x8*)(lds + PG8_SA(b, h) + aoff + m * 2048 + k * 1024); } while (0)
#define PG8_LDB(dst, b, h) do { _Pragma("unroll") for (int n = 0; n < 2; ++n) _Pragma("unroll") for (int k = 0; k < 2; ++k) dst[n][k] = *(const PG8_LAS bf16x8*)(lds + PG8_SB(b, h) + boff + n * 2048 + k * 1024); } while (0)
#define PG8_MMA(ai, bj, At, Bt) do { __builtin_amdgcn_s_setprio(1); _Pragma("unroll") for (int m = 0; m < 4; ++m) _Pragma("unroll") for (int n = 0; n < 2; ++n) _Pragma("unroll") for (int k = 0; k < 2; ++k) \
        acc[ai][bj][m][n] = __builtin_amdgcn_mfma_f32_16x16x32_bf16(Bt[n][k], At[m][k], acc[ai][bj][m][n], 0, 0, 0); __builtin_amdgcn_s_setprio(0); } while (0)
#define PG8_WAIT_V(n) asm volatile("s_waitcnt vmcnt(" #n ")" ::: "memory")
#define PG8_WAIT_L(n) asm volatile("s_waitcnt lgkmcnt(" #n ")" ::: "memory")
#define PG8_BAR __builtin_amdgcn_s_barrier()
#define PG8_SCHED __builtin_amdgcn_sched_barrier(0)
    Unit cur, nxt; int ui = 0;
    if (!S.next(0, cur)) return;
    f32x4 acc[2][2][4][2];
#pragma unroll
    for (int a = 0; a < 2; ++a)
#pragma unroll
        for (int b = 0; b < 2; ++b)
#pragma unroll
            for (int m = 0; m < 4; ++m)
#pragma unroll
                for (int n = 0; n < 2; ++n) acc[a][b][m][n] = (f32x4){0.f, 0.f, 0.f, 0.f};
    bf16x8 At[4][2], B0[2][2], B1[2][2];
    const char* cA = (const char*)g.A + (size_t)cur.pm * tstep; const char* cB = (const char*)g.Bt + (size_t)cur.pn * tstep;
    S.a_ready(cur);
    if constexpr (SP2) {
        PG8_STAGE(PG8_SB(0, 0), cB, voffB); PG8_STAGE(PG8_SB(0, 1), cB + hstep, voffB); PG8_STAGE(PG8_SA(0, 0), cA, voffA); PG8_STAGE(PG8_SA(0, 1), cA + hstep, voffA);
        if (wr == 1) PG8_BAR;
        PG8_WAIT_V(2); PG8_BAR;
        PG8_STAGE(PG8_SB(1, 0), cB + kstep, voffB); PG8_STAGE(PG8_SA(1, 0), cA + kstep, voffA); PG8_STAGE(PG8_SB(1, 1), cB + hstep + kstep, voffB);
        PG8_WAIT_V(6); PG8_BAR;
    } else {
        PG8_STAGE(PG8_SB(0, 0), cB, voffB); PG8_STAGE(PG8_SA(0, 0), cA, voffA); PG8_STAGE(PG8_SB(0, 1), cB + hstep, voffB); PG8_STAGE(PG8_SA(0, 1), cA + hstep, voffA);
        if (wr == 1) PG8_BAR;
        PG8_WAIT_V(4); PG8_BAR;
        PG8_STAGE(PG8_SB(1, 0), cB + kstep, voffB); PG8_STAGE(PG8_SA(1, 0), cA + kstep, voffA); PG8_STAGE(PG8_SB(1, 1), cB + hstep + kstep, voffB);
        PG8_WAIT_V(6); PG8_BAR;
    }
    for (;;) {
        const bool has_next = S.next(ui + 1, nxt);
        const char* nA = has_next ? (const char*)g.A + (size_t)nxt.pm * tstep : cA; const char* nB = has_next ? (const char*)g.Bt + (size_t)nxt.pn * tstep : cB;
        for (int t = 0; t < nt; t += 2) {
            const bool last = (t == nt - 2);
            const char* a1 = cA + (size_t)(t + 1) * kstep;
            const char* a2 = last ? nA : cA + (size_t)(t + 2) * kstep; const char* b2 = last ? nB : cB + (size_t)(t + 2) * kstep;
            const char* a3 = a2 + kstep; const char* b3 = b2 + kstep;
            if (last && has_next) S.a_ready(nxt);
            if constexpr (SP2) {
            PG8_LDB(B0, 0, 0); PG8_LDB(B1, 0, 1); PG8_SCHED; PG8_LDA(At, 0, 0); PG8_STAGE(PG8_SA(1, 1), a1 + hstep, voffA);
            PG8_WAIT_V(8); PG8_WAIT_L(0); PG8_BAR; PG8_MMA(0, 0, At, B0); PG8_MMA(0, 1, At, B1); PG8_BAR; PG8_SCHED;
            PG8_LDA(At, 0, 1); PG8_STAGE(PG8_SB(0, 0), b2, voffB); PG8_STAGE(PG8_SB(0, 1), b2 + hstep, voffB); PG8_STAGE(PG8_SA(0, 0), a2, voffA);
            PG8_WAIT_V(8); PG8_WAIT_L(0); PG8_BAR; PG8_MMA(1, 0, At, B0); PG8_MMA(1, 1, At, B1); PG8_BAR; PG8_SCHED;
            PG8_LDB(B0, 1, 0); PG8_LDB(B1, 1, 1); PG8_SCHED; PG8_LDA(At, 1, 0); PG8_STAGE(PG8_SA(0, 1), a2 + hstep, voffA);
            PG8_WAIT_V(8); PG8_WAIT_L(0); PG8_BAR; PG8_MMA(0, 0, At, B0); PG8_MMA(0, 1, At, B1); PG8_BAR; PG8_SCHED;
            PG8_LDA(At, 1, 1); PG8_STAGE(PG8_SB(1, 0), b3, voffB); PG8_STAGE(PG8_SB(1, 1), b3 + hstep, voffB); PG8_STAGE(PG8_SA(1, 0), a3, voffA);
            PG8_WAIT_V(8); PG8_WAIT_L(0); PG8_BAR; PG8_MMA(1, 0, At, B0); PG8_MMA(1, 1, At, B1); PG8_BAR; PG8_SCHED;
            } else {
            PG8_LDB(B0, 0, 0); PG8_SCHED; PG8_LDA(At, 0, 0); PG8_STAGE(PG8_SA(1, 1), a1 + hstep, voffA);
            PG8_WAIT_L(8); PG8_BAR; PG8_WAIT_L(0); PG8_MMA(0, 0, At, B0); PG8_BAR; PG8_SCHED;
            PG8_LDB(B1, 0, 1); PG8_STAGE(PG8_SB(0, 0), b2, voffB);
            PG8_BAR; PG8_WAIT_L(0); PG8_MMA(0, 1, At, B1); PG8_BAR;
            PG8_LDA(At, 0, 1); PG8_STAGE(PG8_SA(0, 0), a2, voffA);
            PG8_BAR; PG8_WAIT_L(0); PG8_MMA(1, 0, At, B0); PG8_BAR; PG8_SCHED;
            PG8_STAGE(PG8_SB(0, 1), b2 + hstep, voffB);
            PG8_WAIT_V(6); PG8_BAR; PG8_MMA(1, 1, At, B1); PG8_BAR;
            PG8_LDB(B0, 1, 0); PG8_SCHED; PG8_LDA(At, 1, 0); PG8_STAGE(PG8_SA(0, 1), a2 + hstep, voffA);
            PG8_WAIT_L(8); PG8_BAR; PG8_WAIT_L(0); PG8_MMA(0, 0, At, B0); PG8_BAR; PG8_SCHED;
            PG8_LDB(B1, 1, 1); PG8_STAGE(PG8_SB(1, 0), b3, voffB);
            PG8_BAR; PG8_WAIT_L(0); PG8_MMA(0, 1, At, B1); PG8_BAR;
            PG8_LDA(At, 1, 1); PG8_STAGE(PG8_SA(1, 0), a3, voffA);
            PG8_BAR; PG8_WAIT_L(0); PG8_MMA(1, 0, At, B0); PG8_BAR; PG8_SCHED;
            PG8_STAGE(PG8_SB(1, 1), b3 + hstep, voffB);
            PG8_WAIT_V(6); PG8_BAR; PG8_MMA(1, 1, At, B1); PG8_BAR;
            }
        }
        if constexpr (ALIGN_EPI) { if (wr == 0) PG8_BAR; }
        if constexpr (!Epi::AFTER_DRAIN) { E(acc, cur, wr, wc, fr, fq); S.done(cur); }
        if (!has_next) break;
#pragma unroll
        for (int a = 0; a < 2; ++a)
#pragma unroll
            for (int b = 0; b < 2; ++b)
#pragma unroll
                for (int m = 0; m < 4; ++m)
#pragma unroll
                    for (int n = 0; n < 2; ++n) acc[a][b][m][n] = (f32x4){0.f, 0.f, 0.f, 0.f};
        cur = nxt; cA = nA; cB = nB; ++ui;
        if constexpr (ALIGN_EPI) { if (wr == 1) PG8_BAR; }
    }
    PG8_WAIT_V(0);
    if constexpr (!ALIGN_EPI) { if (wr == 0) PG8_BAR; }
    PG8_BAR;
    if constexpr (Epi::AFTER_DRAIN) { E.fused(acc, cur, wr, wc, fr, fq, lds, wid, lane); S.done(cur); }
#undef PG8_SA
#undef PG8_SB
#undef PG8_STAGE
#undef PG8_LDA
#undef PG8_LDB
#undef PG8_MMA
#undef PG8_WAIT_V
#undef PG8_WAIT_L
#undef PG8_BAR
#undef PG8_SCHED
}
}

#include <hip/hip_bf16.h>
#include <cmath>
namespace attn_body {
using bf16=__hip_bfloat16;
using bf16x8=__attribute__((ext_vector_type(8)))short;
using s16x4=__attribute__((ext_vector_type(4)))short;
using f32x16=__attribute__((ext_vector_type(16)))float;
using u32x4=__attribute__((ext_vector_type(4)))unsigned;
constexpr int D=64,QP=512,KP=128,VP=2304,OP=1024;
constexpr int NW=8,QBLK=32,QB=QBLK*NW,KVBLK=64;
constexpr int ATTN_UNIT_ROWS=QB;
__device__ __forceinline__ int crow(int r,int hi){return (r&3)+8*(r>>2)+4*hi;}
#define SBAR() __builtin_amdgcn_sched_barrier(0)
constexpr int NSLOT=3, SLOTB=8192;
constexpr int LDS_K=0, LDS_V=NSLOT*SLOTB, LDS_WS=2*NSLOT*SLOTB, LDS_OST=LDS_WS+NW*64*4, LDS_BYTES=LDS_OST+NW*4096;
constexpr float C2=0.125f*1.4426950408889634f;
__device__ __forceinline__ void glds16(const void*gsrc,unsigned lds_dst){unsigned keep;
  asm volatile("s_mov_b32 %0, m0\n\ts_mov_b32 m0, %2\n\ts_nop 0\n\tglobal_load_lds_dwordx4 %1, off\n\ts_mov_b32 m0, %0":"=&s"(keep):"v"(gsrc),"s"(lds_dst):"memory");}
__device__ __forceinline__ float max3f(float a,float b,float c){float r;asm("v_max3_f32 %0, %1, %2, %3":"=v"(r):"v"(a),"v"(b),"v"(c));return r;}
__device__ __forceinline__ float max2f(float a,float b){float r;asm("v_max_f32_e32 %0, %1, %2":"=v"(r):"v"(a),"v"(b));return r;}
__device__ __forceinline__ float fadd_s(float a,float b){float r;asm("v_add_f32_e32 %0, %1, %2":"=v"(r):"v"(a),"v"(b));return r;}
__device__ __forceinline__ float fsub_s(float a,float b){float r;asm("v_sub_f32_e32 %0, %1, %2":"=v"(r):"v"(a),"v"(b));return r;}
typedef float f32x2_t __attribute__((ext_vector_type(2))); typedef __bf16 bf16x2_t __attribute__((ext_vector_type(2)));
__device__ __forceinline__ unsigned cvtpk_s(float lo,float hi){f32x2_t v={lo,hi};bf16x2_t b=__builtin_convertvector(v,bf16x2_t);return __builtin_bit_cast(unsigned,b);}
#define WAIT_BAR(N) asm volatile("s_waitcnt vmcnt(" #N ") lgkmcnt(0)\n\ts_barrier":::"memory")

__device__ __forceinline__ void qkt(f32x16&p0,f32x16&p1,const char*Kslot,const bf16x8*qr,const f32x16&negm,int r32,int hi){
  const char*kb=Kslot+hi*1024+r32*16;
  #pragma unroll
  for(int d0=0;d0<4;++d0){
    const bf16x8 b0=*reinterpret_cast<const bf16x8*>(kb+d0*2048);
    const bf16x8 b1=*reinterpret_cast<const bf16x8*>(kb+d0*2048+512);
    if(d0==0){p0=__builtin_amdgcn_mfma_f32_32x32x16_bf16(b0,qr[0],negm,0,0,0);p1=__builtin_amdgcn_mfma_f32_32x32x16_bf16(b1,qr[0],negm,0,0,0);}
    else{p0=__builtin_amdgcn_mfma_f32_32x32x16_bf16(b0,qr[d0],p0,0,0,0);p1=__builtin_amdgcn_mfma_f32_32x32x16_bf16(b1,qr[d0],p1,0,0,0);}}
}
typedef __attribute__((address_space(3))) const char* lds_cptr;
typedef short v4i16_t __attribute__((ext_vector_type(4)));
__device__ __forceinline__ void kload8(bf16x8*kf,lds_cptr kp){
  kf[0]=*(const __attribute__((address_space(3))) bf16x8*)(kp);      kf[1]=*(const __attribute__((address_space(3))) bf16x8*)(kp+512);
  kf[2]=*(const __attribute__((address_space(3))) bf16x8*)(kp+2048); kf[3]=*(const __attribute__((address_space(3))) bf16x8*)(kp+2560);
  kf[4]=*(const __attribute__((address_space(3))) bf16x8*)(kp+4096); kf[5]=*(const __attribute__((address_space(3))) bf16x8*)(kp+4608);
  kf[6]=*(const __attribute__((address_space(3))) bf16x8*)(kp+6144); kf[7]=*(const __attribute__((address_space(3))) bf16x8*)(kp+6656);
}
__device__ __forceinline__ void kload2(bf16x8*kf,lds_cptr kp,int j){ kf[2*j]=*(const __attribute__((address_space(3))) bf16x8*)(kp+j*2048); kf[2*j+1]=*(const __attribute__((address_space(3))) bf16x8*)(kp+j*2048+512); }
__device__ __forceinline__ s16x4 vtr(lds_cptr p){ return __builtin_bit_cast(s16x4,__builtin_amdgcn_ds_read_tr16_b64_v4i16((__attribute__((address_space(3))) v4i16_t*)p)); }
__device__ __forceinline__ float rowmax(const f32x16&p0,const f32x16&p1){
  float a=max3f(p0[0],p0[1],p1[0]),b=max3f(p0[2],p0[3],p1[1]);a=max3f(a,p1[2],p1[3]);
  #pragma unroll
  for(int r=4;r<16;r+=4){a=max3f(a,p0[r],p0[r+1]);b=max3f(b,p0[r+2],p0[r+3]);a=max3f(a,p1[r],p1[r+1]);b=max3f(b,p1[r+2],p1[r+3]);}
  const float m=max2f(a,b);
  auto rr=__builtin_amdgcn_permlane32_swap(__float_as_uint(m),__float_as_uint(m),false,false);
  return max2f(__uint_as_float(rr[0]),__uint_as_float(rr[1]));
}
__device__ __forceinline__ void pv(f32x16*o,int vb,bf16x8 pa0,bf16x8 pa1,bf16x8 pa2,bf16x8 pa3){
  #pragma unroll
  for(int d0=0;d0<2;++d0){s16x4 lo[4],hi[4];
    #pragma unroll
    for(int ks=0;ks<4;++ks){
      asm volatile("ds_read_b64_tr_b16 %0,%1 offset:%c2":"=&v"(lo[ks]):"v"(vb),"i"(d0*4096+ks*1024):"memory");
      asm volatile("ds_read_b64_tr_b16 %0,%1 offset:%c2":"=&v"(hi[ks]):"v"(vb),"i"(d0*4096+ks*1024+512):"memory");}
    asm volatile("s_waitcnt lgkmcnt(0)":::"memory");SBAR();
    #define PK(k) (bf16x8){lo[k][0],lo[k][1],lo[k][2],lo[k][3],hi[k][0],hi[k][1],hi[k][2],hi[k][3]}
    o[d0]=__builtin_amdgcn_mfma_f32_32x32x16_bf16(pa0,PK(0),o[d0],0,0,0);
    o[d0]=__builtin_amdgcn_mfma_f32_32x32x16_bf16(pa1,PK(1),o[d0],0,0,0);
    o[d0]=__builtin_amdgcn_mfma_f32_32x32x16_bf16(pa2,PK(2),o[d0],0,0,0);
    o[d0]=__builtin_amdgcn_mfma_f32_32x32x16_bf16(pa3,PK(3),o[d0],0,0,0);
    #undef PK
  }
}

#ifndef ATTN_STORE16
#define ATTN_STORE16(p,v) (*(u32x4*)(p)=(v))
#endif
__device__ __forceinline__ void attn_unit(const bf16*Qw0,const bf16*__restrict__ Kh,const bf16*__restrict__ Vh,bf16*Ow0,const int NT,const float neg_ref,char*shm){
  const int tid=otid(),lane=tid&63,r32=lane&31,hi=lane>>5; const int wid=__builtin_amdgcn_readfirstlane(tid>>6);
  const bf16*Qw=Qw0+(long)(wid*QBLK)*QP;
  const unsigned lds0=(unsigned)(uintptr_t)shm;
  float*wsf=(float*)(shm+LDS_WS)+wid*64;
  const bf16*ksrc=Kh+(long)lane*KP+wid*8;
  const bf16*vsrc=Vh+(long)(16*(wid&3)+(lane>>2))*VP+(wid>>2)*32+(lane&3)*8;
  const unsigned kdst=lds0+LDS_K+wid*1024, vdst=lds0+LDS_V+wid*1024;
  #define DMA_K(t,slot) glds16(ksrc+(long)(t)*KVBLK*KP,(unsigned)__builtin_amdgcn_readfirstlane(kdst+(slot)))
  #define DMA_V(t,slot) glds16(vsrc+(long)(t)*KVBLK*VP,(unsigned)__builtin_amdgcn_readfirstlane(vdst+(slot)))
  const int vb0=(int)(lds0+LDS_V)+((lane>>4)&1)*32+(lane&3)*8+(4*hi+((lane&15)>>2))*64;
  const char*Kbase=shm+LDS_K; bf16x8 kf[8];
  const lds_cptr shm3=(lds_cptr)shm; const lds_cptr kp0=shm3+LDS_K+hi*1024+r32*16; const lds_cptr vp0=shm3+LDS_V+((lane>>4)&1)*32+(lane&3)*8+(4*hi+((lane&15)>>2))*64;
  DMA_K(0,0);DMA_V(0,0);DMA_K(1,SLOTB);
  bf16x8 qr[4];
  #pragma unroll
  for(int d0=0;d0<4;++d0)qr[d0]=*reinterpret_cast<const bf16x8*>(&Qw[(long)r32*QP+d0*16+hi*8]);
  float l_reg=0.f;f32x16 o[2];o[0]=f32x16{};o[1]=f32x16{};f32x16 negm;
  #pragma unroll
  for(int r=0;r<16;++r)negm[r]=neg_ref;
  asm volatile("":"+v"(negm));
  f32x16 pA0,pA1,pB0,pB1;
  int sl_prev=0,sl_cur=0,sl_next=SLOTB;
  #define ROT() do{sl_prev=sl_cur;sl_cur=sl_next;sl_next=(sl_next==(NSLOT-1)*SLOTB)?0:sl_next+SLOTB;}while(0)
  DMA_K(2,2*SLOTB);
  WAIT_BAR(3);
  qkt(pA0,pA1,Kbase,qr,negm,r32,hi);asm volatile("s_nop 15\n\ts_nop 7":"+v"(pA0),"+v"(pA1));
  _Pragma("unroll") for(int r=0;r<16;++r)pA0[r]=__builtin_amdgcn_exp2f(pA0[r]);
  _Pragma("unroll") for(int r=0;r<16;++r)pA1[r]=__builtin_amdgcn_exp2f(pA1[r]);
  WAIT_BAR(0);
  DMA_K(3,0);DMA_V(1,SLOTB);
  ROT();
  kload8(kf,kp0+sl_cur);
  WAIT_BAR(2);
  s16x4 vlo[8],vhi[8]; u32x4 pw0,pw1,pw2,pw3;
  #define PKW(P,B) cvtpk_s(P[B],P[B+1])
  #define PAF(k) __builtin_bit_cast(bf16x8,pw##k)
  #define VFR(i) (bf16x8){vlo[i][0],vlo[i][1],vlo[i][2],vlo[i][3],vhi[i][0],vhi[i][1],vhi[i][2],vhi[i][3]}
  #define PIN(x) asm volatile("":"+v"(x))
  #define MX3(a,b,c) __builtin_fmaxf(__builtin_fmaxf((a),(b)),(c))
  #define GAPA(MF,A0,A1,A2,A3,W0,W1,PW) do{ MF; sacc+=A0; sacc+=A1; sacc+=A2; sacc+=A3; PIN(sacc); W0; W1; PIN(PW); SBAR(); }while(0)
  #define EX(v) __builtin_amdgcn_exp2f(v)
  #define GAPB(MF,X,B) do{ MF; X[B]=EX(X[B]); X[B+1]=EX(X[B+1]); X[B+2]=EX(X[B+2]); X[B+3]=EX(X[B+3]); PIN(X); SBAR(); }while(0)
  #define VRD(i) do{ vlo[i]=vtr(vp_+(((i)>>2)*4096+((i)&3)*1024)); vhi[i]=vtr(vp_+(((i)>>2)*4096+((i)&3)*1024+512)); }while(0)
  #define KRD(G,j) do{ if(G){ kload2(kf,kp0+sl_next,j); SBAR(); } }while(0)
  #define STEP(C0,C1,P0,P1,t,GK,GV,GL) do{ SBAR(); \
    const lds_cptr vp_=vp0+sl_prev; \
    VRD(0); SBAR(); float sacc=(P0[0]+P0[1]); \
    GAPA(C0=__builtin_amdgcn_mfma_f32_32x32x16_bf16(kf[0],qr[0],negm,0,0,0), P0[2],P0[3],P0[4],P0[5],     pw0[0]=PKW(P0,0), pw0[1]=PKW(P0,2), pw0); \
    VRD(4); SBAR(); GAPA(C1=__builtin_amdgcn_mfma_f32_32x32x16_bf16(kf[1],qr[0],negm,0,0,0), P0[6],P0[7],P0[8],P0[9],     pw0[2]=PKW(P0,4), pw0[3]=PKW(P0,6), pw0); \
    VRD(1); SBAR(); GAPA(C0=__builtin_amdgcn_mfma_f32_32x32x16_bf16(kf[2],qr[1],C0,0,0,0),   P0[10],P0[11],P0[12],P0[13], pw1[0]=PKW(P0,8), pw1[1]=PKW(P0,10), pw1); \
    VRD(5); SBAR(); GAPA(C1=__builtin_amdgcn_mfma_f32_32x32x16_bf16(kf[3],qr[1],C1,0,0,0),   P0[14],P0[15],P1[0],P1[1],   pw1[2]=PKW(P0,12),pw1[3]=PKW(P0,14), pw1); \
    VRD(2); SBAR(); GAPA(C0=__builtin_amdgcn_mfma_f32_32x32x16_bf16(kf[4],qr[2],C0,0,0,0),   P1[2],P1[3],P1[4],P1[5],     pw2[0]=PKW(P1,0), pw2[1]=PKW(P1,2), pw2); \
    VRD(6); SBAR(); GAPA(C1=__builtin_amdgcn_mfma_f32_32x32x16_bf16(kf[5],qr[2],C1,0,0,0),   P1[6],P1[7],P1[8],P1[9],     pw2[2]=PKW(P1,4), pw2[3]=PKW(P1,6), pw2); \
    VRD(3); SBAR(); GAPA(C0=__builtin_amdgcn_mfma_f32_32x32x16_bf16(kf[6],qr[3],C0,0,0,0),   P1[10],P1[11],P1[12],P1[13], pw3[0]=PKW(P1,8), pw3[1]=PKW(P1,10), pw3); \
    VRD(7); SBAR(); GAPA(C1=__builtin_amdgcn_mfma_f32_32x32x16_bf16(kf[7],qr[3],C1,0,0,0),   P1[14],P1[15],0.f,0.f,       pw3[2]=PKW(P1,12),pw3[3]=PKW(P1,14), pw3); \
    l_reg+=sacc; \
    if(GK){DMA_K((t)+3,sl_cur);} if(GV){DMA_V((t)+1,sl_next);} \
    SBAR(); \
    GAPB(o[0]=__builtin_amdgcn_mfma_f32_32x32x16_bf16(PAF(0),VFR(0),o[0],0,0,0), C0,0); \
    GAPB(o[1]=__builtin_amdgcn_mfma_f32_32x32x16_bf16(PAF(0),VFR(4),o[1],0,0,0), C0,4); \
    KRD(GL,0); GAPB(o[0]=__builtin_amdgcn_mfma_f32_32x32x16_bf16(PAF(1),VFR(1),o[0],0,0,0), C0,8); \
    KRD(GL,1); GAPB(o[1]=__builtin_amdgcn_mfma_f32_32x32x16_bf16(PAF(1),VFR(5),o[1],0,0,0), C0,12); \
    KRD(GL,2); GAPB(o[0]=__builtin_amdgcn_mfma_f32_32x32x16_bf16(PAF(2),VFR(2),o[0],0,0,0), C1,0); \
    KRD(GL,3); GAPB(o[1]=__builtin_amdgcn_mfma_f32_32x32x16_bf16(PAF(2),VFR(6),o[1],0,0,0), C1,4); \
    GAPB(o[0]=__builtin_amdgcn_mfma_f32_32x32x16_bf16(PAF(3),VFR(3),o[0],0,0,0), C1,8); \
    GAPB(o[1]=__builtin_amdgcn_mfma_f32_32x32x16_bf16(PAF(3),VFR(7),o[1],0,0,0), C1,12); \
    }while(0)
  int t=1;
  for(;t+5<NT;t+=2){
    STEP(pB0,pB1,pA0,pA1,t,true,true,true);     WAIT_BAR(2); ROT();
    STEP(pA0,pA1,pB0,pB1,t+1,true,true,true);   WAIT_BAR(2); ROT();
  }
  #define ENDW(tt) do{ if((tt)+3<NT){WAIT_BAR(2);} else if((tt)+2<NT){WAIT_BAR(1);} else {WAIT_BAR(0);} }while(0)
  for(;t+1<NT;t+=2){
    STEP(pB0,pB1,pA0,pA1,t,(t+3<NT),(t+1<NT),(t+1<NT));       ENDW(t);   ROT();
    STEP(pA0,pA1,pB0,pB1,t+1,(t+4<NT),(t+2<NT),(t+2<NT));     ENDW(t+1); ROT();
  }
  STEP(pB0,pB1,pA0,pA1,NT-1,false,false,false);
  { float sacc=pB0[0]+pB0[1]; _Pragma("unroll") for(int r=2;r<16;++r)sacc+=pB0[r]; _Pragma("unroll") for(int r=0;r<16;++r)sacc+=pB1[r]; l_reg+=sacc;
    pw0=(u32x4){PKW(pB0,0),PKW(pB0,2),PKW(pB0,4),PKW(pB0,6)};pw1=(u32x4){PKW(pB0,8),PKW(pB0,10),PKW(pB0,12),PKW(pB0,14)};pw2=(u32x4){PKW(pB1,0),PKW(pB1,2),PKW(pB1,4),PKW(pB1,6)};pw3=(u32x4){PKW(pB1,8),PKW(pB1,10),PKW(pB1,12),PKW(pB1,14)};
    SBAR(); pv(o,vb0+sl_cur,PAF(0),PAF(1),PAF(2),PAF(3)); }
  #undef PKW
  #undef PAF
  #undef VFR
  #undef PIN
  #undef MX3
  #undef GAPA
  #undef GAPB
  #undef EX
  #undef VRD
  #undef KRD
  #undef STEP
  #undef ENDW
  {auto rr=__builtin_amdgcn_permlane32_swap(__float_as_uint(l_reg),__float_as_uint(l_reg),false,false);l_reg=__uint_as_float(rr[0])+__uint_as_float(rr[1]);}
  if(hi==0)wsf[32+r32]=l_reg;asm volatile("s_waitcnt lgkmcnt(0)":::"memory");
  float rli[16];
  #pragma unroll
  for(int r=0;r<16;++r)rli[r]=__builtin_amdgcn_rcpf(wsf[32+crow(r,hi)]);
  bf16*Ow=Ow0+(long)(wid*QBLK)*OP;
  { bf16*stg=(bf16*)(shm+LDS_OST)+wid*2048;
    #pragma unroll
    for(int r=0;r<16;++r){const int orow=crow(r,hi);
      #pragma unroll
      for(int d0=0;d0<2;++d0)stg[orow*64+d0*32+r32]=__float2bfloat16(o[d0][r]*rli[r]);}
    asm volatile("s_waitcnt lgkmcnt(0)":::"memory");
    #pragma unroll
    for(int i=0;i<4;++i){const int row=i*8+(lane>>3),ch=lane&7; const u32x4 v=*(const u32x4*)(stg+row*64+ch*8); ATTN_STORE16(Ow+(long)row*OP+ch*8,v);} }
  asm volatile("s_waitcnt lgkmcnt(0)\n\ts_barrier":::"memory");
  #undef DMA_K
  #undef DMA_V
  #undef ROT
}
constexpr int ATTN_LDS_BYTES=LDS_BYTES;
#undef SBAR
#undef WAIT_BAR
}


using namespace cfg;
typedef unsigned short bf16_t;
typedef float f32x4 __attribute__((ext_vector_type(4)));
typedef unsigned u32x4 __attribute__((ext_vector_type(4)));
typedef unsigned u32x2 __attribute__((ext_vector_type(2)));

__device__ __forceinline__ float bf2f(unsigned v) { return __uint_as_float(v << 16); }
__device__ __forceinline__ float bflo(unsigned w) { return __uint_as_float(w << 16); }
__device__ __forceinline__ float bfhi(unsigned w) { return __uint_as_float(w & 0xffff0000u); }
__device__ __forceinline__ unsigned f2bf(float f) { unsigned u = __float_as_uint(f); return (u + 0x7fffu + ((u >> 16) & 1u)) >> 16; }
__device__ __forceinline__ unsigned pk2(float lo, float hi) { return f2bf(lo) | (f2bf(hi) << 16); }
__device__ __forceinline__ float sigm(float x) { return 1.f / (1.f + __expf(-x)); }
__device__ __forceinline__ float silu(float x) { return x / (1.f + __expf(-x)); }
template <int M> __device__ __forceinline__ float xsum(float v) {
    if constexpr (M < 32) return v + __uint_as_float((unsigned)__builtin_amdgcn_ds_swizzle((int)__float_as_uint(v), (M << 10) | 0x1f));
    else { auto rr = __builtin_amdgcn_permlane32_swap(__float_as_uint(v), __float_as_uint(v), false, false); return __uint_as_float(rr[0]) + __uint_as_float(rr[1]); }
}
__device__ __forceinline__ float wave_sum(float v) { v = xsum<1>(v); v = xsum<2>(v); v = xsum<4>(v); v = xsum<8>(v); v = xsum<16>(v); v = xsum<32>(v); return v; }
__device__ __forceinline__ size_t stream_off(int row, bool& is_ctx) { const int b = row / PB, p = row - b * PB; is_ctx = p < CTXL; return is_ctx ? ((size_t)b * CTXL + p) * D : ((size_t)b * SEQ + (p - CTXL)) * D; }

constexpr size_t MiB = 1u << 20;
constexpr size_t WS_CTL = 0;
constexpr size_t WS_MODV = 1 * MiB;
constexpr size_t WS_LBF = WS_MODV + 256 * 1024;
constexpr size_t WS_REF = WS_LBF + 8192;
constexpr size_t WS_POOLWT = WS_MODV + 512 * 1024;
constexpr size_t WS_COS = 2 * MiB, WS_SIN = 3 * MiB;
constexpr size_t WS_WIN = 4 * MiB;
constexpr size_t WS_WOUT = 13 * MiB;
constexpr size_t WS_WGU = 17 * MiB;
constexpr size_t WS_WD = 49 * MiB;
constexpr size_t WS_XC = 65 * MiB;
constexpr size_t WS_XN = 67 * MiB;
constexpr size_t WS_PROJ = 100 * MiB;
constexpr size_t WS_QN = 175 * MiB;
constexpr size_t WS_KN = 192 * MiB;
constexpr size_t WS_MIX = 197 * MiB;
constexpr size_t WS_UT = 230 * MiB;
constexpr size_t WS_ST = 247 * MiB;
constexpr size_t WS_DEC = 264 * MiB;
constexpr size_t WS_LIST = 265 * MiB;
constexpr size_t WS_ACT2 = WS_PROJ;
constexpr size_t WS_END = 272 * MiB;
constexpr int CW_CNT = 1024;

__device__ const float ROPE_INV[16] = {1.0f, 0.5623413251903491f, 0.31622776601683794f, 0.1778279410038923f, 0.1f, 0.05623413251903491f, 0.03162277660168379f, 0.01778279410038923f,
                                       0.01f, 0.005623413251903491f, 0.0031622776601683794f, 0.0017782794100389228f, 0.001f, 0.0005623413251903491f, 0.00031622776601683794f, 0.00017782794100389227f};
__device__ __forceinline__ void sincos_d(double a, double& s, double& c) {
    const double k = rint(a * 0.63661977236758134308);
    double r = fma(-k, 1.57079632679489655800e+00, a);
    r = fma(-k, 6.12323399573676603587e-17, r);
    const double r2 = r * r;
    double sp = -7.6471637318198164759e-13;
    sp = fma(sp, r2, 1.6059043836821614599e-10);
    sp = fma(sp, r2, -2.5052108385441718775e-08);
    sp = fma(sp, r2, 2.7557319223985890653e-06);
    sp = fma(sp, r2, -1.9841269841269841270e-04);
    sp = fma(sp, r2, 8.3333333333333333333e-03);
    sp = fma(sp, r2, -1.6666666666666666667e-01);
    const double sr = fma(sp * r2, r, r);
    double cp = 4.7794773323873852974e-14;
    cp = fma(cp, r2, -1.1470745597729724714e-11);
    cp = fma(cp, r2, 2.0876756987868098979e-09);
    cp = fma(cp, r2, -2.7557319223985890653e-07);
    cp = fma(cp, r2, 2.4801587301587301587e-05);
    cp = fma(cp, r2, -1.3888888888888888889e-03);
    cp = fma(cp, r2, 4.1666666666666666667e-02);
    cp = fma(cp, r2, -0.5);
    const double cr = fma(cp, r2, 1.0);
    const int q = ((int)k) & 3;
    s = (q == 0) ? sr : (q == 1) ? cr : (q == 2) ? -sr : -cr;
    c = (q == 0) ? cr : (q == 1) ? -sr : (q == 2) ? -cr : sr;
}

__device__ __forceinline__ void transpose_items(const float* __restrict__ W, int K, int N, bf16_t* __restrict__ WT, int mode, int nbatch, size_t src_stride, size_t dst_stride, float* scr, int gw, int NGW, int lane) {
    const int nblk = N / 32, per = (K / 64) * nblk, nitems = per * nbatch;
    for (int it = gw; it < nitems; it += NGW) {
        const int bt = it / per, item = it - bt * per;
        const float* Wb = W + (size_t)bt * src_stride; bf16_t* WTb = WT + (size_t)bt * dst_stride;
        const int kb = item / nblk, nb = item - kb * nblk, k0 = 64 * kb, n0 = 32 * nb;
#pragma unroll 8
        for (int i = 0; i < 32; ++i) { const int kk = 2 * i + (lane >> 5); scr[kk * 33 + (lane & 31)] = Wb[(size_t)(k0 + kk) * N + n0 + (lane & 31)]; }
        asm volatile("s_waitcnt lgkmcnt(0)" ::: "memory");
        const int rbase = (mode == 0) ? n0 : ((n0 >> 7) * 256 + (mode == 2 ? 128 : 0) + (n0 & 127));
        const int cch = lane & 7;
#pragma unroll
        for (int j = 0; j < 4; ++j) { const int n = (lane >> 3) + 8 * j; const float* s = scr + (8 * cch) * 33 + n;
            u32x4 o; o.x = pk2(s[0 * 33], s[1 * 33]); o.y = pk2(s[2 * 33], s[3 * 33]); o.z = pk2(s[4 * 33], s[5 * 33]); o.w = pk2(s[6 * 33], s[7 * 33]);
            *(u32x4*)(WTb + (size_t)(rbase + n) * K + k0 + 8 * cch) = o; }
        asm volatile("s_waitcnt lgkmcnt(0)" ::: "memory");
    }
}
__device__ __forceinline__ void moe_weight_copies(const float* gate, const float* up, const float* down, bf16_t* WGU, bf16_t* WD, float* scr, int gw, int NGW, int lane) {
    transpose_items(gate, D, DE, WGU, 1, NE, (size_t)D * DE, (size_t)1024 * D, scr, gw, NGW, lane);
    transpose_items(up, D, DE, WGU, 2, NE, (size_t)D * DE, (size_t)1024 * D, scr, gw, NGW, lane);
    transpose_items(down, DE, D, WD, 0, NE, (size_t)DE * D, (size_t)D * DE, scr, gw, NGW, lane);
}
struct ProArgs { const float *c, *c_ctx, *w_mod, *b_mod, *hgrn_lb, *qg, *kg, *w_in, *w_out, *pool_w, *gate, *up, *down; float *MODV, *LBF, *REF, *COS, *SIN; bf16_t *WIN, *WOUT, *POOLWT, *WGU, *WD; };
__device__ __forceinline__ void prologue_phase(unsigned char* lds, const ProArgs& a, int cu, int G) {
    const int tid = otid(), lane = tid & 63, wave = tid >> 6;
    for (int gid = cu * 512 + tid; gid < SEQ * 32; gid += G * 512) {
        const int t = gid >> 5, j = gid & 31;
        const float pos = (float)(j < 16 ? (t >> 6) : (t & 63));
        const float ang = pos * ROPE_INV[j & 15];
        double s, c; sincos_d((double)ang, s, c);
        a.COS[gid] = (float)c; a.SIN[gid] = (float)s;
    }
    if (cu == 0) {
        for (int gid = tid; gid < 1024; gid += 512) {
            const int l = gid >> 9, r = gid & 511; float v = 0.f;
            if (l == 1) v = 1.f / (1.f + expf(a.hgrn_lb[r] - a.hgrn_lb[512 + r]));
            a.LBF[gid] = fmaxf(v, 1e-30f); }
        if (tid < DEPTH) {
            float mq = 0.f, mk = 0.f;
            for (int i = 0; i < 64; ++i) { mq = fmaxf(mq, fabsf(a.qg[tid * 64 + i])); mk = fmaxf(mk, fabsf(a.kg[tid * 64 + i])); }
            a.REF[tid * 64] = -(64.f * C2 * mq * mk * 1.02f + 0.5f); }
    }
    {
        float* act = (float*)lds;
        float* part = (float*)(lds + 12288);
        for (int item = cu; item < 2 * 96; item += G) {
            const int l = item / 96, n0 = (item - l * 96) * 64;
            for (int i = tid; i < 3072; i += 512) { const int r = i >> 10, k = i & 1023; const float v = r < 2 ? a.c[r * 1024 + k] : a.c_ctx[k]; act[i] = silu(v); }
            __syncthreads();
            const float* w = a.w_mod + ((size_t)l * 1024 + (size_t)wave * 128) * 6144 + n0 + lane;
            float a0 = 0.f, a1 = 0.f, a2 = 0.f;
#pragma unroll 8
            for (int k = 0; k < 128; ++k) { const float wv = w[(size_t)k * 6144]; const int kk = wave * 128 + k; a0 += act[kk] * wv; a1 += act[1024 + kk] * wv; a2 += act[2048 + kk] * wv; }
            part[(wave * 3 + 0) * 64 + lane] = a0; part[(wave * 3 + 1) * 64 + lane] = a1; part[(wave * 3 + 2) * 64 + lane] = a2;
            __syncthreads();
            if (tid < 192) { const int r = tid >> 6, nn = tid & 63; float s = 0.f;
#pragma unroll
                for (int q = 0; q < 8; ++q) s += part[(q * 3 + r) * 64 + nn];
                a.MODV[(l * 3 + r) * 6144 + n0 + nn] = s + a.b_mod[l * 6144 + n0 + nn]; }
            __syncthreads();
        }
    }
    {
        float* scr = (float*)(lds + 16384) + wave * (64 * 33);
        const int gw = cu * 8 + wave, NGW = G * 8;
        transpose_items(a.w_in, D, NIN, a.WIN, 0, DEPTH, (size_t)D * NIN, (size_t)NIN * D, scr, gw, NGW, lane);
        transpose_items(a.w_out, D, D, a.WOUT, 0, DEPTH, (size_t)D * D, (size_t)D * D, scr, gw, NGW, lane);
        transpose_items(a.pool_w, 64, 64, a.POOLWT, 0, DEPTH * 4, (size_t)64 * 64, (size_t)64 * 64, scr, gw, NGW, lane);
        moe_weight_copies(a.gate, a.up, a.down, a.WGU, a.WD, scr, gw, NGW, lane);
    }
    __syncthreads();
}

namespace pool {
typedef float f32x16 __attribute__((ext_vector_type(16)));
typedef short bf16x8 __attribute__((ext_vector_type(8)));
constexpr int P = 72, O_X = 0  , O_DM = 81920  , O_OUT = 0  , OP = 264;
__device__ __forceinline__ int crow(int r, int hi) { return (r & 3) + 8 * (r >> 2) + 4 * hi; }
__device__ __forceinline__ void pool_phase(unsigned char* lds, const bf16_t* __restrict__ PROJ, const bf16_t* __restrict__ WT  , const float* __restrict__ pscale, bf16_t* __restrict__ MIX, int cu, int G) {
    const int tid = otid(), lane = tid & 63, r32 = lane & 31, hi = lane >> 5, w = __builtin_amdgcn_readfirstlane(tid >> 6);
    float* X = (float*)(lds + O_X); bf16_t* OUT = (bf16_t*)(lds + O_OUT);
    for (int u = cu; u < MT / 64; u += G) {
        const int row0 = u * 64, b = row0 / PB, p0 = row0 - b * PB; const bool is_ctx = p0 < CTXL;
        const int seg0 = b * PB + (is_ctx ? 0 : CTXL), len = is_ctx ? CTXL : SEQ, t0 = is_ctx ? p0 : p0 - CTXL;
#pragma unroll
        for (int it = 0; it < 5; ++it) { const int piece = tid + it * 512, rr = piece >> 5, pc = piece & 31, t = t0 - 8 + rr;
            u32x4 v = {0u, 0u, 0u, 0u};
            if (t >= 0 && t < len) v = *(const u32x4*)(PROJ + (size_t)(seg0 + t) * NIN + C_BP + pc * 8);
            float* x = X + rr * 256 + pc * 8;
            *(f32x4*)x = (f32x4){bflo(v.x), bfhi(v.x), bflo(v.y), bfhi(v.y)}; *(f32x4*)(x + 4) = (f32x4){bflo(v.z), bfhi(v.z), bflo(v.w), bfhi(v.w)}; }
        __syncthreads();
        {
            const int c = tid & 255, th = tid >> 8, g = c >> 6, hw = 1 << g;
            bf16_t* dm = (bf16_t*)(lds + O_DM) + g * 64 * P + (c & 63);
            for (int tt = 0; tt < 32; ++tt) { const int t = th * 32 + tt, tg = t0 + t;
                int lo = tg - hw; if (lo < 0) lo = 0; int hi2 = tg + hw; if (hi2 > len) hi2 = len;
                float s = 0.f;
                for (int q = lo; q < hi2; ++q) s += X[(q - t0 + 8) * 256 + c];
                dm[t * P] = (bf16_t)f2bf(s / (float)(hi2 - lo) - X[(t + 8) * 256 + c]); }
        }
        __syncthreads();
        {
            const int g = w >> 1, tb = w & 1;
            const bf16_t* A = (const bf16_t*)(lds + O_DM) + g * 64 * P + (tb * 32 + r32) * P + hi * 8;
#pragma unroll
            for (int eb = 0; eb < 2; ++eb) {
                const bf16_t* Bp = WT + (size_t)g * 4096 + (eb * 32 + r32) * 64 + hi * 8;
                f32x16 acc = {};
#pragma unroll
                for (int ks = 0; ks < 4; ++ks) acc = __builtin_amdgcn_mfma_f32_32x32x16_bf16(*(const bf16x8*)(A + ks * 16), *(const bf16x8*)(Bp + ks * 16), acc, 0, 0, 0);
                const int e = g * 64 + eb * 32 + r32; const float sc = pscale[e];
#pragma unroll
                for (int r = 0; r < 16; ++r) OUT[(tb * 32 + crow(r, hi)) * OP + e] = (bf16_t)f2bf(acc[r] * sc);
            }
        }
        __syncthreads();
#pragma unroll
        for (int it = 0; it < 4; ++it) { const int piece = tid + it * 512, t = piece >> 5, pc = piece & 31;
            *(u32x4*)(MIX + (size_t)(row0 + t) * D + 256 + pc * 8) = *(const u32x4*)(OUT + t * OP + pc * 8); }
        __syncthreads();
    }
}
}

__device__ __forceinline__ void norm1_phase(int cu, int G, const float* __restrict__ lat, const float* __restrict__ cx, const float* __restrict__ g, const float* __restrict__ modv, int sh_off, bf16_t* __restrict__ XN) {
    const int lane = otid() & 63, gw = cu * 8 + (otid() >> 6), NGW = G * 8;
    for (int row = gw; row < MT; row += NGW) {
        bool is_ctx; const size_t off = stream_off(row, is_ctx);
        const int r = is_ctx ? 2 : row / PB;
        const f32x4* xr = (const f32x4*)((is_ctx ? cx : lat) + off) + lane;
        f32x4 v[4]; float ss = 0.f;
#pragma unroll
        for (int j = 0; j < 4; ++j) { v[j] = xr[64 * j]; ss += (v[j].x * v[j].x + v[j].y * v[j].y) + (v[j].z * v[j].z + v[j].w * v[j].w); }
        const float rstd = 1.f / sqrtf(wave_sum(ss) * (1.f / D) + EPS);
        const float* mv = modv + r * 6144 + sh_off;
#pragma unroll
        for (int j = 0; j < 4; ++j) { const int col = 4 * lane + 256 * j;
            const f32x4 gg = *(const f32x4*)(g + col), sh = *(const f32x4*)(mv + col), sc = *(const f32x4*)(mv + 1024 + col);
            const f32x4 o = v[j] * rstd * gg * (sc + 1.f) + sh;
            u32x2 w; w.x = pk2(o.x, o.y); w.y = pk2(o.z, o.w);
            *(u32x2*)(XN + (size_t)row * D + col) = w; }
    }
}

__device__ __forceinline__ void norm2_router_phase(int cu, int G, const float* __restrict__ lat, const float* __restrict__ cx, const float* __restrict__ g, const float* __restrict__ modv, int sh_off,
                                                      const float* __restrict__ router_w, const float* __restrict__ router_b, bf16_t* __restrict__ XN, unsigned* __restrict__ cnt, u32x4* __restrict__ LIST, int route_ctx) {
    const int lane = otid() & 63, gw = cu * 8 + (otid() >> 6), NGW = G * 8;
    for (int row = gw; row < MT; row += NGW) {
        bool is_ctx; const size_t off = stream_off(row, is_ctx);
        if (is_ctx && !route_ctx) continue;
        const int r = is_ctx ? 2 : row / PB;
        const f32x4* xr = (const f32x4*)((is_ctx ? cx : lat) + off) + lane;
        f32x4 v[4]; float ss = 0.f;
#pragma unroll
        for (int j = 0; j < 4; ++j) { v[j] = xr[64 * j]; ss += (v[j].x * v[j].x + v[j].y * v[j].y) + (v[j].z * v[j].z + v[j].w * v[j].w); }
        const float rstd = 1.f / sqrtf(wave_sum(ss) * (1.f / D) + EPS);
        const float* mv = modv + r * 6144 + sh_off;
        float lg[16];
#pragma unroll
        for (int e = 0; e < 16; ++e) lg[e] = 0.f;
#pragma unroll
        for (int j = 0; j < 4; ++j) { const int col = 4 * lane + 256 * j;
            const f32x4 gg = *(const f32x4*)(g + col), sh = *(const f32x4*)(mv + col), sc = *(const f32x4*)(mv + 1024 + col);
            const f32x4 o = v[j] * rstd * gg * (sc + 1.f) + sh;
            u32x2 w; w.x = pk2(o.x, o.y); w.y = pk2(o.z, o.w);
            *(u32x2*)(XN + (size_t)row * D + col) = w;
#pragma unroll
            for (int i = 0; i < 4; ++i) { const float ov = o[i]; const f32x4* rw = (const f32x4*)(router_w + (size_t)(col + i) * 16);
#pragma unroll
                for (int q = 0; q < 4; ++q) { const f32x4 w4 = rw[q]; lg[4 * q + 0] += ov * w4.x; lg[4 * q + 1] += ov * w4.y; lg[4 * q + 2] += ov * w4.z; lg[4 * q + 3] += ov * w4.w; }
                asm volatile("" ::: "memory"); } }
        float sc_[16], sel[16];
#pragma unroll
        for (int e = 0; e < 16; ++e) { lg[e] = wave_sum(lg[e]); sc_[e] = 1.f / (1.f + expf(-lg[e])); sel[e] = sc_[e] + router_b[e]; }
        float gs[4]; int gi1[4], gi2[4]; float gw1[4], gw2[4];
#pragma unroll
        for (int q = 0; q < 4; ++q) { float v1 = -INFINITY, v2 = -INFINITY; int i1 = 0, i2 = 0; float s1 = 0.f, s2 = 0.f;
#pragma unroll
            for (int k = 0; k < 4; ++k) { const float x = sel[4 * q + k], sx = sc_[4 * q + k];
                if (x > v1) { v2 = v1; i2 = i1; s2 = s1; v1 = x; i1 = 4 * q + k; s1 = sx; } else if (x > v2) { v2 = x; i2 = 4 * q + k; s2 = sx; } }
            gs[q] = v1 + v2; gi1[q] = i1; gi2[q] = i2; gw1[q] = s1; gw2[q] = s2; }
        float bv = gs[0]; int e0 = gi1[0], e1 = gi2[0]; float w0 = gw1[0], w1 = gw2[0];
#pragma unroll
        for (int q = 1; q < 4; ++q) if (gs[q] > bv) { bv = gs[q]; e0 = gi1[q]; e1 = gi2[q]; w0 = gw1[q]; w1 = gw2[q]; }
        const float ws = w0 + w1; w0 /= ws; w1 /= ws;
        if (lane == 0) {
            const int gq = e0 >> 2; int a = e0 & 3, c = e1 & 3; float wa = w0, wc = w1;
            if (a > c) { const int ti = a; a = c; c = ti; const float tf = wa; wa = wc; wc = tf; }
            const int pi = (a == 0) ? (c - 1) : (a == 1 ? c + 1 : 5);
            const int bk = gq * 6 + pi;
            const unsigned slot = __hip_atomic_fetch_add(cnt + bk, 1u, __ATOMIC_RELAXED, __HIP_MEMORY_SCOPE_AGENT);
            u32x4 sv; sv.x = (unsigned)row; sv.y = __float_as_uint(wa); sv.z = __float_as_uint(wc); sv.w = 0u; LIST[(size_t)bk * MT + slot] = sv; }
    }
}

__device__ __forceinline__ void post_phase(int cu, int G, const bf16_t* __restrict__ PROJ, const float* __restrict__ qg, const float* __restrict__ kg, const float* __restrict__ COS, const float* __restrict__ SIN,
                                              bf16_t* __restrict__ QN, bf16_t* __restrict__ KN) {
    const int lane = otid() & 63, gw = cu * 8 + (otid() >> 6), NGW = G * 8;
    for (int row = gw; row < MT; row += NGW) {
        const int b = row / PB, p = row - b * PB; const bool is_ctx = p < CTXL; const int t = is_ctx ? 0 : p - CTXL;
        const bf16_t* pr = PROJ + (size_t)row * NIN;
        {
            const u32x4 w = *(const u32x4*)(pr + C_CQ + lane * 8);
            float x[8] = {bflo(w.x), bfhi(w.x), bflo(w.y), bfhi(w.y), bflo(w.z), bfhi(w.z), bflo(w.w), bfhi(w.w)};
            float ss = 0.f;
#pragma unroll
            for (int i = 0; i < 8; ++i) ss += x[i] * x[i];
            ss = xsum<1>(ss); ss = xsum<2>(ss); ss = xsum<4>(ss);
            const float rstd = 1.f / sqrtf(ss * (1.f / 64.f) + EPS);
            const int d0 = (lane & 7) * 8;
#pragma unroll
            for (int i = 0; i < 8; ++i) x[i] = x[i] * rstd * qg[d0 + i];
            if (!is_ctx) {
#pragma unroll
                for (int i = 0; i < 4; ++i) { const int j = (d0 >> 1) + i; const float cs = COS[t * 32 + j], sn = SIN[t * 32 + j];
                    const float x1 = x[2 * i], x2 = x[2 * i + 1]; x[2 * i] = x1 * cs - x2 * sn; x[2 * i + 1] = x1 * sn + x2 * cs; } }
            u32x4 o; o.x = pk2(x[0] * C2, x[1] * C2); o.y = pk2(x[2] * C2, x[3] * C2); o.z = pk2(x[4] * C2, x[5] * C2); o.w = pk2(x[6] * C2, x[7] * C2);
            *(u32x4*)(QN + (size_t)row * 512 + lane * 8) = o;
        }
        {
            const unsigned w = *(const unsigned*)(pr + C_CK + lane * 2);
            float x1 = bflo(w), x2 = bfhi(w);
            float ss = x1 * x1 + x2 * x2;
            ss = xsum<1>(ss); ss = xsum<2>(ss); ss = xsum<4>(ss); ss = xsum<8>(ss); ss = xsum<16>(ss);
            const float rstd = 1.f / sqrtf(ss * (1.f / 64.f) + EPS);
            const int j = lane & 31;
            x1 = x1 * rstd * kg[2 * j]; x2 = x2 * rstd * kg[2 * j + 1];
            if (!is_ctx) { const float cs = COS[t * 32 + j], sn = SIN[t * 32 + j]; const float a = x1 * cs - x2 * sn, c = x1 * sn + x2 * cs; x1 = a; x2 = c; }
            *(unsigned*)(KN + (size_t)row * 128 + lane * 2) = pk2(x1, x2);
        }
    }
}

namespace hg {
typedef float f32x16 __attribute__((ext_vector_type(16)));
typedef short bf16x8 __attribute__((ext_vector_type(8)));
typedef short s16x4 __attribute__((ext_vector_type(4)));
typedef float f32x2 __attribute__((ext_vector_type(2)));
constexpr int P = 72;
constexpr int O_ZB = 0, O_ZQ = 32768, O_VT = 40960, O_QH = 50176, O_QT = 68608, O_KH = 87040, O_ST = 105472, O_SSQ = 123904, O_OUT = 0  , O_TOT = 0, LDS_BYTES = 124416;
constexpr int MSZ = 64 * P * 2;
constexpr int NCH = PB / 64;
__device__ __forceinline__ int crow(int r, int hi) { return (r & 3) + 8 * (r >> 2) + 4 * hi; }
__device__ __forceinline__ unsigned cvtpk(float lo, float hi) { typedef __bf16 b2 __attribute__((ext_vector_type(2))); f32x2 v = {lo, hi}; b2 b = __builtin_convertvector(v, b2); return __builtin_bit_cast(unsigned, b); }
__device__ __forceinline__ float clampe(float e) { return fminf(fmaxf(e, -80.f), 80.f); }

template <bool FULL> __device__ __forceinline__ void prep(unsigned char* lds, const bf16_t* __restrict__ PROJ, const float* __restrict__ LBFl, int row0, int h) {
    const int tid = otid();
    float* ZB = (float*)(lds + O_ZB); bf16_t* ZQ = (bf16_t*)(lds + O_ZQ); bf16_t* VT = (bf16_t*)(lds + O_VT);
    {
        const int t = tid >> 3, pc = tid & 7;
        const bf16_t* pr = PROJ + (size_t)(row0 + t) * NIN + h * 64 + pc * 8;
        const u32x4 wf = *(const u32x4*)(pr + C_AFF), wb = *(const u32x4*)(pr + C_AFB), wv = *(const u32x4*)(pr + C_AI);
        float* zf = ZB + t * 64 + pc * 8; float* zb = ZB + 4096 + t * 64 + pc * 8;
        *(f32x4*)zf = (f32x4){bflo(wf.x), bfhi(wf.x), bflo(wf.y), bfhi(wf.y)}; *(f32x4*)(zf + 4) = (f32x4){bflo(wf.z), bfhi(wf.z), bflo(wf.w), bfhi(wf.w)};
        *(f32x4*)zb = (f32x4){bflo(wb.x), bfhi(wb.x), bflo(wb.y), bfhi(wb.y)}; *(f32x4*)(zb + 4) = (f32x4){bflo(wb.z), bfhi(wb.z), bflo(wb.w), bfhi(wb.w)};
        bf16_t* vt = VT + (pc * 8) * P + t;
        vt[0 * P] = (bf16_t)(wv.x & 0xffffu); vt[1 * P] = (bf16_t)(wv.x >> 16); vt[2 * P] = (bf16_t)(wv.y & 0xffffu); vt[3 * P] = (bf16_t)(wv.y >> 16);
        vt[4 * P] = (bf16_t)(wv.z & 0xffffu); vt[5 * P] = (bf16_t)(wv.z >> 16); vt[6 * P] = (bf16_t)(wv.w & 0xffffu); vt[7 * P] = (bf16_t)(wv.w >> 16);
        if (FULL) { const u32x4 wq = *(const u32x4*)(pr + C_AQ); *(u32x4*)(ZQ + t * 64 + pc * 8) = wq; }
    }
    __syncthreads();
    if (tid < 128) {
        const int dir = tid >> 6, i = tid & 63;
        const float lbf = LBFl[dir * 256 + h * 64 + i], oml = 1.f - lbf;
        float* zb = ZB + dir * 4096 + i; float acc = 0.f;
        if (dir == 0) { for (int t = 0; t < 64; ++t) { const float z = zb[t * 64]; const float sg = 1.f / (1.f + __expf(-z)); acc += __logf(lbf + oml * sg); zb[t * 64] = acc; } }
        else { for (int t = 63; t >= 0; --t) { const float z = zb[t * 64]; const float sg = 1.f / (1.f + __expf(-z)); acc += __logf(lbf + oml * sg); zb[t * 64] = acc; } }
    }
    __syncthreads();
#pragma unroll
    for (int it = 0; it < 2; ++it) {
        const int item = tid + it * 512, dir = item >> 9, t = (item >> 3) & 63, i0 = (item & 7) * 8;
        const float* B = ZB + dir * 4096;
        const int tp = dir == 0 ? t - 1 : t + 1; const bool edge = dir == 0 ? (t == 0) : (t == 63);
        const int tref = dir == 0 ? 31 : 32;
        float bc[8], bp[8], br[8];
        { const f32x4 a = *(const f32x4*)(B + t * 64 + i0), c = *(const f32x4*)(B + t * 64 + i0 + 4); bc[0] = a.x; bc[1] = a.y; bc[2] = a.z; bc[3] = a.w; bc[4] = c.x; bc[5] = c.y; bc[6] = c.z; bc[7] = c.w; }
        { const int tq = edge ? t : tp; const f32x4 a = *(const f32x4*)(B + tq * 64 + i0), c = *(const f32x4*)(B + tq * 64 + i0 + 4);
          bp[0] = a.x; bp[1] = a.y; bp[2] = a.z; bp[3] = a.w; bp[4] = c.x; bp[5] = c.y; bp[6] = c.z; bp[7] = c.w;
          if (edge) {
#pragma unroll
              for (int k = 0; k < 8; ++k) bp[k] = 0.f; } }
        { const f32x4 a = *(const f32x4*)(B + tref * 64 + i0), c = *(const f32x4*)(B + tref * 64 + i0 + 4); br[0] = a.x; br[1] = a.y; br[2] = a.z; br[3] = a.w; br[4] = c.x; br[5] = c.y; br[6] = c.z; br[7] = c.w; }
        float kh[8];
#pragma unroll
        for (int k = 0; k < 8; ++k) { const float kk = 1.f - __expf(bc[k] - bp[k]); kh[k] = kk * __expf(clampe(br[k] - bc[k])); }
        if (!FULL) {
            bf16_t* kt = (bf16_t*)(lds + O_KH + dir * MSZ) + i0 * P + t;
#pragma unroll
            for (int k = 0; k < 8; ++k) kt[k * P] = (bf16_t)f2bf(kh[k]);
        } else {
            u32x4 w; w.x = cvtpk(kh[0], kh[1]); w.y = cvtpk(kh[2], kh[3]); w.z = cvtpk(kh[4], kh[5]); w.w = cvtpk(kh[6], kh[7]);
            *(u32x4*)((bf16_t*)(lds + O_KH + dir * MSZ) + t * P + i0) = w;
            const u32x4 wq = *(const u32x4*)(ZQ + t * 64 + i0);
            float q[8] = {silu(bflo(wq.x)), silu(bfhi(wq.x)), silu(bflo(wq.y)), silu(bfhi(wq.y)), silu(bflo(wq.z)), silu(bfhi(wq.z)), silu(bflo(wq.w)), silu(bfhi(wq.w))};
            float qh[8], qt[8];
#pragma unroll
            for (int k = 0; k < 8; ++k) { qh[k] = q[k] * __expf(clampe(bc[k] - br[k])); qt[k] = q[k] * __expf(bc[k]); }
            w.x = cvtpk(qh[0], qh[1]); w.y = cvtpk(qh[2], qh[3]); w.z = cvtpk(qh[4], qh[5]); w.w = cvtpk(qh[6], qh[7]);
            *(u32x4*)((bf16_t*)(lds + O_QH + dir * MSZ) + t * P + i0) = w;
            w.x = cvtpk(qt[0], qt[1]); w.y = cvtpk(qt[2], qt[3]); w.z = cvtpk(qt[4], qt[5]); w.w = cvtpk(qt[6], qt[7]);
            *(u32x4*)((bf16_t*)(lds + O_QT + dir * MSZ) + t * P + i0) = w;
        }
    }
    __syncthreads();
}

__device__ __forceinline__ void h1_phase(unsigned char* lds, const bf16_t* __restrict__ PROJ, const float* __restrict__ LBFl, bf16_t* __restrict__ UT, float* __restrict__ DEC, int cu, int G) {
    const int tid = otid(), lane = tid & 63, r32 = lane & 31, hi = lane >> 5, w = __builtin_amdgcn_readfirstlane(tid >> 6);
    for (int u = cu; u < BATCH * NCH * 4; u += G) {
        const int h = u & 3, bc = u >> 2, b = bc / NCH, cp = bc - b * NCH, row0 = b * PB + cp * 64;
        prep<false>(lds, PROJ, LBFl, row0, h);
        const float* ZB = (const float*)(lds + O_ZB);
        {
            const int dir = w >> 2, jb = (w >> 1) & 1, ib = w & 1;
            const bf16_t* VT = (const bf16_t*)(lds + O_VT) + (jb * 32 + r32) * P + hi * 8;
            const bf16_t* KT = (const bf16_t*)(lds + O_KH + dir * MSZ) + (ib * 32 + r32) * P + hi * 8;
            f32x16 acc = {};
#pragma unroll
            for (int ks = 0; ks < 4; ++ks) acc = __builtin_amdgcn_mfma_f32_32x32x16_bf16(*(const bf16x8*)(VT + ks * 16), *(const bf16x8*)(KT + ks * 16), acc, 0, 0, 0);
            const int i = ib * 32 + r32;
            const float btot = ZB[dir * 4096 + (dir == 0 ? 63 : 0) * 64 + i], bref = ZB[dir * 4096 + (dir == 0 ? 31 : 32) * 64 + i];
            const float sc = __expf(btot - bref);
            const int chain = (b * 4 + h) * 2 + dir;
            bf16_t* ut = UT + ((size_t)chain * NCH + cp) * 4096 + i;
#pragma unroll
            for (int r = 0; r < 16; ++r) ut[(jb * 32 + crow(r, hi)) * 64] = (bf16_t)f2bf(acc[r] * sc);
        }
        if (tid < 128) { const int dir = tid >> 6, i = tid & 63; const int chain = (b * 4 + h) * 2 + dir;
            DEC[((size_t)chain * NCH + cp) * 64 + i] = __expf(ZB[dir * 4096 + (dir == 0 ? 63 : 0) * 64 + i]); }
        __syncthreads();
    }
}

__device__ __forceinline__ void h2_phase(unsigned char* lds, const bf16_t* __restrict__ UT, const float* __restrict__ DEC, bf16_t* __restrict__ ST, int cu, int G) {
    const int tid = otid(), seg = tid >> 7, e = tid & 127, jl = e >> 5, i = (e & 31) * 2;
    f32x4* TOT = (f32x4*)(lds + O_TOT);
    for (int task = cu; task < 256; task += G) {
        const int chain = task >> 4, j = (task & 15) * 4 + jl, dir = chain & 1;
        const size_t cbase = (size_t)chain * NCH;
        float S0 = 0.f, S1 = 0.f, P0 = 1.f, P1 = 1.f;
#pragma unroll 11
        for (int kk = 0; kk < 33; ++kk) { const int k = seg * 33 + kk, cp = dir == 0 ? k : (k < 4 ? 3 - k : 135 - k);
            const unsigned u = *(const unsigned*)(UT + (cbase + cp) * 4096 + j * 64 + i); const f32x2 d = *(const f32x2*)(DEC + (cbase + cp) * 64 + i);
            S0 = d.x * S0 + bflo(u); S1 = d.y * S1 + bfhi(u); P0 *= d.x; P1 *= d.y; }
        TOT[seg * 128 + e] = (f32x4){S0, S1, P0, P1};
        __syncthreads();
        float s0 = 0.f, s1 = 0.f;
#pragma unroll
        for (int sp = 0; sp < 3; ++sp) if (sp < seg) { const f32x4 t = TOT[sp * 128 + e]; s0 = t.z * s0 + t.x; s1 = t.w * s1 + t.y; }
#pragma unroll 11
        for (int kk = 0; kk < 33; ++kk) { const int k = seg * 33 + kk, cp = dir == 0 ? k : (k < 4 ? 3 - k : 135 - k);
            const unsigned u = *(const unsigned*)(UT + (cbase + cp) * 4096 + j * 64 + i); const f32x2 d = *(const f32x2*)(DEC + (cbase + cp) * 64 + i);
            *(unsigned*)(ST + (cbase + cp) * 4096 + j * 64 + i) = pk2(s0, s1);
            s0 = d.x * s0 + bflo(u); s1 = d.y * s1 + bfhi(u); }
        __syncthreads();
    }
}

__device__ __forceinline__ void h3_phase(unsigned char* lds, const bf16_t* __restrict__ PROJ, const float* __restrict__ LBFl, const bf16_t* __restrict__ ST, const float* __restrict__ ng, bf16_t* __restrict__ MIX, int cu, int G) {
    const int tid = otid(), lane = tid & 63, r32 = lane & 31, hi = lane >> 5, w = __builtin_amdgcn_readfirstlane(tid >> 6);
    for (int u = cu; u < BATCH * NCH * 4; u += G) {
        const int h = u & 3, bc = u >> 2, b = bc / NCH, cp = bc - b * NCH, row0 = b * PB + cp * 64;
        {
            const int j = tid >> 3, ic = (tid & 7) * 8;
#pragma unroll
            for (int dir = 0; dir < 2; ++dir) { const int chain = (b * 4 + h) * 2 + dir;
                const u32x4 sv = *(const u32x4*)(ST + ((size_t)chain * NCH + cp) * 4096 + j * 64 + ic);
                *(u32x4*)((bf16_t*)(lds + O_ST + dir * MSZ) + j * P + ic) = sv; }
        }
        prep<true>(lds, PROJ, LBFl, row0, h);
        float* SSQ = (float*)(lds + O_SSQ); bf16_t* OUT = (bf16_t*)(lds + O_OUT);
        f32x16 ot = {};
        const int jb = (w >> 1) & 1, tb = w & 1;
        if (w < 4) {
            const bf16_t* VT = (const bf16_t*)(lds + O_VT) + (jb * 32 + r32) * P;
#pragma unroll
            for (int sb = 0; sb < 2; ++sb) {
                f32x16 xf = {}, xb = {};
                const bf16_t* QF = (const bf16_t*)(lds + O_QH) + (tb * 32 + r32) * P + hi * 8; const bf16_t* QB = QF + 64 * P;
                const bf16_t* KF = (const bf16_t*)(lds + O_KH) + (sb * 32 + r32) * P + hi * 8; const bf16_t* KB = KF + 64 * P;
                if (sb <= tb) {
#pragma unroll
                    for (int ks = 0; ks < 4; ++ks) xf = __builtin_amdgcn_mfma_f32_32x32x16_bf16(*(const bf16x8*)(KF + ks * 16), *(const bf16x8*)(QF + ks * 16), xf, 0, 0, 0); }
                if (sb >= tb) {
#pragma unroll
                    for (int ks = 0; ks < 4; ++ks) xb = __builtin_amdgcn_mfma_f32_32x32x16_bf16(*(const bf16x8*)(KB + ks * 16), *(const bf16x8*)(QB + ks * 16), xb, 0, 0, 0); }
                float x[16];
#pragma unroll
                for (int r = 0; r < 16; ++r) { const int s = crow(r, hi), t = r32;
                    const float vf = (sb < tb || (sb == tb && s <= t)) ? xf[r] : 0.f, vb = (sb > tb || (sb == tb && s >= t)) ? xb[r] : 0.f; x[r] = vf + vb; }
#pragma unroll
                for (int sp = 0; sp < 2; ++sp) {
                    u32x4 xw; xw.x = cvtpk(x[8 * sp + 0], x[8 * sp + 1]); xw.y = cvtpk(x[8 * sp + 2], x[8 * sp + 3]); xw.z = cvtpk(x[8 * sp + 4], x[8 * sp + 5]); xw.w = cvtpk(x[8 * sp + 6], x[8 * sp + 7]);
                    const s16x4 v0 = *(const s16x4*)(VT + sb * 32 + 16 * sp + 4 * hi), v1 = *(const s16x4*)(VT + sb * 32 + 16 * sp + 8 + 4 * hi);
                    const bf16x8 va = {v0[0], v0[1], v0[2], v0[3], v1[0], v1[1], v1[2], v1[3]};
                    ot = __builtin_amdgcn_mfma_f32_32x32x16_bf16(va, __builtin_bit_cast(bf16x8, xw), ot, 0, 0, 0); }
            }
#pragma unroll
            for (int dir = 0; dir < 2; ++dir) {
                const bf16_t* SA = (const bf16_t*)(lds + O_ST + dir * MSZ) + (jb * 32 + r32) * P + hi * 8; const bf16_t* QT = (const bf16_t*)(lds + O_QT + dir * MSZ) + (tb * 32 + r32) * P + hi * 8;
#pragma unroll
                for (int ks = 0; ks < 4; ++ks) ot = __builtin_amdgcn_mfma_f32_32x32x16_bf16(*(const bf16x8*)(SA + ks * 16), *(const bf16x8*)(QT + ks * 16), ot, 0, 0, 0); }
            float part = 0.f;
#pragma unroll
            for (int r = 0; r < 16; ++r) part += ot[r] * ot[r];
            part = xsum<32>(part);
            if (hi == 0) SSQ[jb * 64 + tb * 32 + r32] = part;
        }
        __syncthreads();
        if (w < 4) { const int t = tb * 32 + r32; const float rstd = 1.f / sqrtf((SSQ[t] + SSQ[64 + t]) * (1.f / 64.f) + EPS);
#pragma unroll
            for (int r = 0; r < 16; ++r) { const int j = jb * 32 + crow(r, hi); OUT[t * P + j] = (bf16_t)f2bf(ot[r] * rstd * ng[j]); } }
        __syncthreads();
        {
            const int t = tid >> 3, jc = (tid & 7) * 8;
            const u32x4 y = *(const u32x4*)(OUT + t * P + jc); const u32x4 g = *(const u32x4*)(PROJ + (size_t)(row0 + t) * NIN + C_AG + h * 64 + jc);
            u32x4 o; o.x = pk2(bflo(y.x) * silu(bflo(g.x)), bfhi(y.x) * silu(bfhi(g.x))); o.y = pk2(bflo(y.y) * silu(bflo(g.y)), bfhi(y.y) * silu(bfhi(g.y)));
            o.z = pk2(bflo(y.z) * silu(bflo(g.z)), bfhi(y.z) * silu(bfhi(g.z))); o.w = pk2(bflo(y.w) * silu(bflo(g.w)), bfhi(y.w) * silu(bfhi(g.w)));
            *(u32x4*)(MIX + (size_t)(row0 + t) * D + h * 64 + jc) = o;
        }
        __syncthreads();
    }
}
}
__device__ __forceinline__ int vcu_of(int bx, int G) { return (G % 8 == 0) ? (bx % 8) * (G / 8) + bx / 8 : bx; }
__device__ __forceinline__ void attn_phase(char* lds, const bf16_t* QN, const bf16_t* KN, const bf16_t* PROJ, bf16_t* MIX, float neg_ref, int vcu, int G, bool with_ctx) {
    using attn_body::bf16;
    const int upc = (512 + G - 1) / G;
    const int nun = upc + ((with_ctx && vcu < 16) ? 1 : 0);
    for (int i = 0; i < nun; ++i) {
        int b, h, nt; size_t q0;
        if (i < upc) { const int u = vcu * upc + i; if (u >= 512) continue; const int combo = u >> 7; b = combo >> 1; h = (combo & 1) * 4 + ((u >> 5) & 3); q0 = (size_t)b * PB + CTXL + (size_t)(u & 31) * 256; nt = PB / 64; }
        else { b = vcu >> 3; h = vcu & 7; q0 = (size_t)b * PB; nt = CTXL / 64; }
        const int kvh = h >> 2; const size_t k0 = (size_t)b * PB;
        attn_body::attn_unit((const bf16*)QN + q0 * 512 + h * 64, (const bf16*)KN + k0 * 128 + kvh * 64, (const bf16*)PROJ + k0 * NIN + C_CV + kvh * 64, (bf16*)MIX + q0 * 1024 + 512 + h * 64, nt, neg_ref, lds);
    }
}
namespace pg8 {
struct EpiResid {
    static constexpr bool PERM = false, AFTER_DRAIN = false;
    const float* src_lat; const float* src_ctx; float* dst_lat; float* dst_ctx; const float* modv; int ga_off; int pad;
    __device__ __forceinline__ void operator()(const f32x4 (&acc)[2][2][4][2], const Unit& u, int wr, int wc, int fr, int fq) const {
        asm volatile("" : "+v"(fr), "+v"(fq));
        const int b = u.pm / TPB, w = u.pm - b * TPB;
        const size_t base = (w == 0) ? (size_t)b * CTXL * D : ((size_t)b * SEQ + (size_t)(w - 1) * 256) * D;
        const float* s = ((w == 0) ? src_ctx : src_lat) + base; float* d = ((w == 0) ? dst_ctx : dst_lat) + base;
        const float* ga = modv + ((w == 0) ? 2 : b) * 6144 + ga_off;
        const int row0 = wr * 64 + fr, col0 = u.pn * BM + wc * 32 + 4 * fq;
        f32x4 gv[2][2];
#pragma unroll
        for (int bj = 0; bj < 2; ++bj)
#pragma unroll
            for (int n = 0; n < 2; ++n) gv[bj][n] = *(const f32x4*)(ga + col0 + bj * HALF + n * 16);
#pragma unroll
        for (int ai = 0; ai < 2; ++ai)
#pragma unroll
            for (int m = 0; m < 4; ++m) { const size_t off = (size_t)(row0 + ai * HALF + m * 16) * D + col0;
#pragma unroll
                for (int bj = 0; bj < 2; ++bj)
#pragma unroll
                    for (int n = 0; n < 2; ++n) *(f32x4*)(d + off + bj * HALF + n * 16) = *(const f32x4*)(s + off + bj * HALF + n * 16) + gv[bj][n] * acc[ai][bj][m][n]; }
    }
};
}


namespace pg8 {
struct MUnit { int pm, pn, nrows, lbase, e0, e1; };
__device__ __forceinline__ void build_tiles(PG8_LAS int* TT, const unsigned* cnt) {
    if (otid() == 0) { int off = 0;
        for (int bk = 0; bk < 24; ++bk) { const int c = (int)__hip_atomic_load(cnt + bk, __ATOMIC_RELAXED, __HIP_MEMORY_SCOPE_AGENT); const int nb = (c + 255) >> 8;
            for (int ti = 0; ti < nb; ++ti) { const int rem = c - ti * 256; TT[4 + 4 * off + 0] = bk; TT[4 + 4 * off + 1] = ti; TT[4 + 4 * off + 2] = rem < 256 ? rem : 256; TT[4 + 4 * off + 3] = 0; ++off; } }
        TT[0] = off; }
    __syncthreads();
}
template <int NPN  > struct MoeOrder {
    const PG8_LAS int* TT; int G, c;
    __device__ __forceinline__ bool next(int i, MUnit& u) const {
        const int L = i * G + c, tile = L / NPN; if (tile >= TT[0]) return false;
        const int bk = TT[4 + 4 * tile], ti = TT[4 + 4 * tile + 1];
        u.pm = tile; u.pn = L - tile * NPN; u.nrows = TT[4 + 4 * tile + 2]; u.lbase = bk * MT + ti * 256;
        const int g = bk / 6, pi = bk - g * 6; const int lo = pi < 3 ? 0 : (pi < 5 ? 1 : 2), hi = pi < 3 ? pi + 1 : (pi < 5 ? pi - 1 : 3);
        u.e0 = 4 * g + lo; u.e1 = 4 * g + hi; return true;
    }
};
struct Src1 {
    const bf16_t* XN; const bf16_t* WGU; const u32x4* LIST;
    __device__ __forceinline__ const char* a_base(const MUnit&) const { return (const char*)XN; }
    __device__ __forceinline__ void a_offsets(const MUnit& u, const int (&RA)[2], const int (&CA)[2], unsigned (&ao)[2][2]) const {
#pragma unroll
        for (int h = 0; h < 2; ++h)
#pragma unroll
            for (int i = 0; i < 2; ++i) { const int r = h * HALF + RA[i]; const unsigned row = r < u.nrows ? LIST[u.lbase + r].x : 0u; ao[h][i] = (row * (unsigned)D + (unsigned)CA[i]) * 2u; }
    }
    __device__ __forceinline__ const char* b_base(const MUnit& u, int seg) const { const int e = (u.pn >> 2) ? u.e1 : u.e0;
        return (const char*)(WGU + ((size_t)e * 1024 + (size_t)(u.pn & 3) * 256) * D) + (seg ? (size_t)(D / 2) * 2 : 0); }
    __device__ __forceinline__ void prefetch_rows(const MUnit& u, const int (&)[2], PG8_LAS unsigned char* rows, int wid) const {
        int t2 = otid(); asm volatile("" : "+v"(t2));
        int RA[2];
#pragma unroll
        for (int i = 0; i < 2; ++i) { int R, C; stage_rc(t2 * 16 + i * 8192, R, C); RA[i] = R; }
#pragma unroll
        for (int h = 0; h < 2; ++h)
#pragma unroll
            for (int i = 0; i < 2; ++i) { const int r = h * HALF + RA[i];
                __builtin_amdgcn_global_load_lds((const unsigned*)&LIST[u.lbase + r], (PG8_LAS unsigned*)(rows + ((h * 2 + i) * 8 + wid) * 256), 4, 0, 0); }
    }
    __device__ __forceinline__ void reload_offsets(const MUnit& u, const int (&)[2], const int (&)[2], const PG8_LAS unsigned char* rows, int wid, int lane, unsigned (&ao)[2][2]) const {
        int t2 = otid(); asm volatile("" : "+v"(t2));
        int RA[2], CA[2];
#pragma unroll
        for (int i = 0; i < 2; ++i) { int R, C; stage_rc(t2 * 16 + i * 8192, R, C); RA[i] = R; CA[i] = C; }
#pragma unroll
        for (int h = 0; h < 2; ++h)
#pragma unroll
            for (int i = 0; i < 2; ++i) { const int r = h * HALF + RA[i]; const unsigned v = *(const PG8_LAS unsigned*)(rows + ((h * 2 + i) * 8 + wid) * 256 + lane * 4);
                const unsigned row = r < u.nrows ? v : 0u; ao[h][i] = (row * (unsigned)D + (unsigned)CA[i]) * 2u; }
    }
};
struct Src2 {
    const bf16_t* ACT2; const bf16_t* WD;
    __device__ __forceinline__ const char* a_base(const MUnit& u) const { return (const char*)(ACT2 + (size_t)u.pm * 256 * 1024); }
    __device__ __forceinline__ void a_offsets(const MUnit&, const int (&RA)[2], const int (&CA)[2], unsigned (&ao)[2][2]) const {
#pragma unroll
        for (int h = 0; h < 2; ++h)
#pragma unroll
            for (int i = 0; i < 2; ++i) ao[h][i] = (unsigned)((h * HALF + RA[i]) * 1024 + CA[i]) * 2u;
    }
    __device__ __forceinline__ const char* b_base(const MUnit& u, int seg) const { const int e = seg ? u.e1 : u.e0; return (const char*)(WD + ((size_t)e * 1024 + (size_t)u.pn * 256) * DE); }
    __device__ __forceinline__ void prefetch_rows(const MUnit&, const int (&)[2], PG8_LAS unsigned char*, int) const {}
    __device__ __forceinline__ void reload_offsets(const MUnit&, const int (&)[2], const int (&)[2], const PG8_LAS unsigned char*, int, int, unsigned (&)[2][2]) const {}
};
struct EpiGateUp2 {
    static constexpr bool PERM = true;
    bf16_t* ACT2; const u32x4* LIST;
    __device__ __forceinline__ void operator()(const f32x4 (&acc)[2][2][4][2], const MUnit& u, int wr, int wc, int fr, int fq) const {
        asm volatile("" : "+v"(fr), "+v"(fq));
        const int slot = u.pn >> 2, colA = slot * DE + (u.pn & 3) * HALF + wc * 32 + 8 * fq;
        const unsigned* lw = (const unsigned*)(LIST + u.lbase + wr * 64 + fr) + 1 + slot;
#pragma unroll
        for (int ai = 0; ai < 2; ++ai) {
            unsigned wv[4];
#pragma unroll
            for (int m = 0; m < 4; ++m) wv[m] = lw[(ai * HALF + m * 16) * 4];
#pragma unroll
            for (int m = 0; m < 4; ++m) { const int r = ai * HALF + wr * 64 + m * 16 + fr;
                const bool valid = r < u.nrows; const float cw = valid ? __uint_as_float(wv[m]) : 0.f;
                const f32x4 g0 = acc[ai][0][m][0], g1 = acc[ai][0][m][1], u0 = acc[ai][1][m][0], u1 = acc[ai][1][m][1];
                u32x4 w;
                w.x = cvt_pk_bf16(silu(g0[0]) * u0[0] * cw, silu(g0[1]) * u0[1] * cw); w.y = cvt_pk_bf16(silu(g0[2]) * u0[2] * cw, silu(g0[3]) * u0[3] * cw);
                w.z = cvt_pk_bf16(silu(g1[0]) * u1[0] * cw, silu(g1[1]) * u1[1] * cw); w.w = cvt_pk_bf16(silu(g1[2]) * u1[2] * cw, silu(g1[3]) * u1[3] * cw);
                if (!valid) w = (u32x4){0u, 0u, 0u, 0u};
                *(u32x4*)(ACT2 + ((size_t)u.pm * 256 + r) * 1024 + colA) = w; }
            asm volatile("" ::: "memory"); }
    }
};
struct EpiMoeOut {
    static constexpr bool PERM = false;
    float* lat; float* ctx; const float* modv; const u32x4* LIST;
    __device__ __forceinline__ void operator()(const f32x4 (&acc)[2][2][4][2], const MUnit& u, int wr, int wc, int fr, int fq) const {
        asm volatile("" : "+v"(fr), "+v"(fq));
        const int col0 = u.pn * BM + wc * 32 + 4 * fq;
        const unsigned* lw = (const unsigned*)(LIST + u.lbase + wr * 64 + fr);
        unsigned rv[2][4];
#pragma unroll
        for (int ai = 0; ai < 2; ++ai)
#pragma unroll
            for (int m = 0; m < 4; ++m) rv[ai][m] = lw[(ai * HALF + m * 16) * 4];
#pragma unroll
        for (int ai = 0; ai < 2; ++ai)
#pragma unroll
            for (int m = 0; m < 4; ++m) { const int r = ai * HALF + wr * 64 + m * 16 + fr;
                if (r < u.nrows) { const int row = (int)rv[ai][m]; bool is_ctx; const size_t off = stream_off(row, is_ctx);
                    float* d = (is_ctx ? ctx : lat) + off + col0; const float* ga = modv + (is_ctx ? 2 : row / PB) * 6144 + 5120 + col0;
#pragma unroll
                    for (int bj = 0; bj < 2; ++bj)
#pragma unroll
                        for (int n = 0; n < 2; ++n) { f32x4* p = (f32x4*)(d + bj * HALF + n * 16); *p = *p + *(const f32x4*)(ga + bj * HALF + n * 16) * acc[ai][bj][m][n]; } } }
    }
};

template <class Epi, class Sched, class Src>
__device__ __forceinline__ void gemm_phase_x(PG8_LAS unsigned char* lds, PG8_LAS unsigned char* rows, const Sched& S, const Src& X, const Epi& E, const int KB, const int nt) {
    const int tid = otid(), wid = __builtin_amdgcn_readfirstlane(tid >> 6), lane = tid & 63, wr = wid >> 2, wc = wid & 3, fr = lane & 15, fq = lane >> 4;
    int RA[2], CA[2]; unsigned voffB[2];
#pragma unroll
    for (int i = 0; i < 2; ++i) { int R, C; stage_rc(tid * 16 + i * 8192, R, C); const int Rb = Epi::PERM ? ((R & ~31) + perm32(R & 31)) : R; RA[i] = R; CA[i] = C; voffB[i] = (unsigned)(Rb * KB + C) * 2u; }
    const size_t kstep = (size_t)(BK * 2);
    const size_t hstepB = (size_t)HALF * KB * 2;
    const int half = nt >> 1;
    const unsigned ldsw = (unsigned)wid * 1024u;
    const int aoff = lds_byte(wr * 64 + fr, fq * 8), boff = lds_byte(wc * 32 + fr, fq * 8);
#define PG8_SA(b, h) (((b) * 2 + (h)) * HTB)
#define PG8_SB(b, h) ((4 + (b) * 2 + (h)) * HTB)
#define PG8_STAGE_B(bufoff, gbase) do { _Pragma("unroll") for (int _i = 0; _i < 2; ++_i) \
        __builtin_amdgcn_global_load_lds((const unsigned*)((const char*)(gbase) + voffB[_i]), (PG8_LAS unsigned*)(lds + (bufoff) + ldsw + _i * 8192), 16, 0, 0); } while (0)
#define PG8_STAGE_A(bufoff, gbase, o0, o1) do { \
        __builtin_amdgcn_global_load_lds((const unsigned*)((const char*)(gbase) + (o0)), (PG8_LAS unsigned*)(lds + (bufoff) + ldsw), 16, 0, 0); \
        __builtin_amdgcn_global_load_lds((const unsigned*)((const char*)(gbase) + (o1)), (PG8_LAS unsigned*)(lds + (bufoff) + ldsw + 8192), 16, 0, 0); } while (0)
#define PG8_LDA(dst, b, h) do { _Pragma("unroll") for (int m = 0; m < 4; ++m) _Pragma("unroll") for (int k = 0; k < 2; ++k) dst[m][k] = *(const PG8_LAS bf16x8*)(lds + PG8_SA(b, h) + aoff + m * 2048 + k * 1024); } while (0)
#define PG8_LDB(dst, b, h) do { _Pragma("unroll") for (int n = 0; n < 2; ++n) _Pragma("unroll") for (int k = 0; k < 2; ++k) dst[n][k] = *(const PG8_LAS bf16x8*)(lds + PG8_SB(b, h) + boff + n * 2048 + k * 1024); } while (0)
#define PG8_MMA(ai, bj, At, Bt) do { __builtin_amdgcn_s_setprio(1); _Pragma("unroll") for (int m = 0; m < 4; ++m) _Pragma("unroll") for (int n = 0; n < 2; ++n) _Pragma("unroll") for (int k = 0; k < 2; ++k) \
        acc[ai][bj][m][n] = __builtin_amdgcn_mfma_f32_16x16x32_bf16(Bt[n][k], At[m][k], acc[ai][bj][m][n], 0, 0, 0); __builtin_amdgcn_s_setprio(0); } while (0)
#define PG8_WAIT_V(n) asm volatile("s_waitcnt vmcnt(" #n ")" ::: "memory")
#define PG8_WAIT_L(n) asm volatile("s_waitcnt lgkmcnt(" #n ")" ::: "memory")
#define PG8_BAR __builtin_amdgcn_s_barrier()
#define PG8_SCHED __builtin_amdgcn_sched_barrier(0)
    MUnit cur, nxt; int ui = 0;
    if (!S.next(0, cur)) return;
    f32x4 acc[2][2][4][2];
#pragma unroll
    for (int a = 0; a < 2; ++a)
#pragma unroll
        for (int b = 0; b < 2; ++b)
#pragma unroll
            for (int m = 0; m < 4; ++m)
#pragma unroll
                for (int n = 0; n < 2; ++n) acc[a][b][m][n] = (f32x4){0.f, 0.f, 0.f, 0.f};
    bf16x8 At[4][2], B0[2][2], B1[2][2];
    unsigned aoc[2][2];
    X.a_offsets(cur, RA, CA, aoc);
    const char* cAb = X.a_base(cur); const char* cB0 = X.b_base(cur, 0); const char* cB1 = X.b_base(cur, 1);
    PG8_STAGE_B(PG8_SB(0, 0), cB0); PG8_STAGE_B(PG8_SB(0, 1), cB0 + hstepB); PG8_STAGE_A(PG8_SA(0, 0), cAb, aoc[0][0], aoc[0][1]); PG8_STAGE_A(PG8_SA(0, 1), cAb, aoc[1][0], aoc[1][1]);
    if (wr == 1) PG8_BAR;
    PG8_WAIT_V(2); PG8_BAR;
    PG8_STAGE_B(PG8_SB(1, 0), cB0 + kstep); PG8_STAGE_A(PG8_SA(1, 0), cAb + kstep, aoc[0][0], aoc[0][1]); PG8_STAGE_B(PG8_SB(1, 1), cB0 + hstepB + kstep);
    PG8_WAIT_V(6); PG8_BAR;
    for (;;) {
        const bool has_next = S.next(ui + 1, nxt);
        const char* nAb = cAb; const char* nB0 = cB0; const char* nB1 = cB1;
        if (has_next) { X.prefetch_rows(nxt, RA, rows, wid); nAb = X.a_base(nxt); nB0 = X.b_base(nxt, 0); nB1 = X.b_base(nxt, 1); }
        for (int t = 0; t < nt; t += 2) {
            const bool last = (t == nt - 2);
            const char* a1 = cAb + (size_t)(t + 1) * kstep;
            const int kt2 = t + 2;
            const char* b2 = last ? nB0 : (kt2 < half ? cB0 + (size_t)kt2 * kstep : cB1 + (size_t)(kt2 - half) * kstep);
            const char* a2 = last ? nAb : cAb + (size_t)kt2 * kstep;
            const char* a3 = a2 + kstep; const char* b3 = b2 + kstep;
            PG8_LDB(B0, 0, 0); PG8_LDB(B1, 0, 1); PG8_SCHED; PG8_LDA(At, 0, 0); PG8_STAGE_A(PG8_SA(1, 1), a1, aoc[1][0], aoc[1][1]);
            if (last && has_next) X.reload_offsets(nxt, RA, CA, rows, wid, lane, aoc);
            PG8_WAIT_V(8); PG8_WAIT_L(0); PG8_BAR; PG8_MMA(0, 0, At, B0); PG8_MMA(0, 1, At, B1); PG8_BAR; PG8_SCHED;
            PG8_LDA(At, 0, 1); PG8_STAGE_B(PG8_SB(0, 0), b2); PG8_STAGE_B(PG8_SB(0, 1), b2 + hstepB); PG8_STAGE_A(PG8_SA(0, 0), a2, aoc[0][0], aoc[0][1]);
            PG8_WAIT_V(8); PG8_WAIT_L(0); PG8_BAR; PG8_MMA(1, 0, At, B0); PG8_MMA(1, 1, At, B1); PG8_BAR; PG8_SCHED;
            PG8_LDB(B0, 1, 0); PG8_LDB(B1, 1, 1); PG8_SCHED; PG8_LDA(At, 1, 0); PG8_STAGE_A(PG8_SA(0, 1), a2, aoc[1][0], aoc[1][1]);
            PG8_WAIT_V(8); PG8_WAIT_L(0); PG8_BAR; PG8_MMA(0, 0, At, B0); PG8_MMA(0, 1, At, B1); PG8_BAR; PG8_SCHED;
            PG8_LDA(At, 1, 1); PG8_STAGE_B(PG8_SB(1, 0), b3); PG8_STAGE_B(PG8_SB(1, 1), b3 + hstepB); PG8_STAGE_A(PG8_SA(1, 0), a3, aoc[0][0], aoc[0][1]);
            PG8_WAIT_V(8); PG8_WAIT_L(0); PG8_BAR; PG8_MMA(1, 0, At, B0); PG8_MMA(1, 1, At, B1); PG8_BAR; PG8_SCHED;
        }
        if (wr == 0) PG8_BAR;
        E(acc, cur, wr, wc, fr, fq);
        if (!has_next) break;
#pragma unroll
        for (int a = 0; a < 2; ++a)
#pragma unroll
            for (int b = 0; b < 2; ++b)
#pragma unroll
                for (int m = 0; m < 4; ++m)
#pragma unroll
                    for (int n = 0; n < 2; ++n) acc[a][b][m][n] = (f32x4){0.f, 0.f, 0.f, 0.f};
        cur = nxt; cAb = nAb; cB0 = nB0; cB1 = nB1; ++ui;
        if (wr == 1) PG8_BAR;
    }
    PG8_WAIT_V(0);
    PG8_BAR;
#undef PG8_SA
#undef PG8_SB
#undef PG8_STAGE_A
#undef PG8_STAGE_B
#undef PG8_LDA
#undef PG8_LDB
#undef PG8_MMA
#undef PG8_WAIT_V
#undef PG8_WAIT_L
#undef PG8_BAR
#undef PG8_SCHED
}
}

constexpr int TT_OFF = 132096;
constexpr int ROWS_OFF = 134144;

#define LAS __attribute__((address_space(3)))
#define XB_TMO      128
#define XB_XCNT(j)  (256  + 64 * (j))
#define XB_XSUB(j)  (1280 + 64 * (j))
#define XB_XGEN(j)  (2304 + 64 * (j))
#define XB_TOP      3328
#define XB_TOPGEN   3392
#define XCD_BAR_WORDS 3456
#define XB_SPIN_CAP (1u << 18)

__device__ __forceinline__ unsigned xb_ld(unsigned* p)              { return __hip_atomic_load(p, __ATOMIC_RELAXED, __HIP_MEMORY_SCOPE_AGENT); }
__device__ __forceinline__ unsigned xb_add(unsigned* p, unsigned v) { return __hip_atomic_fetch_add(p, v, __ATOMIC_RELAXED, __HIP_MEMORY_SCOPE_AGENT); }
__device__ __forceinline__ unsigned xb_xcc_id() { return (unsigned)__builtin_amdgcn_s_getreg((3 << 11) | 20) & 0xFu; }
#define XB_SPIN(cond, bar) do { unsigned _sp = 0; while (cond) { __builtin_amdgcn_s_sleep(1); \
    if ((++_sp & 255u) == 0u) { if (xb_ld(&(bar)[XB_TMO])) break; if (_sp > XB_SPIN_CAP) { atomicAdd(&(bar)[XB_TMO], 1u); break; } } } } while (0)

struct XcdBarrier {
    unsigned* bar; unsigned x;
    volatile LAS unsigned* st;
};

__device__ __forceinline__ XcdBarrier xcd_barrier_post(unsigned* bar, volatile LAS unsigned* st) {
    XcdBarrier b; b.bar = bar; b.x = xb_xcc_id(); b.st = st;
    if (threadIdx.x == 0) (void)xb_add(&bar[XB_XCNT(b.x)], 1u);
    return b;
}
__device__ __forceinline__ void xcd_barrier_complete(unsigned* bar, unsigned x, unsigned& nloc, unsigned& nx) {
    const unsigned G = gridDim.x * gridDim.y * gridDim.z;
    unsigned sum, cnt, mine, sp = 0u;
    for (;;) {
        sum = 0u; cnt = 0u; mine = 0u;
#pragma unroll
        for (unsigned j = 0; j < 16; ++j) { const unsigned c = xb_ld(&bar[XB_XCNT(j)]); sum += c; cnt += (c > 0u) ? 1u : 0u; mine = (j == x) ? c : mine; }
        if (sum == G) break;
        __builtin_amdgcn_s_sleep(1);
        if ((++sp & 255u) == 0u) { if (xb_ld(&bar[XB_TMO])) break; if (sp > XB_SPIN_CAP) { atomicAdd(&bar[XB_TMO], 1u); break; } }
    }
    nloc = mine > 0u ? mine : 1u; nx = cnt > 0u ? cnt : 1u;
}

__device__ __forceinline__ void xcd_barrier(const XcdBarrier& b) {
    asm volatile("s_waitcnt vmcnt(0)" ::: "memory");
    __syncthreads();
    if (threadIdx.x == 0) {
        unsigned* bar = b.bar;
        __builtin_amdgcn_s_waitcnt(0);
        unsigned nloc = b.st[0], nx = b.st[1];
        if (nloc == 0u) { xcd_barrier_complete(bar, b.x, nloc, nx); b.st[0] = nloc; b.st[1] = nx; }
        const unsigned old = xb_add(&bar[XB_XSUB(b.x)], 1u);
        const unsigned gen = old / nloc;
        if (old + 1u == (gen + 1u) * nloc) {
            __builtin_amdgcn_fence(__ATOMIC_RELEASE, "agent");
            asm volatile("s_waitcnt vmcnt(0)" ::: "memory");
            const unsigned og = xb_add(&bar[XB_TOP], 1u);
            const unsigned tg = og / nx;
            if (og + 1u == (tg + 1u) * nx) xb_add(&bar[XB_TOPGEN], 1u);
            else XB_SPIN(xb_ld(&bar[XB_TOPGEN]) == tg, bar);
            __builtin_amdgcn_fence(__ATOMIC_ACQUIRE, "agent");
            xb_add(&bar[XB_XGEN(b.x)], 1u);
            asm volatile("s_waitcnt vmcnt(0)" ::: "memory");
        } else {
            XB_SPIN(xb_ld(&bar[XB_XGEN(b.x)]) == gen, bar);
            __builtin_amdgcn_fence(__ATOMIC_ACQUIRE, "agent");
            asm volatile("s_waitcnt vmcnt(0)" ::: "memory");
        }
    }
    __syncthreads();
}

constexpr int LDS_BYTES = 147456;
constexpr int LDSCTL_OFF = 131072, MISC_OFF = LDSCTL_OFF + 320;
constexpr int CW_BAR = 4096;
constexpr int NPHASE = 1 + 9 * DEPTH;
#ifndef MK_SPLIT
#define MK_SPLIT 0
#endif
struct Args {
    const float *x, *c, *ctx, *c_ctx, *w_mod, *b_mod, *norm1_g, *norm2_g, *w_in, *w_out, *hgrn_lb, *hgrn_norm_g, *pool_w, *pool_scale, *q_norm_g, *k_norm_g, *router_w, *router_b, *moe_gate, *moe_up, *moe_down;
    float* out; unsigned char* ws; int ph_lo, ph_hi;
};
typedef const __attribute__((address_space(4))) Args* KArgs;
__device__ __forceinline__ KArgs kargs() { KArgs p = (KArgs)__builtin_amdgcn_kernarg_segment_ptr(); asm volatile("" : "+s"(p)); return p; }
__global__ void __launch_bounds__(512, 2) mega_fwd(Args A_unused) {
    extern __shared__ __attribute__((aligned(16))) unsigned char lds[];
    for (int u = otid(); u < (LDS_BYTES - LDSCTL_OFF) / 4; u += 512) ((LAS unsigned*)((LAS unsigned char*)lds + LDSCTL_OFF))[u] = 0u;
    __syncthreads();
    XcdBarrier bar;
    { KArgs ap = kargs(); unsigned* CTL = (unsigned*)(ap->ws + WS_CTL); bar.bar = CTL + CW_BAR; bar.x = 0; bar.st = nullptr;
      if (!MK_SPLIT) bar = xcd_barrier_post(CTL + CW_BAR, (volatile LAS unsigned*)((LAS unsigned char*)lds + MISC_OFF) + 8); }
    int lo, hi; { KArgs ap = kargs(); lo = ap->ph_lo; hi = ap->ph_hi; }
#ifndef PHMASK
#define PHMASK 0x3ff
#endif
#define IN(k) (lo <= (k) && (k) < hi)
#define SEAM(k) do { if (!MK_SPLIT && IN((k) + 1)) xcd_barrier(bar); } while (0)
#define GCU const int G = (int)gridDim.x, cu = (int)blockIdx.x
    LAS unsigned char* ldsl = (LAS unsigned char*)lds;
    if ((PHMASK & 0x200) && IN(0)) {
        KArgs ap = kargs(); unsigned char* ws = ap->ws; GCU;
        ProArgs pa; pa.c = ap->c; pa.c_ctx = ap->c_ctx; pa.w_mod = ap->w_mod; pa.b_mod = ap->b_mod; pa.hgrn_lb = ap->hgrn_lb; pa.qg = ap->q_norm_g; pa.kg = ap->k_norm_g; pa.w_in = ap->w_in; pa.w_out = ap->w_out; pa.pool_w = ap->pool_w;
        pa.gate = ap->moe_gate; pa.up = ap->moe_up; pa.down = ap->moe_down; pa.MODV = (float*)(ws + WS_MODV); pa.LBF = (float*)(ws + WS_LBF); pa.REF = (float*)(ws + WS_REF); pa.COS = (float*)(ws + WS_COS); pa.SIN = (float*)(ws + WS_SIN);
        pa.WIN = (bf16_t*)(ws + WS_WIN); pa.WOUT = (bf16_t*)(ws + WS_WOUT); pa.POOLWT = (bf16_t*)(ws + WS_POOLWT); pa.WGU = (bf16_t*)(ws + WS_WGU); pa.WD = (bf16_t*)(ws + WS_WD);
        prologue_phase(lds, pa, cu, G);
        SEAM(0);
    }
    for (int l = 0; l < DEPTH; ++l) {
        const int pb = 1 + 9 * l;
        if ((PHMASK & 1) && IN(pb + 0)) {
            KArgs ap = kargs(); unsigned char* ws = ap->ws; GCU;
            const float* slat = (l == 0) ? ap->x : ap->out; const float* sctx = (l == 0) ? ap->ctx : (const float*)(ws + WS_XC);
            norm1_phase(cu, G, slat, sctx, ap->norm1_g + l * D, (const float*)(ws + WS_MODV) + (size_t)l * 3 * 6144, 0, (bf16_t*)(ws + WS_XN));
            if (l > 0) { const int tid = otid(); float* scr = (float*)(lds + 16384) + (tid >> 6) * (64 * 33);
                moe_weight_copies(ap->moe_gate + (size_t)l * NE * D * DE, ap->moe_up + (size_t)l * NE * D * DE, ap->moe_down + (size_t)l * NE * DE * D, (bf16_t*)(ws + WS_WGU), (bf16_t*)(ws + WS_WD), scr, cu * 8 + (tid >> 6), G * 8, tid & 63); }
            SEAM(pb + 0);
        }
        if ((PHMASK & 2) && IN(pb + 1)) {
            KArgs ap = kargs(); unsigned char* ws = ap->ws; GCU;
            pg8::Gemm g; g.A = (const bf16_t*)(ws + WS_XN); g.Bt = (const bf16_t*)(ws + WS_WIN) + (size_t)l * NIN * D; g.M = MT; g.N = NIN; g.K = D; g.pad = 0;
            pg8::StaticOrder S; S.init(MT, NIN, G, cu);
            pg8::EpiBf16<0> E; E.O = (bf16_t*)(ws + WS_PROJ); E.ldc = NIN; E.bias = nullptr; E.split_cols = 0; E.split_stride = 0; E.scale0 = 1.f;
            pg8::gemm_phase<pg8::EpiBf16<0>, pg8::StaticOrder, true, true>(ldsl, g, S, E);
            SEAM(pb + 1);
        }
        if ((PHMASK & 4) && IN(pb + 2)) {
            KArgs ap = kargs(); unsigned char* ws = ap->ws; GCU;
            const bf16_t* PROJ = (const bf16_t*)(ws + WS_PROJ);
            post_phase(cu, G, PROJ, ap->q_norm_g + l * 64, ap->k_norm_g + l * 64, (const float*)(ws + WS_COS), (const float*)(ws + WS_SIN), (bf16_t*)(ws + WS_QN), (bf16_t*)(ws + WS_KN));
            pool::pool_phase(lds, PROJ, (const bf16_t*)(ws + WS_POOLWT) + (size_t)l * 4 * 4096, ap->pool_scale + l * 256, (bf16_t*)(ws + WS_MIX), cu, G);
            hg::h1_phase(lds, PROJ, (const float*)(ws + WS_LBF) + l * 512, (bf16_t*)(ws + WS_UT), (float*)(ws + WS_DEC), cu, G);
            SEAM(pb + 2);
        }
        if ((PHMASK & 8) && IN(pb + 3)) { KArgs ap = kargs(); unsigned char* ws = ap->ws; GCU; hg::h2_phase(lds, (const bf16_t*)(ws + WS_UT), (const float*)(ws + WS_DEC), (bf16_t*)(ws + WS_ST), cu, G); SEAM(pb + 3); }
        if ((PHMASK & 16) && IN(pb + 4)) {
            { KArgs ap = kargs(); unsigned char* ws = ap->ws; GCU;
              attn_phase((char*)lds, (const bf16_t*)(ws + WS_QN), (const bf16_t*)(ws + WS_KN), (const bf16_t*)(ws + WS_PROJ), (bf16_t*)(ws + WS_MIX), ((const float*)(ws + WS_REF))[l * 64], vcu_of(cu, G), G, true); }
            { KArgs ap = kargs(); unsigned char* ws = ap->ws; GCU;
              hg::h3_phase(lds, (const bf16_t*)(ws + WS_PROJ), (const float*)(ws + WS_LBF) + l * 512, (const bf16_t*)(ws + WS_ST), ap->hgrn_norm_g + l * 64, (bf16_t*)(ws + WS_MIX), cu, G); }
            SEAM(pb + 4);
        }
        if ((PHMASK & 32) && IN(pb + 5)) {
            KArgs ap = kargs(); unsigned char* ws = ap->ws; GCU;
            pg8::Gemm g; g.A = (const bf16_t*)(ws + WS_MIX); g.Bt = (const bf16_t*)(ws + WS_WOUT) + (size_t)l * D * D; g.M = MT; g.N = D; g.K = D; g.pad = 0;
            pg8::StaticOrder S; S.init(MT, D, G, cu);
            pg8::EpiResid E; E.src_lat = (l == 0) ? ap->x : ap->out; E.src_ctx = (l == 0) ? ap->ctx : (const float*)(ws + WS_XC); E.dst_lat = ap->out; E.dst_ctx = (float*)(ws + WS_XC);
            E.modv = (const float*)(ws + WS_MODV) + (size_t)l * 3 * 6144; E.ga_off = 2048; E.pad = 0;
            pg8::gemm_phase<pg8::EpiResid, pg8::StaticOrder, true, true>(ldsl, g, S, E);
            SEAM(pb + 5);
        }
        if ((PHMASK & 64) && IN(pb + 6)) { KArgs ap = kargs(); unsigned char* ws = ap->ws; GCU;
            norm2_router_phase(cu, G, ap->out, (const float*)(ws + WS_XC), ap->norm2_g + l * D, (const float*)(ws + WS_MODV) + (size_t)l * 3 * 6144, 3072, ap->router_w, ap->router_b, (bf16_t*)(ws + WS_XN),
                               (unsigned*)(ws + WS_CTL) + CW_CNT + 64 * l, (u32x4*)(ws + WS_LIST), l == 0 ? 1 : 0);
            SEAM(pb + 6); }
        if ((PHMASK & 128) && IN(pb + 7)) {
            KArgs ap = kargs(); unsigned char* ws = ap->ws; GCU;
            LAS int* TT = (LAS int*)(ldsl + TT_OFF);
            pg8::build_tiles(TT, (const unsigned*)(ws + WS_CTL) + CW_CNT + 64 * l);
            pg8::MoeOrder<8> S; S.TT = TT; S.G = G; S.c = vcu_of(cu, G);
            pg8::Src1 X; X.XN = (const bf16_t*)(ws + WS_XN); X.WGU = (const bf16_t*)(ws + WS_WGU); X.LIST = (const u32x4*)(ws + WS_LIST); pg8::EpiGateUp2 E; E.ACT2 = (bf16_t*)(ws + WS_ACT2); E.LIST = X.LIST;
            pg8::gemm_phase_x(ldsl, ldsl + ROWS_OFF, S, X, E, D, D / 64);
            SEAM(pb + 7);
        }
        if ((PHMASK & 256) && IN(pb + 8)) {
            KArgs ap = kargs(); unsigned char* ws = ap->ws; GCU;
            LAS int* TT = (LAS int*)(ldsl + TT_OFF);
            pg8::build_tiles(TT, (const unsigned*)(ws + WS_CTL) + CW_CNT + 64 * l);
            pg8::MoeOrder<4> S; S.TT = TT; S.G = G; S.c = vcu_of(cu, G);
            pg8::Src2 X; X.ACT2 = (const bf16_t*)(ws + WS_ACT2); X.WD = (const bf16_t*)(ws + WS_WD);
            pg8::EpiMoeOut E; E.lat = ap->out; E.ctx = (float*)(ws + WS_XC); E.modv = (const float*)(ws + WS_MODV) + (size_t)l * 3 * 6144; E.LIST = (const u32x4*)(ws + WS_LIST);
            pg8::gemm_phase_x(ldsl, ldsl + ROWS_OFF, S, X, E, DE, 1024 / 64);
            SEAM(pb + 8);
        }
    }
#undef IN
#undef SEAM
#undef GCU
}

extern "C" void kernel_launch(void* const* d_in, const int* in_sizes, int n_in, void* d_out, int out_size, void* d_ws, size_t ws_size, hipStream_t stream) {
    static int grid = 0;
    if (grid == 0) {
        if (n_in != 21 || in_sizes[0] != BATCH * SEQ * D || out_size != BATCH * SEQ * D || ws_size < WS_END) {
            fprintf(stderr, "kernel_launch: unexpected sizes: n_in %d in0 %d out %d ws %zu (need %zu)\n", n_in, n_in > 0 ? in_sizes[0] : -1, out_size, ws_size, (size_t)WS_END); grid = -1; return; }
        int dev = 0, cus = 0, per_cu = 0;
        if (hipGetDevice(&dev) != hipSuccess || hipDeviceGetAttribute(&cus, hipDeviceAttributeMultiprocessorCount, dev) != hipSuccess) { grid = -1; return; }
        if (hipFuncSetAttribute((const void*)mega_fwd, hipFuncAttributeMaxDynamicSharedMemorySize, LDS_BYTES) != hipSuccess) { fprintf(stderr, "kernel_launch: hipFuncSetAttribute failed\n"); grid = -1; return; }
        if (hipOccupancyMaxActiveBlocksPerMultiprocessor(&per_cu, (const void*)mega_fwd, 512, LDS_BYTES) != hipSuccess || per_cu < 1) fprintf(stderr, "kernel_launch: occupancy query reports %d\n", per_cu);
        (void)hipGetLastError();
        grid = cus;
    }
    if (grid < 0) return;
    if (hipMemsetAsync((char*)d_ws + WS_CTL, 0, 1 * MiB, stream) != hipSuccess) return;
    Args a; memset((void*)&a, 0, sizeof(a));
    a.x = (const float*)d_in[0]; a.c = (const float*)d_in[1]; a.ctx = (const float*)d_in[2]; a.c_ctx = (const float*)d_in[3]; a.w_mod = (const float*)d_in[4]; a.b_mod = (const float*)d_in[5];
    a.norm1_g = (const float*)d_in[6]; a.norm2_g = (const float*)d_in[7]; a.w_in = (const float*)d_in[8]; a.w_out = (const float*)d_in[9]; a.hgrn_lb = (const float*)d_in[10]; a.hgrn_norm_g = (const float*)d_in[11];
    a.pool_w = (const float*)d_in[12]; a.pool_scale = (const float*)d_in[13]; a.q_norm_g = (const float*)d_in[14]; a.k_norm_g = (const float*)d_in[15]; a.router_w = (const float*)d_in[16]; a.router_b = (const float*)d_in[17];
    a.moe_gate = (const float*)d_in[18]; a.moe_up = (const float*)d_in[19]; a.moe_down = (const float*)d_in[20];
    a.out = (float*)d_out; a.ws = (unsigned char*)d_ws;
#if MK_SPLIT
    for (int ph = 0; ph < NPHASE; ++ph) { a.ph_lo = ph; a.ph_hi = ph + 1; hipLaunchKernelGGL(mega_fwd, dim3(grid), dim3(512), LDS_BYTES, stream, a); }
#else
    a.ph_lo = 0; a.ph_hi = NPHASE; hipLaunchKernelGGL(mega_fwd, dim3(grid), dim3(512), LDS_BYTES, stream, a);
#endif
}
```

```cpp
#include <hip/hip_runtime.h>
#include <cstdio>
#include <cstdint>
#include <cstring>

namespace cfg {
constexpr int D = 1024, BATCH = 2, SEQ = 8192, CTXL = 256, DEPTH = 2;
constexpr int PB = SEQ + CTXL;
constexpr int MT = BATCH * PB;
constexpr int TPB = PB / 256;
constexpr int NIN = 2304;
constexpr int NE = 16, DE = 512;
constexpr int C_AQ = 0, C_AFF = 256, C_AFB = 512, C_AI = 768, C_AG = 1024, C_BP = 1280, C_CQ = 1536, C_CK = 2048, C_CV = 2176;
constexpr float EPS = 1e-6f;
constexpr float C2 = 0.125f * 1.4426950408889634f;
}

__device__ __forceinline__ int otid() { int t = threadIdx.x; asm volatile("" : "+v"(t)); return t; }

namespace pg8 {
#define PG8_LAS __attribute__((address_space(3)))
typedef unsigned short bf16_t;
typedef short bf16x8 __attribute__((ext_vector_type(8)));
typedef float f32x4 __attribute__((ext_vector_type(4)));
typedef unsigned u32x4 __attribute__((ext_vector_type(4)));
constexpr int BM = 256, BK = 64, HALF = 128, HTB = HALF * BK * 2  , STAGE_BYTES = 8 * HTB, NXCD = 8, WGM = 8;

__host__ __device__ __forceinline__ int lds_byte(int r, int c) { const int st = (r >> 4) * 2 + (c >> 5), rr = r & 15, cc = c & 31, ob = rr * 64 + cc * 2; return st * 1024 + (ob ^ (((ob >> 9) & 1) << 5)); }
__host__ __device__ __forceinline__ void stage_rc(int b, int& R, int& C) { const int st = b / 1024, sb = b % 1024, swz = sb ^ (((sb >> 9) & 1) << 5); R = (st >> 1) * 16 + swz / 64; C = (st & 1) * 32 + (swz % 64) / 2; }
__host__ __device__ __forceinline__ int perm32(int rho) { const int n = rho >> 4, i = rho & 15; return 8 * (i >> 2) + 4 * n + (i & 3); }

struct Unit { int pm, pn; };
struct Gemm { const bf16_t* A; const bf16_t* Bt; int M, N, K, pad; };

struct StaticOrder {
    int nM, nN, nwg, G, c;
    __host__ __device__ void init(int M, int N, int G_, int c_) { nM = M / BM; nN = N / BM; nwg = nM * nN; G = G_; c = c_; }
    __host__ __device__ bool next(int i, Unit& u) const {
        const long L = (long)i * G + c; if (L >= nwg) return false;
        int wgid = (int)L; { const int q = nwg / NXCD, r = nwg % NXCD, xcd = wgid % NXCD, off = wgid / NXCD; wgid = (xcd < r ? xcd * (q + 1) : r * (q + 1) + (xcd - r) * q) + off; }
        const int nig = WGM * nN, gid = wgid / nig, fm = gid * WGM, gsz = (nM - fm) < WGM ? (nM - fm) : WGM;
        u.pm = fm + ((wgid % nig) % gsz); u.pn = (wgid % nig) / gsz; return true;
    }
    __device__ __forceinline__ void a_ready(const Unit&) const {}
    __device__ __forceinline__ void done(const Unit&) const {}
};

__device__ __forceinline__ unsigned cvt_pk_bf16(float lo, float hi) { unsigned r; asm volatile("v_cvt_pk_bf16_f32 %0, %1, %2" : "=v"(r) : "v"(lo), "v"(hi)); return r; }
typedef float f32x2 __attribute__((ext_vector_type(2)));
__device__ __forceinline__ f32x2 gelu_pk(f32x2 v) {
    const f32x2 av = __builtin_elementwise_abs(v), d = av * 0.2316418882f + 1.0f;
    f32x2 t; t.x = __builtin_amdgcn_rcpf(d.x); t.y = __builtin_amdgcn_rcpf(d.y);
    f32x2 q = t * 0.5307027145f + (-0.7265760135f); q = q * t + 0.7107068705f; q = q * t + (-0.142248368f); q = q * t + 0.127414796f; q = q * t;
    const f32x2 s = (v * v) * (-0.72134752044f);
    f32x2 e; e.x = __builtin_amdgcn_exp2f(s.x); e.y = __builtin_amdgcn_exp2f(s.y);
    const f32x2 m = v * (q * e), r = v - m;
    f32x2 o; o.x = v.x < 0.f ? m.x : r.x; o.y = v.y < 0.f ? m.y : r.y; return o;
}

template <int ACT  > struct EpiBf16 {
    static constexpr bool PERM = true, AFTER_DRAIN = false; static_assert(ACT == 0 || ACT == 1, "EpiBf16: ACT is 0 (none) or 1 (gelu_pk)");
    bf16_t* O; int ldc; const float* bias; int split_cols; size_t split_stride; float scale0;
    __device__ __forceinline__ void operator()(const f32x4 (&acc)[2][2][4][2], const Unit& u, int wr, int wc, int fr, int fq) const {
        asm volatile("" : "+v"(fr), "+v"(fq));
        const int row0 = u.pm * BM + wr * 64 + fr; int colt = u.pn * BM; bf16_t* base = O;
        float sc = 1.f; if (split_cols) { const int t = colt / split_cols; base += (size_t)t * split_stride; colt -= t * split_cols; if (t == 0) sc = scale0; }
        const int col0 = colt + wc * 32 + 8 * fq, bcol0 = u.pn * BM + wc * 32 + 8 * fq;
        f32x4 bv[2][2];
#pragma unroll
        for (int bj = 0; bj < 2; ++bj)
#pragma unroll
            for (int n = 0; n < 2; ++n) bv[bj][n] = bias ? *(const f32x4*)(bias + bcol0 + bj * HALF + 4 * n) : (f32x4){0.f, 0.f, 0.f, 0.f};
#pragma unroll
        for (int ai = 0; ai < 2; ++ai)
#pragma unroll
            for (int m = 0; m < 4; ++m) { bf16_t* rowp = base + (size_t)(row0 + ai * HALF + m * 16) * ldc + col0;
#pragma unroll
                for (int bj = 0; bj < 2; ++bj) { f32x4 v0 = acc[ai][bj][m][0] + bv[bj][0], v1 = acc[ai][bj][m][1] + bv[bj][1];
                    if (ACT == 1) { f32x2 a = gelu_pk((f32x2){v0[0], v0[1]}), b = gelu_pk((f32x2){v0[2], v0[3]}), c = gelu_pk((f32x2){v1[0], v1[1]}), d = gelu_pk((f32x2){v1[2], v1[3]});
                        v0 = (f32x4){a.x, a.y, b.x, b.y}; v1 = (f32x4){c.x, c.y, d.x, d.y}; }
                    v0 = v0 * sc; v1 = v1 * sc; u32x4 w; w.x = cvt_pk_bf16(v0[0], v0[1]); w.y = cvt_pk_bf16(v0[2], v0[3]); w.z = cvt_pk_bf16(v1[0], v1[1]); w.w = cvt_pk_bf16(v1[2], v1[3]);
                    *(u32x4*)(rowp + bj * HALF) = w; } }
    }
};

template <class Epi, class Sched, bool ALIGN_EPI = false, bool SP2 = false>
__device__ __forceinline__ void gemm_phase(PG8_LAS unsigned char* lds, const Gemm g, const Sched& S, const Epi& E) {
    const int tid = otid(), wid = __builtin_amdgcn_readfirstlane(tid >> 6), lane = tid & 63, wr = wid >> 2, wc = wid & 3, fr = lane & 15, fq = lane >> 4;
    const int K = g.K, nt = K / BK;
    unsigned voffA[2], voffB[2];
#pragma unroll
    for (int i = 0; i < 2; ++i) { int R, C; stage_rc(tid * 16 + i * 8192, R, C); const int Rb = Epi::PERM ? ((R & ~31) + perm32(R & 31)) : R;
        voffA[i] = (unsigned)(R * K + C) * 2u; voffB[i] = (unsigned)(Rb * K + C) * 2u; }
    const size_t kstep = (size_t)(BK * 2);
    const size_t hstep = (size_t)HALF * K * 2;
    const size_t tstep = 2 * hstep;
    const unsigned ldsw = (unsigned)wid * 1024u;
    const int aoff = lds_byte(wr * 64 + fr, fq * 8), boff = lds_byte(wc * 32 + fr, fq * 8);
#define PG8_SA(b, h) (((b) * 2 + (h)) * HTB)
#define PG8_SB(b, h) ((4 + (b) * 2 + (h)) * HTB)
#define PG8_STAGE(bufoff, gbase, voff) do { _Pragma("unroll") for (int _i = 0; _i < 2; ++_i) \
        __builtin_amdgcn_global_load_lds((const unsigned*)((const char*)(gbase) + (voff)[_i]), (PG8_LAS unsigned*)(lds + (bufoff) + ldsw + _i * 8192), 16, 0, 0); } while (0)
#define PG8_LDA(dst, b, h) do { _Pragma("unroll") for (int m = 0; m < 4; ++m) _Pragma("unroll") for (int k = 0; k < 2; ++k) dst[m][k] = *(const PG8_LAS bf16x8*)(lds + PG8_SA(b, h) + aoff + m * 2048 + k * 1024); } while (0)
#define PG8_LDB(dst, b, h) do { _Pragma("unroll") for (int n = 0; n < 2; ++n) _Pragma("unroll") for (int k = 0; k < 2; ++k) dst[n][k] = *(const PG8_LAS bf16x8*)(lds + PG8_SB(b, h) + boff + n * 2048 + k * 1024); } while (0)
#define PG8_MMA(ai, bj, At, Bt) do { __builtin_amdgcn_s_setprio(1); _Pragma("unroll") for (int m = 0; m < 4; ++m) _Pragma("unroll") for (int n = 0; n < 2; ++n) _Pragma("unroll") for (int k = 0; k < 2; ++k) \
        acc[ai][bj][m][n] = __builtin_amdgcn_mfma_f32_16x16x32_bf16(Bt[n][k], At[m][k], acc[ai][bj][m][n], 0, 0, 0); __builtin_amdgcn_s_setprio(0); } while (0)
#define PG8_WAIT_V(n) asm volatile("s_waitcnt vmcnt(" #n ")" ::: "memory")
#define PG8_WAIT_L(n) asm volatile("s_waitcnt lgkmcnt(" #n ")" ::: "memory")
#define PG8_BAR __builtin_amdgcn_s_barrier()
#define PG8_SCHED __builtin_amdgcn_sched_barrier(0)
    Unit cur, nxt; int ui = 0;
    if (!S.next(0, cur)) return;
    f32x4 acc[2][2][4][2];
#pragma unroll
    for (int a = 0; a < 2; ++a)
#pragma unroll
        for (int b = 0; b < 2; ++b)
#pragma unroll
            for (int m = 0; m < 4; ++m)
#pragma unroll
                for (int n = 0; n < 2; ++n) acc[a][b][m][n] = (f32x4){0.f, 0.f, 0.f, 0.f};
    bf16x8 At[4][2], B0[2][2], B1[2][2];
    const char* cA = (const char*)g.A + (size_t)cur.pm * tstep; const char* cB = (const char*)g.Bt + (size_t)cur.pn * tstep;
    S.a_ready(cur);
    if constexpr (SP2) {
        PG8_STAGE(PG8_SB(0, 0), cB, voffB); PG8_STAGE(PG8_SB(0, 1), cB + hstep, voffB); PG8_STAGE(PG8_SA(0, 0), cA, voffA); PG8_STAGE(PG8_SA(0, 1), cA + hstep, voffA);
        if (wr == 1) PG8_BAR;
        PG8_WAIT_V(2); PG8_BAR;
        PG8_STAGE(PG8_SB(1, 0), cB + kstep, voffB); PG8_STAGE(PG8_SA(1, 0), cA + kstep, voffA); PG8_STAGE(PG8_SB(1, 1), cB + hstep + kstep, voffB);
        PG8_WAIT_V(6); PG8_BAR;
    } else {
        PG8_STAGE(PG8_SB(0, 0), cB, voffB); PG8_STAGE(PG8_SA(0, 0), cA, voffA); PG8_STAGE(PG8_SB(0, 1), cB + hstep, voffB); PG8_STAGE(PG8_SA(0, 1), cA + hstep, voffA);
        if (wr == 1) PG8_BAR;
        PG8_WAIT_V(4); PG8_BAR;
        PG8_STAGE(PG8_SB(1, 0), cB + kstep, voffB); PG8_STAGE(PG8_SA(1, 0), cA + kstep, voffA); PG8_STAGE(PG8_SB(1, 1), cB + hstep + kstep, voffB);
        PG8_WAIT_V(6); PG8_BAR;
    }
    for (;;) {
        const bool has_next = S.next(ui + 1, nxt);
        const char* nA = has_next ? (const char*)g.A + (size_t)nxt.pm * tstep : cA; const char* nB = has_next ? (const char*)g.Bt + (size_t)nxt.pn * tstep : cB;
        for (int t = 0; t < nt; t += 2) {
            const bool last = (t == nt - 2);
            const char* a1 = cA + (size_t)(t + 1) * kstep;
            const char* a2 = last ? nA : cA + (size_t)(t + 2) * kstep; const char* b2 = last ? nB : cB + (size_t)(t + 2) * kstep;
            const char* a3 = a2 + kstep; const char* b3 = b2 + kstep;
            if (last && has_next) S.a_ready(nxt);
            if constexpr (SP2) {
            PG8_LDB(B0, 0, 0); PG8_LDB(B1, 0, 1); PG8_SCHED; PG8_LDA(At, 0, 0); PG8_STAGE(PG8_SA(1, 1), a1 + hstep, voffA);
            PG8_WAIT_V(8); PG8_WAIT_L(0); PG8_BAR; PG8_MMA(0, 0, At, B0); PG8_MMA(0, 1, At, B1); PG8_BAR; PG8_SCHED;
            PG8_LDA(At, 0, 1); PG8_STAGE(PG8_SB(0, 0), b2, voffB); PG8_STAGE(PG8_SB(0, 1), b2 + hstep, voffB); PG8_STAGE(PG8_SA(0, 0), a2, voffA);
            PG8_WAIT_V(8); PG8_WAIT_L(0); PG8_BAR; PG8_MMA(1, 0, At, B0); PG8_MMA(1, 1, At, B1); PG8_BAR; PG8_SCHED;
            PG8_LDB(B0, 1, 0); PG8_LDB(B1, 1, 1); PG8_SCHED; PG8_LDA(At, 1, 0); PG8_STAGE(PG8_SA(0, 1), a2 + hstep, voffA);
            PG8_WAIT_V(8); PG8_WAIT_L(0); PG8_BAR; PG8_MMA(0, 0, At, B0); PG8_MMA(0, 1, At, B1); PG8_BAR; PG8_SCHED;
            PG8_LDA(At, 1, 1); PG8_STAGE(PG8_SB(1, 0), b3, voffB); PG8_STAGE(PG8_SB(1, 1), b3 + hstep, voffB); PG8_STAGE(PG8_SA(1, 0), a3, voffA);
            PG8_WAIT_V(8); PG8_WAIT_L(0); PG8_BAR; PG8_MMA(1, 0, At, B0); PG8_MMA(1, 1, At, B1); PG8_BAR; PG8_SCHED;
            } else {
            PG8_LDB(B0, 0, 0); PG8_SCHED; PG8_LDA(At, 0, 0); PG8_STAGE(PG8_SA(1, 1), a1 + hstep, voffA);
            PG8_WAIT_L(8); PG8_BAR; PG8_WAIT_L(0); PG8_MMA(0, 0, At, B0); PG8_BAR; PG8_SCHED;
            PG8_LDB(B1, 0, 1); PG8_STAGE(PG8_SB(0, 0), b2, voffB);
            PG8_BAR; PG8_WAIT_L(0); PG8_MMA(0, 1, At, B1); PG8_BAR;
            PG8_LDA(At, 0, 1); PG8_STAGE(PG8_SA(0, 0), a2, voffA);
            PG8_BAR; PG8_WAIT_L(0); PG8_MMA(1, 0, At, B0); PG8_BAR; PG8_SCHED;
            PG8_STAGE(PG8_SB(0, 1), b2 + hstep, voffB);
            PG8_WAIT_V(6); PG8_BAR; PG8_MMA(1, 1, At, B1); PG8_BAR;
            PG8_LDB(B0, 1, 0); PG8_SCHED; PG8_LDA(At, 1, 0); PG8_STAGE(PG8_SA(0, 1), a2 + hstep, voffA);
            PG8_WAIT_L(8); PG8_BAR; PG8_WAIT_L(0); PG8_MMA(0, 0, At, B0); PG8_BAR; PG8_SCHED;
            PG8_LDB(B1, 1, 1); PG8_STAGE(PG8_SB(1, 0), b3, voffB);
            PG8_BAR; PG8_WAIT_L(0); PG8_MMA(0, 1, At, B1); PG8_BAR;
            PG8_LDA(At, 1, 1); PG8_STAGE(PG8_SA(1, 0), a3, voffA);
            PG8_BAR; PG8_WAIT_L(0); PG8_MMA(1, 0, At, B0); PG8_BAR; PG8_SCHED;
            PG8_STAGE(PG8_SB(1, 1), b3 + hstep, voffB);
            PG8_WAIT_V(6); PG8_BAR; PG8_MMA(1, 1, At, B1); PG8_BAR;
            }
        }
        if constexpr (ALIGN_EPI) { if (wr == 0) PG8_BAR; }
        if constexpr (!Epi::AFTER_DRAIN) { E(acc, cur, wr, wc, fr, fq); S.done(cur); }
        if (!has_next) break;
#pragma unroll
        for (int a = 0; a < 2; ++a)
#pragma unroll
            for (int b = 0; b < 2; ++b)
#pragma unroll
                for (int m = 0; m < 4; ++m)
#pragma unroll
                    for (int n = 0; n < 2; ++n) acc[a][b][m][n] = (f32x4){0.f, 0.f, 0.f, 0.f};
        cur = nxt; cA = nA; cB = nB; ++ui;
        if constexpr (ALIGN_EPI) { if (wr == 1) PG8_BAR; }
    }
    PG8_WAIT_V(0);
    if constexpr (!ALIGN_EPI) { if (wr == 0) PG8_BAR; }
    PG8_BAR;
    if constexpr (Epi::AFTER_DRAIN) { E.fused(acc, cur, wr, wc, fr, fq, lds, wid, lane); S.done(cur); }
#undef PG8_SA
#undef PG8_SB
#undef PG8_STAGE
#undef PG8_LDA
#undef PG8_LDB
#undef PG8_MMA
#undef PG8_WAIT_V
#undef PG8_WAIT_L
#undef PG8_BAR
#undef PG8_SCHED
}
}

#include <hip/hip_bf16.h>
#include <cmath>
namespace attn_body {
using bf16=__hip_bfloat16;
using bf16x8=__attribute__((ext_vector_type(8)))short;
using s16x4=__attribute__((ext_vector_type(4)))short;
using f32x16=__attribute__((ext_vector_type(16)))float;
using u32x4=__attribute__((ext_vector_type(4)))unsigned;
constexpr int D=64,QP=512,KP=128,VP=2304,OP=1024;
constexpr int NW=8,QBLK=32,QB=QBLK*NW,KVBLK=64;
constexpr int ATTN_UNIT_ROWS=QB;
__device__ __forceinline__ int crow(int r,int hi){return (r&3)+8*(r>>2)+4*hi;}
#define SBAR() __builtin_amdgcn_sched_barrier(0)
constexpr int NSLOT=3, SLOTB=8192;
constexpr int LDS_K=0, LDS_V=NSLOT*SLOTB, LDS_WS=2*NSLOT*SLOTB, LDS_OST=LDS_WS+NW*64*4, LDS_BYTES=LDS_OST+NW*4096;
constexpr float C2=0.125f*1.4426950408889634f;
__device__ __forceinline__ void glds16(const void*gsrc,unsigned lds_dst){unsigned keep;
  asm volatile("s_mov_b32 %0, m0\n\ts_mov_b32 m0, %2\n\ts_nop 0\n\tglobal_load_lds_dwordx4 %1, off\n\ts_mov_b32 m0, %0":"=&s"(keep):"v"(gsrc),"s"(lds_dst):"memory");}
__device__ __forceinline__ float max3f(float a,float b,float c){float r;asm("v_max3_f32 %0, %1, %2, %3":"=v"(r):"v"(a),"v"(b),"v"(c));return r;}
__device__ __forceinline__ float max2f(float a,float b){float r;asm("v_max_f32_e32 %0, %1, %2":"=v"(r):"v"(a),"v"(b));return r;}
__device__ __forceinline__ float fadd_s(float a,float b){float r;asm("v_add_f32_e32 %0, %1, %2":"=v"(r):"v"(a),"v"(b));return r;}
__device__ __forceinline__ float fsub_s(float a,float b){float r;asm("v_sub_f32_e32 %0, %1, %2":"=v"(r):"v"(a),"v"(b));return r;}
typedef float f32x2_t __attribute__((ext_vector_type(2))); typedef __bf16 bf16x2_t __attribute__((ext_vector_type(2)));
__device__ __forceinline__ unsigned cvtpk_s(float lo,float hi){f32x2_t v={lo,hi};bf16x2_t b=__builtin_convertvector(v,bf16x2_t);return __builtin_bit_cast(unsigned,b);}
#define WAIT_BAR(N) asm volatile("s_waitcnt vmcnt(" #N ") lgkmcnt(0)\n\ts_barrier":::"memory")

__device__ __forceinline__ void qkt(f32x16&p0,f32x16&p1,const char*Kslot,const bf16x8*qr,const f32x16&negm,int r32,int hi){
  const char*kb=Kslot+hi*1024+r32*16;
  #pragma unroll
  for(int d0=0;d0<4;++d0){
    const bf16x8 b0=*reinterpret_cast<const bf16x8*>(kb+d0*2048);
    const bf16x8 b1=*reinterpret_cast<const bf16x8*>(kb+d0*2048+512);
    if(d0==0){p0=__builtin_amdgcn_mfma_f32_32x32x16_bf16(b0,qr[0],negm,0,0,0);p1=__builtin_amdgcn_mfma_f32_32x32x16_bf16(b1,qr[0],negm,0,0,0);}
    else{p0=__builtin_amdgcn_mfma_f32_32x32x16_bf16(b0,qr[d0],p0,0,0,0);p1=__builtin_amdgcn_mfma_f32_32x32x16_bf16(b1,qr[d0],p1,0,0,0);}}
}
typedef __attribute__((address_space(3))) const char* lds_cptr;
typedef short v4i16_t __attribute__((ext_vector_type(4)));
__device__ __forceinline__ void kload8(bf16x8*kf,lds_cptr kp){
  kf[0]=*(const __attribute__((address_space(3))) bf16x8*)(kp);      kf[1]=*(const __attribute__((address_space(3))) bf16x8*)(kp+512);
  kf[2]=*(const __attribute__((address_space(3))) bf16x8*)(kp+2048); kf[3]=*(const __attribute__((address_space(3))) bf16x8*)(kp+2560);
  kf[4]=*(const __attribute__((address_space(3))) bf16x8*)(kp+4096); kf[5]=*(const __attribute__((address_space(3))) bf16x8*)(kp+4608);
  kf[6]=*(const __attribute__((address_space(3))) bf16x8*)(kp+6144); kf[7]=*(const __attribute__((address_space(3))) bf16x8*)(kp+6656);
}
__device__ __forceinline__ void kload2(bf16x8*kf,lds_cptr kp,int j){ kf[2*j]=*(const __attribute__((address_space(3))) bf16x8*)(kp+j*2048); kf[2*j+1]=*(const __attribute__((address_space(3))) bf16x8*)(kp+j*2048+512); }
__device__ __forceinline__ s16x4 vtr(lds_cptr p){ return __builtin_bit_cast(s16x4,__builtin_amdgcn_ds_read_tr16_b64_v4i16((__attribute__((address_space(3))) v4i16_t*)p)); }
__device__ __forceinline__ float rowmax(const f32x16&p0,const f32x16&p1){
  float a=max3f(p0[0],p0[1],p1[0]),b=max3f(p0[2],p0[3],p1[1]);a=max3f(a,p1[2],p1[3]);
  #pragma unroll
  for(int r=4;r<16;r+=4){a=max3f(a,p0[r],p0[r+1]);b=max3f(b,p0[r+2],p0[r+3]);a=max3f(a,p1[r],p1[r+1]);b=max3f(b,p1[r+2],p1[r+3]);}
  const float m=max2f(a,b);
  auto rr=__builtin_amdgcn_permlane32_swap(__float_as_uint(m),__float_as_uint(m),false,false);
  return max2f(__uint_as_float(rr[0]),__uint_as_float(rr[1]));
}
__device__ __forceinline__ void pv(f32x16*o,int vb,bf16x8 pa0,bf16x8 pa1,bf16x8 pa2,bf16x8 pa3){
  #pragma unroll
  for(int d0=0;d0<2;++d0){s16x4 lo[4],hi[4];
    #pragma unroll
    for(int ks=0;ks<4;++ks){
      asm volatile("ds_read_b64_tr_b16 %0,%1 offset:%c2":"=&v"(lo[ks]):"v"(vb),"i"(d0*4096+ks*1024):"memory");
      asm volatile("ds_read_b64_tr_b16 %0,%1 offset:%c2":"=&v"(hi[ks]):"v"(vb),"i"(d0*4096+ks*1024+512):"memory");}
    asm volatile("s_waitcnt lgkmcnt(0)":::"memory");SBAR();
    #define PK(k) (bf16x8){lo[k][0],lo[k][1],lo[k][2],lo[k][3],hi[k][0],hi[k][1],hi[k][2],hi[k][3]}
    o[d0]=__builtin_amdgcn_mfma_f32_32x32x16_bf16(pa0,PK(0),o[d0],0,0,0);
    o[d0]=__builtin_amdgcn_mfma_f32_32x32x16_bf16(pa1,PK(1),o[d0],0,0,0);
    o[d0]=__builtin_amdgcn_mfma_f32_32x32x16_bf16(pa2,PK(2),o[d0],0,0,0);
    o[d0]=__builtin_amdgcn_mfma_f32_32x32x16_bf16(pa3,PK(3),o[d0],0,0,0);
    #undef PK
  }
}

#ifndef ATTN_STORE16
#define ATTN_STORE16(p,v) (*(u32x4*)(p)=(v))
#endif
__device__ __forceinline__ void attn_unit(const bf16*Qw0,const bf16*__restrict__ Kh,const bf16*__restrict__ Vh,bf16*Ow0,const int NT,const float neg_ref,char*shm){
  const int tid=otid(),lane=tid&63,r32=lane&31,hi=lane>>5; const int wid=__builtin_amdgcn_readfirstlane(tid>>6);
  const bf16*Qw=Qw0+(long)(wid*QBLK)*QP;
  const unsigned lds0=(unsigned)(uintptr_t)shm;
  float*wsf=(float*)(shm+LDS_WS)+wid*64;
  const bf16*ksrc=Kh+(long)lane*KP+wid*8;
  const bf16*vsrc=Vh+(long)(16*(wid&3)+(lane>>2))*VP+(wid>>2)*32+(lane&3)*8;
  const unsigned kdst=lds0+LDS_K+wid*1024, vdst=lds0+LDS_V+wid*1024;
  #define DMA_K(t,slot) glds16(ksrc+(long)(t)*KVBLK*KP,(unsigned)__builtin_amdgcn_readfirstlane(kdst+(slot)))
  #define DMA_V(t,slot) glds16(vsrc+(long)(t)*KVBLK*VP,(unsigned)__builtin_amdgcn_readfirstlane(vdst+(slot)))
  const int vb0=(int)(lds0+LDS_V)+((lane>>4)&1)*32+(lane&3)*8+(4*hi+((lane&15)>>2))*64;
  const char*Kbase=shm+LDS_K; bf16x8 kf[8];
  const lds_cptr shm3=(lds_cptr)shm; const lds_cptr kp0=shm3+LDS_K+hi*1024+r32*16; const lds_cptr vp0=shm3+LDS_V+((lane>>4)&1)*32+(lane&3)*8+(4*hi+((lane&15)>>2))*64;
  DMA_K(0,0);DMA_V(0,0);DMA_K(1,SLOTB);
  bf16x8 qr[4];
  #pragma unroll
  for(int d0=0;d0<4;++d0)qr[d0]=*reinterpret_cast<const bf16x8*>(&Qw[(long)r32*QP+d0*16+hi*8]);
  float l_reg=0.f;f32x16 o[2];o[0]=f32x16{};o[1]=f32x16{};f32x16 negm;
  #pragma unroll
  for(int r=0;r<16;++r)negm[r]=neg_ref;
  asm volatile("":"+v"(negm));
  f32x16 pA0,pA1,pB0,pB1;
  int sl_prev=0,sl_cur=0,sl_next=SLOTB;
  #define ROT() do{sl_prev=sl_cur;sl_cur=sl_next;sl_next=(sl_next==(NSLOT-1)*SLOTB)?0:sl_next+SLOTB;}while(0)
  DMA_K(2,2*SLOTB);
  WAIT_BAR(3);
  qkt(pA0,pA1,Kbase,qr,negm,r32,hi);asm volatile("s_nop 15\n\ts_nop 7":"+v"(pA0),"+v"(pA1));
  _Pragma("unroll") for(int r=0;r<16;++r)pA0[r]=__builtin_amdgcn_exp2f(pA0[r]);
  _Pragma("unroll") for(int r=0;r<16;++r)pA1[r]=__builtin_amdgcn_exp2f(pA1[r]);
  WAIT_BAR(0);
  DMA_K(3,0);DMA_V(1,SLOTB);
  ROT();
  kload8(kf,kp0+sl_cur);
  WAIT_BAR(2);
  s16x4 vlo[8],vhi[8]; u32x4 pw0,pw1,pw2,pw3;
  #define PKW(P,B) cvtpk_s(P[B],P[B+1])
  #define PAF(k) __builtin_bit_cast(bf16x8,pw##k)
  #define VFR(i) (bf16x8){vlo[i][0],vlo[i][1],vlo[i][2],vlo[i][3],vhi[i][0],vhi[i][1],vhi[i][2],vhi[i][3]}
  #define PIN(x) asm volatile("":"+v"(x))
  #define MX3(a,b,c) __builtin_fmaxf(__builtin_fmaxf((a),(b)),(c))
  #define GAPA(MF,A0,A1,A2,A3,W0,W1,PW) do{ MF; sacc+=A0; sacc+=A1; sacc+=A2; sacc+=A3; PIN(sacc); W0; W1; PIN(PW); SBAR(); }while(0)
  #define EX(v) __builtin_amdgcn_exp2f(v)
  #define GAPB(MF,X,B) do{ MF; X[B]=EX(X[B]); X[B+1]=EX(X[B+1]); X[B+2]=EX(X[B+2]); X[B+3]=EX(X[B+3]); PIN(X); SBAR(); }while(0)
  #define VRD(i) do{ vlo[i]=vtr(vp_+(((i)>>2)*4096+((i)&3)*1024)); vhi[i]=vtr(vp_+(((i)>>2)*4096+((i)&3)*1024+512)); }while(0)
  #define KRD(G,j) do{ if(G){ kload2(kf,kp0+sl_next,j); SBAR(); } }while(0)
  #define STEP(C0,C1,P0,P1,t,GK,GV,GL) do{ SBAR(); \
    const lds_cptr vp_=vp0+sl_prev; \
    VRD(0); SBAR(); float sacc=(P0[0]+P0[1]); \
    GAPA(C0=__builtin_amdgcn_mfma_f32_32x32x16_bf16(kf[0],qr[0],negm,0,0,0), P0[2],P0[3],P0[4],P0[5],     pw0[0]=PKW(P0,0), pw0[1]=PKW(P0,2), pw0); \
    VRD(4); SBAR(); GAPA(C1=__builtin_amdgcn_mfma_f32_32x32x16_bf16(kf[1],qr[0],negm,0,0,0), P0[6],P0[7],P0[8],P0[9],     pw0[2]=PKW(P0,4), pw0[3]=PKW(P0,6), pw0); \
    VRD(1); SBAR(); GAPA(C0=__builtin_amdgcn_mfma_f32_32x32x16_bf16(kf[2],qr[1],C0,0,0,0),   P0[10],P0[11],P0[12],P0[13], pw1[0]=PKW(P0,8), pw1[1]=PKW(P0,10), pw1); \
    VRD(5); SBAR(); GAPA(C1=__builtin_amdgcn_mfma_f32_32x32x16_bf16(kf[3],qr[1],C1,0,0,0),   P0[14],P0[15],P1[0],P1[1],   pw1[2]=PKW(P0,12),pw1[3]=PKW(P0,14), pw1); \
    VRD(2); SBAR(); GAPA(C0=__builtin_amdgcn_mfma_f32_32x32x16_bf16(kf[4],qr[2],C0,0,0,0),   P1[2],P1[3],P1[4],P1[5],     pw2[0]=PKW(P1,0), pw2[1]=PKW(P1,2), pw2); \
    VRD(6); SBAR(); GAPA(C1=__builtin_amdgcn_mfma_f32_32x32x16_bf16(kf[5],qr[2],C1,0,0,0),   P1[6],P1[7],P1[8],P1[9],     pw2[2]=PKW(P1,4), pw2[3]=PKW(P1,6), pw2); \
    VRD(3); SBAR(); GAPA(C0=__builtin_amdgcn_mfma_f32_32x32x16_bf16(kf[6],qr[3],C0,0,0,0),   P1[10],P1[11],P1[12],P1[13], pw3[0]=PKW(P1,8), pw3[1]=PKW(P1,10), pw3); \
    VRD(7); SBAR(); GAPA(C1=__builtin_amdgcn_mfma_f32_32x32x16_bf16(kf[7],qr[3],C1,0,0,0),   P1[14],P1[15],0.f,0.f,       pw3[2]=PKW(P1,12),pw3[3]=PKW(P1,14), pw3); \
    l_reg+=sacc; \
    if(GK){DMA_K((t)+3,sl_cur);} if(GV){DMA_V((t)+1,sl_next);} \
    SBAR(); \
    GAPB(o[0]=__builtin_amdgcn_mfma_f32_32x32x16_bf16(PAF(0),VFR(0),o[0],0,0,0), C0,0); \
    GAPB(o[1]=__builtin_amdgcn_mfma_f32_32x32x16_bf16(PAF(0),VFR(4),o[1],0,0,0), C0,4); \
    KRD(GL,0); GAPB(o[0]=__builtin_amdgcn_mfma_f32_32x32x16_bf16(PAF(1),VFR(1),o[0],0,0,0), C0,8); \
    KRD(GL,1); GAPB(o[1]=__builtin_amdgcn_mfma_f32_32x32x16_bf16(PAF(1),VFR(5),o[1],0,0,0), C0,12); \
    KRD(GL,2); GAPB(o[0]=__builtin_amdgcn_mfma_f32_32x32x16_bf16(PAF(2),VFR(2),o[0],0,0,0), C1,0); \
    KRD(GL,3); GAPB(o[1]=__builtin_amdgcn_mfma_f32_32x32x16_bf16(PAF(2),VFR(6),o[1],0,0,0), C1,4); \
    GAPB(o[0]=__builtin_amdgcn_mfma_f32_32x32x16_bf16(PAF(3),VFR(3),o[0],0,0,0), C1,8); \
    GAPB(o[1]=__builtin_amdgcn_mfma_f32_32x32x16_bf16(PAF(3),VFR(7),o[1],0,0,0), C1,12); \
    }while(0)
  int t=1;
  for(;t+5<NT;t+=2){
    STEP(pB0,pB1,pA0,pA1,t,true,true,true);     WAIT_BAR(2); ROT();
    STEP(pA0,pA1,pB0,pB1,t+1,true,true,true);   WAIT_BAR(2); ROT();
  }
  #define ENDW(tt) do{ if((tt)+3<NT){WAIT_BAR(2);} else if((tt)+2<NT){WAIT_BAR(1);} else {WAIT_BAR(0);} }while(0)
  for(;t+1<NT;t+=2){
    STEP(pB0,pB1,pA0,pA1,t,(t+3<NT),(t+1<NT),(t+1<NT));       ENDW(t);   ROT();
    STEP(pA0,pA1,pB0,pB1,t+1,(t+4<NT),(t+2<NT),(t+2<NT));     ENDW(t+1); ROT();
  }
  STEP(pB0,pB1,pA0,pA1,NT-1,false,false,false);
  { float sacc=pB0[0]+pB0[1]; _Pragma("unroll") for(int r=2;r<16;++r)sacc+=pB0[r]; _Pragma("unroll") for(int r=0;r<16;++r)sacc+=pB1[r]; l_reg+=sacc;
    pw0=(u32x4){PKW(pB0,0),PKW(pB0,2),PKW(pB0,4),PKW(pB0,6)};pw1=(u32x4){PKW(pB0,8),PKW(pB0,10),PKW(pB0,12),PKW(pB0,14)};pw2=(u32x4){PKW(pB1,0),PKW(pB1,2),PKW(pB1,4),PKW(pB1,6)};pw3=(u32x4){PKW(pB1,8),PKW(pB1,10),PKW(pB1,12),PKW(pB1,14)};
    SBAR(); pv(o,vb0+sl_cur,PAF(0),PAF(1),PAF(2),PAF(3)); }
  #undef PKW
  #undef PAF
  #undef VFR
  #undef PIN
  #undef MX3
  #undef GAPA
  #undef GAPB
  #undef EX
  #undef VRD
  #undef KRD
  #undef STEP
  #undef ENDW
  {auto rr=__builtin_amdgcn_permlane32_swap(__float_as_uint(l_reg),__float_as_uint(l_reg),false,false);l_reg=__uint_as_float(rr[0])+__uint_as_float(rr[1]);}
  if(hi==0)wsf[32+r32]=l_reg;asm volatile("s_waitcnt lgkmcnt(0)":::"memory");
  float rli[16];
  #pragma unroll
  for(int r=0;r<16;++r)rli[r]=__builtin_amdgcn_rcpf(wsf[32+crow(r,hi)]);
  bf16*Ow=Ow0+(long)(wid*QBLK)*OP;
  { bf16*stg=(bf16*)(shm+LDS_OST)+wid*2048;
    #pragma unroll
    for(int r=0;r<16;++r){const int orow=crow(r,hi);
      #pragma unroll
      for(int d0=0;d0<2;++d0)stg[orow*64+d0*32+r32]=__float2bfloat16(o[d0][r]*rli[r]);}
    asm volatile("s_waitcnt lgkmcnt(0)":::"memory");
    #pragma unroll
    for(int i=0;i<4;++i){const int row=i*8+(lane>>3),ch=lane&7; const u32x4 v=*(const u32x4*)(stg+row*64+ch*8); ATTN_STORE16(Ow+(long)row*OP+ch*8,v);} }
  asm volatile("s_waitcnt lgkmcnt(0)\n\ts_barrier":::"memory");
  #undef DMA_K
  #undef DMA_V
  #undef ROT
}
constexpr int ATTN_LDS_BYTES=LDS_BYTES;
#undef SBAR
#undef WAIT_BAR
}


using namespace cfg;
typedef unsigned short bf16_t;
typedef float f32x4 __attribute__((ext_vector_type(4)));
typedef unsigned u32x4 __attribute__((ext_vector_type(4)));
typedef unsigned u32x2 __attribute__((ext_vector_type(2)));

__device__ __forceinline__ float bf2f(unsigned v) { return __uint_as_float(v << 16); }
__device__ __forceinline__ float bflo(unsigned w) { return __uint_as_float(w << 16); }
__device__ __forceinline__ float bfhi(unsigned w) { return __uint_as_float(w & 0xffff0000u); }
__device__ __forceinline__ unsigned f2bf(float f) { unsigned u = __float_as_uint(f); return (u + 0x7fffu + ((u >> 16) & 1u)) >> 16; }
__device__ __forceinline__ unsigned pk2(float lo, float hi) { return f2bf(lo) | (f2bf(hi) << 16); }
__device__ __forceinline__ float sigm(float x) { return 1.f / (1.f + __expf(-x)); }
__device__ __forceinline__ float silu(float x) { return x / (1.f + __expf(-x)); }
template <int M> __device__ __forceinline__ float xsum(float v) {
    if constexpr (M < 32) return v + __uint_as_float((unsigned)__builtin_amdgcn_ds_swizzle((int)__float_as_uint(v), (M << 10) | 0x1f));
    else { auto rr = __builtin_amdgcn_permlane32_swap(__float_as_uint(v), __float_as_uint(v), false, false); return __uint_as_float(rr[0]) + __uint_as_float(rr[1]); }
}
__device__ __forceinline__ float wave_sum(float v) { v = xsum<1>(v); v = xsum<2>(v); v = xsum<4>(v); v = xsum<8>(v); v = xsum<16>(v); v = xsum<32>(v); return v; }
__device__ __forceinline__ size_t stream_off(int row, bool& is_ctx) { const int b = row / PB, p = row - b * PB; is_ctx = p < CTXL; return is_ctx ? ((size_t)b * CTXL + p) * D : ((size_t)b * SEQ + (p - CTXL)) * D; }

constexpr size_t MiB = 1u << 20;
constexpr size_t WS_CTL = 0;
constexpr size_t WS_MODV = 1 * MiB;
constexpr size_t WS_LBF = WS_MODV + 256 * 1024;
constexpr size_t WS_REF = WS_LBF + 8192;
constexpr size_t WS_POOLWT = WS_MODV + 512 * 1024;
constexpr size_t WS_COS = 2 * MiB, WS_SIN = 3 * MiB;
constexpr size_t WS_WIN = 4 * MiB;
constexpr size_t WS_WOUT = 13 * MiB;
constexpr size_t WS_WGU = 17 * MiB;
constexpr size_t WS_WD = 49 * MiB;
constexpr size_t WS_XC = 65 * MiB;
constexpr size_t WS_XN = 67 * MiB;
constexpr size_t WS_PROJ = 100 * MiB;
constexpr size_t WS_QN = 175 * MiB;
constexpr size_t WS_KN = 192 * MiB;
constexpr size_t WS_MIX = 197 * MiB;
constexpr size_t WS_UT = 230 * MiB;
constexpr size_t WS_ST = 247 * MiB;
constexpr size_t WS_DEC = 264 * MiB;
constexpr size_t WS_LIST = 265 * MiB;
constexpr size_t WS_ACT2 = WS_PROJ;
constexpr size_t WS_END = 272 * MiB;
constexpr int CW_CNT = 1024;

__device__ const float ROPE_INV[16] = {1.0f, 0.5623413251903491f, 0.31622776601683794f, 0.1778279410038923f, 0.1f, 0.05623413251903491f, 0.03162277660168379f, 0.01778279410038923f,
                                       0.01f, 0.005623413251903491f, 0.0031622776601683794f, 0.0017782794100389228f, 0.001f, 0.0005623413251903491f, 0.00031622776601683794f, 0.00017782794100389227f};
__device__ __forceinline__ void sincos_d(double a, double& s, double& c) {
    const double k = rint(a * 0.63661977236758134308);
    double r = fma(-k, 1.57079632679489655800e+00, a);
    r = fma(-k, 6.12323399573676603587e-17, r);
    const double r2 = r * r;
    double sp = -7.6471637318198164759e-13;
    sp = fma(sp, r2, 1.6059043836821614599e-10);
    sp = fma(sp, r2, -2.5052108385441718775e-08);
    sp = fma(sp, r2, 2.7557319223985890653e-06);
    sp = fma(sp, r2, -1.9841269841269841270e-04);
    sp = fma(sp, r2, 8.3333333333333333333e-03);
    sp = fma(sp, r2, -1.6666666666666666667e-01);
    const double sr = fma(sp * r2, r, r);
    double cp = 4.7794773323873852974e-14;
    cp = fma(cp, r2, -1.1470745597729724714e-11);
    cp = fma(cp, r2, 2.0876756987868098979e-09);
    cp = fma(cp, r2, -2.7557319223985890653e-07);
    cp = fma(cp, r2, 2.4801587301587301587e-05);
    cp = fma(cp, r2, -1.3888888888888888889e-03);
    cp = fma(cp, r2, 4.1666666666666666667e-02);
    cp = fma(cp, r2, -0.5);
    const double cr = fma(cp, r2, 1.0);
    const int q = ((int)k) & 3;
    s = (q == 0) ? sr : (q == 1) ? cr : (q == 2) ? -sr : -cr;
    c = (q == 0) ? cr : (q == 1) ? -sr : (q == 2) ? -cr : sr;
}

__device__ __forceinline__ void transpose_items(const float* __restrict__ W, int K, int N, bf16_t* __restrict__ WT, int mode, int nbatch, size_t src_stride, size_t dst_stride, float* scr, int gw, int NGW, int lane) {
    const int nblk = N / 32, per = (K / 64) * nblk, nitems = per * nbatch;
    for (int it = gw; it < nitems; it += NGW) {
        const int bt = it / per, item = it - bt * per;
        const float* Wb = W + (size_t)bt * src_stride; bf16_t* WTb = WT + (size_t)bt * dst_stride;
        const int kb = item / nblk, nb = item - kb * nblk, k0 = 64 * kb, n0 = 32 * nb;
#pragma unroll 8
        for (int i = 0; i < 32; ++i) { const int kk = 2 * i + (lane >> 5); scr[kk * 33 + (lane & 31)] = Wb[(size_t)(k0 + kk) * N + n0 + (lane & 31)]; }
        asm volatile("s_waitcnt lgkmcnt(0)" ::: "memory");
        const int rbase = (mode == 0) ? n0 : ((n0 >> 7) * 256 + (mode == 2 ? 128 : 0) + (n0 & 127));
        const int cch = lane & 7;
#pragma unroll
        for (int j = 0; j < 4; ++j) { const int n = (lane >> 3) + 8 * j; const float* s = scr + (8 * cch) * 33 + n;
            u32x4 o; o.x = pk2(s[0 * 33], s[1 * 33]); o.y = pk2(s[2 * 33], s[3 * 33]); o.z = pk2(s[4 * 33], s[5 * 33]); o.w = pk2(s[6 * 33], s[7 * 33]);
            *(u32x4*)(WTb + (size_t)(rbase + n) * K + k0 + 8 * cch) = o; }
        asm volatile("s_waitcnt lgkmcnt(0)" ::: "memory");
    }
}
__device__ __forceinline__ void moe_weight_copies(const float* gate, const float* up, const float* down, bf16_t* WGU, bf16_t* WD, float* scr, int gw, int NGW, int lane) {
    transpose_items(gate, D, DE, WGU, 1, NE, (size_t)D * DE, (size_t)1024 * D, scr, gw, NGW, lane);
    transpose_items(up, D, DE, WGU, 2, NE, (size_t)D * DE, (size_t)1024 * D, scr, gw, NGW, lane);
    transpose_items(down, DE, D, WD, 0, NE, (size_t)DE * D, (size_t)D * DE, scr, gw, NGW, lane);
}
struct ProArgs { const float *c, *c_ctx, *w_mod, *b_mod, *hgrn_lb, *qg, *kg, *w_in, *w_out, *pool_w, *gate, *up, *down; float *MODV, *LBF, *REF, *COS, *SIN; bf16_t *WIN, *WOUT, *POOLWT, *WGU, *WD; };
__device__ __forceinline__ void prologue_phase(unsigned char* lds, const ProArgs& a, int cu, int G) {
    const int tid = otid(), lane = tid & 63, wave = tid >> 6;
    for (int gid = cu * 512 + tid; gid < SEQ * 32; gid += G * 512) {
        const int t = gid >> 5, j = gid & 31;
        const float pos = (float)(j < 16 ? (t >> 6) : (t & 63));
        const float ang = pos * ROPE_INV[j & 15];
        double s, c; sincos_d((double)ang, s, c);
        a.COS[gid] = (float)c; a.SIN[gid] = (float)s;
    }
    if (cu == 0) {
        for (int gid = tid; gid < 1024; gid += 512) {
            const int l = gid >> 9, r = gid & 511; float v = 0.f;
            if (l == 1) v = 1.f / (1.f + expf(a.hgrn_lb[r] - a.hgrn_lb[512 + r]));
            a.LBF[gid] = fmaxf(v, 1e-30f); }
        if (tid < DEPTH) {
            float mq = 0.f, mk = 0.f;
            for (int i = 0; i < 64; ++i) { mq = fmaxf(mq, fabsf(a.qg[tid * 64 + i])); mk = fmaxf(mk, fabsf(a.kg[tid * 64 + i])); }
            a.REF[tid * 64] = -(64.f * C2 * mq * mk * 1.02f + 0.5f); }
    }
    {
        float* act = (float*)lds;
        float* part = (float*)(lds + 12288);
        for (int item = cu; item < 2 * 96; item += G) {
            const int l = item / 96, n0 = (item - l * 96) * 64;
            for (int i = tid; i < 3072; i += 512) { const int r = i >> 10, k = i & 1023; const float v = r < 2 ? a.c[r * 1024 + k] : a.c_ctx[k]; act[i] = silu(v); }
            __syncthreads();
            const float* w = a.w_mod + ((size_t)l * 1024 + (size_t)wave * 128) * 6144 + n0 + lane;
            float a0 = 0.f, a1 = 0.f, a2 = 0.f;
#pragma unroll 8
            for (int k = 0; k < 128; ++k) { const float wv = w[(size_t)k * 6144]; const int kk = wave * 128 + k; a0 += act[kk] * wv; a1 += act[1024 + kk] * wv; a2 += act[2048 + kk] * wv; }
            part[(wave * 3 + 0) * 64 + lane] = a0; part[(wave * 3 + 1) * 64 + lane] = a1; part[(wave * 3 + 2) * 64 + lane] = a2;
            __syncthreads();
            if (tid < 192) { const int r = tid >> 6, nn = tid & 63; float s = 0.f;
#pragma unroll
                for (int q = 0; q < 8; ++q) s += part[(q * 3 + r) * 64 + nn];
                a.MODV[(l * 3 + r) * 6144 + n0 + nn] = s + a.b_mod[l * 6144 + n0 + nn]; }
            __syncthreads();
        }
    }
    {
        float* scr = (float*)(lds + 16384) + wave * (64 * 33);
        const int gw = cu * 8 + wave, NGW = G * 8;
        transpose_items(a.w_in, D, NIN, a.WIN, 0, DEPTH, (size_t)D * NIN, (size_t)NIN * D, scr, gw, NGW, lane);
        transpose_items(a.w_out, D, D, a.WOUT, 0, DEPTH, (size_t)D * D, (size_t)D * D, scr, gw, NGW, lane);
        transpose_items(a.pool_w, 64, 64, a.POOLWT, 0, DEPTH * 4, (size_t)64 * 64, (size_t)64 * 64, scr, gw, NGW, lane);
        moe_weight_copies(a.gate, a.up, a.down, a.WGU, a.WD, scr, gw, NGW, lane);
    }
    __syncthreads();
}

namespace pool {
typedef float f32x16 __attribute__((ext_vector_type(16)));
typedef short bf16x8 __attribute__((ext_vector_type(8)));
constexpr int P = 72, O_X = 0  , O_DM = 81920  , O_OUT = 0  , OP = 264;
__device__ __forceinline__ int crow(int r, int hi) { return (r & 3) + 8 * (r >> 2) + 4 * hi; }
__device__ __forceinline__ void pool_phase(unsigned char* lds, const bf16_t* __restrict__ PROJ, const bf16_t* __restrict__ WT  , const float* __restrict__ pscale, bf16_t* __restrict__ MIX, int cu, int G) {
    const int tid = otid(), lane = tid & 63, r32 = lane & 31, hi = lane >> 5, w = __builtin_amdgcn_readfirstlane(tid >> 6);
    float* X = (float*)(lds + O_X); bf16_t* OUT = (bf16_t*)(lds + O_OUT);
    for (int u = cu; u < MT / 64; u += G) {
        const int row0 = u * 64, b = row0 / PB, p0 = row0 - b * PB; const bool is_ctx = p0 < CTXL;
        const int seg0 = b * PB + (is_ctx ? 0 : CTXL), len = is_ctx ? CTXL : SEQ, t0 = is_ctx ? p0 : p0 - CTXL;
#pragma unroll
        for (int it = 0; it < 5; ++it) { const int piece = tid + it * 512, rr = piece >> 5, pc = piece & 31, t = t0 - 8 + rr;
            u32x4 v = {0u, 0u, 0u, 0u};
            if (t >= 0 && t < len) v = *(const u32x4*)(PROJ + (size_t)(seg0 + t) * NIN + C_BP + pc * 8);
            float* x = X + rr * 256 + pc * 8;
            *(f32x4*)x = (f32x4){bflo(v.x), bfhi(v.x), bflo(v.y), bfhi(v.y)}; *(f32x4*)(x + 4) = (f32x4){bflo(v.z), bfhi(v.z), bflo(v.w), bfhi(v.w)}; }
        __syncthreads();
        {
            const int c = tid & 255, th = tid >> 8, g = c >> 6, hw = 1 << g;
            bf16_t* dm = (bf16_t*)(lds + O_DM) + g * 64 * P + (c & 63);
            for (int tt = 0; tt < 32; ++tt) { const int t = th * 32 + tt, tg = t0 + t;
                int lo = tg - hw; if (lo < 0) lo = 0; int hi2 = tg + hw; if (hi2 > len) hi2 = len;
                float s = 0.f;
                for (int q = lo; q < hi2; ++q) s += X[(q - t0 + 8) * 256 + c];
                dm[t * P] = (bf16_t)f2bf(s / (float)(hi2 - lo) - X[(t + 8) * 256 + c]); }
        }
        __syncthreads();
        {
            const int g = w >> 1, tb = w & 1;
            const bf16_t* A = (const bf16_t*)(lds + O_DM) + g * 64 * P + (tb * 32 + r32) * P + hi * 8;
#pragma unroll
            for (int eb = 0; eb < 2; ++eb) {
                const bf16_t* Bp = WT + (size_t)g * 4096 + (eb * 32 + r32) * 64 + hi * 8;
                f32x16 acc = {};
#pragma unroll
                for (int ks = 0; ks < 4; ++ks) acc = __builtin_amdgcn_mfma_f32_32x32x16_bf16(*(const bf16x8*)(A + ks * 16), *(const bf16x8*)(Bp + ks * 16), acc, 0, 0, 0);
                const int e = g * 64 + eb * 32 + r32; const float sc = pscale[e];
#pragma unroll
                for (int r = 0; r < 16; ++r) OUT[(tb * 32 + crow(r, hi)) * OP + e] = (bf16_t)f2bf(acc[r] * sc);
            }
        }
        __syncthreads();
#pragma unroll
        for (int it = 0; it < 4; ++it) { const int piece = tid + it * 512, t = piece >> 5, pc = piece & 31;
            *(u32x4*)(MIX + (size_t)(row0 + t) * D + 256 + pc * 8) = *(const u32x4*)(OUT + t * OP + pc * 8); }
        __syncthreads();
    }
}
}

__device__ __forceinline__ void norm1_phase(int cu, int G, const float* __restrict__ lat, const float* __restrict__ cx, const float* __restrict__ g, const float* __restrict__ modv, int sh_off, bf16_t* __restrict__ XN) {
    const int lane = otid() & 63, gw = cu * 8 + (otid() >> 6), NGW = G * 8;
    for (int row0 = gw * 4; row0 < MT; row0 += NGW * 4) {
        bool is_ctx; const size_t off = stream_off(row0, is_ctx);
        const int r = is_ctx ? 2 : row0 / PB;
        const f32x4* xr = (const f32x4*)((is_ctx ? cx : lat) + off) + lane;
        f32x4 v[4][4]; float ss[4];
#pragma unroll
        for (int q = 0; q < 4; ++q) { ss[q] = 0.f;
#pragma unroll
            for (int j = 0; j < 4; ++j) v[q][j] = xr[q * 256 + 64 * j]; }
        const float* mv = modv + r * 6144 + sh_off;
        f32x4 gs[4], sh[4];
#pragma unroll
        for (int j = 0; j < 4; ++j) { const int col = 4 * lane + 256 * j; gs[j] = *(const f32x4*)(g + col) * (*(const f32x4*)(mv + 1024 + col) + 1.f); sh[j] = *(const f32x4*)(mv + col); }
#pragma unroll
        for (int q = 0; q < 4; ++q) {
#pragma unroll
            for (int j = 0; j < 4; ++j) ss[q] += (v[q][j].x * v[q][j].x + v[q][j].y * v[q][j].y) + (v[q][j].z * v[q][j].z + v[q][j].w * v[q][j].w);
            const float rstd = 1.f / sqrtf(wave_sum(ss[q]) * (1.f / D) + EPS);
#pragma unroll
            for (int j = 0; j < 4; ++j) { const f32x4 o = v[q][j] * rstd * gs[j] + sh[j];
                u32x2 w; w.x = pk2(o.x, o.y); w.y = pk2(o.z, o.w);
                *(u32x2*)(XN + (size_t)(row0 + q) * D + 4 * lane + 256 * j) = w; } }
    }
}

__device__ __forceinline__ void norm2_router_phase(int cu, int G, const float* __restrict__ lat, const float* __restrict__ cx, const float* __restrict__ g, const float* __restrict__ modv, int sh_off,
                                                      const float* __restrict__ router_w, const float* __restrict__ router_b, bf16_t* __restrict__ XN, unsigned* __restrict__ cnt, u32x4* __restrict__ LIST, int route_ctx) {
    const int lane = otid() & 63, gw = cu * 8 + (otid() >> 6), NGW = G * 8;
    for (int row = gw; row < MT; row += NGW) {
        bool is_ctx; const size_t off = stream_off(row, is_ctx);
        if (is_ctx && !route_ctx) continue;
        const int r = is_ctx ? 2 : row / PB;
        const f32x4* xr = (const f32x4*)((is_ctx ? cx : lat) + off) + lane;
        f32x4 v[4]; float ss = 0.f;
#pragma unroll
        for (int j = 0; j < 4; ++j) { v[j] = xr[64 * j]; ss += (v[j].x * v[j].x + v[j].y * v[j].y) + (v[j].z * v[j].z + v[j].w * v[j].w); }
        const float rstd = 1.f / sqrtf(wave_sum(ss) * (1.f / D) + EPS);
        const float* mv = modv + r * 6144 + sh_off;
        float lg[16];
#pragma unroll
        for (int e = 0; e < 16; ++e) lg[e] = 0.f;
#pragma unroll
        for (int j = 0; j < 4; ++j) { const int col = 4 * lane + 256 * j;
            const f32x4 gg = *(const f32x4*)(g + col), sh = *(const f32x4*)(mv + col), sc = *(const f32x4*)(mv + 1024 + col);
            const f32x4 o = v[j] * rstd * gg * (sc + 1.f) + sh;
            u32x2 w; w.x = pk2(o.x, o.y); w.y = pk2(o.z, o.w);
            *(u32x2*)(XN + (size_t)row * D + col) = w;
#pragma unroll
            for (int i = 0; i < 4; ++i) { const float ov = o[i]; const f32x4* rw = (const f32x4*)(router_w + (size_t)(col + i) * 16);
#pragma unroll
                for (int q = 0; q < 4; ++q) { const f32x4 w4 = rw[q]; lg[4 * q + 0] += ov * w4.x; lg[4 * q + 1] += ov * w4.y; lg[4 * q + 2] += ov * w4.z; lg[4 * q + 3] += ov * w4.w; }
                asm volatile("" ::: "memory"); } }
        float sc_[16], sel[16];
#pragma unroll
        for (int e = 0; e < 16; ++e) { lg[e] = wave_sum(lg[e]); sc_[e] = 1.f / (1.f + expf(-lg[e])); sel[e] = sc_[e] + router_b[e]; }
        float gs[4]; int gi1[4], gi2[4]; float gw1[4], gw2[4];
#pragma unroll
        for (int q = 0; q < 4; ++q) { float v1 = -INFINITY, v2 = -INFINITY; int i1 = 0, i2 = 0; float s1 = 0.f, s2 = 0.f;
#pragma unroll
            for (int k = 0; k < 4; ++k) { const float x = sel[4 * q + k], sx = sc_[4 * q + k];
                if (x > v1) { v2 = v1; i2 = i1; s2 = s1; v1 = x; i1 = 4 * q + k; s1 = sx; } else if (x > v2) { v2 = x; i2 = 4 * q + k; s2 = sx; } }
            gs[q] = v1 + v2; gi1[q] = i1; gi2[q] = i2; gw1[q] = s1; gw2[q] = s2; }
        float bv = gs[0]; int e0 = gi1[0], e1 = gi2[0]; float w0 = gw1[0], w1 = gw2[0];
#pragma unroll
        for (int q = 1; q < 4; ++q) if (gs[q] > bv) { bv = gs[q]; e0 = gi1[q]; e1 = gi2[q]; w0 = gw1[q]; w1 = gw2[q]; }
        const float ws = w0 + w1; w0 /= ws; w1 /= ws;
        if (lane == 0) {
            const int gq = e0 >> 2; int a = e0 & 3, c = e1 & 3; float wa = w0, wc = w1;
            if (a > c) { const int ti = a; a = c; c = ti; const float tf = wa; wa = wc; wc = tf; }
            const int pi = (a == 0) ? (c - 1) : (a == 1 ? c + 1 : 5);
            const int bk = gq * 6 + pi;
            const unsigned slot = __hip_atomic_fetch_add(cnt + bk, 1u, __ATOMIC_RELAXED, __HIP_MEMORY_SCOPE_AGENT);
            u32x4 sv; sv.x = (unsigned)row; sv.y = __float_as_uint(wa); sv.z = __float_as_uint(wc); sv.w = 0u; LIST[(size_t)bk * MT + slot] = sv; }
    }
}

__device__ __forceinline__ void post_phase(int cu, int G, const bf16_t* __restrict__ PROJ, const float* __restrict__ qg, const float* __restrict__ kg, const float* __restrict__ COS, const float* __restrict__ SIN,
                                              bf16_t* __restrict__ QN, bf16_t* __restrict__ KN) {
    const int lane = otid() & 63, gw = cu * 8 + (otid() >> 6), NGW = G * 8;
    const int d0 = (lane & 7) * 8, jk = lane & 31;
    float qgv[8];
#pragma unroll
    for (int i = 0; i < 8; ++i) qgv[i] = qg[d0 + i];
    const float kg0 = kg[2 * jk], kg1 = kg[2 * jk + 1];
    for (int row0 = gw * 4; row0 < MT; row0 += NGW * 4) {
        const int b = row0 / PB, p0 = row0 - b * PB; const bool is_ctx = p0 < CTXL; const int t0 = is_ctx ? 0 : p0 - CTXL;
        u32x4 wq[4]; unsigned wk[4]; f32x4 cq[4], sq[4]; float ck[4], sk[4];
#pragma unroll
        for (int q = 0; q < 4; ++q) { const bf16_t* pr = PROJ + (size_t)(row0 + q) * NIN;
            wq[q] = *(const u32x4*)(pr + C_CQ + lane * 8); wk[q] = *(const unsigned*)(pr + C_CK + lane * 2);
            const int t = is_ctx ? 0 : t0 + q;
            cq[q] = *(const f32x4*)(COS + t * 32 + (d0 >> 1)); sq[q] = *(const f32x4*)(SIN + t * 32 + (d0 >> 1)); ck[q] = COS[t * 32 + jk]; sk[q] = SIN[t * 32 + jk]; }
#pragma unroll
        for (int q = 0; q < 4; ++q) {
            {
                const u32x4 w = wq[q];
                float x[8] = {bflo(w.x), bfhi(w.x), bflo(w.y), bfhi(w.y), bflo(w.z), bfhi(w.z), bflo(w.w), bfhi(w.w)};
                float ss = 0.f;
#pragma unroll
                for (int i = 0; i < 8; ++i) ss += x[i] * x[i];
                ss = xsum<1>(ss); ss = xsum<2>(ss); ss = xsum<4>(ss);
                const float rstd = 1.f / sqrtf(ss * (1.f / 64.f) + EPS);
#pragma unroll
                for (int i = 0; i < 8; ++i) x[i] = x[i] * rstd * qgv[i];
                if (!is_ctx) {
#pragma unroll
                    for (int i = 0; i < 4; ++i) { const float cs = cq[q][i], sn = sq[q][i];
                        const float x1 = x[2 * i], x2 = x[2 * i + 1]; x[2 * i] = x1 * cs - x2 * sn; x[2 * i + 1] = x1 * sn + x2 * cs; } }
                u32x4 o; o.x = pk2(x[0] * C2, x[1] * C2); o.y = pk2(x[2] * C2, x[3] * C2); o.z = pk2(x[4] * C2, x[5] * C2); o.w = pk2(x[6] * C2, x[7] * C2);
                *(u32x4*)(QN + (size_t)(row0 + q) * 512 + lane * 8) = o;
            }
            {
                float x1 = bflo(wk[q]), x2 = bfhi(wk[q]);
                float ss = x1 * x1 + x2 * x2;
                ss = xsum<1>(ss); ss = xsum<2>(ss); ss = xsum<4>(ss); ss = xsum<8>(ss); ss = xsum<16>(ss);
                const float rstd = 1.f / sqrtf(ss * (1.f / 64.f) + EPS);
                x1 = x1 * rstd * kg0; x2 = x2 * rstd * kg1;
                if (!is_ctx) { const float cs = ck[q], sn = sk[q]; const float a = x1 * cs - x2 * sn, c = x1 * sn + x2 * cs; x1 = a; x2 = c; }
                *(unsigned*)(KN + (size_t)(row0 + q) * 128 + lane * 2) = pk2(x1, x2);
            }
        }
    }
}

namespace hg {
typedef float f32x16 __attribute__((ext_vector_type(16)));
typedef short bf16x8 __attribute__((ext_vector_type(8)));
typedef short s16x4 __attribute__((ext_vector_type(4)));
typedef float f32x2 __attribute__((ext_vector_type(2)));
constexpr int P = 72;
constexpr int O_ZB = 0, O_ZQ = 32768, O_VT = 40960, O_QH = 50176, O_QT = 68608, O_KH = 87040, O_ST = 105472, O_SSQ = 123904, O_OUT = 0  , O_TOT = 0, LDS_BYTES = 124416;
constexpr int MSZ = 64 * P * 2;
constexpr int NCH = PB / 64;
__device__ __forceinline__ int crow(int r, int hi) { return (r & 3) + 8 * (r >> 2) + 4 * hi; }
__device__ __forceinline__ unsigned cvtpk(float lo, float hi) { typedef __bf16 b2 __attribute__((ext_vector_type(2))); f32x2 v = {lo, hi}; b2 b = __builtin_convertvector(v, b2); return __builtin_bit_cast(unsigned, b); }
__device__ __forceinline__ float clampe(float e) { return fminf(fmaxf(e, -80.f), 80.f); }

template <bool FULL> __device__ __forceinline__ void prep(unsigned char* lds, const bf16_t* __restrict__ PROJ, const float* __restrict__ LBFl, int row0, int h) {
    const int tid = otid();
    float* ZB = (float*)(lds + O_ZB); bf16_t* ZQ = (bf16_t*)(lds + O_ZQ); bf16_t* VT = (bf16_t*)(lds + O_VT);
    {
        const int t = tid >> 3, pc = tid & 7;
        const bf16_t* pr = PROJ + (size_t)(row0 + t) * NIN + h * 64 + pc * 8;
        const u32x4 wf = *(const u32x4*)(pr + C_AFF), wb = *(const u32x4*)(pr + C_AFB), wv = *(const u32x4*)(pr + C_AI);
        float* zf = ZB + t * 64 + pc * 8; float* zb = ZB + 4096 + t * 64 + pc * 8;
        *(f32x4*)zf = (f32x4){bflo(wf.x), bfhi(wf.x), bflo(wf.y), bfhi(wf.y)}; *(f32x4*)(zf + 4) = (f32x4){bflo(wf.z), bfhi(wf.z), bflo(wf.w), bfhi(wf.w)};
        *(f32x4*)zb = (f32x4){bflo(wb.x), bfhi(wb.x), bflo(wb.y), bfhi(wb.y)}; *(f32x4*)(zb + 4) = (f32x4){bflo(wb.z), bfhi(wb.z), bflo(wb.w), bfhi(wb.w)};
        bf16_t* vt = VT + (pc * 8) * P + t;
        vt[0 * P] = (bf16_t)(wv.x & 0xffffu); vt[1 * P] = (bf16_t)(wv.x >> 16); vt[2 * P] = (bf16_t)(wv.y & 0xffffu); vt[3 * P] = (bf16_t)(wv.y >> 16);
        vt[4 * P] = (bf16_t)(wv.z & 0xffffu); vt[5 * P] = (bf16_t)(wv.z >> 16); vt[6 * P] = (bf16_t)(wv.w & 0xffffu); vt[7 * P] = (bf16_t)(wv.w >> 16);
        if (FULL) { const u32x4 wq = *(const u32x4*)(pr + C_AQ); *(u32x4*)(ZQ + t * 64 + pc * 8) = wq; }
    }
    __syncthreads();
    if (tid < 128) {
        const int dir = tid >> 6, i = tid & 63;
        const float lbf = LBFl[dir * 256 + h * 64 + i], oml = 1.f - lbf;
        float* zb = ZB + dir * 4096 + i; float acc = 0.f;
        if (dir == 0) { for (int t = 0; t < 64; ++t) { const float z = zb[t * 64]; const float sg = 1.f / (1.f + __expf(-z)); acc += __logf(lbf + oml * sg); zb[t * 64] = acc; } }
        else { for (int t = 63; t >= 0; --t) { const float z = zb[t * 64]; const float sg = 1.f / (1.f + __expf(-z)); acc += __logf(lbf + oml * sg); zb[t * 64] = acc; } }
    }
    __syncthreads();
#pragma unroll
    for (int it = 0; it < 2; ++it) {
        const int item = tid + it * 512, dir = item >> 9, t = (item >> 3) & 63, i0 = (item & 7) * 8;
        const float* B = ZB + dir * 4096;
        const int tp = dir == 0 ? t - 1 : t + 1; const bool edge = dir == 0 ? (t == 0) : (t == 63);
        const int tref = dir == 0 ? 31 : 32;
        float bc[8], bp[8], br[8];
        { const f32x4 a = *(const f32x4*)(B + t * 64 + i0), c = *(const f32x4*)(B + t * 64 + i0 + 4); bc[0] = a.x; bc[1] = a.y; bc[2] = a.z; bc[3] = a.w; bc[4] = c.x; bc[5] = c.y; bc[6] = c.z; bc[7] = c.w; }
        { const int tq = edge ? t : tp; const f32x4 a = *(const f32x4*)(B + tq * 64 + i0), c = *(const f32x4*)(B + tq * 64 + i0 + 4);
          bp[0] = a.x; bp[1] = a.y; bp[2] = a.z; bp[3] = a.w; bp[4] = c.x; bp[5] = c.y; bp[6] = c.z; bp[7] = c.w;
          if (edge) {
#pragma unroll
              for (int k = 0; k < 8; ++k) bp[k] = 0.f; } }
        { const f32x4 a = *(const f32x4*)(B + tref * 64 + i0), c = *(const f32x4*)(B + tref * 64 + i0 + 4); br[0] = a.x; br[1] = a.y; br[2] = a.z; br[3] = a.w; br[4] = c.x; br[5] = c.y; br[6] = c.z; br[7] = c.w; }
        float kh[8];
#pragma unroll
        for (int k = 0; k < 8; ++k) { const float kk = 1.f - __expf(bc[k] - bp[k]); kh[k] = kk * __expf(clampe(br[k] - bc[k])); }
        if (!FULL) {
            bf16_t* kt = (bf16_t*)(lds + O_KH + dir * MSZ) + i0 * P + t;
#pragma unroll
            for (int k = 0; k < 8; ++k) kt[k * P] = (bf16_t)f2bf(kh[k]);
        } else {
            u32x4 w; w.x = cvtpk(kh[0], kh[1]); w.y = cvtpk(kh[2], kh[3]); w.z = cvtpk(kh[4], kh[5]); w.w = cvtpk(kh[6], kh[7]);
            *(u32x4*)((bf16_t*)(lds + O_KH + dir * MSZ) + t * P + i0) = w;
            const u32x4 wq = *(const u32x4*)(ZQ + t * 64 + i0);
            float q[8] = {silu(bflo(wq.x)), silu(bfhi(wq.x)), silu(bflo(wq.y)), silu(bfhi(wq.y)), silu(bflo(wq.z)), silu(bfhi(wq.z)), silu(bflo(wq.w)), silu(bfhi(wq.w))};
            float qh[8], qt[8];
#pragma unroll
            for (int k = 0; k < 8; ++k) { qh[k] = q[k] * __expf(clampe(bc[k] - br[k])); qt[k] = q[k] * __expf(bc[k]); }
            w.x = cvtpk(qh[0], qh[1]); w.y = cvtpk(qh[2], qh[3]); w.z = cvtpk(qh[4], qh[5]); w.w = cvtpk(qh[6], qh[7]);
            *(u32x4*)((bf16_t*)(lds + O_QH + dir * MSZ) + t * P + i0) = w;
            w.x = cvtpk(qt[0], qt[1]); w.y = cvtpk(qt[2], qt[3]); w.z = cvtpk(qt[4], qt[5]); w.w = cvtpk(qt[6], qt[7]);
            *(u32x4*)((bf16_t*)(lds + O_QT + dir * MSZ) + t * P + i0) = w;
        }
    }
    __syncthreads();
}

__device__ __forceinline__ void h1_phase(unsigned char* lds, const bf16_t* __restrict__ PROJ, const float* __restrict__ LBFl, bf16_t* __restrict__ UT, float* __restrict__ DEC, int cu, int G) {
    const int tid = otid(), lane = tid & 63, r32 = lane & 31, hi = lane >> 5, w = __builtin_amdgcn_readfirstlane(tid >> 6);
    for (int u = cu; u < BATCH * NCH * 4; u += G) {
        const int h = u & 3, bc = u >> 2, b = bc / NCH, cp = bc - b * NCH, row0 = b * PB + cp * 64;
        prep<false>(lds, PROJ, LBFl, row0, h);
        const float* ZB = (const float*)(lds + O_ZB);
        {
            const int dir = w >> 2, jb = (w >> 1) & 1, ib = w & 1;
            const bf16_t* VT = (const bf16_t*)(lds + O_VT) + (jb * 32 + r32) * P + hi * 8;
            const bf16_t* KT = (const bf16_t*)(lds + O_KH + dir * MSZ) + (ib * 32 + r32) * P + hi * 8;
            f32x16 acc = {};
#pragma unroll
            for (int ks = 0; ks < 4; ++ks) acc = __builtin_amdgcn_mfma_f32_32x32x16_bf16(*(const bf16x8*)(VT + ks * 16), *(const bf16x8*)(KT + ks * 16), acc, 0, 0, 0);
            const int i = ib * 32 + r32;
            const float btot = ZB[dir * 4096 + (dir == 0 ? 63 : 0) * 64 + i], bref = ZB[dir * 4096 + (dir == 0 ? 31 : 32) * 64 + i];
            const float sc = __expf(btot - bref);
            const int chain = (b * 4 + h) * 2 + dir;
            bf16_t* ut = UT + ((size_t)chain * NCH + cp) * 4096 + i;
#pragma unroll
            for (int r = 0; r < 16; ++r) ut[(jb * 32 + crow(r, hi)) * 64] = (bf16_t)f2bf(acc[r] * sc);
        }
        if (tid < 128) { const int dir = tid >> 6, i = tid & 63; const int chain = (b * 4 + h) * 2 + dir;
            DEC[((size_t)chain * NCH + cp) * 64 + i] = __expf(ZB[dir * 4096 + (dir == 0 ? 63 : 0) * 64 + i]); }
        __syncthreads();
    }
}

__device__ __forceinline__ void h2_phase(unsigned char* lds, const bf16_t* __restrict__ UT, const float* __restrict__ DEC, bf16_t* __restrict__ ST, int cu, int G) {
    const int tid = otid(), seg = tid >> 7, e = tid & 127, jl = e >> 5, i = (e & 31) * 2;
    f32x4* TOT = (f32x4*)(lds + O_TOT);
    for (int task = cu; task < 256; task += G) {
        const int chain = task >> 4, j = (task & 15) * 4 + jl, dir = chain & 1;
        const size_t cbase = (size_t)chain * NCH;
        float S0 = 0.f, S1 = 0.f, P0 = 1.f, P1 = 1.f;
#pragma unroll 11
        for (int kk = 0; kk < 33; ++kk) { const int k = seg * 33 + kk, cp = dir == 0 ? k : (k < 4 ? 3 - k : 135 - k);
            const unsigned u = *(const unsigned*)(UT + (cbase + cp) * 4096 + j * 64 + i); const f32x2 d = *(const f32x2*)(DEC + (cbase + cp) * 64 + i);
            S0 = d.x * S0 + bflo(u); S1 = d.y * S1 + bfhi(u); P0 *= d.x; P1 *= d.y; }
        TOT[seg * 128 + e] = (f32x4){S0, S1, P0, P1};
        __syncthreads();
        float s0 = 0.f, s1 = 0.f;
#pragma unroll
        for (int sp = 0; sp < 3; ++sp) if (sp < seg) { const f32x4 t = TOT[sp * 128 + e]; s0 = t.z * s0 + t.x; s1 = t.w * s1 + t.y; }
#pragma unroll 11
        for (int kk = 0; kk < 33; ++kk) { const int k = seg * 33 + kk, cp = dir == 0 ? k : (k < 4 ? 3 - k : 135 - k);
            const unsigned u = *(const unsigned*)(UT + (cbase + cp) * 4096 + j * 64 + i); const f32x2 d = *(const f32x2*)(DEC + (cbase + cp) * 64 + i);
            *(unsigned*)(ST + (cbase + cp) * 4096 + j * 64 + i) = pk2(s0, s1);
            s0 = d.x * s0 + bflo(u); s1 = d.y * s1 + bfhi(u); }
        __syncthreads();
    }
}

__device__ __forceinline__ void h3_phase(unsigned char* lds, const bf16_t* __restrict__ PROJ, const float* __restrict__ LBFl, const bf16_t* __restrict__ ST, const float* __restrict__ ng, bf16_t* __restrict__ MIX, int cu, int G) {
    const int tid = otid(), lane = tid & 63, r32 = lane & 31, hi = lane >> 5, w = __builtin_amdgcn_readfirstlane(tid >> 6);
    for (int u = cu; u < BATCH * NCH * 4; u += G) {
        const int h = u & 3, bc = u >> 2, b = bc / NCH, cp = bc - b * NCH, row0 = b * PB + cp * 64;
        {
            const int j = tid >> 3, ic = (tid & 7) * 8;
#pragma unroll
            for (int dir = 0; dir < 2; ++dir) { const int chain = (b * 4 + h) * 2 + dir;
                const u32x4 sv = *(const u32x4*)(ST + ((size_t)chain * NCH + cp) * 4096 + j * 64 + ic);
                *(u32x4*)((bf16_t*)(lds + O_ST + dir * MSZ) + j * P + ic) = sv; }
        }
        prep<true>(lds, PROJ, LBFl, row0, h);
        float* SSQ = (float*)(lds + O_SSQ); bf16_t* OUT = (bf16_t*)(lds + O_OUT);
        f32x16 ot = {};
        const int jb = (w >> 1) & 1, tb = w & 1;
        if (w < 4) {
            const bf16_t* VT = (const bf16_t*)(lds + O_VT) + (jb * 32 + r32) * P;
#pragma unroll
            for (int sb = 0; sb < 2; ++sb) {
                f32x16 xf = {}, xb = {};
                const bf16_t* QF = (const bf16_t*)(lds + O_QH) + (tb * 32 + r32) * P + hi * 8; const bf16_t* QB = QF + 64 * P;
                const bf16_t* KF = (const bf16_t*)(lds + O_KH) + (sb * 32 + r32) * P + hi * 8; const bf16_t* KB = KF + 64 * P;
                if (sb <= tb) {
#pragma unroll
                    for (int ks = 0; ks < 4; ++ks) xf = __builtin_amdgcn_mfma_f32_32x32x16_bf16(*(const bf16x8*)(KF + ks * 16), *(const bf16x8*)(QF + ks * 16), xf, 0, 0, 0); }
                if (sb >= tb) {
#pragma unroll
                    for (int ks = 0; ks < 4; ++ks) xb = __builtin_amdgcn_mfma_f32_32x32x16_bf16(*(const bf16x8*)(KB + ks * 16), *(const bf16x8*)(QB + ks * 16), xb, 0, 0, 0); }
                float x[16];
#pragma unroll
                for (int r = 0; r < 16; ++r) { const int s = crow(r, hi), t = r32;
                    const float vf = (sb < tb || (sb == tb && s <= t)) ? xf[r] : 0.f, vb = (sb > tb || (sb == tb && s >= t)) ? xb[r] : 0.f; x[r] = vf + vb; }
#pragma unroll
                for (int sp = 0; sp < 2; ++sp) {
                    u32x4 xw; xw.x = cvtpk(x[8 * sp + 0], x[8 * sp + 1]); xw.y = cvtpk(x[8 * sp + 2], x[8 * sp + 3]); xw.z = cvtpk(x[8 * sp + 4], x[8 * sp + 5]); xw.w = cvtpk(x[8 * sp + 6], x[8 * sp + 7]);
                    const s16x4 v0 = *(const s16x4*)(VT + sb * 32 + 16 * sp + 4 * hi), v1 = *(const s16x4*)(VT + sb * 32 + 16 * sp + 8 + 4 * hi);
                    const bf16x8 va = {v0[0], v0[1], v0[2], v0[3], v1[0], v1[1], v1[2], v1[3]};
                    ot = __builtin_amdgcn_mfma_f32_32x32x16_bf16(va, __builtin_bit_cast(bf16x8, xw), ot, 0, 0, 0); }
            }
#pragma unroll
            for (int dir = 0; dir < 2; ++dir) {
                const bf16_t* SA = (const bf16_t*)(lds + O_ST + dir * MSZ) + (jb * 32 + r32) * P + hi * 8; const bf16_t* QT = (const bf16_t*)(lds + O_QT + dir * MSZ) + (tb * 32 + r32) * P + hi * 8;
#pragma unroll
                for (int ks = 0; ks < 4; ++ks) ot = __builtin_amdgcn_mfma_f32_32x32x16_bf16(*(const bf16x8*)(SA + ks * 16), *(const bf16x8*)(QT + ks * 16), ot, 0, 0, 0); }
            float part = 0.f;
#pragma unroll
            for (int r = 0; r < 16; ++r) part += ot[r] * ot[r];
            part = xsum<32>(part);
            if (hi == 0) SSQ[jb * 64 + tb * 32 + r32] = part;
        }
        __syncthreads();
        if (w < 4) { const int t = tb * 32 + r32; const float rstd = 1.f / sqrtf((SSQ[t] + SSQ[64 + t]) * (1.f / 64.f) + EPS);
#pragma unroll
            for (int r = 0; r < 16; ++r) { const int j = jb * 32 + crow(r, hi); OUT[t * P + j] = (bf16_t)f2bf(ot[r] * rstd * ng[j]); } }
        __syncthreads();
        {
            const int t = tid >> 3, jc = (tid & 7) * 8;
            const u32x4 y = *(const u32x4*)(OUT + t * P + jc); const u32x4 g = *(const u32x4*)(PROJ + (size_t)(row0 + t) * NIN + C_AG + h * 64 + jc);
            u32x4 o; o.x = pk2(bflo(y.x) * silu(bflo(g.x)), bfhi(y.x) * silu(bfhi(g.x))); o.y = pk2(bflo(y.y) * silu(bflo(g.y)), bfhi(y.y) * silu(bfhi(g.y)));
            o.z = pk2(bflo(y.z) * silu(bflo(g.z)), bfhi(y.z) * silu(bfhi(g.z))); o.w = pk2(bflo(y.w) * silu(bflo(g.w)), bfhi(y.w) * silu(bfhi(g.w)));
            *(u32x4*)(MIX + (size_t)(row0 + t) * D + h * 64 + jc) = o;
        }
        __syncthreads();
    }
}
}
__device__ __forceinline__ int vcu_of(int bx, int G) { return (G % 8 == 0) ? (bx % 8) * (G / 8) + bx / 8 : bx; }
__device__ __forceinline__ void attn_phase(char* lds, const bf16_t* QN, const bf16_t* KN, const bf16_t* PROJ, bf16_t* MIX, float neg_ref, int vcu, int G, bool with_ctx) {
    using attn_body::bf16;
    const int upc = (512 + G - 1) / G;
    const int nun = upc + ((with_ctx && vcu < 16) ? 1 : 0);
    for (int i = 0; i < nun; ++i) {
        int b, h, nt; size_t q0;
        if (i < upc) { const int u = vcu * upc + i; if (u >= 512) continue; const int combo = u >> 7; b = combo >> 1; h = (combo & 1) * 4 + ((u >> 5) & 3); q0 = (size_t)b * PB + CTXL + (size_t)(u & 31) * 256; nt = PB / 64; }
        else { b = vcu >> 3; h = vcu & 7; q0 = (size_t)b * PB; nt = CTXL / 64; }
        const int kvh = h >> 2; const size_t k0 = (size_t)b * PB;
        attn_body::attn_unit((const bf16*)QN + q0 * 512 + h * 64, (const bf16*)KN + k0 * 128 + kvh * 64, (const bf16*)PROJ + k0 * NIN + C_CV + kvh * 64, (bf16*)MIX + q0 * 1024 + 512 + h * 64, nt, neg_ref, lds);
    }
}
namespace pg8 {
struct EpiResid {
    static constexpr bool PERM = false, AFTER_DRAIN = false;
    const float* src_lat; const float* src_ctx; float* dst_lat; float* dst_ctx; const float* modv; int ga_off; int pad;
    __device__ __forceinline__ void operator()(const f32x4 (&acc)[2][2][4][2], const Unit& u, int wr, int wc, int fr, int fq) const {
        asm volatile("" : "+v"(fr), "+v"(fq));
        const int b = u.pm / TPB, w = u.pm - b * TPB;
        const size_t base = (w == 0) ? (size_t)b * CTXL * D : ((size_t)b * SEQ + (size_t)(w - 1) * 256) * D;
        const float* s = ((w == 0) ? src_ctx : src_lat) + base; float* d = ((w == 0) ? dst_ctx : dst_lat) + base;
        const float* ga = modv + ((w == 0) ? 2 : b) * 6144 + ga_off;
        const int row0 = wr * 64 + fr, col0 = u.pn * BM + wc * 32 + 4 * fq;
        f32x4 gv[2][2];
#pragma unroll
        for (int bj = 0; bj < 2; ++bj)
#pragma unroll
            for (int n = 0; n < 2; ++n) gv[bj][n] = *(const f32x4*)(ga + col0 + bj * HALF + n * 16);
#pragma unroll
        for (int ai = 0; ai < 2; ++ai)
#pragma unroll
            for (int m = 0; m < 4; ++m) { const size_t off = (size_t)(row0 + ai * HALF + m * 16) * D + col0;
#pragma unroll
                for (int bj = 0; bj < 2; ++bj)
#pragma unroll
                    for (int n = 0; n < 2; ++n) *(f32x4*)(d + off + bj * HALF + n * 16) = *(const f32x4*)(s + off + bj * HALF + n * 16) + gv[bj][n] * acc[ai][bj][m][n]; }
    }
};
}


namespace pg8 {
struct MUnit { int pm, pn, nrows, lbase, e0, e1; };
__device__ __forceinline__ void build_tiles(PG8_LAS int* TT, const unsigned* cnt) {
    if (otid() == 0) { int off = 0;
        for (int bk = 0; bk < 24; ++bk) { const int c = (int)__hip_atomic_load(cnt + bk, __ATOMIC_RELAXED, __HIP_MEMORY_SCOPE_AGENT); const int nb = (c + 255) >> 8;
            for (int ti = 0; ti < nb; ++ti) { const int rem = c - ti * 256; TT[4 + 4 * off + 0] = bk; TT[4 + 4 * off + 1] = ti; TT[4 + 4 * off + 2] = rem < 256 ? rem : 256; TT[4 + 4 * off + 3] = 0; ++off; } }
        TT[0] = off; }
    __syncthreads();
}
template <int NPN  > struct MoeOrder {
    const PG8_LAS int* TT; int G, c;
    __device__ __forceinline__ bool next(int i, MUnit& u) const {
        const int L = i * G + c, tile = L / NPN; if (tile >= TT[0]) return false;
        const int bk = TT[4 + 4 * tile], ti = TT[4 + 4 * tile + 1];
        u.pm = tile; u.pn = L - tile * NPN; u.nrows = TT[4 + 4 * tile + 2]; u.lbase = bk * MT + ti * 256;
        const int g = bk / 6, pi = bk - g * 6; const int lo = pi < 3 ? 0 : (pi < 5 ? 1 : 2), hi = pi < 3 ? pi + 1 : (pi < 5 ? pi - 1 : 3);
        u.e0 = 4 * g + lo; u.e1 = 4 * g + hi; return true;
    }
};
struct Src1 {
    const bf16_t* XN; const bf16_t* WGU; const u32x4* LIST;
    __device__ __forceinline__ const char* a_base(const MUnit&) const { return (const char*)XN; }
    __device__ __forceinline__ void a_offsets(const MUnit& u, const int (&RA)[2], const int (&CA)[2], unsigned (&ao)[2][2]) const {
#pragma unroll
        for (int h = 0; h < 2; ++h)
#pragma unroll
            for (int i = 0; i < 2; ++i) { const int r = h * HALF + RA[i]; const unsigned row = r < u.nrows ? LIST[u.lbase + r].x : 0u; ao[h][i] = (row * (unsigned)D + (unsigned)CA[i]) * 2u; }
    }
    __device__ __forceinline__ const char* b_base(const MUnit& u, int seg) const { const int e = (u.pn >> 2) ? u.e1 : u.e0;
        return (const char*)(WGU + ((size_t)e * 1024 + (size_t)(u.pn & 3) * 256) * D) + (seg ? (size_t)(D / 2) * 2 : 0); }
    __device__ __forceinline__ void prefetch_rows(const MUnit& u, const int (&)[2], PG8_LAS unsigned char* rows, int wid) const {
        int t2 = otid(); asm volatile("" : "+v"(t2));
        int RA[2];
#pragma unroll
        for (int i = 0; i < 2; ++i) { int R, C; stage_rc(t2 * 16 + i * 8192, R, C); RA[i] = R; }
#pragma unroll
        for (int h = 0; h < 2; ++h)
#pragma unroll
            for (int i = 0; i < 2; ++i) { const int r = h * HALF + RA[i];
                __builtin_amdgcn_global_load_lds((const unsigned*)&LIST[u.lbase + r], (PG8_LAS unsigned*)(rows + ((h * 2 + i) * 8 + wid) * 256), 4, 0, 0); }
    }
    __device__ __forceinline__ void reload_offsets(const MUnit& u, const int (&)[2], const int (&)[2], const PG8_LAS unsigned char* rows, int wid, int lane, unsigned (&ao)[2][2]) const {
        int t2 = otid(); asm volatile("" : "+v"(t2));
        int RA[2], CA[2];
#pragma unroll
        for (int i = 0; i < 2; ++i) { int R, C; stage_rc(t2 * 16 + i * 8192, R, C); RA[i] = R; CA[i] = C; }
#pragma unroll
        for (int h = 0; h < 2; ++h)
#pragma unroll
            for (int i = 0; i < 2; ++i) { const int r = h * HALF + RA[i]; const unsigned v = *(const PG8_LAS unsigned*)(rows + ((h * 2 + i) * 8 + wid) * 256 + lane * 4);
                const unsigned row = r < u.nrows ? v : 0u; ao[h][i] = (row * (unsigned)D + (unsigned)CA[i]) * 2u; }
    }
};
struct Src2 {
    const bf16_t* ACT2; const bf16_t* WD;
    __device__ __forceinline__ const char* a_base(const MUnit& u) const { return (const char*)(ACT2 + (size_t)u.pm * 256 * 1024); }
    __device__ __forceinline__ void a_offsets(const MUnit&, const int (&RA)[2], const int (&CA)[2], unsigned (&ao)[2][2]) const {
#pragma unroll
        for (int h = 0; h < 2; ++h)
#pragma unroll
            for (int i = 0; i < 2; ++i) ao[h][i] = (unsigned)((h * HALF + RA[i]) * 1024 + CA[i]) * 2u;
    }
    __device__ __forceinline__ const char* b_base(const MUnit& u, int seg) const { const int e = seg ? u.e1 : u.e0; return (const char*)(WD + ((size_t)e * 1024 + (size_t)u.pn * 256) * DE); }
    __device__ __forceinline__ void prefetch_rows(const MUnit&, const int (&)[2], PG8_LAS unsigned char*, int) const {}
    __device__ __forceinline__ void reload_offsets(const MUnit&, const int (&)[2], const int (&)[2], const PG8_LAS unsigned char*, int, int, unsigned (&)[2][2]) const {}
};
struct EpiGateUp2 {
    static constexpr bool PERM = true;
    bf16_t* ACT2; const u32x4* LIST;
    __device__ __forceinline__ void operator()(const f32x4 (&acc)[2][2][4][2], const MUnit& u, int wr, int wc, int fr, int fq) const {
        asm volatile("" : "+v"(fr), "+v"(fq));
        const int slot = u.pn >> 2, colA = slot * DE + (u.pn & 3) * HALF + wc * 32 + 8 * fq;
        const unsigned* lw = (const unsigned*)(LIST + u.lbase + wr * 64 + fr) + 1 + slot;
#pragma unroll
        for (int ai = 0; ai < 2; ++ai) {
            unsigned wv[4];
#pragma unroll
            for (int m = 0; m < 4; ++m) wv[m] = lw[(ai * HALF + m * 16) * 4];
#pragma unroll
            for (int m = 0; m < 4; ++m) { const int r = ai * HALF + wr * 64 + m * 16 + fr;
                const bool valid = r < u.nrows; const float cw = valid ? __uint_as_float(wv[m]) : 0.f;
                const f32x4 g0 = acc[ai][0][m][0], g1 = acc[ai][0][m][1], u0 = acc[ai][1][m][0], u1 = acc[ai][1][m][1];
                u32x4 w;
                w.x = cvt_pk_bf16(silu(g0[0]) * u0[0] * cw, silu(g0[1]) * u0[1] * cw); w.y = cvt_pk_bf16(silu(g0[2]) * u0[2] * cw, silu(g0[3]) * u0[3] * cw);
                w.z = cvt_pk_bf16(silu(g1[0]) * u1[0] * cw, silu(g1[1]) * u1[1] * cw); w.w = cvt_pk_bf16(silu(g1[2]) * u1[2] * cw, silu(g1[3]) * u1[3] * cw);
                if (!valid) w = (u32x4){0u, 0u, 0u, 0u};
                *(u32x4*)(ACT2 + ((size_t)u.pm * 256 + r) * 1024 + colA) = w; }
            asm volatile("" ::: "memory"); }
    }
};
struct EpiMoeOut {
    static constexpr bool PERM = false;
    float* lat; float* ctx; const float* modv; const u32x4* LIST;
    __device__ __forceinline__ void operator()(const f32x4 (&acc)[2][2][4][2], const MUnit& u, int wr, int wc, int fr, int fq) const {
        asm volatile("" : "+v"(fr), "+v"(fq));
        const int col0 = u.pn * BM + wc * 32 + 4 * fq;
        const unsigned* lw = (const unsigned*)(LIST + u.lbase + wr * 64 + fr);
        unsigned rv[2][4];
#pragma unroll
        for (int ai = 0; ai < 2; ++ai)
#pragma unroll
            for (int m = 0; m < 4; ++m) rv[ai][m] = lw[(ai * HALF + m * 16) * 4];
#pragma unroll
        for (int ai = 0; ai < 2; ++ai)
#pragma unroll
            for (int m = 0; m < 4; ++m) { const int r = ai * HALF + wr * 64 + m * 16 + fr;
                if (r < u.nrows) { const int row = (int)rv[ai][m]; bool is_ctx; const size_t off = stream_off(row, is_ctx);
                    float* d = (is_ctx ? ctx : lat) + off + col0; const float* ga = modv + (is_ctx ? 2 : row / PB) * 6144 + 5120 + col0;
#pragma unroll
                    for (int bj = 0; bj < 2; ++bj)
#pragma unroll
                        for (int n = 0; n < 2; ++n) { f32x4* p = (f32x4*)(d + bj * HALF + n * 16); *p = *p + *(const f32x4*)(ga + bj * HALF + n * 16) * acc[ai][bj][m][n]; } } }
    }
};

template <class Epi, class Sched, class Src>
__device__ __forceinline__ void gemm_phase_x(PG8_LAS unsigned char* lds, PG8_LAS unsigned char* rows, const Sched& S, const Src& X, const Epi& E, const int KB, const int nt) {
    const int tid = otid(), wid = __builtin_amdgcn_readfirstlane(tid >> 6), lane = tid & 63, wr = wid >> 2, wc = wid & 3, fr = lane & 15, fq = lane >> 4;
    int RA[2], CA[2]; unsigned voffB[2];
#pragma unroll
    for (int i = 0; i < 2; ++i) { int R, C; stage_rc(tid * 16 + i * 8192, R, C); const int Rb = Epi::PERM ? ((R & ~31) + perm32(R & 31)) : R; RA[i] = R; CA[i] = C; voffB[i] = (unsigned)(Rb * KB + C) * 2u; }
    const size_t kstep = (size_t)(BK * 2);
    const size_t hstepB = (size_t)HALF * KB * 2;
    const int half = nt >> 1;
    const unsigned ldsw = (unsigned)wid * 1024u;
    const int aoff = lds_byte(wr * 64 + fr, fq * 8), boff = lds_byte(wc * 32 + fr, fq * 8);
#define PG8_SA(b, h) (((b) * 2 + (h)) * HTB)
#define PG8_SB(b, h) ((4 + (b) * 2 + (h)) * HTB)
#define PG8_STAGE_B(bufoff, gbase) do { _Pragma("unroll") for (int _i = 0; _i < 2; ++_i) \
        __builtin_amdgcn_global_load_lds((const unsigned*)((const char*)(gbase) + voffB[_i]), (PG8_LAS unsigned*)(lds + (bufoff) + ldsw + _i * 8192), 16, 0, 0); } while (0)
#define PG8_STAGE_A(bufoff, gbase, o0, o1) do { \
        __builtin_amdgcn_global_load_lds((const unsigned*)((const char*)(gbase) + (o0)), (PG8_LAS unsigned*)(lds + (bufoff) + ldsw), 16, 0, 0); \
        __builtin_amdgcn_global_load_lds((const unsigned*)((const char*)(gbase) + (o1)), (PG8_LAS unsigned*)(lds + (bufoff) + ldsw + 8192), 16, 0, 0); } while (0)
#define PG8_LDA(dst, b, h) do { _Pragma("unroll") for (int m = 0; m < 4; ++m) _Pragma("unroll") for (int k = 0; k < 2; ++k) dst[m][k] = *(const PG8_LAS bf16x8*)(lds + PG8_SA(b, h) + aoff + m * 2048 + k * 1024); } while (0)
#define PG8_LDB(dst, b, h) do { _Pragma("unroll") for (int n = 0; n < 2; ++n) _Pragma("unroll") for (int k = 0; k < 2; ++k) dst[n][k] = *(const PG8_LAS bf16x8*)(lds + PG8_SB(b, h) + boff + n * 2048 + k * 1024); } while (0)
#define PG8_MMA(ai, bj, At, Bt) do { __builtin_amdgcn_s_setprio(1); _Pragma("unroll") for (int m = 0; m < 4; ++m) _Pragma("unroll") for (int n = 0; n < 2; ++n) _Pragma("unroll") for (int k = 0; k < 2; ++k) \
        acc[ai][bj][m][n] = __builtin_amdgcn_mfma_f32_16x16x32_bf16(Bt[n][k], At[m][k], acc[ai][bj][m][n], 0, 0, 0); __builtin_amdgcn_s_setprio(0); } while (0)
#define PG8_WAIT_V(n) asm volatile("s_waitcnt vmcnt(" #n ")" ::: "memory")
#define PG8_WAIT_L(n) asm volatile("s_waitcnt lgkmcnt(" #n ")" ::: "memory")
#define PG8_BAR __builtin_amdgcn_s_barrier()
#define PG8_SCHED __builtin_amdgcn_sched_barrier(0)
    MUnit cur, nxt; int ui = 0;
    if (!S.next(0, cur)) return;
    f32x4 acc[2][2][4][2];
#pragma unroll
    for (int a = 0; a < 2; ++a)
#pragma unroll
        for (int b = 0; b < 2; ++b)
#pragma unroll
            for (int m = 0; m < 4; ++m)
#pragma unroll
                for (int n = 0; n < 2; ++n) acc[a][b][m][n] = (f32x4){0.f, 0.f, 0.f, 0.f};
    bf16x8 At[4][2], B0[2][2], B1[2][2];
    unsigned aoc[2][2];
    X.a_offsets(cur, RA, CA, aoc);
    const char* cAb = X.a_base(cur); const char* cB0 = X.b_base(cur, 0); const char* cB1 = X.b_base(cur, 1);
    PG8_STAGE_B(PG8_SB(0, 0), cB0); PG8_STAGE_B(PG8_SB(0, 1), cB0 + hstepB); PG8_STAGE_A(PG8_SA(0, 0), cAb, aoc[0][0], aoc[0][1]); PG8_STAGE_A(PG8_SA(0, 1), cAb, aoc[1][0], aoc[1][1]);
    if (wr == 1) PG8_BAR;
    PG8_WAIT_V(2); PG8_BAR;
    PG8_STAGE_B(PG8_SB(1, 0), cB0 + kstep); PG8_STAGE_A(PG8_SA(1, 0), cAb + kstep, aoc[0][0], aoc[0][1]); PG8_STAGE_B(PG8_SB(1, 1), cB0 + hstepB + kstep);
    PG8_WAIT_V(6); PG8_BAR;
    for (;;) {
        const bool has_next = S.next(ui + 1, nxt);
        const char* nAb = cAb; const char* nB0 = cB0; const char* nB1 = cB1;
        if (has_next) { X.prefetch_rows(nxt, RA, rows, wid); nAb = X.a_base(nxt); nB0 = X.b_base(nxt, 0); nB1 = X.b_base(nxt, 1); }
        for (int t = 0; t < nt; t += 2) {
            const bool last = (t == nt - 2);
            const char* a1 = cAb + (size_t)(t + 1) * kstep;
            const int kt2 = t + 2;
            const char* b2 = last ? nB0 : (kt2 < half ? cB0 + (size_t)kt2 * kstep : cB1 + (size_t)(kt2 - half) * kstep);
            const char* a2 = last ? nAb : cAb + (size_t)kt2 * kstep;
            const char* a3 = a2 + kstep; const char* b3 = b2 + kstep;
            PG8_LDB(B0, 0, 0); PG8_LDB(B1, 0, 1); PG8_SCHED; PG8_LDA(At, 0, 0); PG8_STAGE_A(PG8_SA(1, 1), a1, aoc[1][0], aoc[1][1]);
            if (last && has_next) X.reload_offsets(nxt, RA, CA, rows, wid, lane, aoc);
            PG8_WAIT_V(8); PG8_WAIT_L(0); PG8_BAR; PG8_MMA(0, 0, At, B0); PG8_MMA(0, 1, At, B1); PG8_BAR; PG8_SCHED;
            PG8_LDA(At, 0, 1); PG8_STAGE_B(PG8_SB(0, 0), b2); PG8_STAGE_B(PG8_SB(0, 1), b2 + hstepB); PG8_STAGE_A(PG8_SA(0, 0), a2, aoc[0][0], aoc[0][1]);
            PG8_WAIT_V(8); PG8_WAIT_L(0); PG8_BAR; PG8_MMA(1, 0, At, B0); PG8_MMA(1, 1, At, B1); PG8_BAR; PG8_SCHED;
            PG8_LDB(B0, 1, 0); PG8_LDB(B1, 1, 1); PG8_SCHED; PG8_LDA(At, 1, 0); PG8_STAGE_A(PG8_SA(0, 1), a2, aoc[1][0], aoc[1][1]);
            PG8_WAIT_V(8); PG8_WAIT_L(0); PG8_BAR; PG8_MMA(0, 0, At, B0); PG8_MMA(0, 1, At, B1); PG8_BAR; PG8_SCHED;
            PG8_LDA(At, 1, 1); PG8_STAGE_B(PG8_SB(1, 0), b3); PG8_STAGE_B(PG8_SB(1, 1), b3 + hstepB); PG8_STAGE_A(PG8_SA(1, 0), a3, aoc[0][0], aoc[0][1]);
            PG8_WAIT_V(8); PG8_WAIT_L(0); PG8_BAR; PG8_MMA(1, 0, At, B0); PG8_MMA(1, 1, At, B1); PG8_BAR; PG8_SCHED;
        }
        if (wr == 0) PG8_BAR;
        E(acc, cur, wr, wc, fr, fq);
        if (!has_next) break;
#pragma unroll
        for (int a = 0; a < 2; ++a)
#pragma unroll
            for (int b = 0; b < 2; ++b)
#pragma unroll
                for (int m = 0; m < 4; ++m)
#pragma unroll
                    for (int n = 0; n < 2; ++n) acc[a][b][m][n] = (f32x4){0.f, 0.f, 0.f, 0.f};
        cur = nxt; cAb = nAb; cB0 = nB0; cB1 = nB1; ++ui;
        if (wr == 1) PG8_BAR;
    }
    PG8_WAIT_V(0);
    PG8_BAR;
#undef PG8_SA
#undef PG8_SB
#undef PG8_STAGE_A
#undef PG8_STAGE_B
#undef PG8_LDA
#undef PG8_LDB
#undef PG8_MMA
#undef PG8_WAIT_V
#undef PG8_WAIT_L
#undef PG8_BAR
#undef PG8_SCHED
}
}

constexpr int TT_OFF = 132096;
constexpr int ROWS_OFF = 134144;

#define LAS __attribute__((address_space(3)))
#define XB_TMO      128
#define XB_XCNT(j)  (256  + 64 * (j))
#define XB_XSUB(j)  (1280 + 64 * (j))
#define XB_XGEN(j)  (2304 + 64 * (j))
#define XB_TOP      3328
#define XB_TOPGEN   3392
#define XCD_BAR_WORDS 3456
#define XB_SPIN_CAP (1u << 18)

__device__ __forceinline__ unsigned xb_ld(unsigned* p)              { return __hip_atomic_load(p, __ATOMIC_RELAXED, __HIP_MEMORY_SCOPE_AGENT); }
__device__ __forceinline__ unsigned xb_add(unsigned* p, unsigned v) { return __hip_atomic_fetch_add(p, v, __ATOMIC_RELAXED, __HIP_MEMORY_SCOPE_AGENT); }
__device__ __forceinline__ unsigned xb_xcc_id() { return (unsigned)__builtin_amdgcn_s_getreg((3 << 11) | 20) & 0xFu; }
#define XB_SPIN(cond, bar) do { unsigned _sp = 0; while (cond) { __builtin_amdgcn_s_sleep(1); \
    if ((++_sp & 255u) == 0u) { if (xb_ld(&(bar)[XB_TMO])) break; if (_sp > XB_SPIN_CAP) { atomicAdd(&(bar)[XB_TMO], 1u); break; } } } } while (0)

struct XcdBarrier {
    unsigned* bar; unsigned x;
    volatile LAS unsigned* st;
};

__device__ __forceinline__ XcdBarrier xcd_barrier_post(unsigned* bar, volatile LAS unsigned* st) {
    XcdBarrier b; b.bar = bar; b.x = xb_xcc_id(); b.st = st;
    if (threadIdx.x == 0) (void)xb_add(&bar[XB_XCNT(b.x)], 1u);
    return b;
}
__device__ __forceinline__ void xcd_barrier_complete(unsigned* bar, unsigned x, unsigned& nloc, unsigned& nx) {
    const unsigned G = gridDim.x * gridDim.y * gridDim.z;
    unsigned sum, cnt, mine, sp = 0u;
    for (;;) {
        sum = 0u; cnt = 0u; mine = 0u;
#pragma unroll
        for (unsigned j = 0; j < 16; ++j) { const unsigned c = xb_ld(&bar[XB_XCNT(j)]); sum += c; cnt += (c > 0u) ? 1u : 0u; mine = (j == x) ? c : mine; }
        if (sum == G) break;
        __builtin_amdgcn_s_sleep(1);
        if ((++sp & 255u) == 0u) { if (xb_ld(&bar[XB_TMO])) break; if (sp > XB_SPIN_CAP) { atomicAdd(&bar[XB_TMO], 1u); break; } }
    }
    nloc = mine > 0u ? mine : 1u; nx = cnt > 0u ? cnt : 1u;
}

__device__ __forceinline__ void xcd_barrier(const XcdBarrier& b) {
    asm volatile("s_waitcnt vmcnt(0)" ::: "memory");
    __syncthreads();
    if (threadIdx.x == 0) {
        unsigned* bar = b.bar;
        __builtin_amdgcn_s_waitcnt(0);
        unsigned nloc = b.st[0], nx = b.st[1];
        if (nloc == 0u) { xcd_barrier_complete(bar, b.x, nloc, nx); b.st[0] = nloc; b.st[1] = nx; }
        const unsigned old = xb_add(&bar[XB_XSUB(b.x)], 1u);
        const unsigned gen = old / nloc;
        if (old + 1u == (gen + 1u) * nloc) {
            __builtin_amdgcn_fence(__ATOMIC_RELEASE, "agent");
            asm volatile("s_waitcnt vmcnt(0)" ::: "memory");
            const unsigned og = xb_add(&bar[XB_TOP], 1u);
            const unsigned tg = og / nx;
            if (og + 1u == (tg + 1u) * nx) xb_add(&bar[XB_TOPGEN], 1u);
            else XB_SPIN(xb_ld(&bar[XB_TOPGEN]) == tg, bar);
            __builtin_amdgcn_fence(__ATOMIC_ACQUIRE, "agent");
            xb_add(&bar[XB_XGEN(b.x)], 1u);
            asm volatile("s_waitcnt vmcnt(0)" ::: "memory");
        } else {
            XB_SPIN(xb_ld(&bar[XB_XGEN(b.x)]) == gen, bar);
            __builtin_amdgcn_fence(__ATOMIC_ACQUIRE, "agent");
            asm volatile("s_waitcnt vmcnt(0)" ::: "memory");
        }
    }
    __syncthreads();
}

constexpr int LDS_BYTES = 147456;
constexpr int LDSCTL_OFF = 131072, MISC_OFF = LDSCTL_OFF + 320;
constexpr int CW_BAR = 4096;
constexpr int NPHASE = 1 + 9 * DEPTH;
#ifndef MK_SPLIT
#define MK_SPLIT 0
#endif
struct Args {
    const float *x, *c, *ctx, *c_ctx, *w_mod, *b_mod, *norm1_g, *norm2_g, *w_in, *w_out, *hgrn_lb, *hgrn_norm_g, *pool_w, *pool_scale, *q_norm_g, *k_norm_g, *router_w, *router_b, *moe_gate, *moe_up, *moe_down;
    float* out; unsigned char* ws; int ph_lo, ph_hi;
};
typedef const __attribute__((address_space(4))) Args* KArgs;
__device__ __forceinline__ KArgs kargs() { KArgs p = (KArgs)__builtin_amdgcn_kernarg_segment_ptr(); asm volatile("" : "+s"(p)); return p; }
__global__ void __launch_bounds__(512, 2) mega_fwd(Args A_unused) {
    extern __shared__ __attribute__((aligned(16))) unsigned char lds[];
    for (int u = otid(); u < (LDS_BYTES - LDSCTL_OFF) / 4; u += 512) ((LAS unsigned*)((LAS unsigned char*)lds + LDSCTL_OFF))[u] = 0u;
    __syncthreads();
    XcdBarrier bar;
    { KArgs ap = kargs(); unsigned* CTL = (unsigned*)(ap->ws + WS_CTL); bar.bar = CTL + CW_BAR; bar.x = 0; bar.st = nullptr;
      if (!MK_SPLIT) bar = xcd_barrier_post(CTL + CW_BAR, (volatile LAS unsigned*)((LAS unsigned char*)lds + MISC_OFF) + 8); }
    int lo, hi; { KArgs ap = kargs(); lo = ap->ph_lo; hi = ap->ph_hi; }
#ifndef PHMASK
#define PHMASK 0x3ff
#endif
#define IN(k) (lo <= (k) && (k) < hi)
#define SEAM(k) do { if (!MK_SPLIT && IN((k) + 1)) xcd_barrier(bar); } while (0)
#define GCU const int G = (int)gridDim.x, cu = (int)blockIdx.x
#ifndef DUPMASK
#define DUPMASK 0
#endif
    LAS unsigned char* ldsl = (LAS unsigned char*)lds;
    if ((PHMASK & 0x200) && IN(0)) {
        _Pragma("unroll") for (int rep_ = 0; rep_ < ((((DUPMASK) & (0x200)) && true) ? 2 : 1); ++rep_) {
        KArgs ap = kargs(); unsigned char* ws = ap->ws; GCU;
        ProArgs pa; pa.c = ap->c; pa.c_ctx = ap->c_ctx; pa.w_mod = ap->w_mod; pa.b_mod = ap->b_mod; pa.hgrn_lb = ap->hgrn_lb; pa.qg = ap->q_norm_g; pa.kg = ap->k_norm_g; pa.w_in = ap->w_in; pa.w_out = ap->w_out; pa.pool_w = ap->pool_w;
        pa.gate = ap->moe_gate; pa.up = ap->moe_up; pa.down = ap->moe_down; pa.MODV = (float*)(ws + WS_MODV); pa.LBF = (float*)(ws + WS_LBF); pa.REF = (float*)(ws + WS_REF); pa.COS = (float*)(ws + WS_COS); pa.SIN = (float*)(ws + WS_SIN);
        pa.WIN = (bf16_t*)(ws + WS_WIN); pa.WOUT = (bf16_t*)(ws + WS_WOUT); pa.POOLWT = (bf16_t*)(ws + WS_POOLWT); pa.WGU = (bf16_t*)(ws + WS_WGU); pa.WD = (bf16_t*)(ws + WS_WD);
        prologue_phase(lds, pa, cu, G);
            if (rep_ + 1 < ((((DUPMASK) & (0x200)) && true) ? 2 : 1)) xcd_barrier(bar); }
        SEAM(0);
    }
    for (int l = 0; l < DEPTH; ++l) {
        const int pb = 1 + 9 * l;
        if ((PHMASK & 1) && IN(pb + 0)) {
        _Pragma("unroll") for (int rep_ = 0; rep_ < ((((DUPMASK) & (1)) && true) ? 2 : 1); ++rep_) {
            KArgs ap = kargs(); unsigned char* ws = ap->ws; GCU;
            const float* slat = (l == 0) ? ap->x : ap->out; const float* sctx = (l == 0) ? ap->ctx : (const float*)(ws + WS_XC);
            norm1_phase(cu, G, slat, sctx, ap->norm1_g + l * D, (const float*)(ws + WS_MODV) + (size_t)l * 3 * 6144, 0, (bf16_t*)(ws + WS_XN));
            if (l > 0) { const int tid = otid(); float* scr = (float*)(lds + 16384) + (tid >> 6) * (64 * 33);
                moe_weight_copies(ap->moe_gate + (size_t)l * NE * D * DE, ap->moe_up + (size_t)l * NE * D * DE, ap->moe_down + (size_t)l * NE * DE * D, (bf16_t*)(ws + WS_WGU), (bf16_t*)(ws + WS_WD), scr, cu * 8 + (tid >> 6), G * 8, tid & 63); }
            if (rep_ + 1 < ((((DUPMASK) & (1)) && true) ? 2 : 1)) xcd_barrier(bar); }
            SEAM(pb + 0);
        }
        if ((PHMASK & 2) && IN(pb + 1)) {
        _Pragma("unroll") for (int rep_ = 0; rep_ < ((((DUPMASK) & (2)) && true) ? 2 : 1); ++rep_) {
            KArgs ap = kargs(); unsigned char* ws = ap->ws; GCU;
            pg8::Gemm g; g.A = (const bf16_t*)(ws + WS_XN); g.Bt = (const bf16_t*)(ws + WS_WIN) + (size_t)l * NIN * D; g.M = MT; g.N = NIN; g.K = D; g.pad = 0;
            pg8::StaticOrder S; S.init(MT, NIN, G, cu);
            pg8::EpiBf16<0> E; E.O = (bf16_t*)(ws + WS_PROJ); E.ldc = NIN; E.bias = nullptr; E.split_cols = 0; E.split_stride = 0; E.scale0 = 1.f;
            pg8::gemm_phase<pg8::EpiBf16<0>, pg8::StaticOrder, true, true>(ldsl, g, S, E);
            if (rep_ + 1 < ((((DUPMASK) & (2)) && true) ? 2 : 1)) xcd_barrier(bar); }
            SEAM(pb + 1);
        }
        if ((PHMASK & 4) && IN(pb + 2)) {
        _Pragma("unroll") for (int rep_ = 0; rep_ < ((((DUPMASK) & (4)) && true) ? 2 : 1); ++rep_) {
            KArgs ap = kargs(); unsigned char* ws = ap->ws; GCU;
            const bf16_t* PROJ = (const bf16_t*)(ws + WS_PROJ);
            post_phase(cu, G, PROJ, ap->q_norm_g + l * 64, ap->k_norm_g + l * 64, (const float*)(ws + WS_COS), (const float*)(ws + WS_SIN), (bf16_t*)(ws + WS_QN), (bf16_t*)(ws + WS_KN));
            pool::pool_phase(lds, PROJ, (const bf16_t*)(ws + WS_POOLWT) + (size_t)l * 4 * 4096, ap->pool_scale + l * 256, (bf16_t*)(ws + WS_MIX), cu, G);
            hg::h1_phase(lds, PROJ, (const float*)(ws + WS_LBF) + l * 512, (bf16_t*)(ws + WS_UT), (float*)(ws + WS_DEC), cu, G);
            if (rep_ + 1 < ((((DUPMASK) & (4)) && true) ? 2 : 1)) xcd_barrier(bar); }
            SEAM(pb + 2);
        }
        if ((PHMASK & 8) && IN(pb + 3)) {
        _Pragma("unroll") for (int rep_ = 0; rep_ < ((((DUPMASK) & (8)) && true) ? 2 : 1); ++rep_) {
            KArgs ap = kargs(); unsigned char* ws = ap->ws; GCU; hg::h2_phase(lds, (const bf16_t*)(ws + WS_UT), (const float*)(ws + WS_DEC), (bf16_t*)(ws + WS_ST), cu, G);
            if (rep_ + 1 < ((((DUPMASK) & (8)) && true) ? 2 : 1)) xcd_barrier(bar); }
            SEAM(pb + 3);
        }
        if ((PHMASK & 16) && IN(pb + 4)) {
        _Pragma("unroll") for (int rep_ = 0; rep_ < ((((DUPMASK) & (16)) && true) ? 2 : 1); ++rep_) {
            { KArgs ap = kargs(); unsigned char* ws = ap->ws; GCU;
              attn_phase((char*)lds, (const bf16_t*)(ws + WS_QN), (const bf16_t*)(ws + WS_KN), (const bf16_t*)(ws + WS_PROJ), (bf16_t*)(ws + WS_MIX), ((const float*)(ws + WS_REF))[l * 64], vcu_of(cu, G), G, true); }
            { KArgs ap = kargs(); unsigned char* ws = ap->ws; GCU;
              hg::h3_phase(lds, (const bf16_t*)(ws + WS_PROJ), (const float*)(ws + WS_LBF) + l * 512, (const bf16_t*)(ws + WS_ST), ap->hgrn_norm_g + l * 64, (bf16_t*)(ws + WS_MIX), cu, G); }
            if (rep_ + 1 < ((((DUPMASK) & (16)) && true) ? 2 : 1)) xcd_barrier(bar); }
            SEAM(pb + 4);
        }
        if ((PHMASK & 32) && IN(pb + 5)) {
        _Pragma("unroll") for (int rep_ = 0; rep_ < ((((DUPMASK) & (32)) && (l == 0)) ? 2 : 1); ++rep_) {
            KArgs ap = kargs(); unsigned char* ws = ap->ws; GCU;
            pg8::Gemm g; g.A = (const bf16_t*)(ws + WS_MIX); g.Bt = (const bf16_t*)(ws + WS_WOUT) + (size_t)l * D * D; g.M = MT; g.N = D; g.K = D; g.pad = 0;
            pg8::StaticOrder S; S.init(MT, D, G, cu);
            pg8::EpiResid E; E.src_lat = (l == 0) ? ap->x : ap->out; E.src_ctx = (l == 0) ? ap->ctx : (const float*)(ws + WS_XC); E.dst_lat = ap->out; E.dst_ctx = (float*)(ws + WS_XC);
            E.modv = (const float*)(ws + WS_MODV) + (size_t)l * 3 * 6144; E.ga_off = 2048; E.pad = 0;
            pg8::gemm_phase<pg8::EpiResid, pg8::StaticOrder, true, true>(ldsl, g, S, E);
            if (rep_ + 1 < ((((DUPMASK) & (32)) && (l == 0)) ? 2 : 1)) xcd_barrier(bar); }
            SEAM(pb + 5);
        }
        if ((PHMASK & 64) && IN(pb + 6)) {
        _Pragma("unroll") for (int rep_ = 0; rep_ < ((((DUPMASK) & (64)) && true) ? 2 : 1); ++rep_) {
            KArgs ap = kargs(); unsigned char* ws = ap->ws; GCU;
            norm2_router_phase(cu, G, ap->out, (const float*)(ws + WS_XC), ap->norm2_g + l * D, (const float*)(ws + WS_MODV) + (size_t)l * 3 * 6144, 3072, ap->router_w, ap->router_b, (bf16_t*)(ws + WS_XN),
                               (unsigned*)(ws + WS_CTL) + CW_CNT + 64 * l, (u32x4*)(ws + WS_LIST), l == 0 ? 1 : 0);
            if (rep_ + 1 < ((((DUPMASK) & (64)) && true) ? 2 : 1)) xcd_barrier(bar); }
            SEAM(pb + 6);
        }
        if ((PHMASK & 128) && IN(pb + 7)) {
        _Pragma("unroll") for (int rep_ = 0; rep_ < ((((DUPMASK) & (128)) && true) ? 2 : 1); ++rep_) {
            KArgs ap = kargs(); unsigned char* ws = ap->ws; GCU;
            LAS int* TT = (LAS int*)(ldsl + TT_OFF);
            pg8::build_tiles(TT, (const unsigned*)(ws + WS_CTL) + CW_CNT + 64 * l);
            pg8::MoeOrder<8> S; S.TT = TT; S.G = G; S.c = vcu_of(cu, G);
            pg8::Src1 X; X.XN = (const bf16_t*)(ws + WS_XN); X.WGU = (const bf16_t*)(ws + WS_WGU); X.LIST = (const u32x4*)(ws + WS_LIST); pg8::EpiGateUp2 E; E.ACT2 = (bf16_t*)(ws + WS_ACT2); E.LIST = X.LIST;
            pg8::gemm_phase_x(ldsl, ldsl + ROWS_OFF, S, X, E, D, D / 64);
            if (rep_ + 1 < ((((DUPMASK) & (128)) && true) ? 2 : 1)) xcd_barrier(bar); }
            SEAM(pb + 7);
        }
        if ((PHMASK & 256) && IN(pb + 8)) {
        _Pragma("unroll") for (int rep_ = 0; rep_ < ((((DUPMASK) & (256)) && true) ? 2 : 1); ++rep_) {
            KArgs ap = kargs(); unsigned char* ws = ap->ws; GCU;
            LAS int* TT = (LAS int*)(ldsl + TT_OFF);
            pg8::build_tiles(TT, (const unsigned*)(ws + WS_CTL) + CW_CNT + 64 * l);
            pg8::MoeOrder<4> S; S.TT = TT; S.G = G; S.c = vcu_of(cu, G);
            pg8::Src2 X; X.ACT2 = (const bf16_t*)(ws + WS_ACT2); X.WD = (const bf16_t*)(ws + WS_WD);
            pg8::EpiMoeOut E; E.lat = ap->out; E.ctx = (float*)(ws + WS_XC); E.modv = (const float*)(ws + WS_MODV) + (size_t)l * 3 * 6144; E.LIST = (const u32x4*)(ws + WS_LIST);
            pg8::gemm_phase_x(ldsl, ldsl + ROWS_OFF, S, X, E, DE, 1024 / 64);
            if (rep_ + 1 < ((((DUPMASK) & (256)) && true) ? 2 : 1)) xcd_barrier(bar); }
            SEAM(pb + 8);
        }
    }
#undef IN
#undef SEAM
#undef GCU
}

extern "C" void kernel_launch(void* const* d_in, const int* in_sizes, int n_in, void* d_out, int out_size, void* d_ws, size_t ws_size, hipStream_t stream) {
    static int grid = 0;
    if (grid == 0) {
        if (n_in != 21 || in_sizes[0] != BATCH * SEQ * D || out_size != BATCH * SEQ * D || ws_size < WS_END) {
            fprintf(stderr, "kernel_launch: unexpected sizes: n_in %d in0 %d out %d ws %zu (need %zu)\n", n_in, n_in > 0 ? in_sizes[0] : -1, out_size, ws_size, (size_t)WS_END); grid = -1; return; }
        int dev = 0, cus = 0, per_cu = 0;
        if (hipGetDevice(&dev) != hipSuccess || hipDeviceGetAttribute(&cus, hipDeviceAttributeMultiprocessorCount, dev) != hipSuccess) { grid = -1; return; }
        if (hipFuncSetAttribute((const void*)mega_fwd, hipFuncAttributeMaxDynamicSharedMemorySize, LDS_BYTES) != hipSuccess) { fprintf(stderr, "kernel_launch: hipFuncSetAttribute failed\n"); grid = -1; return; }
        if (hipOccupancyMaxActiveBlocksPerMultiprocessor(&per_cu, (const void*)mega_fwd, 512, LDS_BYTES) != hipSuccess || per_cu < 1) fprintf(stderr, "kernel_launch: occupancy query reports %d\n", per_cu);
        (void)hipGetLastError();
        grid = cus;
    }
    if (grid < 0) return;
    if (hipMemsetAsync((char*)d_ws + WS_CTL, 0, 1 * MiB, stream) != hipSuccess) return;
    Args a; memset((void*)&a, 0, sizeof(a));
    a.x = (const float*)d_in[0]; a.c = (const float*)d_in[1]; a.ctx = (const float*)d_in[2]; a.c_ctx = (const float*)d_in[3]; a.w_mod = (const float*)d_in[4]; a.b_mod = (const float*)d_in[5];
    a.norm1_g = (const float*)d_in[6]; a.norm2_g = (const float*)d_in[7]; a.w_in = (const float*)d_in[8]; a.w_out = (const float*)d_in[9]; a.hgrn_lb = (const float*)d_in[10]; a.hgrn_norm_g = (const float*)d_in[11];
    a.pool_w = (const float*)d_in[12]; a.pool_scale = (const float*)d_in[13]; a.q_norm_g = (const float*)d_in[14]; a.k_norm_g = (const float*)d_in[15]; a.router_w = (const float*)d_in[16]; a.router_b = (const float*)d_in[17];
    a.moe_gate = (const float*)d_in[18]; a.moe_up = (const float*)d_in[19]; a.moe_down = (const float*)d_in[20];
    a.out = (float*)d_out; a.ws = (unsigned char*)d_ws;
#if MK_SPLIT
    for (int ph = 0; ph < NPHASE; ++ph) { a.ph_lo = ph; a.ph_hi = ph + 1; hipLaunchKernelGGL(mega_fwd, dim3(grid), dim3(512), LDS_BYTES, stream, a); }
#else
    a.ph_lo = 0; a.ph_hi = NPHASE; hipLaunchKernelGGL(mega_fwd, dim3(grid), dim3(512), LDS_BYTES, stream, a);
#endif
}
```

```cpp
#include <hip/hip_runtime.h>
#include <cstdio>
#include <cstdint>
#include <cstring>

namespace cfg {
constexpr int D = 1024, BATCH = 2, SEQ = 8192, CTXL = 256, DEPTH = 2;
constexpr int PB = SEQ + CTXL;
constexpr int MT = BATCH * PB;
constexpr int TPB = PB / 256;
constexpr int NIN = 2304;
constexpr int NE = 16, DE = 512;
constexpr int C_AQ = 0, C_AFF = 256, C_AFB = 512, C_AI = 768, C_AG = 1024, C_BP = 1280, C_CQ = 1536, C_CK = 2048, C_CV = 2176;
constexpr float EPS = 1e-6f;
constexpr float C2 = 0.125f * 1.4426950408889634f;
}

__device__ __forceinline__ int otid() { int t = threadIdx.x; asm volatile("" : "+v"(t)); return t; }

namespace pg8 {
#define PG8_LAS __attribute__((address_space(3)))
typedef unsigned short bf16_t;
typedef short bf16x8 __attribute__((ext_vector_type(8)));
typedef float f32x4 __attribute__((ext_vector_type(4)));
typedef unsigned u32x4 __attribute__((ext_vector_type(4)));
constexpr int BM = 256, BK = 64, HALF = 128, HTB = HALF * BK * 2  , STAGE_BYTES = 8 * HTB, NXCD = 8, WGM = 8;

__host__ __device__ __forceinline__ int lds_byte(int r, int c) { const int st = (r >> 4) * 2 + (c >> 5), rr = r & 15, cc = c & 31, ob = rr * 64 + cc * 2; return st * 1024 + (ob ^ (((ob >> 9) & 1) << 5)); }
__host__ __device__ __forceinline__ void stage_rc(int b, int& R, int& C) { const int st = b / 1024, sb = b % 1024, swz = sb ^ (((sb >> 9) & 1) << 5); R = (st >> 1) * 16 + swz / 64; C = (st & 1) * 32 + (swz % 64) / 2; }
__host__ __device__ __forceinline__ int perm32(int rho) { const int n = rho >> 4, i = rho & 15; return 8 * (i >> 2) + 4 * n + (i & 3); }

struct Unit { int pm, pn; };
struct Gemm { const bf16_t* A; const bf16_t* Bt; int M, N, K, pad; };

struct StaticOrder {
    int nM, nN, nwg, G, c;
    __host__ __device__ void init(int M, int N, int G_, int c_) { nM = M / BM; nN = N / BM; nwg = nM * nN; G = G_; c = c_; }
    __host__ __device__ bool next(int i, Unit& u) const {
        const long L = (long)i * G + c; if (L >= nwg) return false;
        int wgid = (int)L; { const int q = nwg / NXCD, r = nwg % NXCD, xcd = wgid % NXCD, off = wgid / NXCD; wgid = (xcd < r ? xcd * (q + 1) : r * (q + 1) + (xcd - r) * q) + off; }
        const int nig = WGM * nN, gid = wgid / nig, fm = gid * WGM, gsz = (nM - fm) < WGM ? (nM - fm) : WGM;
        u.pm = fm + ((wgid % nig) % gsz); u.pn = (wgid % nig) / gsz; return true;
    }
    __device__ __forceinline__ void a_ready(const Unit&) const {}
    __device__ __forceinline__ void done(const Unit&) const {}
};

__device__ __forceinline__ unsigned cvt_pk_bf16(float lo, float hi) { unsigned r; asm volatile("v_cvt_pk_bf16_f32 %0, %1, %2" : "=v"(r) : "v"(lo), "v"(hi)); return r; }
typedef float f32x2 __attribute__((ext_vector_type(2)));
__device__ __forceinline__ f32x2 gelu_pk(f32x2 v) {
    const f32x2 av = __builtin_elementwise_abs(v), d = av * 0.2316418882f + 1.0f;
    f32x2 t; t.x = __builtin_amdgcn_rcpf(d.x); t.y = __builtin_amdgcn_rcpf(d.y);
    f32x2 q = t * 0.5307027145f + (-0.7265760135f); q = q * t + 0.7107068705f; q = q * t + (-0.142248368f); q = q * t + 0.127414796f; q = q * t;
    const f32x2 s = (v * v) * (-0.72134752044f);
    f32x2 e; e.x = __builtin_amdgcn_exp2f(s.x); e.y = __builtin_amdgcn_exp2f(s.y);
    const f32x2 m = v * (q * e), r = v - m;
    f32x2 o; o.x = v.x < 0.f ? m.x : r.x; o.y = v.y < 0.f ? m.y : r.y; return o;
}

template <int ACT  > struct EpiBf16 {
    static constexpr bool PERM = true, AFTER_DRAIN = false; static_assert(ACT == 0 || ACT == 1, "EpiBf16: ACT is 0 (none) or 1 (gelu_pk)");
    bf16_t* O; int ldc; const float* bias; int split_cols; size_t split_stride; float scale0;
    __device__ __forceinline__ void operator()(const f32x4 (&acc)[2][2][4][2], const Unit& u, int wr, int wc, int fr, int fq) const {
        asm volatile("" : "+v"(fr), "+v"(fq));
        const int row0 = u.pm * BM + wr * 64 + fr; int colt = u.pn * BM; bf16_t* base = O;
        float sc = 1.f; if (split_cols) { const int t = colt / split_cols; base += (size_t)t * split_stride; colt -= t * split_cols; if (t == 0) sc = scale0; }
        const int col0 = colt + wc * 32 + 8 * fq, bcol0 = u.pn * BM + wc * 32 + 8 * fq;
        f32x4 bv[2][2];
#pragma unroll
        for (int bj = 0; bj < 2; ++bj)
#pragma unroll
            for (int n = 0; n < 2; ++n) bv[bj][n] = bias ? *(const f32x4*)(bias + bcol0 + bj * HALF + 4 * n) : (f32x4){0.f, 0.f, 0.f, 0.f};
#pragma unroll
        for (int ai = 0; ai < 2; ++ai)
#pragma unroll
            for (int m = 0; m < 4; ++m) { bf16_t* rowp = base + (size_t)(row0 + ai * HALF + m * 16) * ldc + col0;
#pragma unroll
                for (int bj = 0; bj < 2; ++bj) { f32x4 v0 = acc[ai][bj][m][0] + bv[bj][0], v1 = acc[ai][bj][m][1] + bv[bj][1];
                    if (ACT == 1) { f32x2 a = gelu_pk((f32x2){v0[0], v0[1]}), b = gelu_pk((f32x2){v0[2], v0[3]}), c = gelu_pk((f32x2){v1[0], v1[1]}), d = gelu_pk((f32x2){v1[2], v1[3]});
                        v0 = (f32x4){a.x, a.y, b.x, b.y}; v1 = (f32x4){c.x, c.y, d.x, d.y}; }
                    v0 = v0 * sc; v1 = v1 * sc; u32x4 w; w.x = cvt_pk_bf16(v0[0], v0[1]); w.y = cvt_pk_bf16(v0[2], v0[3]); w.z = cvt_pk_bf16(v1[0], v1[1]); w.w = cvt_pk_bf16(v1[2], v1[3]);
                    *(u32x4*)(rowp + bj * HALF) = w; } }
    }
};

template <class Epi, class Sched, bool ALIGN_EPI = false, bool SP2 = false>
__device__ __forceinline__ void gemm_phase(PG8_LAS unsigned char* lds, const Gemm g, const Sched& S, const Epi& E) {
    const int tid = otid(), wid = __builtin_amdgcn_readfirstlane(tid >> 6), lane = tid & 63, wr = wid >> 2, wc = wid & 3, fr = lane & 15, fq = lane >> 4;
    const int K = g.K, nt = K / BK;
    unsigned voffA[2], voffB[2];
#pragma unroll
    for (int i = 0; i < 2; ++i) { int R, C; stage_rc(tid * 16 + i * 8192, R, C); const int Rb = Epi::PERM ? ((R & ~31) + perm32(R & 31)) : R;
        voffA[i] = (unsigned)(R * K + C) * 2u; voffB[i] = (unsigned)(Rb * K + C) * 2u; }
    const size_t kstep = (size_t)(BK * 2);
    const size_t hstep = (size_t)HALF * K * 2;
    const size_t tstep = 2 * hstep;
    const unsigned ldsw = (unsigned)wid * 1024u;
    const int aoff = lds_byte(wr * 64 + fr, fq * 8), boff = lds_byte(wc * 32 + fr, fq * 8);
#define PG8_SA(b, h) (((b) * 2 + (h)) * HTB)
#define PG8_SB(b, h) ((4 + (b) * 2 + (h)) * HTB)
#define PG8_STAGE(bufoff, gbase, voff) do { _Pragma("unroll") for (int _i = 0; _i < 2; ++_i) \
        __builtin_amdgcn_global_load_lds((const unsigned*)((const char*)(gbase) + (voff)[_i]), (PG8_LAS unsigned*)(lds + (bufoff) + ldsw + _i * 8192), 16, 0, 0); } while (0)
#define PG8_LDA(dst, b, h) do { _Pragma("unroll") for (int m = 0; m < 4; ++m) _Pragma("unroll") for (int k = 0; k < 2; ++k) dst[m][k] = *(const PG8_LAS bf16x8*)(lds + PG8_SA(b, h) + aoff + m * 2048 + k * 1024); } while (0)
#define PG8_LDB(dst, b, h) do { _Pragma("unroll") for (int n = 0; n < 2; ++n) _Pragma("unroll") for (int k = 0; k < 2; ++k) dst[n][k] = *(const PG8_LAS bf16x8*)(lds + PG8_SB(b, h) + boff + n * 2048 + k * 1024); } while (0)
#define PG8_MMA(ai, bj, At, Bt) do { __builtin_amdgcn_s_setprio(1); _Pragma("unroll") for (int m = 0; m < 4; ++m) _Pragma("unroll") for (int n = 0; n < 2; ++n) _Pragma("unroll") for (int k = 0; k < 2; ++k) \
        acc[ai][bj][m][n] = __builtin_amdgcn_mfma_f32_16x16x32_bf16(Bt[n][k], At[m][k], acc[ai][bj][m][n], 0, 0, 0); __builtin_amdgcn_s_setprio(0); } while (0)
#define PG8_WAIT_V(n) asm volatile("s_waitcnt vmcnt(" #n ")" ::: "memory")
#define PG8_WAIT_L(n) asm volatile("s_waitcnt lgkmcnt(" #n ")" ::: "memory")
#define PG8_BAR __builtin_amdgcn_s_barrier()
#define PG8_SCHED __builtin_amdgcn_sched_barrier(0)
    Unit cur, nxt; int ui = 0;
    if (!S.next(0, cur)) return;
    f32x4 acc[2][2][4][2];
#pragma unroll
    for (int a = 0; a < 2; ++a)
#pragma unroll
        for (int b = 0; b < 2; ++b)
#pragma unroll
            for (int m = 0; m < 4; ++m)
#pragma unroll
                for (int n = 0; n < 2; ++n) acc[a][b][m][n] = (f32x4){0.f, 0.f, 0.f, 0.f};
    bf16x8 At[4][2], B0[2][2], B1[2][2];
    const char* cA = (const char*)g.A + (size_t)cur.pm * tstep; const char* cB = (const char*)g.Bt + (size_t)cur.pn * tstep;
    S.a_ready(cur);
    if constexpr (SP2) {
        PG8_STAGE(PG8_SB(0, 0), cB, voffB); PG8_STAGE(PG8_SB(0, 1), cB + hstep, voffB); PG8_STAGE(PG8_SA(0, 0), cA, voffA); PG8_STAGE(PG8_SA(0, 1), cA + hstep, voffA);
        if (wr == 1) PG8_BAR;
        PG8_WAIT_V(2); PG8_BAR;
        PG8_STAGE(PG8_SB(1, 0), cB + kstep, voffB); PG8_STAGE(PG8_SA(1, 0), cA + kstep, voffA); PG8_STAGE(PG8_SB(1, 1), cB + hstep + kstep, voffB);
        PG8_WAIT_V(6); PG8_BAR;
    } else {
        PG8_STAGE(PG8_SB(0, 0), cB, voffB); PG8_STAGE(PG8_SA(0, 0), cA, voffA); PG8_STAGE(PG8_SB(0, 1), cB + hstep, voffB); PG8_STAGE(PG8_SA(0, 1), cA + hstep, voffA);
        if (wr == 1) PG8_BAR;
        PG8_WAIT_V(4); PG8_BAR;
        PG8_STAGE(PG8_SB(1, 0), cB + kstep, voffB); PG8_STAGE(PG8_SA(1, 0), cA + kstep, voffA); PG8_STAGE(PG8_SB(1, 1), cB + hstep + kstep, voffB);
        PG8_WAIT_V(6); PG8_BAR;
    }
    for (;;) {
        const bool has_next = S.next(ui + 1, nxt);
        const char* nA = has_next ? (const char*)g.A + (size_t)nxt.pm * tstep : cA; const char* nB = has_next ? (const char*)g.Bt + (size_t)nxt.pn * tstep : cB;
        for (int t = 0; t < nt; t += 2) {
            const bool last = (t == nt - 2);
            const char* a1 = cA + (size_t)(t + 1) * kstep;
            const char* a2 = last ? nA : cA + (size_t)(t + 2) * kstep; const char* b2 = last ? nB : cB + (size_t)(t + 2) * kstep;
            const char* a3 = a2 + kstep; const char* b3 = b2 + kstep;
            if (last && has_next) S.a_ready(nxt);
            if constexpr (SP2) {
            PG8_LDB(B0, 0, 0); PG8_LDB(B1, 0, 1); PG8_SCHED; PG8_LDA(At, 0, 0); PG8_STAGE(PG8_SA(1, 1), a1 + hstep, voffA);
            PG8_WAIT_V(8); PG8_WAIT_L(0); PG8_BAR; PG8_MMA(0, 0, At, B0); PG8_MMA(0, 1, At, B1); PG8_BAR; PG8_SCHED;
            PG8_LDA(At, 0, 1); PG8_STAGE(PG8_SB(0, 0), b2, voffB); PG8_STAGE(PG8_SB(0, 1), b2 + hstep, voffB); PG8_STAGE(PG8_SA(0, 0), a2, voffA);
            PG8_WAIT_V(8); PG8_WAIT_L(0); PG8_BAR; PG8_MMA(1, 0, At, B0); PG8_MMA(1, 1, At, B1); PG8_BAR; PG8_SCHED;
            PG8_LDB(B0, 1, 0); PG8_LDB(B1, 1, 1); PG8_SCHED; PG8_LDA(At, 1, 0); PG8_STAGE(PG8_SA(0, 1), a2 + hstep, voffA);
            PG8_WAIT_V(8); PG8_WAIT_L(0); PG8_BAR; PG8_MMA(0, 0, At, B0); PG8_MMA(0, 1, At, B1); PG8_BAR; PG8_SCHED;
            PG8_LDA(At, 1, 1); PG8_STAGE(PG8_SB(1, 0), b3, voffB); PG8_STAGE(PG8_SB(1, 1), b3 + hstep, voffB); PG8_STAGE(PG8_SA(1, 0), a3, voffA);
            PG8_WAIT_V(8); PG8_WAIT_L(0); PG8_BAR; PG8_MMA(1, 0, At, B0); PG8_MMA(1, 1, At, B1); PG8_BAR; PG8_SCHED;
            } else {
            PG8_LDB(B0, 0, 0); PG8_SCHED; PG8_LDA(At, 0, 0); PG8_STAGE(PG8_SA(1, 1), a1 + hstep, voffA);
            PG8_WAIT_L(8); PG8_BAR; PG8_WAIT_L(0); PG8_MMA(0, 0, At, B0); PG8_BAR; PG8_SCHED;
            PG8_LDB(B1, 0, 1); PG8_STAGE(PG8_SB(0, 0), b2, voffB);
            PG8_BAR; PG8_WAIT_L(0); PG8_MMA(0, 1, At, B1); PG8_BAR;
            PG8_LDA(At, 0, 1); PG8_STAGE(PG8_SA(0, 0), a2, voffA);
            PG8_BAR; PG8_WAIT_L(0); PG8_MMA(1, 0, At, B0); PG8_BAR; PG8_SCHED;
            PG8_STAGE(PG8_SB(0, 1), b2 + hstep, voffB);
            PG8_WAIT_V(6); PG8_BAR; PG8_MMA(1, 1, At, B1); PG8_BAR;
            PG8_LDB(B0, 1, 0); PG8_SCHED; PG8_LDA(At, 1, 0); PG8_STAGE(PG8_SA(0, 1), a2 + hstep, voffA);
            PG8_WAIT_L(8); PG8_BAR; PG8_WAIT_L(0); PG8_MMA(0, 0, At, B0); PG8_BAR; PG8_SCHED;
            PG8_LDB(B1, 1, 1); PG8_STAGE(PG8_SB(1, 0), b3, voffB);
            PG8_BAR; PG8_WAIT_L(0); PG8_MMA(0, 1, At, B1); PG8_BAR;
            PG8_LDA(At, 1, 1); PG8_STAGE(PG8_SA(1, 0), a3, voffA);
            PG8_BAR; PG8_WAIT_L(0); PG8_MMA(1, 0, At, B0); PG8_BAR; PG8_SCHED;
            PG8_STAGE(PG8_SB(1, 1), b3 + hstep, voffB);
            PG8_WAIT_V(6); PG8_BAR; PG8_MMA(1, 1, At, B1); PG8_BAR;
            }
        }
        if constexpr (ALIGN_EPI) { if (wr == 0) PG8_BAR; }
        if constexpr (!Epi::AFTER_DRAIN) { E(acc, cur, wr, wc, fr, fq); S.done(cur); }
        if (!has_next) break;
#pragma unroll
        for (int a = 0; a < 2; ++a)
#pragma unroll
            for (int b = 0; b < 2; ++b)
#pragma unroll
                for (int m = 0; m < 4; ++m)
#pragma unroll
                    for (int n = 0; n < 2; ++n) acc[a][b][m][n] = (f32x4){0.f, 0.f, 0.f, 0.f};
        cur = nxt; cA = nA; cB = nB; ++ui;
        if constexpr (ALIGN_EPI) { if (wr == 1) PG8_BAR; }
    }
    PG8_WAIT_V(0);
    if constexpr (!ALIGN_EPI) { if (wr == 0) PG8_BAR; }
    PG8_BAR;
    if constexpr (Epi::AFTER_DRAIN) { E.fused(acc, cur, wr, wc, fr, fq, lds, wid, lane); S.done(cur); }
#undef PG8_SA
#undef PG8_SB
#undef PG8_STAGE
#undef PG8_LDA
#undef PG8_LDB
#undef PG8_MMA
#undef PG8_WAIT_V
#undef PG8_WAIT_L
#undef PG8_BAR
#undef PG8_SCHED
}
}

#include <hip/hip_bf16.h>
#include <cmath>
namespace attn_body {
using bf16=__hip_bfloat16;
using bf16x8=__attribute__((ext_vector_type(8)))short;
using s16x4=__attribute__((ext_vector_type(4)))short;
using f32x16=__attribute__((ext_vector_type(16)))float;
using u32x4=__attribute__((ext_vector_type(4)))unsigned;
constexpr int D=64,QP=512,KP=128,VP=2304,OP=1024;
constexpr int NW=8,QBLK=32,QB=QBLK*NW,KVBLK=64;
constexpr int ATTN_UNIT_ROWS=QB;
__device__ __forceinline__ int crow(int r,int hi){return (r&3)+8*(r>>2)+4*hi;}
#define SBAR() __builtin_amdgcn_sched_barrier(0)
constexpr int NSLOT=3, SLOTB=8192;
constexpr int LDS_K=0, LDS_V=NSLOT*SLOTB, LDS_WS=2*NSLOT*SLOTB, LDS_OST=LDS_WS+NW*64*4, LDS_BYTES=LDS_OST+NW*4096;
constexpr float C2=0.125f*1.4426950408889634f;
__device__ __forceinline__ void glds16(const void*gsrc,unsigned lds_dst){unsigned keep;
  asm volatile("s_mov_b32 %0, m0\n\ts_mov_b32 m0, %2\n\ts_nop 0\n\tglobal_load_lds_dwordx4 %1, off\n\ts_mov_b32 m0, %0":"=&s"(keep):"v"(gsrc),"s"(lds_dst):"memory");}
__device__ __forceinline__ float max3f(float a,float b,float c){float r;asm("v_max3_f32 %0, %1, %2, %3":"=v"(r):"v"(a),"v"(b),"v"(c));return r;}
__device__ __forceinline__ float max2f(float a,float b){float r;asm("v_max_f32_e32 %0, %1, %2":"=v"(r):"v"(a),"v"(b));return r;}
__device__ __forceinline__ float fadd_s(float a,float b){float r;asm("v_add_f32_e32 %0, %1, %2":"=v"(r):"v"(a),"v"(b));return r;}
__device__ __forceinline__ float fsub_s(float a,float b){float r;asm("v_sub_f32_e32 %0, %1, %2":"=v"(r):"v"(a),"v"(b));return r;}
typedef float f32x2_t __attribute__((ext_vector_type(2))); typedef __bf16 bf16x2_t __attribute__((ext_vector_type(2)));
__device__ __forceinline__ unsigned cvtpk_s(float lo,float hi){f32x2_t v={lo,hi};bf16x2_t b=__builtin_convertvector(v,bf16x2_t);return __builtin_bit_cast(unsigned,b);}
#define WAIT_BAR(N) asm volatile("s_waitcnt vmcnt(" #N ") lgkmcnt(0)\n\ts_barrier":::"memory")

__device__ __forceinline__ void qkt(f32x16&p0,f32x16&p1,const char*Kslot,const bf16x8*qr,const f32x16&negm,int r32,int hi){
  const char*kb=Kslot+hi*1024+r32*16;
  #pragma unroll
  for(int d0=0;d0<4;++d0){
    const bf16x8 b0=*reinterpret_cast<const bf16x8*>(kb+d0*2048);
    const bf16x8 b1=*reinterpret_cast<const bf16x8*>(kb+d0*2048+512);
    if(d0==0){p0=__builtin_amdgcn_mfma_f32_32x32x16_bf16(b0,qr[0],negm,0,0,0);p1=__builtin_amdgcn_mfma_f32_32x32x16_bf16(b1,qr[0],negm,0,0,0);}
    else{p0=__builtin_amdgcn_mfma_f32_32x32x16_bf16(b0,qr[d0],p0,0,0,0);p1=__builtin_amdgcn_mfma_f32_32x32x16_bf16(b1,qr[d0],p1,0,0,0);}}
}
typedef __attribute__((address_space(3))) const char* lds_cptr;
typedef short v4i16_t __attribute__((ext_vector_type(4)));
__device__ __forceinline__ void kload8(bf16x8*kf,lds_cptr kp){
  kf[0]=*(const __attribute__((address_space(3))) bf16x8*)(kp);      kf[1]=*(const __attribute__((address_space(3))) bf16x8*)(kp+512);
  kf[2]=*(const __attribute__((address_space(3))) bf16x8*)(kp+2048); kf[3]=*(const __attribute__((address_space(3))) bf16x8*)(kp+2560);
  kf[4]=*(const __attribute__((address_space(3))) bf16x8*)(kp+4096); kf[5]=*(const __attribute__((address_space(3))) bf16x8*)(kp+4608);
  kf[6]=*(const __attribute__((address_space(3))) bf16x8*)(kp+6144); kf[7]=*(const __attribute__((address_space(3))) bf16x8*)(kp+6656);
}
__device__ __forceinline__ void kload2(bf16x8*kf,lds_cptr kp,int j){ kf[2*j]=*(const __attribute__((address_space(3))) bf16x8*)(kp+j*2048); kf[2*j+1]=*(const __attribute__((address_space(3))) bf16x8*)(kp+j*2048+512); }
__device__ __forceinline__ s16x4 vtr(lds_cptr p){ return __builtin_bit_cast(s16x4,__builtin_amdgcn_ds_read_tr16_b64_v4i16((__attribute__((address_space(3))) v4i16_t*)p)); }
__device__ __forceinline__ float rowmax(const f32x16&p0,const f32x16&p1){
  float a=max3f(p0[0],p0[1],p1[0]),b=max3f(p0[2],p0[3],p1[1]);a=max3f(a,p1[2],p1[3]);
  #pragma unroll
  for(int r=4;r<16;r+=4){a=max3f(a,p0[r],p0[r+1]);b=max3f(b,p0[r+2],p0[r+3]);a=max3f(a,p1[r],p1[r+1]);b=max3f(b,p1[r+2],p1[r+3]);}
  const float m=max2f(a,b);
  auto rr=__builtin_amdgcn_permlane32_swap(__float_as_uint(m),__float_as_uint(m),false,false);
  return max2f(__uint_as_float(rr[0]),__uint_as_float(rr[1]));
}
__device__ __forceinline__ void pv(f32x16*o,int vb,bf16x8 pa0,bf16x8 pa1,bf16x8 pa2,bf16x8 pa3){
  #pragma unroll
  for(int d0=0;d0<2;++d0){s16x4 lo[4],hi[4];
    #pragma unroll
    for(int ks=0;ks<4;++ks){
      asm volatile("ds_read_b64_tr_b16 %0,%1 offset:%c2":"=&v"(lo[ks]):"v"(vb),"i"(d0*4096+ks*1024):"memory");
      asm volatile("ds_read_b64_tr_b16 %0,%1 offset:%c2":"=&v"(hi[ks]):"v"(vb),"i"(d0*4096+ks*1024+512):"memory");}
    asm volatile("s_waitcnt lgkmcnt(0)":::"memory");SBAR();
    #define PK(k) (bf16x8){lo[k][0],lo[k][1],lo[k][2],lo[k][3],hi[k][0],hi[k][1],hi[k][2],hi[k][3]}
    o[d0]=__builtin_amdgcn_mfma_f32_32x32x16_bf16(pa0,PK(0),o[d0],0,0,0);
    o[d0]=__builtin_amdgcn_mfma_f32_32x32x16_bf16(pa1,PK(1),o[d0],0,0,0);
    o[d0]=__builtin_amdgcn_mfma_f32_32x32x16_bf16(pa2,PK(2),o[d0],0,0,0);
    o[d0]=__builtin_amdgcn_mfma_f32_32x32x16_bf16(pa3,PK(3),o[d0],0,0,0);
    #undef PK
  }
}

#ifndef ATTN_STORE16
#define ATTN_STORE16(p,v) (*(u32x4*)(p)=(v))
#endif
__device__ __forceinline__ void attn_unit(const bf16*Qw0,const bf16*__restrict__ Kh,const bf16*__restrict__ Vh,bf16*Ow0,const int NT,const float neg_ref,char*shm){
  const int tid=otid(),lane=tid&63,r32=lane&31,hi=lane>>5; const int wid=__builtin_amdgcn_readfirstlane(tid>>6);
  const bf16*Qw=Qw0+(long)(wid*QBLK)*QP;
  const unsigned lds0=(unsigned)(uintptr_t)shm;
  float*wsf=(float*)(shm+LDS_WS)+wid*64;
  const bf16*ksrc=Kh+(long)lane*KP+wid*8;
  const bf16*vsrc=Vh+(long)(16*(wid&3)+(lane>>2))*VP+(wid>>2)*32+(lane&3)*8;
  const unsigned kdst=lds0+LDS_K+wid*1024, vdst=lds0+LDS_V+wid*1024;
  #define DMA_K(t,slot) glds16(ksrc+(long)(t)*KVBLK*KP,(unsigned)__builtin_amdgcn_readfirstlane(kdst+(slot)))
  #define DMA_V(t,slot) glds16(vsrc+(long)(t)*KVBLK*VP,(unsigned)__builtin_amdgcn_readfirstlane(vdst+(slot)))
  const int vb0=(int)(lds0+LDS_V)+((lane>>4)&1)*32+(lane&3)*8+(4*hi+((lane&15)>>2))*64;
  const char*Kbase=shm+LDS_K; bf16x8 kf[8];
  const lds_cptr shm3=(lds_cptr)shm; const lds_cptr kp0=shm3+LDS_K+hi*1024+r32*16; const lds_cptr vp0=shm3+LDS_V+((lane>>4)&1)*32+(lane&3)*8+(4*hi+((lane&15)>>2))*64;
  DMA_K(0,0);DMA_V(0,0);DMA_K(1,SLOTB);
  bf16x8 qr[4];
  #pragma unroll
  for(int d0=0;d0<4;++d0)qr[d0]=*reinterpret_cast<const bf16x8*>(&Qw[(long)r32*QP+d0*16+hi*8]);
  float l_reg=0.f;f32x16 o[2];o[0]=f32x16{};o[1]=f32x16{};f32x16 negm;
  #pragma unroll
  for(int r=0;r<16;++r)negm[r]=neg_ref;
  asm volatile("":"+v"(negm));
  f32x16 pA0,pA1,pB0,pB1;
  int sl_prev=0,sl_cur=0,sl_next=SLOTB;
  #define ROT() do{sl_prev=sl_cur;sl_cur=sl_next;sl_next=(sl_next==(NSLOT-1)*SLOTB)?0:sl_next+SLOTB;}while(0)
  DMA_K(2,2*SLOTB);
  WAIT_BAR(3);
  qkt(pA0,pA1,Kbase,qr,negm,r32,hi);asm volatile("s_nop 15\n\ts_nop 7":"+v"(pA0),"+v"(pA1));
  _Pragma("unroll") for(int r=0;r<16;++r)pA0[r]=__builtin_amdgcn_exp2f(pA0[r]);
  _Pragma("unroll") for(int r=0;r<16;++r)pA1[r]=__builtin_amdgcn_exp2f(pA1[r]);
  WAIT_BAR(0);
  DMA_K(3,0);DMA_V(1,SLOTB);
  ROT();
  kload8(kf,kp0+sl_cur);
  WAIT_BAR(2);
  s16x4 vlo[8],vhi[8]; u32x4 pw0,pw1,pw2,pw3;
  #define PKW(P,B) cvtpk_s(P[B],P[B+1])
  #define PAF(k) __builtin_bit_cast(bf16x8,pw##k)
  #define VFR(i) (bf16x8){vlo[i][0],vlo[i][1],vlo[i][2],vlo[i][3],vhi[i][0],vhi[i][1],vhi[i][2],vhi[i][3]}
  #define PIN(x) asm volatile("":"+v"(x))
  #define MX3(a,b,c) __builtin_fmaxf(__builtin_fmaxf((a),(b)),(c))
  #define GAPA(MF,A0,A1,A2,A3,W0,W1,PW) do{ MF; sacc+=A0; sacc+=A1; sacc+=A2; sacc+=A3; PIN(sacc); W0; W1; PIN(PW); SBAR(); }while(0)
  #define EX(v) __builtin_amdgcn_exp2f(v)
  #define GAPB(MF,X,B) do{ MF; X[B]=EX(X[B]); X[B+1]=EX(X[B+1]); X[B+2]=EX(X[B+2]); X[B+3]=EX(X[B+3]); PIN(X); SBAR(); }while(0)
  #define VRD(i) do{ vlo[i]=vtr(vp_+(((i)>>2)*4096+((i)&3)*1024)); vhi[i]=vtr(vp_+(((i)>>2)*4096+((i)&3)*1024+512)); }while(0)
  #define KRD(G,j) do{ if(G){ kload2(kf,kp0+sl_next,j); SBAR(); } }while(0)
  #define STEP(C0,C1,P0,P1,t,GK,GV,GL) do{ SBAR(); \
    const lds_cptr vp_=vp0+sl_prev; \
    VRD(0); SBAR(); float sacc=(P0[0]+P0[1]); \
    GAPA(C0=__builtin_amdgcn_mfma_f32_32x32x16_bf16(kf[0],qr[0],negm,0,0,0), P0[2],P0[3],P0[4],P0[5],     pw0[0]=PKW(P0,0), pw0[1]=PKW(P0,2), pw0); \
    VRD(4); SBAR(); GAPA(C1=__builtin_amdgcn_mfma_f32_32x32x16_bf16(kf[1],qr[0],negm,0,0,0), P0[6],P0[7],P0[8],P0[9],     pw0[2]=PKW(P0,4), pw0[3]=PKW(P0,6), pw0); \
    VRD(1); SBAR(); GAPA(C0=__builtin_amdgcn_mfma_f32_32x32x16_bf16(kf[2],qr[1],C0,0,0,0),   P0[10],P0[11],P0[12],P0[13], pw1[0]=PKW(P0,8), pw1[1]=PKW(P0,10), pw1); \
    VRD(5); SBAR(); GAPA(C1=__builtin_amdgcn_mfma_f32_32x32x16_bf16(kf[3],qr[1],C1,0,0,0),   P0[14],P0[15],P1[0],P1[1],   pw1[2]=PKW(P0,12),pw1[3]=PKW(P0,14), pw1); \
    VRD(2); SBAR(); GAPA(C0=__builtin_amdgcn_mfma_f32_32x32x16_bf16(kf[4],qr[2],C0,0,0,0),   P1[2],P1[3],P1[4],P1[5],     pw2[0]=PKW(P1,0), pw2[1]=PKW(P1,2), pw2); \
    VRD(6); SBAR(); GAPA(C1=__builtin_amdgcn_mfma_f32_32x32x16_bf16(kf[5],qr[2],C1,0,0,0),   P1[6],P1[7],P1[8],P1[9],     pw2[2]=PKW(P1,4), pw2[3]=PKW(P1,6), pw2); \
    VRD(3); SBAR(); GAPA(C0=__builtin_amdgcn_mfma_f32_32x32x16_bf16(kf[6],qr[3],C0,0,0,0),   P1[10],P1[11],P1[12],P1[13], pw3[0]=PKW(P1,8), pw3[1]=PKW(P1,10), pw3); \
    VRD(7); SBAR(); GAPA(C1=__builtin_amdgcn_mfma_f32_32x32x16_bf16(kf[7],qr[3],C1,0,0,0),   P1[14],P1[15],0.f,0.f,       pw3[2]=PKW(P1,12),pw3[3]=PKW(P1,14), pw3); \
    l_reg+=sacc; \
    if(GK){DMA_K((t)+3,sl_cur);} if(GV){DMA_V((t)+1,sl_next);} \
    SBAR(); \
    GAPB(o[0]=__builtin_amdgcn_mfma_f32_32x32x16_bf16(PAF(0),VFR(0),o[0],0,0,0), C0,0); \
    GAPB(o[1]=__builtin_amdgcn_mfma_f32_32x32x16_bf16(PAF(0),VFR(4),o[1],0,0,0), C0,4); \
    KRD(GL,0); GAPB(o[0]=__builtin_amdgcn_mfma_f32_32x32x16_bf16(PAF(1),VFR(1),o[0],0,0,0), C0,8); \
    KRD(GL,1); GAPB(o[1]=__builtin_amdgcn_mfma_f32_32x32x16_bf16(PAF(1),VFR(5),o[1],0,0,0), C0,12); \
    KRD(GL,2); GAPB(o[0]=__builtin_amdgcn_mfma_f32_32x32x16_bf16(PAF(2),VFR(2),o[0],0,0,0), C1,0); \
    KRD(GL,3); GAPB(o[1]=__builtin_amdgcn_mfma_f32_32x32x16_bf16(PAF(2),VFR(6),o[1],0,0,0), C1,4); \
    GAPB(o[0]=__builtin_amdgcn_mfma_f32_32x32x16_bf16(PAF(3),VFR(3),o[0],0,0,0), C1,8); \
    GAPB(o[1]=__builtin_amdgcn_mfma_f32_32x32x16_bf16(PAF(3),VFR(7),o[1],0,0,0), C1,12); \
    }while(0)
  int t=1;
  for(;t+5<NT;t+=2){
    STEP(pB0,pB1,pA0,pA1,t,true,true,true);     WAIT_BAR(2); ROT();
    STEP(pA0,pA1,pB0,pB1,t+1,true,true,true);   WAIT_BAR(2); ROT();
  }
  #define ENDW(tt) do{ if((tt)+3<NT){WAIT_BAR(2);} else if((tt)+2<NT){WAIT_BAR(1);} else {WAIT_BAR(0);} }while(0)
  for(;t+1<NT;t+=2){
    STEP(pB0,pB1,pA0,pA1,t,(t+3<NT),(t+1<NT),(t+1<NT));       ENDW(t);   ROT();
    STEP(pA0,pA1,pB0,pB1,t+1,(t+4<NT),(t+2<NT),(t+2<NT));     ENDW(t+1); ROT();
  }
  STEP(pB0,pB1,pA0,pA1,NT-1,false,false,false);
  { float sacc=pB0[0]+pB0[1]; _Pragma("unroll") for(int r=2;r<16;++r)sacc+=pB0[r]; _Pragma("unroll") for(int r=0;r<16;++r)sacc+=pB1[r]; l_reg+=sacc;
    pw0=(u32x4){PKW(pB0,0),PKW(pB0,2),PKW(pB0,4),PKW(pB0,6)};pw1=(u32x4){PKW(pB0,8),PKW(pB0,10),PKW(pB0,12),PKW(pB0,14)};pw2=(u32x4){PKW(pB1,0),PKW(pB1,2),PKW(pB1,4),PKW(pB1,6)};pw3=(u32x4){PKW(pB1,8),PKW(pB1,10),PKW(pB1,12),PKW(pB1,14)};
    SBAR(); pv(o,vb0+sl_cur,PAF(0),PAF(1),PAF(2),PAF(3)); }
  #undef PKW
  #undef PAF
  #undef VFR
  #undef PIN
  #undef MX3
  #undef GAPA
  #undef GAPB
  #undef EX
  #undef VRD
  #undef KRD
  #undef STEP
  #undef ENDW
  {auto rr=__builtin_amdgcn_permlane32_swap(__float_as_uint(l_reg),__float_as_uint(l_reg),false,false);l_reg=__uint_as_float(rr[0])+__uint_as_float(rr[1]);}
  if(hi==0)wsf[32+r32]=l_reg;asm volatile("s_waitcnt lgkmcnt(0)":::"memory");
  float rli[16];
  #pragma unroll
  for(int r=0;r<16;++r)rli[r]=__builtin_amdgcn_rcpf(wsf[32+crow(r,hi)]);
  bf16*Ow=Ow0+(long)(wid*QBLK)*OP;
  { bf16*stg=(bf16*)(shm+LDS_OST)+wid*2048;
    #pragma unroll
    for(int r=0;r<16;++r){const int orow=crow(r,hi);
      #pragma unroll
      for(int d0=0;d0<2;++d0)stg[orow*64+d0*32+r32]=__float2bfloat16(o[d0][r]*rli[r]);}
    asm volatile("s_waitcnt lgkmcnt(0)":::"memory");
    #pragma unroll
    for(int i=0;i<4;++i){const int row=i*8+(lane>>3),ch=lane&7; const u32x4 v=*(const u32x4*)(stg+row*64+ch*8); ATTN_STORE16(Ow+(long)row*OP+ch*8,v);} }
  asm volatile("s_waitcnt lgkmcnt(0)\n\ts_barrier":::"memory");
  #undef DMA_K
  #undef DMA_V
  #undef ROT
}
constexpr int ATTN_LDS_BYTES=LDS_BYTES;
#undef SBAR
#undef WAIT_BAR
}


using namespace cfg;
typedef unsigned short bf16_t;
typedef float f32x4 __attribute__((ext_vector_type(4)));
typedef unsigned u32x4 __attribute__((ext_vector_type(4)));
typedef unsigned u32x2 __attribute__((ext_vector_type(2)));

__device__ __forceinline__ float bf2f(unsigned v) { return __uint_as_float(v << 16); }
__device__ __forceinline__ float bflo(unsigned w) { return __uint_as_float(w << 16); }
__device__ __forceinline__ float bfhi(unsigned w) { return __uint_as_float(w & 0xffff0000u); }
__device__ __forceinline__ unsigned f2bf(float f) { unsigned u = __float_as_uint(f); return (u + 0x7fffu + ((u >> 16) & 1u)) >> 16; }
__device__ __forceinline__ unsigned pk2(float lo, float hi) { return f2bf(lo) | (f2bf(hi) << 16); }
__device__ __forceinline__ float sigm(float x) { return 1.f / (1.f + __expf(-x)); }
__device__ __forceinline__ float silu(float x) { return x / (1.f + __expf(-x)); }
template <int M> __device__ __forceinline__ float xsum(float v) {
    if constexpr (M < 32) return v + __uint_as_float((unsigned)__builtin_amdgcn_ds_swizzle((int)__float_as_uint(v), (M << 10) | 0x1f));
    else { auto rr = __builtin_amdgcn_permlane32_swap(__float_as_uint(v), __float_as_uint(v), false, false); return __uint_as_float(rr[0]) + __uint_as_float(rr[1]); }
}
__device__ __forceinline__ float wave_sum(float v) { v = xsum<1>(v); v = xsum<2>(v); v = xsum<4>(v); v = xsum<8>(v); v = xsum<16>(v); v = xsum<32>(v); return v; }
__device__ __forceinline__ size_t stream_off(int row, bool& is_ctx) { const int b = row / PB, p = row - b * PB; is_ctx = p < CTXL; return is_ctx ? ((size_t)b * CTXL + p) * D : ((size_t)b * SEQ + (p - CTXL)) * D; }

constexpr size_t MiB = 1u << 20;
constexpr size_t WS_CTL = 0;
constexpr size_t WS_MODV = 1 * MiB;
constexpr size_t WS_LBF = WS_MODV + 256 * 1024;
constexpr size_t WS_REF = WS_LBF + 8192;
constexpr size_t WS_POOLWT = WS_MODV + 512 * 1024;
constexpr size_t WS_COS = 2 * MiB, WS_SIN = 3 * MiB;
constexpr size_t WS_WIN = 4 * MiB;
constexpr size_t WS_WOUT = 13 * MiB;
constexpr size_t WS_WGU = 17 * MiB;
constexpr size_t WS_WD = 49 * MiB;
constexpr size_t WS_XC = 65 * MiB;
constexpr size_t WS_XN = 67 * MiB;
constexpr size_t WS_PROJ = 100 * MiB;
constexpr size_t WS_QN = 175 * MiB;
constexpr size_t WS_KN = 192 * MiB;
constexpr size_t WS_MIX = 197 * MiB;
constexpr size_t WS_UT = 230 * MiB;
constexpr size_t WS_ST = 247 * MiB;
constexpr size_t WS_DEC = 264 * MiB;
constexpr size_t WS_LIST = 265 * MiB;
constexpr size_t WS_ACT2 = WS_PROJ;
constexpr size_t WS_END = 272 * MiB;
constexpr int CW_CNT = 1024;

__device__ const float ROPE_INV[16] = {1.0f, 0.5623413251903491f, 0.31622776601683794f, 0.1778279410038923f, 0.1f, 0.05623413251903491f, 0.03162277660168379f, 0.01778279410038923f,
                                       0.01f, 0.005623413251903491f, 0.0031622776601683794f, 0.0017782794100389228f, 0.001f, 0.0005623413251903491f, 0.00031622776601683794f, 0.00017782794100389227f};
__device__ __forceinline__ void sincos_d(double a, double& s, double& c) {
    const double k = rint(a * 0.63661977236758134308);
    double r = fma(-k, 1.57079632679489655800e+00, a);
    r = fma(-k, 6.12323399573676603587e-17, r);
    const double r2 = r * r;
    double sp = -7.6471637318198164759e-13;
    sp = fma(sp, r2, 1.6059043836821614599e-10);
    sp = fma(sp, r2, -2.5052108385441718775e-08);
    sp = fma(sp, r2, 2.7557319223985890653e-06);
    sp = fma(sp, r2, -1.9841269841269841270e-04);
    sp = fma(sp, r2, 8.3333333333333333333e-03);
    sp = fma(sp, r2, -1.6666666666666666667e-01);
    const double sr = fma(sp * r2, r, r);
    double cp = 4.7794773323873852974e-14;
    cp = fma(cp, r2, -1.1470745597729724714e-11);
    cp = fma(cp, r2, 2.0876756987868098979e-09);
    cp = fma(cp, r2, -2.7557319223985890653e-07);
    cp = fma(cp, r2, 2.4801587301587301587e-05);
    cp = fma(cp, r2, -1.3888888888888888889e-03);
    cp = fma(cp, r2, 4.1666666666666666667e-02);
    cp = fma(cp, r2, -0.5);
    const double cr = fma(cp, r2, 1.0);
    const int q = ((int)k) & 3;
    s = (q == 0) ? sr : (q == 1) ? cr : (q == 2) ? -sr : -cr;
    c = (q == 0) ? cr : (q == 1) ? -sr : (q == 2) ? -cr : sr;
}

__device__ __forceinline__ void transpose_items(const float* __restrict__ W, int K, int N, bf16_t* __restrict__ WT, int mode, int nbatch, size_t src_stride, size_t dst_stride, float* scr, int gw, int NGW, int lane) {
    const int nblk = N / 32, per = (K / 64) * nblk, nitems = per * nbatch;
    for (int it = gw; it < nitems; it += NGW) {
        const int bt = it / per, item = it - bt * per;
        const float* Wb = W + (size_t)bt * src_stride; bf16_t* WTb = WT + (size_t)bt * dst_stride;
        const int kb = item / nblk, nb = item - kb * nblk, k0 = 64 * kb, n0 = 32 * nb;
#pragma unroll 8
        for (int i = 0; i < 32; ++i) { const int kk = 2 * i + (lane >> 5); scr[kk * 33 + (lane & 31)] = Wb[(size_t)(k0 + kk) * N + n0 + (lane & 31)]; }
        asm volatile("s_waitcnt lgkmcnt(0)" ::: "memory");
        const int rbase = (mode == 0) ? n0 : ((n0 >> 7) * 256 + (mode == 2 ? 128 : 0) + (n0 & 127));
        const int cch = lane & 7;
#pragma unroll
        for (int j = 0; j < 4; ++j) { const int n = (lane >> 3) + 8 * j; const float* s = scr + (8 * cch) * 33 + n;
            u32x4 o; o.x = pk2(s[0 * 33], s[1 * 33]); o.y = pk2(s[2 * 33], s[3 * 33]); o.z = pk2(s[4 * 33], s[5 * 33]); o.w = pk2(s[6 * 33], s[7 * 33]);
            *(u32x4*)(WTb + (size_t)(rbase + n) * K + k0 + 8 * cch) = o; }
        asm volatile("s_waitcnt lgkmcnt(0)" ::: "memory");
    }
}
__device__ __forceinline__ void moe_weight_copies(const float* gate, const float* up, const float* down, bf16_t* WGU, bf16_t* WD, float* scr, int gw, int NGW, int lane) {
    transpose_items(gate, D, DE, WGU, 1, NE, (size_t)D * DE, (size_t)1024 * D, scr, gw, NGW, lane);
    transpose_items(up, D, DE, WGU, 2, NE, (size_t)D * DE, (size_t)1024 * D, scr, gw, NGW, lane);
    transpose_items(down, DE, D, WD, 0, NE, (size_t)DE * D, (size_t)D * DE, scr, gw, NGW, lane);
}
struct ProArgs { const float *c, *c_ctx, *w_mod, *b_mod, *hgrn_lb, *qg, *kg, *w_in, *w_out, *pool_w, *gate, *up, *down; float *MODV, *LBF, *REF, *COS, *SIN; bf16_t *WIN, *WOUT, *POOLWT, *WGU, *WD; };
__device__ __forceinline__ void prologue_phase(unsigned char* lds, const ProArgs& a, int cu, int G) {
    const int tid = otid(), lane = tid & 63, wave = tid >> 6;
    for (int gid = cu * 512 + tid; gid < SEQ * 32; gid += G * 512) {
        const int t = gid >> 5, j = gid & 31;
        const float pos = (float)(j < 16 ? (t >> 6) : (t & 63));
        const float ang = pos * ROPE_INV[j & 15];
        double s, c; sincos_d((double)ang, s, c);
        a.COS[gid] = (float)c; a.SIN[gid] = (float)s;
    }
    if (cu == 0) {
        for (int gid = tid; gid < 1024; gid += 512) {
            const int l = gid >> 9, r = gid & 511; float v = 0.f;
            if (l == 1) v = 1.f / (1.f + expf(a.hgrn_lb[r] - a.hgrn_lb[512 + r]));
            a.LBF[gid] = fmaxf(v, 1e-30f); }
        if (tid < DEPTH) {
            float mq = 0.f, mk = 0.f;
            for (int i = 0; i < 64; ++i) { mq = fmaxf(mq, fabsf(a.qg[tid * 64 + i])); mk = fmaxf(mk, fabsf(a.kg[tid * 64 + i])); }
            a.REF[tid * 64] = -(64.f * C2 * mq * mk * 1.02f + 0.5f); }
    }
    {
        float* act = (float*)lds;
        float* part = (float*)(lds + 12288);
        for (int item = cu; item < 2 * 96; item += G) {
            const int l = item / 96, n0 = (item - l * 96) * 64;
            for (int i = tid; i < 3072; i += 512) { const int r = i >> 10, k = i & 1023; const float v = r < 2 ? a.c[r * 1024 + k] : a.c_ctx[k]; act[i] = silu(v); }
            __syncthreads();
            const float* w = a.w_mod + ((size_t)l * 1024 + (size_t)wave * 128) * 6144 + n0 + lane;
            float a0 = 0.f, a1 = 0.f, a2 = 0.f;
#pragma unroll 8
            for (int k = 0; k < 128; ++k) { const float wv = w[(size_t)k * 6144]; const int kk = wave * 128 + k; a0 += act[kk] * wv; a1 += act[1024 + kk] * wv; a2 += act[2048 + kk] * wv; }
            part[(wave * 3 + 0) * 64 + lane] = a0; part[(wave * 3 + 1) * 64 + lane] = a1; part[(wave * 3 + 2) * 64 + lane] = a2;
            __syncthreads();
            if (tid < 192) { const int r = tid >> 6, nn = tid & 63; float s = 0.f;
#pragma unroll
                for (int q = 0; q < 8; ++q) s += part[(q * 3 + r) * 64 + nn];
                a.MODV[(l * 3 + r) * 6144 + n0 + nn] = s + a.b_mod[l * 6144 + n0 + nn]; }
            __syncthreads();
        }
    }
    {
        float* scr = (float*)(lds + 16384) + wave * (64 * 33);
        const int gw = cu * 8 + wave, NGW = G * 8;
        transpose_items(a.w_in, D, NIN, a.WIN, 0, DEPTH, (size_t)D * NIN, (size_t)NIN * D, scr, gw, NGW, lane);
        transpose_items(a.w_out, D, D, a.WOUT, 0, DEPTH, (size_t)D * D, (size_t)D * D, scr, gw, NGW, lane);
        transpose_items(a.pool_w, 64, 64, a.POOLWT, 0, DEPTH * 4, (size_t)64 * 64, (size_t)64 * 64, scr, gw, NGW, lane);
        moe_weight_copies(a.gate, a.up, a.down, a.WGU, a.WD, scr, gw, NGW, lane);
    }
    __syncthreads();
}

namespace pool {
typedef float f32x16 __attribute__((ext_vector_type(16)));
typedef short bf16x8 __attribute__((ext_vector_type(8)));
constexpr int P = 72, O_X = 0  , O_DM = 81920  , O_OUT = 0  , OP = 264;
__device__ __forceinline__ int crow(int r, int hi) { return (r & 3) + 8 * (r >> 2) + 4 * hi; }
__device__ __forceinline__ void pool_phase(unsigned char* lds, const bf16_t* __restrict__ PROJ, const bf16_t* __restrict__ WT  , const float* __restrict__ pscale, bf16_t* __restrict__ MIX, int cu, int G) {
    const int tid = otid(), lane = tid & 63, r32 = lane & 31, hi = lane >> 5, w = __builtin_amdgcn_readfirstlane(tid >> 6);
    float* X = (float*)(lds + O_X); bf16_t* OUT = (bf16_t*)(lds + O_OUT);
    for (int u = cu; u < MT / 64; u += G) {
        const int row0 = u * 64, b = row0 / PB, p0 = row0 - b * PB; const bool is_ctx = p0 < CTXL;
        const int seg0 = b * PB + (is_ctx ? 0 : CTXL), len = is_ctx ? CTXL : SEQ, t0 = is_ctx ? p0 : p0 - CTXL;
#pragma unroll
        for (int it = 0; it < 5; ++it) { const int piece = tid + it * 512, rr = piece >> 5, pc = piece & 31, t = t0 - 8 + rr;
            u32x4 v = {0u, 0u, 0u, 0u};
            if (t >= 0 && t < len) v = *(const u32x4*)(PROJ + (size_t)(seg0 + t) * NIN + C_BP + pc * 8);
            float* x = X + rr * 256 + pc * 8;
            *(f32x4*)x = (f32x4){bflo(v.x), bfhi(v.x), bflo(v.y), bfhi(v.y)}; *(f32x4*)(x + 4) = (f32x4){bflo(v.z), bfhi(v.z), bflo(v.w), bfhi(v.w)}; }
        __syncthreads();
        {
            const int c = tid & 255, th = tid >> 8, g = c >> 6, hw = 1 << g;
            bf16_t* dm = (bf16_t*)(lds + O_DM) + g * 64 * P + (c & 63);
            for (int tt = 0; tt < 32; ++tt) { const int t = th * 32 + tt, tg = t0 + t;
                int lo = tg - hw; if (lo < 0) lo = 0; int hi2 = tg + hw; if (hi2 > len) hi2 = len;
                float s = 0.f;
                for (int q = lo; q < hi2; ++q) s += X[(q - t0 + 8) * 256 + c];
                dm[t * P] = (bf16_t)f2bf(s / (float)(hi2 - lo) - X[(t + 8) * 256 + c]); }
        }
        __syncthreads();
        {
            const int g = w >> 1, tb = w & 1;
            const bf16_t* A = (const bf16_t*)(lds + O_DM) + g * 64 * P + (tb * 32 + r32) * P + hi * 8;
#pragma unroll
            for (int eb = 0; eb < 2; ++eb) {
                const bf16_t* Bp = WT + (size_t)g * 4096 + (eb * 32 + r32) * 64 + hi * 8;
                f32x16 acc = {};
#pragma unroll
                for (int ks = 0; ks < 4; ++ks) acc = __builtin_amdgcn_mfma_f32_32x32x16_bf16(*(const bf16x8*)(A + ks * 16), *(const bf16x8*)(Bp + ks * 16), acc, 0, 0, 0);
                const int e = g * 64 + eb * 32 + r32; const float sc = pscale[e];
#pragma unroll
                for (int r = 0; r < 16; ++r) OUT[(tb * 32 + crow(r, hi)) * OP + e] = (bf16_t)f2bf(acc[r] * sc);
            }
        }
        __syncthreads();
#pragma unroll
        for (int it = 0; it < 4; ++it) { const int piece = tid + it * 512, t = piece >> 5, pc = piece & 31;
            *(u32x4*)(MIX + (size_t)(row0 + t) * D + 256 + pc * 8) = *(const u32x4*)(OUT + t * OP + pc * 8); }
        __syncthreads();
    }
}
}

#ifndef LAS
#define LAS __attribute__((address_space(3)))
#endif
__device__ __forceinline__ void norm1_phase(int cu, int G, const float* __restrict__ lat, const float* __restrict__ cx, const float* __restrict__ g, const float* __restrict__ modv, int sh_off, bf16_t* __restrict__ XN) {
    const int lane = otid() & 63, gw = cu * 8 + (otid() >> 6), NGW = G * 8;
    for (int row0 = gw * 4; row0 < MT; row0 += NGW * 4) {
        bool is_ctx; const size_t off = stream_off(row0, is_ctx);
        const int r = is_ctx ? 2 : row0 / PB;
        const f32x4* xr = (const f32x4*)((is_ctx ? cx : lat) + off) + lane;
        f32x4 v[4][4]; float ss[4];
#pragma unroll
        for (int q = 0; q < 4; ++q) { ss[q] = 0.f;
#pragma unroll
            for (int j = 0; j < 4; ++j) v[q][j] = xr[q * 256 + 64 * j]; }
        const float* mv = modv + r * 6144 + sh_off;
        f32x4 gs[4], sh[4];
#pragma unroll
        for (int j = 0; j < 4; ++j) { const int col = 4 * lane + 256 * j; gs[j] = *(const f32x4*)(g + col) * (*(const f32x4*)(mv + 1024 + col) + 1.f); sh[j] = *(const f32x4*)(mv + col); }
#pragma unroll
        for (int q = 0; q < 4; ++q) {
#pragma unroll
            for (int j = 0; j < 4; ++j) ss[q] += (v[q][j].x * v[q][j].x + v[q][j].y * v[q][j].y) + (v[q][j].z * v[q][j].z + v[q][j].w * v[q][j].w);
            const float rstd = 1.f / sqrtf(wave_sum(ss[q]) * (1.f / D) + EPS);
#pragma unroll
            for (int j = 0; j < 4; ++j) { const f32x4 o = v[q][j] * rstd * gs[j] + sh[j];
                u32x2 w; w.x = pk2(o.x, o.y); w.y = pk2(o.z, o.w);
                *(u32x2*)(XN + (size_t)(row0 + q) * D + 4 * lane + 256 * j) = w; } }
    }
}

__device__ __forceinline__ void norm2_router_phase(unsigned char* lds, int cu, int G, const float* __restrict__ lat, const float* __restrict__ cx, const float* __restrict__ g, const float* __restrict__ modv, int sh_off,
                                                   const float* __restrict__ router_w, const float* __restrict__ router_b, bf16_t* __restrict__ XN, unsigned* __restrict__ cnt, u32x4* __restrict__ LIST, int route_ctx) {
    const int tid = otid(), lane = tid & 63, wave = tid >> 6, gw = cu * 8 + wave, NGW = G * 8;
    float* RW = (float*)lds;
    u32x4* ENT = (u32x4*)(lds + 65536) + wave * 64;
    LAS unsigned* BC = (LAS unsigned*)((LAS unsigned char*)lds + 65536 + 8192);
#pragma unroll
    for (int it = 0; it < 8; ++it) { const int p = tid + it * 512, col = p >> 2, q = p & 3; const f32x4 w4 = *(const f32x4*)(router_w + (size_t)col * 16 + 4 * q);
        RW[(4 * q + 0) * 1024 + col] = w4.x; RW[(4 * q + 1) * 1024 + col] = w4.y; RW[(4 * q + 2) * 1024 + col] = w4.z; RW[(4 * q + 3) * 1024 + col] = w4.w; }
    if (tid < 48) BC[tid] = 0u;
    __syncthreads();
    int nent = 0;
    f32x4 vn[4];
    { int row = gw < MT ? gw : 0; bool ic; const size_t off = stream_off(row, ic); const f32x4* xr = (const f32x4*)((ic ? cx : lat) + off) + lane;
#pragma unroll
      for (int j = 0; j < 4; ++j) vn[j] = xr[64 * j]; }
    for (int row = gw; row < MT; row += NGW) {
        f32x4 v[4];
#pragma unroll
        for (int j = 0; j < 4; ++j) v[j] = vn[j];
        { const int nr = row + NGW < MT ? row + NGW : row; bool ic; const size_t off = stream_off(nr, ic); const f32x4* xr = (const f32x4*)((ic ? cx : lat) + off) + lane;
#pragma unroll
          for (int j = 0; j < 4; ++j) vn[j] = xr[64 * j]; }
        bool is_ctx; (void)stream_off(row, is_ctx);
        if (is_ctx && !route_ctx) continue;
        const int r = is_ctx ? 2 : row / PB;
        float ss = 0.f;
#pragma unroll
        for (int j = 0; j < 4; ++j) ss += (v[j].x * v[j].x + v[j].y * v[j].y) + (v[j].z * v[j].z + v[j].w * v[j].w);
        const float rstd = 1.f / sqrtf(wave_sum(ss) * (1.f / D) + EPS);
        const float* mv = modv + r * 6144 + sh_off;
#pragma unroll
        for (int j = 0; j < 4; ++j) { const int col = 4 * lane + 256 * j;
            const f32x4 gg = *(const f32x4*)(g + col), sh = *(const f32x4*)(mv + col), sc = *(const f32x4*)(mv + 1024 + col);
            v[j] = v[j] * rstd * gg * (sc + 1.f) + sh;
            u32x2 w; w.x = pk2(v[j].x, v[j].y); w.y = pk2(v[j].z, v[j].w);
            *(u32x2*)(XN + (size_t)row * D + col) = w; }
        float sc_[16], sel[16];
#pragma unroll
        for (int e = 0; e < 16; ++e) { float a = 0.f;
#pragma unroll
            for (int j = 0; j < 4; ++j) { const f32x4 w4 = *(const f32x4*)(RW + e * 1024 + 256 * j + 4 * lane); a += (v[j].x * w4.x + v[j].y * w4.y) + (v[j].z * w4.z + v[j].w * w4.w); }
            a = wave_sum(a); sc_[e] = 1.f / (1.f + __expf(-a)); sel[e] = sc_[e] + router_b[e]; }
        float gs[4]; int gi1[4], gi2[4]; float gw1[4], gw2[4];
#pragma unroll
        for (int q = 0; q < 4; ++q) { float v1 = -INFINITY, v2 = -INFINITY; int i1 = 0, i2 = 0; float s1 = 0.f, s2 = 0.f;
#pragma unroll
            for (int k = 0; k < 4; ++k) { const float x = sel[4 * q + k], sx = sc_[4 * q + k];
                if (x > v1) { v2 = v1; i2 = i1; s2 = s1; v1 = x; i1 = 4 * q + k; s1 = sx; } else if (x > v2) { v2 = x; i2 = 4 * q + k; s2 = sx; } }
            gs[q] = v1 + v2; gi1[q] = i1; gi2[q] = i2; gw1[q] = s1; gw2[q] = s2; }
        float bv = gs[0]; int e0 = gi1[0], e1 = gi2[0]; float w0 = gw1[0], w1 = gw2[0];
#pragma unroll
        for (int q = 1; q < 4; ++q) if (gs[q] > bv) { bv = gs[q]; e0 = gi1[q]; e1 = gi2[q]; w0 = gw1[q]; w1 = gw2[q]; }
        const float ws = w0 + w1; w0 /= ws; w1 /= ws;
        {
            const int gq = e0 >> 2; int a = e0 & 3, c = e1 & 3; float wa = w0, wc = w1;
            if (a > c) { const int ti = a; a = c; c = ti; const float tf = wa; wa = wc; wc = tf; }
            const int pi = (a == 0) ? (c - 1) : (a == 1 ? c + 1 : 5);
            const int bk = gq * 6 + pi;
            if (lane == 0) { const unsigned loc = __hip_atomic_fetch_add(BC + bk, 1u, __ATOMIC_RELAXED, __HIP_MEMORY_SCOPE_WORKGROUP);
                u32x4 sv; sv.x = (unsigned)bk | (loc << 8); sv.y = (unsigned)row; sv.z = __float_as_uint(wa); sv.w = __float_as_uint(wc); ENT[nent] = sv; }
            ++nent; }
    }
    __syncthreads();
    if (tid < 24) { const unsigned n = BC[tid]; BC[24 + tid] = n ? __hip_atomic_fetch_add(cnt + tid, n, __ATOMIC_RELAXED, __HIP_MEMORY_SCOPE_AGENT) : 0u; }
    __syncthreads();
    if (lane < nent) { const u32x4 en = ENT[lane]; const unsigned bk = en.x & 255u, slot = BC[24 + bk] + (en.x >> 8);
        u32x4 sv; sv.x = en.y; sv.y = en.z; sv.z = en.w; sv.w = 0u; LIST[(size_t)bk * MT + slot] = sv; }
    __syncthreads();
}

__device__ __forceinline__ void post_phase(int cu, int G, const bf16_t* __restrict__ PROJ, const float* __restrict__ qg, const float* __restrict__ kg, const float* __restrict__ COS, const float* __restrict__ SIN,
                                              bf16_t* __restrict__ QN, bf16_t* __restrict__ KN) {
    const int lane = otid() & 63, gw = cu * 8 + (otid() >> 6), NGW = G * 8;
    const int d0 = (lane & 7) * 8, jk = lane & 31;
    float qgv[8];
#pragma unroll
    for (int i = 0; i < 8; ++i) qgv[i] = qg[d0 + i];
    const float kg0 = kg[2 * jk], kg1 = kg[2 * jk + 1];
    for (int row0 = gw * 4; row0 < MT; row0 += NGW * 4) {
        const int b = row0 / PB, p0 = row0 - b * PB; const bool is_ctx = p0 < CTXL; const int t0 = is_ctx ? 0 : p0 - CTXL;
        u32x4 wq[4]; unsigned wk[4]; f32x4 cq[4], sq[4]; float ck[4], sk[4];
#pragma unroll
        for (int q = 0; q < 4; ++q) { const bf16_t* pr = PROJ + (size_t)(row0 + q) * NIN;
            wq[q] = *(const u32x4*)(pr + C_CQ + lane * 8); wk[q] = *(const unsigned*)(pr + C_CK + lane * 2);
            const int t = is_ctx ? 0 : t0 + q;
            cq[q] = *(const f32x4*)(COS + t * 32 + (d0 >> 1)); sq[q] = *(const f32x4*)(SIN + t * 32 + (d0 >> 1)); ck[q] = COS[t * 32 + jk]; sk[q] = SIN[t * 32 + jk]; }
#pragma unroll
        for (int q = 0; q < 4; ++q) {
            {
                const u32x4 w = wq[q];
                float x[8] = {bflo(w.x), bfhi(w.x), bflo(w.y), bfhi(w.y), bflo(w.z), bfhi(w.z), bflo(w.w), bfhi(w.w)};
                float ss = 0.f;
#pragma unroll
                for (int i = 0; i < 8; ++i) ss += x[i] * x[i];
                ss = xsum<1>(ss); ss = xsum<2>(ss); ss = xsum<4>(ss);
                const float rstd = 1.f / sqrtf(ss * (1.f / 64.f) + EPS);
#pragma unroll
                for (int i = 0; i < 8; ++i) x[i] = x[i] * rstd * qgv[i];
                if (!is_ctx) {
#pragma unroll
                    for (int i = 0; i < 4; ++i) { const float cs = cq[q][i], sn = sq[q][i];
                        const float x1 = x[2 * i], x2 = x[2 * i + 1]; x[2 * i] = x1 * cs - x2 * sn; x[2 * i + 1] = x1 * sn + x2 * cs; } }
                u32x4 o; o.x = pk2(x[0] * C2, x[1] * C2); o.y = pk2(x[2] * C2, x[3] * C2); o.z = pk2(x[4] * C2, x[5] * C2); o.w = pk2(x[6] * C2, x[7] * C2);
                *(u32x4*)(QN + (size_t)(row0 + q) * 512 + lane * 8) = o;
            }
            {
                float x1 = bflo(wk[q]), x2 = bfhi(wk[q]);
                float ss = x1 * x1 + x2 * x2;
                ss = xsum<1>(ss); ss = xsum<2>(ss); ss = xsum<4>(ss); ss = xsum<8>(ss); ss = xsum<16>(ss);
                const float rstd = 1.f / sqrtf(ss * (1.f / 64.f) + EPS);
                x1 = x1 * rstd * kg0; x2 = x2 * rstd * kg1;
                if (!is_ctx) { const float cs = ck[q], sn = sk[q]; const float a = x1 * cs - x2 * sn, c = x1 * sn + x2 * cs; x1 = a; x2 = c; }
                *(unsigned*)(KN + (size_t)(row0 + q) * 128 + lane * 2) = pk2(x1, x2);
            }
        }
    }
}

namespace hg {
typedef float f32x16 __attribute__((ext_vector_type(16)));
typedef short bf16x8 __attribute__((ext_vector_type(8)));
typedef short s16x4 __attribute__((ext_vector_type(4)));
typedef float f32x2 __attribute__((ext_vector_type(2)));
constexpr int P = 72;
constexpr int O_ZB = 0, O_ZQ = 32768, O_VT = 40960, O_QH = 50176, O_QT = 68608, O_KH = 87040, O_ST = 105472, O_SSQ = 123904, O_OUT = 0  , O_TOT = 0, LDS_BYTES = 124416;
constexpr int MSZ = 64 * P * 2;
constexpr int NCH = PB / 64;
__device__ __forceinline__ int crow(int r, int hi) { return (r & 3) + 8 * (r >> 2) + 4 * hi; }
__device__ __forceinline__ unsigned cvtpk(float lo, float hi) { typedef __bf16 b2 __attribute__((ext_vector_type(2))); f32x2 v = {lo, hi}; b2 b = __builtin_convertvector(v, b2); return __builtin_bit_cast(unsigned, b); }
__device__ __forceinline__ float clampe(float e) { return fminf(fmaxf(e, -80.f), 80.f); }

template <bool FULL> __device__ __forceinline__ void prep(unsigned char* lds, const bf16_t* __restrict__ PROJ, const float* __restrict__ LBFl, int row0, int h) {
    const int tid = otid();
    float* ZB = (float*)(lds + O_ZB); bf16_t* ZQ = (bf16_t*)(lds + O_ZQ); bf16_t* VT = (bf16_t*)(lds + O_VT);
    {
        const int t = tid >> 3, pc = tid & 7;
        const bf16_t* pr = PROJ + (size_t)(row0 + t) * NIN + h * 64 + pc * 8;
        const u32x4 wf = *(const u32x4*)(pr + C_AFF), wb = *(const u32x4*)(pr + C_AFB), wv = *(const u32x4*)(pr + C_AI);
        float* zf = ZB + t * 64 + pc * 8; float* zb = ZB + 4096 + t * 64 + pc * 8;
        *(f32x4*)zf = (f32x4){bflo(wf.x), bfhi(wf.x), bflo(wf.y), bfhi(wf.y)}; *(f32x4*)(zf + 4) = (f32x4){bflo(wf.z), bfhi(wf.z), bflo(wf.w), bfhi(wf.w)};
        *(f32x4*)zb = (f32x4){bflo(wb.x), bfhi(wb.x), bflo(wb.y), bfhi(wb.y)}; *(f32x4*)(zb + 4) = (f32x4){bflo(wb.z), bfhi(wb.z), bflo(wb.w), bfhi(wb.w)};
        bf16_t* vt = VT + (pc * 8) * P + t;
        vt[0 * P] = (bf16_t)(wv.x & 0xffffu); vt[1 * P] = (bf16_t)(wv.x >> 16); vt[2 * P] = (bf16_t)(wv.y & 0xffffu); vt[3 * P] = (bf16_t)(wv.y >> 16);
        vt[4 * P] = (bf16_t)(wv.z & 0xffffu); vt[5 * P] = (bf16_t)(wv.z >> 16); vt[6 * P] = (bf16_t)(wv.w & 0xffffu); vt[7 * P] = (bf16_t)(wv.w >> 16);
        if (FULL) { const u32x4 wq = *(const u32x4*)(pr + C_AQ); *(u32x4*)(ZQ + t * 64 + pc * 8) = wq; }
    }
    __syncthreads();
    if (tid < 128) {
        const int dir = tid >> 6, i = tid & 63;
        const float lbf = LBFl[dir * 256 + h * 64 + i], oml = 1.f - lbf;
        float* zb = ZB + dir * 4096 + i; float acc = 0.f;
        if (dir == 0) { for (int t = 0; t < 64; ++t) { const float z = zb[t * 64]; const float sg = 1.f / (1.f + __expf(-z)); acc += __logf(lbf + oml * sg); zb[t * 64] = acc; } }
        else { for (int t = 63; t >= 0; --t) { const float z = zb[t * 64]; const float sg = 1.f / (1.f + __expf(-z)); acc += __logf(lbf + oml * sg); zb[t * 64] = acc; } }
    }
    __syncthreads();
#pragma unroll
    for (int it = 0; it < 2; ++it) {
        const int item = tid + it * 512, dir = item >> 9, t = (item >> 3) & 63, i0 = (item & 7) * 8;
        const float* B = ZB + dir * 4096;
        const int tp = dir == 0 ? t - 1 : t + 1; const bool edge = dir == 0 ? (t == 0) : (t == 63);
        const int tref = dir == 0 ? 31 : 32;
        float bc[8], bp[8], br[8];
        { const f32x4 a = *(const f32x4*)(B + t * 64 + i0), c = *(const f32x4*)(B + t * 64 + i0 + 4); bc[0] = a.x; bc[1] = a.y; bc[2] = a.z; bc[3] = a.w; bc[4] = c.x; bc[5] = c.y; bc[6] = c.z; bc[7] = c.w; }
        { const int tq = edge ? t : tp; const f32x4 a = *(const f32x4*)(B + tq * 64 + i0), c = *(const f32x4*)(B + tq * 64 + i0 + 4);
          bp[0] = a.x; bp[1] = a.y; bp[2] = a.z; bp[3] = a.w; bp[4] = c.x; bp[5] = c.y; bp[6] = c.z; bp[7] = c.w;
          if (edge) {
#pragma unroll
              for (int k = 0; k < 8; ++k) bp[k] = 0.f; } }
        { const f32x4 a = *(const f32x4*)(B + tref * 64 + i0), c = *(const f32x4*)(B + tref * 64 + i0 + 4); br[0] = a.x; br[1] = a.y; br[2] = a.z; br[3] = a.w; br[4] = c.x; br[5] = c.y; br[6] = c.z; br[7] = c.w; }
        float kh[8];
#pragma unroll
        for (int k = 0; k < 8; ++k) { const float kk = 1.f - __expf(bc[k] - bp[k]); kh[k] = kk * __expf(clampe(br[k] - bc[k])); }
        if (!FULL) {
            bf16_t* kt = (bf16_t*)(lds + O_KH + dir * MSZ) + i0 * P + t;
#pragma unroll
            for (int k = 0; k < 8; ++k) kt[k * P] = (bf16_t)f2bf(kh[k]);
        } else {
            u32x4 w; w.x = cvtpk(kh[0], kh[1]); w.y = cvtpk(kh[2], kh[3]); w.z = cvtpk(kh[4], kh[5]); w.w = cvtpk(kh[6], kh[7]);
            *(u32x4*)((bf16_t*)(lds + O_KH + dir * MSZ) + t * P + i0) = w;
            const u32x4 wq = *(const u32x4*)(ZQ + t * 64 + i0);
            float q[8] = {silu(bflo(wq.x)), silu(bfhi(wq.x)), silu(bflo(wq.y)), silu(bfhi(wq.y)), silu(bflo(wq.z)), silu(bfhi(wq.z)), silu(bflo(wq.w)), silu(bfhi(wq.w))};
            float qh[8], qt[8];
#pragma unroll
            for (int k = 0; k < 8; ++k) { qh[k] = q[k] * __expf(clampe(bc[k] - br[k])); qt[k] = q[k] * __expf(bc[k]); }
            w.x = cvtpk(qh[0], qh[1]); w.y = cvtpk(qh[2], qh[3]); w.z = cvtpk(qh[4], qh[5]); w.w = cvtpk(qh[6], qh[7]);
            *(u32x4*)((bf16_t*)(lds + O_QH + dir * MSZ) + t * P + i0) = w;
            w.x = cvtpk(qt[0], qt[1]); w.y = cvtpk(qt[2], qt[3]); w.z = cvtpk(qt[4], qt[5]); w.w = cvtpk(qt[6], qt[7]);
            *(u32x4*)((bf16_t*)(lds + O_QT + dir * MSZ) + t * P + i0) = w;
        }
    }
    __syncthreads();
}

__device__ __forceinline__ void h1_phase(unsigned char* lds, const bf16_t* __restrict__ PROJ, const float* __restrict__ LBFl, bf16_t* __restrict__ UT, float* __restrict__ DEC, int cu, int G) {
    const int tid = otid(), lane = tid & 63, r32 = lane & 31, hi = lane >> 5, w = __builtin_amdgcn_readfirstlane(tid >> 6);
    for (int u = cu; u < BATCH * NCH * 4; u += G) {
        const int h = u & 3, bc = u >> 2, b = bc / NCH, cp = bc - b * NCH, row0 = b * PB + cp * 64;
        prep<false>(lds, PROJ, LBFl, row0, h);
        const float* ZB = (const float*)(lds + O_ZB);
        {
            const int dir = w >> 2, jb = (w >> 1) & 1, ib = w & 1;
            const bf16_t* VT = (const bf16_t*)(lds + O_VT) + (jb * 32 + r32) * P + hi * 8;
            const bf16_t* KT = (const bf16_t*)(lds + O_KH + dir * MSZ) + (ib * 32 + r32) * P + hi * 8;
            f32x16 acc = {};
#pragma unroll
            for (int ks = 0; ks < 4; ++ks) acc = __builtin_amdgcn_mfma_f32_32x32x16_bf16(*(const bf16x8*)(VT + ks * 16), *(const bf16x8*)(KT + ks * 16), acc, 0, 0, 0);
            const int i = ib * 32 + r32;
            const float btot = ZB[dir * 4096 + (dir == 0 ? 63 : 0) * 64 + i], bref = ZB[dir * 4096 + (dir == 0 ? 31 : 32) * 64 + i];
            const float sc = __expf(btot - bref);
            const int chain = (b * 4 + h) * 2 + dir;
            bf16_t* ut = UT + ((size_t)chain * NCH + cp) * 4096 + i;
#pragma unroll
            for (int r = 0; r < 16; ++r) ut[(jb * 32 + crow(r, hi)) * 64] = (bf16_t)f2bf(acc[r] * sc);
        }
        if (tid < 128) { const int dir = tid >> 6, i = tid & 63; const int chain = (b * 4 + h) * 2 + dir;
            DEC[((size_t)chain * NCH + cp) * 64 + i] = __expf(ZB[dir * 4096 + (dir == 0 ? 63 : 0) * 64 + i]); }
        __syncthreads();
    }
}

__device__ __forceinline__ void h2_phase(unsigned char* lds, const bf16_t* __restrict__ UT, const float* __restrict__ DEC, bf16_t* __restrict__ ST, int cu, int G) {
    const int tid = otid(), seg = tid >> 7, e = tid & 127, jl = e >> 5, i = (e & 31) * 2;
    f32x4* TOT = (f32x4*)(lds + O_TOT);
    for (int task = cu; task < 256; task += G) {
        const int chain = task >> 4, j = (task & 15) * 4 + jl, dir = chain & 1;
        const size_t cbase = (size_t)chain * NCH;
        float S0 = 0.f, S1 = 0.f, P0 = 1.f, P1 = 1.f;
#pragma unroll 11
        for (int kk = 0; kk < 33; ++kk) { const int k = seg * 33 + kk, cp = dir == 0 ? k : (k < 4 ? 3 - k : 135 - k);
            const unsigned u = *(const unsigned*)(UT + (cbase + cp) * 4096 + j * 64 + i); const f32x2 d = *(const f32x2*)(DEC + (cbase + cp) * 64 + i);
            S0 = d.x * S0 + bflo(u); S1 = d.y * S1 + bfhi(u); P0 *= d.x; P1 *= d.y; }
        TOT[seg * 128 + e] = (f32x4){S0, S1, P0, P1};
        __syncthreads();
        float s0 = 0.f, s1 = 0.f;
#pragma unroll
        for (int sp = 0; sp < 3; ++sp) if (sp < seg) { const f32x4 t = TOT[sp * 128 + e]; s0 = t.z * s0 + t.x; s1 = t.w * s1 + t.y; }
#pragma unroll 11
        for (int kk = 0; kk < 33; ++kk) { const int k = seg * 33 + kk, cp = dir == 0 ? k : (k < 4 ? 3 - k : 135 - k);
            const unsigned u = *(const unsigned*)(UT + (cbase + cp) * 4096 + j * 64 + i); const f32x2 d = *(const f32x2*)(DEC + (cbase + cp) * 64 + i);
            *(unsigned*)(ST + (cbase + cp) * 4096 + j * 64 + i) = pk2(s0, s1);
            s0 = d.x * s0 + bflo(u); s1 = d.y * s1 + bfhi(u); }
        __syncthreads();
    }
}

__device__ __forceinline__ void h3_phase(unsigned char* lds, const bf16_t* __restrict__ PROJ, const float* __restrict__ LBFl, const bf16_t* __restrict__ ST, const float* __restrict__ ng, bf16_t* __restrict__ MIX, int cu, int G) {
    const int tid = otid(), lane = tid & 63, r32 = lane & 31, hi = lane >> 5, w = __builtin_amdgcn_readfirstlane(tid >> 6);
    for (int u = cu; u < BATCH * NCH * 4; u += G) {
        const int h = u & 3, bc = u >> 2, b = bc / NCH, cp = bc - b * NCH, row0 = b * PB + cp * 64;
        {
            const int j = tid >> 3, ic = (tid & 7) * 8;
#pragma unroll
            for (int dir = 0; dir < 2; ++dir) { const int chain = (b * 4 + h) * 2 + dir;
                const u32x4 sv = *(const u32x4*)(ST + ((size_t)chain * NCH + cp) * 4096 + j * 64 + ic);
                *(u32x4*)((bf16_t*)(lds + O_ST + dir * MSZ) + j * P + ic) = sv; }
        }
        prep<true>(lds, PROJ, LBFl, row0, h);
        float* SSQ = (float*)(lds + O_SSQ); bf16_t* OUT = (bf16_t*)(lds + O_OUT);
        f32x16 ot = {};
        const int jb = (w >> 1) & 1, tb = w & 1;
        if (w < 4) {
            const bf16_t* VT = (const bf16_t*)(lds + O_VT) + (jb * 32 + r32) * P;
#pragma unroll
            for (int sb = 0; sb < 2; ++sb) {
                f32x16 xf = {}, xb = {};
                const bf16_t* QF = (const bf16_t*)(lds + O_QH) + (tb * 32 + r32) * P + hi * 8; const bf16_t* QB = QF + 64 * P;
                const bf16_t* KF = (const bf16_t*)(lds + O_KH) + (sb * 32 + r32) * P + hi * 8; const bf16_t* KB = KF + 64 * P;
                if (sb <= tb) {
#pragma unroll
                    for (int ks = 0; ks < 4; ++ks) xf = __builtin_amdgcn_mfma_f32_32x32x16_bf16(*(const bf16x8*)(KF + ks * 16), *(const bf16x8*)(QF + ks * 16), xf, 0, 0, 0); }
                if (sb >= tb) {
#pragma unroll
                    for (int ks = 0; ks < 4; ++ks) xb = __builtin_amdgcn_mfma_f32_32x32x16_bf16(*(const bf16x8*)(KB + ks * 16), *(const bf16x8*)(QB + ks * 16), xb, 0, 0, 0); }
                float x[16];
#pragma unroll
                for (int r = 0; r < 16; ++r) { const int s = crow(r, hi), t = r32;
                    const float vf = (sb < tb || (sb == tb && s <= t)) ? xf[r] : 0.f, vb = (sb > tb || (sb == tb && s >= t)) ? xb[r] : 0.f; x[r] = vf + vb; }
#pragma unroll
                for (int sp = 0; sp < 2; ++sp) {
                    u32x4 xw; xw.x = cvtpk(x[8 * sp + 0], x[8 * sp + 1]); xw.y = cvtpk(x[8 * sp + 2], x[8 * sp + 3]); xw.z = cvtpk(x[8 * sp + 4], x[8 * sp + 5]); xw.w = cvtpk(x[8 * sp + 6], x[8 * sp + 7]);
                    const s16x4 v0 = *(const s16x4*)(VT + sb * 32 + 16 * sp + 4 * hi), v1 = *(const s16x4*)(VT + sb * 32 + 16 * sp + 8 + 4 * hi);
                    const bf16x8 va = {v0[0], v0[1], v0[2], v0[3], v1[0], v1[1], v1[2], v1[3]};
                    ot = __builtin_amdgcn_mfma_f32_32x32x16_bf16(va, __builtin_bit_cast(bf16x8, xw), ot, 0, 0, 0); }
            }
#pragma unroll
            for (int dir = 0; dir < 2; ++dir) {
                const bf16_t* SA = (const bf16_t*)(lds + O_ST + dir * MSZ) + (jb * 32 + r32) * P + hi * 8; const bf16_t* QT = (const bf16_t*)(lds + O_QT + dir * MSZ) + (tb * 32 + r32) * P + hi * 8;
#pragma unroll
                for (int ks = 0; ks < 4; ++ks) ot = __builtin_amdgcn_mfma_f32_32x32x16_bf16(*(const bf16x8*)(SA + ks * 16), *(const bf16x8*)(QT + ks * 16), ot, 0, 0, 0); }
            float part = 0.f;
#pragma unroll
            for (int r = 0; r < 16; ++r) part += ot[r] * ot[r];
            part = xsum<32>(part);
            if (hi == 0) SSQ[jb * 64 + tb * 32 + r32] = part;
        }
        __syncthreads();
        if (w < 4) { const int t = tb * 32 + r32; const float rstd = 1.f / sqrtf((SSQ[t] + SSQ[64 + t]) * (1.f / 64.f) + EPS);
#pragma unroll
            for (int r = 0; r < 16; ++r) { const int j = jb * 32 + crow(r, hi); OUT[t * P + j] = (bf16_t)f2bf(ot[r] * rstd * ng[j]); } }
        __syncthreads();
        {
            const int t = tid >> 3, jc = (tid & 7) * 8;
            const u32x4 y = *(const u32x4*)(OUT + t * P + jc); const u32x4 g = *(const u32x4*)(PROJ + (size_t)(row0 + t) * NIN + C_AG + h * 64 + jc);
            u32x4 o; o.x = pk2(bflo(y.x) * silu(bflo(g.x)), bfhi(y.x) * silu(bfhi(g.x))); o.y = pk2(bflo(y.y) * silu(bflo(g.y)), bfhi(y.y) * silu(bfhi(g.y)));
            o.z = pk2(bflo(y.z) * silu(bflo(g.z)), bfhi(y.z) * silu(bfhi(g.z))); o.w = pk2(bflo(y.w) * silu(bflo(g.w)), bfhi(y.w) * silu(bfhi(g.w)));
            *(u32x4*)(MIX + (size_t)(row0 + t) * D + h * 64 + jc) = o;
        }
        __syncthreads();
    }
}
}
__device__ __forceinline__ int vcu_of(int bx, int G) { return (G % 8 == 0) ? (bx % 8) * (G / 8) + bx / 8 : bx; }
__device__ __forceinline__ void attn_phase(char* lds, const bf16_t* QN, const bf16_t* KN, const bf16_t* PROJ, bf16_t* MIX, float neg_ref, int vcu, int G, bool with_ctx) {
    using attn_body::bf16;
    const int upc = (512 + G - 1) / G;
    const int nun = upc + ((with_ctx && vcu < 16) ? 1 : 0);
    for (int i = 0; i < nun; ++i) {
        int b, h, nt; size_t q0;
        if (i < upc) { const int u = vcu * upc + i; if (u >= 512) continue; const int combo = u >> 7; b = combo >> 1; h = (combo & 1) * 4 + ((u >> 5) & 3); q0 = (size_t)b * PB + CTXL + (size_t)(u & 31) * 256; nt = PB / 64; }
        else { b = vcu >> 3; h = vcu & 7; q0 = (size_t)b * PB; nt = CTXL / 64; }
        const int kvh = h >> 2; const size_t k0 = (size_t)b * PB;
        attn_body::attn_unit((const bf16*)QN + q0 * 512 + h * 64, (const bf16*)KN + k0 * 128 + kvh * 64, (const bf16*)PROJ + k0 * NIN + C_CV + kvh * 64, (bf16*)MIX + q0 * 1024 + 512 + h * 64, nt, neg_ref, lds);
    }
}
namespace pg8 {
struct EpiResid {
    static constexpr bool PERM = false, AFTER_DRAIN = false;
    const float* src_lat; const float* src_ctx; float* dst_lat; float* dst_ctx; const float* modv; int ga_off; int pad;
    __device__ __forceinline__ void operator()(const f32x4 (&acc)[2][2][4][2], const Unit& u, int wr, int wc, int fr, int fq) const {
        asm volatile("" : "+v"(fr), "+v"(fq));
        const int b = u.pm / TPB, w = u.pm - b * TPB;
        const size_t base = (w == 0) ? (size_t)b * CTXL * D : ((size_t)b * SEQ + (size_t)(w - 1) * 256) * D;
        const float* s = ((w == 0) ? src_ctx : src_lat) + base; float* d = ((w == 0) ? dst_ctx : dst_lat) + base;
        const float* ga = modv + ((w == 0) ? 2 : b) * 6144 + ga_off;
        const int row0 = wr * 64 + fr, col0 = u.pn * BM + wc * 32 + 4 * fq;
        f32x4 gv[2][2];
#pragma unroll
        for (int bj = 0; bj < 2; ++bj)
#pragma unroll
            for (int n = 0; n < 2; ++n) gv[bj][n] = *(const f32x4*)(ga + col0 + bj * HALF + n * 16);
#pragma unroll
        for (int ai = 0; ai < 2; ++ai)
#pragma unroll
            for (int m = 0; m < 4; ++m) { const size_t off = (size_t)(row0 + ai * HALF + m * 16) * D + col0;
#pragma unroll
                for (int bj = 0; bj < 2; ++bj)
#pragma unroll
                    for (int n = 0; n < 2; ++n) *(f32x4*)(d + off + bj * HALF + n * 16) = *(const f32x4*)(s + off + bj * HALF + n * 16) + gv[bj][n] * acc[ai][bj][m][n]; }
    }
};
}


namespace pg8 {
struct MUnit { int pm, pn, nrows, lbase, e0, e1; };
__device__ __forceinline__ void build_tiles(PG8_LAS int* TT, const unsigned* cnt) {
    if (otid() == 0) { int off = 0;
        for (int bk = 0; bk < 24; ++bk) { const int c = (int)__hip_atomic_load(cnt + bk, __ATOMIC_RELAXED, __HIP_MEMORY_SCOPE_AGENT); const int nb = (c + 255) >> 8;
            for (int ti = 0; ti < nb; ++ti) { const int rem = c - ti * 256; TT[4 + 4 * off + 0] = bk; TT[4 + 4 * off + 1] = ti; TT[4 + 4 * off + 2] = rem < 256 ? rem : 256; TT[4 + 4 * off + 3] = 0; ++off; } }
        TT[0] = off; }
    __syncthreads();
}
template <int NPN  > struct MoeOrder {
    const PG8_LAS int* TT; int G, c;
    __device__ __forceinline__ bool next(int i, MUnit& u) const {
        const int L = i * G + c, tile = L / NPN; if (tile >= TT[0]) return false;
        const int bk = TT[4 + 4 * tile], ti = TT[4 + 4 * tile + 1];
        u.pm = tile; u.pn = L - tile * NPN; u.nrows = TT[4 + 4 * tile + 2]; u.lbase = bk * MT + ti * 256;
        const int g = bk / 6, pi = bk - g * 6; const int lo = pi < 3 ? 0 : (pi < 5 ? 1 : 2), hi = pi < 3 ? pi + 1 : (pi < 5 ? pi - 1 : 3);
        u.e0 = 4 * g + lo; u.e1 = 4 * g + hi; return true;
    }
};
struct Src1 {
    const bf16_t* XN; const bf16_t* WGU; const u32x4* LIST;
    __device__ __forceinline__ const char* a_base(const MUnit&) const { return (const char*)XN; }
    __device__ __forceinline__ void a_offsets(const MUnit& u, const int (&RA)[2], const int (&CA)[2], unsigned (&ao)[2][2]) const {
#pragma unroll
        for (int h = 0; h < 2; ++h)
#pragma unroll
            for (int i = 0; i < 2; ++i) { const int r = h * HALF + RA[i]; const unsigned row = r < u.nrows ? LIST[u.lbase + r].x : 0u; ao[h][i] = (row * (unsigned)D + (unsigned)CA[i]) * 2u; }
    }
    __device__ __forceinline__ const char* b_base(const MUnit& u, int seg) const { const int e = (u.pn >> 2) ? u.e1 : u.e0;
        return (const char*)(WGU + ((size_t)e * 1024 + (size_t)(u.pn & 3) * 256) * D) + (seg ? (size_t)(D / 2) * 2 : 0); }
    __device__ __forceinline__ void prefetch_rows(const MUnit& u, const int (&)[2], PG8_LAS unsigned char* rows, int wid) const {
        int t2 = otid(); asm volatile("" : "+v"(t2));
        int RA[2];
#pragma unroll
        for (int i = 0; i < 2; ++i) { int R, C; stage_rc(t2 * 16 + i * 8192, R, C); RA[i] = R; }
#pragma unroll
        for (int h = 0; h < 2; ++h)
#pragma unroll
            for (int i = 0; i < 2; ++i) { const int r = h * HALF + RA[i];
                __builtin_amdgcn_global_load_lds((const unsigned*)&LIST[u.lbase + r], (PG8_LAS unsigned*)(rows + ((h * 2 + i) * 8 + wid) * 256), 4, 0, 0); }
    }
    __device__ __forceinline__ void reload_offsets(const MUnit& u, const int (&)[2], const int (&)[2], const PG8_LAS unsigned char* rows, int wid, int lane, unsigned (&ao)[2][2]) const {
        int t2 = otid(); asm volatile("" : "+v"(t2));
        int RA[2], CA[2];
#pragma unroll
        for (int i = 0; i < 2; ++i) { int R, C; stage_rc(t2 * 16 + i * 8192, R, C); RA[i] = R; CA[i] = C; }
#pragma unroll
        for (int h = 0; h < 2; ++h)
#pragma unroll
            for (int i = 0; i < 2; ++i) { const int r = h * HALF + RA[i]; const unsigned v = *(const PG8_LAS unsigned*)(rows + ((h * 2 + i) * 8 + wid) * 256 + lane * 4);
                const unsigned row = r < u.nrows ? v : 0u; ao[h][i] = (row * (unsigned)D + (unsigned)CA[i]) * 2u; }
    }
};
struct Src2 {
    const bf16_t* ACT2; const bf16_t* WD;
    __device__ __forceinline__ const char* a_base(const MUnit& u) const { return (const char*)(ACT2 + (size_t)u.pm * 256 * 1024); }
    __device__ __forceinline__ void a_offsets(const MUnit&, const int (&RA)[2], const int (&CA)[2], unsigned (&ao)[2][2]) const {
#pragma unroll
        for (int h = 0; h < 2; ++h)
#pragma unroll
            for (int i = 0; i < 2; ++i) ao[h][i] = (unsigned)((h * HALF + RA[i]) * 1024 + CA[i]) * 2u;
    }
    __device__ __forceinline__ const char* b_base(const MUnit& u, int seg) const { const int e = seg ? u.e1 : u.e0; return (const char*)(WD + ((size_t)e * 1024 + (size_t)u.pn * 256) * DE); }
    __device__ __forceinline__ void prefetch_rows(const MUnit&, const int (&)[2], PG8_LAS unsigned char*, int) const {}
    __device__ __forceinline__ void reload_offsets(const MUnit&, const int (&)[2], const int (&)[2], const PG8_LAS unsigned char*, int, int, unsigned (&)[2][2]) const {}
};
struct EpiGateUp2 {
    static constexpr bool PERM = true;
    bf16_t* ACT2; const u32x4* LIST;
    __device__ __forceinline__ void operator()(const f32x4 (&acc)[2][2][4][2], const MUnit& u, int wr, int wc, int fr, int fq) const {
        asm volatile("" : "+v"(fr), "+v"(fq));
        const int slot = u.pn >> 2, colA = slot * DE + (u.pn & 3) * HALF + wc * 32 + 8 * fq;
        const unsigned* lw = (const unsigned*)(LIST + u.lbase + wr * 64 + fr) + 1 + slot;
#pragma unroll
        for (int ai = 0; ai < 2; ++ai) {
            unsigned wv[4];
#pragma unroll
            for (int m = 0; m < 4; ++m) wv[m] = lw[(ai * HALF + m * 16) * 4];
#pragma unroll
            for (int m = 0; m < 4; ++m) { const int r = ai * HALF + wr * 64 + m * 16 + fr;
                const bool valid = r < u.nrows; const float cw = valid ? __uint_as_float(wv[m]) : 0.f;
                const f32x4 g0 = acc[ai][0][m][0], g1 = acc[ai][0][m][1], u0 = acc[ai][1][m][0], u1 = acc[ai][1][m][1];
                u32x4 w;
                w.x = cvt_pk_bf16(silu(g0[0]) * u0[0] * cw, silu(g0[1]) * u0[1] * cw); w.y = cvt_pk_bf16(silu(g0[2]) * u0[2] * cw, silu(g0[3]) * u0[3] * cw);
                w.z = cvt_pk_bf16(silu(g1[0]) * u1[0] * cw, silu(g1[1]) * u1[1] * cw); w.w = cvt_pk_bf16(silu(g1[2]) * u1[2] * cw, silu(g1[3]) * u1[3] * cw);
                if (!valid) w = (u32x4){0u, 0u, 0u, 0u};
                *(u32x4*)(ACT2 + ((size_t)u.pm * 256 + r) * 1024 + colA) = w; }
            asm volatile("" ::: "memory"); }
    }
};
struct EpiMoeOut {
    static constexpr bool PERM = false;
    float* lat; float* ctx; const float* modv; const u32x4* LIST;
    __device__ __forceinline__ void operator()(const f32x4 (&acc)[2][2][4][2], const MUnit& u, int wr, int wc, int fr, int fq) const {
        asm volatile("" : "+v"(fr), "+v"(fq));
        const int col0 = u.pn * BM + wc * 32 + 4 * fq;
        const unsigned* lw = (const unsigned*)(LIST + u.lbase + wr * 64 + fr);
        unsigned rv[2][4];
#pragma unroll
        for (int ai = 0; ai < 2; ++ai)
#pragma unroll
            for (int m = 0; m < 4; ++m) rv[ai][m] = lw[(ai * HALF + m * 16) * 4];
#pragma unroll
        for (int ai = 0; ai < 2; ++ai)
#pragma unroll
            for (int m = 0; m < 4; ++m) { const int r = ai * HALF + wr * 64 + m * 16 + fr;
                if (r < u.nrows) { const int row = (int)rv[ai][m]; bool is_ctx; const size_t off = stream_off(row, is_ctx);
                    float* d = (is_ctx ? ctx : lat) + off + col0; const float* ga = modv + (is_ctx ? 2 : row / PB) * 6144 + 5120 + col0;
#pragma unroll
                    for (int bj = 0; bj < 2; ++bj)
#pragma unroll
                        for (int n = 0; n < 2; ++n) { f32x4* p = (f32x4*)(d + bj * HALF + n * 16); *p = *p + *(const f32x4*)(ga + bj * HALF + n * 16) * acc[ai][bj][m][n]; } } }
    }
};

template <class Epi, class Sched, class Src>
__device__ __forceinline__ void gemm_phase_x(PG8_LAS unsigned char* lds, PG8_LAS unsigned char* rows, const Sched& S, const Src& X, const Epi& E, const int KB, const int nt) {
    const int tid = otid(), wid = __builtin_amdgcn_readfirstlane(tid >> 6), lane = tid & 63, wr = wid >> 2, wc = wid & 3, fr = lane & 15, fq = lane >> 4;
    int RA[2], CA[2]; unsigned voffB[2];
#pragma unroll
    for (int i = 0; i < 2; ++i) { int R, C; stage_rc(tid * 16 + i * 8192, R, C); const int Rb = Epi::PERM ? ((R & ~31) + perm32(R & 31)) : R; RA[i] = R; CA[i] = C; voffB[i] = (unsigned)(Rb * KB + C) * 2u; }
    const size_t kstep = (size_t)(BK * 2);
    const size_t hstepB = (size_t)HALF * KB * 2;
    const int half = nt >> 1;
    const unsigned ldsw = (unsigned)wid * 1024u;
    const int aoff = lds_byte(wr * 64 + fr, fq * 8), boff = lds_byte(wc * 32 + fr, fq * 8);
#define PG8_SA(b, h) (((b) * 2 + (h)) * HTB)
#define PG8_SB(b, h) ((4 + (b) * 2 + (h)) * HTB)
#define PG8_STAGE_B(bufoff, gbase) do { _Pragma("unroll") for (int _i = 0; _i < 2; ++_i) \
        __builtin_amdgcn_global_load_lds((const unsigned*)((const char*)(gbase) + voffB[_i]), (PG8_LAS unsigned*)(lds + (bufoff) + ldsw + _i * 8192), 16, 0, 0); } while (0)
#define PG8_STAGE_A(bufoff, gbase, o0, o1) do { \
        __builtin_amdgcn_global_load_lds((const unsigned*)((const char*)(gbase) + (o0)), (PG8_LAS unsigned*)(lds + (bufoff) + ldsw), 16, 0, 0); \
        __builtin_amdgcn_global_load_lds((const unsigned*)((const char*)(gbase) + (o1)), (PG8_LAS unsigned*)(lds + (bufoff) + ldsw + 8192), 16, 0, 0); } while (0)
#define PG8_LDA(dst, b, h) do { _Pragma("unroll") for (int m = 0; m < 4; ++m) _Pragma("unroll") for (int k = 0; k < 2; ++k) dst[m][k] = *(const PG8_LAS bf16x8*)(lds + PG8_SA(b, h) + aoff + m * 2048 + k * 1024); } while (0)
#define PG8_LDB(dst, b, h) do { _Pragma("unroll") for (int n = 0; n < 2; ++n) _Pragma("unroll") for (int k = 0; k < 2; ++k) dst[n][k] = *(const PG8_LAS bf16x8*)(lds + PG8_SB(b, h) + boff + n * 2048 + k * 1024); } while (0)
#define PG8_MMA(ai, bj, At, Bt) do { __builtin_amdgcn_s_setprio(1); _Pragma("unroll") for (int m = 0; m < 4; ++m) _Pragma("unroll") for (int n = 0; n < 2; ++n) _Pragma("unroll") for (int k = 0; k < 2; ++k) \
        acc[ai][bj][m][n] = __builtin_amdgcn_mfma_f32_16x16x32_bf16(Bt[n][k], At[m][k], acc[ai][bj][m][n], 0, 0, 0); __builtin_amdgcn_s_setprio(0); } while (0)
#define PG8_WAIT_V(n) asm volatile("s_waitcnt vmcnt(" #n ")" ::: "memory")
#define PG8_WAIT_L(n) asm volatile("s_waitcnt lgkmcnt(" #n ")" ::: "memory")
#define PG8_BAR __builtin_amdgcn_s_barrier()
#define PG8_SCHED __builtin_amdgcn_sched_barrier(0)
    MUnit cur, nxt; int ui = 0;
    if (!S.next(0, cur)) return;
    f32x4 acc[2][2][4][2];
#pragma unroll
    for (int a = 0; a < 2; ++a)
#pragma unroll
        for (int b = 0; b < 2; ++b)
#pragma unroll
            for (int m = 0; m < 4; ++m)
#pragma unroll
                for (int n = 0; n < 2; ++n) acc[a][b][m][n] = (f32x4){0.f, 0.f, 0.f, 0.f};
    bf16x8 At[4][2], B0[2][2], B1[2][2];
    unsigned aoc[2][2];
    X.a_offsets(cur, RA, CA, aoc);
    const char* cAb = X.a_base(cur); const char* cB0 = X.b_base(cur, 0); const char* cB1 = X.b_base(cur, 1);
    PG8_STAGE_B(PG8_SB(0, 0), cB0); PG8_STAGE_B(PG8_SB(0, 1), cB0 + hstepB); PG8_STAGE_A(PG8_SA(0, 0), cAb, aoc[0][0], aoc[0][1]); PG8_STAGE_A(PG8_SA(0, 1), cAb, aoc[1][0], aoc[1][1]);
    if (wr == 1) PG8_BAR;
    PG8_WAIT_V(2); PG8_BAR;
    PG8_STAGE_B(PG8_SB(1, 0), cB0 + kstep); PG8_STAGE_A(PG8_SA(1, 0), cAb + kstep, aoc[0][0], aoc[0][1]); PG8_STAGE_B(PG8_SB(1, 1), cB0 + hstepB + kstep);
    PG8_WAIT_V(6); PG8_BAR;
    for (;;) {
        const bool has_next = S.next(ui + 1, nxt);
        const char* nAb = cAb; const char* nB0 = cB0; const char* nB1 = cB1;
        if (has_next) { X.prefetch_rows(nxt, RA, rows, wid); nAb = X.a_base(nxt); nB0 = X.b_base(nxt, 0); nB1 = X.b_base(nxt, 1); }
        for (int t = 0; t < nt; t += 2) {
            const bool last = (t == nt - 2);
            const char* a1 = cAb + (size_t)(t + 1) * kstep;
            const int kt2 = t + 2;
            const char* b2 = last ? nB0 : (kt2 < half ? cB0 + (size_t)kt2 * kstep : cB1 + (size_t)(kt2 - half) * kstep);
            const char* a2 = last ? nAb : cAb + (size_t)kt2 * kstep;
            const char* a3 = a2 + kstep; const char* b3 = b2 + kstep;
            PG8_LDB(B0, 0, 0); PG8_LDB(B1, 0, 1); PG8_SCHED; PG8_LDA(At, 0, 0); PG8_STAGE_A(PG8_SA(1, 1), a1, aoc[1][0], aoc[1][1]);
            if (last && has_next) X.reload_offsets(nxt, RA, CA, rows, wid, lane, aoc);
            PG8_WAIT_V(8); PG8_WAIT_L(0); PG8_BAR; PG8_MMA(0, 0, At, B0); PG8_MMA(0, 1, At, B1); PG8_BAR; PG8_SCHED;
            PG8_LDA(At, 0, 1); PG8_STAGE_B(PG8_SB(0, 0), b2); PG8_STAGE_B(PG8_SB(0, 1), b2 + hstepB); PG8_STAGE_A(PG8_SA(0, 0), a2, aoc[0][0], aoc[0][1]);
            PG8_WAIT_V(8); PG8_WAIT_L(0); PG8_BAR; PG8_MMA(1, 0, At, B0); PG8_MMA(1, 1, At, B1); PG8_BAR; PG8_SCHED;
            PG8_LDB(B0, 1, 0); PG8_LDB(B1, 1, 1); PG8_SCHED; PG8_LDA(At, 1, 0); PG8_STAGE_A(PG8_SA(0, 1), a2, aoc[1][0], aoc[1][1]);
            PG8_WAIT_V(8); PG8_WAIT_L(0); PG8_BAR; PG8_MMA(0, 0, At, B0); PG8_MMA(0, 1, At, B1); PG8_BAR; PG8_SCHED;
            PG8_LDA(At, 1, 1); PG8_STAGE_B(PG8_SB(1, 0), b3); PG8_STAGE_B(PG8_SB(1, 1), b3 + hstepB); PG8_STAGE_A(PG8_SA(1, 0), a3, aoc[0][0], aoc[0][1]);
            PG8_WAIT_V(8); PG8_WAIT_L(0); PG8_BAR; PG8_MMA(1, 0, At, B0); PG8_MMA(1, 1, At, B1); PG8_BAR; PG8_SCHED;
        }
        if (wr == 0) PG8_BAR;
        E(acc, cur, wr, wc, fr, fq);
        if (!has_next) break;
#pragma unroll
        for (int a = 0; a < 2; ++a)
#pragma unroll
            for (int b = 0; b < 2; ++b)
#pragma unroll
                for (int m = 0; m < 4; ++m)
#pragma unroll
                    for (int n = 0; n < 2; ++n) acc[a][b][m][n] = (f32x4){0.f, 0.f, 0.f, 0.f};
        cur = nxt; cAb = nAb; cB0 = nB0; cB1 = nB1; ++ui;
        if (wr == 1) PG8_BAR;
    }
    PG8_WAIT_V(0);
    PG8_BAR;
#undef PG8_SA
#undef PG8_SB
#undef PG8_STAGE_A
#undef PG8_STAGE_B
#undef PG8_LDA
#undef PG8_LDB
#undef PG8_MMA
#undef PG8_WAIT_V
#undef PG8_WAIT_L
#undef PG8_BAR
#undef PG8_SCHED
}
}

constexpr int TT_OFF = 132096;
constexpr int ROWS_OFF = 134144;

#define XB_TMO      128
#define XB_XCNT(j)  (256  + 64 * (j))
#define XB_XSUB(j)  (1280 + 64 * (j))
#define XB_XGEN(j)  (2304 + 64 * (j))
#define XB_TOP      3328
#define XB_TOPGEN   3392
#define XCD_BAR_WORDS 3456
#define XB_SPIN_CAP (1u << 18)

__device__ __forceinline__ unsigned xb_ld(unsigned* p)              { return __hip_atomic_load(p, __ATOMIC_RELAXED, __HIP_MEMORY_SCOPE_AGENT); }
__device__ __forceinline__ unsigned xb_add(unsigned* p, unsigned v) { return __hip_atomic_fetch_add(p, v, __ATOMIC_RELAXED, __HIP_MEMORY_SCOPE_AGENT); }
__device__ __forceinline__ unsigned xb_xcc_id() { return (unsigned)__builtin_amdgcn_s_getreg((3 << 11) | 20) & 0xFu; }
#define XB_SPIN(cond, bar) do { unsigned _sp = 0; while (cond) { __builtin_amdgcn_s_sleep(1); \
    if ((++_sp & 255u) == 0u) { if (xb_ld(&(bar)[XB_TMO])) break; if (_sp > XB_SPIN_CAP) { atomicAdd(&(bar)[XB_TMO], 1u); break; } } } } while (0)

struct XcdBarrier {
    unsigned* bar; unsigned x;
    volatile LAS unsigned* st;
};

__device__ __forceinline__ XcdBarrier xcd_barrier_post(unsigned* bar, volatile LAS unsigned* st) {
    XcdBarrier b; b.bar = bar; b.x = xb_xcc_id(); b.st = st;
    if (threadIdx.x == 0) (void)xb_add(&bar[XB_XCNT(b.x)], 1u);
    return b;
}
__device__ __forceinline__ void xcd_barrier_complete(unsigned* bar, unsigned x, unsigned& nloc, unsigned& nx) {
    const unsigned G = gridDim.x * gridDim.y * gridDim.z;
    unsigned sum, cnt, mine, sp = 0u;
    for (;;) {
        sum = 0u; cnt = 0u; mine = 0u;
#pragma unroll
        for (unsigned j = 0; j < 16; ++j) { const unsigned c = xb_ld(&bar[XB_XCNT(j)]); sum += c; cnt += (c > 0u) ? 1u : 0u; mine = (j == x) ? c : mine; }
        if (sum == G) break;
        __builtin_amdgcn_s_sleep(1);
        if ((++sp & 255u) == 0u) { if (xb_ld(&bar[XB_TMO])) break; if (sp > XB_SPIN_CAP) { atomicAdd(&bar[XB_TMO], 1u); break; } }
    }
    nloc = mine > 0u ? mine : 1u; nx = cnt > 0u ? cnt : 1u;
}

__device__ __forceinline__ void xcd_barrier(const XcdBarrier& b) {
    asm volatile("s_waitcnt vmcnt(0)" ::: "memory");
    __syncthreads();
    if (threadIdx.x == 0) {
        unsigned* bar = b.bar;
        __builtin_amdgcn_s_waitcnt(0);
        unsigned nloc = b.st[0], nx = b.st[1];
        if (nloc == 0u) { xcd_barrier_complete(bar, b.x, nloc, nx); b.st[0] = nloc; b.st[1] = nx; }
        const unsigned old = xb_add(&bar[XB_XSUB(b.x)], 1u);
        const unsigned gen = old / nloc;
        if (old + 1u == (gen + 1u) * nloc) {
            __builtin_amdgcn_fence(__ATOMIC_RELEASE, "agent");
            asm volatile("s_waitcnt vmcnt(0)" ::: "memory");
            const unsigned og = xb_add(&bar[XB_TOP], 1u);
            const unsigned tg = og / nx;
            if (og + 1u == (tg + 1u) * nx) xb_add(&bar[XB_TOPGEN], 1u);
            else XB_SPIN(xb_ld(&bar[XB_TOPGEN]) == tg, bar);
            __builtin_amdgcn_fence(__ATOMIC_ACQUIRE, "agent");
            xb_add(&bar[XB_XGEN(b.x)], 1u);
            asm volatile("s_waitcnt vmcnt(0)" ::: "memory");
        } else {
            XB_SPIN(xb_ld(&bar[XB_XGEN(b.x)]) == gen, bar);
            __builtin_amdgcn_fence(__ATOMIC_ACQUIRE, "agent");
            asm volatile("s_waitcnt vmcnt(0)" ::: "memory");
        }
    }
    __syncthreads();
}

constexpr int LDS_BYTES = 147456;
constexpr int LDSCTL_OFF = 131072, MISC_OFF = LDSCTL_OFF + 320;
constexpr int CW_BAR = 4096;
constexpr int NPHASE = 1 + 9 * DEPTH;
#ifndef MK_SPLIT
#define MK_SPLIT 0
#endif
struct Args {
    const float *x, *c, *ctx, *c_ctx, *w_mod, *b_mod, *norm1_g, *norm2_g, *w_in, *w_out, *hgrn_lb, *hgrn_norm_g, *pool_w, *pool_scale, *q_norm_g, *k_norm_g, *router_w, *router_b, *moe_gate, *moe_up, *moe_down;
    float* out; unsigned char* ws; int ph_lo, ph_hi;
};
typedef const __attribute__((address_space(4))) Args* KArgs;
__device__ __forceinline__ KArgs kargs() { KArgs p = (KArgs)__builtin_amdgcn_kernarg_segment_ptr(); asm volatile("" : "+s"(p)); return p; }
__global__ void __launch_bounds__(512, 2) mega_fwd(Args A_unused) {
    extern __shared__ __attribute__((aligned(16))) unsigned char lds[];
    for (int u = otid(); u < (LDS_BYTES - LDSCTL_OFF) / 4; u += 512) ((LAS unsigned*)((LAS unsigned char*)lds + LDSCTL_OFF))[u] = 0u;
    __syncthreads();
    XcdBarrier bar;
    { KArgs ap = kargs(); unsigned* CTL = (unsigned*)(ap->ws + WS_CTL); bar.bar = CTL + CW_BAR; bar.x = 0; bar.st = nullptr;
      if (!MK_SPLIT) bar = xcd_barrier_post(CTL + CW_BAR, (volatile LAS unsigned*)((LAS unsigned char*)lds + MISC_OFF) + 8); }
    int lo, hi; { KArgs ap = kargs(); lo = ap->ph_lo; hi = ap->ph_hi; }
#ifndef PHMASK
#define PHMASK 0x3ff
#endif
#define IN(k) (lo <= (k) && (k) < hi)
#define SEAM(k) do { if (!MK_SPLIT && IN((k) + 1)) xcd_barrier(bar); } while (0)
#define GCU const int G = (int)gridDim.x, cu = (int)blockIdx.x
#ifndef DUPMASK
#define DUPMASK 0
#endif
    LAS unsigned char* ldsl = (LAS unsigned char*)lds;
    if ((PHMASK & 0x200) && IN(0)) {
        _Pragma("unroll") for (int rep_ = 0; rep_ < ((((DUPMASK) & (0x200)) && true) ? 2 : 1); ++rep_) {
        KArgs ap = kargs(); unsigned char* ws = ap->ws; GCU;
        ProArgs pa; pa.c = ap->c; pa.c_ctx = ap->c_ctx; pa.w_mod = ap->w_mod; pa.b_mod = ap->b_mod; pa.hgrn_lb = ap->hgrn_lb; pa.qg = ap->q_norm_g; pa.kg = ap->k_norm_g; pa.w_in = ap->w_in; pa.w_out = ap->w_out; pa.pool_w = ap->pool_w;
        pa.gate = ap->moe_gate; pa.up = ap->moe_up; pa.down = ap->moe_down; pa.MODV = (float*)(ws + WS_MODV); pa.LBF = (float*)(ws + WS_LBF); pa.REF = (float*)(ws + WS_REF); pa.COS = (float*)(ws + WS_COS); pa.SIN = (float*)(ws + WS_SIN);
        pa.WIN = (bf16_t*)(ws + WS_WIN); pa.WOUT = (bf16_t*)(ws + WS_WOUT); pa.POOLWT = (bf16_t*)(ws + WS_POOLWT); pa.WGU = (bf16_t*)(ws + WS_WGU); pa.WD = (bf16_t*)(ws + WS_WD);
        prologue_phase(lds, pa, cu, G);
            if (rep_ + 1 < ((((DUPMASK) & (0x200)) && true) ? 2 : 1)) xcd_barrier(bar); }
        SEAM(0);
    }
    for (int l = 0; l < DEPTH; ++l) {
        const int pb = 1 + 9 * l;
        if ((PHMASK & 1) && IN(pb + 0)) {
        _Pragma("unroll") for (int rep_ = 0; rep_ < ((((DUPMASK) & (1)) && true) ? 2 : 1); ++rep_) {
            KArgs ap = kargs(); unsigned char* ws = ap->ws; GCU;
            const float* slat = (l == 0) ? ap->x : ap->out; const float* sctx = (l == 0) ? ap->ctx : (const float*)(ws + WS_XC);
            norm1_phase(cu, G, slat, sctx, ap->norm1_g + l * D, (const float*)(ws + WS_MODV) + (size_t)l * 3 * 6144, 0, (bf16_t*)(ws + WS_XN));
            if (l > 0) { const int tid = otid(); float* scr = (float*)(lds + 16384) + (tid >> 6) * (64 * 33);
                moe_weight_copies(ap->moe_gate + (size_t)l * NE * D * DE, ap->moe_up + (size_t)l * NE * D * DE, ap->moe_down + (size_t)l * NE * DE * D, (bf16_t*)(ws + WS_WGU), (bf16_t*)(ws + WS_WD), scr, cu * 8 + (tid >> 6), G * 8, tid & 63); }
            if (rep_ + 1 < ((((DUPMASK) & (1)) && true) ? 2 : 1)) xcd_barrier(bar); }
            SEAM(pb + 0);
        }
        if ((PHMASK & 2) && IN(pb + 1)) {
        _Pragma("unroll") for (int rep_ = 0; rep_ < ((((DUPMASK) & (2)) && true) ? 2 : 1); ++rep_) {
            KArgs ap = kargs(); unsigned char* ws = ap->ws; GCU;
            pg8::Gemm g; g.A = (const bf16_t*)(ws + WS_XN); g.Bt = (const bf16_t*)(ws + WS_WIN) + (size_t)l * NIN * D; g.M = MT; g.N = NIN; g.K = D; g.pad = 0;
            pg8::StaticOrder S; S.init(MT, NIN, G, cu);
            pg8::EpiBf16<0> E; E.O = (bf16_t*)(ws + WS_PROJ); E.ldc = NIN; E.bias = nullptr; E.split_cols = 0; E.split_stride = 0; E.scale0 = 1.f;
            pg8::gemm_phase<pg8::EpiBf16<0>, pg8::StaticOrder, true, true>(ldsl, g, S, E);
            if (rep_ + 1 < ((((DUPMASK) & (2)) && true) ? 2 : 1)) xcd_barrier(bar); }
            SEAM(pb + 1);
        }
        if ((PHMASK & 4) && IN(pb + 2)) {
        _Pragma("unroll") for (int rep_ = 0; rep_ < ((((DUPMASK) & (4)) && true) ? 2 : 1); ++rep_) {
            KArgs ap = kargs(); unsigned char* ws = ap->ws; GCU;
            const bf16_t* PROJ = (const bf16_t*)(ws + WS_PROJ);
            post_phase(cu, G, PROJ, ap->q_norm_g + l * 64, ap->k_norm_g + l * 64, (const float*)(ws + WS_COS), (const float*)(ws + WS_SIN), (bf16_t*)(ws + WS_QN), (bf16_t*)(ws + WS_KN));
            pool::pool_phase(lds, PROJ, (const bf16_t*)(ws + WS_POOLWT) + (size_t)l * 4 * 4096, ap->pool_scale + l * 256, (bf16_t*)(ws + WS_MIX), cu, G);
            hg::h1_phase(lds, PROJ, (const float*)(ws + WS_LBF) + l * 512, (bf16_t*)(ws + WS_UT), (float*)(ws + WS_DEC), cu, G);
            if (rep_ + 1 < ((((DUPMASK) & (4)) && true) ? 2 : 1)) xcd_barrier(bar); }
            SEAM(pb + 2);
        }
        if ((PHMASK & 8) && IN(pb + 3)) {
        _Pragma("unroll") for (int rep_ = 0; rep_ < ((((DUPMASK) & (8)) && true) ? 2 : 1); ++rep_) {
            KArgs ap = kargs(); unsigned char* ws = ap->ws; GCU; hg::h2_phase(lds, (const bf16_t*)(ws + WS_UT), (const float*)(ws + WS_DEC), (bf16_t*)(ws + WS_ST), cu, G);
            if (rep_ + 1 < ((((DUPMASK) & (8)) && true) ? 2 : 1)) xcd_barrier(bar); }
            SEAM(pb + 3);
        }
        if ((PHMASK & 16) && IN(pb + 4)) {
        _Pragma("unroll") for (int rep_ = 0; rep_ < ((((DUPMASK) & (16)) && true) ? 2 : 1); ++rep_) {
            { KArgs ap = kargs(); unsigned char* ws = ap->ws; GCU;
              attn_phase((char*)lds, (const bf16_t*)(ws + WS_QN), (const bf16_t*)(ws + WS_KN), (const bf16_t*)(ws + WS_PROJ), (bf16_t*)(ws + WS_MIX), ((const float*)(ws + WS_REF))[l * 64], vcu_of(cu, G), G, true); }
            { KArgs ap = kargs(); unsigned char* ws = ap->ws; GCU;
              hg::h3_phase(lds, (const bf16_t*)(ws + WS_PROJ), (const float*)(ws + WS_LBF) + l * 512, (const bf16_t*)(ws + WS_ST), ap->hgrn_norm_g + l * 64, (bf16_t*)(ws + WS_MIX), cu, G); }
            if (rep_ + 1 < ((((DUPMASK) & (16)) && true) ? 2 : 1)) xcd_barrier(bar); }
            SEAM(pb + 4);
        }
        if ((PHMASK & 32) && IN(pb + 5)) {
        _Pragma("unroll") for (int rep_ = 0; rep_ < ((((DUPMASK) & (32)) && (l == 0)) ? 2 : 1); ++rep_) {
            KArgs ap = kargs(); unsigned char* ws = ap->ws; GCU;
            pg8::Gemm g; g.A = (const bf16_t*)(ws + WS_MIX); g.Bt = (const bf16_t*)(ws + WS_WOUT) + (size_t)l * D * D; g.M = MT; g.N = D; g.K = D; g.pad = 0;
            pg8::StaticOrder S; S.init(MT, D, G, cu);
            pg8::EpiResid E; E.src_lat = (l == 0) ? ap->x : ap->out; E.src_ctx = (l == 0) ? ap->ctx : (const float*)(ws + WS_XC); E.dst_lat = ap->out; E.dst_ctx = (float*)(ws + WS_XC);
            E.modv = (const float*)(ws + WS_MODV) + (size_t)l * 3 * 6144; E.ga_off = 2048; E.pad = 0;
            pg8::gemm_phase<pg8::EpiResid, pg8::StaticOrder, true, true>(ldsl, g, S, E);
            if (rep_ + 1 < ((((DUPMASK) & (32)) && (l == 0)) ? 2 : 1)) xcd_barrier(bar); }
            SEAM(pb + 5);
        }
        if ((PHMASK & 64) && IN(pb + 6)) {
        _Pragma("unroll") for (int rep_ = 0; rep_ < ((((DUPMASK) & (64)) && true) ? 2 : 1); ++rep_) {
            KArgs ap = kargs(); unsigned char* ws = ap->ws; GCU;
            norm2_router_phase(lds, cu, G, ap->out, (const float*)(ws + WS_XC), ap->norm2_g + l * D, (const float*)(ws + WS_MODV) + (size_t)l * 3 * 6144, 3072, ap->router_w, ap->router_b, (bf16_t*)(ws + WS_XN),
                               (unsigned*)(ws + WS_CTL) + CW_CNT + 64 * l, (u32x4*)(ws + WS_LIST), l == 0 ? 1 : 0);
            if (rep_ + 1 < ((((DUPMASK) & (64)) && true) ? 2 : 1)) xcd_barrier(bar); }
            SEAM(pb + 6);
        }
        if ((PHMASK & 128) && IN(pb + 7)) {
        _Pragma("unroll") for (int rep_ = 0; rep_ < ((((DUPMASK) & (128)) && true) ? 2 : 1); ++rep_) {
            KArgs ap = kargs(); unsigned char* ws = ap->ws; GCU;
            LAS int* TT = (LAS int*)(ldsl + TT_OFF);
            pg8::build_tiles(TT, (const unsigned*)(ws + WS_CTL) + CW_CNT + 64 * l);
            pg8::MoeOrder<8> S; S.TT = TT; S.G = G; S.c = vcu_of(cu, G);
            pg8::Src1 X; X.XN = (const bf16_t*)(ws + WS_XN); X.WGU = (const bf16_t*)(ws + WS_WGU); X.LIST = (const u32x4*)(ws + WS_LIST); pg8::EpiGateUp2 E; E.ACT2 = (bf16_t*)(ws + WS_ACT2); E.LIST = X.LIST;
            pg8::gemm_phase_x(ldsl, ldsl + ROWS_OFF, S, X, E, D, D / 64);
            if (rep_ + 1 < ((((DUPMASK) & (128)) && true) ? 2 : 1)) xcd_barrier(bar); }
            SEAM(pb + 7);
        }
        if ((PHMASK & 256) && IN(pb + 8)) {
        _Pragma("unroll") for (int rep_ = 0; rep_ < ((((DUPMASK) & (256)) && true) ? 2 : 1); ++rep_) {
            KArgs ap = kargs(); unsigned char* ws = ap->ws; GCU;
            LAS int* TT = (LAS int*)(ldsl + TT_OFF);
            pg8::build_tiles(TT, (const unsigned*)(ws + WS_CTL) + CW_CNT + 64 * l);
            pg8::MoeOrder<4> S; S.TT = TT; S.G = G; S.c = vcu_of(cu, G);
            pg8::Src2 X; X.ACT2 = (const bf16_t*)(ws + WS_ACT2); X.WD = (const bf16_t*)(ws + WS_WD);
            pg8::EpiMoeOut E; E.lat = ap->out; E.ctx = (float*)(ws + WS_XC); E.modv = (const float*)(ws + WS_MODV) + (size_t)l * 3 * 6144; E.LIST = (const u32x4*)(ws + WS_LIST);
            pg8::gemm_phase_x(ldsl, ldsl + ROWS_OFF, S, X, E, DE, 1024 / 64);
            if (rep_ + 1 < ((((DUPMASK) & (256)) && true) ? 2 : 1)) xcd_barrier(bar); }
            SEAM(pb + 8);
        }
    }
#undef IN
#undef SEAM
#undef GCU
}

extern "C" void kernel_launch(void* const* d_in, const int* in_sizes, int n_in, void* d_out, int out_size, void* d_ws, size_t ws_size, hipStream_t stream) {
    static int grid = 0;
    if (grid == 0) {
        if (n_in != 21 || in_sizes[0] != BATCH * SEQ * D || out_size != BATCH * SEQ * D || ws_size < WS_END) {
            fprintf(stderr, "kernel_launch: unexpected sizes: n_in %d in0 %d out %d ws %zu (need %zu)\n", n_in, n_in > 0 ? in_sizes[0] : -1, out_size, ws_size, (size_t)WS_END); grid = -1; return; }
        int dev = 0, cus = 0, per_cu = 0;
        if (hipGetDevice(&dev) != hipSuccess || hipDeviceGetAttribute(&cus, hipDeviceAttributeMultiprocessorCount, dev) != hipSuccess) { grid = -1; return; }
        if (hipFuncSetAttribute((const void*)mega_fwd, hipFuncAttributeMaxDynamicSharedMemorySize, LDS_BYTES) != hipSuccess) { fprintf(stderr, "kernel_launch: hipFuncSetAttribute failed\n"); grid = -1; return; }
        if (hipOccupancyMaxActiveBlocksPerMultiprocessor(&per_cu, (const void*)mega_fwd, 512, LDS_BYTES) != hipSuccess || per_cu < 1) fprintf(stderr, "kernel_launch: occupancy query reports %d\n", per_cu);
        (void)hipGetLastError();
        grid = cus;
    }
    if (grid < 0) return;
    if (hipMemsetAsync((char*)d_ws + WS_CTL, 0, 1 * MiB, stream) != hipSuccess) return;
    Args a; memset((void*)&a, 0, sizeof(a));
    a.x = (const float*)d_in[0]; a.c = (const float*)d_in[1]; a.ctx = (const float*)d_in[2]; a.c_ctx = (const float*)d_in[3]; a.w_mod = (const float*)d_in[4]; a.b_mod = (const float*)d_in[5];
    a.norm1_g = (const float*)d_in[6]; a.norm2_g = (const float*)d_in[7]; a.w_in = (const float*)d_in[8]; a.w_out = (const float*)d_in[9]; a.hgrn_lb = (const float*)d_in[10]; a.hgrn_norm_g = (const float*)d_in[11];
    a.pool_w = (const float*)d_in[12]; a.pool_scale = (const float*)d_in[13]; a.q_norm_g = (const float*)d_in[14]; a.k_norm_g = (const float*)d_in[15]; a.router_w = (const float*)d_in[16]; a.router_b = (const float*)d_in[17];
    a.moe_gate = (const float*)d_in[18]; a.moe_up = (const float*)d_in[19]; a.moe_down = (const float*)d_in[20];
    a.out = (float*)d_out; a.ws = (unsigned char*)d_ws;
#if MK_SPLIT
    for (int ph = 0; ph < NPHASE; ++ph) { a.ph_lo = ph; a.ph_hi = ph + 1; hipLaunchKernelGGL(mega_fwd, dim3(grid), dim3(512), LDS_BYTES, stream, a); }
#else
    a.ph_lo = 0; a.ph_hi = NPHASE; hipLaunchKernelGGL(mega_fwd, dim3(grid), dim3(512), LDS_BYTES, stream, a);
#endif
}
```

```cpp
#include <hip/hip_runtime.h>
#include <cstdio>
#include <cstdint>
#include <cstring>

namespace cfg {
constexpr int D = 1024, BATCH = 2, SEQ = 8192, CTXL = 256, DEPTH = 2;
constexpr int PB = SEQ + CTXL;
constexpr int MT = BATCH * PB;
constexpr int TPB = PB / 256;
constexpr int NIN = 2304;
constexpr int NE = 16, DE = 512;
constexpr int C_AQ = 0, C_AFF = 256, C_AFB = 512, C_AI = 768, C_AG = 1024, C_BP = 1280, C_CQ = 1536, C_CK = 2048, C_CV = 2176;
constexpr float EPS = 1e-6f;
constexpr float C2 = 0.125f * 1.4426950408889634f;
}

__device__ __forceinline__ int otid() { int t = threadIdx.x; asm volatile("" : "+v"(t)); return t; }

namespace pg8 {
#define PG8_LAS __attribute__((address_space(3)))
typedef unsigned short bf16_t;
typedef short bf16x8 __attribute__((ext_vector_type(8)));
typedef float f32x4 __attribute__((ext_vector_type(4)));
typedef unsigned u32x4 __attribute__((ext_vector_type(4)));
constexpr int BM = 256, BK = 64, HALF = 128, HTB = HALF * BK * 2  , STAGE_BYTES = 8 * HTB, NXCD = 8, WGM = 8;

__host__ __device__ __forceinline__ int lds_byte(int r, int c) { const int st = (r >> 4) * 2 + (c >> 5), rr = r & 15, cc = c & 31, ob = rr * 64 + cc * 2; return st * 1024 + (ob ^ (((ob >> 9) & 1) << 5)); }
__host__ __device__ __forceinline__ void stage_rc(int b, int& R, int& C) { const int st = b / 1024, sb = b % 1024, swz = sb ^ (((sb >> 9) & 1) << 5); R = (st >> 1) * 16 + swz / 64; C = (st & 1) * 32 + (swz % 64) / 2; }
__host__ __device__ __forceinline__ int perm32(int rho) { const int n = rho >> 4, i = rho & 15; return 8 * (i >> 2) + 4 * n + (i & 3); }

struct Unit { int pm, pn; };
struct Gemm { const bf16_t* A; const bf16_t* Bt; int M, N, K, pad; };

struct StaticOrder {
    int nM, nN, nwg, G, c;
    __host__ __device__ void init(int M, int N, int G_, int c_) { nM = M / BM; nN = N / BM; nwg = nM * nN; G = G_; c = c_; }
    __host__ __device__ bool next(int i, Unit& u) const {
        const long L = (long)i * G + c; if (L >= nwg) return false;
        int wgid = (int)L; { const int q = nwg / NXCD, r = nwg % NXCD, xcd = wgid % NXCD, off = wgid / NXCD; wgid = (xcd < r ? xcd * (q + 1) : r * (q + 1) + (xcd - r) * q) + off; }
        const int nig = WGM * nN, gid = wgid / nig, fm = gid * WGM, gsz = (nM - fm) < WGM ? (nM - fm) : WGM;
        u.pm = fm + ((wgid % nig) % gsz); u.pn = (wgid % nig) / gsz; return true;
    }
    __device__ __forceinline__ void a_ready(const Unit&) const {}
    __device__ __forceinline__ void done(const Unit&) const {}
};

__device__ __forceinline__ unsigned cvt_pk_bf16(float lo, float hi) { unsigned r; asm volatile("v_cvt_pk_bf16_f32 %0, %1, %2" : "=v"(r) : "v"(lo), "v"(hi)); return r; }
typedef float f32x2 __attribute__((ext_vector_type(2)));
__device__ __forceinline__ f32x2 gelu_pk(f32x2 v) {
    const f32x2 av = __builtin_elementwise_abs(v), d = av * 0.2316418882f + 1.0f;
    f32x2 t; t.x = __builtin_amdgcn_rcpf(d.x); t.y = __builtin_amdgcn_rcpf(d.y);
    f32x2 q = t * 0.5307027145f + (-0.7265760135f); q = q * t + 0.7107068705f; q = q * t + (-0.142248368f); q = q * t + 0.127414796f; q = q * t;
    const f32x2 s = (v * v) * (-0.72134752044f);
    f32x2 e; e.x = __builtin_amdgcn_exp2f(s.x); e.y = __builtin_amdgcn_exp2f(s.y);
    const f32x2 m = v * (q * e), r = v - m;
    f32x2 o; o.x = v.x < 0.f ? m.x : r.x; o.y = v.y < 0.f ? m.y : r.y; return o;
}

template <int ACT  > struct EpiBf16 {
    static constexpr bool PERM = true, AFTER_DRAIN = false; static_assert(ACT == 0 || ACT == 1, "EpiBf16: ACT is 0 (none) or 1 (gelu_pk)");
    bf16_t* O; int ldc; const float* bias; int split_cols; size_t split_stride; float scale0;
    __device__ __forceinline__ void operator()(const f32x4 (&acc)[2][2][4][2], const Unit& u, int wr, int wc, int fr, int fq) const {
        asm volatile("" : "+v"(fr), "+v"(fq));
        const int row0 = u.pm * BM + wr * 64 + fr; int colt = u.pn * BM; bf16_t* base = O;
        float sc = 1.f; if (split_cols) { const int t = colt / split_cols; base += (size_t)t * split_stride; colt -= t * split_cols; if (t == 0) sc = scale0; }
        const int col0 = colt + wc * 32 + 8 * fq, bcol0 = u.pn * BM + wc * 32 + 8 * fq;
        f32x4 bv[2][2];
#pragma unroll
        for (int bj = 0; bj < 2; ++bj)
#pragma unroll
            for (int n = 0; n < 2; ++n) bv[bj][n] = bias ? *(const f32x4*)(bias + bcol0 + bj * HALF + 4 * n) : (f32x4){0.f, 0.f, 0.f, 0.f};
#pragma unroll
        for (int ai = 0; ai < 2; ++ai)
#pragma unroll
            for (int m = 0; m < 4; ++m) { bf16_t* rowp = base + (size_t)(row0 + ai * HALF + m * 16) * ldc + col0;
#pragma unroll
                for (int bj = 0; bj < 2; ++bj) { f32x4 v0 = acc[ai][bj][m][0] + bv[bj][0], v1 = acc[ai][bj][m][1] + bv[bj][1];
                    if (ACT == 1) { f32x2 a = gelu_pk((f32x2){v0[0], v0[1]}), b = gelu_pk((f32x2){v0[2], v0[3]}), c = gelu_pk((f32x2){v1[0], v1[1]}), d = gelu_pk((f32x2){v1[2], v1[3]});
                        v0 = (f32x4){a.x, a.y, b.x, b.y}; v1 = (f32x4){c.x, c.y, d.x, d.y}; }
                    v0 = v0 * sc; v1 = v1 * sc; u32x4 w; w.x = cvt_pk_bf16(v0[0], v0[1]); w.y = cvt_pk_bf16(v0[2], v0[3]); w.z = cvt_pk_bf16(v1[0], v1[1]); w.w = cvt_pk_bf16(v1[2], v1[3]);
                    *(u32x4*)(rowp + bj * HALF) = w; } }
    }
};

template <class Epi, class Sched, bool ALIGN_EPI = false, bool SP2 = false>
__device__ __forceinline__ void gemm_phase(PG8_LAS unsigned char* lds, const Gemm g, const Sched& S, const Epi& E) {
    const int tid = otid(), wid = __builtin_amdgcn_readfirstlane(tid >> 6), lane = tid & 63, wr = wid >> 2, wc = wid & 3, fr = lane & 15, fq = lane >> 4;
    const int K = g.K, nt = K / BK;
    unsigned voffA[2], voffB[2];
#pragma unroll
    for (int i = 0; i < 2; ++i) { int R, C; stage_rc(tid * 16 + i * 8192, R, C); const int Rb = Epi::PERM ? ((R & ~31) + perm32(R & 31)) : R;
        voffA[i] = (unsigned)(R * K + C) * 2u; voffB[i] = (unsigned)(Rb * K + C) * 2u; }
    const size_t kstep = (size_t)(BK * 2);
    const size_t hstep = (size_t)HALF * K * 2;
    const size_t tstep = 2 * hstep;
    const unsigned ldsw = (unsigned)wid * 1024u;
    const int aoff = lds_byte(wr * 64 + fr, fq * 8), boff = lds_byte(wc * 32 + fr, fq * 8);
#define PG8_SA(b, h) (((b) * 2 + (h)) * HTB)
#define PG8_SB(b, h) ((4 + (b) * 2 + (h)) * HTB)
#define PG8_STAGE(bufoff, gbase, voff) do { _Pragma("unroll") for (int _i = 0; _i < 2; ++_i) \
        __builtin_amdgcn_global_load_lds((const unsigned*)((const char*)(gbase) + (voff)[_i]), (PG8_LAS unsigned*)(lds + (bufoff) + ldsw + _i * 8192), 16, 0, 0); } while (0)
#define PG8_LDA(dst, b, h) do { _Pragma("unroll") for (int m = 0; m < 4; ++m) _Pragma("unroll") for (int k = 0; k < 2; ++k) dst[m][k] = *(const PG8_LAS bf16x8*)(lds + PG8_SA(b, h) + aoff + m * 2048 + k * 1024); } while (0)
#define PG8_LDB(dst, b, h) do { _Pragma("unroll") for (int n = 0; n < 2; ++n) _Pragma("unroll") for (int k = 0; k < 2; ++k) dst[n][k] = *(const PG8_LAS bf16x8*)(lds + PG8_SB(b, h) + boff + n * 2048 + k * 1024); } while (0)
#define PG8_MMA(ai, bj, At, Bt) do { __builtin_amdgcn_s_setprio(1); _Pragma("unroll") for (int m = 0; m < 4; ++m) _Pragma("unroll") for (int n = 0; n < 2; ++n) _Pragma("unroll") for (int k = 0; k < 2; ++k) \
        acc[ai][bj][m][n] = __builtin_amdgcn_mfma_f32_16x16x32_bf16(Bt[n][k], At[m][k], acc[ai][bj][m][n], 0, 0, 0); __builtin_amdgcn_s_setprio(0); } while (0)
#define PG8_WAIT_V(n) asm volatile("s_waitcnt vmcnt(" #n ")" ::: "memory")
#define PG8_WAIT_L(n) asm volatile("s_waitcnt lgkmcnt(" #n ")" ::: "memory")
#define PG8_BAR __builtin_amdgcn_s_barrier()
#define PG8_SCHED __builtin_amdgcn_sched_barrier(0)
    Unit cur, nxt; int ui = 0;
    if (!S.next(0, cur)) return;
    f32x4 acc[2][2][4][2];
#pragma unroll
    for (int a = 0; a < 2; ++a)
#pragma unroll
        for (int b = 0; b < 2; ++b)
#pragma unroll
            for (int m = 0; m < 4; ++m)
#pragma unroll
                for (int n = 0; n < 2; ++n) acc[a][b][m][n] = (f32x4){0.f, 0.f, 0.f, 0.f};
    bf16x8 At[4][2], B0[2][2], B1[2][2];
    const char* cA = (const char*)g.A + (size_t)cur.pm * tstep; const char* cB = (const char*)g.Bt + (size_t)cur.pn * tstep;
    S.a_ready(cur);
    if constexpr (SP2) {
        PG8_STAGE(PG8_SB(0, 0), cB, voffB); PG8_STAGE(PG8_SB(0, 1), cB + hstep, voffB); PG8_STAGE(PG8_SA(0, 0), cA, voffA); PG8_STAGE(PG8_SA(0, 1), cA + hstep, voffA);
        if (wr == 1) PG8_BAR;
        PG8_WAIT_V(2); PG8_BAR;
        PG8_STAGE(PG8_SB(1, 0), cB + kstep, voffB); PG8_STAGE(PG8_SA(1, 0), cA + kstep, voffA); PG8_STAGE(PG8_SB(1, 1), cB + hstep + kstep, voffB);
        PG8_WAIT_V(6); PG8_BAR;
    } else {
        PG8_STAGE(PG8_SB(0, 0), cB, voffB); PG8_STAGE(PG8_SA(0, 0), cA, voffA); PG8_STAGE(PG8_SB(0, 1), cB + hstep, voffB); PG8_STAGE(PG8_SA(0, 1), cA + hstep, voffA);
        if (wr == 1) PG8_BAR;
        PG8_WAIT_V(4); PG8_BAR;
        PG8_STAGE(PG8_SB(1, 0), cB + kstep, voffB); PG8_STAGE(PG8_SA(1, 0), cA + kstep, voffA); PG8_STAGE(PG8_SB(1, 1), cB + hstep + kstep, voffB);
        PG8_WAIT_V(6); PG8_BAR;
    }
    for (;;) {
        const bool has_next = S.next(ui + 1, nxt);
        const char* nA = has_next ? (const char*)g.A + (size_t)nxt.pm * tstep : cA; const char* nB = has_next ? (const char*)g.Bt + (size_t)nxt.pn * tstep : cB;
        for (int t = 0; t < nt; t += 2) {
            const bool last = (t == nt - 2);
            const char* a1 = cA + (size_t)(t + 1) * kstep;
            const char* a2 = last ? nA : cA + (size_t)(t + 2) * kstep; const char* b2 = last ? nB : cB + (size_t)(t + 2) * kstep;
            const char* a3 = a2 + kstep; const char* b3 = b2 + kstep;
            if (last && has_next) S.a_ready(nxt);
            if constexpr (SP2) {
            PG8_LDB(B0, 0, 0); PG8_LDB(B1, 0, 1); PG8_SCHED; PG8_LDA(At, 0, 0); PG8_STAGE(PG8_SA(1, 1), a1 + hstep, voffA);
            PG8_WAIT_V(8); PG8_WAIT_L(0); PG8_BAR; PG8_MMA(0, 0, At, B0); PG8_MMA(0, 1, At, B1); PG8_BAR; PG8_SCHED;
            PG8_LDA(At, 0, 1); PG8_STAGE(PG8_SB(0, 0), b2, voffB); PG8_STAGE(PG8_SB(0, 1), b2 + hstep, voffB); PG8_STAGE(PG8_SA(0, 0), a2, voffA);
            PG8_WAIT_V(8); PG8_WAIT_L(0); PG8_BAR; PG8_MMA(1, 0, At, B0); PG8_MMA(1, 1, At, B1); PG8_BAR; PG8_SCHED;
            PG8_LDB(B0, 1, 0); PG8_LDB(B1, 1, 1); PG8_SCHED; PG8_LDA(At, 1, 0); PG8_STAGE(PG8_SA(0, 1), a2 + hstep, voffA);
            PG8_WAIT_V(8); PG8_WAIT_L(0); PG8_BAR; PG8_MMA(0, 0, At, B0); PG8_MMA(0, 1, At, B1); PG8_BAR; PG8_SCHED;
            PG8_LDA(At, 1, 1); PG8_STAGE(PG8_SB(1, 0), b3, voffB); PG8_STAGE(PG8_SB(1, 1), b3 + hstep, voffB); PG8_STAGE(PG8_SA(1, 0), a3, voffA);
            PG8_WAIT_V(8); PG8_WAIT_L(0); PG8_BAR; PG8_MMA(1, 0, At, B0); PG8_MMA(1, 1, At, B1); PG8_BAR; PG8_SCHED;
            } else {
            PG8_LDB(B0, 0, 0); PG8_SCHED; PG8_LDA(At, 0, 0); PG8_STAGE(PG8_SA(1, 1), a1 + hstep, voffA);
            PG8_WAIT_L(8); PG8_BAR; PG8_WAIT_L(0); PG8_MMA(0, 0, At, B0); PG8_BAR; PG8_SCHED;
            PG8_LDB(B1, 0, 1); PG8_STAGE(PG8_SB(0, 0), b2, voffB);
            PG8_BAR; PG8_WAIT_L(0); PG8_MMA(0, 1, At, B1); PG8_BAR;
            PG8_LDA(At, 0, 1); PG8_STAGE(PG8_SA(0, 0), a2, voffA);
            PG8_BAR; PG8_WAIT_L(0); PG8_MMA(1, 0, At, B0); PG8_BAR; PG8_SCHED;
            PG8_STAGE(PG8_SB(0, 1), b2 + hstep, voffB);
            PG8_WAIT_V(6); PG8_BAR; PG8_MMA(1, 1, At, B1); PG8_BAR;
            PG8_LDB(B0, 1, 0); PG8_SCHED; PG8_LDA(At, 1, 0); PG8_STAGE(PG8_SA(0, 1), a2 + hstep, voffA);
            PG8_WAIT_L(8); PG8_BAR; PG8_WAIT_L(0); PG8_MMA(0, 0, At, B0); PG8_BAR; PG8_SCHED;
            PG8_LDB(B1, 1, 1); PG8_STAGE(PG8_SB(1, 0), b3, voffB);
            PG8_BAR; PG8_WAIT_L(0); PG8_MMA(0, 1, At, B1); PG8_BAR;
            PG8_LDA(At, 1, 1); PG8_STAGE(PG8_SA(1, 0), a3, voffA);
            PG8_BAR; PG8_WAIT_L(0); PG8_MMA(1, 0, At, B0); PG8_BAR; PG8_SCHED;
            PG8_STAGE(PG8_SB(1, 1), b3 + hstep, voffB);
            PG8_WAIT_V(6); PG8_BAR; PG8_MMA(1, 1, At, B1); PG8_BAR;
            }
        }
        if constexpr (ALIGN_EPI) { if (wr == 0) PG8_BAR; }
        if constexpr (!Epi::AFTER_DRAIN) { E(acc, cur, wr, wc, fr, fq); S.done(cur); }
        if (!has_next) break;
#pragma unroll
        for (int a = 0; a < 2; ++a)
#pragma unroll
            for (int b = 0; b < 2; ++b)
#pragma unroll
                for (int m = 0; m < 4; ++m)
#pragma unroll
                    for (int n = 0; n < 2; ++n) acc[a][b][m][n] = (f32x4){0.f, 0.f, 0.f, 0.f};
        cur = nxt; cA = nA; cB = nB; ++ui;
        if constexpr (ALIGN_EPI) { if (wr == 1) PG8_BAR; }
    }
    PG8_WAIT_V(0);
    if constexpr (!ALIGN_EPI) { if (wr == 0) PG8_BAR; }
    PG8_BAR;
    if constexpr (Epi::AFTER_DRAIN) { E.fused(acc, cur, wr, wc, fr, fq, lds, wid, lane); S.done(cur); }
#undef PG8_SA
#undef PG8_SB
#undef PG8_STAGE
#undef PG8_LDA
#undef PG8_LDB
#undef PG8_MMA
#undef PG8_WAIT_V
#undef PG8_WAIT_L
#undef PG8_BAR
#undef PG8_SCHED
}
}

#include <hip/hip_bf16.h>
#include <cmath>
namespace attn_body {
using bf16=__hip_bfloat16;
using bf16x8=__attribute__((ext_vector_type(8)))short;
using s16x4=__attribute__((ext_vector_type(4)))short;
using f32x16=__attribute__((ext_vector_type(16)))float;
using u32x4=__attribute__((ext_vector_type(4)))unsigned;
constexpr int D=64,QP=512,KP=128,VP=2304,OP=1024;
constexpr int NW=8,QBLK=32,QB=QBLK*NW,KVBLK=64;
constexpr int ATTN_UNIT_ROWS=QB;
__device__ __forceinline__ int crow(int r,int hi){return (r&3)+8*(r>>2)+4*hi;}
#define SBAR() __builtin_amdgcn_sched_barrier(0)
constexpr int NSLOT=3, SLOTB=8192;
constexpr int LDS_K=0, LDS_V=NSLOT*SLOTB, LDS_WS=2*NSLOT*SLOTB, LDS_OST=LDS_WS+NW*64*4, LDS_BYTES=LDS_OST+NW*4096;
constexpr float C2=0.125f*1.4426950408889634f;
__device__ __forceinline__ void glds16(const void*gsrc,unsigned lds_dst){unsigned keep;
  asm volatile("s_mov_b32 %0, m0\n\ts_mov_b32 m0, %2\n\ts_nop 0\n\tglobal_load_lds_dwordx4 %1, off\n\ts_mov_b32 m0, %0":"=&s"(keep):"v"(gsrc),"s"(lds_dst):"memory");}
__device__ __forceinline__ float max3f(float a,float b,float c){float r;asm("v_max3_f32 %0, %1, %2, %3":"=v"(r):"v"(a),"v"(b),"v"(c));return r;}
__device__ __forceinline__ float max2f(float a,float b){float r;asm("v_max_f32_e32 %0, %1, %2":"=v"(r):"v"(a),"v"(b));return r;}
__device__ __forceinline__ float fadd_s(float a,float b){float r;asm("v_add_f32_e32 %0, %1, %2":"=v"(r):"v"(a),"v"(b));return r;}
__device__ __forceinline__ float fsub_s(float a,float b){float r;asm("v_sub_f32_e32 %0, %1, %2":"=v"(r):"v"(a),"v"(b));return r;}
typedef float f32x2_t __attribute__((ext_vector_type(2))); typedef __bf16 bf16x2_t __attribute__((ext_vector_type(2)));
__device__ __forceinline__ unsigned cvtpk_s(float lo,float hi){f32x2_t v={lo,hi};bf16x2_t b=__builtin_convertvector(v,bf16x2_t);return __builtin_bit_cast(unsigned,b);}
#define WAIT_BAR(N) asm volatile("s_waitcnt vmcnt(" #N ") lgkmcnt(0)\n\ts_barrier":::"memory")

__device__ __forceinline__ void qkt(f32x16&p0,f32x16&p1,const char*Kslot,const bf16x8*qr,const f32x16&negm,int r32,int hi){
  const char*kb=Kslot+hi*1024+r32*16;
  #pragma unroll
  for(int d0=0;d0<4;++d0){
    const bf16x8 b0=*reinterpret_cast<const bf16x8*>(kb+d0*2048);
    const bf16x8 b1=*reinterpret_cast<const bf16x8*>(kb+d0*2048+512);
    if(d0==0){p0=__builtin_amdgcn_mfma_f32_32x32x16_bf16(b0,qr[0],negm,0,0,0);p1=__builtin_amdgcn_mfma_f32_32x32x16_bf16(b1,qr[0],negm,0,0,0);}
    else{p0=__builtin_amdgcn_mfma_f32_32x32x16_bf16(b0,qr[d0],p0,0,0,0);p1=__builtin_amdgcn_mfma_f32_32x32x16_bf16(b1,qr[d0],p1,0,0,0);}}
}
typedef __attribute__((address_space(3))) const char* lds_cptr;
typedef short v4i16_t __attribute__((ext_vector_type(4)));
__device__ __forceinline__ void kload8(bf16x8*kf,lds_cptr kp){
  kf[0]=*(const __attribute__((address_space(3))) bf16x8*)(kp);      kf[1]=*(const __attribute__((address_space(3))) bf16x8*)(kp+512);
  kf[2]=*(const __attribute__((address_space(3))) bf16x8*)(kp+2048); kf[3]=*(const __attribute__((address_space(3))) bf16x8*)(kp+2560);
  kf[4]=*(const __attribute__((address_space(3))) bf16x8*)(kp+4096); kf[5]=*(const __attribute__((address_space(3))) bf16x8*)(kp+4608);
  kf[6]=*(const __attribute__((address_space(3))) bf16x8*)(kp+6144); kf[7]=*(const __attribute__((address_space(3))) bf16x8*)(kp+6656);
}
__device__ __forceinline__ void kload2(bf16x8*kf,lds_cptr kp,int j){ kf[2*j]=*(const __attribute__((address_space(3))) bf16x8*)(kp+j*2048); kf[2*j+1]=*(const __attribute__((address_space(3))) bf16x8*)(kp+j*2048+512); }
__device__ __forceinline__ s16x4 vtr(lds_cptr p){ return __builtin_bit_cast(s16x4,__builtin_amdgcn_ds_read_tr16_b64_v4i16((__attribute__((address_space(3))) v4i16_t*)p)); }
__device__ __forceinline__ float rowmax(const f32x16&p0,const f32x16&p1){
  float a=max3f(p0[0],p0[1],p1[0]),b=max3f(p0[2],p0[3],p1[1]);a=max3f(a,p1[2],p1[3]);
  #pragma unroll
  for(int r=4;r<16;r+=4){a=max3f(a,p0[r],p0[r+1]);b=max3f(b,p0[r+2],p0[r+3]);a=max3f(a,p1[r],p1[r+1]);b=max3f(b,p1[r+2],p1[r+3]);}
  const float m=max2f(a,b);
  auto rr=__builtin_amdgcn_permlane32_swap(__float_as_uint(m),__float_as_uint(m),false,false);
  return max2f(__uint_as_float(rr[0]),__uint_as_float(rr[1]));
}
__device__ __forceinline__ void pv(f32x16*o,int vb,bf16x8 pa0,bf16x8 pa1,bf16x8 pa2,bf16x8 pa3){
  #pragma unroll
  for(int d0=0;d0<2;++d0){s16x4 lo[4],hi[4];
    #pragma unroll
    for(int ks=0;ks<4;++ks){
      asm volatile("ds_read_b64_tr_b16 %0,%1 offset:%c2":"=&v"(lo[ks]):"v"(vb),"i"(d0*4096+ks*1024):"memory");
      asm volatile("ds_read_b64_tr_b16 %0,%1 offset:%c2":"=&v"(hi[ks]):"v"(vb),"i"(d0*4096+ks*1024+512):"memory");}
    asm volatile("s_waitcnt lgkmcnt(0)":::"memory");SBAR();
    #define PK(k) (bf16x8){lo[k][0],lo[k][1],lo[k][2],lo[k][3],hi[k][0],hi[k][1],hi[k][2],hi[k][3]}
    o[d0]=__builtin_amdgcn_mfma_f32_32x32x16_bf16(pa0,PK(0),o[d0],0,0,0);
    o[d0]=__builtin_amdgcn_mfma_f32_32x32x16_bf16(pa1,PK(1),o[d0],0,0,0);
    o[d0]=__builtin_amdgcn_mfma_f32_32x32x16_bf16(pa2,PK(2),o[d0],0,0,0);
    o[d0]=__builtin_amdgcn_mfma_f32_32x32x16_bf16(pa3,PK(3),o[d0],0,0,0);
    #undef PK
  }
}

#ifndef ATTN_STORE16
#define ATTN_STORE16(p,v) (*(u32x4*)(p)=(v))
#endif
__device__ __forceinline__ void attn_unit(const bf16*Qw0,const bf16*__restrict__ Kh,const bf16*__restrict__ Vh,bf16*Ow0,const int NT,const float neg_ref,char*shm){
  const int tid=otid(),lane=tid&63,r32=lane&31,hi=lane>>5; const int wid=__builtin_amdgcn_readfirstlane(tid>>6);
  const bf16*Qw=Qw0+(long)(wid*QBLK)*QP;
  const unsigned lds0=(unsigned)(uintptr_t)shm;
  float*wsf=(float*)(shm+LDS_WS)+wid*64;
  const bf16*ksrc=Kh+(long)lane*KP+wid*8;
  const bf16*vsrc=Vh+(long)(16*(wid&3)+(lane>>2))*VP+(wid>>2)*32+(lane&3)*8;
  const unsigned kdst=lds0+LDS_K+wid*1024, vdst=lds0+LDS_V+wid*1024;
  #define DMA_K(t,slot) glds16(ksrc+(long)(t)*KVBLK*KP,(unsigned)__builtin_amdgcn_readfirstlane(kdst+(slot)))
  #define DMA_V(t,slot) glds16(vsrc+(long)(t)*KVBLK*VP,(unsigned)__builtin_amdgcn_readfirstlane(vdst+(slot)))
  const int vb0=(int)(lds0+LDS_V)+((lane>>4)&1)*32+(lane&3)*8+(4*hi+((lane&15)>>2))*64;
  const char*Kbase=shm+LDS_K; bf16x8 kf[8];
  const lds_cptr shm3=(lds_cptr)shm; const lds_cptr kp0=shm3+LDS_K+hi*1024+r32*16; const lds_cptr vp0=shm3+LDS_V+((lane>>4)&1)*32+(lane&3)*8+(4*hi+((lane&15)>>2))*64;
  DMA_K(0,0);DMA_V(0,0);DMA_K(1,SLOTB);
  bf16x8 qr[4];
  #pragma unroll
  for(int d0=0;d0<4;++d0)qr[d0]=*reinterpret_cast<const bf16x8*>(&Qw[(long)r32*QP+d0*16+hi*8]);
  float l_reg=0.f;f32x16 o[2];o[0]=f32x16{};o[1]=f32x16{};f32x16 negm;
  #pragma unroll
  for(int r=0;r<16;++r)negm[r]=neg_ref;
  asm volatile("":"+v"(negm));
  f32x16 pA0,pA1,pB0,pB1;
  int sl_prev=0,sl_cur=0,sl_next=SLOTB;
  #define ROT() do{sl_prev=sl_cur;sl_cur=sl_next;sl_next=(sl_next==(NSLOT-1)*SLOTB)?0:sl_next+SLOTB;}while(0)
  DMA_K(2,2*SLOTB);
  WAIT_BAR(3);
  qkt(pA0,pA1,Kbase,qr,negm,r32,hi);asm volatile("s_nop 15\n\ts_nop 7":"+v"(pA0),"+v"(pA1));
  _Pragma("unroll") for(int r=0;r<16;++r)pA0[r]=__builtin_amdgcn_exp2f(pA0[r]);
  _Pragma("unroll") for(int r=0;r<16;++r)pA1[r]=__builtin_amdgcn_exp2f(pA1[r]);
  WAIT_BAR(0);
  DMA_K(3,0);DMA_V(1,SLOTB);
  ROT();
  kload8(kf,kp0+sl_cur);
  WAIT_BAR(2);
  s16x4 vlo[8],vhi[8]; u32x4 pw0,pw1,pw2,pw3;
  #define PKW(P,B) cvtpk_s(P[B],P[B+1])
  #define PAF(k) __builtin_bit_cast(bf16x8,pw##k)
  #define VFR(i) (bf16x8){vlo[i][0],vlo[i][1],vlo[i][2],vlo[i][3],vhi[i][0],vhi[i][1],vhi[i][2],vhi[i][3]}
  #define PIN(x) asm volatile("":"+v"(x))
  #define MX3(a,b,c) __builtin_fmaxf(__builtin_fmaxf((a),(b)),(c))
  #define GAPA(MF,A0,A1,A2,A3,W0,W1,PW) do{ MF; sacc+=A0; sacc+=A1; sacc+=A2; sacc+=A3; PIN(sacc); W0; W1; PIN(PW); SBAR(); }while(0)
  #define EX(v) __builtin_amdgcn_exp2f(v)
  #define GAPB(MF,X,B) do{ MF; X[B]=EX(X[B]); X[B+1]=EX(X[B+1]); X[B+2]=EX(X[B+2]); X[B+3]=EX(X[B+3]); PIN(X); SBAR(); }while(0)
  #define VRD(i) do{ vlo[i]=vtr(vp_+(((i)>>2)*4096+((i)&3)*1024)); vhi[i]=vtr(vp_+(((i)>>2)*4096+((i)&3)*1024+512)); }while(0)
  #define KRD(G,j) do{ if(G){ kload2(kf,kp0+sl_next,j); SBAR(); } }while(0)
  #define STEP(C0,C1,P0,P1,t,GK,GV,GL) do{ SBAR(); \
    const lds_cptr vp_=vp0+sl_prev; \
    VRD(0); SBAR(); float sacc=(P0[0]+P0[1]); \
    GAPA(C0=__builtin_amdgcn_mfma_f32_32x32x16_bf16(kf[0],qr[0],negm,0,0,0), P0[2],P0[3],P0[4],P0[5],     pw0[0]=PKW(P0,0), pw0[1]=PKW(P0,2), pw0); \
    VRD(4); SBAR(); GAPA(C1=__builtin_amdgcn_mfma_f32_32x32x16_bf16(kf[1],qr[0],negm,0,0,0), P0[6],P0[7],P0[8],P0[9],     pw0[2]=PKW(P0,4), pw0[3]=PKW(P0,6), pw0); \
    VRD(1); SBAR(); GAPA(C0=__builtin_amdgcn_mfma_f32_32x32x16_bf16(kf[2],qr[1],C0,0,0,0),   P0[10],P0[11],P0[12],P0[13], pw1[0]=PKW(P0,8), pw1[1]=PKW(P0,10), pw1); \
    VRD(5); SBAR(); GAPA(C1=__builtin_amdgcn_mfma_f32_32x32x16_bf16(kf[3],qr[1],C1,0,0,0),   P0[14],P0[15],P1[0],P1[1],   pw1[2]=PKW(P0,12),pw1[3]=PKW(P0,14), pw1); \
    VRD(2); SBAR(); GAPA(C0=__builtin_amdgcn_mfma_f32_32x32x16_bf16(kf[4],qr[2],C0,0,0,0),   P1[2],P1[3],P1[4],P1[5],     pw2[0]=PKW(P1,0), pw2[1]=PKW(P1,2), pw2); \
    VRD(6); SBAR(); GAPA(C1=__builtin_amdgcn_mfma_f32_32x32x16_bf16(kf[5],qr[2],C1,0,0,0),   P1[6],P1[7],P1[8],P1[9],     pw2[2]=PKW(P1,4), pw2[3]=PKW(P1,6), pw2); \
    VRD(3); SBAR(); GAPA(C0=__builtin_amdgcn_mfma_f32_32x32x16_bf16(kf[6],qr[3],C0,0,0,0),   P1[10],P1[11],P1[12],P1[13], pw3[0]=PKW(P1,8), pw3[1]=PKW(P1,10), pw3); \
    VRD(7); SBAR(); GAPA(C1=__builtin_amdgcn_mfma_f32_32x32x16_bf16(kf[7],qr[3],C1,0,0,0),   P1[14],P1[15],0.f,0.f,       pw3[2]=PKW(P1,12),pw3[3]=PKW(P1,14), pw3); \
    l_reg+=sacc; \
    if(GK){DMA_K((t)+3,sl_cur);} if(GV){DMA_V((t)+1,sl_next);} \
    SBAR(); \
    GAPB(o[0]=__builtin_amdgcn_mfma_f32_32x32x16_bf16(PAF(0),VFR(0),o[0],0,0,0), C0,0); \
    GAPB(o[1]=__builtin_amdgcn_mfma_f32_32x32x16_bf16(PAF(0),VFR(4),o[1],0,0,0), C0,4); \
    KRD(GL,0); GAPB(o[0]=__builtin_amdgcn_mfma_f32_32x32x16_bf16(PAF(1),VFR(1),o[0],0,0,0), C0,8); \
    KRD(GL,1); GAPB(o[1]=__builtin_amdgcn_mfma_f32_32x32x16_bf16(PAF(1),VFR(5),o[1],0,0,0), C0,12); \
    KRD(GL,2); GAPB(o[0]=__builtin_amdgcn_mfma_f32_32x32x16_bf16(PAF(2),VFR(2),o[0],0,0,0), C1,0); \
    KRD(GL,3); GAPB(o[1]=__builtin_amdgcn_mfma_f32_32x32x16_bf16(PAF(2),VFR(6),o[1],0,0,0), C1,4); \
    GAPB(o[0]=__builtin_amdgcn_mfma_f32_32x32x16_bf16(PAF(3),VFR(3),o[0],0,0,0), C1,8); \
    GAPB(o[1]=__builtin_amdgcn_mfma_f32_32x32x16_bf16(PAF(3),VFR(7),o[1],0,0,0), C1,12); \
    }while(0)
  int t=1;
  for(;t+5<NT;t+=2){
    STEP(pB0,pB1,pA0,pA1,t,true,true,true);     WAIT_BAR(2); ROT();
    STEP(pA0,pA1,pB0,pB1,t+1,true,true,true);   WAIT_BAR(2); ROT();
  }
  #define ENDW(tt) do{ if((tt)+3<NT){WAIT_BAR(2);} else if((tt)+2<NT){WAIT_BAR(1);} else {WAIT_BAR(0);} }while(0)
  for(;t+1<NT;t+=2){
    STEP(pB0,pB1,pA0,pA1,t,(t+3<NT),(t+1<NT),(t+1<NT));       ENDW(t);   ROT();
    STEP(pA0,pA1,pB0,pB1,t+1,(t+4<NT),(t+2<NT),(t+2<NT));     ENDW(t+1); ROT();
  }
  STEP(pB0,pB1,pA0,pA1,NT-1,false,false,false);
  { float sacc=pB0[0]+pB0[1]; _Pragma("unroll") for(int r=2;r<16;++r)sacc+=pB0[r]; _Pragma("unroll") for(int r=0;r<16;++r)sacc+=pB1[r]; l_reg+=sacc;
    pw0=(u32x4){PKW(pB0,0),PKW(pB0,2),PKW(pB0,4),PKW(pB0,6)};pw1=(u32x4){PKW(pB0,8),PKW(pB0,10),PKW(pB0,12),PKW(pB0,14)};pw2=(u32x4){PKW(pB1,0),PKW(pB1,2),PKW(pB1,4),PKW(pB1,6)};pw3=(u32x4){PKW(pB1,8),PKW(pB1,10),PKW(pB1,12),PKW(pB1,14)};
    SBAR(); pv(o,vb0+sl_cur,PAF(0),PAF(1),PAF(2),PAF(3)); }
  #undef PKW
  #undef PAF
  #undef VFR
  #undef PIN
  #undef MX3
  #undef GAPA
  #undef GAPB
  #undef EX
  #undef VRD
  #undef KRD
  #undef STEP
  #undef ENDW
  {auto rr=__builtin_amdgcn_permlane32_swap(__float_as_uint(l_reg),__float_as_uint(l_reg),false,false);l_reg=__uint_as_float(rr[0])+__uint_as_float(rr[1]);}
  if(hi==0)wsf[32+r32]=l_reg;asm volatile("s_waitcnt lgkmcnt(0)":::"memory");
  float rli[16];
  #pragma unroll
  for(int r=0;r<16;++r)rli[r]=__builtin_amdgcn_rcpf(wsf[32+crow(r,hi)]);
  bf16*Ow=Ow0+(long)(wid*QBLK)*OP;
  { bf16*stg=(bf16*)(shm+LDS_OST)+wid*2048;
    #pragma unroll
    for(int r=0;r<16;++r){const int orow=crow(r,hi);
      #pragma unroll
      for(int d0=0;d0<2;++d0)stg[orow*64+d0*32+r32]=__float2bfloat16(o[d0][r]*rli[r]);}
    asm volatile("s_waitcnt lgkmcnt(0)":::"memory");
    #pragma unroll
    for(int i=0;i<4;++i){const int row=i*8+(lane>>3),ch=lane&7; const u32x4 v=*(const u32x4*)(stg+row*64+ch*8); ATTN_STORE16(Ow+(long)row*OP+ch*8,v);} }
  asm volatile("s_waitcnt lgkmcnt(0)\n\ts_barrier":::"memory");
  #undef DMA_K
  #undef DMA_V
  #undef ROT
}
constexpr int ATTN_LDS_BYTES=LDS_BYTES;
#undef SBAR
#undef WAIT_BAR
}


using namespace cfg;
typedef unsigned short bf16_t;
typedef float f32x4 __attribute__((ext_vector_type(4)));
typedef unsigned u32x4 __attribute__((ext_vector_type(4)));
typedef unsigned u32x2 __attribute__((ext_vector_type(2)));

__device__ __forceinline__ float bf2f(unsigned v) { return __uint_as_float(v << 16); }
__device__ __forceinline__ float bflo(unsigned w) { return __uint_as_float(w << 16); }
__device__ __forceinline__ float bfhi(unsigned w) { return __uint_as_float(w & 0xffff0000u); }
__device__ __forceinline__ unsigned f2bf(float f) { unsigned u = __float_as_uint(f); return (u + 0x7fffu + ((u >> 16) & 1u)) >> 16; }
__device__ __forceinline__ unsigned pk2(float lo, float hi) { return f2bf(lo) | (f2bf(hi) << 16); }
__device__ __forceinline__ float sigm(float x) { return 1.f / (1.f + __expf(-x)); }
__device__ __forceinline__ float silu(float x) { return x / (1.f + __expf(-x)); }
template <int M> __device__ __forceinline__ float xsum(float v) {
    if constexpr (M < 32) return v + __uint_as_float((unsigned)__builtin_amdgcn_ds_swizzle((int)__float_as_uint(v), (M << 10) | 0x1f));
    else { auto rr = __builtin_amdgcn_permlane32_swap(__float_as_uint(v), __float_as_uint(v), false, false); return __uint_as_float(rr[0]) + __uint_as_float(rr[1]); }
}
__device__ __forceinline__ float wave_sum(float v) { v = xsum<1>(v); v = xsum<2>(v); v = xsum<4>(v); v = xsum<8>(v); v = xsum<16>(v); v = xsum<32>(v); return v; }
__device__ __forceinline__ size_t stream_off(int row, bool& is_ctx) { const int b = row / PB, p = row - b * PB; is_ctx = p < CTXL; return is_ctx ? ((size_t)b * CTXL + p) * D : ((size_t)b * SEQ + (p - CTXL)) * D; }

constexpr size_t MiB = 1u << 20;
constexpr size_t WS_CTL = 0;
constexpr size_t WS_MODV = 1 * MiB;
constexpr size_t WS_LBF = WS_MODV + 256 * 1024;
constexpr size_t WS_REF = WS_LBF + 8192;
constexpr size_t WS_POOLWT = WS_MODV + 512 * 1024;
constexpr size_t WS_COS = 2 * MiB, WS_SIN = 3 * MiB;
constexpr size_t WS_WIN = 4 * MiB;
constexpr size_t WS_WOUT = 13 * MiB;
constexpr size_t WS_WGU = 17 * MiB;
constexpr size_t WS_WD = 49 * MiB;
constexpr size_t WS_XC = 65 * MiB;
constexpr size_t WS_XN = 67 * MiB;
constexpr size_t WS_PROJ = 100 * MiB;
constexpr size_t WS_QN = 175 * MiB;
constexpr size_t WS_KN = 192 * MiB;
constexpr size_t WS_MIX = 197 * MiB;
constexpr size_t WS_UT = 230 * MiB;
constexpr size_t WS_ST = 247 * MiB;
constexpr size_t WS_DEC = 264 * MiB;
constexpr size_t WS_LIST = 265 * MiB;
constexpr size_t WS_ACT2 = WS_PROJ;
constexpr size_t WS_WGU1 = 272 * MiB;
constexpr size_t WS_WD1 = 304 * MiB;
constexpr size_t WS_END = 320 * MiB;
constexpr int CW_CNT = 1024;

__device__ const float ROPE_INV[16] = {1.0f, 0.5623413251903491f, 0.31622776601683794f, 0.1778279410038923f, 0.1f, 0.05623413251903491f, 0.03162277660168379f, 0.01778279410038923f,
                                       0.01f, 0.005623413251903491f, 0.0031622776601683794f, 0.0017782794100389228f, 0.001f, 0.0005623413251903491f, 0.00031622776601683794f, 0.00017782794100389227f};
__device__ __forceinline__ void sincos_d(double a, double& s, double& c) {
    const double k = rint(a * 0.63661977236758134308);
    double r = fma(-k, 1.57079632679489655800e+00, a);
    r = fma(-k, 6.12323399573676603587e-17, r);
    const double r2 = r * r;
    double sp = -7.6471637318198164759e-13;
    sp = fma(sp, r2, 1.6059043836821614599e-10);
    sp = fma(sp, r2, -2.5052108385441718775e-08);
    sp = fma(sp, r2, 2.7557319223985890653e-06);
    sp = fma(sp, r2, -1.9841269841269841270e-04);
    sp = fma(sp, r2, 8.3333333333333333333e-03);
    sp = fma(sp, r2, -1.6666666666666666667e-01);
    const double sr = fma(sp * r2, r, r);
    double cp = 4.7794773323873852974e-14;
    cp = fma(cp, r2, -1.1470745597729724714e-11);
    cp = fma(cp, r2, 2.0876756987868098979e-09);
    cp = fma(cp, r2, -2.7557319223985890653e-07);
    cp = fma(cp, r2, 2.4801587301587301587e-05);
    cp = fma(cp, r2, -1.3888888888888888889e-03);
    cp = fma(cp, r2, 4.1666666666666666667e-02);
    cp = fma(cp, r2, -0.5);
    const double cr = fma(cp, r2, 1.0);
    const int q = ((int)k) & 3;
    s = (q == 0) ? sr : (q == 1) ? cr : (q == 2) ? -sr : -cr;
    c = (q == 0) ? cr : (q == 1) ? -sr : (q == 2) ? -cr : sr;
}

__device__ __forceinline__ void transpose_items(const float* __restrict__ W, int K, int N, bf16_t* __restrict__ WT, int mode, int nbatch, size_t src_stride, size_t dst_stride, float* scr, int gw, int NGW, int lane, int it_lo = 0, int it_hi = 0x7fffffff) {
    const int nblk = N / 32, per = (K / 64) * nblk, nitems = per * nbatch;
    if (it_hi > nitems) it_hi = nitems;
    for (int it = it_lo + gw; it < it_hi; it += NGW) {
        const int bt = it / per, item = it - bt * per;
        const float* Wb = W + (size_t)bt * src_stride; bf16_t* WTb = WT + (size_t)bt * dst_stride;
        const int kb = item / nblk, nb = item - kb * nblk, k0 = 64 * kb, n0 = 32 * nb;
#pragma unroll 8
        for (int i = 0; i < 32; ++i) { const int kk = 2 * i + (lane >> 5); scr[kk * 33 + (lane & 31)] = Wb[(size_t)(k0 + kk) * N + n0 + (lane & 31)]; }
        asm volatile("s_waitcnt lgkmcnt(0)" ::: "memory");
        const int rbase = (mode == 0) ? n0 : ((n0 >> 7) * 256 + (mode == 2 ? 128 : 0) + (n0 & 127));
        const int cch = lane & 7;
#pragma unroll
        for (int j = 0; j < 4; ++j) { const int n = (lane >> 3) + 8 * j; const float* s = scr + (8 * cch) * 33 + n;
            u32x4 o; o.x = pk2(s[0 * 33], s[1 * 33]); o.y = pk2(s[2 * 33], s[3 * 33]); o.z = pk2(s[4 * 33], s[5 * 33]); o.w = pk2(s[6 * 33], s[7 * 33]);
            *(u32x4*)(WTb + (size_t)(rbase + n) * K + k0 + 8 * cch) = o; }
        asm volatile("s_waitcnt lgkmcnt(0)" ::: "memory");
    }
}
constexpr int MOE_ITEMS = 3 * 4096;
__device__ __forceinline__ void moe_weight_copies(const float* gate, const float* up, const float* down, bf16_t* WGU, bf16_t* WD, float* scr, int gw, int NGW, int lane, int lo, int hi) {
    if (lo < 4096) transpose_items(gate, D, DE, WGU, 1, NE, (size_t)D * DE, (size_t)1024 * D, scr, gw, NGW, lane, lo, hi < 4096 ? hi : 4096);
    if (lo < 8192 && hi > 4096) transpose_items(up, D, DE, WGU, 2, NE, (size_t)D * DE, (size_t)1024 * D, scr, gw, NGW, lane, lo > 4096 ? lo - 4096 : 0, hi < 8192 ? hi - 4096 : 4096);
    if (hi > 8192) transpose_items(down, DE, D, WD, 0, NE, (size_t)DE * D, (size_t)D * DE, scr, gw, NGW, lane, lo > 8192 ? lo - 8192 : 0, hi - 8192);
}
__device__ __forceinline__ void moe_filler(unsigned char* lds, const float* gate, const float* up, const float* down, unsigned char* ws, int lw, int lo, int hi, int U, int G, int c) {
    const int rem = U % G; int rank = c, nr = G;
    if (rem != 0) { if (c < rem) return; rank = c - rem; nr = G - rem; }
    const int tid = otid(); float* scr = (float*)(lds + 16384) + (tid >> 6) * (64 * 33);
    moe_weight_copies(gate + (size_t)lw * NE * D * DE, up + (size_t)lw * NE * D * DE, down + (size_t)lw * NE * DE * D, (bf16_t*)(ws + (lw ? WS_WGU1 : WS_WGU)), (bf16_t*)(ws + (lw ? WS_WD1 : WS_WD)), scr, rank * 8 + (tid >> 6), nr * 8, tid & 63, lo, hi);
}
struct ProArgs { const float *c, *c_ctx, *w_mod, *b_mod, *hgrn_lb, *qg, *kg, *w_in, *w_out, *pool_w, *gate, *up, *down; float *MODV, *LBF, *REF, *COS, *SIN; bf16_t *WIN, *WOUT, *POOLWT, *WGU, *WD; };
__device__ __forceinline__ void prologue_phase(unsigned char* lds, const ProArgs& a, int cu, int G) {
    const int tid = otid(), lane = tid & 63, wave = tid >> 6;
    for (int gid = cu * 512 + tid; gid < SEQ * 32; gid += G * 512) {
        const int t = gid >> 5, j = gid & 31;
        const float pos = (float)(j < 16 ? (t >> 6) : (t & 63));
        const float ang = pos * ROPE_INV[j & 15];
        double s, c; sincos_d((double)ang, s, c);
        a.COS[gid] = (float)c; a.SIN[gid] = (float)s;
    }
    if (cu == 0) {
        for (int gid = tid; gid < 1024; gid += 512) {
            const int l = gid >> 9, r = gid & 511; float v = 0.f;
            if (l == 1) v = 1.f / (1.f + expf(a.hgrn_lb[r] - a.hgrn_lb[512 + r]));
            a.LBF[gid] = fmaxf(v, 1e-30f); }
        if (tid < DEPTH) {
            float mq = 0.f, mk = 0.f;
            for (int i = 0; i < 64; ++i) { mq = fmaxf(mq, fabsf(a.qg[tid * 64 + i])); mk = fmaxf(mk, fabsf(a.kg[tid * 64 + i])); }
            a.REF[tid * 64] = -(64.f * C2 * mq * mk * 1.02f + 0.5f); }
    }
    {
        float* act = (float*)lds;
        float* part = (float*)(lds + 12288);
        for (int item = cu; item < 2 * 96; item += G) {
            const int l = item / 96, n0 = (item - l * 96) * 64;
            for (int i = tid; i < 3072; i += 512) { const int r = i >> 10, k = i & 1023; const float v = r < 2 ? a.c[r * 1024 + k] : a.c_ctx[k]; act[i] = silu(v); }
            __syncthreads();
            const float* w = a.w_mod + ((size_t)l * 1024 + (size_t)wave * 128) * 6144 + n0 + lane;
            float a0 = 0.f, a1 = 0.f, a2 = 0.f;
#pragma unroll 8
            for (int k = 0; k < 128; ++k) { const float wv = w[(size_t)k * 6144]; const int kk = wave * 128 + k; a0 += act[kk] * wv; a1 += act[1024 + kk] * wv; a2 += act[2048 + kk] * wv; }
            part[(wave * 3 + 0) * 64 + lane] = a0; part[(wave * 3 + 1) * 64 + lane] = a1; part[(wave * 3 + 2) * 64 + lane] = a2;
            __syncthreads();
            if (tid < 192) { const int r = tid >> 6, nn = tid & 63; float s = 0.f;
#pragma unroll
                for (int q = 0; q < 8; ++q) s += part[(q * 3 + r) * 64 + nn];
                a.MODV[(l * 3 + r) * 6144 + n0 + nn] = s + a.b_mod[l * 6144 + n0 + nn]; }
            __syncthreads();
        }
    }
    {
        float* scr = (float*)(lds + 16384) + wave * (64 * 33);
        const int gw = cu * 8 + wave, NGW = G * 8;
        transpose_items(a.w_in, D, NIN, a.WIN, 0, DEPTH, (size_t)D * NIN, (size_t)NIN * D, scr, gw, NGW, lane);
        transpose_items(a.w_out, D, D, a.WOUT, 0, DEPTH, (size_t)D * D, (size_t)D * D, scr, gw, NGW, lane);
        transpose_items(a.pool_w, 64, 64, a.POOLWT, 0, DEPTH * 4, (size_t)64 * 64, (size_t)64 * 64, scr, gw, NGW, lane);
    }
    __syncthreads();
}

namespace pool {
typedef float f32x16 __attribute__((ext_vector_type(16)));
typedef short bf16x8 __attribute__((ext_vector_type(8)));
constexpr int P = 72, O_X = 0  , O_DM = 81920  , O_OUT = 0  , OP = 264;
__device__ __forceinline__ int crow(int r, int hi) { return (r & 3) + 8 * (r >> 2) + 4 * hi; }
__device__ __forceinline__ void pool_phase(unsigned char* lds, const bf16_t* __restrict__ PROJ, const bf16_t* __restrict__ WT  , const float* __restrict__ pscale, bf16_t* __restrict__ MIX, int cu, int G) {
    const int tid = otid(), lane = tid & 63, r32 = lane & 31, hi = lane >> 5, w = __builtin_amdgcn_readfirstlane(tid >> 6);
    float* X = (float*)(lds + O_X); bf16_t* OUT = (bf16_t*)(lds + O_OUT);
    for (int u = cu; u < MT / 64; u += G) {
        const int row0 = u * 64, b = row0 / PB, p0 = row0 - b * PB; const bool is_ctx = p0 < CTXL;
        const int seg0 = b * PB + (is_ctx ? 0 : CTXL), len = is_ctx ? CTXL : SEQ, t0 = is_ctx ? p0 : p0 - CTXL;
#pragma unroll
        for (int it = 0; it < 5; ++it) { const int piece = tid + it * 512, rr = piece >> 5, pc = piece & 31, t = t0 - 8 + rr;
            u32x4 v = {0u, 0u, 0u, 0u};
            if (t >= 0 && t < len) v = *(const u32x4*)(PROJ + (size_t)(seg0 + t) * NIN + C_BP + pc * 8);
            float* x = X + rr * 256 + pc * 8;
            *(f32x4*)x = (f32x4){bflo(v.x), bfhi(v.x), bflo(v.y), bfhi(v.y)}; *(f32x4*)(x + 4) = (f32x4){bflo(v.z), bfhi(v.z), bflo(v.w), bfhi(v.w)}; }
        __syncthreads();
        {
            const int c = tid & 255, th = tid >> 8, g = c >> 6, hw = 1 << g;
            bf16_t* dm = (bf16_t*)(lds + O_DM) + g * 64 * P + (c & 63);
            for (int tt = 0; tt < 32; ++tt) { const int t = th * 32 + tt, tg = t0 + t;
                int lo = tg - hw; if (lo < 0) lo = 0; int hi2 = tg + hw; if (hi2 > len) hi2 = len;
                float s = 0.f;
                for (int q = lo; q < hi2; ++q) s += X[(q - t0 + 8) * 256 + c];
                dm[t * P] = (bf16_t)f2bf(s / (float)(hi2 - lo) - X[(t + 8) * 256 + c]); }
        }
        __syncthreads();
        {
            const int g = w >> 1, tb = w & 1;
            const bf16_t* A = (const bf16_t*)(lds + O_DM) + g * 64 * P + (tb * 32 + r32) * P + hi * 8;
#pragma unroll
            for (int eb = 0; eb < 2; ++eb) {
                const bf16_t* Bp = WT + (size_t)g * 4096 + (eb * 32 + r32) * 64 + hi * 8;
                f32x16 acc = {};
#pragma unroll
                for (int ks = 0; ks < 4; ++ks) acc = __builtin_amdgcn_mfma_f32_32x32x16_bf16(*(const bf16x8*)(A + ks * 16), *(const bf16x8*)(Bp + ks * 16), acc, 0, 0, 0);
                const int e = g * 64 + eb * 32 + r32; const float sc = pscale[e];
#pragma unroll
                for (int r = 0; r < 16; ++r) OUT[(tb * 32 + crow(r, hi)) * OP + e] = (bf16_t)f2bf(acc[r] * sc);
            }
        }
        __syncthreads();
#pragma unroll
        for (int it = 0; it < 4; ++it) { const int piece = tid + it * 512, t = piece >> 5, pc = piece & 31;
            *(u32x4*)(MIX + (size_t)(row0 + t) * D + 256 + pc * 8) = *(const u32x4*)(OUT + t * OP + pc * 8); }
        __syncthreads();
    }
}
}

#ifndef LAS
#define LAS __attribute__((address_space(3)))
#endif
__device__ __forceinline__ void norm1_phase(int cu, int G, const float* __restrict__ lat, const float* __restrict__ cx, const float* __restrict__ g, const float* __restrict__ modv, int sh_off, bf16_t* __restrict__ XN) {
    const int lane = otid() & 63, gw = cu * 8 + (otid() >> 6), NGW = G * 8;
    for (int row0 = gw * 4; row0 < MT; row0 += NGW * 4) {
        bool is_ctx; const size_t off = stream_off(row0, is_ctx);
        const int r = is_ctx ? 2 : row0 / PB;
        const f32x4* xr = (const f32x4*)((is_ctx ? cx : lat) + off) + lane;
        f32x4 v[4][4]; float ss[4];
#pragma unroll
        for (int q = 0; q < 4; ++q) { ss[q] = 0.f;
#pragma unroll
            for (int j = 0; j < 4; ++j) v[q][j] = xr[q * 256 + 64 * j]; }
        const float* mv = modv + r * 6144 + sh_off;
        f32x4 gs[4], sh[4];
#pragma unroll
        for (int j = 0; j < 4; ++j) { const int col = 4 * lane + 256 * j; gs[j] = *(const f32x4*)(g + col) * (*(const f32x4*)(mv + 1024 + col) + 1.f); sh[j] = *(const f32x4*)(mv + col); }
#pragma unroll
        for (int q = 0; q < 4; ++q) {
#pragma unroll
            for (int j = 0; j < 4; ++j) ss[q] += (v[q][j].x * v[q][j].x + v[q][j].y * v[q][j].y) + (v[q][j].z * v[q][j].z + v[q][j].w * v[q][j].w);
            const float rstd = 1.f / sqrtf(wave_sum(ss[q]) * (1.f / D) + EPS);
#pragma unroll
            for (int j = 0; j < 4; ++j) { const f32x4 o = v[q][j] * rstd * gs[j] + sh[j];
                u32x2 w; w.x = pk2(o.x, o.y); w.y = pk2(o.z, o.w);
                *(u32x2*)(XN + (size_t)(row0 + q) * D + 4 * lane + 256 * j) = w; } }
    }
}

__device__ __forceinline__ void norm2_router_phase(unsigned char* lds, int cu, int G, const float* __restrict__ lat, const float* __restrict__ cx, const float* __restrict__ g, const float* __restrict__ modv, int sh_off,
                                                   const float* __restrict__ router_w, const float* __restrict__ router_b, bf16_t* __restrict__ XN, unsigned* __restrict__ cnt, u32x4* __restrict__ LIST, int route_ctx) {
    const int tid = otid(), lane = tid & 63, wave = tid >> 6, gw = cu * 8 + wave, NGW = G * 8;
    float* RW = (float*)lds;
    u32x4* ENT = (u32x4*)(lds + 65536) + wave * 64;
    LAS unsigned* BC = (LAS unsigned*)((LAS unsigned char*)lds + 65536 + 8192);
#pragma unroll
    for (int it = 0; it < 8; ++it) { const int p = tid + it * 512, col = p >> 2, q = p & 3; const f32x4 w4 = *(const f32x4*)(router_w + (size_t)col * 16 + 4 * q);
        RW[(4 * q + 0) * 1024 + col] = w4.x; RW[(4 * q + 1) * 1024 + col] = w4.y; RW[(4 * q + 2) * 1024 + col] = w4.z; RW[(4 * q + 3) * 1024 + col] = w4.w; }
    if (tid < 48) BC[tid] = 0u;
    __syncthreads();
    int nent = 0;
    f32x4 vn[4];
    { int row = gw < MT ? gw : 0; bool ic; const size_t off = stream_off(row, ic); const f32x4* xr = (const f32x4*)((ic ? cx : lat) + off) + lane;
#pragma unroll
      for (int j = 0; j < 4; ++j) vn[j] = xr[64 * j]; }
    for (int row = gw; row < MT; row += NGW) {
        f32x4 v[4];
#pragma unroll
        for (int j = 0; j < 4; ++j) v[j] = vn[j];
        { const int nr = row + NGW < MT ? row + NGW : row; bool ic; const size_t off = stream_off(nr, ic); const f32x4* xr = (const f32x4*)((ic ? cx : lat) + off) + lane;
#pragma unroll
          for (int j = 0; j < 4; ++j) vn[j] = xr[64 * j]; }
        bool is_ctx; (void)stream_off(row, is_ctx);
        if (is_ctx && !route_ctx) continue;
        const int r = is_ctx ? 2 : row / PB;
        float ss = 0.f;
#pragma unroll
        for (int j = 0; j < 4; ++j) ss += (v[j].x * v[j].x + v[j].y * v[j].y) + (v[j].z * v[j].z + v[j].w * v[j].w);
        const float rstd = 1.f / sqrtf(wave_sum(ss) * (1.f / D) + EPS);
        const float* mv = modv + r * 6144 + sh_off;
#pragma unroll
        for (int j = 0; j < 4; ++j) { const int col = 4 * lane + 256 * j;
            const f32x4 gg = *(const f32x4*)(g + col), sh = *(const f32x4*)(mv + col), sc = *(const f32x4*)(mv + 1024 + col);
            v[j] = v[j] * rstd * gg * (sc + 1.f) + sh;
            u32x2 w; w.x = pk2(v[j].x, v[j].y); w.y = pk2(v[j].z, v[j].w);
            *(u32x2*)(XN + (size_t)row * D + col) = w; }
        float sc_[16], sel[16];
#pragma unroll
        for (int e = 0; e < 16; ++e) { float a = 0.f;
#pragma unroll
            for (int j = 0; j < 4; ++j) { const f32x4 w4 = *(const f32x4*)(RW + e * 1024 + 256 * j + 4 * lane); a += (v[j].x * w4.x + v[j].y * w4.y) + (v[j].z * w4.z + v[j].w * w4.w); }
            a = wave_sum(a); sc_[e] = 1.f / (1.f + __expf(-a)); sel[e] = sc_[e] + router_b[e]; }
        float gs[4]; int gi1[4], gi2[4]; float gw1[4], gw2[4];
#pragma unroll
        for (int q = 0; q < 4; ++q) { float v1 = -INFINITY, v2 = -INFINITY; int i1 = 0, i2 = 0; float s1 = 0.f, s2 = 0.f;
#pragma unroll
            for (int k = 0; k < 4; ++k) { const float x = sel[4 * q + k], sx = sc_[4 * q + k];
                if (x > v1) { v2 = v1; i2 = i1; s2 = s1; v1 = x; i1 = 4 * q + k; s1 = sx; } else if (x > v2) { v2 = x; i2 = 4 * q + k; s2 = sx; } }
            gs[q] = v1 + v2; gi1[q] = i1; gi2[q] = i2; gw1[q] = s1; gw2[q] = s2; }
        float bv = gs[0]; int e0 = gi1[0], e1 = gi2[0]; float w0 = gw1[0], w1 = gw2[0];
#pragma unroll
        for (int q = 1; q < 4; ++q) if (gs[q] > bv) { bv = gs[q]; e0 = gi1[q]; e1 = gi2[q]; w0 = gw1[q]; w1 = gw2[q]; }
        const float ws = w0 + w1; w0 /= ws; w1 /= ws;
        {
            const int gq = e0 >> 2; int a = e0 & 3, c = e1 & 3; float wa = w0, wc = w1;
            if (a > c) { const int ti = a; a = c; c = ti; const float tf = wa; wa = wc; wc = tf; }
            const int pi = (a == 0) ? (c - 1) : (a == 1 ? c + 1 : 5);
            const int bk = gq * 6 + pi;
            if (lane == 0) { const unsigned loc = __hip_atomic_fetch_add(BC + bk, 1u, __ATOMIC_RELAXED, __HIP_MEMORY_SCOPE_WORKGROUP);
                u32x4 sv; sv.x = (unsigned)bk | (loc << 8); sv.y = (unsigned)row; sv.z = __float_as_uint(wa); sv.w = __float_as_uint(wc); ENT[nent] = sv; }
            ++nent; }
    }
    __syncthreads();
    if (tid < 24) { const unsigned n = BC[tid]; BC[24 + tid] = n ? __hip_atomic_fetch_add(cnt + tid, n, __ATOMIC_RELAXED, __HIP_MEMORY_SCOPE_AGENT) : 0u; }
    __syncthreads();
    if (lane < nent) { const u32x4 en = ENT[lane]; const unsigned bk = en.x & 255u, slot = BC[24 + bk] + (en.x >> 8);
        u32x4 sv; sv.x = en.y; sv.y = en.z; sv.z = en.w; sv.w = 0u; LIST[(size_t)bk * MT + slot] = sv; }
    __syncthreads();
}

__device__ __forceinline__ void post_phase(int cu, int G, const bf16_t* __restrict__ PROJ, const float* __restrict__ qg, const float* __restrict__ kg, const float* __restrict__ COS, const float* __restrict__ SIN,
                                              bf16_t* __restrict__ QN, bf16_t* __restrict__ KN) {
    const int lane = otid() & 63, gw = cu * 8 + (otid() >> 6), NGW = G * 8;
    const int d0 = (lane & 7) * 8, jk = lane & 31;
    float qgv[8];
#pragma unroll
    for (int i = 0; i < 8; ++i) qgv[i] = qg[d0 + i];
    const float kg0 = kg[2 * jk], kg1 = kg[2 * jk + 1];
    for (int row0 = gw * 4; row0 < MT; row0 += NGW * 4) {
        const int b = row0 / PB, p0 = row0 - b * PB; const bool is_ctx = p0 < CTXL; const int t0 = is_ctx ? 0 : p0 - CTXL;
        u32x4 wq[4]; unsigned wk[4]; f32x4 cq[4], sq[4]; float ck[4], sk[4];
#pragma unroll
        for (int q = 0; q < 4; ++q) { const bf16_t* pr = PROJ + (size_t)(row0 + q) * NIN;
            wq[q] = *(const u32x4*)(pr + C_CQ + lane * 8); wk[q] = *(const unsigned*)(pr + C_CK + lane * 2);
            const int t = is_ctx ? 0 : t0 + q;
            cq[q] = *(const f32x4*)(COS + t * 32 + (d0 >> 1)); sq[q] = *(const f32x4*)(SIN + t * 32 + (d0 >> 1)); ck[q] = COS[t * 32 + jk]; sk[q] = SIN[t * 32 + jk]; }
#pragma unroll
        for (int q = 0; q < 4; ++q) {
            {
                const u32x4 w = wq[q];
                float x[8] = {bflo(w.x), bfhi(w.x), bflo(w.y), bfhi(w.y), bflo(w.z), bfhi(w.z), bflo(w.w), bfhi(w.w)};
                float ss = 0.f;
#pragma unroll
                for (int i = 0; i < 8; ++i) ss += x[i] * x[i];
                ss = xsum<1>(ss); ss = xsum<2>(ss); ss = xsum<4>(ss);
                const float rstd = 1.f / sqrtf(ss * (1.f / 64.f) + EPS);
#pragma unroll
                for (int i = 0; i < 8; ++i) x[i] = x[i] * rstd * qgv[i];
                if (!is_ctx) {
#pragma unroll
                    for (int i = 0; i < 4; ++i) { const float cs = cq[q][i], sn = sq[q][i];
                        const float x1 = x[2 * i], x2 = x[2 * i + 1]; x[2 * i] = x1 * cs - x2 * sn; x[2 * i + 1] = x1 * sn + x2 * cs; } }
                u32x4 o; o.x = pk2(x[0] * C2, x[1] * C2); o.y = pk2(x[2] * C2, x[3] * C2); o.z = pk2(x[4] * C2, x[5] * C2); o.w = pk2(x[6] * C2, x[7] * C2);
                *(u32x4*)(QN + (size_t)(row0 + q) * 512 + lane * 8) = o;
            }
            {
                float x1 = bflo(wk[q]), x2 = bfhi(wk[q]);
                float ss = x1 * x1 + x2 * x2;
                ss = xsum<1>(ss); ss = xsum<2>(ss); ss = xsum<4>(ss); ss = xsum<8>(ss); ss = xsum<16>(ss);
                const float rstd = 1.f / sqrtf(ss * (1.f / 64.f) + EPS);
                x1 = x1 * rstd * kg0; x2 = x2 * rstd * kg1;
                if (!is_ctx) { const float cs = ck[q], sn = sk[q]; const float a = x1 * cs - x2 * sn, c = x1 * sn + x2 * cs; x1 = a; x2 = c; }
                *(unsigned*)(KN + (size_t)(row0 + q) * 128 + lane * 2) = pk2(x1, x2);
            }
        }
    }
}

namespace hg {
typedef float f32x16 __attribute__((ext_vector_type(16)));
typedef short bf16x8 __attribute__((ext_vector_type(8)));
typedef short s16x4 __attribute__((ext_vector_type(4)));
typedef float f32x2 __attribute__((ext_vector_type(2)));
constexpr int P = 72;
constexpr int O_ZB = 0, O_ZQ = 32768, O_VT = 40960, O_QH = 50176, O_QT = 68608, O_KH = 87040, O_ST = 105472, O_SSQ = 123904, O_OUT = 0  , O_TOT = 0, LDS_BYTES = 124416;
constexpr int MSZ = 64 * P * 2;
constexpr int NCH = PB / 64;
__device__ __forceinline__ int crow(int r, int hi) { return (r & 3) + 8 * (r >> 2) + 4 * hi; }
__device__ __forceinline__ unsigned cvtpk(float lo, float hi) { typedef __bf16 b2 __attribute__((ext_vector_type(2))); f32x2 v = {lo, hi}; b2 b = __builtin_convertvector(v, b2); return __builtin_bit_cast(unsigned, b); }
__device__ __forceinline__ float clampe(float e) { return fminf(fmaxf(e, -80.f), 80.f); }

template <bool FULL> __device__ __forceinline__ void prep(unsigned char* lds, const bf16_t* __restrict__ PROJ, const float* __restrict__ LBFl, int row0, int h) {
    const int tid = otid();
    float* ZB = (float*)(lds + O_ZB); bf16_t* ZQ = (bf16_t*)(lds + O_ZQ); bf16_t* VT = (bf16_t*)(lds + O_VT);
    {
        const int t = tid >> 3, pc = tid & 7;
        const bf16_t* pr = PROJ + (size_t)(row0 + t) * NIN + h * 64 + pc * 8;
        const u32x4 wf = *(const u32x4*)(pr + C_AFF), wb = *(const u32x4*)(pr + C_AFB), wv = *(const u32x4*)(pr + C_AI);
        float* zf = ZB + t * 64 + pc * 8; float* zb = ZB + 4096 + t * 64 + pc * 8;
        *(f32x4*)zf = (f32x4){bflo(wf.x), bfhi(wf.x), bflo(wf.y), bfhi(wf.y)}; *(f32x4*)(zf + 4) = (f32x4){bflo(wf.z), bfhi(wf.z), bflo(wf.w), bfhi(wf.w)};
        *(f32x4*)zb = (f32x4){bflo(wb.x), bfhi(wb.x), bflo(wb.y), bfhi(wb.y)}; *(f32x4*)(zb + 4) = (f32x4){bflo(wb.z), bfhi(wb.z), bflo(wb.w), bfhi(wb.w)};
        bf16_t* vt = VT + (pc * 8) * P + t;
        vt[0 * P] = (bf16_t)(wv.x & 0xffffu); vt[1 * P] = (bf16_t)(wv.x >> 16); vt[2 * P] = (bf16_t)(wv.y & 0xffffu); vt[3 * P] = (bf16_t)(wv.y >> 16);
        vt[4 * P] = (bf16_t)(wv.z & 0xffffu); vt[5 * P] = (bf16_t)(wv.z >> 16); vt[6 * P] = (bf16_t)(wv.w & 0xffffu); vt[7 * P] = (bf16_t)(wv.w >> 16);
        if (FULL) { const u32x4 wq = *(const u32x4*)(pr + C_AQ); *(u32x4*)(ZQ + t * 64 + pc * 8) = wq; }
    }
    __syncthreads();
#pragma unroll
    for (int it = 0; it < 2; ++it) {
        const int item = tid + it * 512, dir = item >> 9, t = (item >> 3) & 63, i0 = (item & 7) * 8;
        float* zp = ZB + dir * 4096 + t * 64 + i0; const float* lp = LBFl + dir * 256 + h * 64 + i0;
        f32x4 za = *(const f32x4*)zp, zc = *(const f32x4*)(zp + 4); const f32x4 la = *(const f32x4*)lp, lc = *(const f32x4*)(lp + 4);
#pragma unroll
        for (int k = 0; k < 4; ++k) { za[k] = __logf(la[k] + (1.f - la[k]) / (1.f + __expf(-za[k]))); zc[k] = __logf(lc[k] + (1.f - lc[k]) / (1.f + __expf(-zc[k]))); }
        *(f32x4*)zp = za; *(f32x4*)(zp + 4) = zc;
    }
    __syncthreads();
    if (tid < 128) {
        const int dir = tid >> 6, i = tid & 63;
        float* zb = ZB + dir * 4096 + i; float acc = 0.f;
        if (dir == 0) {
#pragma unroll 16
            for (int t = 0; t < 64; ++t) { acc += zb[t * 64]; zb[t * 64] = acc; } }
        else {
#pragma unroll 16
            for (int t = 63; t >= 0; --t) { acc += zb[t * 64]; zb[t * 64] = acc; } }
    }
    __syncthreads();
#pragma unroll
    for (int it = 0; it < 2; ++it) {
        const int item = tid + it * 512, dir = item >> 9, t = (item >> 3) & 63, i0 = (item & 7) * 8;
        const float* B = ZB + dir * 4096;
        const int tp = dir == 0 ? t - 1 : t + 1; const bool edge = dir == 0 ? (t == 0) : (t == 63);
        const int tref = dir == 0 ? 31 : 32;
        float bc[8], bp[8], br[8];
        { const f32x4 a = *(const f32x4*)(B + t * 64 + i0), c = *(const f32x4*)(B + t * 64 + i0 + 4); bc[0] = a.x; bc[1] = a.y; bc[2] = a.z; bc[3] = a.w; bc[4] = c.x; bc[5] = c.y; bc[6] = c.z; bc[7] = c.w; }
        { const int tq = edge ? t : tp; const f32x4 a = *(const f32x4*)(B + tq * 64 + i0), c = *(const f32x4*)(B + tq * 64 + i0 + 4);
          bp[0] = a.x; bp[1] = a.y; bp[2] = a.z; bp[3] = a.w; bp[4] = c.x; bp[5] = c.y; bp[6] = c.z; bp[7] = c.w;
          if (edge) {
#pragma unroll
              for (int k = 0; k < 8; ++k) bp[k] = 0.f; } }
        { const f32x4 a = *(const f32x4*)(B + tref * 64 + i0), c = *(const f32x4*)(B + tref * 64 + i0 + 4); br[0] = a.x; br[1] = a.y; br[2] = a.z; br[3] = a.w; br[4] = c.x; br[5] = c.y; br[6] = c.z; br[7] = c.w; }
        float kh[8];
#pragma unroll
        for (int k = 0; k < 8; ++k) { const float kk = 1.f - __expf(bc[k] - bp[k]); kh[k] = kk * __expf(clampe(br[k] - bc[k])); }
        if (!FULL) {
            bf16_t* kt = (bf16_t*)(lds + O_KH + dir * MSZ) + i0 * P + t;
#pragma unroll
            for (int k = 0; k < 8; ++k) kt[k * P] = (bf16_t)f2bf(kh[k]);
        } else {
            u32x4 w; w.x = cvtpk(kh[0], kh[1]); w.y = cvtpk(kh[2], kh[3]); w.z = cvtpk(kh[4], kh[5]); w.w = cvtpk(kh[6], kh[7]);
            *(u32x4*)((bf16_t*)(lds + O_KH + dir * MSZ) + t * P + i0) = w;
            const u32x4 wq = *(const u32x4*)(ZQ + t * 64 + i0);
            float q[8] = {silu(bflo(wq.x)), silu(bfhi(wq.x)), silu(bflo(wq.y)), silu(bfhi(wq.y)), silu(bflo(wq.z)), silu(bfhi(wq.z)), silu(bflo(wq.w)), silu(bfhi(wq.w))};
            float qh[8], qt[8];
#pragma unroll
            for (int k = 0; k < 8; ++k) { qh[k] = q[k] * __expf(clampe(bc[k] - br[k])); qt[k] = q[k] * __expf(bc[k]); }
            w.x = cvtpk(qh[0], qh[1]); w.y = cvtpk(qh[2], qh[3]); w.z = cvtpk(qh[4], qh[5]); w.w = cvtpk(qh[6], qh[7]);
            *(u32x4*)((bf16_t*)(lds + O_QH + dir * MSZ) + t * P + i0) = w;
            w.x = cvtpk(qt[0], qt[1]); w.y = cvtpk(qt[2], qt[3]); w.z = cvtpk(qt[4], qt[5]); w.w = cvtpk(qt[6], qt[7]);
            *(u32x4*)((bf16_t*)(lds + O_QT + dir * MSZ) + t * P + i0) = w;
        }
    }
    __syncthreads();
}

__device__ __forceinline__ void h1_phase(unsigned char* lds, const bf16_t* __restrict__ PROJ, const float* __restrict__ LBFl, bf16_t* __restrict__ UT, float* __restrict__ DEC, int cu, int G) {
    const int tid = otid(), lane = tid & 63, r32 = lane & 31, hi = lane >> 5, w = __builtin_amdgcn_readfirstlane(tid >> 6);
    for (int u = cu; u < BATCH * NCH * 4; u += G) {
        const int h = u & 3, bc = u >> 2, b = bc / NCH, cp = bc - b * NCH, row0 = b * PB + cp * 64;
        prep<false>(lds, PROJ, LBFl, row0, h);
        const float* ZB = (const float*)(lds + O_ZB);
        {
            const int dir = w >> 2, jb = (w >> 1) & 1, ib = w & 1;
            const bf16_t* VT = (const bf16_t*)(lds + O_VT) + (jb * 32 + r32) * P + hi * 8;
            const bf16_t* KT = (const bf16_t*)(lds + O_KH + dir * MSZ) + (ib * 32 + r32) * P + hi * 8;
            f32x16 acc = {};
#pragma unroll
            for (int ks = 0; ks < 4; ++ks) acc = __builtin_amdgcn_mfma_f32_32x32x16_bf16(*(const bf16x8*)(VT + ks * 16), *(const bf16x8*)(KT + ks * 16), acc, 0, 0, 0);
            const int i = ib * 32 + r32;
            const float btot = ZB[dir * 4096 + (dir == 0 ? 63 : 0) * 64 + i], bref = ZB[dir * 4096 + (dir == 0 ? 31 : 32) * 64 + i];
            const float sc = __expf(btot - bref);
            const int chain = (b * 4 + h) * 2 + dir;
            bf16_t* ut = UT + ((size_t)chain * NCH + cp) * 4096 + i;
#pragma unroll
            for (int r = 0; r < 16; ++r) ut[(jb * 32 + crow(r, hi)) * 64] = (bf16_t)f2bf(acc[r] * sc);
        }
        if (tid < 128) { const int dir = tid >> 6, i = tid & 63; const int chain = (b * 4 + h) * 2 + dir;
            DEC[((size_t)chain * NCH + cp) * 64 + i] = __expf(ZB[dir * 4096 + (dir == 0 ? 63 : 0) * 64 + i]); }
        __syncthreads();
    }
}

__device__ __forceinline__ void h2_phase(unsigned char* lds, const bf16_t* __restrict__ UT, const float* __restrict__ DEC, bf16_t* __restrict__ ST, int cu, int G) {
    const int tid = otid(), seg = tid >> 7, e = tid & 127, jl = e >> 5, i = (e & 31) * 2;
    f32x4* TOT = (f32x4*)(lds + O_TOT);
    for (int task = cu; task < 256; task += G) {
        const int chain = task >> 4, j = (task & 15) * 4 + jl, dir = chain & 1;
        const size_t cbase = (size_t)chain * NCH;
        float S0 = 0.f, S1 = 0.f, P0 = 1.f, P1 = 1.f;
#pragma unroll 11
        for (int kk = 0; kk < 33; ++kk) { const int k = seg * 33 + kk, cp = dir == 0 ? k : (k < 4 ? 3 - k : 135 - k);
            const unsigned u = *(const unsigned*)(UT + (cbase + cp) * 4096 + j * 64 + i); const f32x2 d = *(const f32x2*)(DEC + (cbase + cp) * 64 + i);
            S0 = d.x * S0 + bflo(u); S1 = d.y * S1 + bfhi(u); P0 *= d.x; P1 *= d.y; }
        TOT[seg * 128 + e] = (f32x4){S0, S1, P0, P1};
        __syncthreads();
        float s0 = 0.f, s1 = 0.f;
#pragma unroll
        for (int sp = 0; sp < 3; ++sp) if (sp < seg) { const f32x4 t = TOT[sp * 128 + e]; s0 = t.z * s0 + t.x; s1 = t.w * s1 + t.y; }
#pragma unroll 11
        for (int kk = 0; kk < 33; ++kk) { const int k = seg * 33 + kk, cp = dir == 0 ? k : (k < 4 ? 3 - k : 135 - k);
            const unsigned u = *(const unsigned*)(UT + (cbase + cp) * 4096 + j * 64 + i); const f32x2 d = *(const f32x2*)(DEC + (cbase + cp) * 64 + i);
            *(unsigned*)(ST + (cbase + cp) * 4096 + j * 64 + i) = pk2(s0, s1);
            s0 = d.x * s0 + bflo(u); s1 = d.y * s1 + bfhi(u); }
        __syncthreads();
    }
}

__device__ __forceinline__ void h3_phase(unsigned char* lds, const bf16_t* __restrict__ PROJ, const float* __restrict__ LBFl, const bf16_t* __restrict__ ST, const float* __restrict__ ng, bf16_t* __restrict__ MIX, int cu, int G) {
    const int tid = otid(), lane = tid & 63, r32 = lane & 31, hi = lane >> 5, w = __builtin_amdgcn_readfirstlane(tid >> 6);
    for (int u = cu; u < BATCH * NCH * 4; u += G) {
        const int h = u & 3, bc = u >> 2, b = bc / NCH, cp = bc - b * NCH, row0 = b * PB + cp * 64;
        {
            const int j = tid >> 3, ic = (tid & 7) * 8;
#pragma unroll
            for (int dir = 0; dir < 2; ++dir) { const int chain = (b * 4 + h) * 2 + dir;
                const u32x4 sv = *(const u32x4*)(ST + ((size_t)chain * NCH + cp) * 4096 + j * 64 + ic);
                *(u32x4*)((bf16_t*)(lds + O_ST + dir * MSZ) + j * P + ic) = sv; }
        }
        prep<true>(lds, PROJ, LBFl, row0, h);
        float* SSQ = (float*)(lds + O_SSQ); bf16_t* OUT = (bf16_t*)(lds + O_OUT);
        f32x16 ot = {};
        const int jb = (w >> 1) & 1, tb = w & 1;
        if (w < 4) {
            const bf16_t* VT = (const bf16_t*)(lds + O_VT) + (jb * 32 + r32) * P;
#pragma unroll
            for (int sb = 0; sb < 2; ++sb) {
                f32x16 xf = {}, xb = {};
                const bf16_t* QF = (const bf16_t*)(lds + O_QH) + (tb * 32 + r32) * P + hi * 8; const bf16_t* QB = QF + 64 * P;
                const bf16_t* KF = (const bf16_t*)(lds + O_KH) + (sb * 32 + r32) * P + hi * 8; const bf16_t* KB = KF + 64 * P;
                if (sb <= tb) {
#pragma unroll
                    for (int ks = 0; ks < 4; ++ks) xf = __builtin_amdgcn_mfma_f32_32x32x16_bf16(*(const bf16x8*)(KF + ks * 16), *(const bf16x8*)(QF + ks * 16), xf, 0, 0, 0); }
                if (sb >= tb) {
#pragma unroll
                    for (int ks = 0; ks < 4; ++ks) xb = __builtin_amdgcn_mfma_f32_32x32x16_bf16(*(const bf16x8*)(KB + ks * 16), *(const bf16x8*)(QB + ks * 16), xb, 0, 0, 0); }
                float x[16];
#pragma unroll
                for (int r = 0; r < 16; ++r) { const int s = crow(r, hi), t = r32;
                    const float vf = (sb < tb || (sb == tb && s <= t)) ? xf[r] : 0.f, vb = (sb > tb || (sb == tb && s >= t)) ? xb[r] : 0.f; x[r] = vf + vb; }
#pragma unroll
                for (int sp = 0; sp < 2; ++sp) {
                    u32x4 xw; xw.x = cvtpk(x[8 * sp + 0], x[8 * sp + 1]); xw.y = cvtpk(x[8 * sp + 2], x[8 * sp + 3]); xw.z = cvtpk(x[8 * sp + 4], x[8 * sp + 5]); xw.w = cvtpk(x[8 * sp + 6], x[8 * sp + 7]);
                    const s16x4 v0 = *(const s16x4*)(VT + sb * 32 + 16 * sp + 4 * hi), v1 = *(const s16x4*)(VT + sb * 32 + 16 * sp + 8 + 4 * hi);
                    const bf16x8 va = {v0[0], v0[1], v0[2], v0[3], v1[0], v1[1], v1[2], v1[3]};
                    ot = __builtin_amdgcn_mfma_f32_32x32x16_bf16(va, __builtin_bit_cast(bf16x8, xw), ot, 0, 0, 0); }
            }
#pragma unroll
            for (int dir = 0; dir < 2; ++dir) {
                const bf16_t* SA = (const bf16_t*)(lds + O_ST + dir * MSZ) + (jb * 32 + r32) * P + hi * 8; const bf16_t* QT = (const bf16_t*)(lds + O_QT + dir * MSZ) + (tb * 32 + r32) * P + hi * 8;
#pragma unroll
                for (int ks = 0; ks < 4; ++ks) ot = __builtin_amdgcn_mfma_f32_32x32x16_bf16(*(const bf16x8*)(SA + ks * 16), *(const bf16x8*)(QT + ks * 16), ot, 0, 0, 0); }
            float part = 0.f;
#pragma unroll
            for (int r = 0; r < 16; ++r) part += ot[r] * ot[r];
            part = xsum<32>(part);
            if (hi == 0) SSQ[jb * 64 + tb * 32 + r32] = part;
        }
        __syncthreads();
        if (w < 4) { const int t = tb * 32 + r32; const float rstd = 1.f / sqrtf((SSQ[t] + SSQ[64 + t]) * (1.f / 64.f) + EPS);
#pragma unroll
            for (int r = 0; r < 16; ++r) { const int j = jb * 32 + crow(r, hi); OUT[t * P + j] = (bf16_t)f2bf(ot[r] * rstd * ng[j]); } }
        __syncthreads();
        {
            const int t = tid >> 3, jc = (tid & 7) * 8;
            const u32x4 y = *(const u32x4*)(OUT + t * P + jc); const u32x4 g = *(const u32x4*)(PROJ + (size_t)(row0 + t) * NIN + C_AG + h * 64 + jc);
            u32x4 o; o.x = pk2(bflo(y.x) * silu(bflo(g.x)), bfhi(y.x) * silu(bfhi(g.x))); o.y = pk2(bflo(y.y) * silu(bflo(g.y)), bfhi(y.y) * silu(bfhi(g.y)));
            o.z = pk2(bflo(y.z) * silu(bflo(g.z)), bfhi(y.z) * silu(bfhi(g.z))); o.w = pk2(bflo(y.w) * silu(bflo(g.w)), bfhi(y.w) * silu(bfhi(g.w)));
            *(u32x4*)(MIX + (size_t)(row0 + t) * D + h * 64 + jc) = o;
        }
        __syncthreads();
    }
}
}
__device__ __forceinline__ int vcu_of(int bx, int G) { return (G % 8 == 0) ? (bx % 8) * (G / 8) + bx / 8 : bx; }
__device__ __forceinline__ void attn_phase(char* lds, const bf16_t* QN, const bf16_t* KN, const bf16_t* PROJ, bf16_t* MIX, float neg_ref, int vcu, int G, bool with_ctx) {
    using attn_body::bf16;
    const int upc = (512 + G - 1) / G;
    const int nun = upc + ((with_ctx && vcu < 16) ? 1 : 0);
    for (int i = 0; i < nun; ++i) {
        int b, h, nt; size_t q0;
        if (i < upc) { const int u = vcu * upc + i; if (u >= 512) continue; const int combo = u >> 7; b = combo >> 1; h = (combo & 1) * 4 + ((u >> 5) & 3); q0 = (size_t)b * PB + CTXL + (size_t)(u & 31) * 256; nt = PB / 64; }
        else { b = vcu >> 3; h = vcu & 7; q0 = (size_t)b * PB; nt = CTXL / 64; }
        const int kvh = h >> 2; const size_t k0 = (size_t)b * PB;
        attn_body::attn_unit((const bf16*)QN + q0 * 512 + h * 64, (const bf16*)KN + k0 * 128 + kvh * 64, (const bf16*)PROJ + k0 * NIN + C_CV + kvh * 64, (bf16*)MIX + q0 * 1024 + 512 + h * 64, nt, neg_ref, lds);
    }
}
namespace pg8 {
struct EpiResid {
    static constexpr bool PERM = false, AFTER_DRAIN = false;
    const float* src_lat; const float* src_ctx; float* dst_lat; float* dst_ctx; const float* modv; int ga_off; int pad;
    __device__ __forceinline__ void operator()(const f32x4 (&acc)[2][2][4][2], const Unit& u, int wr, int wc, int fr, int fq) const {
        asm volatile("" : "+v"(fr), "+v"(fq));
        const int b = u.pm / TPB, w = u.pm - b * TPB;
        const size_t base = (w == 0) ? (size_t)b * CTXL * D : ((size_t)b * SEQ + (size_t)(w - 1) * 256) * D;
        const float* s = ((w == 0) ? src_ctx : src_lat) + base; float* d = ((w == 0) ? dst_ctx : dst_lat) + base;
        const float* ga = modv + ((w == 0) ? 2 : b) * 6144 + ga_off;
        const int row0 = wr * 64 + fr, col0 = u.pn * BM + wc * 32 + 4 * fq;
        f32x4 gv[2][2];
#pragma unroll
        for (int bj = 0; bj < 2; ++bj)
#pragma unroll
            for (int n = 0; n < 2; ++n) gv[bj][n] = *(const f32x4*)(ga + col0 + bj * HALF + n * 16);
#pragma unroll
        for (int ai = 0; ai < 2; ++ai)
#pragma unroll
            for (int m = 0; m < 4; ++m) { const size_t off = (size_t)(row0 + ai * HALF + m * 16) * D + col0;
#pragma unroll
                for (int bj = 0; bj < 2; ++bj)
#pragma unroll
                    for (int n = 0; n < 2; ++n) *(f32x4*)(d + off + bj * HALF + n * 16) = *(const f32x4*)(s + off + bj * HALF + n * 16) + gv[bj][n] * acc[ai][bj][m][n]; }
    }
};
struct OutOrder : StaticOrder {
    int lat_only;
    __device__ __forceinline__ bool next(int i, Unit& u) const { if (!StaticOrder::next(i, u)) return false; if (lat_only) u.pm = (u.pm >> 5) * TPB + 1 + (u.pm & 31); return true; }
};
}


namespace pg8 {
struct MUnit { int pm, pn, nrows, lbase, e0, e1; };
__device__ __forceinline__ void build_tiles(PG8_LAS int* TT, const unsigned* cnt) {
    if (otid() == 0) { int off = 0;
        for (int bk = 0; bk < 24; ++bk) { const int c = (int)__hip_atomic_load(cnt + bk, __ATOMIC_RELAXED, __HIP_MEMORY_SCOPE_AGENT); const int nb = (c + 255) >> 8;
            for (int ti = 0; ti < nb; ++ti) { const int rem = c - ti * 256; TT[4 + 4 * off + 0] = bk; TT[4 + 4 * off + 1] = ti; TT[4 + 4 * off + 2] = rem < 256 ? rem : 256; TT[4 + 4 * off + 3] = 0; ++off; } }
        TT[0] = off; }
    __syncthreads();
}
template <int NPN  > struct MoeOrder {
    const PG8_LAS int* TT; int G, c;
    __device__ __forceinline__ bool next(int i, MUnit& u) const {
        const int L = i * G + c, tile = L / NPN; if (tile >= TT[0]) return false;
        const int bk = TT[4 + 4 * tile], ti = TT[4 + 4 * tile + 1];
        u.pm = tile; u.pn = L - tile * NPN; u.nrows = TT[4 + 4 * tile + 2]; u.lbase = bk * MT + ti * 256;
        const int g = bk / 6, pi = bk - g * 6; const int lo = pi < 3 ? 0 : (pi < 5 ? 1 : 2), hi = pi < 3 ? pi + 1 : (pi < 5 ? pi - 1 : 3);
        u.e0 = 4 * g + lo; u.e1 = 4 * g + hi; return true;
    }
};
struct Src1 {
    const bf16_t* XN; const bf16_t* WGU; const u32x4* LIST;
    __device__ __forceinline__ const char* a_base(const MUnit&) const { return (const char*)XN; }
    __device__ __forceinline__ void a_offsets(const MUnit& u, const int (&RA)[2], const int (&CA)[2], unsigned (&ao)[2][2]) const {
#pragma unroll
        for (int h = 0; h < 2; ++h)
#pragma unroll
            for (int i = 0; i < 2; ++i) { const int r = h * HALF + RA[i]; const unsigned row = r < u.nrows ? LIST[u.lbase + r].x : 0u; ao[h][i] = (row * (unsigned)D + (unsigned)CA[i]) * 2u; }
    }
    __device__ __forceinline__ const char* b_base(const MUnit& u, int seg) const { const int e = (u.pn >> 2) ? u.e1 : u.e0;
        return (const char*)(WGU + ((size_t)e * 1024 + (size_t)(u.pn & 3) * 256) * D) + (seg ? (size_t)(D / 2) * 2 : 0); }
    __device__ __forceinline__ void prefetch_rows(const MUnit& u, const int (&)[2], PG8_LAS unsigned char* rows, int wid) const {
        int t2 = otid(); asm volatile("" : "+v"(t2));
        int RA[2];
#pragma unroll
        for (int i = 0; i < 2; ++i) { int R, C; stage_rc(t2 * 16 + i * 8192, R, C); RA[i] = R; }
#pragma unroll
        for (int h = 0; h < 2; ++h)
#pragma unroll
            for (int i = 0; i < 2; ++i) { const int r = h * HALF + RA[i];
                __builtin_amdgcn_global_load_lds((const unsigned*)&LIST[u.lbase + r], (PG8_LAS unsigned*)(rows + ((h * 2 + i) * 8 + wid) * 256), 4, 0, 0); }
    }
    __device__ __forceinline__ void reload_offsets(const MUnit& u, const int (&)[2], const int (&)[2], const PG8_LAS unsigned char* rows, int wid, int lane, unsigned (&ao)[2][2]) const {
        int t2 = otid(); asm volatile("" : "+v"(t2));
        int RA[2], CA[2];
#pragma unroll
        for (int i = 0; i < 2; ++i) { int R, C; stage_rc(t2 * 16 + i * 8192, R, C); RA[i] = R; CA[i] = C; }
#pragma unroll
        for (int h = 0; h < 2; ++h)
#pragma unroll
            for (int i = 0; i < 2; ++i) { const int r = h * HALF + RA[i]; const unsigned v = *(const PG8_LAS unsigned*)(rows + ((h * 2 + i) * 8 + wid) * 256 + lane * 4);
                const unsigned row = r < u.nrows ? v : 0u; ao[h][i] = (row * (unsigned)D + (unsigned)CA[i]) * 2u; }
    }
};
struct Src2 {
    const bf16_t* ACT2; const bf16_t* WD;
    __device__ __forceinline__ const char* a_base(const MUnit& u) const { return (const char*)(ACT2 + (size_t)u.pm * 256 * 1024); }
    __device__ __forceinline__ void a_offsets(const MUnit&, const int (&RA)[2], const int (&CA)[2], unsigned (&ao)[2][2]) const {
#pragma unroll
        for (int h = 0; h < 2; ++h)
#pragma unroll
            for (int i = 0; i < 2; ++i) ao[h][i] = (unsigned)((h * HALF + RA[i]) * 1024 + CA[i]) * 2u;
    }
    __device__ __forceinline__ const char* b_base(const MUnit& u, int seg) const { const int e = seg ? u.e1 : u.e0; return (const char*)(WD + ((size_t)e * 1024 + (size_t)u.pn * 256) * DE); }
    __device__ __forceinline__ void prefetch_rows(const MUnit&, const int (&)[2], PG8_LAS unsigned char*, int) const {}
    __device__ __forceinline__ void reload_offsets(const MUnit&, const int (&)[2], const int (&)[2], const PG8_LAS unsigned char*, int, int, unsigned (&)[2][2]) const {}
};
struct EpiGateUp2 {
    static constexpr bool PERM = true;
    bf16_t* ACT2; const u32x4* LIST;
    __device__ __forceinline__ void operator()(const f32x4 (&acc)[2][2][4][2], const MUnit& u, int wr, int wc, int fr, int fq) const {
        asm volatile("" : "+v"(fr), "+v"(fq));
        const int slot = u.pn >> 2, colA = slot * DE + (u.pn & 3) * HALF + wc * 32 + 8 * fq;
        const unsigned* lw = (const unsigned*)(LIST + u.lbase + wr * 64 + fr) + 1 + slot;
#pragma unroll
        for (int ai = 0; ai < 2; ++ai) {
            unsigned wv[4];
#pragma unroll
            for (int m = 0; m < 4; ++m) wv[m] = lw[(ai * HALF + m * 16) * 4];
#pragma unroll
            for (int m = 0; m < 4; ++m) { const int r = ai * HALF + wr * 64 + m * 16 + fr;
                const bool valid = r < u.nrows; const float cw = valid ? __uint_as_float(wv[m]) : 0.f;
                const f32x4 g0 = acc[ai][0][m][0], g1 = acc[ai][0][m][1], u0 = acc[ai][1][m][0], u1 = acc[ai][1][m][1];
                u32x4 w;
                w.x = cvt_pk_bf16(silu(g0[0]) * u0[0] * cw, silu(g0[1]) * u0[1] * cw); w.y = cvt_pk_bf16(silu(g0[2]) * u0[2] * cw, silu(g0[3]) * u0[3] * cw);
                w.z = cvt_pk_bf16(silu(g1[0]) * u1[0] * cw, silu(g1[1]) * u1[1] * cw); w.w = cvt_pk_bf16(silu(g1[2]) * u1[2] * cw, silu(g1[3]) * u1[3] * cw);
                if (!valid) w = (u32x4){0u, 0u, 0u, 0u};
                *(u32x4*)(ACT2 + ((size_t)u.pm * 256 + r) * 1024 + colA) = w; }
            asm volatile("" ::: "memory"); }
    }
};
struct EpiMoeOut {
    static constexpr bool PERM = false;
    float* lat; float* ctx; const float* modv; const u32x4* LIST;
    __device__ __forceinline__ void operator()(const f32x4 (&acc)[2][2][4][2], const MUnit& u, int wr, int wc, int fr, int fq) const {
        asm volatile("" : "+v"(fr), "+v"(fq));
        const int col0 = u.pn * BM + wc * 32 + 4 * fq;
        const unsigned* lw = (const unsigned*)(LIST + u.lbase + wr * 64 + fr);
        unsigned rv[2][4];
#pragma unroll
        for (int ai = 0; ai < 2; ++ai)
#pragma unroll
            for (int m = 0; m < 4; ++m) rv[ai][m] = lw[(ai * HALF + m * 16) * 4];
#pragma unroll
        for (int ai = 0; ai < 2; ++ai)
#pragma unroll
            for (int m = 0; m < 4; ++m) { const int r = ai * HALF + wr * 64 + m * 16 + fr;
                if (r < u.nrows) { const int row = (int)rv[ai][m]; bool is_ctx; const size_t off = stream_off(row, is_ctx);
                    float* d = (is_ctx ? ctx : lat) + off + col0; const float* ga = modv + (is_ctx ? 2 : row / PB) * 6144 + 5120 + col0;
#pragma unroll
                    for (int bj = 0; bj < 2; ++bj)
#pragma unroll
                        for (int n = 0; n < 2; ++n) { f32x4* p = (f32x4*)(d + bj * HALF + n * 16); *p = *p + *(const f32x4*)(ga + bj * HALF + n * 16) * acc[ai][bj][m][n]; } } }
    }
};

template <class Epi, class Sched, class Src>
__device__ __forceinline__ void gemm_phase_x(PG8_LAS unsigned char* lds, PG8_LAS unsigned char* rows, const Sched& S, const Src& X, const Epi& E, const int KB, const int nt) {
    const int tid = otid(), wid = __builtin_amdgcn_readfirstlane(tid >> 6), lane = tid & 63, wr = wid >> 2, wc = wid & 3, fr = lane & 15, fq = lane >> 4;
    int RA[2], CA[2]; unsigned voffB[2];
#pragma unroll
    for (int i = 0; i < 2; ++i) { int R, C; stage_rc(tid * 16 + i * 8192, R, C); const int Rb = Epi::PERM ? ((R & ~31) + perm32(R & 31)) : R; RA[i] = R; CA[i] = C; voffB[i] = (unsigned)(Rb * KB + C) * 2u; }
    const size_t kstep = (size_t)(BK * 2);
    const size_t hstepB = (size_t)HALF * KB * 2;
    const int half = nt >> 1;
    const unsigned ldsw = (unsigned)wid * 1024u;
    const int aoff = lds_byte(wr * 64 + fr, fq * 8), boff = lds_byte(wc * 32 + fr, fq * 8);
#define PG8_SA(b, h) (((b) * 2 + (h)) * HTB)
#define PG8_SB(b, h) ((4 + (b) * 2 + (h)) * HTB)
#define PG8_STAGE_B(bufoff, gbase) do { _Pragma("unroll") for (int _i = 0; _i < 2; ++_i) \
        __builtin_amdgcn_global_load_lds((const unsigned*)((const char*)(gbase) + voffB[_i]), (PG8_LAS unsigned*)(lds + (bufoff) + ldsw + _i * 8192), 16, 0, 0); } while (0)
#define PG8_STAGE_A(bufoff, gbase, o0, o1) do { \
        __builtin_amdgcn_global_load_lds((const unsigned*)((const char*)(gbase) + (o0)), (PG8_LAS unsigned*)(lds + (bufoff) + ldsw), 16, 0, 0); \
        __builtin_amdgcn_global_load_lds((const unsigned*)((const char*)(gbase) + (o1)), (PG8_LAS unsigned*)(lds + (bufoff) + ldsw + 8192), 16, 0, 0); } while (0)
#define PG8_LDA(dst, b, h) do { _Pragma("unroll") for (int m = 0; m < 4; ++m) _Pragma("unroll") for (int k = 0; k < 2; ++k) dst[m][k] = *(const PG8_LAS bf16x8*)(lds + PG8_SA(b, h) + aoff + m * 2048 + k * 1024); } while (0)
#define PG8_LDB(dst, b, h) do { _Pragma("unroll") for (int n = 0; n < 2; ++n) _Pragma("unroll") for (int k = 0; k < 2; ++k) dst[n][k] = *(const PG8_LAS bf16x8*)(lds + PG8_SB(b, h) + boff + n * 2048 + k * 1024); } while (0)
#define PG8_MMA(ai, bj, At, Bt) do { __builtin_amdgcn_s_setprio(1); _Pragma("unroll") for (int m = 0; m < 4; ++m) _Pragma("unroll") for (int n = 0; n < 2; ++n) _Pragma("unroll") for (int k = 0; k < 2; ++k) \
        acc[ai][bj][m][n] = __builtin_amdgcn_mfma_f32_16x16x32_bf16(Bt[n][k], At[m][k], acc[ai][bj][m][n], 0, 0, 0); __builtin_amdgcn_s_setprio(0); } while (0)
#define PG8_WAIT_V(n) asm volatile("s_waitcnt vmcnt(" #n ")" ::: "memory")
#define PG8_WAIT_L(n) asm volatile("s_waitcnt lgkmcnt(" #n ")" ::: "memory")
#define PG8_BAR __builtin_amdgcn_s_barrier()
#define PG8_SCHED __builtin_amdgcn_sched_barrier(0)
    MUnit cur, nxt; int ui = 0;
    if (!S.next(0, cur)) return;
    f32x4 acc[2][2][4][2];
#pragma unroll
    for (int a = 0; a < 2; ++a)
#pragma unroll
        for (int b = 0; b < 2; ++b)
#pragma unroll
            for (int m = 0; m < 4; ++m)
#pragma unroll
                for (int n = 0; n < 2; ++n) acc[a][b][m][n] = (f32x4){0.f, 0.f, 0.f, 0.f};
    bf16x8 At[4][2], B0[2][2], B1[2][2];
    unsigned aoc[2][2];
    X.a_offsets(cur, RA, CA, aoc);
    const char* cAb = X.a_base(cur); const char* cB0 = X.b_base(cur, 0); const char* cB1 = X.b_base(cur, 1);
    PG8_STAGE_B(PG8_SB(0, 0), cB0); PG8_STAGE_B(PG8_SB(0, 1), cB0 + hstepB); PG8_STAGE_A(PG8_SA(0, 0), cAb, aoc[0][0], aoc[0][1]); PG8_STAGE_A(PG8_SA(0, 1), cAb, aoc[1][0], aoc[1][1]);
    if (wr == 1) PG8_BAR;
    PG8_WAIT_V(2); PG8_BAR;
    PG8_STAGE_B(PG8_SB(1, 0), cB0 + kstep); PG8_STAGE_A(PG8_SA(1, 0), cAb + kstep, aoc[0][0], aoc[0][1]); PG8_STAGE_B(PG8_SB(1, 1), cB0 + hstepB + kstep);
    PG8_WAIT_V(6); PG8_BAR;
    for (;;) {
        const bool has_next = S.next(ui + 1, nxt);
        const char* nAb = cAb; const char* nB0 = cB0; const char* nB1 = cB1;
        if (has_next) { X.prefetch_rows(nxt, RA, rows, wid); nAb = X.a_base(nxt); nB0 = X.b_base(nxt, 0); nB1 = X.b_base(nxt, 1); }
        for (int t = 0; t < nt; t += 2) {
            const bool last = (t == nt - 2);
            const char* a1 = cAb + (size_t)(t + 1) * kstep;
            const int kt2 = t + 2;
            const char* b2 = last ? nB0 : (kt2 < half ? cB0 + (size_t)kt2 * kstep : cB1 + (size_t)(kt2 - half) * kstep);
            const char* a2 = last ? nAb : cAb + (size_t)kt2 * kstep;
            const char* a3 = a2 + kstep; const char* b3 = b2 + kstep;
            PG8_LDB(B0, 0, 0); PG8_LDB(B1, 0, 1); PG8_SCHED; PG8_LDA(At, 0, 0); PG8_STAGE_A(PG8_SA(1, 1), a1, aoc[1][0], aoc[1][1]);
            if (last && has_next) X.reload_offsets(nxt, RA, CA, rows, wid, lane, aoc);
            PG8_WAIT_V(8); PG8_WAIT_L(0); PG8_BAR; PG8_MMA(0, 0, At, B0); PG8_MMA(0, 1, At, B1); PG8_BAR; PG8_SCHED;
            PG8_LDA(At, 0, 1); PG8_STAGE_B(PG8_SB(0, 0), b2); PG8_STAGE_B(PG8_SB(0, 1), b2 + hstepB); PG8_STAGE_A(PG8_SA(0, 0), a2, aoc[0][0], aoc[0][1]);
            PG8_WAIT_V(8); PG8_WAIT_L(0); PG8_BAR; PG8_MMA(1, 0, At, B0); PG8_MMA(1, 1, At, B1); PG8_BAR; PG8_SCHED;
            PG8_LDB(B0, 1, 0); PG8_LDB(B1, 1, 1); PG8_SCHED; PG8_LDA(At, 1, 0); PG8_STAGE_A(PG8_SA(0, 1), a2, aoc[1][0], aoc[1][1]);
            PG8_WAIT_V(8); PG8_WAIT_L(0); PG8_BAR; PG8_MMA(0, 0, At, B0); PG8_MMA(0, 1, At, B1); PG8_BAR; PG8_SCHED;
            PG8_LDA(At, 1, 1); PG8_STAGE_B(PG8_SB(1, 0), b3); PG8_STAGE_B(PG8_SB(1, 1), b3 + hstepB); PG8_STAGE_A(PG8_SA(1, 0), a3, aoc[0][0], aoc[0][1]);
            PG8_WAIT_V(8); PG8_WAIT_L(0); PG8_BAR; PG8_MMA(1, 0, At, B0); PG8_MMA(1, 1, At, B1); PG8_BAR; PG8_SCHED;
        }
        if (wr == 0) PG8_BAR;
        E(acc, cur, wr, wc, fr, fq);
        if (!has_next) break;
#pragma unroll
        for (int a = 0; a < 2; ++a)
#pragma unroll
            for (int b = 0; b < 2; ++b)
#pragma unroll
                for (int m = 0; m < 4; ++m)
#pragma unroll
                    for (int n = 0; n < 2; ++n) acc[a][b][m][n] = (f32x4){0.f, 0.f, 0.f, 0.f};
        cur = nxt; cAb = nAb; cB0 = nB0; cB1 = nB1; ++ui;
        if (wr == 1) PG8_BAR;
    }
    PG8_WAIT_V(0);
    PG8_BAR;
#undef PG8_SA
#undef PG8_SB
#undef PG8_STAGE_A
#undef PG8_STAGE_B
#undef PG8_LDA
#undef PG8_LDB
#undef PG8_MMA
#undef PG8_WAIT_V
#undef PG8_WAIT_L
#undef PG8_BAR
#undef PG8_SCHED
}
}

constexpr int TT_OFF = 132096;
constexpr int ROWS_OFF = 134144;

#define XB_TMO      128
#define XB_XCNT(j)  (256  + 64 * (j))
#define XB_XSUB(j)  (1280 + 64 * (j))
#define XB_XGEN(j)  (2304 + 64 * (j))
#define XB_TOP      3328
#define XB_TOPGEN   3392
#define XCD_BAR_WORDS 3456
#define XB_SPIN_CAP (1u << 18)

__device__ __forceinline__ unsigned xb_ld(unsigned* p)              { return __hip_atomic_load(p, __ATOMIC_RELAXED, __HIP_MEMORY_SCOPE_AGENT); }
__device__ __forceinline__ unsigned xb_add(unsigned* p, unsigned v) { return __hip_atomic_fetch_add(p, v, __ATOMIC_RELAXED, __HIP_MEMORY_SCOPE_AGENT); }
__device__ __forceinline__ unsigned xb_xcc_id() { return (unsigned)__builtin_amdgcn_s_getreg((3 << 11) | 20) & 0xFu; }
#define XB_SPIN(cond, bar) do { unsigned _sp = 0; while (cond) { __builtin_amdgcn_s_sleep(1); \
    if ((++_sp & 255u) == 0u) { if (xb_ld(&(bar)[XB_TMO])) break; if (_sp > XB_SPIN_CAP) { atomicAdd(&(bar)[XB_TMO], 1u); break; } } } } while (0)

struct XcdBarrier {
    unsigned* bar; unsigned x;
    volatile LAS unsigned* st;
};

__device__ __forceinline__ XcdBarrier xcd_barrier_post(unsigned* bar, volatile LAS unsigned* st) {
    XcdBarrier b; b.bar = bar; b.x = xb_xcc_id(); b.st = st;
    if (threadIdx.x == 0) (void)xb_add(&bar[XB_XCNT(b.x)], 1u);
    return b;
}
__device__ __forceinline__ void xcd_barrier_complete(unsigned* bar, unsigned x, unsigned& nloc, unsigned& nx) {
    const unsigned G = gridDim.x * gridDim.y * gridDim.z;
    unsigned sum, cnt, mine, sp = 0u;
    for (;;) {
        sum = 0u; cnt = 0u; mine = 0u;
#pragma unroll
        for (unsigned j = 0; j < 16; ++j) { const unsigned c = xb_ld(&bar[XB_XCNT(j)]); sum += c; cnt += (c > 0u) ? 1u : 0u; mine = (j == x) ? c : mine; }
        if (sum == G) break;
        __builtin_amdgcn_s_sleep(1);
        if ((++sp & 255u) == 0u) { if (xb_ld(&bar[XB_TMO])) break; if (sp > XB_SPIN_CAP) { atomicAdd(&bar[XB_TMO], 1u); break; } }
    }
    nloc = mine > 0u ? mine : 1u; nx = cnt > 0u ? cnt : 1u;
}

__device__ __forceinline__ void xcd_barrier(const XcdBarrier& b) {
    asm volatile("s_waitcnt vmcnt(0)" ::: "memory");
    __syncthreads();
    if (threadIdx.x == 0) {
        unsigned* bar = b.bar;
        __builtin_amdgcn_s_waitcnt(0);
        unsigned nloc = b.st[0], nx = b.st[1];
        if (nloc == 0u) { xcd_barrier_complete(bar, b.x, nloc, nx); b.st[0] = nloc; b.st[1] = nx; }
        const unsigned old = xb_add(&bar[XB_XSUB(b.x)], 1u);
        const unsigned gen = old / nloc;
        if (old + 1u == (gen + 1u) * nloc) {
            __builtin_amdgcn_fence(__ATOMIC_RELEASE, "agent");
            asm volatile("s_waitcnt vmcnt(0)" ::: "memory");
            const unsigned og = xb_add(&bar[XB_TOP], 1u);
            const unsigned tg = og / nx;
            if (og + 1u == (tg + 1u) * nx) xb_add(&bar[XB_TOPGEN], 1u);
            else XB_SPIN(xb_ld(&bar[XB_TOPGEN]) == tg, bar);
            __builtin_amdgcn_fence(__ATOMIC_ACQUIRE, "agent");
            xb_add(&bar[XB_XGEN(b.x)], 1u);
            asm volatile("s_waitcnt vmcnt(0)" ::: "memory");
        } else {
            XB_SPIN(xb_ld(&bar[XB_XGEN(b.x)]) == gen, bar);
            __builtin_amdgcn_fence(__ATOMIC_ACQUIRE, "agent");
            asm volatile("s_waitcnt vmcnt(0)" ::: "memory");
        }
    }
    __syncthreads();
}

constexpr int LDS_BYTES = 147456;
constexpr int LDSCTL_OFF = 131072, MISC_OFF = LDSCTL_OFF + 320;
constexpr int CW_BAR = 4096;
constexpr int NPHASE = 1 + 9 * DEPTH;
#ifndef MK_SPLIT
#define MK_SPLIT 0
#endif
struct Args {
    const float *x, *c, *ctx, *c_ctx, *w_mod, *b_mod, *norm1_g, *norm2_g, *w_in, *w_out, *hgrn_lb, *hgrn_norm_g, *pool_w, *pool_scale, *q_norm_g, *k_norm_g, *router_w, *router_b, *moe_gate, *moe_up, *moe_down;
    float* out; unsigned char* ws; int ph_lo, ph_hi;
};
typedef const __attribute__((address_space(4))) Args* KArgs;
__device__ __forceinline__ KArgs kargs() { KArgs p = (KArgs)__builtin_amdgcn_kernarg_segment_ptr(); asm volatile("" : "+s"(p)); return p; }
__global__ void __launch_bounds__(512, 2) mega_fwd(Args A_unused) {
    extern __shared__ __attribute__((aligned(16))) unsigned char lds[];
    for (int u = otid(); u < (LDS_BYTES - LDSCTL_OFF) / 4; u += 512) ((LAS unsigned*)((LAS unsigned char*)lds + LDSCTL_OFF))[u] = 0u;
    __syncthreads();
    XcdBarrier bar;
    { KArgs ap = kargs(); unsigned* CTL = (unsigned*)(ap->ws + WS_CTL); bar.bar = CTL + CW_BAR; bar.x = 0; bar.st = nullptr;
      if (!MK_SPLIT) bar = xcd_barrier_post(CTL + CW_BAR, (volatile LAS unsigned*)((LAS unsigned char*)lds + MISC_OFF) + 8); }
    int lo, hi; { KArgs ap = kargs(); lo = ap->ph_lo; hi = ap->ph_hi; }
#ifndef PHMASK
#define PHMASK 0x3ff
#endif
#define IN(k) (lo <= (k) && (k) < hi)
#define SEAM(k) do { if (!MK_SPLIT && IN((k) + 1)) xcd_barrier(bar); } while (0)
#define GCU const int G = (int)gridDim.x, cu = (int)blockIdx.x
#ifndef DUPMASK
#define DUPMASK 0
#endif
    LAS unsigned char* ldsl = (LAS unsigned char*)lds;
    if ((PHMASK & 0x200) && IN(0)) {
        _Pragma("unroll") for (int rep_ = 0; rep_ < ((((DUPMASK) & (0x200)) && true) ? 2 : 1); ++rep_) {
        KArgs ap = kargs(); unsigned char* ws = ap->ws; GCU;
        ProArgs pa; pa.c = ap->c; pa.c_ctx = ap->c_ctx; pa.w_mod = ap->w_mod; pa.b_mod = ap->b_mod; pa.hgrn_lb = ap->hgrn_lb; pa.qg = ap->q_norm_g; pa.kg = ap->k_norm_g; pa.w_in = ap->w_in; pa.w_out = ap->w_out; pa.pool_w = ap->pool_w;
        pa.gate = ap->moe_gate; pa.up = ap->moe_up; pa.down = ap->moe_down; pa.MODV = (float*)(ws + WS_MODV); pa.LBF = (float*)(ws + WS_LBF); pa.REF = (float*)(ws + WS_REF); pa.COS = (float*)(ws + WS_COS); pa.SIN = (float*)(ws + WS_SIN);
        pa.WIN = (bf16_t*)(ws + WS_WIN); pa.WOUT = (bf16_t*)(ws + WS_WOUT); pa.POOLWT = (bf16_t*)(ws + WS_POOLWT); pa.WGU = (bf16_t*)(ws + WS_WGU); pa.WD = (bf16_t*)(ws + WS_WD);
        prologue_phase(lds, pa, cu, G);
            if (rep_ + 1 < ((((DUPMASK) & (0x200)) && true) ? 2 : 1)) xcd_barrier(bar); }
        SEAM(0);
    }
    for (int l = 0; l < DEPTH; ++l) {
        const int pb = 1 + 9 * l;
        if ((PHMASK & 1) && IN(pb + 0)) {
        _Pragma("unroll") for (int rep_ = 0; rep_ < ((((DUPMASK) & (1)) && true) ? 2 : 1); ++rep_) {
            KArgs ap = kargs(); unsigned char* ws = ap->ws; GCU;
            const float* slat = (l == 0) ? ap->x : ap->out; const float* sctx = (l == 0) ? ap->ctx : (const float*)(ws + WS_XC);
            norm1_phase(cu, G, slat, sctx, ap->norm1_g + l * D, (const float*)(ws + WS_MODV) + (size_t)l * 3 * 6144, 0, (bf16_t*)(ws + WS_XN));
            if (rep_ + 1 < ((((DUPMASK) & (1)) && true) ? 2 : 1)) xcd_barrier(bar); }
            SEAM(pb + 0);
        }
        if ((PHMASK & 2) && IN(pb + 1)) {
        _Pragma("unroll") for (int rep_ = 0; rep_ < ((((DUPMASK) & (2)) && true) ? 2 : 1); ++rep_) {
            KArgs ap = kargs(); unsigned char* ws = ap->ws; GCU;
            pg8::Gemm g; g.A = (const bf16_t*)(ws + WS_XN); g.Bt = (const bf16_t*)(ws + WS_WIN) + (size_t)l * NIN * D; g.M = MT; g.N = NIN; g.K = D; g.pad = 0;
            pg8::StaticOrder S; S.init(MT, NIN, G, cu);
            pg8::EpiBf16<0> E; E.O = (bf16_t*)(ws + WS_PROJ); E.ldc = NIN; E.bias = nullptr; E.split_cols = 0; E.split_stride = 0; E.scale0 = 1.f;
            pg8::gemm_phase<pg8::EpiBf16<0>, pg8::StaticOrder, true, true>(ldsl, g, S, E);
            { KArgs aq = kargs(); if (l == 0) moe_filler(lds, aq->moe_gate, aq->moe_up, aq->moe_down, aq->ws, 0, 0, 5530, (MT / 256) * (NIN / 256), G, cu);
              else moe_filler(lds, aq->moe_gate, aq->moe_up, aq->moe_down, aq->ws, 1, 7986, MOE_ITEMS, (MT / 256) * (NIN / 256), G, cu); }
            if (rep_ + 1 < ((((DUPMASK) & (2)) && true) ? 2 : 1)) xcd_barrier(bar); }
            SEAM(pb + 1);
        }
        if ((PHMASK & 4) && IN(pb + 2)) {
        _Pragma("unroll") for (int rep_ = 0; rep_ < ((((DUPMASK) & (4)) && true) ? 2 : 1); ++rep_) {
            KArgs ap = kargs(); unsigned char* ws = ap->ws; GCU;
            const bf16_t* PROJ = (const bf16_t*)(ws + WS_PROJ);
            post_phase(cu, G, PROJ, ap->q_norm_g + l * 64, ap->k_norm_g + l * 64, (const float*)(ws + WS_COS), (const float*)(ws + WS_SIN), (bf16_t*)(ws + WS_QN), (bf16_t*)(ws + WS_KN));
            pool::pool_phase(lds, PROJ, (const bf16_t*)(ws + WS_POOLWT) + (size_t)l * 4 * 4096, ap->pool_scale + l * 256, (bf16_t*)(ws + WS_MIX), cu, G);
            hg::h1_phase(lds, PROJ, (const float*)(ws + WS_LBF) + l * 512, (bf16_t*)(ws + WS_UT), (float*)(ws + WS_DEC), cu, G);
            if (rep_ + 1 < ((((DUPMASK) & (4)) && true) ? 2 : 1)) xcd_barrier(bar); }
            SEAM(pb + 2);
        }
        if ((PHMASK & 8) && IN(pb + 3)) {
        _Pragma("unroll") for (int rep_ = 0; rep_ < ((((DUPMASK) & (8)) && true) ? 2 : 1); ++rep_) {
            KArgs ap = kargs(); unsigned char* ws = ap->ws; GCU; hg::h2_phase(lds, (const bf16_t*)(ws + WS_UT), (const float*)(ws + WS_DEC), (bf16_t*)(ws + WS_ST), cu, G);
            if (rep_ + 1 < ((((DUPMASK) & (8)) && true) ? 2 : 1)) xcd_barrier(bar); }
            SEAM(pb + 3);
        }
        if ((PHMASK & 16) && IN(pb + 4)) {
        _Pragma("unroll") for (int rep_ = 0; rep_ < ((((DUPMASK) & (16)) && true) ? 2 : 1); ++rep_) {
            { KArgs ap = kargs(); unsigned char* ws = ap->ws; GCU;
              attn_phase((char*)lds, (const bf16_t*)(ws + WS_QN), (const bf16_t*)(ws + WS_KN), (const bf16_t*)(ws + WS_PROJ), (bf16_t*)(ws + WS_MIX), ((const float*)(ws + WS_REF))[l * 64], vcu_of(cu, G), G, true); }
            { KArgs ap = kargs(); unsigned char* ws = ap->ws; GCU;
              hg::h3_phase(lds, (const bf16_t*)(ws + WS_PROJ), (const float*)(ws + WS_LBF) + l * 512, (const bf16_t*)(ws + WS_ST), ap->hgrn_norm_g + l * 64, (bf16_t*)(ws + WS_MIX), cu, G); }
            if (rep_ + 1 < ((((DUPMASK) & (16)) && true) ? 2 : 1)) xcd_barrier(bar); }
            SEAM(pb + 4);
        }
        if ((PHMASK & 32) && IN(pb + 5)) {
        _Pragma("unroll") for (int rep_ = 0; rep_ < ((((DUPMASK) & (32)) && (l == 0)) ? 2 : 1); ++rep_) {
            KArgs ap = kargs(); unsigned char* ws = ap->ws; GCU;
            pg8::Gemm g; g.A = (const bf16_t*)(ws + WS_MIX); g.Bt = (const bf16_t*)(ws + WS_WOUT) + (size_t)l * D * D; g.M = MT; g.N = D; g.K = D; g.pad = 0;
            pg8::OutOrder S; S.lat_only = (l == DEPTH - 1); S.init(S.lat_only ? BATCH * SEQ : MT, D, G, cu);
            pg8::EpiResid E; E.src_lat = (l == 0) ? ap->x : ap->out; E.src_ctx = (l == 0) ? ap->ctx : (const float*)(ws + WS_XC); E.dst_lat = ap->out; E.dst_ctx = (float*)(ws + WS_XC);
            E.modv = (const float*)(ws + WS_MODV) + (size_t)l * 3 * 6144; E.ga_off = 2048; E.pad = 0;
            pg8::gemm_phase<pg8::EpiResid, pg8::OutOrder, true, true>(ldsl, g, S, E);
            if (l == 0) { KArgs aq = kargs(); moe_filler(lds, aq->moe_gate, aq->moe_up, aq->moe_down, aq->ws, 0, 5530, MOE_ITEMS, (MT / 256) * (D / 256), G, cu); }
            if (rep_ + 1 < ((((DUPMASK) & (32)) && (l == 0)) ? 2 : 1)) xcd_barrier(bar); }
            SEAM(pb + 5);
        }
        if ((PHMASK & 64) && IN(pb + 6)) {
        _Pragma("unroll") for (int rep_ = 0; rep_ < ((((DUPMASK) & (64)) && true) ? 2 : 1); ++rep_) {
            KArgs ap = kargs(); unsigned char* ws = ap->ws; GCU;
            norm2_router_phase(lds, cu, G, ap->out, (const float*)(ws + WS_XC), ap->norm2_g + l * D, (const float*)(ws + WS_MODV) + (size_t)l * 3 * 6144, 3072, ap->router_w, ap->router_b, (bf16_t*)(ws + WS_XN),
                               (unsigned*)(ws + WS_CTL) + CW_CNT + 64 * l, (u32x4*)(ws + WS_LIST), l == 0 ? 1 : 0);
            if (rep_ + 1 < ((((DUPMASK) & (64)) && true) ? 2 : 1)) xcd_barrier(bar); }
            SEAM(pb + 6);
        }
        if ((PHMASK & 128) && IN(pb + 7)) {
        _Pragma("unroll") for (int rep_ = 0; rep_ < ((((DUPMASK) & (128)) && true) ? 2 : 1); ++rep_) {
            KArgs ap = kargs(); unsigned char* ws = ap->ws; GCU;
            LAS int* TT = (LAS int*)(ldsl + TT_OFF);
            pg8::build_tiles(TT, (const unsigned*)(ws + WS_CTL) + CW_CNT + 64 * l);
            pg8::MoeOrder<8> S; S.TT = TT; S.G = G; S.c = vcu_of(cu, G);
            pg8::Src1 X; X.XN = (const bf16_t*)(ws + WS_XN); X.WGU = (const bf16_t*)(ws + (l ? WS_WGU1 : WS_WGU)); X.LIST = (const u32x4*)(ws + WS_LIST); pg8::EpiGateUp2 E; E.ACT2 = (bf16_t*)(ws + WS_ACT2); E.LIST = X.LIST;
            pg8::gemm_phase_x(ldsl, ldsl + ROWS_OFF, S, X, E, D, D / 64);
            if (l == 0) { KArgs aq = kargs(); const int U = TT[0] * 8; moe_filler(lds, aq->moe_gate, aq->moe_up, aq->moe_down, aq->ws, 1, 0, 3686, U, G, vcu_of(cu, G)); }
            if (rep_ + 1 < ((((DUPMASK) & (128)) && true) ? 2 : 1)) xcd_barrier(bar); }
            SEAM(pb + 7);
        }
        if ((PHMASK & 256) && IN(pb + 8)) {
        _Pragma("unroll") for (int rep_ = 0; rep_ < ((((DUPMASK) & (256)) && true) ? 2 : 1); ++rep_) {
            KArgs ap = kargs(); unsigned char* ws = ap->ws; GCU;
            LAS int* TT = (LAS int*)(ldsl + TT_OFF);
            pg8::build_tiles(TT, (const unsigned*)(ws + WS_CTL) + CW_CNT + 64 * l);
            pg8::MoeOrder<4> S; S.TT = TT; S.G = G; S.c = vcu_of(cu, G);
            pg8::Src2 X; X.ACT2 = (const bf16_t*)(ws + WS_ACT2); X.WD = (const bf16_t*)(ws + (l ? WS_WD1 : WS_WD));
            pg8::EpiMoeOut E; E.lat = ap->out; E.ctx = (float*)(ws + WS_XC); E.modv = (const float*)(ws + WS_MODV) + (size_t)l * 3 * 6144; E.LIST = (const u32x4*)(ws + WS_LIST);
            pg8::gemm_phase_x(ldsl, ldsl + ROWS_OFF, S, X, E, DE, 1024 / 64);
            if (l == 0) { KArgs aq = kargs(); const int U = TT[0] * 4; moe_filler(lds, aq->moe_gate, aq->moe_up, aq->moe_down, aq->ws, 1, 3686, 7986, U, G, vcu_of(cu, G)); }
            if (rep_ + 1 < ((((DUPMASK) & (256)) && true) ? 2 : 1)) xcd_barrier(bar); }
            SEAM(pb + 8);
        }
    }
#undef IN
#undef SEAM
#undef GCU
}

extern "C" void kernel_launch(void* const* d_in, const int* in_sizes, int n_in, void* d_out, int out_size, void* d_ws, size_t ws_size, hipStream_t stream) {
    static int grid = 0;
    if (grid == 0) {
        if (n_in != 21 || in_sizes[0] != BATCH * SEQ * D || out_size != BATCH * SEQ * D || ws_size < WS_END) {
            fprintf(stderr, "kernel_launch: unexpected sizes: n_in %d in0 %d out %d ws %zu (need %zu)\n", n_in, n_in > 0 ? in_sizes[0] : -1, out_size, ws_size, (size_t)WS_END); grid = -1; return; }
        int dev = 0, cus = 0, per_cu = 0;
        if (hipGetDevice(&dev) != hipSuccess || hipDeviceGetAttribute(&cus, hipDeviceAttributeMultiprocessorCount, dev) != hipSuccess) { grid = -1; return; }
        if (hipFuncSetAttribute((const void*)mega_fwd, hipFuncAttributeMaxDynamicSharedMemorySize, LDS_BYTES) != hipSuccess) { fprintf(stderr, "kernel_launch: hipFuncSetAttribute failed\n"); grid = -1; return; }
        if (hipOccupancyMaxActiveBlocksPerMultiprocessor(&per_cu, (const void*)mega_fwd, 512, LDS_BYTES) != hipSuccess || per_cu < 1) fprintf(stderr, "kernel_launch: occupancy query reports %d\n", per_cu);
        (void)hipGetLastError();
        grid = cus;
    }
    if (grid < 0) return;
    if (hipMemsetAsync((char*)d_ws + WS_CTL, 0, 1 * MiB, stream) != hipSuccess) return;
    Args a; memset((void*)&a, 0, sizeof(a));
    a.x = (const float*)d_in[0]; a.c = (const float*)d_in[1]; a.ctx = (const float*)d_in[2]; a.c_ctx = (const float*)d_in[3]; a.w_mod = (const float*)d_in[4]; a.b_mod = (const float*)d_in[5];
    a.norm1_g = (const float*)d_in[6]; a.norm2_g = (const float*)d_in[7]; a.w_in = (const float*)d_in[8]; a.w_out = (const float*)d_in[9]; a.hgrn_lb = (const float*)d_in[10]; a.hgrn_norm_g = (const float*)d_in[11];
    a.pool_w = (const float*)d_in[12]; a.pool_scale = (const float*)d_in[13]; a.q_norm_g = (const float*)d_in[14]; a.k_norm_g = (const float*)d_in[15]; a.router_w = (const float*)d_in[16]; a.router_b = (const float*)d_in[17];
    a.moe_gate = (const float*)d_in[18]; a.moe_up = (const float*)d_in[19]; a.moe_down = (const float*)d_in[20];
    a.out = (float*)d_out; a.ws = (unsigned char*)d_ws;
#if MK_SPLIT
    for (int ph = 0; ph < NPHASE; ++ph) { a.ph_lo = ph; a.ph_hi = ph + 1; hipLaunchKernelGGL(mega_fwd, dim3(grid), dim3(512), LDS_BYTES, stream, a); }
#else
    a.ph_lo = 0; a.ph_hi = NPHASE; hipLaunchKernelGGL(mega_fwd, dim3(grid), dim3(512), LDS_BYTES, stream, a);
#endif
}
```

```cpp
#include <hip/hip_runtime.h>
#include <cstdio>
#include <cstdint>
#include <cstring>

namespace cfg {
constexpr int D = 1024, BATCH = 2, SEQ = 8192, CTXL = 256, DEPTH = 2;
constexpr int PB = SEQ + CTXL;
constexpr int MT = BATCH * PB;
constexpr int TPB = PB / 256;
constexpr int NIN = 2304;
constexpr int NE = 16, DE = 512;
constexpr int C_AQ = 0, C_AFF = 256, C_AFB = 512, C_AI = 768, C_AG = 1024, C_BP = 1280, C_CQ = 1536, C_CK = 2048, C_CV = 2176;
constexpr float EPS = 1e-6f;
constexpr float C2 = 0.125f * 1.4426950408889634f;
}

__device__ __forceinline__ int otid() { int t = threadIdx.x; asm volatile("" : "+v"(t)); return t; }

namespace pg8 {
#define PG8_LAS __attribute__((address_space(3)))
typedef unsigned short bf16_t;
typedef short bf16x8 __attribute__((ext_vector_type(8)));
typedef float f32x4 __attribute__((ext_vector_type(4)));
typedef unsigned u32x4 __attribute__((ext_vector_type(4)));
constexpr int BM = 256, BK = 64, HALF = 128, HTB = HALF * BK * 2  , STAGE_BYTES = 8 * HTB, NXCD = 8, WGM = 8;

__host__ __device__ __forceinline__ int lds_byte(int r, int c) { const int st = (r >> 4) * 2 + (c >> 5), rr = r & 15, cc = c & 31, ob = rr * 64 + cc * 2; return st * 1024 + (ob ^ (((ob >> 9) & 1) << 5)); }
__host__ __device__ __forceinline__ void stage_rc(int b, int& R, int& C) { const int st = b / 1024, sb = b % 1024, swz = sb ^ (((sb >> 9) & 1) << 5); R = (st >> 1) * 16 + swz / 64; C = (st & 1) * 32 + (swz % 64) / 2; }
__host__ __device__ __forceinline__ int perm32(int rho) { const int n = rho >> 4, i = rho & 15; return 8 * (i >> 2) + 4 * n + (i & 3); }

struct Unit { int pm, pn; };
struct Gemm { const bf16_t* A; const bf16_t* Bt; int M, N, K, pad; };

struct StaticOrder {
    int nM, nN, nwg, G, c;
    __host__ __device__ void init(int M, int N, int G_, int c_) { nM = M / BM; nN = N / BM; nwg = nM * nN; G = G_; c = c_; }
    __host__ __device__ bool next(int i, Unit& u) const {
        const long L = (long)i * G + c; if (L >= nwg) return false;
        int wgid = (int)L; { const int q = nwg / NXCD, r = nwg % NXCD, xcd = wgid % NXCD, off = wgid / NXCD; wgid = (xcd < r ? xcd * (q + 1) : r * (q + 1) + (xcd - r) * q) + off; }
        const int nig = WGM * nN, gid = wgid / nig, fm = gid * WGM, gsz = (nM - fm) < WGM ? (nM - fm) : WGM;
        u.pm = fm + ((wgid % nig) % gsz); u.pn = (wgid % nig) / gsz; return true;
    }
    __device__ __forceinline__ void a_ready(const Unit&) const {}
    __device__ __forceinline__ void done(const Unit&) const {}
};

__device__ __forceinline__ unsigned cvt_pk_bf16(float lo, float hi) { unsigned r; asm volatile("v_cvt_pk_bf16_f32 %0, %1, %2" : "=v"(r) : "v"(lo), "v"(hi)); return r; }
typedef float f32x2 __attribute__((ext_vector_type(2)));
__device__ __forceinline__ f32x2 gelu_pk(f32x2 v) {
    const f32x2 av = __builtin_elementwise_abs(v), d = av * 0.2316418882f + 1.0f;
    f32x2 t; t.x = __builtin_amdgcn_rcpf(d.x); t.y = __builtin_amdgcn_rcpf(d.y);
    f32x2 q = t * 0.5307027145f + (-0.7265760135f); q = q * t + 0.7107068705f; q = q * t + (-0.142248368f); q = q * t + 0.127414796f; q = q * t;
    const f32x2 s = (v * v) * (-0.72134752044f);
    f32x2 e; e.x = __builtin_amdgcn_exp2f(s.x); e.y = __builtin_amdgcn_exp2f(s.y);
    const f32x2 m = v * (q * e), r = v - m;
    f32x2 o; o.x = v.x < 0.f ? m.x : r.x; o.y = v.y < 0.f ? m.y : r.y; return o;
}

template <int ACT  > struct EpiBf16 {
    static constexpr bool PERM = true, AFTER_DRAIN = false; static_assert(ACT == 0 || ACT == 1, "EpiBf16: ACT is 0 (none) or 1 (gelu_pk)");
    bf16_t* O; int ldc; const float* bias; int split_cols; size_t split_stride; float scale0;
    __device__ __forceinline__ void operator()(const f32x4 (&acc)[2][2][4][2], const Unit& u, int wr, int wc, int fr, int fq) const {
        asm volatile("" : "+v"(fr), "+v"(fq));
        const int row0 = u.pm * BM + wr * 64 + fr; int colt = u.pn * BM; bf16_t* base = O;
        float sc = 1.f; if (split_cols) { const int t = colt / split_cols; base += (size_t)t * split_stride; colt -= t * split_cols; if (t == 0) sc = scale0; }
        const int col0 = colt + wc * 32 + 8 * fq, bcol0 = u.pn * BM + wc * 32 + 8 * fq;
        f32x4 bv[2][2];
#pragma unroll
        for (int bj = 0; bj < 2; ++bj)
#pragma unroll
            for (int n = 0; n < 2; ++n) bv[bj][n] = bias ? *(const f32x4*)(bias + bcol0 + bj * HALF + 4 * n) : (f32x4){0.f, 0.f, 0.f, 0.f};
#pragma unroll
        for (int ai = 0; ai < 2; ++ai)
#pragma unroll
            for (int m = 0; m < 4; ++m) { bf16_t* rowp = base + (size_t)(row0 + ai * HALF + m * 16) * ldc + col0;
#pragma unroll
                for (int bj = 0; bj < 2; ++bj) { f32x4 v0 = acc[ai][bj][m][0] + bv[bj][0], v1 = acc[ai][bj][m][1] + bv[bj][1];
                    if (ACT == 1) { f32x2 a = gelu_pk((f32x2){v0[0], v0[1]}), b = gelu_pk((f32x2){v0[2], v0[3]}), c = gelu_pk((f32x2){v1[0], v1[1]}), d = gelu_pk((f32x2){v1[2], v1[3]});
                        v0 = (f32x4){a.x, a.y, b.x, b.y}; v1 = (f32x4){c.x, c.y, d.x, d.y}; }
                    v0 = v0 * sc; v1 = v1 * sc; u32x4 w; w.x = cvt_pk_bf16(v0[0], v0[1]); w.y = cvt_pk_bf16(v0[2], v0[3]); w.z = cvt_pk_bf16(v1[0], v1[1]); w.w = cvt_pk_bf16(v1[2], v1[3]);
                    *(u32x4*)(rowp + bj * HALF) = w; } }
    }
};

template <class Epi, class Sched, bool ALIGN_EPI = false, bool SP2 = false>
__device__ __forceinline__ void gemm_phase(PG8_LAS unsigned char* lds, const Gemm g, const Sched& S, const Epi& E) {
    const int tid = otid(), wid = __builtin_amdgcn_readfirstlane(tid >> 6), lane = tid & 63, wr = wid >> 2, wc = wid & 3, fr = lane & 15, fq = lane >> 4;
    const int K = g.K, nt = K / BK;
    unsigned voffA[2], voffB[2];
#pragma unroll
    for (int i = 0; i < 2; ++i) { int R, C; stage_rc(tid * 16 + i * 8192, R, C); const int Rb = Epi::PERM ? ((R & ~31) + perm32(R & 31)) : R;
        voffA[i] = (unsigned)(R * K + C) * 2u; voffB[i] = (unsigned)(Rb * K + C) * 2u; }
    const size_t kstep = (size_t)(BK * 2);
    const size_t hstep = (size_t)HALF * K * 2;
    const size_t tstep = 2 * hstep;
    const unsigned ldsw = (unsigned)wid * 1024u;
    const int aoff = lds_byte(wr * 64 + fr, fq * 8), boff = lds_byte(wc * 32 + fr, fq * 8);
#define PG8_SA(b, h) (((b) * 2 + (h)) * HTB)
#define PG8_SB(b, h) ((4 + (b) * 2 + (h)) * HTB)
#define PG8_STAGE(bufoff, gbase, voff) do { _Pragma("unroll") for (int _i = 0; _i < 2; ++_i) \
        __builtin_amdgcn_global_load_lds((const unsigned*)((const char*)(gbase) + (voff)[_i]), (PG8_LAS unsigned*)(lds + (bufoff) + ldsw + _i * 8192), 16, 0, 0); } while (0)
#define PG8_LDA(dst, b, h) do { _Pragma("unroll") for (int m = 0; m < 4; ++m) _Pragma("unroll") for (int k = 0; k < 2; ++k) dst[m][k] = *(const PG8_LAS bf16x8*)(lds + PG8_SA(b, h) + aoff + m * 2048 + k * 1024); } while (0)
#define PG8_LDB(dst, b, h) do { _Pragma("unroll") for (int n = 0; n < 2; ++n) _Pragma("unroll") for (int k = 0; k < 2; ++k) dst[n][k] = *(const PG8_LAS bf16x8*)(lds + PG8_SB(b, h) + boff + n * 2048 + k * 1024); } while (0)
#define PG8_MMA(ai, bj, At, Bt) do { __builtin_amdgcn_s_setprio(1); _Pragma("unroll") for (int m = 0; m < 4; ++m) _Pragma("unroll") for (int n = 0; n < 2; ++n) _Pragma("unroll") for (int k = 0; k < 2; ++k) \
        acc[ai][bj][m][n] = __builtin_amdgcn_mfma_f32_16x16x32_bf16(Bt[n][k], At[m][k], acc[ai][bj][m][n], 0, 0, 0); __builtin_amdgcn_s_setprio(0); } while (0)
#define PG8_WAIT_V(n) asm volatile("s_waitcnt vmcnt(" #n ")" ::: "memory")
#define PG8_WAIT_L(n) asm volatile("s_waitcnt lgkmcnt(" #n ")" ::: "memory")
#define PG8_BAR __builtin_amdgcn_s_barrier()
#define PG8_SCHED __builtin_amdgcn_sched_barrier(0)
    Unit cur, nxt; int ui = 0;
    if (!S.next(0, cur)) return;
    f32x4 acc[2][2][4][2];
#pragma unroll
    for (int a = 0; a < 2; ++a)
#pragma unroll
        for (int b = 0; b < 2; ++b)
#pragma unroll
            for (int m = 0; m < 4; ++m)
#pragma unroll
                for (int n = 0; n < 2; ++n) acc[a][b][m][n] = (f32x4){0.f, 0.f, 0.f, 0.f};
    bf16x8 At[4][2], B0[2][2], B1[2][2];
    const char* cA = (const char*)g.A + (size_t)cur.pm * tstep; const char* cB = (const char*)g.Bt + (size_t)cur.pn * tstep;
    S.a_ready(cur);
    if constexpr (SP2) {
        PG8_STAGE(PG8_SB(0, 0), cB, voffB); PG8_STAGE(PG8_SB(0, 1), cB + hstep, voffB); PG8_STAGE(PG8_SA(0, 0), cA, voffA); PG8_STAGE(PG8_SA(0, 1), cA + hstep, voffA);
        if (wr == 1) PG8_BAR;
        PG8_WAIT_V(2); PG8_BAR;
        PG8_STAGE(PG8_SB(1, 0), cB + kstep, voffB); PG8_STAGE(PG8_SA(1, 0), cA + kstep, voffA); PG8_STAGE(PG8_SB(1, 1), cB + hstep + kstep, voffB);
        PG8_WAIT_V(6); PG8_BAR;
    } else {
        PG8_STAGE(PG8_SB(0, 0), cB, voffB); PG8_STAGE(PG8_SA(0, 0), cA, voffA); PG8_STAGE(PG8_SB(0, 1), cB + hstep, voffB); PG8_STAGE(PG8_SA(0, 1), cA + hstep, voffA);
        if (wr == 1) PG8_BAR;
        PG8_WAIT_V(4); PG8_BAR;
        PG8_STAGE(PG8_SB(1, 0), cB + kstep, voffB); PG8_STAGE(PG8_SA(1, 0), cA + kstep, voffA); PG8_STAGE(PG8_SB(1, 1), cB + hstep + kstep, voffB);
        PG8_WAIT_V(6); PG8_BAR;
    }
    for (;;) {
        const bool has_next = S.next(ui + 1, nxt);
        const char* nA = has_next ? (const char*)g.A + (size_t)nxt.pm * tstep : cA; const char* nB = has_next ? (const char*)g.Bt + (size_t)nxt.pn * tstep : cB;
        for (int t = 0; t < nt; t += 2) {
            const bool last = (t == nt - 2);
            const char* a1 = cA + (size_t)(t + 1) * kstep;
            const char* a2 = last ? nA : cA + (size_t)(t + 2) * kstep; const char* b2 = last ? nB : cB + (size_t)(t + 2) * kstep;
            const char* a3 = a2 + kstep; const char* b3 = b2 + kstep;
            if (last && has_next) S.a_ready(nxt);
            if constexpr (SP2) {
            PG8_LDB(B0, 0, 0); PG8_LDB(B1, 0, 1); PG8_SCHED; PG8_LDA(At, 0, 0); PG8_STAGE(PG8_SA(1, 1), a1 + hstep, voffA);
            PG8_WAIT_V(8); PG8_WAIT_L(0); PG8_BAR; PG8_MMA(0, 0, At, B0); PG8_MMA(0, 1, At, B1); PG8_BAR; PG8_SCHED;
            PG8_LDA(At, 0, 1); PG8_STAGE(PG8_SB(0, 0), b2, voffB); PG8_STAGE(PG8_SB(0, 1), b2 + hstep, voffB); PG8_STAGE(PG8_SA(0, 0), a2, voffA);
            PG8_WAIT_V(8); PG8_WAIT_L(0); PG8_BAR; PG8_MMA(1, 0, At, B0); PG8_MMA(1, 1, At, B1); PG8_BAR; PG8_SCHED;
            PG8_LDB(B0, 1, 0); PG8_LDB(B1, 1, 1); PG8_SCHED; PG8_LDA(At, 1, 0); PG8_STAGE(PG8_SA(0, 1), a2 + hstep, voffA);
            PG8_WAIT_V(8); PG8_WAIT_L(0); PG8_BAR; PG8_MMA(0, 0, At, B0); PG8_MMA(0, 1, At, B1); PG8_BAR; PG8_SCHED;
            PG8_LDA(At, 1, 1); PG8_STAGE(PG8_SB(1, 0), b3, voffB); PG8_STAGE(PG8_SB(1, 1), b3 + hstep, voffB); PG8_STAGE(PG8_SA(1, 0), a3, voffA);
            PG8_WAIT_V(8); PG8_WAIT_L(0); PG8_BAR; PG8_MMA(1, 0, At, B0); PG8_MMA(1, 1, At, B1); PG8_BAR; PG8_SCHED;
            } else {
            PG8_LDB(B0, 0, 0); PG8_SCHED; PG8_LDA(At, 0, 0); PG8_STAGE(PG8_SA(1, 1), a1 + hstep, voffA);
            PG8_WAIT_L(8); PG8_BAR; PG8_WAIT_L(0); PG8_MMA(0, 0, At, B0); PG8_BAR; PG8_SCHED;
            PG8_LDB(B1, 0, 1); PG8_STAGE(PG8_SB(0, 0), b2, voffB);
            PG8_BAR; PG8_WAIT_L(0); PG8_MMA(0, 1, At, B1); PG8_BAR;
            PG8_LDA(At, 0, 1); PG8_STAGE(PG8_SA(0, 0), a2, voffA);
            PG8_BAR; PG8_WAIT_L(0); PG8_MMA(1, 0, At, B0); PG8_BAR; PG8_SCHED;
            PG8_STAGE(PG8_SB(0, 1), b2 + hstep, voffB);
            PG8_WAIT_V(6); PG8_BAR; PG8_MMA(1, 1, At, B1); PG8_BAR;
            PG8_LDB(B0, 1, 0); PG8_SCHED; PG8_LDA(At, 1, 0); PG8_STAGE(PG8_SA(0, 1), a2 + hstep, voffA);
            PG8_WAIT_L(8); PG8_BAR; PG8_WAIT_L(0); PG8_MMA(0, 0, At, B0); PG8_BAR; PG8_SCHED;
            PG8_LDB(B1, 1, 1); PG8_STAGE(PG8_SB(1, 0), b3, voffB);
            PG8_BAR; PG8_WAIT_L(0); PG8_MMA(0, 1, At, B1); PG8_BAR;
            PG8_LDA(At, 1, 1); PG8_STAGE(PG8_SA(1, 0), a3, voffA);
            PG8_BAR; PG8_WAIT_L(0); PG8_MMA(1, 0, At, B0); PG8_BAR; PG8_SCHED;
            PG8_STAGE(PG8_SB(1, 1), b3 + hstep, voffB);
            PG8_WAIT_V(6); PG8_BAR; PG8_MMA(1, 1, At, B1); PG8_BAR;
            }
        }
        if constexpr (ALIGN_EPI) { if (wr == 0) PG8_BAR; }
        if constexpr (!Epi::AFTER_DRAIN) { E(acc, cur, wr, wc, fr, fq); S.done(cur); }
        if (!has_next) break;
#pragma unroll
        for (int a = 0; a < 2; ++a)
#pragma unroll
            for (int b = 0; b < 2; ++b)
#pragma unroll
                for (int m = 0; m < 4; ++m)
#pragma unroll
                    for (int n = 0; n < 2; ++n) acc[a][b][m][n] = (f32x4){0.f, 0.f, 0.f, 0.f};
        cur = nxt; cA = nA; cB = nB; ++ui;
        if constexpr (ALIGN_EPI) { if (wr == 1) PG8_BAR; }
    }
    PG8_WAIT_V(0);
    if constexpr (!ALIGN_EPI) { if (wr == 0) PG8_BAR; }
    PG8_BAR;
    if constexpr (Epi::AFTER_DRAIN) { E.fused(acc, cur, wr, wc, fr, fq, lds, wid, lane); S.done(cur); }
#undef PG8_SA
#undef PG8_SB
#undef PG8_STAGE
#undef PG8_LDA
#undef PG8_LDB
#undef PG8_MMA
#undef PG8_WAIT_V
#undef PG8_WAIT_L
#undef PG8_BAR
#undef PG8_SCHED
}
}

#include <hip/hip_bf16.h>
#include <cmath>
namespace attn_body {
using bf16=__hip_bfloat16;
using bf16x8=__attribute__((ext_vector_type(8)))short;
using s16x4=__attribute__((ext_vector_type(4)))short;
using f32x16=__attribute__((ext_vector_type(16)))float;
using u32x4=__attribute__((ext_vector_type(4)))unsigned;
constexpr int D=64,QP=512,KP=128,VP=2304,OP=1024;
constexpr int NW=8,QBLK=32,QB=QBLK*NW,KVBLK=64;
constexpr int ATTN_UNIT_ROWS=QB;
__device__ __forceinline__ int crow(int r,int hi){return (r&3)+8*(r>>2)+4*hi;}
#define SBAR() __builtin_amdgcn_sched_barrier(0)
constexpr int NSLOT=3, SLOTB=8192;
constexpr int LDS_K=0, LDS_V=NSLOT*SLOTB, LDS_WS=2*NSLOT*SLOTB, LDS_OST=LDS_WS+NW*64*4, LDS_BYTES=LDS_OST+NW*4096;
constexpr float C2=0.125f*1.4426950408889634f;
__device__ __forceinline__ void glds16(const void*gsrc,unsigned lds_dst){unsigned keep;
  asm volatile("s_mov_b32 %0, m0\n\ts_mov_b32 m0, %2\n\ts_nop 0\n\tglobal_load_lds_dwordx4 %1, off\n\ts_mov_b32 m0, %0":"=&s"(keep):"v"(gsrc),"s"(lds_dst):"memory");}
__device__ __forceinline__ float max3f(float a,float b,float c){float r;asm("v_max3_f32 %0, %1, %2, %3":"=v"(r):"v"(a),"v"(b),"v"(c));return r;}
__device__ __forceinline__ float max2f(float a,float b){float r;asm("v_max_f32_e32 %0, %1, %2":"=v"(r):"v"(a),"v"(b));return r;}
__device__ __forceinline__ float fadd_s(float a,float b){float r;asm("v_add_f32_e32 %0, %1, %2":"=v"(r):"v"(a),"v"(b));return r;}
__device__ __forceinline__ float fsub_s(float a,float b){float r;asm("v_sub_f32_e32 %0, %1, %2":"=v"(r):"v"(a),"v"(b));return r;}
typedef float f32x2_t __attribute__((ext_vector_type(2))); typedef __bf16 bf16x2_t __attribute__((ext_vector_type(2)));
__device__ __forceinline__ unsigned cvtpk_s(float lo,float hi){f32x2_t v={lo,hi};bf16x2_t b=__builtin_convertvector(v,bf16x2_t);return __builtin_bit_cast(unsigned,b);}
#define WAIT_BAR(N) asm volatile("s_waitcnt vmcnt(" #N ") lgkmcnt(0)\n\ts_barrier":::"memory")

__device__ __forceinline__ void qkt(f32x16&p0,f32x16&p1,const char*Kslot,const bf16x8*qr,const f32x16&negm,int r32,int hi){
  const char*kb=Kslot+hi*1024+r32*16;
  #pragma unroll
  for(int d0=0;d0<4;++d0){
    const bf16x8 b0=*reinterpret_cast<const bf16x8*>(kb+d0*2048);
    const bf16x8 b1=*reinterpret_cast<const bf16x8*>(kb+d0*2048+512);
    if(d0==0){p0=__builtin_amdgcn_mfma_f32_32x32x16_bf16(b0,qr[0],negm,0,0,0);p1=__builtin_amdgcn_mfma_f32_32x32x16_bf16(b1,qr[0],negm,0,0,0);}
    else{p0=__builtin_amdgcn_mfma_f32_32x32x16_bf16(b0,qr[d0],p0,0,0,0);p1=__builtin_amdgcn_mfma_f32_32x32x16_bf16(b1,qr[d0],p1,0,0,0);}}
}
typedef __attribute__((address_space(3))) const char* lds_cptr;
typedef short v4i16_t __attribute__((ext_vector_type(4)));
__device__ __forceinline__ void kload8(bf16x8*kf,lds_cptr kp){
  kf[0]=*(const __attribute__((address_space(3))) bf16x8*)(kp);      kf[1]=*(const __attribute__((address_space(3))) bf16x8*)(kp+512);
  kf[2]=*(const __attribute__((address_space(3))) bf16x8*)(kp+2048); kf[3]=*(const __attribute__((address_space(3))) bf16x8*)(kp+2560);
  kf[4]=*(const __attribute__((address_space(3))) bf16x8*)(kp+4096); kf[5]=*(const __attribute__((address_space(3))) bf16x8*)(kp+4608);
  kf[6]=*(const __attribute__((address_space(3))) bf16x8*)(kp+6144); kf[7]=*(const __attribute__((address_space(3))) bf16x8*)(kp+6656);
}
__device__ __forceinline__ void kload2(bf16x8*kf,lds_cptr kp,int j){ kf[2*j]=*(const __attribute__((address_space(3))) bf16x8*)(kp+j*2048); kf[2*j+1]=*(const __attribute__((address_space(3))) bf16x8*)(kp+j*2048+512); }
__device__ __forceinline__ s16x4 vtr(lds_cptr p){ return __builtin_bit_cast(s16x4,__builtin_amdgcn_ds_read_tr16_b64_v4i16((__attribute__((address_space(3))) v4i16_t*)p)); }
__device__ __forceinline__ float rowmax(const f32x16&p0,const f32x16&p1){
  float a=max3f(p0[0],p0[1],p1[0]),b=max3f(p0[2],p0[3],p1[1]);a=max3f(a,p1[2],p1[3]);
  #pragma unroll
  for(int r=4;r<16;r+=4){a=max3f(a,p0[r],p0[r+1]);b=max3f(b,p0[r+2],p0[r+3]);a=max3f(a,p1[r],p1[r+1]);b=max3f(b,p1[r+2],p1[r+3]);}
  const float m=max2f(a,b);
  auto rr=__builtin_amdgcn_permlane32_swap(__float_as_uint(m),__float_as_uint(m),false,false);
  return max2f(__uint_as_float(rr[0]),__uint_as_float(rr[1]));
}
__device__ __forceinline__ void pv(f32x16*o,int vb,bf16x8 pa0,bf16x8 pa1,bf16x8 pa2,bf16x8 pa3){
  #pragma unroll
  for(int d0=0;d0<2;++d0){s16x4 lo[4],hi[4];
    #pragma unroll
    for(int ks=0;ks<4;++ks){
      asm volatile("ds_read_b64_tr_b16 %0,%1 offset:%c2":"=&v"(lo[ks]):"v"(vb),"i"(d0*4096+ks*1024):"memory");
      asm volatile("ds_read_b64_tr_b16 %0,%1 offset:%c2":"=&v"(hi[ks]):"v"(vb),"i"(d0*4096+ks*1024+512):"memory");}
    asm volatile("s_waitcnt lgkmcnt(0)":::"memory");SBAR();
    #define PK(k) (bf16x8){lo[k][0],lo[k][1],lo[k][2],lo[k][3],hi[k][0],hi[k][1],hi[k][2],hi[k][3]}
    o[d0]=__builtin_amdgcn_mfma_f32_32x32x16_bf16(pa0,PK(0),o[d0],0,0,0);
    o[d0]=__builtin_amdgcn_mfma_f32_32x32x16_bf16(pa1,PK(1),o[d0],0,0,0);
    o[d0]=__builtin_amdgcn_mfma_f32_32x32x16_bf16(pa2,PK(2),o[d0],0,0,0);
    o[d0]=__builtin_amdgcn_mfma_f32_32x32x16_bf16(pa3,PK(3),o[d0],0,0,0);
    #undef PK
  }
}

#ifndef ATTN_STORE16
#define ATTN_STORE16(p,v) (*(u32x4*)(p)=(v))
#endif
__device__ __forceinline__ void attn_unit(const bf16*Qw0,const bf16*__restrict__ Kh,const bf16*__restrict__ Vh,bf16*Ow0,const int NT,const float neg_ref,char*shm){
  const int tid=otid(),lane=tid&63,r32=lane&31,hi=lane>>5; const int wid=__builtin_amdgcn_readfirstlane(tid>>6);
  const bf16*Qw=Qw0+(long)(wid*QBLK)*QP;
  const unsigned lds0=(unsigned)(uintptr_t)shm;
  float*wsf=(float*)(shm+LDS_WS)+wid*64;
  const bf16*ksrc=Kh+(long)lane*KP+wid*8;
  const bf16*vsrc=Vh+(long)(16*(wid&3)+(lane>>2))*VP+(wid>>2)*32+(lane&3)*8;
  const unsigned kdst=lds0+LDS_K+wid*1024, vdst=lds0+LDS_V+wid*1024;
  #define DMA_K(t,slot) glds16(ksrc+(long)(t)*KVBLK*KP,(unsigned)__builtin_amdgcn_readfirstlane(kdst+(slot)))
  #define DMA_V(t,slot) glds16(vsrc+(long)(t)*KVBLK*VP,(unsigned)__builtin_amdgcn_readfirstlane(vdst+(slot)))
  const int vb0=(int)(lds0+LDS_V)+((lane>>4)&1)*32+(lane&3)*8+(4*hi+((lane&15)>>2))*64;
  const char*Kbase=shm+LDS_K; bf16x8 kf[8];
  const lds_cptr shm3=(lds_cptr)shm; const lds_cptr kp0=shm3+LDS_K+hi*1024+r32*16; const lds_cptr vp0=shm3+LDS_V+((lane>>4)&1)*32+(lane&3)*8+(4*hi+((lane&15)>>2))*64;
  DMA_K(0,0);DMA_V(0,0);DMA_K(1,SLOTB);
  bf16x8 qr[4];
  #pragma unroll
  for(int d0=0;d0<4;++d0)qr[d0]=*reinterpret_cast<const bf16x8*>(&Qw[(long)r32*QP+d0*16+hi*8]);
  float l_reg=0.f;f32x16 o[2];o[0]=f32x16{};o[1]=f32x16{};f32x16 negm;
  #pragma unroll
  for(int r=0;r<16;++r)negm[r]=neg_ref;
  asm volatile("":"+v"(negm));
  f32x16 pA0,pA1,pB0,pB1;
  int sl_prev=0,sl_cur=0,sl_next=SLOTB;
  #define ROT() do{sl_prev=sl_cur;sl_cur=sl_next;sl_next=(sl_next==(NSLOT-1)*SLOTB)?0:sl_next+SLOTB;}while(0)
  DMA_K(2,2*SLOTB);
  WAIT_BAR(3);
  qkt(pA0,pA1,Kbase,qr,negm,r32,hi);asm volatile("s_nop 15\n\ts_nop 7":"+v"(pA0),"+v"(pA1));
  _Pragma("unroll") for(int r=0;r<16;++r)pA0[r]=__builtin_amdgcn_exp2f(pA0[r]);
  _Pragma("unroll") for(int r=0;r<16;++r)pA1[r]=__builtin_amdgcn_exp2f(pA1[r]);
  WAIT_BAR(0);
  DMA_K(3,0);DMA_V(1,SLOTB);
  ROT();
  kload8(kf,kp0+sl_cur);
  WAIT_BAR(2);
  s16x4 vlo[8],vhi[8]; u32x4 pw0,pw1,pw2,pw3;
  #define PKW(P,B) cvtpk_s(P[B],P[B+1])
  #define PAF(k) __builtin_bit_cast(bf16x8,pw##k)
  #define VFR(i) (bf16x8){vlo[i][0],vlo[i][1],vlo[i][2],vlo[i][3],vhi[i][0],vhi[i][1],vhi[i][2],vhi[i][3]}
  #define PIN(x) asm volatile("":"+v"(x))
  #define MX3(a,b,c) __builtin_fmaxf(__builtin_fmaxf((a),(b)),(c))
  #define GAPA(MF,A0,A1,A2,A3,W0,W1,PW) do{ MF; sacc+=A0; sacc+=A1; sacc+=A2; sacc+=A3; PIN(sacc); W0; W1; PIN(PW); SBAR(); }while(0)
  #define EX(v) __builtin_amdgcn_exp2f(v)
  #define GAPB(MF,X,B) do{ MF; X[B]=EX(X[B]); X[B+1]=EX(X[B+1]); X[B+2]=EX(X[B+2]); X[B+3]=EX(X[B+3]); PIN(X); SBAR(); }while(0)
  #define VRD(i) do{ vlo[i]=vtr(vp_+(((i)>>2)*4096+((i)&3)*1024)); vhi[i]=vtr(vp_+(((i)>>2)*4096+((i)&3)*1024+512)); }while(0)
  #define KRD(G,j) do{ if(G){ kload2(kf,kp0+sl_next,j); SBAR(); } }while(0)
  #define STEP(C0,C1,P0,P1,t,GK,GV,GL) do{ SBAR(); \
    const lds_cptr vp_=vp0+sl_prev; \
    VRD(0); SBAR(); float sacc=(P0[0]+P0[1]); \
    GAPA(C0=__builtin_amdgcn_mfma_f32_32x32x16_bf16(kf[0],qr[0],negm,0,0,0), P0[2],P0[3],P0[4],P0[5],     pw0[0]=PKW(P0,0), pw0[1]=PKW(P0,2), pw0); \
    VRD(4); SBAR(); GAPA(C1=__builtin_amdgcn_mfma_f32_32x32x16_bf16(kf[1],qr[0],negm,0,0,0), P0[6],P0[7],P0[8],P0[9],     pw0[2]=PKW(P0,4), pw0[3]=PKW(P0,6), pw0); \
    VRD(1); SBAR(); GAPA(C0=__builtin_amdgcn_mfma_f32_32x32x16_bf16(kf[2],qr[1],C0,0,0,0),   P0[10],P0[11],P0[12],P0[13], pw1[0]=PKW(P0,8), pw1[1]=PKW(P0,10), pw1); \
    VRD(5); SBAR(); GAPA(C1=__builtin_amdgcn_mfma_f32_32x32x16_bf16(kf[3],qr[1],C1,0,0,0),   P0[14],P0[15],P1[0],P1[1],   pw1[2]=PKW(P0,12),pw1[3]=PKW(P0,14), pw1); \
    VRD(2); SBAR(); GAPA(C0=__builtin_amdgcn_mfma_f32_32x32x16_bf16(kf[4],qr[2],C0,0,0,0),   P1[2],P1[3],P1[4],P1[5],     pw2[0]=PKW(P1,0), pw2[1]=PKW(P1,2), pw2); \
    VRD(6); SBAR(); GAPA(C1=__builtin_amdgcn_mfma_f32_32x32x16_bf16(kf[5],qr[2],C1,0,0,0),   P1[6],P1[7],P1[8],P1[9],     pw2[2]=PKW(P1,4), pw2[3]=PKW(P1,6), pw2); \
    VRD(3); SBAR(); GAPA(C0=__builtin_amdgcn_mfma_f32_32x32x16_bf16(kf[6],qr[3],C0,0,0,0),   P1[10],P1[11],P1[12],P1[13], pw3[0]=PKW(P1,8), pw3[1]=PKW(P1,10), pw3); \
    VRD(7); SBAR(); GAPA(C1=__builtin_amdgcn_mfma_f32_32x32x16_bf16(kf[7],qr[3],C1,0,0,0),   P1[14],P1[15],0.f,0.f,       pw3[2]=PKW(P1,12),pw3[3]=PKW(P1,14), pw3); \
    l_reg+=sacc; \
    if(GK){DMA_K((t)+3,sl_cur);} if(GV){DMA_V((t)+1,sl_next);} \
    SBAR(); \
    GAPB(o[0]=__builtin_amdgcn_mfma_f32_32x32x16_bf16(PAF(0),VFR(0),o[0],0,0,0), C0,0); \
    GAPB(o[1]=__builtin_amdgcn_mfma_f32_32x32x16_bf16(PAF(0),VFR(4),o[1],0,0,0), C0,4); \
    KRD(GL,0); GAPB(o[0]=__builtin_amdgcn_mfma_f32_32x32x16_bf16(PAF(1),VFR(1),o[0],0,0,0), C0,8); \
    KRD(GL,1); GAPB(o[1]=__builtin_amdgcn_mfma_f32_32x32x16_bf16(PAF(1),VFR(5),o[1],0,0,0), C0,12); \
    KRD(GL,2); GAPB(o[0]=__builtin_amdgcn_mfma_f32_32x32x16_bf16(PAF(2),VFR(2),o[0],0,0,0), C1,0); \
    KRD(GL,3); GAPB(o[1]=__builtin_amdgcn_mfma_f32_32x32x16_bf16(PAF(2),VFR(6),o[1],0,0,0), C1,4); \
    GAPB(o[0]=__builtin_amdgcn_mfma_f32_32x32x16_bf16(PAF(3),VFR(3),o[0],0,0,0), C1,8); \
    GAPB(o[1]=__builtin_amdgcn_mfma_f32_32x32x16_bf16(PAF(3),VFR(7),o[1],0,0,0), C1,12); \
    }while(0)
  int t=1;
  for(;t+5<NT;t+=2){
    STEP(pB0,pB1,pA0,pA1,t,true,true,true);     WAIT_BAR(2); ROT();
    STEP(pA0,pA1,pB0,pB1,t+1,true,true,true);   WAIT_BAR(2); ROT();
  }
  #define ENDW(tt) do{ if((tt)+3<NT){WAIT_BAR(2);} else if((tt)+2<NT){WAIT_BAR(1);} else {WAIT_BAR(0);} }while(0)
  for(;t+1<NT;t+=2){
    STEP(pB0,pB1,pA0,pA1,t,(t+3<NT),(t+1<NT),(t+1<NT));       ENDW(t);   ROT();
    STEP(pA0,pA1,pB0,pB1,t+1,(t+4<NT),(t+2<NT),(t+2<NT));     ENDW(t+1); ROT();
  }
  STEP(pB0,pB1,pA0,pA1,NT-1,false,false,false);
  { float sacc=pB0[0]+pB0[1]; _Pragma("unroll") for(int r=2;r<16;++r)sacc+=pB0[r]; _Pragma("unroll") for(int r=0;r<16;++r)sacc+=pB1[r]; l_reg+=sacc;
    pw0=(u32x4){PKW(pB0,0),PKW(pB0,2),PKW(pB0,4),PKW(pB0,6)};pw1=(u32x4){PKW(pB0,8),PKW(pB0,10),PKW(pB0,12),PKW(pB0,14)};pw2=(u32x4){PKW(pB1,0),PKW(pB1,2),PKW(pB1,4),PKW(pB1,6)};pw3=(u32x4){PKW(pB1,8),PKW(pB1,10),PKW(pB1,12),PKW(pB1,14)};
    SBAR(); pv(o,vb0+sl_cur,PAF(0),PAF(1),PAF(2),PAF(3)); }
  #undef PKW
  #undef PAF
  #undef VFR
  #undef PIN
  #undef MX3
  #undef GAPA
  #undef GAPB
  #undef EX
  #undef VRD
  #undef KRD
  #undef STEP
  #undef ENDW
  {auto rr=__builtin_amdgcn_permlane32_swap(__float_as_uint(l_reg),__float_as_uint(l_reg),false,false);l_reg=__uint_as_float(rr[0])+__uint_as_float(rr[1]);}
  if(hi==0)wsf[32+r32]=l_reg;asm volatile("s_waitcnt lgkmcnt(0)":::"memory");
  float rli[16];
  #pragma unroll
  for(int r=0;r<16;++r)rli[r]=__builtin_amdgcn_rcpf(wsf[32+crow(r,hi)]);
  bf16*Ow=Ow0+(long)(wid*QBLK)*OP;
  { bf16*stg=(bf16*)(shm+LDS_OST)+wid*2048;
    #pragma unroll
    for(int r=0;r<16;++r){const int orow=crow(r,hi);
      #pragma unroll
      for(int d0=0;d0<2;++d0)stg[orow*64+d0*32+r32]=__float2bfloat16(o[d0][r]*rli[r]);}
    asm volatile("s_waitcnt lgkmcnt(0)":::"memory");
    #pragma unroll
    for(int i=0;i<4;++i){const int row=i*8+(lane>>3),ch=lane&7; const u32x4 v=*(const u32x4*)(stg+row*64+ch*8); ATTN_STORE16(Ow+(long)row*OP+ch*8,v);} }
  asm volatile("s_waitcnt lgkmcnt(0)\n\ts_barrier":::"memory");
  #undef DMA_K
  #undef DMA_V
  #undef ROT
}
constexpr int ATTN_LDS_BYTES=LDS_BYTES;
#undef SBAR
#undef WAIT_BAR
}


using namespace cfg;
typedef unsigned short bf16_t;
typedef float f32x4 __attribute__((ext_vector_type(4)));
typedef unsigned u32x4 __attribute__((ext_vector_type(4)));
typedef unsigned u32x2 __attribute__((ext_vector_type(2)));

__device__ __forceinline__ float bf2f(unsigned v) { return __uint_as_float(v << 16); }
__device__ __forceinline__ float bflo(unsigned w) { return __uint_as_float(w << 16); }
__device__ __forceinline__ float bfhi(unsigned w) { return __uint_as_float(w & 0xffff0000u); }
__device__ __forceinline__ unsigned f2bf(float f) { unsigned u = __float_as_uint(f); return (u + 0x7fffu + ((u >> 16) & 1u)) >> 16; }
__device__ __forceinline__ unsigned pk2(float lo, float hi) { return f2bf(lo) | (f2bf(hi) << 16); }
__device__ __forceinline__ float sigm(float x) { return 1.f / (1.f + __expf(-x)); }
__device__ __forceinline__ float silu(float x) { return x / (1.f + __expf(-x)); }
template <int M> __device__ __forceinline__ float xsum(float v) {
    if constexpr (M < 32) return v + __uint_as_float((unsigned)__builtin_amdgcn_ds_swizzle((int)__float_as_uint(v), (M << 10) | 0x1f));
    else { auto rr = __builtin_amdgcn_permlane32_swap(__float_as_uint(v), __float_as_uint(v), false, false); return __uint_as_float(rr[0]) + __uint_as_float(rr[1]); }
}
__device__ __forceinline__ float wave_sum(float v) { v = xsum<1>(v); v = xsum<2>(v); v = xsum<4>(v); v = xsum<8>(v); v = xsum<16>(v); v = xsum<32>(v); return v; }
__device__ __forceinline__ size_t stream_off(int row, bool& is_ctx) { const int b = row / PB, p = row - b * PB; is_ctx = p < CTXL; return is_ctx ? ((size_t)b * CTXL + p) * D : ((size_t)b * SEQ + (p - CTXL)) * D; }

constexpr size_t MiB = 1u << 20;
constexpr size_t WS_CTL = 0;
constexpr size_t WS_MODV = 1 * MiB;
constexpr size_t WS_LBF = WS_MODV + 256 * 1024;
constexpr size_t WS_REF = WS_LBF + 8192;
constexpr size_t WS_POOLWT = WS_MODV + 512 * 1024;
constexpr size_t WS_COS = 2 * MiB, WS_SIN = 3 * MiB;
constexpr size_t WS_WIN = 4 * MiB;
constexpr size_t WS_WOUT = 13 * MiB;
constexpr size_t WS_WGU = 17 * MiB;
constexpr size_t WS_WD = 49 * MiB;
constexpr size_t WS_XC = 65 * MiB;
constexpr size_t WS_XN = 67 * MiB;
constexpr size_t WS_PROJ = 100 * MiB;
constexpr size_t WS_QN = 175 * MiB;
constexpr size_t WS_KN = 192 * MiB;
constexpr size_t WS_MIX = 197 * MiB;
constexpr size_t WS_UT = 230 * MiB;
constexpr size_t WS_ST = 247 * MiB;
constexpr size_t WS_DEC = 264 * MiB;
constexpr size_t WS_LIST = 265 * MiB;
constexpr size_t WS_ACT2 = WS_PROJ;
constexpr size_t WS_WGU1 = 272 * MiB;
constexpr size_t WS_WD1 = 304 * MiB;
constexpr size_t WS_END = 320 * MiB;
constexpr int CW_CNT = 1024;

__device__ const float ROPE_INV[16] = {1.0f, 0.5623413251903491f, 0.31622776601683794f, 0.1778279410038923f, 0.1f, 0.05623413251903491f, 0.03162277660168379f, 0.01778279410038923f,
                                       0.01f, 0.005623413251903491f, 0.0031622776601683794f, 0.0017782794100389228f, 0.001f, 0.0005623413251903491f, 0.00031622776601683794f, 0.00017782794100389227f};
__device__ __forceinline__ void sincos_d(double a, double& s, double& c) {
    const double k = rint(a * 0.63661977236758134308);
    double r = fma(-k, 1.57079632679489655800e+00, a);
    r = fma(-k, 6.12323399573676603587e-17, r);
    const double r2 = r * r;
    double sp = -7.6471637318198164759e-13;
    sp = fma(sp, r2, 1.6059043836821614599e-10);
    sp = fma(sp, r2, -2.5052108385441718775e-08);
    sp = fma(sp, r2, 2.7557319223985890653e-06);
    sp = fma(sp, r2, -1.9841269841269841270e-04);
    sp = fma(sp, r2, 8.3333333333333333333e-03);
    sp = fma(sp, r2, -1.6666666666666666667e-01);
    const double sr = fma(sp * r2, r, r);
    double cp = 4.7794773323873852974e-14;
    cp = fma(cp, r2, -1.1470745597729724714e-11);
    cp = fma(cp, r2, 2.0876756987868098979e-09);
    cp = fma(cp, r2, -2.7557319223985890653e-07);
    cp = fma(cp, r2, 2.4801587301587301587e-05);
    cp = fma(cp, r2, -1.3888888888888888889e-03);
    cp = fma(cp, r2, 4.1666666666666666667e-02);
    cp = fma(cp, r2, -0.5);
    const double cr = fma(cp, r2, 1.0);
    const int q = ((int)k) & 3;
    s = (q == 0) ? sr : (q == 1) ? cr : (q == 2) ? -sr : -cr;
    c = (q == 0) ? cr : (q == 1) ? -sr : (q == 2) ? -cr : sr;
}

__device__ __forceinline__ void transpose_items(const float* __restrict__ W, int K, int N, bf16_t* __restrict__ WT, int mode, int nbatch, size_t src_stride, size_t dst_stride, float* scr, int gw, int NGW, int lane, int it_lo = 0, int it_hi = 0x7fffffff) {
    const int nblk = N / 32, per = (K / 64) * nblk, nitems = per * nbatch;
    if (it_hi > nitems) it_hi = nitems;
    for (int it = it_lo + gw; it < it_hi; it += NGW) {
        const int bt = it / per, item = it - bt * per;
        const float* Wb = W + (size_t)bt * src_stride; bf16_t* WTb = WT + (size_t)bt * dst_stride;
        const int kb = item / nblk, nb = item - kb * nblk, k0 = 64 * kb, n0 = 32 * nb;
        f32x4 wv[8];
#pragma unroll
        for (int i = 0; i < 8; ++i) wv[i] = *(const f32x4*)(Wb + (size_t)(k0 + 8 * i + (lane >> 3)) * N + n0 + (lane & 7) * 4);
#pragma unroll
        for (int i = 0; i < 8; ++i) { float* s = scr + (8 * i + (lane >> 3)) * 33 + (lane & 7) * 4; s[0] = wv[i].x; s[1] = wv[i].y; s[2] = wv[i].z; s[3] = wv[i].w; }
        asm volatile("s_waitcnt lgkmcnt(0)" ::: "memory");
        const int rbase = (mode == 0) ? n0 : ((n0 >> 7) * 256 + (mode == 2 ? 128 : 0) + (n0 & 127));
        const int cch = lane & 7;
#pragma unroll
        for (int j = 0; j < 4; ++j) { const int n = (lane >> 3) + 8 * j; const float* s = scr + (8 * cch) * 33 + n;
            u32x4 o; o.x = pk2(s[0 * 33], s[1 * 33]); o.y = pk2(s[2 * 33], s[3 * 33]); o.z = pk2(s[4 * 33], s[5 * 33]); o.w = pk2(s[6 * 33], s[7 * 33]);
            *(u32x4*)(WTb + (size_t)(rbase + n) * K + k0 + 8 * cch) = o; }
        asm volatile("s_waitcnt lgkmcnt(0)" ::: "memory");
    }
}
constexpr int MOE_ITEMS = 3 * 4096;
__device__ __forceinline__ void moe_weight_copies(const float* gate, const float* up, const float* down, bf16_t* WGU, bf16_t* WD, float* scr, int gw, int NGW, int lane, int lo, int hi) {
    if (lo < 4096) transpose_items(gate, D, DE, WGU, 1, NE, (size_t)D * DE, (size_t)1024 * D, scr, gw, NGW, lane, lo, hi < 4096 ? hi : 4096);
    if (lo < 8192 && hi > 4096) transpose_items(up, D, DE, WGU, 2, NE, (size_t)D * DE, (size_t)1024 * D, scr, gw, NGW, lane, lo > 4096 ? lo - 4096 : 0, hi < 8192 ? hi - 4096 : 4096);
    if (hi > 8192) transpose_items(down, DE, D, WD, 0, NE, (size_t)DE * D, (size_t)D * DE, scr, gw, NGW, lane, lo > 8192 ? lo - 8192 : 0, hi - 8192);
}
__device__ __forceinline__ void moe_filler(unsigned char* lds, const float* gate, const float* up, const float* down, unsigned char* ws, int lw, int lo, int hi, int U, int G, int c) {
    const int rem = U % G; int rank = c, nr = G;
    if (rem != 0) { if (c < rem) return; rank = c - rem; nr = G - rem; }
    const int tid = otid(); float* scr = (float*)(lds + 16384) + (tid >> 6) * (64 * 33);
    moe_weight_copies(gate + (size_t)lw * NE * D * DE, up + (size_t)lw * NE * D * DE, down + (size_t)lw * NE * DE * D, (bf16_t*)(ws + (lw ? WS_WGU1 : WS_WGU)), (bf16_t*)(ws + (lw ? WS_WD1 : WS_WD)), scr, rank * 8 + (tid >> 6), nr * 8, tid & 63, lo, hi);
}
struct ProArgs { const float *c, *c_ctx, *w_mod, *b_mod, *hgrn_lb, *qg, *kg, *w_in, *w_out, *pool_w, *gate, *up, *down; float *MODV, *LBF, *REF, *COS, *SIN; bf16_t *WIN, *WOUT, *POOLWT, *WGU, *WD; };
__device__ __forceinline__ void prologue_phase(unsigned char* lds, const ProArgs& a, int cu, int G) {
    const int tid = otid(), lane = tid & 63, wave = tid >> 6;
    for (int gid = cu * 512 + tid; gid < SEQ * 32; gid += G * 512) {
        const int t = gid >> 5, j = gid & 31;
        const float pos = (float)(j < 16 ? (t >> 6) : (t & 63));
        const float ang = pos * ROPE_INV[j & 15];
        double s, c; sincos_d((double)ang, s, c);
        a.COS[gid] = (float)c; a.SIN[gid] = (float)s;
    }
    if (cu == 0) {
        for (int gid = tid; gid < 1024; gid += 512) {
            const int l = gid >> 9, r = gid & 511; float v = 0.f;
            if (l == 1) v = 1.f / (1.f + expf(a.hgrn_lb[r] - a.hgrn_lb[512 + r]));
            a.LBF[gid] = fmaxf(v, 1e-30f); }
        if (tid < DEPTH) {
            float mq = 0.f, mk = 0.f;
            for (int i = 0; i < 64; ++i) { mq = fmaxf(mq, fabsf(a.qg[tid * 64 + i])); mk = fmaxf(mk, fabsf(a.kg[tid * 64 + i])); }
            a.REF[tid * 64] = -(64.f * C2 * mq * mk * 1.02f + 0.5f); }
    }
    {
        float* act = (float*)lds;
        float* part = (float*)(lds + 12288);
        for (int item = cu; item < 2 * 96; item += G) {
            const int l = item / 96, n0 = (item - l * 96) * 64;
            for (int i = tid; i < 3072; i += 512) { const int r = i >> 10, k = i & 1023; const float v = r < 2 ? a.c[r * 1024 + k] : a.c_ctx[k]; act[i] = silu(v); }
            __syncthreads();
            const float* w = a.w_mod + ((size_t)l * 1024 + (size_t)wave * 128) * 6144 + n0 + lane;
            float a0 = 0.f, a1 = 0.f, a2 = 0.f;
#pragma unroll 32
            for (int k = 0; k < 128; ++k) { const float wv = w[(size_t)k * 6144]; const int kk = wave * 128 + k; a0 += act[kk] * wv; a1 += act[1024 + kk] * wv; a2 += act[2048 + kk] * wv; }
            part[(wave * 3 + 0) * 64 + lane] = a0; part[(wave * 3 + 1) * 64 + lane] = a1; part[(wave * 3 + 2) * 64 + lane] = a2;
            __syncthreads();
            if (tid < 192) { const int r = tid >> 6, nn = tid & 63; float s = 0.f;
#pragma unroll
                for (int q = 0; q < 8; ++q) s += part[(q * 3 + r) * 64 + nn];
                a.MODV[(l * 3 + r) * 6144 + n0 + nn] = s + a.b_mod[l * 6144 + n0 + nn]; }
            __syncthreads();
        }
    }
    {
        float* scr = (float*)(lds + 16384) + wave * (64 * 33);
        const int gw = cu * 8 + wave, NGW = G * 8;
        transpose_items(a.w_in, D, NIN, a.WIN, 0, DEPTH, (size_t)D * NIN, (size_t)NIN * D, scr, gw, NGW, lane);
        transpose_items(a.w_out, D, D, a.WOUT, 0, DEPTH, (size_t)D * D, (size_t)D * D, scr, gw, NGW, lane);
        transpose_items(a.pool_w, 64, 64, a.POOLWT, 0, DEPTH * 4, (size_t)64 * 64, (size_t)64 * 64, scr, gw, NGW, lane);
    }
    __syncthreads();
}

namespace pool {
typedef float f32x16 __attribute__((ext_vector_type(16)));
typedef short bf16x8 __attribute__((ext_vector_type(8)));
constexpr int P = 72, O_X = 0  , O_DM = 81920  , O_OUT = 0  , OP = 264;
__device__ __forceinline__ int crow(int r, int hi) { return (r & 3) + 8 * (r >> 2) + 4 * hi; }
__device__ __forceinline__ void pool_phase(unsigned char* lds, const bf16_t* __restrict__ PROJ, const bf16_t* __restrict__ WT  , const float* __restrict__ pscale, bf16_t* __restrict__ MIX, int cu, int G) {
    const int tid = otid(), lane = tid & 63, r32 = lane & 31, hi = lane >> 5, w = __builtin_amdgcn_readfirstlane(tid >> 6);
    float* X = (float*)(lds + O_X); bf16_t* OUT = (bf16_t*)(lds + O_OUT);
    for (int u = cu; u < MT / 64; u += G) {
        const int row0 = u * 64, b = row0 / PB, p0 = row0 - b * PB; const bool is_ctx = p0 < CTXL;
        const int seg0 = b * PB + (is_ctx ? 0 : CTXL), len = is_ctx ? CTXL : SEQ, t0 = is_ctx ? p0 : p0 - CTXL;
#pragma unroll
        for (int it = 0; it < 5; ++it) { const int piece = tid + it * 512, rr = piece >> 5, pc = piece & 31, t = t0 - 8 + rr;
            u32x4 v = {0u, 0u, 0u, 0u};
            if (t >= 0 && t < len) v = *(const u32x4*)(PROJ + (size_t)(seg0 + t) * NIN + C_BP + pc * 8);
            float* x = X + rr * 256 + pc * 8;
            *(f32x4*)x = (f32x4){bflo(v.x), bfhi(v.x), bflo(v.y), bfhi(v.y)}; *(f32x4*)(x + 4) = (f32x4){bflo(v.z), bfhi(v.z), bflo(v.w), bfhi(v.w)}; }
        __syncthreads();
        {
            const int c = tid & 255, th = tid >> 8, g = c >> 6, hw = 1 << g;
            bf16_t* dm = (bf16_t*)(lds + O_DM) + g * 64 * P + (c & 63);
            for (int tt = 0; tt < 32; ++tt) { const int t = th * 32 + tt, tg = t0 + t;
                int lo = tg - hw; if (lo < 0) lo = 0; int hi2 = tg + hw; if (hi2 > len) hi2 = len;
                float s = 0.f;
                for (int q = lo; q < hi2; ++q) s += X[(q - t0 + 8) * 256 + c];
                dm[t * P] = (bf16_t)f2bf(s / (float)(hi2 - lo) - X[(t + 8) * 256 + c]); }
        }
        __syncthreads();
        {
            const int g = w >> 1, tb = w & 1;
            const bf16_t* A = (const bf16_t*)(lds + O_DM) + g * 64 * P + (tb * 32 + r32) * P + hi * 8;
#pragma unroll
            for (int eb = 0; eb < 2; ++eb) {
                const bf16_t* Bp = WT + (size_t)g * 4096 + (eb * 32 + r32) * 64 + hi * 8;
                f32x16 acc = {};
#pragma unroll
                for (int ks = 0; ks < 4; ++ks) acc = __builtin_amdgcn_mfma_f32_32x32x16_bf16(*(const bf16x8*)(A + ks * 16), *(const bf16x8*)(Bp + ks * 16), acc, 0, 0, 0);
                const int e = g * 64 + eb * 32 + r32; const float sc = pscale[e];
#pragma unroll
                for (int r = 0; r < 16; ++r) OUT[(tb * 32 + crow(r, hi)) * OP + e] = (bf16_t)f2bf(acc[r] * sc);
            }
        }
        __syncthreads();
#pragma unroll
        for (int it = 0; it < 4; ++it) { const int piece = tid + it * 512, t = piece >> 5, pc = piece & 31;
            *(u32x4*)(MIX + (size_t)(row0 + t) * D + 256 + pc * 8) = *(const u32x4*)(OUT + t * OP + pc * 8); }
        __syncthreads();
    }
}
}

#ifndef LAS
#define LAS __attribute__((address_space(3)))
#endif
__device__ __forceinline__ void norm1_phase(int cu, int G, const float* __restrict__ lat, const float* __restrict__ cx, const float* __restrict__ g, const float* __restrict__ modv, int sh_off, bf16_t* __restrict__ XN) {
    const int lane = otid() & 63, gw = cu * 8 + (otid() >> 6), NGW = G * 8;
    for (int row0 = gw * 4; row0 < MT; row0 += NGW * 4) {
        bool is_ctx; const size_t off = stream_off(row0, is_ctx);
        const int r = is_ctx ? 2 : row0 / PB;
        const f32x4* xr = (const f32x4*)((is_ctx ? cx : lat) + off) + lane;
        f32x4 v[4][4]; float ss[4];
#pragma unroll
        for (int q = 0; q < 4; ++q) { ss[q] = 0.f;
#pragma unroll
            for (int j = 0; j < 4; ++j) v[q][j] = xr[q * 256 + 64 * j]; }
        const float* mv = modv + r * 6144 + sh_off;
        f32x4 gs[4], sh[4];
#pragma unroll
        for (int j = 0; j < 4; ++j) { const int col = 4 * lane + 256 * j; gs[j] = *(const f32x4*)(g + col) * (*(const f32x4*)(mv + 1024 + col) + 1.f); sh[j] = *(const f32x4*)(mv + col); }
#pragma unroll
        for (int q = 0; q < 4; ++q) {
#pragma unroll
            for (int j = 0; j < 4; ++j) ss[q] += (v[q][j].x * v[q][j].x + v[q][j].y * v[q][j].y) + (v[q][j].z * v[q][j].z + v[q][j].w * v[q][j].w);
            const float rstd = 1.f / sqrtf(wave_sum(ss[q]) * (1.f / D) + EPS);
#pragma unroll
            for (int j = 0; j < 4; ++j) { const f32x4 o = v[q][j] * rstd * gs[j] + sh[j];
                u32x2 w; w.x = pk2(o.x, o.y); w.y = pk2(o.z, o.w);
                *(u32x2*)(XN + (size_t)(row0 + q) * D + 4 * lane + 256 * j) = w; } }
    }
}

__device__ __forceinline__ void norm2_router_phase(unsigned char* lds, int cu, int G, const float* __restrict__ lat, const float* __restrict__ cx, const float* __restrict__ g, const float* __restrict__ modv, int sh_off,
                                                   const float* __restrict__ router_w, const float* __restrict__ router_b, bf16_t* __restrict__ XN, unsigned* __restrict__ cnt, u32x4* __restrict__ LIST, int route_ctx) {
    const int tid = otid(), lane = tid & 63, wave = tid >> 6, gw = cu * 8 + wave, NGW = G * 8;
    float* RW = (float*)lds;
    u32x4* ENT = (u32x4*)(lds + 65536) + wave * 64;
    LAS unsigned* BC = (LAS unsigned*)((LAS unsigned char*)lds + 65536 + 8192);
#pragma unroll
    for (int it = 0; it < 8; ++it) { const int p = tid + it * 512, col = p >> 2, q = p & 3; const f32x4 w4 = *(const f32x4*)(router_w + (size_t)col * 16 + 4 * q);
        RW[(4 * q + 0) * 1024 + col] = w4.x; RW[(4 * q + 1) * 1024 + col] = w4.y; RW[(4 * q + 2) * 1024 + col] = w4.z; RW[(4 * q + 3) * 1024 + col] = w4.w; }
    if (tid < 48) BC[tid] = 0u;
    __syncthreads();
    int nent = 0;
    f32x4 vn[4];
    { int row = gw < MT ? gw : 0; bool ic; const size_t off = stream_off(row, ic); const f32x4* xr = (const f32x4*)((ic ? cx : lat) + off) + lane;
#pragma unroll
      for (int j = 0; j < 4; ++j) vn[j] = xr[64 * j]; }
    for (int row = gw; row < MT; row += NGW) {
        f32x4 v[4];
#pragma unroll
        for (int j = 0; j < 4; ++j) v[j] = vn[j];
        { const int nr = row + NGW < MT ? row + NGW : row; bool ic; const size_t off = stream_off(nr, ic); const f32x4* xr = (const f32x4*)((ic ? cx : lat) + off) + lane;
#pragma unroll
          for (int j = 0; j < 4; ++j) vn[j] = xr[64 * j]; }
        bool is_ctx; (void)stream_off(row, is_ctx);
        if (is_ctx && !route_ctx) continue;
        const int r = is_ctx ? 2 : row / PB;
        float ss = 0.f;
#pragma unroll
        for (int j = 0; j < 4; ++j) ss += (v[j].x * v[j].x + v[j].y * v[j].y) + (v[j].z * v[j].z + v[j].w * v[j].w);
        const float rstd = 1.f / sqrtf(wave_sum(ss) * (1.f / D) + EPS);
        const float* mv = modv + r * 6144 + sh_off;
#pragma unroll
        for (int j = 0; j < 4; ++j) { const int col = 4 * lane + 256 * j;
            const f32x4 gg = *(const f32x4*)(g + col), sh = *(const f32x4*)(mv + col), sc = *(const f32x4*)(mv + 1024 + col);
            v[j] = v[j] * rstd * gg * (sc + 1.f) + sh;
            u32x2 w; w.x = pk2(v[j].x, v[j].y); w.y = pk2(v[j].z, v[j].w);
            *(u32x2*)(XN + (size_t)row * D + col) = w; }
        float sc_[16], sel[16];
#pragma unroll
        for (int e = 0; e < 16; ++e) { float a = 0.f;
#pragma unroll
            for (int j = 0; j < 4; ++j) { const f32x4 w4 = *(const f32x4*)(RW + e * 1024 + 256 * j + 4 * lane); a += (v[j].x * w4.x + v[j].y * w4.y) + (v[j].z * w4.z + v[j].w * w4.w); }
            a = wave_sum(a); sc_[e] = 1.f / (1.f + __expf(-a)); sel[e] = sc_[e] + router_b[e]; }
        float gs[4]; int gi1[4], gi2[4]; float gw1[4], gw2[4];
#pragma unroll
        for (int q = 0; q < 4; ++q) { float v1 = -INFINITY, v2 = -INFINITY; int i1 = 0, i2 = 0; float s1 = 0.f, s2 = 0.f;
#pragma unroll
            for (int k = 0; k < 4; ++k) { const float x = sel[4 * q + k], sx = sc_[4 * q + k];
                if (x > v1) { v2 = v1; i2 = i1; s2 = s1; v1 = x; i1 = 4 * q + k; s1 = sx; } else if (x > v2) { v2 = x; i2 = 4 * q + k; s2 = sx; } }
            gs[q] = v1 + v2; gi1[q] = i1; gi2[q] = i2; gw1[q] = s1; gw2[q] = s2; }
        float bv = gs[0]; int e0 = gi1[0], e1 = gi2[0]; float w0 = gw1[0], w1 = gw2[0];
#pragma unroll
        for (int q = 1; q < 4; ++q) if (gs[q] > bv) { bv = gs[q]; e0 = gi1[q]; e1 = gi2[q]; w0 = gw1[q]; w1 = gw2[q]; }
        const float ws = w0 + w1; w0 /= ws; w1 /= ws;
        {
            const int gq = e0 >> 2; int a = e0 & 3, c = e1 & 3; float wa = w0, wc = w1;
            if (a > c) { const int ti = a; a = c; c = ti; const float tf = wa; wa = wc; wc = tf; }
            const int pi = (a == 0) ? (c - 1) : (a == 1 ? c + 1 : 5);
            const int bk = gq * 6 + pi;
            if (lane == 0) { const unsigned loc = __hip_atomic_fetch_add(BC + bk, 1u, __ATOMIC_RELAXED, __HIP_MEMORY_SCOPE_WORKGROUP);
                u32x4 sv; sv.x = (unsigned)bk | (loc << 8); sv.y = (unsigned)row; sv.z = __float_as_uint(wa); sv.w = __float_as_uint(wc); ENT[nent] = sv; }
            ++nent; }
    }
    __syncthreads();
    if (tid < 24) { const unsigned n = BC[tid]; BC[24 + tid] = n ? __hip_atomic_fetch_add(cnt + tid, n, __ATOMIC_RELAXED, __HIP_MEMORY_SCOPE_AGENT) : 0u; }
    __syncthreads();
    if (lane < nent) { const u32x4 en = ENT[lane]; const unsigned bk = en.x & 255u, slot = BC[24 + bk] + (en.x >> 8);
        u32x4 sv; sv.x = en.y; sv.y = en.z; sv.z = en.w; sv.w = 0u; LIST[(size_t)bk * MT + slot] = sv; }
    __syncthreads();
}

__device__ __forceinline__ void post_phase(int cu, int G, const bf16_t* __restrict__ PROJ, const float* __restrict__ qg, const float* __restrict__ kg, const float* __restrict__ COS, const float* __restrict__ SIN,
                                              bf16_t* __restrict__ QN, bf16_t* __restrict__ KN) {
    const int lane = otid() & 63, gw = cu * 8 + (otid() >> 6), NGW = G * 8;
    const int d0 = (lane & 7) * 8, jk = lane & 31;
    float qgv[8];
#pragma unroll
    for (int i = 0; i < 8; ++i) qgv[i] = qg[d0 + i];
    const float kg0 = kg[2 * jk], kg1 = kg[2 * jk + 1];
    for (int row0 = gw * 4; row0 < MT; row0 += NGW * 4) {
        const int b = row0 / PB, p0 = row0 - b * PB; const bool is_ctx = p0 < CTXL; const int t0 = is_ctx ? 0 : p0 - CTXL;
        u32x4 wq[4]; unsigned wk[4]; f32x4 cq[4], sq[4]; float ck[4], sk[4];
#pragma unroll
        for (int q = 0; q < 4; ++q) { const bf16_t* pr = PROJ + (size_t)(row0 + q) * NIN;
            wq[q] = *(const u32x4*)(pr + C_CQ + lane * 8); wk[q] = *(const unsigned*)(pr + C_CK + lane * 2);
            const int t = is_ctx ? 0 : t0 + q;
            cq[q] = *(const f32x4*)(COS + t * 32 + (d0 >> 1)); sq[q] = *(const f32x4*)(SIN + t * 32 + (d0 >> 1)); ck[q] = COS[t * 32 + jk]; sk[q] = SIN[t * 32 + jk]; }
#pragma unroll
        for (int q = 0; q < 4; ++q) {
            {
                const u32x4 w = wq[q];
                float x[8] = {bflo(w.x), bfhi(w.x), bflo(w.y), bfhi(w.y), bflo(w.z), bfhi(w.z), bflo(w.w), bfhi(w.w)};
                float ss = 0.f;
#pragma unroll
                for (int i = 0; i < 8; ++i) ss += x[i] * x[i];
                ss = xsum<1>(ss); ss = xsum<2>(ss); ss = xsum<4>(ss);
                const float rstd = 1.f / sqrtf(ss * (1.f / 64.f) + EPS);
#pragma unroll
                for (int i = 0; i < 8; ++i) x[i] = x[i] * rstd * qgv[i];
                if (!is_ctx) {
#pragma unroll
                    for (int i = 0; i < 4; ++i) { const float cs = cq[q][i], sn = sq[q][i];
                        const float x1 = x[2 * i], x2 = x[2 * i + 1]; x[2 * i] = x1 * cs - x2 * sn; x[2 * i + 1] = x1 * sn + x2 * cs; } }
                u32x4 o; o.x = pk2(x[0] * C2, x[1] * C2); o.y = pk2(x[2] * C2, x[3] * C2); o.z = pk2(x[4] * C2, x[5] * C2); o.w = pk2(x[6] * C2, x[7] * C2);
                *(u32x4*)(QN + (size_t)(row0 + q) * 512 + lane * 8) = o;
            }
            {
                float x1 = bflo(wk[q]), x2 = bfhi(wk[q]);
                float ss = x1 * x1 + x2 * x2;
                ss = xsum<1>(ss); ss = xsum<2>(ss); ss = xsum<4>(ss); ss = xsum<8>(ss); ss = xsum<16>(ss);
                const float rstd = 1.f / sqrtf(ss * (1.f / 64.f) + EPS);
                x1 = x1 * rstd * kg0; x2 = x2 * rstd * kg1;
                if (!is_ctx) { const float cs = ck[q], sn = sk[q]; const float a = x1 * cs - x2 * sn, c = x1 * sn + x2 * cs; x1 = a; x2 = c; }
                *(unsigned*)(KN + (size_t)(row0 + q) * 128 + lane * 2) = pk2(x1, x2);
            }
        }
    }
}

namespace hg {
typedef float f32x16 __attribute__((ext_vector_type(16)));
typedef short bf16x8 __attribute__((ext_vector_type(8)));
typedef short s16x4 __attribute__((ext_vector_type(4)));
typedef float f32x2 __attribute__((ext_vector_type(2)));
constexpr int P = 72;
constexpr int O_ZB = 0, O_ZQ = 32768, O_VT = 40960, O_QH = 50176, O_QT = 68608, O_KH = 87040, O_ST = 105472, O_SSQ = 123904, O_OUT = 0  , O_TOT = 0, LDS_BYTES = 124416;
constexpr int MSZ = 64 * P * 2;
constexpr int NCH = PB / 64;
__device__ __forceinline__ int crow(int r, int hi) { return (r & 3) + 8 * (r >> 2) + 4 * hi; }
__device__ __forceinline__ unsigned cvtpk(float lo, float hi) { typedef __bf16 b2 __attribute__((ext_vector_type(2))); f32x2 v = {lo, hi}; b2 b = __builtin_convertvector(v, b2); return __builtin_bit_cast(unsigned, b); }
__device__ __forceinline__ float clampe(float e) { return fminf(fmaxf(e, -80.f), 80.f); }

template <bool FULL> __device__ __forceinline__ void prep(unsigned char* lds, const bf16_t* __restrict__ PROJ, const float* __restrict__ LBFl, int row0, int h) {
    const int tid = otid();
    float* ZB = (float*)(lds + O_ZB); bf16_t* ZQ = (bf16_t*)(lds + O_ZQ); bf16_t* VT = (bf16_t*)(lds + O_VT);
    {
        const int t = tid >> 3, pc = tid & 7;
        const bf16_t* pr = PROJ + (size_t)(row0 + t) * NIN + h * 64 + pc * 8;
        const u32x4 wf = *(const u32x4*)(pr + C_AFF), wb = *(const u32x4*)(pr + C_AFB), wv = *(const u32x4*)(pr + C_AI);
        float* zf = ZB + t * 64 + pc * 8; float* zb = ZB + 4096 + t * 64 + pc * 8;
        *(f32x4*)zf = (f32x4){bflo(wf.x), bfhi(wf.x), bflo(wf.y), bfhi(wf.y)}; *(f32x4*)(zf + 4) = (f32x4){bflo(wf.z), bfhi(wf.z), bflo(wf.w), bfhi(wf.w)};
        *(f32x4*)zb = (f32x4){bflo(wb.x), bfhi(wb.x), bflo(wb.y), bfhi(wb.y)}; *(f32x4*)(zb + 4) = (f32x4){bflo(wb.z), bfhi(wb.z), bflo(wb.w), bfhi(wb.w)};
        bf16_t* vt = VT + (pc * 8) * P + t;
        vt[0 * P] = (bf16_t)(wv.x & 0xffffu); vt[1 * P] = (bf16_t)(wv.x >> 16); vt[2 * P] = (bf16_t)(wv.y & 0xffffu); vt[3 * P] = (bf16_t)(wv.y >> 16);
        vt[4 * P] = (bf16_t)(wv.z & 0xffffu); vt[5 * P] = (bf16_t)(wv.z >> 16); vt[6 * P] = (bf16_t)(wv.w & 0xffffu); vt[7 * P] = (bf16_t)(wv.w >> 16);
        if (FULL) { const u32x4 wq = *(const u32x4*)(pr + C_AQ); *(u32x4*)(ZQ + t * 64 + pc * 8) = wq; }
    }
    __syncthreads();
#pragma unroll
    for (int it = 0; it < 2; ++it) {
        const int item = tid + it * 512, dir = item >> 9, t = (item >> 3) & 63, i0 = (item & 7) * 8;
        float* zp = ZB + dir * 4096 + t * 64 + i0; const float* lp = LBFl + dir * 256 + h * 64 + i0;
        f32x4 za = *(const f32x4*)zp, zc = *(const f32x4*)(zp + 4); const f32x4 la = *(const f32x4*)lp, lc = *(const f32x4*)(lp + 4);
#pragma unroll
        for (int k = 0; k < 4; ++k) { za[k] = __logf(la[k] + (1.f - la[k]) / (1.f + __expf(-za[k]))); zc[k] = __logf(lc[k] + (1.f - lc[k]) / (1.f + __expf(-zc[k]))); }
        *(f32x4*)zp = za; *(f32x4*)(zp + 4) = zc;
    }
    __syncthreads();
    if (tid < 128) {
        const int dir = tid >> 6, i = tid & 63;
        float* zb = ZB + dir * 4096 + i; float acc = 0.f;
        if (dir == 0) {
#pragma unroll 16
            for (int t = 0; t < 64; ++t) { acc += zb[t * 64]; zb[t * 64] = acc; } }
        else {
#pragma unroll 16
            for (int t = 63; t >= 0; --t) { acc += zb[t * 64]; zb[t * 64] = acc; } }
    }
    __syncthreads();
#pragma unroll
    for (int it = 0; it < 2; ++it) {
        const int item = tid + it * 512, dir = item >> 9, t = (item >> 3) & 63, i0 = (item & 7) * 8;
        const float* B = ZB + dir * 4096;
        const int tp = dir == 0 ? t - 1 : t + 1; const bool edge = dir == 0 ? (t == 0) : (t == 63);
        const int tref = dir == 0 ? 31 : 32;
        float bc[8], bp[8], br[8];
        { const f32x4 a = *(const f32x4*)(B + t * 64 + i0), c = *(const f32x4*)(B + t * 64 + i0 + 4); bc[0] = a.x; bc[1] = a.y; bc[2] = a.z; bc[3] = a.w; bc[4] = c.x; bc[5] = c.y; bc[6] = c.z; bc[7] = c.w; }
        { const int tq = edge ? t : tp; const f32x4 a = *(const f32x4*)(B + tq * 64 + i0), c = *(const f32x4*)(B + tq * 64 + i0 + 4);
          bp[0] = a.x; bp[1] = a.y; bp[2] = a.z; bp[3] = a.w; bp[4] = c.x; bp[5] = c.y; bp[6] = c.z; bp[7] = c.w;
          if (edge) {
#pragma unroll
              for (int k = 0; k < 8; ++k) bp[k] = 0.f; } }
        { const f32x4 a = *(const f32x4*)(B + tref * 64 + i0), c = *(const f32x4*)(B + tref * 64 + i0 + 4); br[0] = a.x; br[1] = a.y; br[2] = a.z; br[3] = a.w; br[4] = c.x; br[5] = c.y; br[6] = c.z; br[7] = c.w; }
        float kh[8];
#pragma unroll
        for (int k = 0; k < 8; ++k) { const float kk = 1.f - __expf(bc[k] - bp[k]); kh[k] = kk * __expf(clampe(br[k] - bc[k])); }
        if (!FULL) {
            bf16_t* kt = (bf16_t*)(lds + O_KH + dir * MSZ) + i0 * P + t;
#pragma unroll
            for (int k = 0; k < 8; ++k) kt[k * P] = (bf16_t)f2bf(kh[k]);
        } else {
            u32x4 w; w.x = cvtpk(kh[0], kh[1]); w.y = cvtpk(kh[2], kh[3]); w.z = cvtpk(kh[4], kh[5]); w.w = cvtpk(kh[6], kh[7]);
            *(u32x4*)((bf16_t*)(lds + O_KH + dir * MSZ) + t * P + i0) = w;
            const u32x4 wq = *(const u32x4*)(ZQ + t * 64 + i0);
            float q[8] = {silu(bflo(wq.x)), silu(bfhi(wq.x)), silu(bflo(wq.y)), silu(bfhi(wq.y)), silu(bflo(wq.z)), silu(bfhi(wq.z)), silu(bflo(wq.w)), silu(bfhi(wq.w))};
            float qh[8], qt[8];
#pragma unroll
            for (int k = 0; k < 8; ++k) { qh[k] = q[k] * __expf(clampe(bc[k] - br[k])); qt[k] = q[k] * __expf(bc[k]); }
            w.x = cvtpk(qh[0], qh[1]); w.y = cvtpk(qh[2], qh[3]); w.z = cvtpk(qh[4], qh[5]); w.w = cvtpk(qh[6], qh[7]);
            *(u32x4*)((bf16_t*)(lds + O_QH + dir * MSZ) + t * P + i0) = w;
            w.x = cvtpk(qt[0], qt[1]); w.y = cvtpk(qt[2], qt[3]); w.z = cvtpk(qt[4], qt[5]); w.w = cvtpk(qt[6], qt[7]);
            *(u32x4*)((bf16_t*)(lds + O_QT + dir * MSZ) + t * P + i0) = w;
        }
    }
    __syncthreads();
}

__device__ __forceinline__ void h1_phase(unsigned char* lds, const bf16_t* __restrict__ PROJ, const float* __restrict__ LBFl, bf16_t* __restrict__ UT, float* __restrict__ DEC, int cu, int G) {
    const int tid = otid(), lane = tid & 63, r32 = lane & 31, hi = lane >> 5, w = __builtin_amdgcn_readfirstlane(tid >> 6);
    for (int u = cu; u < BATCH * NCH * 4; u += G) {
        const int h = u & 3, bc = u >> 2, b = bc / NCH, cp = bc - b * NCH, row0 = b * PB + cp * 64;
        prep<false>(lds, PROJ, LBFl, row0, h);
        const float* ZB = (const float*)(lds + O_ZB);
        {
            const int dir = w >> 2, jb = (w >> 1) & 1, ib = w & 1;
            const bf16_t* VT = (const bf16_t*)(lds + O_VT) + (jb * 32 + r32) * P + hi * 8;
            const bf16_t* KT = (const bf16_t*)(lds + O_KH + dir * MSZ) + (ib * 32 + r32) * P + hi * 8;
            f32x16 acc = {};
#pragma unroll
            for (int ks = 0; ks < 4; ++ks) acc = __builtin_amdgcn_mfma_f32_32x32x16_bf16(*(const bf16x8*)(VT + ks * 16), *(const bf16x8*)(KT + ks * 16), acc, 0, 0, 0);
            const int i = ib * 32 + r32;
            const float btot = ZB[dir * 4096 + (dir == 0 ? 63 : 0) * 64 + i], bref = ZB[dir * 4096 + (dir == 0 ? 31 : 32) * 64 + i];
            const float sc = __expf(btot - bref);
            const int chain = (b * 4 + h) * 2 + dir;
            bf16_t* ut = UT + ((size_t)chain * NCH + cp) * 4096 + i;
#pragma unroll
            for (int r = 0; r < 16; ++r) ut[(jb * 32 + crow(r, hi)) * 64] = (bf16_t)f2bf(acc[r] * sc);
        }
        if (tid < 128) { const int dir = tid >> 6, i = tid & 63; const int chain = (b * 4 + h) * 2 + dir;
            DEC[((size_t)chain * NCH + cp) * 64 + i] = __expf(ZB[dir * 4096 + (dir == 0 ? 63 : 0) * 64 + i]); }
        __syncthreads();
    }
}

__device__ __forceinline__ void h2_phase(unsigned char* lds, const bf16_t* __restrict__ UT, const float* __restrict__ DEC, bf16_t* __restrict__ ST, int cu, int G) {
    const int tid = otid(), seg = tid >> 7, e = tid & 127, jl = e >> 5, i = (e & 31) * 2;
    f32x4* TOT = (f32x4*)(lds + O_TOT);
    for (int task = cu; task < 256; task += G) {
        const int chain = task >> 4, j = (task & 15) * 4 + jl, dir = chain & 1;
        const size_t cbase = (size_t)chain * NCH;
        float S0 = 0.f, S1 = 0.f, P0 = 1.f, P1 = 1.f;
#pragma unroll 11
        for (int kk = 0; kk < 33; ++kk) { const int k = seg * 33 + kk, cp = dir == 0 ? k : (k < 4 ? 3 - k : 135 - k);
            const unsigned u = *(const unsigned*)(UT + (cbase + cp) * 4096 + j * 64 + i); const f32x2 d = *(const f32x2*)(DEC + (cbase + cp) * 64 + i);
            S0 = d.x * S0 + bflo(u); S1 = d.y * S1 + bfhi(u); P0 *= d.x; P1 *= d.y; }
        TOT[seg * 128 + e] = (f32x4){S0, S1, P0, P1};
        __syncthreads();
        float s0 = 0.f, s1 = 0.f;
#pragma unroll
        for (int sp = 0; sp < 3; ++sp) if (sp < seg) { const f32x4 t = TOT[sp * 128 + e]; s0 = t.z * s0 + t.x; s1 = t.w * s1 + t.y; }
#pragma unroll 11
        for (int kk = 0; kk < 33; ++kk) { const int k = seg * 33 + kk, cp = dir == 0 ? k : (k < 4 ? 3 - k : 135 - k);
            const unsigned u = *(const unsigned*)(UT + (cbase + cp) * 4096 + j * 64 + i); const f32x2 d = *(const f32x2*)(DEC + (cbase + cp) * 64 + i);
            *(unsigned*)(ST + (cbase + cp) * 4096 + j * 64 + i) = pk2(s0, s1);
            s0 = d.x * s0 + bflo(u); s1 = d.y * s1 + bfhi(u); }
        __syncthreads();
    }
}

__device__ __forceinline__ void h3_phase(unsigned char* lds, const bf16_t* __restrict__ PROJ, const float* __restrict__ LBFl, const bf16_t* __restrict__ ST, const float* __restrict__ ng, bf16_t* __restrict__ MIX, int cu, int G) {
    const int tid = otid(), lane = tid & 63, r32 = lane & 31, hi = lane >> 5, w = __builtin_amdgcn_readfirstlane(tid >> 6);
    for (int u = cu; u < BATCH * NCH * 4; u += G) {
        const int h = u & 3, bc = u >> 2, b = bc / NCH, cp = bc - b * NCH, row0 = b * PB + cp * 64;
        {
            const int j = tid >> 3, ic = (tid & 7) * 8;
#pragma unroll
            for (int dir = 0; dir < 2; ++dir) { const int chain = (b * 4 + h) * 2 + dir;
                const u32x4 sv = *(const u32x4*)(ST + ((size_t)chain * NCH + cp) * 4096 + j * 64 + ic);
                *(u32x4*)((bf16_t*)(lds + O_ST + dir * MSZ) + j * P + ic) = sv; }
        }
        prep<true>(lds, PROJ, LBFl, row0, h);
        float* SSQ = (float*)(lds + O_SSQ); bf16_t* OUT = (bf16_t*)(lds + O_OUT);
        f32x16 ot = {};
        const int jb = (w >> 1) & 1, tb = w & 1;
        if (w < 4) {
            const bf16_t* VT = (const bf16_t*)(lds + O_VT) + (jb * 32 + r32) * P;
#pragma unroll
            for (int sb = 0; sb < 2; ++sb) {
                f32x16 xf = {}, xb = {};
                const bf16_t* QF = (const bf16_t*)(lds + O_QH) + (tb * 32 + r32) * P + hi * 8; const bf16_t* QB = QF + 64 * P;
                const bf16_t* KF = (const bf16_t*)(lds + O_KH) + (sb * 32 + r32) * P + hi * 8; const bf16_t* KB = KF + 64 * P;
                if (sb <= tb) {
#pragma unroll
                    for (int ks = 0; ks < 4; ++ks) xf = __builtin_amdgcn_mfma_f32_32x32x16_bf16(*(const bf16x8*)(KF + ks * 16), *(const bf16x8*)(QF + ks * 16), xf, 0, 0, 0); }
                if (sb >= tb) {
#pragma unroll
                    for (int ks = 0; ks < 4; ++ks) xb = __builtin_amdgcn_mfma_f32_32x32x16_bf16(*(const bf16x8*)(KB + ks * 16), *(const bf16x8*)(QB + ks * 16), xb, 0, 0, 0); }
                float x[16];
#pragma unroll
                for (int r = 0; r < 16; ++r) { const int s = crow(r, hi), t = r32;
                    const float vf = (sb < tb || (sb == tb && s <= t)) ? xf[r] : 0.f, vb = (sb > tb || (sb == tb && s >= t)) ? xb[r] : 0.f; x[r] = vf + vb; }
#pragma unroll
                for (int sp = 0; sp < 2; ++sp) {
                    u32x4 xw; xw.x = cvtpk(x[8 * sp + 0], x[8 * sp + 1]); xw.y = cvtpk(x[8 * sp + 2], x[8 * sp + 3]); xw.z = cvtpk(x[8 * sp + 4], x[8 * sp + 5]); xw.w = cvtpk(x[8 * sp + 6], x[8 * sp + 7]);
                    const s16x4 v0 = *(const s16x4*)(VT + sb * 32 + 16 * sp + 4 * hi), v1 = *(const s16x4*)(VT + sb * 32 + 16 * sp + 8 + 4 * hi);
                    const bf16x8 va = {v0[0], v0[1], v0[2], v0[3], v1[0], v1[1], v1[2], v1[3]};
                    ot = __builtin_amdgcn_mfma_f32_32x32x16_bf16(va, __builtin_bit_cast(bf16x8, xw), ot, 0, 0, 0); }
            }
#pragma unroll
            for (int dir = 0; dir < 2; ++dir) {
                const bf16_t* SA = (const bf16_t*)(lds + O_ST + dir * MSZ) + (jb * 32 + r32) * P + hi * 8; const bf16_t* QT = (const bf16_t*)(lds + O_QT + dir * MSZ) + (tb * 32 + r32) * P + hi * 8;
#pragma unroll
                for (int ks = 0; ks < 4; ++ks) ot = __builtin_amdgcn_mfma_f32_32x32x16_bf16(*(const bf16x8*)(SA + ks * 16), *(const bf16x8*)(QT + ks * 16), ot, 0, 0, 0); }
            float part = 0.f;
#pragma unroll
            for (int r = 0; r < 16; ++r) part += ot[r] * ot[r];
            part = xsum<32>(part);
            if (hi == 0) SSQ[jb * 64 + tb * 32 + r32] = part;
        }
        __syncthreads();
        if (w < 4) { const int t = tb * 32 + r32; const float rstd = 1.f / sqrtf((SSQ[t] + SSQ[64 + t]) * (1.f / 64.f) + EPS);
#pragma unroll
            for (int r = 0; r < 16; ++r) { const int j = jb * 32 + crow(r, hi); OUT[t * P + j] = (bf16_t)f2bf(ot[r] * rstd * ng[j]); } }
        __syncthreads();
        {
            const int t = tid >> 3, jc = (tid & 7) * 8;
            const u32x4 y = *(const u32x4*)(OUT + t * P + jc); const u32x4 g = *(const u32x4*)(PROJ + (size_t)(row0 + t) * NIN + C_AG + h * 64 + jc);
            u32x4 o; o.x = pk2(bflo(y.x) * silu(bflo(g.x)), bfhi(y.x) * silu(bfhi(g.x))); o.y = pk2(bflo(y.y) * silu(bflo(g.y)), bfhi(y.y) * silu(bfhi(g.y)));
            o.z = pk2(bflo(y.z) * silu(bflo(g.z)), bfhi(y.z) * silu(bfhi(g.z))); o.w = pk2(bflo(y.w) * silu(bflo(g.w)), bfhi(y.w) * silu(bfhi(g.w)));
            *(u32x4*)(MIX + (size_t)(row0 + t) * D + h * 64 + jc) = o;
        }
        __syncthreads();
    }
}
}
__device__ __forceinline__ int vcu_of(int bx, int G) { return (G % 8 == 0) ? (bx % 8) * (G / 8) + bx / 8 : bx; }
__device__ __forceinline__ void attn_phase(char* lds, const bf16_t* QN, const bf16_t* KN, const bf16_t* PROJ, bf16_t* MIX, float neg_ref, int vcu, int G, bool with_ctx) {
    using attn_body::bf16;
    const int upc = (512 + G - 1) / G;
    const int nun = upc + ((with_ctx && vcu < 16) ? 1 : 0);
    for (int i = 0; i < nun; ++i) {
        int b, h, nt; size_t q0;
        if (i < upc) { const int u = vcu * upc + i; if (u >= 512) continue; const int combo = u >> 7; b = combo >> 1; h = (combo & 1) * 4 + ((u >> 5) & 3); q0 = (size_t)b * PB + CTXL + (size_t)(u & 31) * 256; nt = PB / 64; }
        else { b = vcu >> 3; h = vcu & 7; q0 = (size_t)b * PB; nt = CTXL / 64; }
        const int kvh = h >> 2; const size_t k0 = (size_t)b * PB;
        attn_body::attn_unit((const bf16*)QN + q0 * 512 + h * 64, (const bf16*)KN + k0 * 128 + kvh * 64, (const bf16*)PROJ + k0 * NIN + C_CV + kvh * 64, (bf16*)MIX + q0 * 1024 + 512 + h * 64, nt, neg_ref, lds);
    }
}
namespace pg8 {
struct EpiResid {
    static constexpr bool PERM = false, AFTER_DRAIN = false;
    const float* src_lat; const float* src_ctx; float* dst_lat; float* dst_ctx; const float* modv; int ga_off; int pad;
    __device__ __forceinline__ void operator()(const f32x4 (&acc)[2][2][4][2], const Unit& u, int wr, int wc, int fr, int fq) const {
        asm volatile("" : "+v"(fr), "+v"(fq));
        const int b = u.pm / TPB, w = u.pm - b * TPB;
        const size_t base = (w == 0) ? (size_t)b * CTXL * D : ((size_t)b * SEQ + (size_t)(w - 1) * 256) * D;
        const float* s = ((w == 0) ? src_ctx : src_lat) + base; float* d = ((w == 0) ? dst_ctx : dst_lat) + base;
        const float* ga = modv + ((w == 0) ? 2 : b) * 6144 + ga_off;
        const int row0 = wr * 64 + fr, col0 = u.pn * BM + wc * 32 + 4 * fq;
        f32x4 gv[2][2];
#pragma unroll
        for (int bj = 0; bj < 2; ++bj)
#pragma unroll
            for (int n = 0; n < 2; ++n) gv[bj][n] = *(const f32x4*)(ga + col0 + bj * HALF + n * 16);
#pragma unroll
        for (int ai = 0; ai < 2; ++ai)
#pragma unroll
            for (int m = 0; m < 4; ++m) { const size_t off = (size_t)(row0 + ai * HALF + m * 16) * D + col0;
#pragma unroll
                for (int bj = 0; bj < 2; ++bj)
#pragma unroll
                    for (int n = 0; n < 2; ++n) *(f32x4*)(d + off + bj * HALF + n * 16) = *(const f32x4*)(s + off + bj * HALF + n * 16) + gv[bj][n] * acc[ai][bj][m][n]; }
    }
};
struct OutOrder : StaticOrder {
    int lat_only;
    __device__ __forceinline__ bool next(int i, Unit& u) const { if (!StaticOrder::next(i, u)) return false; if (lat_only) u.pm = (u.pm >> 5) * TPB + 1 + (u.pm & 31); return true; }
};
}


namespace pg8 {
struct MUnit { int pm, pn, nrows, lbase, e0, e1; };
__device__ __forceinline__ void build_tiles(PG8_LAS int* TT, const unsigned* cnt) {
    if (otid() == 0) { int off = 0;
        for (int bk = 0; bk < 24; ++bk) { const int c = (int)__hip_atomic_load(cnt + bk, __ATOMIC_RELAXED, __HIP_MEMORY_SCOPE_AGENT); const int nb = (c + 255) >> 8;
            for (int ti = 0; ti < nb; ++ti) { const int rem = c - ti * 256; TT[4 + 4 * off + 0] = bk; TT[4 + 4 * off + 1] = ti; TT[4 + 4 * off + 2] = rem < 256 ? rem : 256; TT[4 + 4 * off + 3] = 0; ++off; } }
        TT[0] = off; }
    __syncthreads();
}
template <int NPN  > struct MoeOrder {
    const PG8_LAS int* TT; int G, c;
    __device__ __forceinline__ bool next(int i, MUnit& u) const {
        const int L = i * G + c, tile = L / NPN; if (tile >= TT[0]) return false;
        const int bk = TT[4 + 4 * tile], ti = TT[4 + 4 * tile + 1];
        u.pm = tile; u.pn = L - tile * NPN; u.nrows = TT[4 + 4 * tile + 2]; u.lbase = bk * MT + ti * 256;
        const int g = bk / 6, pi = bk - g * 6; const int lo = pi < 3 ? 0 : (pi < 5 ? 1 : 2), hi = pi < 3 ? pi + 1 : (pi < 5 ? pi - 1 : 3);
        u.e0 = 4 * g + lo; u.e1 = 4 * g + hi; return true;
    }
};
struct Src1 {
    const bf16_t* XN; const bf16_t* WGU; const u32x4* LIST;
    __device__ __forceinline__ const char* a_base(const MUnit&) const { return (const char*)XN; }
    __device__ __forceinline__ void a_offsets(const MUnit& u, const int (&RA)[2], const int (&CA)[2], unsigned (&ao)[2][2]) const {
#pragma unroll
        for (int h = 0; h < 2; ++h)
#pragma unroll
            for (int i = 0; i < 2; ++i) { const int r = h * HALF + RA[i]; const unsigned row = r < u.nrows ? LIST[u.lbase + r].x : 0u; ao[h][i] = (row * (unsigned)D + (unsigned)CA[i]) * 2u; }
    }
    __device__ __forceinline__ const char* b_base(const MUnit& u, int seg) const { const int e = (u.pn >> 2) ? u.e1 : u.e0;
        return (const char*)(WGU + ((size_t)e * 1024 + (size_t)(u.pn & 3) * 256) * D) + (seg ? (size_t)(D / 2) * 2 : 0); }
    __device__ __forceinline__ void prefetch_rows(const MUnit& u, const int (&)[2], PG8_LAS unsigned char* rows, int wid) const {
        int t2 = otid(); asm volatile("" : "+v"(t2));
        int RA[2];
#pragma unroll
        for (int i = 0; i < 2; ++i) { int R, C; stage_rc(t2 * 16 + i * 8192, R, C); RA[i] = R; }
#pragma unroll
        for (int h = 0; h < 2; ++h)
#pragma unroll
            for (int i = 0; i < 2; ++i) { const int r = h * HALF + RA[i];
                __builtin_amdgcn_global_load_lds((const unsigned*)&LIST[u.lbase + r], (PG8_LAS unsigned*)(rows + ((h * 2 + i) * 8 + wid) * 256), 4, 0, 0); }
    }
    __device__ __forceinline__ void reload_offsets(const MUnit& u, const int (&)[2], const int (&)[2], const PG8_LAS unsigned char* rows, int wid, int lane, unsigned (&ao)[2][2]) const {
        int t2 = otid(); asm volatile("" : "+v"(t2));
        int RA[2], CA[2];
#pragma unroll
        for (int i = 0; i < 2; ++i) { int R, C; stage_rc(t2 * 16 + i * 8192, R, C); RA[i] = R; CA[i] = C; }
#pragma unroll
        for (int h = 0; h < 2; ++h)
#pragma unroll
            for (int i = 0; i < 2; ++i) { const int r = h * HALF + RA[i]; const unsigned v = *(const PG8_LAS unsigned*)(rows + ((h * 2 + i) * 8 + wid) * 256 + lane * 4);
                const unsigned row = r < u.nrows ? v : 0u; ao[h][i] = (row * (unsigned)D + (unsigned)CA[i]) * 2u; }
    }
};
struct Src2 {
    const bf16_t* ACT2; const bf16_t* WD;
    __device__ __forceinline__ const char* a_base(const MUnit& u) const { return (const char*)(ACT2 + (size_t)u.pm * 256 * 1024); }
    __device__ __forceinline__ void a_offsets(const MUnit&, const int (&RA)[2], const int (&CA)[2], unsigned (&ao)[2][2]) const {
#pragma unroll
        for (int h = 0; h < 2; ++h)
#pragma unroll
            for (int i = 0; i < 2; ++i) ao[h][i] = (unsigned)((h * HALF + RA[i]) * 1024 + CA[i]) * 2u;
    }
    __device__ __forceinline__ const char* b_base(const MUnit& u, int seg) const { const int e = seg ? u.e1 : u.e0; return (const char*)(WD + ((size_t)e * 1024 + (size_t)u.pn * 256) * DE); }
    __device__ __forceinline__ void prefetch_rows(const MUnit&, const int (&)[2], PG8_LAS unsigned char*, int) const {}
    __device__ __forceinline__ void reload_offsets(const MUnit&, const int (&)[2], const int (&)[2], const PG8_LAS unsigned char*, int, int, unsigned (&)[2][2]) const {}
};
struct EpiGateUp2 {
    static constexpr bool PERM = true;
    bf16_t* ACT2; const u32x4* LIST;
    __device__ __forceinline__ void operator()(const f32x4 (&acc)[2][2][4][2], const MUnit& u, int wr, int wc, int fr, int fq) const {
        asm volatile("" : "+v"(fr), "+v"(fq));
        const int slot = u.pn >> 2, colA = slot * DE + (u.pn & 3) * HALF + wc * 32 + 8 * fq;
        const unsigned* lw = (const unsigned*)(LIST + u.lbase + wr * 64 + fr) + 1 + slot;
#pragma unroll
        for (int ai = 0; ai < 2; ++ai) {
            unsigned wv[4];
#pragma unroll
            for (int m = 0; m < 4; ++m) wv[m] = lw[(ai * HALF + m * 16) * 4];
#pragma unroll
            for (int m = 0; m < 4; ++m) { const int r = ai * HALF + wr * 64 + m * 16 + fr;
                const bool valid = r < u.nrows; const float cw = valid ? __uint_as_float(wv[m]) : 0.f;
                const f32x4 g0 = acc[ai][0][m][0], g1 = acc[ai][0][m][1], u0 = acc[ai][1][m][0], u1 = acc[ai][1][m][1];
                u32x4 w;
                w.x = cvt_pk_bf16(silu(g0[0]) * u0[0] * cw, silu(g0[1]) * u0[1] * cw); w.y = cvt_pk_bf16(silu(g0[2]) * u0[2] * cw, silu(g0[3]) * u0[3] * cw);
                w.z = cvt_pk_bf16(silu(g1[0]) * u1[0] * cw, silu(g1[1]) * u1[1] * cw); w.w = cvt_pk_bf16(silu(g1[2]) * u1[2] * cw, silu(g1[3]) * u1[3] * cw);
                if (!valid) w = (u32x4){0u, 0u, 0u, 0u};
                *(u32x4*)(ACT2 + ((size_t)u.pm * 256 + r) * 1024 + colA) = w; }
            asm volatile("" ::: "memory"); }
    }
};
struct EpiMoeOut {
    static constexpr bool PERM = false;
    float* lat; float* ctx; const float* modv; const u32x4* LIST;
    __device__ __forceinline__ void operator()(const f32x4 (&acc)[2][2][4][2], const MUnit& u, int wr, int wc, int fr, int fq) const {
        asm volatile("" : "+v"(fr), "+v"(fq));
        const int col0 = u.pn * BM + wc * 32 + 4 * fq;
        const unsigned* lw = (const unsigned*)(LIST + u.lbase + wr * 64 + fr);
        unsigned rv[2][4];
#pragma unroll
        for (int ai = 0; ai < 2; ++ai)
#pragma unroll
            for (int m = 0; m < 4; ++m) rv[ai][m] = lw[(ai * HALF + m * 16) * 4];
#pragma unroll
        for (int ai = 0; ai < 2; ++ai)
#pragma unroll
            for (int m = 0; m < 4; ++m) { const int r = ai * HALF + wr * 64 + m * 16 + fr;
                if (r < u.nrows) { const int row = (int)rv[ai][m]; bool is_ctx; const size_t off = stream_off(row, is_ctx);
                    float* d = (is_ctx ? ctx : lat) + off + col0; const float* ga = modv + (is_ctx ? 2 : row / PB) * 6144 + 5120 + col0;
#pragma unroll
                    for (int bj = 0; bj < 2; ++bj)
#pragma unroll
                        for (int n = 0; n < 2; ++n) { f32x4* p = (f32x4*)(d + bj * HALF + n * 16); *p = *p + *(const f32x4*)(ga + bj * HALF + n * 16) * acc[ai][bj][m][n]; } } }
    }
};

template <class Epi, class Sched, class Src>
__device__ __forceinline__ void gemm_phase_x(PG8_LAS unsigned char* lds, PG8_LAS unsigned char* rows, const Sched& S, const Src& X, const Epi& E, const int KB, const int nt) {
    const int tid = otid(), wid = __builtin_amdgcn_readfirstlane(tid >> 6), lane = tid & 63, wr = wid >> 2, wc = wid & 3, fr = lane & 15, fq = lane >> 4;
    int RA[2], CA[2]; unsigned voffB[2];
#pragma unroll
    for (int i = 0; i < 2; ++i) { int R, C; stage_rc(tid * 16 + i * 8192, R, C); const int Rb = Epi::PERM ? ((R & ~31) + perm32(R & 31)) : R; RA[i] = R; CA[i] = C; voffB[i] = (unsigned)(Rb * KB + C) * 2u; }
    const size_t kstep = (size_t)(BK * 2);
    const size_t hstepB = (size_t)HALF * KB * 2;
    const int half = nt >> 1;
    const unsigned ldsw = (unsigned)wid * 1024u;
    const int aoff = lds_byte(wr * 64 + fr, fq * 8), boff = lds_byte(wc * 32 + fr, fq * 8);
#define PG8_SA(b, h) (((b) * 2 + (h)) * HTB)
#define PG8_SB(b, h) ((4 + (b) * 2 + (h)) * HTB)
#define PG8_STAGE_B(bufoff, gbase) do { _Pragma("unroll") for (int _i = 0; _i < 2; ++_i) \
        __builtin_amdgcn_global_load_lds((const unsigned*)((const char*)(gbase) + voffB[_i]), (PG8_LAS unsigned*)(lds + (bufoff) + ldsw + _i * 8192), 16, 0, 0); } while (0)
#define PG8_STAGE_A(bufoff, gbase, o0, o1) do { \
        __builtin_amdgcn_global_load_lds((const unsigned*)((const char*)(gbase) + (o0)), (PG8_LAS unsigned*)(lds + (bufoff) + ldsw), 16, 0, 0); \
        __builtin_amdgcn_global_load_lds((const unsigned*)((const char*)(gbase) + (o1)), (PG8_LAS unsigned*)(lds + (bufoff) + ldsw + 8192), 16, 0, 0); } while (0)
#define PG8_LDA(dst, b, h) do { _Pragma("unroll") for (int m = 0; m < 4; ++m) _Pragma("unroll") for (int k = 0; k < 2; ++k) dst[m][k] = *(const PG8_LAS bf16x8*)(lds + PG8_SA(b, h) + aoff + m * 2048 + k * 1024); } while (0)
#define PG8_LDB(dst, b, h) do { _Pragma("unroll") for (int n = 0; n < 2; ++n) _Pragma("unroll") for (int k = 0; k < 2; ++k) dst[n][k] = *(const PG8_LAS bf16x8*)(lds + PG8_SB(b, h) + boff + n * 2048 + k * 1024); } while (0)
#define PG8_MMA(ai, bj, At, Bt) do { __builtin_amdgcn_s_setprio(1); _Pragma("unroll") for (int m = 0; m < 4; ++m) _Pragma("unroll") for (int n = 0; n < 2; ++n) _Pragma("unroll") for (int k = 0; k < 2; ++k) \
        acc[ai][bj][m][n] = __builtin_amdgcn_mfma_f32_16x16x32_bf16(Bt[n][k], At[m][k], acc[ai][bj][m][n], 0, 0, 0); __builtin_amdgcn_s_setprio(0); } while (0)
#define PG8_WAIT_V(n) asm volatile("s_waitcnt vmcnt(" #n ")" ::: "memory")
#define PG8_WAIT_L(n) asm volatile("s_waitcnt lgkmcnt(" #n ")" ::: "memory")
#define PG8_BAR __builtin_amdgcn_s_barrier()
#define PG8_SCHED __builtin_amdgcn_sched_barrier(0)
    MUnit cur, nxt; int ui = 0;
    if (!S.next(0, cur)) return;
    f32x4 acc[2][2][4][2];
#pragma unroll
    for (int a = 0; a < 2; ++a)
#pragma unroll
        for (int b = 0; b < 2; ++b)
#pragma unroll
            for (int m = 0; m < 4; ++m)
#pragma unroll
                for (int n = 0; n < 2; ++n) acc[a][b][m][n] = (f32x4){0.f, 0.f, 0.f, 0.f};
    bf16x8 At[4][2], B0[2][2], B1[2][2];
    unsigned aoc[2][2];
    X.a_offsets(cur, RA, CA, aoc);
    const char* cAb = X.a_base(cur); const char* cB0 = X.b_base(cur, 0); const char* cB1 = X.b_base(cur, 1);
    PG8_STAGE_B(PG8_SB(0, 0), cB0); PG8_STAGE_B(PG8_SB(0, 1), cB0 + hstepB); PG8_STAGE_A(PG8_SA(0, 0), cAb, aoc[0][0], aoc[0][1]); PG8_STAGE_A(PG8_SA(0, 1), cAb, aoc[1][0], aoc[1][1]);
    if (wr == 1) PG8_BAR;
    PG8_WAIT_V(2); PG8_BAR;
    PG8_STAGE_B(PG8_SB(1, 0), cB0 + kstep); PG8_STAGE_A(PG8_SA(1, 0), cAb + kstep, aoc[0][0], aoc[0][1]); PG8_STAGE_B(PG8_SB(1, 1), cB0 + hstepB + kstep);
    PG8_WAIT_V(6); PG8_BAR;
    for (;;) {
        const bool has_next = S.next(ui + 1, nxt);
        const char* nAb = cAb; const char* nB0 = cB0; const char* nB1 = cB1;
        if (has_next) { X.prefetch_rows(nxt, RA, rows, wid); nAb = X.a_base(nxt); nB0 = X.b_base(nxt, 0); nB1 = X.b_base(nxt, 1); }
        for (int t = 0; t < nt; t += 2) {
            const bool last = (t == nt - 2);
            const char* a1 = cAb + (size_t)(t + 1) * kstep;
            const int kt2 = t + 2;
            const char* b2 = last ? nB0 : (kt2 < half ? cB0 + (size_t)kt2 * kstep : cB1 + (size_t)(kt2 - half) * kstep);
            const char* a2 = last ? nAb : cAb + (size_t)kt2 * kstep;
            const char* a3 = a2 + kstep; const char* b3 = b2 + kstep;
            PG8_LDB(B0, 0, 0); PG8_LDB(B1, 0, 1); PG8_SCHED; PG8_LDA(At, 0, 0); PG8_STAGE_A(PG8_SA(1, 1), a1, aoc[1][0], aoc[1][1]);
            if (last && has_next) X.reload_offsets(nxt, RA, CA, rows, wid, lane, aoc);
            PG8_WAIT_V(8); PG8_WAIT_L(0); PG8_BAR; PG8_MMA(0, 0, At, B0); PG8_MMA(0, 1, At, B1); PG8_BAR; PG8_SCHED;
            PG8_LDA(At, 0, 1); PG8_STAGE_B(PG8_SB(0, 0), b2); PG8_STAGE_B(PG8_SB(0, 1), b2 + hstepB); PG8_STAGE_A(PG8_SA(0, 0), a2, aoc[0][0], aoc[0][1]);
            PG8_WAIT_V(8); PG8_WAIT_L(0); PG8_BAR; PG8_MMA(1, 0, At, B0); PG8_MMA(1, 1, At, B1); PG8_BAR; PG8_SCHED;
            PG8_LDB(B0, 1, 0); PG8_LDB(B1, 1, 1); PG8_SCHED; PG8_LDA(At, 1, 0); PG8_STAGE_A(PG8_SA(0, 1), a2, aoc[1][0], aoc[1][1]);
            PG8_WAIT_V(8); PG8_WAIT_L(0); PG8_BAR; PG8_MMA(0, 0, At, B0); PG8_MMA(0, 1, At, B1); PG8_BAR; PG8_SCHED;
            PG8_LDA(At, 1, 1); PG8_STAGE_B(PG8_SB(1, 0), b3); PG8_STAGE_B(PG8_SB(1, 1), b3 + hstepB); PG8_STAGE_A(PG8_SA(1, 0), a3, aoc[0][0], aoc[0][1]);
            PG8_WAIT_V(8); PG8_WAIT_L(0); PG8_BAR; PG8_MMA(1, 0, At, B0); PG8_MMA(1, 1, At, B1); PG8_BAR; PG8_SCHED;
        }
        if (wr == 0) PG8_BAR;
        E(acc, cur, wr, wc, fr, fq);
        if (!has_next) break;
#pragma unroll
        for (int a = 0; a < 2; ++a)
#pragma unroll
            for (int b = 0; b < 2; ++b)
#pragma unroll
                for (int m = 0; m < 4; ++m)
#pragma unroll
                    for (int n = 0; n < 2; ++n) acc[a][b][m][n] = (f32x4){0.f, 0.f, 0.f, 0.f};
        cur = nxt; cAb = nAb; cB0 = nB0; cB1 = nB1; ++ui;
        if (wr == 1) PG8_BAR;
    }
    PG8_WAIT_V(0);
    PG8_BAR;
#undef PG8_SA
#undef PG8_SB
#undef PG8_STAGE_A
#undef PG8_STAGE_B
#undef PG8_LDA
#undef PG8_LDB
#undef PG8_MMA
#undef PG8_WAIT_V
#undef PG8_WAIT_L
#undef PG8_BAR
#undef PG8_SCHED
}
}

constexpr int TT_OFF = 132096;
constexpr int ROWS_OFF = 134144;

#define XB_TMO      128
#define XB_XCNT(j)  (256  + 64 * (j))
#define XB_XSUB(j)  (1280 + 64 * (j))
#define XB_XGEN(j)  (2304 + 64 * (j))
#define XB_TOP      3328
#define XB_TOPGEN   3392
#define XCD_BAR_WORDS 3456
#define XB_SPIN_CAP (1u << 18)

__device__ __forceinline__ unsigned xb_ld(unsigned* p)              { return __hip_atomic_load(p, __ATOMIC_RELAXED, __HIP_MEMORY_SCOPE_AGENT); }
__device__ __forceinline__ unsigned xb_add(unsigned* p, unsigned v) { return __hip_atomic_fetch_add(p, v, __ATOMIC_RELAXED, __HIP_MEMORY_SCOPE_AGENT); }
__device__ __forceinline__ unsigned xb_xcc_id() { return (unsigned)__builtin_amdgcn_s_getreg((3 << 11) | 20) & 0xFu; }
#define XB_SPIN(cond, bar) do { unsigned _sp = 0; while (cond) { __builtin_amdgcn_s_sleep(1); \
    if ((++_sp & 255u) == 0u) { if (xb_ld(&(bar)[XB_TMO])) break; if (_sp > XB_SPIN_CAP) { atomicAdd(&(bar)[XB_TMO], 1u); break; } } } } while (0)

struct XcdBarrier {
    unsigned* bar; unsigned x;
    volatile LAS unsigned* st;
};

__device__ __forceinline__ XcdBarrier xcd_barrier_post(unsigned* bar, volatile LAS unsigned* st) {
    XcdBarrier b; b.bar = bar; b.x = xb_xcc_id(); b.st = st;
    if (threadIdx.x == 0) (void)xb_add(&bar[XB_XCNT(b.x)], 1u);
    return b;
}
__device__ __forceinline__ void xcd_barrier_complete(unsigned* bar, unsigned x, unsigned& nloc, unsigned& nx) {
    const unsigned G = gridDim.x * gridDim.y * gridDim.z;
    unsigned sum, cnt, mine, sp = 0u;
    for (;;) {
        sum = 0u; cnt = 0u; mine = 0u;
#pragma unroll
        for (unsigned j = 0; j < 16; ++j) { const unsigned c = xb_ld(&bar[XB_XCNT(j)]); sum += c; cnt += (c > 0u) ? 1u : 0u; mine = (j == x) ? c : mine; }
        if (sum == G) break;
        __builtin_amdgcn_s_sleep(1);
        if ((++sp & 255u) == 0u) { if (xb_ld(&bar[XB_TMO])) break; if (sp > XB_SPIN_CAP) { atomicAdd(&bar[XB_TMO], 1u); break; } }
    }
    nloc = mine > 0u ? mine : 1u; nx = cnt > 0u ? cnt : 1u;
}

__device__ __forceinline__ void xcd_barrier(const XcdBarrier& b) {
    asm volatile("s_waitcnt vmcnt(0)" ::: "memory");
    __syncthreads();
    if (threadIdx.x == 0) {
        unsigned* bar = b.bar;
        __builtin_amdgcn_s_waitcnt(0);
        unsigned nloc = b.st[0], nx = b.st[1];
        if (nloc == 0u) { xcd_barrier_complete(bar, b.x, nloc, nx); b.st[0] = nloc; b.st[1] = nx; }
        const unsigned old = xb_add(&bar[XB_XSUB(b.x)], 1u);
        const unsigned gen = old / nloc;
        if (old + 1u == (gen + 1u) * nloc) {
            __builtin_amdgcn_fence(__ATOMIC_RELEASE, "agent");
            asm volatile("s_waitcnt vmcnt(0)" ::: "memory");
            const unsigned og = xb_add(&bar[XB_TOP], 1u);
            const unsigned tg = og / nx;
            if (og + 1u == (tg + 1u) * nx) xb_add(&bar[XB_TOPGEN], 1u);
            else XB_SPIN(xb_ld(&bar[XB_TOPGEN]) == tg, bar);
            __builtin_amdgcn_fence(__ATOMIC_ACQUIRE, "agent");
            xb_add(&bar[XB_XGEN(b.x)], 1u);
            asm volatile("s_waitcnt vmcnt(0)" ::: "memory");
        } else {
            XB_SPIN(xb_ld(&bar[XB_XGEN(b.x)]) == gen, bar);
            __builtin_amdgcn_fence(__ATOMIC_ACQUIRE, "agent");
            asm volatile("s_waitcnt vmcnt(0)" ::: "memory");
        }
    }
    __syncthreads();
}

constexpr int LDS_BYTES = 147456;
constexpr int LDSCTL_OFF = 131072, MISC_OFF = LDSCTL_OFF + 320;
constexpr int CW_BAR = 4096;
constexpr int NPHASE = 1 + 9 * DEPTH;
#ifndef MK_SPLIT
#define MK_SPLIT 0
#endif
struct Args {
    const float *x, *c, *ctx, *c_ctx, *w_mod, *b_mod, *norm1_g, *norm2_g, *w_in, *w_out, *hgrn_lb, *hgrn_norm_g, *pool_w, *pool_scale, *q_norm_g, *k_norm_g, *router_w, *router_b, *moe_gate, *moe_up, *moe_down;
    float* out; unsigned char* ws; int ph_lo, ph_hi;
};
typedef const __attribute__((address_space(4))) Args* KArgs;
__device__ __forceinline__ KArgs kargs() { KArgs p = (KArgs)__builtin_amdgcn_kernarg_segment_ptr(); asm volatile("" : "+s"(p)); return p; }
__global__ void __launch_bounds__(512, 2) mega_fwd(Args A_unused) {
    extern __shared__ __attribute__((aligned(16))) unsigned char lds[];
    for (int u = otid(); u < (LDS_BYTES - LDSCTL_OFF) / 4; u += 512) ((LAS unsigned*)((LAS unsigned char*)lds + LDSCTL_OFF))[u] = 0u;
    __syncthreads();
    XcdBarrier bar;
    { KArgs ap = kargs(); unsigned* CTL = (unsigned*)(ap->ws + WS_CTL); bar.bar = CTL + CW_BAR; bar.x = 0; bar.st = nullptr;
      if (!MK_SPLIT) bar = xcd_barrier_post(CTL + CW_BAR, (volatile LAS unsigned*)((LAS unsigned char*)lds + MISC_OFF) + 8); }
    int lo, hi; { KArgs ap = kargs(); lo = ap->ph_lo; hi = ap->ph_hi; }
#ifndef PHMASK
#define PHMASK 0x3ff
#endif
#define IN(k) (lo <= (k) && (k) < hi)
#define SEAM(k) do { if (!MK_SPLIT && IN((k) + 1)) xcd_barrier(bar); } while (0)
#define GCU const int G = (int)gridDim.x, cu = (int)blockIdx.x
#ifndef DUPMASK
#define DUPMASK 0
#endif
    LAS unsigned char* ldsl = (LAS unsigned char*)lds;
    if ((PHMASK & 0x200) && IN(0)) {
        _Pragma("unroll") for (int rep_ = 0; rep_ < ((((DUPMASK) & (0x200)) && true) ? 2 : 1); ++rep_) {
        KArgs ap = kargs(); unsigned char* ws = ap->ws; GCU;
        ProArgs pa; pa.c = ap->c; pa.c_ctx = ap->c_ctx; pa.w_mod = ap->w_mod; pa.b_mod = ap->b_mod; pa.hgrn_lb = ap->hgrn_lb; pa.qg = ap->q_norm_g; pa.kg = ap->k_norm_g; pa.w_in = ap->w_in; pa.w_out = ap->w_out; pa.pool_w = ap->pool_w;
        pa.gate = ap->moe_gate; pa.up = ap->moe_up; pa.down = ap->moe_down; pa.MODV = (float*)(ws + WS_MODV); pa.LBF = (float*)(ws + WS_LBF); pa.REF = (float*)(ws + WS_REF); pa.COS = (float*)(ws + WS_COS); pa.SIN = (float*)(ws + WS_SIN);
        pa.WIN = (bf16_t*)(ws + WS_WIN); pa.WOUT = (bf16_t*)(ws + WS_WOUT); pa.POOLWT = (bf16_t*)(ws + WS_POOLWT); pa.WGU = (bf16_t*)(ws + WS_WGU); pa.WD = (bf16_t*)(ws + WS_WD);
        prologue_phase(lds, pa, cu, G);
            if (rep_ + 1 < ((((DUPMASK) & (0x200)) && true) ? 2 : 1)) xcd_barrier(bar); }
        SEAM(0);
    }
    for (int l = 0; l < DEPTH; ++l) {
        const int pb = 1 + 9 * l;
        if ((PHMASK & 1) && IN(pb + 0)) {
        _Pragma("unroll") for (int rep_ = 0; rep_ < ((((DUPMASK) & (1)) && true) ? 2 : 1); ++rep_) {
            KArgs ap = kargs(); unsigned char* ws = ap->ws; GCU;
            const float* slat = (l == 0) ? ap->x : ap->out; const float* sctx = (l == 0) ? ap->ctx : (const float*)(ws + WS_XC);
            norm1_phase(cu, G, slat, sctx, ap->norm1_g + l * D, (const float*)(ws + WS_MODV) + (size_t)l * 3 * 6144, 0, (bf16_t*)(ws + WS_XN));
            if (rep_ + 1 < ((((DUPMASK) & (1)) && true) ? 2 : 1)) xcd_barrier(bar); }
            SEAM(pb + 0);
        }
        if ((PHMASK & 2) && IN(pb + 1)) {
        _Pragma("unroll") for (int rep_ = 0; rep_ < ((((DUPMASK) & (2)) && true) ? 2 : 1); ++rep_) {
            KArgs ap = kargs(); unsigned char* ws = ap->ws; GCU;
            pg8::Gemm g; g.A = (const bf16_t*)(ws + WS_XN); g.Bt = (const bf16_t*)(ws + WS_WIN) + (size_t)l * NIN * D; g.M = MT; g.N = NIN; g.K = D; g.pad = 0;
            pg8::StaticOrder S; S.init(MT, NIN, G, cu);
            pg8::EpiBf16<0> E; E.O = (bf16_t*)(ws + WS_PROJ); E.ldc = NIN; E.bias = nullptr; E.split_cols = 0; E.split_stride = 0; E.scale0 = 1.f;
            pg8::gemm_phase<pg8::EpiBf16<0>, pg8::StaticOrder, true, true>(ldsl, g, S, E);
            { KArgs aq = kargs(); if (l == 0) moe_filler(lds, aq->moe_gate, aq->moe_up, aq->moe_down, aq->ws, 0, 0, 5530, (MT / 256) * (NIN / 256), G, cu);
              else moe_filler(lds, aq->moe_gate, aq->moe_up, aq->moe_down, aq->ws, 1, 7986, MOE_ITEMS, (MT / 256) * (NIN / 256), G, cu); }
            if (rep_ + 1 < ((((DUPMASK) & (2)) && true) ? 2 : 1)) xcd_barrier(bar); }
            SEAM(pb + 1);
        }
        if ((PHMASK & 4) && IN(pb + 2)) {
        _Pragma("unroll") for (int rep_ = 0; rep_ < ((((DUPMASK) & (4)) && true) ? 2 : 1); ++rep_) {
            KArgs ap = kargs(); unsigned char* ws = ap->ws; GCU;
            const bf16_t* PROJ = (const bf16_t*)(ws + WS_PROJ);
            post_phase(cu, G, PROJ, ap->q_norm_g + l * 64, ap->k_norm_g + l * 64, (const float*)(ws + WS_COS), (const float*)(ws + WS_SIN), (bf16_t*)(ws + WS_QN), (bf16_t*)(ws + WS_KN));
            pool::pool_phase(lds, PROJ, (const bf16_t*)(ws + WS_POOLWT) + (size_t)l * 4 * 4096, ap->pool_scale + l * 256, (bf16_t*)(ws + WS_MIX), cu, G);
            hg::h1_phase(lds, PROJ, (const float*)(ws + WS_LBF) + l * 512, (bf16_t*)(ws + WS_UT), (float*)(ws + WS_DEC), cu, G);
            if (rep_ + 1 < ((((DUPMASK) & (4)) && true) ? 2 : 1)) xcd_barrier(bar); }
            SEAM(pb + 2);
        }
        if ((PHMASK & 8) && IN(pb + 3)) {
        _Pragma("unroll") for (int rep_ = 0; rep_ < ((((DUPMASK) & (8)) && true) ? 2 : 1); ++rep_) {
            KArgs ap = kargs(); unsigned char* ws = ap->ws; GCU; hg::h2_phase(lds, (const bf16_t*)(ws + WS_UT), (const float*)(ws + WS_DEC), (bf16_t*)(ws + WS_ST), cu, G);
            if (rep_ + 1 < ((((DUPMASK) & (8)) && true) ? 2 : 1)) xcd_barrier(bar); }
            SEAM(pb + 3);
        }
        if ((PHMASK & 16) && IN(pb + 4)) {
        _Pragma("unroll") for (int rep_ = 0; rep_ < ((((DUPMASK) & (16)) && true) ? 2 : 1); ++rep_) {
            { KArgs ap = kargs(); unsigned char* ws = ap->ws; GCU;
              attn_phase((char*)lds, (const bf16_t*)(ws + WS_QN), (const bf16_t*)(ws + WS_KN), (const bf16_t*)(ws + WS_PROJ), (bf16_t*)(ws + WS_MIX), ((const float*)(ws + WS_REF))[l * 64], vcu_of(cu, G), G, true); }
            { KArgs ap = kargs(); unsigned char* ws = ap->ws; GCU;
              hg::h3_phase(lds, (const bf16_t*)(ws + WS_PROJ), (const float*)(ws + WS_LBF) + l * 512, (const bf16_t*)(ws + WS_ST), ap->hgrn_norm_g + l * 64, (bf16_t*)(ws + WS_MIX), cu, G); }
            if (rep_ + 1 < ((((DUPMASK) & (16)) && true) ? 2 : 1)) xcd_barrier(bar); }
            SEAM(pb + 4);
        }
        if ((PHMASK & 32) && IN(pb + 5)) {
        _Pragma("unroll") for (int rep_ = 0; rep_ < ((((DUPMASK) & (32)) && (l == 0)) ? 2 : 1); ++rep_) {
            KArgs ap = kargs(); unsigned char* ws = ap->ws; GCU;
            pg8::Gemm g; g.A = (const bf16_t*)(ws + WS_MIX); g.Bt = (const bf16_t*)(ws + WS_WOUT) + (size_t)l * D * D; g.M = MT; g.N = D; g.K = D; g.pad = 0;
            pg8::OutOrder S; S.lat_only = (l == DEPTH - 1); S.init(S.lat_only ? BATCH * SEQ : MT, D, G, cu);
            pg8::EpiResid E; E.src_lat = (l == 0) ? ap->x : ap->out; E.src_ctx = (l == 0) ? ap->ctx : (const float*)(ws + WS_XC); E.dst_lat = ap->out; E.dst_ctx = (float*)(ws + WS_XC);
            E.modv = (const float*)(ws + WS_MODV) + (size_t)l * 3 * 6144; E.ga_off = 2048; E.pad = 0;
            pg8::gemm_phase<pg8::EpiResid, pg8::OutOrder, true, true>(ldsl, g, S, E);
            if (l == 0) { KArgs aq = kargs(); moe_filler(lds, aq->moe_gate, aq->moe_up, aq->moe_down, aq->ws, 0, 5530, MOE_ITEMS, (MT / 256) * (D / 256), G, cu); }
            if (rep_ + 1 < ((((DUPMASK) & (32)) && (l == 0)) ? 2 : 1)) xcd_barrier(bar); }
            SEAM(pb + 5);
        }
        if ((PHMASK & 64) && IN(pb + 6)) {
        _Pragma("unroll") for (int rep_ = 0; rep_ < ((((DUPMASK) & (64)) && true) ? 2 : 1); ++rep_) {
            KArgs ap = kargs(); unsigned char* ws = ap->ws; GCU;
            norm2_router_phase(lds, cu, G, ap->out, (const float*)(ws + WS_XC), ap->norm2_g + l * D, (const float*)(ws + WS_MODV) + (size_t)l * 3 * 6144, 3072, ap->router_w, ap->router_b, (bf16_t*)(ws + WS_XN),
                               (unsigned*)(ws + WS_CTL) + CW_CNT + 64 * l + 32 * rep_, (u32x4*)(ws + WS_LIST), l == 0 ? 1 : 0);
            if (rep_ + 1 < ((((DUPMASK) & (64)) && true) ? 2 : 1)) xcd_barrier(bar); }
            SEAM(pb + 6);
        }
        if ((PHMASK & 128) && IN(pb + 7)) {
        _Pragma("unroll") for (int rep_ = 0; rep_ < ((((DUPMASK) & (128)) && true) ? 2 : 1); ++rep_) {
            KArgs ap = kargs(); unsigned char* ws = ap->ws; GCU;
            LAS int* TT = (LAS int*)(ldsl + TT_OFF);
            pg8::build_tiles(TT, (const unsigned*)(ws + WS_CTL) + CW_CNT + 64 * l);
            pg8::MoeOrder<8> S; S.TT = TT; S.G = G; S.c = vcu_of(cu, G);
            pg8::Src1 X; X.XN = (const bf16_t*)(ws + WS_XN); X.WGU = (const bf16_t*)(ws + (l ? WS_WGU1 : WS_WGU)); X.LIST = (const u32x4*)(ws + WS_LIST); pg8::EpiGateUp2 E; E.ACT2 = (bf16_t*)(ws + WS_ACT2); E.LIST = X.LIST;
            pg8::gemm_phase_x(ldsl, ldsl + ROWS_OFF, S, X, E, D, D / 64);
            if (l == 0) { KArgs aq = kargs(); const int U = TT[0] * 8; moe_filler(lds, aq->moe_gate, aq->moe_up, aq->moe_down, aq->ws, 1, 0, 3686, U, G, vcu_of(cu, G)); }
            if (rep_ + 1 < ((((DUPMASK) & (128)) && true) ? 2 : 1)) xcd_barrier(bar); }
            SEAM(pb + 7);
        }
        if ((PHMASK & 256) && IN(pb + 8)) {
        _Pragma("unroll") for (int rep_ = 0; rep_ < ((((DUPMASK) & (256)) && true) ? 2 : 1); ++rep_) {
            KArgs ap = kargs(); unsigned char* ws = ap->ws; GCU;
            LAS int* TT = (LAS int*)(ldsl + TT_OFF);
            pg8::build_tiles(TT, (const unsigned*)(ws + WS_CTL) + CW_CNT + 64 * l);
            pg8::MoeOrder<4> S; S.TT = TT; S.G = G; S.c = vcu_of(cu, G);
            pg8::Src2 X; X.ACT2 = (const bf16_t*)(ws + WS_ACT2); X.WD = (const bf16_t*)(ws + (l ? WS_WD1 : WS_WD));
            pg8::EpiMoeOut E; E.lat = ap->out; E.ctx = (float*)(ws + WS_XC); E.modv = (const float*)(ws + WS_MODV) + (size_t)l * 3 * 6144; E.LIST = (const u32x4*)(ws + WS_LIST);
            pg8::gemm_phase_x(ldsl, ldsl + ROWS_OFF, S, X, E, DE, 1024 / 64);
            if (l == 0) { KArgs aq = kargs(); const int U = TT[0] * 4; moe_filler(lds, aq->moe_gate, aq->moe_up, aq->moe_down, aq->ws, 1, 3686, 7986, U, G, vcu_of(cu, G)); }
            if (rep_ + 1 < ((((DUPMASK) & (256)) && true) ? 2 : 1)) xcd_barrier(bar); }
            SEAM(pb + 8);
        }
    }
#undef IN
#undef SEAM
#undef GCU
}

extern "C" void kernel_launch(void* const* d_in, const int* in_sizes, int n_in, void* d_out, int out_size, void* d_ws, size_t ws_size, hipStream_t stream) {
    static int grid = 0;
    if (grid == 0) {
        if (n_in != 21 || in_sizes[0] != BATCH * SEQ * D || out_size != BATCH * SEQ * D || ws_size < WS_END) {
            fprintf(stderr, "kernel_launch: unexpected sizes: n_in %d in0 %d out %d ws %zu (need %zu)\n", n_in, n_in > 0 ? in_sizes[0] : -1, out_size, ws_size, (size_t)WS_END); grid = -1; return; }
        int dev = 0, cus = 0, per_cu = 0;
        if (hipGetDevice(&dev) != hipSuccess || hipDeviceGetAttribute(&cus, hipDeviceAttributeMultiprocessorCount, dev) != hipSuccess) { grid = -1; return; }
        if (hipFuncSetAttribute((const void*)mega_fwd, hipFuncAttributeMaxDynamicSharedMemorySize, LDS_BYTES) != hipSuccess) { fprintf(stderr, "kernel_launch: hipFuncSetAttribute failed\n"); grid = -1; return; }
        if (hipOccupancyMaxActiveBlocksPerMultiprocessor(&per_cu, (const void*)mega_fwd, 512, LDS_BYTES) != hipSuccess || per_cu < 1) fprintf(stderr, "kernel_launch: occupancy query reports %d\n", per_cu);
        (void)hipGetLastError();
        grid = cus;
    }
    if (grid < 0) return;
    if (hipMemsetAsync((char*)d_ws + WS_CTL, 0, 1 * MiB, stream) != hipSuccess) return;
    Args a; memset((void*)&a, 0, sizeof(a));
    a.x = (const float*)d_in[0]; a.c = (const float*)d_in[1]; a.ctx = (const float*)d_in[2]; a.c_ctx = (const float*)d_in[3]; a.w_mod = (const float*)d_in[4]; a.b_mod = (const float*)d_in[5];
    a.norm1_g = (const float*)d_in[6]; a.norm2_g = (const float*)d_in[7]; a.w_in = (const float*)d_in[8]; a.w_out = (const float*)d_in[9]; a.hgrn_lb = (const float*)d_in[10]; a.hgrn_norm_g = (const float*)d_in[11];
    a.pool_w = (const float*)d_in[12]; a.pool_scale = (const float*)d_in[13]; a.q_norm_g = (const float*)d_in[14]; a.k_norm_g = (const float*)d_in[15]; a.router_w = (const float*)d_in[16]; a.router_b = (const float*)d_in[17];
    a.moe_gate = (const float*)d_in[18]; a.moe_up = (const float*)d_in[19]; a.moe_down = (const float*)d_in[20];
    a.out = (float*)d_out; a.ws = (unsigned char*)d_ws;
#if MK_SPLIT
    for (int ph = 0; ph < NPHASE; ++ph) { a.ph_lo = ph; a.ph_hi = ph + 1; hipLaunchKernelGGL(mega_fwd, dim3(grid), dim3(512), LDS_BYTES, stream, a); }
#else
    a.ph_lo = 0; a.ph_hi = NPHASE; hipLaunchKernelGGL(mega_fwd, dim3(grid), dim3(512), LDS_BYTES, stream, a);
#endif
}
```

```cpp
#include <hip/hip_runtime.h>
#include <cstdio>
#include <cstdint>
#include <cstring>

namespace cfg {
constexpr int D = 1024, BATCH = 2, SEQ = 8192, CTXL = 256, DEPTH = 2;
constexpr int PB = SEQ + CTXL;
constexpr int MT = BATCH * PB;
constexpr int TPB = PB / 256;
constexpr int NIN = 2304;
constexpr int NE = 16, DE = 512;
constexpr int C_AQ = 0, C_AFF = 256, C_AFB = 512, C_AI = 768, C_AG = 1024, C_BP = 1280, C_CQ = 1536, C_CK = 2048, C_CV = 2176;
constexpr float EPS = 1e-6f;
constexpr float C2 = 0.125f * 1.4426950408889634f;
}

__device__ __forceinline__ int otid() { int t = threadIdx.x; asm volatile("" : "+v"(t)); return t; }

namespace pg8 {
#define PG8_LAS __attribute__((address_space(3)))
typedef unsigned short bf16_t;
typedef short bf16x8 __attribute__((ext_vector_type(8)));
typedef float f32x4 __attribute__((ext_vector_type(4)));
typedef unsigned u32x4 __attribute__((ext_vector_type(4)));
constexpr int BM = 256, BK = 64, HALF = 128, HTB = HALF * BK * 2  , STAGE_BYTES = 8 * HTB, NXCD = 8, WGM = 8;

__host__ __device__ __forceinline__ int lds_byte(int r, int c) { const int st = (r >> 4) * 2 + (c >> 5), rr = r & 15, cc = c & 31, ob = rr * 64 + cc * 2; return st * 1024 + (ob ^ (((ob >> 9) & 1) << 5)); }
__host__ __device__ __forceinline__ void stage_rc(int b, int& R, int& C) { const int st = b / 1024, sb = b % 1024, swz = sb ^ (((sb >> 9) & 1) << 5); R = (st >> 1) * 16 + swz / 64; C = (st & 1) * 32 + (swz % 64) / 2; }
__host__ __device__ __forceinline__ int perm32(int rho) { const int n = rho >> 4, i = rho & 15; return 8 * (i >> 2) + 4 * n + (i & 3); }

struct Unit { int pm, pn; };
struct Gemm { const bf16_t* A; const bf16_t* Bt; int M, N, K, pad; };

struct StaticOrder {
    int nM, nN, nwg, G, c;
    __host__ __device__ void init(int M, int N, int G_, int c_) { nM = M / BM; nN = N / BM; nwg = nM * nN; G = G_; c = c_; }
    __host__ __device__ bool next(int i, Unit& u) const {
        const long L = (long)i * G + c; if (L >= nwg) return false;
        int wgid = (int)L; { const int q = nwg / NXCD, r = nwg % NXCD, xcd = wgid % NXCD, off = wgid / NXCD; wgid = (xcd < r ? xcd * (q + 1) : r * (q + 1) + (xcd - r) * q) + off; }
        const int nig = WGM * nN, gid = wgid / nig, fm = gid * WGM, gsz = (nM - fm) < WGM ? (nM - fm) : WGM;
        u.pm = fm + ((wgid % nig) % gsz); u.pn = (wgid % nig) / gsz; return true;
    }
    __device__ __forceinline__ void a_ready(const Unit&) const {}
    __device__ __forceinline__ void done(const Unit&) const {}
};

__device__ __forceinline__ unsigned cvt_pk_bf16(float lo, float hi) { unsigned r; asm volatile("v_cvt_pk_bf16_f32 %0, %1, %2" : "=v"(r) : "v"(lo), "v"(hi)); return r; }
typedef float f32x2 __attribute__((ext_vector_type(2)));
__device__ __forceinline__ f32x2 gelu_pk(f32x2 v) {
    const f32x2 av = __builtin_elementwise_abs(v), d = av * 0.2316418882f + 1.0f;
    f32x2 t; t.x = __builtin_amdgcn_rcpf(d.x); t.y = __builtin_amdgcn_rcpf(d.y);
    f32x2 q = t * 0.5307027145f + (-0.7265760135f); q = q * t + 0.7107068705f; q = q * t + (-0.142248368f); q = q * t + 0.127414796f; q = q * t;
    const f32x2 s = (v * v) * (-0.72134752044f);
    f32x2 e; e.x = __builtin_amdgcn_exp2f(s.x); e.y = __builtin_amdgcn_exp2f(s.y);
    const f32x2 m = v * (q * e), r = v - m;
    f32x2 o; o.x = v.x < 0.f ? m.x : r.x; o.y = v.y < 0.f ? m.y : r.y; return o;
}

template <int ACT  > struct EpiBf16 {
    static constexpr bool PERM = true, AFTER_DRAIN = false; static_assert(ACT == 0 || ACT == 1, "EpiBf16: ACT is 0 (none) or 1 (gelu_pk)");
    bf16_t* O; int ldc; const float* bias; int split_cols; size_t split_stride; float scale0;
    __device__ __forceinline__ void operator()(const f32x4 (&acc)[2][2][4][2], const Unit& u, int wr, int wc, int fr, int fq) const {
        asm volatile("" : "+v"(fr), "+v"(fq));
        const int row0 = u.pm * BM + wr * 64 + fr; int colt = u.pn * BM; bf16_t* base = O;
        float sc = 1.f; if (split_cols) { const int t = colt / split_cols; base += (size_t)t * split_stride; colt -= t * split_cols; if (t == 0) sc = scale0; }
        const int col0 = colt + wc * 32 + 8 * fq, bcol0 = u.pn * BM + wc * 32 + 8 * fq;
        f32x4 bv[2][2];
#pragma unroll
        for (int bj = 0; bj < 2; ++bj)
#pragma unroll
            for (int n = 0; n < 2; ++n) bv[bj][n] = bias ? *(const f32x4*)(bias + bcol0 + bj * HALF + 4 * n) : (f32x4){0.f, 0.f, 0.f, 0.f};
#pragma unroll
        for (int ai = 0; ai < 2; ++ai)
#pragma unroll
            for (int m = 0; m < 4; ++m) { bf16_t* rowp = base + (size_t)(row0 + ai * HALF + m * 16) * ldc + col0;
#pragma unroll
                for (int bj = 0; bj < 2; ++bj) { f32x4 v0 = acc[ai][bj][m][0] + bv[bj][0], v1 = acc[ai][bj][m][1] + bv[bj][1];
                    if (ACT == 1) { f32x2 a = gelu_pk((f32x2){v0[0], v0[1]}), b = gelu_pk((f32x2){v0[2], v0[3]}), c = gelu_pk((f32x2){v1[0], v1[1]}), d = gelu_pk((f32x2){v1[2], v1[3]});
                        v0 = (f32x4){a.x, a.y, b.x, b.y}; v1 = (f32x4){c.x, c.y, d.x, d.y}; }
                    v0 = v0 * sc; v1 = v1 * sc; u32x4 w; w.x = cvt_pk_bf16(v0[0], v0[1]); w.y = cvt_pk_bf16(v0[2], v0[3]); w.z = cvt_pk_bf16(v1[0], v1[1]); w.w = cvt_pk_bf16(v1[2], v1[3]);
                    *(u32x4*)(rowp + bj * HALF) = w; } }
    }
};

template <class Epi, class Sched, bool ALIGN_EPI = false, bool SP2 = false>
__device__ __forceinline__ void gemm_phase(PG8_LAS unsigned char* lds, const Gemm g, const Sched& S, const Epi& E) {
    const int tid = otid(), wid = __builtin_amdgcn_readfirstlane(tid >> 6), lane = tid & 63, wr = wid >> 2, wc = wid & 3, fr = lane & 15, fq = lane >> 4;
    const int K = g.K, nt = K / BK;
    unsigned voffA[2], voffB[2];
#pragma unroll
    for (int i = 0; i < 2; ++i) { int R, C; stage_rc(tid * 16 + i * 8192, R, C); const int Rb = Epi::PERM ? ((R & ~31) + perm32(R & 31)) : R;
        voffA[i] = (unsigned)(R * K + C) * 2u; voffB[i] = (unsigned)(Rb * K + C) * 2u; }
    const size_t kstep = (size_t)(BK * 2);
    const size_t hstep = (size_t)HALF * K * 2;
    const size_t tstep = 2 * hstep;
    const unsigned ldsw = (unsigned)wid * 1024u;
    const int aoff = lds_byte(wr * 64 + fr, fq * 8), boff = lds_byte(wc * 32 + fr, fq * 8);
#define PG8_SA(b, h) (((b) * 2 + (h)) * HTB)
#define PG8_SB(b, h) ((4 + (b) * 2 + (h)) * HTB)
#define PG8_STAGE(bufoff, gbase, voff) do { _Pragma("unroll") for (int _i = 0; _i < 2; ++_i) \
        __builtin_amdgcn_global_load_lds((const unsigned*)((const char*)(gbase) + (voff)[_i]), (PG8_LAS unsigned*)(lds + (bufoff) + ldsw + _i * 8192), 16, 0, 0); } while (0)
#define PG8_LDA(dst, b, h) do { _Pragma("unroll") for (int m = 0; m < 4; ++m) _Pragma("unroll") for (int k = 0; k < 2; ++k) dst[m][k] = *(const PG8_LAS bf16x8*)(lds + PG8_SA(b, h) + aoff + m * 2048 + k * 1024); } while (0)
#define PG8_LDB(dst, b, h) do { _Pragma("unroll") for (int n = 0; n < 2; ++n) _Pragma("unroll") for (int k = 0; k < 2; ++k) dst[n][k] = *(const PG8_LAS bf16x8*)(lds + PG8_SB(b, h) + boff + n * 2048 + k * 1024); } while (0)
#define PG8_MMA(ai, bj, At, Bt) do { __builtin_amdgcn_s_setprio(1); _Pragma("unroll") for (int m = 0; m < 4; ++m) _Pragma("unroll") for (int n = 0; n < 2; ++n) _Pragma("unroll") for (int k = 0; k < 2; ++k) \
        acc[ai][bj][m][n] = __builtin_amdgcn_mfma_f32_16x16x32_bf16(Bt[n][k], At[m][k], acc[ai][bj][m][n], 0, 0, 0); __builtin_amdgcn_s_setprio(0); } while (0)
#define PG8_WAIT_V(n) asm volatile("s_waitcnt vmcnt(" #n ")" ::: "memory")
#define PG8_WAIT_L(n) asm volatile("s_waitcnt lgkmcnt(" #n ")" ::: "memory")
#define PG8_BAR __builtin_amdgcn_s_barrier()
#define PG8_SCHED __builtin_amdgcn_sched_barrier(0)
    Unit cur, nxt; int ui = 0;
    if (!S.next(0, cur)) return;
    f32x4 acc[2][2][4][2];
#pragma unroll
    for (int a = 0; a < 2; ++a)
#pragma unroll
        for (int b = 0; b < 2; ++b)
#pragma unroll
            for (int m = 0; m < 4; ++m)
#pragma unroll
                for (int n = 0; n < 2; ++n) acc[a][b][m][n] = (f32x4){0.f, 0.f, 0.f, 0.f};
    bf16x8 At[4][2], B0[2][2], B1[2][2];
    const char* cA = (const char*)g.A + (size_t)cur.pm * tstep; const char* cB = (const char*)g.Bt + (size_t)cur.pn * tstep;
    S.a_ready(cur);
    if constexpr (SP2) {
        PG8_STAGE(PG8_SB(0, 0), cB, voffB); PG8_STAGE(PG8_SB(0, 1), cB + hstep, voffB); PG8_STAGE(PG8_SA(0, 0), cA, voffA); PG8_STAGE(PG8_SA(0, 1), cA + hstep, voffA);
        if (wr == 1) PG8_BAR;
        PG8_WAIT_V(2); PG8_BAR;
        PG8_STAGE(PG8_SB(1, 0), cB + kstep, voffB); PG8_STAGE(PG8_SA(1, 0), cA + kstep, voffA); PG8_STAGE(PG8_SB(1, 1), cB + hstep + kstep, voffB);
        PG8_WAIT_V(6); PG8_BAR;
    } else {
        PG8_STAGE(PG8_SB(0, 0), cB, voffB); PG8_STAGE(PG8_SA(0, 0), cA, voffA); PG8_STAGE(PG8_SB(0, 1), cB + hstep, voffB); PG8_STAGE(PG8_SA(0, 1), cA + hstep, voffA);
        if (wr == 1) PG8_BAR;
        PG8_WAIT_V(4); PG8_BAR;
        PG8_STAGE(PG8_SB(1, 0), cB + kstep, voffB); PG8_STAGE(PG8_SA(1, 0), cA + kstep, voffA); PG8_STAGE(PG8_SB(1, 1), cB + hstep + kstep, voffB);
        PG8_WAIT_V(6); PG8_BAR;
    }
    for (;;) {
        const bool has_next = S.next(ui + 1, nxt);
        const char* nA = has_next ? (const char*)g.A + (size_t)nxt.pm * tstep : cA; const char* nB = has_next ? (const char*)g.Bt + (size_t)nxt.pn * tstep : cB;
        for (int t = 0; t < nt; t += 2) {
            const bool last = (t == nt - 2);
            const char* a1 = cA + (size_t)(t + 1) * kstep;
            const char* a2 = last ? nA : cA + (size_t)(t + 2) * kstep; const char* b2 = last ? nB : cB + (size_t)(t + 2) * kstep;
            const char* a3 = a2 + kstep; const char* b3 = b2 + kstep;
            if (last && has_next) S.a_ready(nxt);
            if constexpr (SP2) {
            PG8_LDB(B0, 0, 0); PG8_LDB(B1, 0, 1); PG8_SCHED; PG8_LDA(At, 0, 0); PG8_STAGE(PG8_SA(1, 1), a1 + hstep, voffA);
            PG8_WAIT_V(8); PG8_WAIT_L(0); PG8_BAR; PG8_MMA(0, 0, At, B0); PG8_MMA(0, 1, At, B1); PG8_BAR; PG8_SCHED;
            PG8_LDA(At, 0, 1); PG8_STAGE(PG8_SB(0, 0), b2, voffB); PG8_STAGE(PG8_SB(0, 1), b2 + hstep, voffB); PG8_STAGE(PG8_SA(0, 0), a2, voffA);
            PG8_WAIT_V(8); PG8_WAIT_L(0); PG8_BAR; PG8_MMA(1, 0, At, B0); PG8_MMA(1, 1, At, B1); PG8_BAR; PG8_SCHED;
            PG8_LDB(B0, 1, 0); PG8_LDB(B1, 1, 1); PG8_SCHED; PG8_LDA(At, 1, 0); PG8_STAGE(PG8_SA(0, 1), a2 + hstep, voffA);
            PG8_WAIT_V(8); PG8_WAIT_L(0); PG8_BAR; PG8_MMA(0, 0, At, B0); PG8_MMA(0, 1, At, B1); PG8_BAR; PG8_SCHED;
            PG8_LDA(At, 1, 1); PG8_STAGE(PG8_SB(1, 0), b3, voffB); PG8_STAGE(PG8_SB(1, 1), b3 + hstep, voffB); PG8_STAGE(PG8_SA(1, 0), a3, voffA);
            PG8_WAIT_V(8); PG8_WAIT_L(0); PG8_BAR; PG8_MMA(1, 0, At, B0); PG8_MMA(1, 1, At, B1); PG8_BAR; PG8_SCHED;
            } else {
            PG8_LDB(B0, 0, 0); PG8_SCHED; PG8_LDA(At, 0, 0); PG8_STAGE(PG8_SA(1, 1), a1 + hstep, voffA);
            PG8_WAIT_L(8); PG8_BAR; PG8_WAIT_L(0); PG8_MMA(0, 0, At, B0); PG8_BAR; PG8_SCHED;
            PG8_LDB(B1, 0, 1); PG8_STAGE(PG8_SB(0, 0), b2, voffB);
            PG8_BAR; PG8_WAIT_L(0); PG8_MMA(0, 1, At, B1); PG8_BAR;
            PG8_LDA(At, 0, 1); PG8_STAGE(PG8_SA(0, 0), a2, voffA);
            PG8_BAR; PG8_WAIT_L(0); PG8_MMA(1, 0, At, B0); PG8_BAR; PG8_SCHED;
            PG8_STAGE(PG8_SB(0, 1), b2 + hstep, voffB);
            PG8_WAIT_V(6); PG8_BAR; PG8_MMA(1, 1, At, B1); PG8_BAR;
            PG8_LDB(B0, 1, 0); PG8_SCHED; PG8_LDA(At, 1, 0); PG8_STAGE(PG8_SA(0, 1), a2 + hstep, voffA);
            PG8_WAIT_L(8); PG8_BAR; PG8_WAIT_L(0); PG8_MMA(0, 0, At, B0); PG8_BAR; PG8_SCHED;
            PG8_LDB(B1, 1, 1); PG8_STAGE(PG8_SB(1, 0), b3, voffB);
            PG8_BAR; PG8_WAIT_L(0); PG8_MMA(0, 1, At, B1); PG8_BAR;
            PG8_LDA(At, 1, 1); PG8_STAGE(PG8_SA(1, 0), a3, voffA);
            PG8_BAR; PG8_WAIT_L(0); PG8_MMA(1, 0, At, B0); PG8_BAR; PG8_SCHED;
            PG8_STAGE(PG8_SB(1, 1), b3 + hstep, voffB);
            PG8_WAIT_V(6); PG8_BAR; PG8_MMA(1, 1, At, B1); PG8_BAR;
            }
        }
        if constexpr (ALIGN_EPI) { if (wr == 0) PG8_BAR; }
        if constexpr (!Epi::AFTER_DRAIN) { E(acc, cur, wr, wc, fr, fq); S.done(cur); }
        if (!has_next) break;
#pragma unroll
        for (int a = 0; a < 2; ++a)
#pragma unroll
            for (int b = 0; b < 2; ++b)
#pragma unroll
                for (int m = 0; m < 4; ++m)
#pragma unroll
                    for (int n = 0; n < 2; ++n) acc[a][b][m][n] = (f32x4){0.f, 0.f, 0.f, 0.f};
        cur = nxt; cA = nA; cB = nB; ++ui;
        if constexpr (ALIGN_EPI) { if (wr == 1) PG8_BAR; }
    }
    PG8_WAIT_V(0);
    if constexpr (!ALIGN_EPI) { if (wr == 0) PG8_BAR; }
    PG8_BAR;
    if constexpr (Epi::AFTER_DRAIN) { E.fused(acc, cur, wr, wc, fr, fq, lds, wid, lane); S.done(cur); }
#undef PG8_SA
#undef PG8_SB
#undef PG8_STAGE
#undef PG8_LDA
#undef PG8_LDB
#undef PG8_MMA
#undef PG8_WAIT_V
#undef PG8_WAIT_L
#undef PG8_BAR
#undef PG8_SCHED
}
}

#include <hip/hip_bf16.h>
#include <cmath>
namespace attn_body {
using bf16=__hip_bfloat16;
using bf16x8=__attribute__((ext_vector_type(8)))short;
using s16x4=__attribute__((ext_vector_type(4)))short;
using f32x16=__attribute__((ext_vector_type(16)))float;
using u32x4=__attribute__((ext_vector_type(4)))unsigned;
constexpr int D=64,QP=512,KP=128,VP=2304,OP=1024;
constexpr int NW=8,QBLK=32,QB=QBLK*NW,KVBLK=64;
constexpr int ATTN_UNIT_ROWS=QB;
__device__ __forceinline__ int crow(int r,int hi){return (r&3)+8*(r>>2)+4*hi;}
#define SBAR() __builtin_amdgcn_sched_barrier(0)
constexpr int NSLOT=3, SLOTB=8192;
constexpr int LDS_K=0, LDS_V=NSLOT*SLOTB, LDS_WS=2*NSLOT*SLOTB, LDS_OST=LDS_WS+NW*64*4, LDS_BYTES=LDS_OST+NW*4096;
constexpr float C2=0.125f*1.4426950408889634f;
__device__ __forceinline__ void glds16(const void*gsrc,unsigned lds_dst){unsigned keep;
  asm volatile("s_mov_b32 %0, m0\n\ts_mov_b32 m0, %2\n\ts_nop 0\n\tglobal_load_lds_dwordx4 %1, off\n\ts_mov_b32 m0, %0":"=&s"(keep):"v"(gsrc),"s"(lds_dst):"memory");}
__device__ __forceinline__ float max3f(float a,float b,float c){float r;asm("v_max3_f32 %0, %1, %2, %3":"=v"(r):"v"(a),"v"(b),"v"(c));return r;}
__device__ __forceinline__ float max2f(float a,float b){float r;asm("v_max_f32_e32 %0, %1, %2":"=v"(r):"v"(a),"v"(b));return r;}
__device__ __forceinline__ float fadd_s(float a,float b){float r;asm("v_add_f32_e32 %0, %1, %2":"=v"(r):"v"(a),"v"(b));return r;}
__device__ __forceinline__ float fsub_s(float a,float b){float r;asm("v_sub_f32_e32 %0, %1, %2":"=v"(r):"v"(a),"v"(b));return r;}
typedef float f32x2_t __attribute__((ext_vector_type(2))); typedef __bf16 bf16x2_t __attribute__((ext_vector_type(2)));
__device__ __forceinline__ unsigned cvtpk_s(float lo,float hi){f32x2_t v={lo,hi};bf16x2_t b=__builtin_convertvector(v,bf16x2_t);return __builtin_bit_cast(unsigned,b);}
#define WAIT_BAR(N) asm volatile("s_waitcnt vmcnt(" #N ") lgkmcnt(0)\n\ts_barrier":::"memory")

__device__ __forceinline__ void qkt(f32x16&p0,f32x16&p1,const char*Kslot,const bf16x8*qr,const f32x16&negm,int r32,int hi){
  const char*kb=Kslot+hi*1024+r32*16;
  #pragma unroll
  for(int d0=0;d0<4;++d0){
    const bf16x8 b0=*reinterpret_cast<const bf16x8*>(kb+d0*2048);
    const bf16x8 b1=*reinterpret_cast<const bf16x8*>(kb+d0*2048+512);
    if(d0==0){p0=__builtin_amdgcn_mfma_f32_32x32x16_bf16(b0,qr[0],negm,0,0,0);p1=__builtin_amdgcn_mfma_f32_32x32x16_bf16(b1,qr[0],negm,0,0,0);}
    else{p0=__builtin_amdgcn_mfma_f32_32x32x16_bf16(b0,qr[d0],p0,0,0,0);p1=__builtin_amdgcn_mfma_f32_32x32x16_bf16(b1,qr[d0],p1,0,0,0);}}
}
typedef __attribute__((address_space(3))) const char* lds_cptr;
typedef short v4i16_t __attribute__((ext_vector_type(4)));
__device__ __forceinline__ void kload8(bf16x8*kf,lds_cptr kp){
  kf[0]=*(const __attribute__((address_space(3))) bf16x8*)(kp);      kf[1]=*(const __attribute__((address_space(3))) bf16x8*)(kp+512);
  kf[2]=*(const __attribute__((address_space(3))) bf16x8*)(kp+2048); kf[3]=*(const __attribute__((address_space(3))) bf16x8*)(kp+2560);
  kf[4]=*(const __attribute__((address_space(3))) bf16x8*)(kp+4096); kf[5]=*(const __attribute__((address_space(3))) bf16x8*)(kp+4608);
  kf[6]=*(const __attribute__((address_space(3))) bf16x8*)(kp+6144); kf[7]=*(const __attribute__((address_space(3))) bf16x8*)(kp+6656);
}
__device__ __forceinline__ void kload2(bf16x8*kf,lds_cptr kp,int j){ kf[2*j]=*(const __attribute__((address_space(3))) bf16x8*)(kp+j*2048); kf[2*j+1]=*(const __attribute__((address_space(3))) bf16x8*)(kp+j*2048+512); }
__device__ __forceinline__ s16x4 vtr(lds_cptr p){ return __builtin_bit_cast(s16x4,__builtin_amdgcn_ds_read_tr16_b64_v4i16((__attribute__((address_space(3))) v4i16_t*)p)); }
__device__ __forceinline__ float rowmax(const f32x16&p0,const f32x16&p1){
  float a=max3f(p0[0],p0[1],p1[0]),b=max3f(p0[2],p0[3],p1[1]);a=max3f(a,p1[2],p1[3]);
  #pragma unroll
  for(int r=4;r<16;r+=4){a=max3f(a,p0[r],p0[r+1]);b=max3f(b,p0[r+2],p0[r+3]);a=max3f(a,p1[r],p1[r+1]);b=max3f(b,p1[r+2],p1[r+3]);}
  const float m=max2f(a,b);
  auto rr=__builtin_amdgcn_permlane32_swap(__float_as_uint(m),__float_as_uint(m),false,false);
  return max2f(__uint_as_float(rr[0]),__uint_as_float(rr[1]));
}
__device__ __forceinline__ void pv(f32x16*o,int vb,bf16x8 pa0,bf16x8 pa1,bf16x8 pa2,bf16x8 pa3){
  #pragma unroll
  for(int d0=0;d0<2;++d0){s16x4 lo[4],hi[4];
    #pragma unroll
    for(int ks=0;ks<4;++ks){
      asm volatile("ds_read_b64_tr_b16 %0,%1 offset:%c2":"=&v"(lo[ks]):"v"(vb),"i"(d0*4096+ks*1024):"memory");
      asm volatile("ds_read_b64_tr_b16 %0,%1 offset:%c2":"=&v"(hi[ks]):"v"(vb),"i"(d0*4096+ks*1024+512):"memory");}
    asm volatile("s_waitcnt lgkmcnt(0)":::"memory");SBAR();
    #define PK(k) (bf16x8){lo[k][0],lo[k][1],lo[k][2],lo[k][3],hi[k][0],hi[k][1],hi[k][2],hi[k][3]}
    o[d0]=__builtin_amdgcn_mfma_f32_32x32x16_bf16(pa0,PK(0),o[d0],0,0,0);
    o[d0]=__builtin_amdgcn_mfma_f32_32x32x16_bf16(pa1,PK(1),o[d0],0,0,0);
    o[d0]=__builtin_amdgcn_mfma_f32_32x32x16_bf16(pa2,PK(2),o[d0],0,0,0);
    o[d0]=__builtin_amdgcn_mfma_f32_32x32x16_bf16(pa3,PK(3),o[d0],0,0,0);
    #undef PK
  }
}

#ifndef ATTN_STORE16
#define ATTN_STORE16(p,v) (*(u32x4*)(p)=(v))
#endif
__device__ __forceinline__ void attn_unit(const bf16*Qw0,const bf16*__restrict__ Kh,const bf16*__restrict__ Vh,bf16*Ow0,const int NT,const float neg_ref,char*shm){
  const int tid=otid(),lane=tid&63,r32=lane&31,hi=lane>>5; const int wid=__builtin_amdgcn_readfirstlane(tid>>6);
  const bf16*Qw=Qw0+(long)(wid*QBLK)*QP;
  const unsigned lds0=(unsigned)(uintptr_t)shm;
  float*wsf=(float*)(shm+LDS_WS)+wid*64;
  const bf16*ksrc=Kh+(long)lane*KP+wid*8;
  const bf16*vsrc=Vh+(long)(16*(wid&3)+(lane>>2))*VP+(wid>>2)*32+(lane&3)*8;
  const unsigned kdst=lds0+LDS_K+wid*1024, vdst=lds0+LDS_V+wid*1024;
  #define DMA_K(t,slot) glds16(ksrc+(long)(t)*KVBLK*KP,(unsigned)__builtin_amdgcn_readfirstlane(kdst+(slot)))
  #define DMA_V(t,slot) glds16(vsrc+(long)(t)*KVBLK*VP,(unsigned)__builtin_amdgcn_readfirstlane(vdst+(slot)))
  const int vb0=(int)(lds0+LDS_V)+((lane>>4)&1)*32+(lane&3)*8+(4*hi+((lane&15)>>2))*64;
  const char*Kbase=shm+LDS_K; bf16x8 kf[8];
  const lds_cptr shm3=(lds_cptr)shm; const lds_cptr kp0=shm3+LDS_K+hi*1024+r32*16; const lds_cptr vp0=shm3+LDS_V+((lane>>4)&1)*32+(lane&3)*8+(4*hi+((lane&15)>>2))*64;
  DMA_K(0,0);DMA_V(0,0);DMA_K(1,SLOTB);
  bf16x8 qr[4];
  #pragma unroll
  for(int d0=0;d0<4;++d0)qr[d0]=*reinterpret_cast<const bf16x8*>(&Qw[(long)r32*QP+d0*16+hi*8]);
  float l_reg=0.f;f32x16 o[2];o[0]=f32x16{};o[1]=f32x16{};f32x16 negm;
  #pragma unroll
  for(int r=0;r<16;++r)negm[r]=neg_ref;
  asm volatile("":"+v"(negm));
  f32x16 pA0,pA1,pB0,pB1;
  int sl_prev=0,sl_cur=0,sl_next=SLOTB;
  #define ROT() do{sl_prev=sl_cur;sl_cur=sl_next;sl_next=(sl_next==(NSLOT-1)*SLOTB)?0:sl_next+SLOTB;}while(0)
  DMA_K(2,2*SLOTB);
  WAIT_BAR(3);
  qkt(pA0,pA1,Kbase,qr,negm,r32,hi);asm volatile("s_nop 15\n\ts_nop 7":"+v"(pA0),"+v"(pA1));
  _Pragma("unroll") for(int r=0;r<16;++r)pA0[r]=__builtin_amdgcn_exp2f(pA0[r]);
  _Pragma("unroll") for(int r=0;r<16;++r)pA1[r]=__builtin_amdgcn_exp2f(pA1[r]);
  WAIT_BAR(0);
  DMA_K(3,0);DMA_V(1,SLOTB);
  ROT();
  kload8(kf,kp0+sl_cur);
  WAIT_BAR(2);
  s16x4 vlo[8],vhi[8]; u32x4 pw0,pw1,pw2,pw3;
  #define PKW(P,B) cvtpk_s(P[B],P[B+1])
  #define PAF(k) __builtin_bit_cast(bf16x8,pw##k)
  #define VFR(i) (bf16x8){vlo[i][0],vlo[i][1],vlo[i][2],vlo[i][3],vhi[i][0],vhi[i][1],vhi[i][2],vhi[i][3]}
  #define PIN(x) asm volatile("":"+v"(x))
  #define MX3(a,b,c) __builtin_fmaxf(__builtin_fmaxf((a),(b)),(c))
  #define GAPA(MF,A0,A1,A2,A3,W0,W1,PW) do{ MF; sacc+=A0; sacc+=A1; sacc+=A2; sacc+=A3; PIN(sacc); W0; W1; PIN(PW); SBAR(); }while(0)
  #define EX(v) __builtin_amdgcn_exp2f(v)
  #define GAPB(MF,X,B) do{ MF; X[B]=EX(X[B]); X[B+1]=EX(X[B+1]); X[B+2]=EX(X[B+2]); X[B+3]=EX(X[B+3]); PIN(X); SBAR(); }while(0)
  #define VRD(i) do{ vlo[i]=vtr(vp_+(((i)>>2)*4096+((i)&3)*1024)); vhi[i]=vtr(vp_+(((i)>>2)*4096+((i)&3)*1024+512)); }while(0)
  #define KRD(G,j) do{ if(G){ kload2(kf,kp0+sl_next,j); SBAR(); } }while(0)
  #define STEP(C0,C1,P0,P1,t,GK,GV,GL) do{ SBAR(); \
    const lds_cptr vp_=vp0+sl_prev; \
    VRD(0); SBAR(); float sacc=(P0[0]+P0[1]); \
    GAPA(C0=__builtin_amdgcn_mfma_f32_32x32x16_bf16(kf[0],qr[0],negm,0,0,0), P0[2],P0[3],P0[4],P0[5],     pw0[0]=PKW(P0,0), pw0[1]=PKW(P0,2), pw0); \
    VRD(4); SBAR(); GAPA(C1=__builtin_amdgcn_mfma_f32_32x32x16_bf16(kf[1],qr[0],negm,0,0,0), P0[6],P0[7],P0[8],P0[9],     pw0[2]=PKW(P0,4), pw0[3]=PKW(P0,6), pw0); \
    VRD(1); SBAR(); GAPA(C0=__builtin_amdgcn_mfma_f32_32x32x16_bf16(kf[2],qr[1],C0,0,0,0),   P0[10],P0[11],P0[12],P0[13], pw1[0]=PKW(P0,8), pw1[1]=PKW(P0,10), pw1); \
    VRD(5); SBAR(); GAPA(C1=__builtin_amdgcn_mfma_f32_32x32x16_bf16(kf[3],qr[1],C1,0,0,0),   P0[14],P0[15],P1[0],P1[1],   pw1[2]=PKW(P0,12),pw1[3]=PKW(P0,14), pw1); \
    VRD(2); SBAR(); GAPA(C0=__builtin_amdgcn_mfma_f32_32x32x16_bf16(kf[4],qr[2],C0,0,0,0),   P1[2],P1[3],P1[4],P1[5],     pw2[0]=PKW(P1,0), pw2[1]=PKW(P1,2), pw2); \
    VRD(6); SBAR(); GAPA(C1=__builtin_amdgcn_mfma_f32_32x32x16_bf16(kf[5],qr[2],C1,0,0,0),   P1[6],P1[7],P1[8],P1[9],     pw2[2]=PKW(P1,4), pw2[3]=PKW(P1,6), pw2); \
    VRD(3); SBAR(); GAPA(C0=__builtin_amdgcn_mfma_f32_32x32x16_bf16(kf[6],qr[3],C0,0,0,0),   P1[10],P1[11],P1[12],P1[13], pw3[0]=PKW(P1,8), pw3[1]=PKW(P1,10), pw3); \
    VRD(7); SBAR(); GAPA(C1=__builtin_amdgcn_mfma_f32_32x32x16_bf16(kf[7],qr[3],C1,0,0,0),   P1[14],P1[15],0.f,0.f,       pw3[2]=PKW(P1,12),pw3[3]=PKW(P1,14), pw3); \
    l_reg+=sacc; \
    if(GK){DMA_K((t)+3,sl_cur);} if(GV){DMA_V((t)+1,sl_next);} \
    SBAR(); \
    GAPB(o[0]=__builtin_amdgcn_mfma_f32_32x32x16_bf16(PAF(0),VFR(0),o[0],0,0,0), C0,0); \
    GAPB(o[1]=__builtin_amdgcn_mfma_f32_32x32x16_bf16(PAF(0),VFR(4),o[1],0,0,0), C0,4); \
    KRD(GL,0); GAPB(o[0]=__builtin_amdgcn_mfma_f32_32x32x16_bf16(PAF(1),VFR(1),o[0],0,0,0), C0,8); \
    KRD(GL,1); GAPB(o[1]=__builtin_amdgcn_mfma_f32_32x32x16_bf16(PAF(1),VFR(5),o[1],0,0,0), C0,12); \
    KRD(GL,2); GAPB(o[0]=__builtin_amdgcn_mfma_f32_32x32x16_bf16(PAF(2),VFR(2),o[0],0,0,0), C1,0); \
    KRD(GL,3); GAPB(o[1]=__builtin_amdgcn_mfma_f32_32x32x16_bf16(PAF(2),VFR(6),o[1],0,0,0), C1,4); \
    GAPB(o[0]=__builtin_amdgcn_mfma_f32_32x32x16_bf16(PAF(3),VFR(3),o[0],0,0,0), C1,8); \
    GAPB(o[1]=__builtin_amdgcn_mfma_f32_32x32x16_bf16(PAF(3),VFR(7),o[1],0,0,0), C1,12); \
    }while(0)
  int t=1;
  for(;t+5<NT;t+=2){
    STEP(pB0,pB1,pA0,pA1,t,true,true,true);     WAIT_BAR(2); ROT();
    STEP(pA0,pA1,pB0,pB1,t+1,true,true,true);   WAIT_BAR(2); ROT();
  }
  #define ENDW(tt) do{ if((tt)+3<NT){WAIT_BAR(2);} else if((tt)+2<NT){WAIT_BAR(1);} else {WAIT_BAR(0);} }while(0)
  for(;t+1<NT;t+=2){
    STEP(pB0,pB1,pA0,pA1,t,(t+3<NT),(t+1<NT),(t+1<NT));       ENDW(t);   ROT();
    STEP(pA0,pA1,pB0,pB1,t+1,(t+4<NT),(t+2<NT),(t+2<NT));     ENDW(t+1); ROT();
  }
  STEP(pB0,pB1,pA0,pA1,NT-1,false,false,false);
  { float sacc=pB0[0]+pB0[1]; _Pragma("unroll") for(int r=2;r<16;++r)sacc+=pB0[r]; _Pragma("unroll") for(int r=0;r<16;++r)sacc+=pB1[r]; l_reg+=sacc;
    pw0=(u32x4){PKW(pB0,0),PKW(pB0,2),PKW(pB0,4),PKW(pB0,6)};pw1=(u32x4){PKW(pB0,8),PKW(pB0,10),PKW(pB0,12),PKW(pB0,14)};pw2=(u32x4){PKW(pB1,0),PKW(pB1,2),PKW(pB1,4),PKW(pB1,6)};pw3=(u32x4){PKW(pB1,8),PKW(pB1,10),PKW(pB1,12),PKW(pB1,14)};
    SBAR(); pv(o,vb0+sl_cur,PAF(0),PAF(1),PAF(2),PAF(3)); }
  #undef PKW
  #undef PAF
  #undef VFR
  #undef PIN
  #undef MX3
  #undef GAPA
  #undef GAPB
  #undef EX
  #undef VRD
  #undef KRD
  #undef STEP
  #undef ENDW
  {auto rr=__builtin_amdgcn_permlane32_swap(__float_as_uint(l_reg),__float_as_uint(l_reg),false,false);l_reg=__uint_as_float(rr[0])+__uint_as_float(rr[1]);}
  if(hi==0)wsf[32+r32]=l_reg;asm volatile("s_waitcnt lgkmcnt(0)":::"memory");
  float rli[16];
  #pragma unroll
  for(int r=0;r<16;++r)rli[r]=__builtin_amdgcn_rcpf(wsf[32+crow(r,hi)]);
  bf16*Ow=Ow0+(long)(wid*QBLK)*OP;
  { bf16*stg=(bf16*)(shm+LDS_OST)+wid*2048;
    #pragma unroll
    for(int r=0;r<16;++r){const int orow=crow(r,hi);
      #pragma unroll
      for(int d0=0;d0<2;++d0)stg[orow*64+d0*32+r32]=__float2bfloat16(o[d0][r]*rli[r]);}
    asm volatile("s_waitcnt lgkmcnt(0)":::"memory");
    #pragma unroll
    for(int i=0;i<4;++i){const int row=i*8+(lane>>3),ch=lane&7; const u32x4 v=*(const u32x4*)(stg+row*64+ch*8); ATTN_STORE16(Ow+(long)row*OP+ch*8,v);} }
  asm volatile("s_waitcnt lgkmcnt(0)\n\ts_barrier":::"memory");
  #undef DMA_K
  #undef DMA_V
  #undef ROT
}
constexpr int ATTN_LDS_BYTES=LDS_BYTES;
#undef SBAR
#undef WAIT_BAR
}


using namespace cfg;
typedef unsigned short bf16_t;
typedef float f32x4 __attribute__((ext_vector_type(4)));
typedef unsigned u32x4 __attribute__((ext_vector_type(4)));
typedef unsigned u32x2 __attribute__((ext_vector_type(2)));

__device__ __forceinline__ float bf2f(unsigned v) { return __uint_as_float(v << 16); }
__device__ __forceinline__ float bflo(unsigned w) { return __uint_as_float(w << 16); }
__device__ __forceinline__ float bfhi(unsigned w) { return __uint_as_float(w & 0xffff0000u); }
__device__ __forceinline__ unsigned f2bf(float f) { unsigned u = __float_as_uint(f); return (u + 0x7fffu + ((u >> 16) & 1u)) >> 16; }
__device__ __forceinline__ unsigned pk2(float lo, float hi) { return f2bf(lo) | (f2bf(hi) << 16); }
__device__ __forceinline__ float sigm(float x) { return 1.f / (1.f + __expf(-x)); }
__device__ __forceinline__ float silu(float x) { return x / (1.f + __expf(-x)); }
template <int M> __device__ __forceinline__ float xsum(float v) {
    if constexpr (M < 32) return v + __uint_as_float((unsigned)__builtin_amdgcn_ds_swizzle((int)__float_as_uint(v), (M << 10) | 0x1f));
    else { auto rr = __builtin_amdgcn_permlane32_swap(__float_as_uint(v), __float_as_uint(v), false, false); return __uint_as_float(rr[0]) + __uint_as_float(rr[1]); }
}
__device__ __forceinline__ float wave_sum(float v) { v = xsum<1>(v); v = xsum<2>(v); v = xsum<4>(v); v = xsum<8>(v); v = xsum<16>(v); v = xsum<32>(v); return v; }
__device__ __forceinline__ size_t stream_off(int row, bool& is_ctx) { const int b = row / PB, p = row - b * PB; is_ctx = p < CTXL; return is_ctx ? ((size_t)b * CTXL + p) * D : ((size_t)b * SEQ + (p - CTXL)) * D; }

constexpr size_t MiB = 1u << 20;
constexpr size_t WS_CTL = 0;
constexpr size_t WS_MODV = 1 * MiB;
constexpr size_t WS_LBF = WS_MODV + 256 * 1024;
constexpr size_t WS_REF = WS_LBF + 8192;
constexpr size_t WS_POOLWT = WS_MODV + 512 * 1024;
constexpr size_t WS_COS = 2 * MiB, WS_SIN = 3 * MiB;
constexpr size_t WS_WIN = 4 * MiB;
constexpr size_t WS_WOUT = 13 * MiB;
constexpr size_t WS_WGU = 17 * MiB;
constexpr size_t WS_WD = 49 * MiB;
constexpr size_t WS_XC = 65 * MiB;
constexpr size_t WS_XN = 67 * MiB;
constexpr size_t WS_PROJ = 100 * MiB;
constexpr size_t WS_QN = 175 * MiB;
constexpr size_t WS_KN = 192 * MiB;
constexpr size_t WS_MIX = 197 * MiB;
constexpr size_t WS_UT = 230 * MiB;
constexpr size_t WS_ST = 247 * MiB;
constexpr size_t WS_DEC = 264 * MiB;
constexpr size_t WS_LIST = 265 * MiB;
constexpr size_t WS_ACT2 = WS_PROJ;
constexpr size_t WS_WGU1 = 272 * MiB;
constexpr size_t WS_WD1 = 304 * MiB;
constexpr size_t WS_END = 320 * MiB;
constexpr int CW_CNT = 1024;

__device__ const float ROPE_INV[16] = {1.0f, 0.5623413251903491f, 0.31622776601683794f, 0.1778279410038923f, 0.1f, 0.05623413251903491f, 0.03162277660168379f, 0.01778279410038923f,
                                       0.01f, 0.005623413251903491f, 0.0031622776601683794f, 0.0017782794100389228f, 0.001f, 0.0005623413251903491f, 0.00031622776601683794f, 0.00017782794100389227f};
__device__ __forceinline__ void sincos_d(double a, double& s, double& c) {
    const double k = rint(a * 0.63661977236758134308);
    double r = fma(-k, 1.57079632679489655800e+00, a);
    r = fma(-k, 6.12323399573676603587e-17, r);
    const double r2 = r * r;
    double sp = -7.6471637318198164759e-13;
    sp = fma(sp, r2, 1.6059043836821614599e-10);
    sp = fma(sp, r2, -2.5052108385441718775e-08);
    sp = fma(sp, r2, 2.7557319223985890653e-06);
    sp = fma(sp, r2, -1.9841269841269841270e-04);
    sp = fma(sp, r2, 8.3333333333333333333e-03);
    sp = fma(sp, r2, -1.6666666666666666667e-01);
    const double sr = fma(sp * r2, r, r);
    double cp = 4.7794773323873852974e-14;
    cp = fma(cp, r2, -1.1470745597729724714e-11);
    cp = fma(cp, r2, 2.0876756987868098979e-09);
    cp = fma(cp, r2, -2.7557319223985890653e-07);
    cp = fma(cp, r2, 2.4801587301587301587e-05);
    cp = fma(cp, r2, -1.3888888888888888889e-03);
    cp = fma(cp, r2, 4.1666666666666666667e-02);
    cp = fma(cp, r2, -0.5);
    const double cr = fma(cp, r2, 1.0);
    const int q = ((int)k) & 3;
    s = (q == 0) ? sr : (q == 1) ? cr : (q == 2) ? -sr : -cr;
    c = (q == 0) ? cr : (q == 1) ? -sr : (q == 2) ? -cr : sr;
}

__device__ __forceinline__ void transpose_items(const float* __restrict__ W, int K, int N, bf16_t* __restrict__ WT, int mode, int nbatch, size_t src_stride, size_t dst_stride, float* scr, int gw, int NGW, int lane, int it_lo = 0, int it_hi = 0x7fffffff) {
    const int nblk = N / 32, per = (K / 64) * nblk, nitems = per * nbatch;
    if (it_hi > nitems) it_hi = nitems;
    for (int it = it_lo + gw; it < it_hi; it += NGW) {
        const int bt = it / per, item = it - bt * per;
        const float* Wb = W + (size_t)bt * src_stride; bf16_t* WTb = WT + (size_t)bt * dst_stride;
        const int kb = item / nblk, nb = item - kb * nblk, k0 = 64 * kb, n0 = 32 * nb;
        f32x4 wv[8];
#pragma unroll
        for (int i = 0; i < 8; ++i) wv[i] = *(const f32x4*)(Wb + (size_t)(k0 + 8 * i + (lane >> 3)) * N + n0 + (lane & 7) * 4);
#pragma unroll
        for (int i = 0; i < 8; ++i) { float* s = scr + (8 * i + (lane >> 3)) * 33 + (lane & 7) * 4; s[0] = wv[i].x; s[1] = wv[i].y; s[2] = wv[i].z; s[3] = wv[i].w; }
        asm volatile("s_waitcnt lgkmcnt(0)" ::: "memory");
        const int rbase = (mode == 0) ? n0 : ((n0 >> 7) * 256 + (mode == 2 ? 128 : 0) + (n0 & 127));
        const int cch = lane & 7;
#pragma unroll
        for (int j = 0; j < 4; ++j) { const int n = (lane >> 3) + 8 * j; const float* s = scr + (8 * cch) * 33 + n;
            u32x4 o; o.x = pk2(s[0 * 33], s[1 * 33]); o.y = pk2(s[2 * 33], s[3 * 33]); o.z = pk2(s[4 * 33], s[5 * 33]); o.w = pk2(s[6 * 33], s[7 * 33]);
            *(u32x4*)(WTb + (size_t)(rbase + n) * K + k0 + 8 * cch) = o; }
        asm volatile("s_waitcnt lgkmcnt(0)" ::: "memory");
    }
}
constexpr int MOE_ITEMS = 3 * 4096;
__device__ __forceinline__ void moe_weight_copies(const float* gate, const float* up, const float* down, bf16_t* WGU, bf16_t* WD, float* scr, int gw, int NGW, int lane, int lo, int hi) {
    if (lo < 4096) transpose_items(gate, D, DE, WGU, 1, NE, (size_t)D * DE, (size_t)1024 * D, scr, gw, NGW, lane, lo, hi < 4096 ? hi : 4096);
    if (lo < 8192 && hi > 4096) transpose_items(up, D, DE, WGU, 2, NE, (size_t)D * DE, (size_t)1024 * D, scr, gw, NGW, lane, lo > 4096 ? lo - 4096 : 0, hi < 8192 ? hi - 4096 : 4096);
    if (hi > 8192) transpose_items(down, DE, D, WD, 0, NE, (size_t)DE * D, (size_t)D * DE, scr, gw, NGW, lane, lo > 8192 ? lo - 8192 : 0, hi - 8192);
}
__device__ __forceinline__ void moe_filler(unsigned char* lds, const float* gate, const float* up, const float* down, unsigned char* ws, int lw, int lo, int hi, int U, int G, int c) {
    const int rem = U % G; int rank = c, nr = G;
    if (rem != 0) { if (c < rem) return; rank = c - rem; nr = G - rem; }
    const int tid = otid(); float* scr = (float*)(lds + 16384) + (tid >> 6) * (64 * 33);
    moe_weight_copies(gate + (size_t)lw * NE * D * DE, up + (size_t)lw * NE * D * DE, down + (size_t)lw * NE * DE * D, (bf16_t*)(ws + (lw ? WS_WGU1 : WS_WGU)), (bf16_t*)(ws + (lw ? WS_WD1 : WS_WD)), scr, rank * 8 + (tid >> 6), nr * 8, tid & 63, lo, hi);
}
struct ProArgs { const float *c, *c_ctx, *w_mod, *b_mod, *hgrn_lb, *qg, *kg, *w_in, *w_out, *pool_w, *gate, *up, *down; float *MODV, *LBF, *REF, *COS, *SIN; bf16_t *WIN, *WOUT, *POOLWT, *WGU, *WD; };
__device__ __forceinline__ void prologue_phase(unsigned char* lds, const ProArgs& a, int cu, int G) {
    const int tid = otid(), lane = tid & 63, wave = tid >> 6;
    for (int gid = cu * 512 + tid; gid < SEQ * 32; gid += G * 512) {
        const int t = gid >> 5, j = gid & 31;
        const float pos = (float)(j < 16 ? (t >> 6) : (t & 63));
        const float ang = pos * ROPE_INV[j & 15];
        double s, c; sincos_d((double)ang, s, c);
        a.COS[gid] = (float)c; a.SIN[gid] = (float)s;
    }
    if (cu == 0) {
        for (int gid = tid; gid < 1024; gid += 512) {
            const int l = gid >> 9, r = gid & 511; float v = 0.f;
            if (l == 1) v = 1.f / (1.f + expf(a.hgrn_lb[r] - a.hgrn_lb[512 + r]));
            a.LBF[gid] = fmaxf(v, 1e-30f); }
        if (tid < DEPTH) {
            float mq = 0.f, mk = 0.f;
            for (int i = 0; i < 64; ++i) { mq = fmaxf(mq, fabsf(a.qg[tid * 64 + i])); mk = fmaxf(mk, fabsf(a.kg[tid * 64 + i])); }
            a.REF[tid * 64] = -(64.f * C2 * mq * mk * 1.02f + 0.5f); }
    }
    {
        float* act = (float*)lds;
        float* part = (float*)(lds + 12288);
        for (int item = cu; item < 2 * 96; item += G) {
            const int l = item / 96, n0 = (item - l * 96) * 64;
            for (int i = tid; i < 3072; i += 512) { const int r = i >> 10, k = i & 1023; const float v = r < 2 ? a.c[r * 1024 + k] : a.c_ctx[k]; act[i] = silu(v); }
            __syncthreads();
            const float* w = a.w_mod + ((size_t)l * 1024 + (size_t)wave * 128) * 6144 + n0 + lane;
            float a0 = 0.f, a1 = 0.f, a2 = 0.f;
#pragma unroll 32
            for (int k = 0; k < 128; ++k) { const float wv = w[(size_t)k * 6144]; const int kk = wave * 128 + k; a0 += act[kk] * wv; a1 += act[1024 + kk] * wv; a2 += act[2048 + kk] * wv; }
            part[(wave * 3 + 0) * 64 + lane] = a0; part[(wave * 3 + 1) * 64 + lane] = a1; part[(wave * 3 + 2) * 64 + lane] = a2;
            __syncthreads();
            if (tid < 192) { const int r = tid >> 6, nn = tid & 63; float s = 0.f;
#pragma unroll
                for (int q = 0; q < 8; ++q) s += part[(q * 3 + r) * 64 + nn];
                a.MODV[(l * 3 + r) * 6144 + n0 + nn] = s + a.b_mod[l * 6144 + n0 + nn]; }
            __syncthreads();
        }
    }
    {
        float* scr = (float*)(lds + 16384) + wave * (64 * 33);
        const int gw = cu * 8 + wave, NGW = G * 8;
        transpose_items(a.w_in, D, NIN, a.WIN, 0, DEPTH, (size_t)D * NIN, (size_t)NIN * D, scr, gw, NGW, lane);
        transpose_items(a.w_out, D, D, a.WOUT, 0, DEPTH, (size_t)D * D, (size_t)D * D, scr, gw, NGW, lane);
        transpose_items(a.pool_w, 64, 64, a.POOLWT, 0, DEPTH * 4, (size_t)64 * 64, (size_t)64 * 64, scr, gw, NGW, lane);
    }
    __syncthreads();
}

namespace pool {
typedef float f32x16 __attribute__((ext_vector_type(16)));
typedef short bf16x8 __attribute__((ext_vector_type(8)));
constexpr int P = 72, O_X = 0  , O_DM = 81920  , O_OUT = 0  , OP = 264;
__device__ __forceinline__ int crow(int r, int hi) { return (r & 3) + 8 * (r >> 2) + 4 * hi; }
__device__ __forceinline__ void pool_phase(unsigned char* lds, const bf16_t* __restrict__ PROJ, const bf16_t* __restrict__ WT  , const float* __restrict__ pscale, bf16_t* __restrict__ MIX, int cu, int G) {
    const int tid = otid(), lane = tid & 63, r32 = lane & 31, hi = lane >> 5, w = __builtin_amdgcn_readfirstlane(tid >> 6);
    float* X = (float*)(lds + O_X); bf16_t* OUT = (bf16_t*)(lds + O_OUT);
    for (int u = G - 1 - cu; u < MT / 64; u += G) {
        const int row0 = u * 64, b = row0 / PB, p0 = row0 - b * PB; const bool is_ctx = p0 < CTXL;
        const int seg0 = b * PB + (is_ctx ? 0 : CTXL), len = is_ctx ? CTXL : SEQ, t0 = is_ctx ? p0 : p0 - CTXL;
#pragma unroll
        for (int it = 0; it < 5; ++it) { const int piece = tid + it * 512, rr = piece >> 5, pc = piece & 31, t = t0 - 8 + rr;
            u32x4 v = {0u, 0u, 0u, 0u};
            if (t >= 0 && t < len) v = *(const u32x4*)(PROJ + (size_t)(seg0 + t) * NIN + C_BP + pc * 8);
            float* x = X + rr * 256 + pc * 8;
            *(f32x4*)x = (f32x4){bflo(v.x), bfhi(v.x), bflo(v.y), bfhi(v.y)}; *(f32x4*)(x + 4) = (f32x4){bflo(v.z), bfhi(v.z), bflo(v.w), bfhi(v.w)}; }
        __syncthreads();
        {
            const int c = tid & 255, th = tid >> 8, g = c >> 6, hw = 1 << g;
            bf16_t* dm = (bf16_t*)(lds + O_DM) + g * 64 * P + (c & 63);
            const float* xc = X + c;
            const int ta = th * 32;
            float s = 0.f;
            for (int q = ta - hw; q < ta + hw; ++q) s += xc[(q + 8) * 256];
#pragma unroll 8
            for (int tt = 0; tt < 32; ++tt) { const int t = ta + tt, tg = t0 + t;
                int lo = tg - hw; if (lo < 0) lo = 0; int hi2 = tg + hw; if (hi2 > len) hi2 = len;
                dm[t * P] = (bf16_t)f2bf(s / (float)(hi2 - lo) - xc[(t + 8) * 256]);
                s += xc[(t + hw + 8) * 256] - xc[(t - hw + 8) * 256]; }
        }
        __syncthreads();
        {
            const int g = w >> 1, tb = w & 1;
            const bf16_t* A = (const bf16_t*)(lds + O_DM) + g * 64 * P + (tb * 32 + r32) * P + hi * 8;
#pragma unroll
            for (int eb = 0; eb < 2; ++eb) {
                const bf16_t* Bp = WT + (size_t)g * 4096 + (eb * 32 + r32) * 64 + hi * 8;
                f32x16 acc = {};
#pragma unroll
                for (int ks = 0; ks < 4; ++ks) acc = __builtin_amdgcn_mfma_f32_32x32x16_bf16(*(const bf16x8*)(A + ks * 16), *(const bf16x8*)(Bp + ks * 16), acc, 0, 0, 0);
                const int e = g * 64 + eb * 32 + r32; const float sc = pscale[e];
#pragma unroll
                for (int r = 0; r < 16; ++r) OUT[(tb * 32 + crow(r, hi)) * OP + e] = (bf16_t)f2bf(acc[r] * sc);
            }
        }
        __syncthreads();
#pragma unroll
        for (int it = 0; it < 4; ++it) { const int piece = tid + it * 512, t = piece >> 5, pc = piece & 31;
            *(u32x4*)(MIX + (size_t)(row0 + t) * D + 256 + pc * 8) = *(const u32x4*)(OUT + t * OP + pc * 8); }
        __syncthreads();
    }
}
}

#ifndef LAS
#define LAS __attribute__((address_space(3)))
#endif
__device__ __forceinline__ void norm1_phase(int cu, int G, const float* __restrict__ lat, const float* __restrict__ cx, const float* __restrict__ g, const float* __restrict__ modv, int sh_off, bf16_t* __restrict__ XN) {
    const int lane = otid() & 63, gw = cu * 8 + (otid() >> 6), NGW = G * 8;
    for (int row0 = gw * 4; row0 < MT; row0 += NGW * 4) {
        bool is_ctx; const size_t off = stream_off(row0, is_ctx);
        const int r = is_ctx ? 2 : row0 / PB;
        const f32x4* xr = (const f32x4*)((is_ctx ? cx : lat) + off) + lane;
        f32x4 v[4][4]; float ss[4];
#pragma unroll
        for (int q = 0; q < 4; ++q) { ss[q] = 0.f;
#pragma unroll
            for (int j = 0; j < 4; ++j) v[q][j] = xr[q * 256 + 64 * j]; }
        const float* mv = modv + r * 6144 + sh_off;
        f32x4 gs[4], sh[4];
#pragma unroll
        for (int j = 0; j < 4; ++j) { const int col = 4 * lane + 256 * j; gs[j] = *(const f32x4*)(g + col) * (*(const f32x4*)(mv + 1024 + col) + 1.f); sh[j] = *(const f32x4*)(mv + col); }
#pragma unroll
        for (int q = 0; q < 4; ++q) {
#pragma unroll
            for (int j = 0; j < 4; ++j) ss[q] += (v[q][j].x * v[q][j].x + v[q][j].y * v[q][j].y) + (v[q][j].z * v[q][j].z + v[q][j].w * v[q][j].w);
            const float rstd = 1.f / sqrtf(wave_sum(ss[q]) * (1.f / D) + EPS);
#pragma unroll
            for (int j = 0; j < 4; ++j) { const f32x4 o = v[q][j] * rstd * gs[j] + sh[j];
                u32x2 w; w.x = pk2(o.x, o.y); w.y = pk2(o.z, o.w);
                *(u32x2*)(XN + (size_t)(row0 + q) * D + 4 * lane + 256 * j) = w; } }
    }
}

__device__ __forceinline__ void norm2_router_phase(unsigned char* lds, int cu, int G, const float* __restrict__ lat, const float* __restrict__ cx, const float* __restrict__ g, const float* __restrict__ modv, int sh_off,
                                                   const float* __restrict__ router_w, const float* __restrict__ router_b, bf16_t* __restrict__ XN, unsigned* __restrict__ cnt, u32x4* __restrict__ LIST, int route_ctx) {
    const int tid = otid(), lane = tid & 63, wave = tid >> 6, gw = cu * 8 + wave, NGW = G * 8;
    float* RW = (float*)lds;
    u32x4* ENT = (u32x4*)(lds + 65536) + wave * 64;
    LAS unsigned* BC = (LAS unsigned*)((LAS unsigned char*)lds + 65536 + 8192);
#pragma unroll
    for (int it = 0; it < 8; ++it) { const int p = tid + it * 512, col = p >> 2, q = p & 3; const f32x4 w4 = *(const f32x4*)(router_w + (size_t)col * 16 + 4 * q);
        RW[(4 * q + 0) * 1024 + col] = w4.x; RW[(4 * q + 1) * 1024 + col] = w4.y; RW[(4 * q + 2) * 1024 + col] = w4.z; RW[(4 * q + 3) * 1024 + col] = w4.w; }
    if (tid < 48) BC[tid] = 0u;
    __syncthreads();
    int nent = 0;
    f32x4 vn[4];
    { int row = gw < MT ? gw : 0; bool ic; const size_t off = stream_off(row, ic); const f32x4* xr = (const f32x4*)((ic ? cx : lat) + off) + lane;
#pragma unroll
      for (int j = 0; j < 4; ++j) vn[j] = xr[64 * j]; }
    for (int row = gw; row < MT; row += NGW) {
        f32x4 v[4];
#pragma unroll
        for (int j = 0; j < 4; ++j) v[j] = vn[j];
        { const int nr = row + NGW < MT ? row + NGW : row; bool ic; const size_t off = stream_off(nr, ic); const f32x4* xr = (const f32x4*)((ic ? cx : lat) + off) + lane;
#pragma unroll
          for (int j = 0; j < 4; ++j) vn[j] = xr[64 * j]; }
        bool is_ctx; (void)stream_off(row, is_ctx);
        if (is_ctx && !route_ctx) continue;
        const int r = is_ctx ? 2 : row / PB;
        float ss = 0.f;
#pragma unroll
        for (int j = 0; j < 4; ++j) ss += (v[j].x * v[j].x + v[j].y * v[j].y) + (v[j].z * v[j].z + v[j].w * v[j].w);
        const float rstd = 1.f / sqrtf(wave_sum(ss) * (1.f / D) + EPS);
        const float* mv = modv + r * 6144 + sh_off;
#pragma unroll
        for (int j = 0; j < 4; ++j) { const int col = 4 * lane + 256 * j;
            const f32x4 gg = *(const f32x4*)(g + col), sh = *(const f32x4*)(mv + col), sc = *(const f32x4*)(mv + 1024 + col);
            v[j] = v[j] * rstd * gg * (sc + 1.f) + sh;
            u32x2 w; w.x = pk2(v[j].x, v[j].y); w.y = pk2(v[j].z, v[j].w);
            *(u32x2*)(XN + (size_t)row * D + col) = w; }
        float sc_[16], sel[16];
#pragma unroll
        for (int e = 0; e < 16; ++e) { float a = 0.f;
#pragma unroll
            for (int j = 0; j < 4; ++j) { const f32x4 w4 = *(const f32x4*)(RW + e * 1024 + 256 * j + 4 * lane); a += (v[j].x * w4.x + v[j].y * w4.y) + (v[j].z * w4.z + v[j].w * w4.w); }
            a = wave_sum(a); sc_[e] = 1.f / (1.f + __expf(-a)); sel[e] = sc_[e] + router_b[e]; }
        float gs[4]; int gi1[4], gi2[4]; float gw1[4], gw2[4];
#pragma unroll
        for (int q = 0; q < 4; ++q) { float v1 = -INFINITY, v2 = -INFINITY; int i1 = 0, i2 = 0; float s1 = 0.f, s2 = 0.f;
#pragma unroll
            for (int k = 0; k < 4; ++k) { const float x = sel[4 * q + k], sx = sc_[4 * q + k];
                if (x > v1) { v2 = v1; i2 = i1; s2 = s1; v1 = x; i1 = 4 * q + k; s1 = sx; } else if (x > v2) { v2 = x; i2 = 4 * q + k; s2 = sx; } }
            gs[q] = v1 + v2; gi1[q] = i1; gi2[q] = i2; gw1[q] = s1; gw2[q] = s2; }
        float bv = gs[0]; int e0 = gi1[0], e1 = gi2[0]; float w0 = gw1[0], w1 = gw2[0];
#pragma unroll
        for (int q = 1; q < 4; ++q) if (gs[q] > bv) { bv = gs[q]; e0 = gi1[q]; e1 = gi2[q]; w0 = gw1[q]; w1 = gw2[q]; }
        const float ws = w0 + w1; w0 /= ws; w1 /= ws;
        {
            const int gq = e0 >> 2; int a = e0 & 3, c = e1 & 3; float wa = w0, wc = w1;
            if (a > c) { const int ti = a; a = c; c = ti; const float tf = wa; wa = wc; wc = tf; }
            const int pi = (a == 0) ? (c - 1) : (a == 1 ? c + 1 : 5);
            const int bk = gq * 6 + pi;
            if (lane == 0) { const unsigned loc = __hip_atomic_fetch_add(BC + bk, 1u, __ATOMIC_RELAXED, __HIP_MEMORY_SCOPE_WORKGROUP);
                u32x4 sv; sv.x = (unsigned)bk | (loc << 8); sv.y = (unsigned)row; sv.z = __float_as_uint(wa); sv.w = __float_as_uint(wc); ENT[nent] = sv; }
            ++nent; }
    }
    __syncthreads();
    if (tid < 24) { const unsigned n = BC[tid]; BC[24 + tid] = n ? __hip_atomic_fetch_add(cnt + tid, n, __ATOMIC_RELAXED, __HIP_MEMORY_SCOPE_AGENT) : 0u; }
    __syncthreads();
    if (lane < nent) { const u32x4 en = ENT[lane]; const unsigned bk = en.x & 255u, slot = BC[24 + bk] + (en.x >> 8);
        u32x4 sv; sv.x = en.y; sv.y = en.z; sv.z = en.w; sv.w = 0u; LIST[(size_t)bk * MT + slot] = sv; }
    __syncthreads();
}

__device__ __forceinline__ void post_phase(int cu, int G, const bf16_t* __restrict__ PROJ, const float* __restrict__ qg, const float* __restrict__ kg, const float* __restrict__ COS, const float* __restrict__ SIN,
                                              bf16_t* __restrict__ QN, bf16_t* __restrict__ KN) {
    const int lane = otid() & 63, gw = cu * 8 + (otid() >> 6), NGW = G * 8;
    const int d0 = (lane & 7) * 8, jk = lane & 31;
    float qgv[8];
#pragma unroll
    for (int i = 0; i < 8; ++i) qgv[i] = qg[d0 + i];
    const float kg0 = kg[2 * jk], kg1 = kg[2 * jk + 1];
    for (int row0 = gw * 4; row0 < MT; row0 += NGW * 4) {
        const int b = row0 / PB, p0 = row0 - b * PB; const bool is_ctx = p0 < CTXL; const int t0 = is_ctx ? 0 : p0 - CTXL;
        u32x4 wq[4]; unsigned wk[4]; f32x4 cq[4], sq[4]; float ck[4], sk[4];
#pragma unroll
        for (int q = 0; q < 4; ++q) { const bf16_t* pr = PROJ + (size_t)(row0 + q) * NIN;
            wq[q] = *(const u32x4*)(pr + C_CQ + lane * 8); wk[q] = *(const unsigned*)(pr + C_CK + lane * 2);
            const int t = is_ctx ? 0 : t0 + q;
            cq[q] = *(const f32x4*)(COS + t * 32 + (d0 >> 1)); sq[q] = *(const f32x4*)(SIN + t * 32 + (d0 >> 1)); ck[q] = COS[t * 32 + jk]; sk[q] = SIN[t * 32 + jk]; }
#pragma unroll
        for (int q = 0; q < 4; ++q) {
            {
                const u32x4 w = wq[q];
                float x[8] = {bflo(w.x), bfhi(w.x), bflo(w.y), bfhi(w.y), bflo(w.z), bfhi(w.z), bflo(w.w), bfhi(w.w)};
                float ss = 0.f;
#pragma unroll
                for (int i = 0; i < 8; ++i) ss += x[i] * x[i];
                ss = xsum<1>(ss); ss = xsum<2>(ss); ss = xsum<4>(ss);
                const float rstd = 1.f / sqrtf(ss * (1.f / 64.f) + EPS);
#pragma unroll
                for (int i = 0; i < 8; ++i) x[i] = x[i] * rstd * qgv[i];
                if (!is_ctx) {
#pragma unroll
                    for (int i = 0; i < 4; ++i) { const float cs = cq[q][i], sn = sq[q][i];
                        const float x1 = x[2 * i], x2 = x[2 * i + 1]; x[2 * i] = x1 * cs - x2 * sn; x[2 * i + 1] = x1 * sn + x2 * cs; } }
                u32x4 o; o.x = pk2(x[0] * C2, x[1] * C2); o.y = pk2(x[2] * C2, x[3] * C2); o.z = pk2(x[4] * C2, x[5] * C2); o.w = pk2(x[6] * C2, x[7] * C2);
                *(u32x4*)(QN + (size_t)(row0 + q) * 512 + lane * 8) = o;
            }
            {
                float x1 = bflo(wk[q]), x2 = bfhi(wk[q]);
                float ss = x1 * x1 + x2 * x2;
                ss = xsum<1>(ss); ss = xsum<2>(ss); ss = xsum<4>(ss); ss = xsum<8>(ss); ss = xsum<16>(ss);
                const float rstd = 1.f / sqrtf(ss * (1.f / 64.f) + EPS);
                x1 = x1 * rstd * kg0; x2 = x2 * rstd * kg1;
                if (!is_ctx) { const float cs = ck[q], sn = sk[q]; const float a = x1 * cs - x2 * sn, c = x1 * sn + x2 * cs; x1 = a; x2 = c; }
                *(unsigned*)(KN + (size_t)(row0 + q) * 128 + lane * 2) = pk2(x1, x2);
            }
        }
    }
}

namespace hg {
typedef float f32x16 __attribute__((ext_vector_type(16)));
typedef short bf16x8 __attribute__((ext_vector_type(8)));
typedef short s16x4 __attribute__((ext_vector_type(4)));
typedef float f32x2 __attribute__((ext_vector_type(2)));
constexpr int P = 72;
constexpr int O_ZB = 0, O_ZQ = 32768, O_VT = 40960, O_QH = 50176, O_QT = 68608, O_KH = 87040, O_ST = 105472, O_SSQ = 123904, O_OUT = 0  , O_TOT = 0, LDS_BYTES = 124416;
constexpr int MSZ = 64 * P * 2;
constexpr int NCH = PB / 64;
__device__ __forceinline__ int crow(int r, int hi) { return (r & 3) + 8 * (r >> 2) + 4 * hi; }
__device__ __forceinline__ unsigned cvtpk(float lo, float hi) { typedef __bf16 b2 __attribute__((ext_vector_type(2))); f32x2 v = {lo, hi}; b2 b = __builtin_convertvector(v, b2); return __builtin_bit_cast(unsigned, b); }
__device__ __forceinline__ float clampe(float e) { return fminf(fmaxf(e, -80.f), 80.f); }

template <bool FULL> __device__ __forceinline__ void prep(unsigned char* lds, const bf16_t* __restrict__ PROJ, const float* __restrict__ LBFl, int row0, int h) {
    const int tid = otid();
    float* ZB = (float*)(lds + O_ZB); bf16_t* ZQ = (bf16_t*)(lds + O_ZQ); bf16_t* VT = (bf16_t*)(lds + O_VT);
    {
        const int t = tid >> 3, pc = tid & 7;
        const bf16_t* pr = PROJ + (size_t)(row0 + t) * NIN + h * 64 + pc * 8;
        const u32x4 wf = *(const u32x4*)(pr + C_AFF), wb = *(const u32x4*)(pr + C_AFB), wv = *(const u32x4*)(pr + C_AI);
        float* zf = ZB + t * 64 + pc * 8; float* zb = ZB + 4096 + t * 64 + pc * 8;
        *(f32x4*)zf = (f32x4){bflo(wf.x), bfhi(wf.x), bflo(wf.y), bfhi(wf.y)}; *(f32x4*)(zf + 4) = (f32x4){bflo(wf.z), bfhi(wf.z), bflo(wf.w), bfhi(wf.w)};
        *(f32x4*)zb = (f32x4){bflo(wb.x), bfhi(wb.x), bflo(wb.y), bfhi(wb.y)}; *(f32x4*)(zb + 4) = (f32x4){bflo(wb.z), bfhi(wb.z), bflo(wb.w), bfhi(wb.w)};
        bf16_t* vt = VT + (pc * 8) * P + t;
        vt[0 * P] = (bf16_t)(wv.x & 0xffffu); vt[1 * P] = (bf16_t)(wv.x >> 16); vt[2 * P] = (bf16_t)(wv.y & 0xffffu); vt[3 * P] = (bf16_t)(wv.y >> 16);
        vt[4 * P] = (bf16_t)(wv.z & 0xffffu); vt[5 * P] = (bf16_t)(wv.z >> 16); vt[6 * P] = (bf16_t)(wv.w & 0xffffu); vt[7 * P] = (bf16_t)(wv.w >> 16);
        if (FULL) { const u32x4 wq = *(const u32x4*)(pr + C_AQ); *(u32x4*)(ZQ + t * 64 + pc * 8) = wq; }
    }
    __syncthreads();
#pragma unroll
    for (int it = 0; it < 2; ++it) {
        const int item = tid + it * 512, dir = item >> 9, t = (item >> 3) & 63, i0 = (item & 7) * 8;
        float* zp = ZB + dir * 4096 + t * 64 + i0; const float* lp = LBFl + dir * 256 + h * 64 + i0;
        f32x4 za = *(const f32x4*)zp, zc = *(const f32x4*)(zp + 4); const f32x4 la = *(const f32x4*)lp, lc = *(const f32x4*)(lp + 4);
#pragma unroll
        for (int k = 0; k < 4; ++k) { za[k] = __logf(la[k] + (1.f - la[k]) / (1.f + __expf(-za[k]))); zc[k] = __logf(lc[k] + (1.f - lc[k]) / (1.f + __expf(-zc[k]))); }
        *(f32x4*)zp = za; *(f32x4*)(zp + 4) = zc;
    }
    __syncthreads();
    if (tid < 128) {
        const int dir = tid >> 6, i = tid & 63;
        float* zb = ZB + dir * 4096 + i; float acc = 0.f;
        if (dir == 0) {
#pragma unroll 16
            for (int t = 0; t < 64; ++t) { acc += zb[t * 64]; zb[t * 64] = acc; } }
        else {
#pragma unroll 16
            for (int t = 63; t >= 0; --t) { acc += zb[t * 64]; zb[t * 64] = acc; } }
    }
    __syncthreads();
#pragma unroll
    for (int it = 0; it < 2; ++it) {
        const int item = tid + it * 512, dir = item >> 9, t = (item >> 3) & 63, i0 = (item & 7) * 8;
        const float* B = ZB + dir * 4096;
        const int tp = dir == 0 ? t - 1 : t + 1; const bool edge = dir == 0 ? (t == 0) : (t == 63);
        const int tref = dir == 0 ? 31 : 32;
        float bc[8], bp[8], br[8];
        { const f32x4 a = *(const f32x4*)(B + t * 64 + i0), c = *(const f32x4*)(B + t * 64 + i0 + 4); bc[0] = a.x; bc[1] = a.y; bc[2] = a.z; bc[3] = a.w; bc[4] = c.x; bc[5] = c.y; bc[6] = c.z; bc[7] = c.w; }
        { const int tq = edge ? t : tp; const f32x4 a = *(const f32x4*)(B + tq * 64 + i0), c = *(const f32x4*)(B + tq * 64 + i0 + 4);
          bp[0] = a.x; bp[1] = a.y; bp[2] = a.z; bp[3] = a.w; bp[4] = c.x; bp[5] = c.y; bp[6] = c.z; bp[7] = c.w;
          if (edge) {
#pragma unroll
              for (int k = 0; k < 8; ++k) bp[k] = 0.f; } }
        { const f32x4 a = *(const f32x4*)(B + tref * 64 + i0), c = *(const f32x4*)(B + tref * 64 + i0 + 4); br[0] = a.x; br[1] = a.y; br[2] = a.z; br[3] = a.w; br[4] = c.x; br[5] = c.y; br[6] = c.z; br[7] = c.w; }
        float kh[8];
#pragma unroll
        for (int k = 0; k < 8; ++k) { const float kk = 1.f - __expf(bc[k] - bp[k]); kh[k] = kk * __expf(clampe(br[k] - bc[k])); }
        if (!FULL) {
            bf16_t* kt = (bf16_t*)(lds + O_KH + dir * MSZ) + i0 * P + t;
#pragma unroll
            for (int k = 0; k < 8; ++k) kt[k * P] = (bf16_t)f2bf(kh[k]);
        } else {
            u32x4 w; w.x = cvtpk(kh[0], kh[1]); w.y = cvtpk(kh[2], kh[3]); w.z = cvtpk(kh[4], kh[5]); w.w = cvtpk(kh[6], kh[7]);
            *(u32x4*)((bf16_t*)(lds + O_KH + dir * MSZ) + t * P + i0) = w;
            const u32x4 wq = *(const u32x4*)(ZQ + t * 64 + i0);
            float q[8] = {silu(bflo(wq.x)), silu(bfhi(wq.x)), silu(bflo(wq.y)), silu(bfhi(wq.y)), silu(bflo(wq.z)), silu(bfhi(wq.z)), silu(bflo(wq.w)), silu(bfhi(wq.w))};
            float qh[8], qt[8];
#pragma unroll
            for (int k = 0; k < 8; ++k) { qh[k] = q[k] * __expf(clampe(bc[k] - br[k])); qt[k] = q[k] * __expf(bc[k]); }
            w.x = cvtpk(qh[0], qh[1]); w.y = cvtpk(qh[2], qh[3]); w.z = cvtpk(qh[4], qh[5]); w.w = cvtpk(qh[6], qh[7]);
            *(u32x4*)((bf16_t*)(lds + O_QH + dir * MSZ) + t * P + i0) = w;
            w.x = cvtpk(qt[0], qt[1]); w.y = cvtpk(qt[2], qt[3]); w.z = cvtpk(qt[4], qt[5]); w.w = cvtpk(qt[6], qt[7]);
            *(u32x4*)((bf16_t*)(lds + O_QT + dir * MSZ) + t * P + i0) = w;
        }
    }
    __syncthreads();
}

__device__ __forceinline__ void h1_phase(unsigned char* lds, const bf16_t* __restrict__ PROJ, const float* __restrict__ LBFl, bf16_t* __restrict__ UT, float* __restrict__ DEC, int cu, int G) {
    const int tid = otid(), lane = tid & 63, r32 = lane & 31, hi = lane >> 5, w = __builtin_amdgcn_readfirstlane(tid >> 6);
    for (int u = cu; u < BATCH * NCH * 4; u += G) {
        const int h = u & 3, bc = u >> 2, b = bc / NCH, cp = bc - b * NCH, row0 = b * PB + cp * 64;
        prep<false>(lds, PROJ, LBFl, row0, h);
        const float* ZB = (const float*)(lds + O_ZB);
        {
            const int dir = w >> 2, jb = (w >> 1) & 1, ib = w & 1;
            const bf16_t* VT = (const bf16_t*)(lds + O_VT) + (jb * 32 + r32) * P + hi * 8;
            const bf16_t* KT = (const bf16_t*)(lds + O_KH + dir * MSZ) + (ib * 32 + r32) * P + hi * 8;
            f32x16 acc = {};
#pragma unroll
            for (int ks = 0; ks < 4; ++ks) acc = __builtin_amdgcn_mfma_f32_32x32x16_bf16(*(const bf16x8*)(VT + ks * 16), *(const bf16x8*)(KT + ks * 16), acc, 0, 0, 0);
            const int i = ib * 32 + r32;
            const float btot = ZB[dir * 4096 + (dir == 0 ? 63 : 0) * 64 + i], bref = ZB[dir * 4096 + (dir == 0 ? 31 : 32) * 64 + i];
            const float sc = __expf(btot - bref);
            const int chain = (b * 4 + h) * 2 + dir;
            bf16_t* ut = UT + ((size_t)chain * NCH + cp) * 4096 + i;
#pragma unroll
            for (int r = 0; r < 16; ++r) ut[(jb * 32 + crow(r, hi)) * 64] = (bf16_t)f2bf(acc[r] * sc);
        }
        if (tid < 128) { const int dir = tid >> 6, i = tid & 63; const int chain = (b * 4 + h) * 2 + dir;
            DEC[((size_t)chain * NCH + cp) * 64 + i] = __expf(ZB[dir * 4096 + (dir == 0 ? 63 : 0) * 64 + i]); }
        __syncthreads();
    }
}

__device__ __forceinline__ void h2_phase(unsigned char* lds, const bf16_t* __restrict__ UT, const float* __restrict__ DEC, bf16_t* __restrict__ ST, int cu, int G) {
    const int tid = otid(), seg = tid >> 7, e = tid & 127, jl = e >> 5, i = (e & 31) * 2;
    f32x4* TOT = (f32x4*)(lds + O_TOT);
    for (int task = cu; task < 256; task += G) {
        const int chain = task >> 4, j = (task & 15) * 4 + jl, dir = chain & 1;
        const size_t cbase = (size_t)chain * NCH;
        float S0 = 0.f, S1 = 0.f, P0 = 1.f, P1 = 1.f;
#pragma unroll 11
        for (int kk = 0; kk < 33; ++kk) { const int k = seg * 33 + kk, cp = dir == 0 ? k : (k < 4 ? 3 - k : 135 - k);
            const unsigned u = *(const unsigned*)(UT + (cbase + cp) * 4096 + j * 64 + i); const f32x2 d = *(const f32x2*)(DEC + (cbase + cp) * 64 + i);
            S0 = d.x * S0 + bflo(u); S1 = d.y * S1 + bfhi(u); P0 *= d.x; P1 *= d.y; }
        TOT[seg * 128 + e] = (f32x4){S0, S1, P0, P1};
        __syncthreads();
        float s0 = 0.f, s1 = 0.f;
#pragma unroll
        for (int sp = 0; sp < 3; ++sp) if (sp < seg) { const f32x4 t = TOT[sp * 128 + e]; s0 = t.z * s0 + t.x; s1 = t.w * s1 + t.y; }
#pragma unroll 11
        for (int kk = 0; kk < 33; ++kk) { const int k = seg * 33 + kk, cp = dir == 0 ? k : (k < 4 ? 3 - k : 135 - k);
            const unsigned u = *(const unsigned*)(UT + (cbase + cp) * 4096 + j * 64 + i); const f32x2 d = *(const f32x2*)(DEC + (cbase + cp) * 64 + i);
            *(unsigned*)(ST + (cbase + cp) * 4096 + j * 64 + i) = pk2(s0, s1);
            s0 = d.x * s0 + bflo(u); s1 = d.y * s1 + bfhi(u); }
        __syncthreads();
    }
}

__device__ __forceinline__ void h3_phase(unsigned char* lds, const bf16_t* __restrict__ PROJ, const float* __restrict__ LBFl, const bf16_t* __restrict__ ST, const float* __restrict__ ng, bf16_t* __restrict__ MIX, int cu, int G) {
    const int tid = otid(), lane = tid & 63, r32 = lane & 31, hi = lane >> 5, w = __builtin_amdgcn_readfirstlane(tid >> 6);
    for (int u = cu; u < BATCH * NCH * 4; u += G) {
        const int h = u & 3, bc = u >> 2, b = bc / NCH, cp = bc - b * NCH, row0 = b * PB + cp * 64;
        {
            const int j = tid >> 3, ic = (tid & 7) * 8;
#pragma unroll
            for (int dir = 0; dir < 2; ++dir) { const int chain = (b * 4 + h) * 2 + dir;
                const u32x4 sv = *(const u32x4*)(ST + ((size_t)chain * NCH + cp) * 4096 + j * 64 + ic);
                *(u32x4*)((bf16_t*)(lds + O_ST + dir * MSZ) + j * P + ic) = sv; }
        }
        prep<true>(lds, PROJ, LBFl, row0, h);
        float* SSQ = (float*)(lds + O_SSQ); bf16_t* OUT = (bf16_t*)(lds + O_OUT);
        f32x16 ot = {};
        const int jb = (w >> 1) & 1, tb = w & 1;
        if (w < 4) {
            const bf16_t* VT = (const bf16_t*)(lds + O_VT) + (jb * 32 + r32) * P;
#pragma unroll
            for (int sb = 0; sb < 2; ++sb) {
                f32x16 xf = {}, xb = {};
                const bf16_t* QF = (const bf16_t*)(lds + O_QH) + (tb * 32 + r32) * P + hi * 8; const bf16_t* QB = QF + 64 * P;
                const bf16_t* KF = (const bf16_t*)(lds + O_KH) + (sb * 32 + r32) * P + hi * 8; const bf16_t* KB = KF + 64 * P;
                if (sb <= tb) {
#pragma unroll
                    for (int ks = 0; ks < 4; ++ks) xf = __builtin_amdgcn_mfma_f32_32x32x16_bf16(*(const bf16x8*)(KF + ks * 16), *(const bf16x8*)(QF + ks * 16), xf, 0, 0, 0); }
                if (sb >= tb) {
#pragma unroll
                    for (int ks = 0; ks < 4; ++ks) xb = __builtin_amdgcn_mfma_f32_32x32x16_bf16(*(const bf16x8*)(KB + ks * 16), *(const bf16x8*)(QB + ks * 16), xb, 0, 0, 0); }
                float x[16];
#pragma unroll
                for (int r = 0; r < 16; ++r) { const int s = crow(r, hi), t = r32;
                    const float vf = (sb < tb || (sb == tb && s <= t)) ? xf[r] : 0.f, vb = (sb > tb || (sb == tb && s >= t)) ? xb[r] : 0.f; x[r] = vf + vb; }
#pragma unroll
                for (int sp = 0; sp < 2; ++sp) {
                    u32x4 xw; xw.x = cvtpk(x[8 * sp + 0], x[8 * sp + 1]); xw.y = cvtpk(x[8 * sp + 2], x[8 * sp + 3]); xw.z = cvtpk(x[8 * sp + 4], x[8 * sp + 5]); xw.w = cvtpk(x[8 * sp + 6], x[8 * sp + 7]);
                    const s16x4 v0 = *(const s16x4*)(VT + sb * 32 + 16 * sp + 4 * hi), v1 = *(const s16x4*)(VT + sb * 32 + 16 * sp + 8 + 4 * hi);
                    const bf16x8 va = {v0[0], v0[1], v0[2], v0[3], v1[0], v1[1], v1[2], v1[3]};
                    ot = __builtin_amdgcn_mfma_f32_32x32x16_bf16(va, __builtin_bit_cast(bf16x8, xw), ot, 0, 0, 0); }
            }
#pragma unroll
            for (int dir = 0; dir < 2; ++dir) {
                const bf16_t* SA = (const bf16_t*)(lds + O_ST + dir * MSZ) + (jb * 32 + r32) * P + hi * 8; const bf16_t* QT = (const bf16_t*)(lds + O_QT + dir * MSZ) + (tb * 32 + r32) * P + hi * 8;
#pragma unroll
                for (int ks = 0; ks < 4; ++ks) ot = __builtin_amdgcn_mfma_f32_32x32x16_bf16(*(const bf16x8*)(SA + ks * 16), *(const bf16x8*)(QT + ks * 16), ot, 0, 0, 0); }
            float part = 0.f;
#pragma unroll
            for (int r = 0; r < 16; ++r) part += ot[r] * ot[r];
            part = xsum<32>(part);
            if (hi == 0) SSQ[jb * 64 + tb * 32 + r32] = part;
        }
        __syncthreads();
        if (w < 4) { const int t = tb * 32 + r32; const float rstd = 1.f / sqrtf((SSQ[t] + SSQ[64 + t]) * (1.f / 64.f) + EPS);
#pragma unroll
            for (int r = 0; r < 16; ++r) { const int j = jb * 32 + crow(r, hi); OUT[t * P + j] = (bf16_t)f2bf(ot[r] * rstd * ng[j]); } }
        __syncthreads();
        {
            const int t = tid >> 3, jc = (tid & 7) * 8;
            const u32x4 y = *(const u32x4*)(OUT + t * P + jc); const u32x4 g = *(const u32x4*)(PROJ + (size_t)(row0 + t) * NIN + C_AG + h * 64 + jc);
            u32x4 o; o.x = pk2(bflo(y.x) * silu(bflo(g.x)), bfhi(y.x) * silu(bfhi(g.x))); o.y = pk2(bflo(y.y) * silu(bflo(g.y)), bfhi(y.y) * silu(bfhi(g.y)));
            o.z = pk2(bflo(y.z) * silu(bflo(g.z)), bfhi(y.z) * silu(bfhi(g.z))); o.w = pk2(bflo(y.w) * silu(bflo(g.w)), bfhi(y.w) * silu(bfhi(g.w)));
            *(u32x4*)(MIX + (size_t)(row0 + t) * D + h * 64 + jc) = o;
        }
        __syncthreads();
    }
}
}
__device__ __forceinline__ int vcu_of(int bx, int G) { return (G % 8 == 0) ? (bx % 8) * (G / 8) + bx / 8 : bx; }
__device__ __forceinline__ void attn_phase(char* lds, const bf16_t* QN, const bf16_t* KN, const bf16_t* PROJ, bf16_t* MIX, float neg_ref, int vcu, int G, bool with_ctx) {
    using attn_body::bf16;
    const int upc = (512 + G - 1) / G;
    const int nun = upc + ((with_ctx && vcu < 16) ? 1 : 0);
    for (int i = 0; i < nun; ++i) {
        int b, h, nt; size_t q0;
        if (i < upc) { const int u = vcu * upc + i; if (u >= 512) continue; const int combo = u >> 7; b = combo >> 1; h = (combo & 1) * 4 + ((u >> 5) & 3); q0 = (size_t)b * PB + CTXL + (size_t)(u & 31) * 256; nt = PB / 64; }
        else { b = vcu >> 3; h = vcu & 7; q0 = (size_t)b * PB; nt = CTXL / 64; }
        const int kvh = h >> 2; const size_t k0 = (size_t)b * PB;
        attn_body::attn_unit((const bf16*)QN + q0 * 512 + h * 64, (const bf16*)KN + k0 * 128 + kvh * 64, (const bf16*)PROJ + k0 * NIN + C_CV + kvh * 64, (bf16*)MIX + q0 * 1024 + 512 + h * 64, nt, neg_ref, lds);
    }
}
namespace pg8 {
struct EpiResid {
    static constexpr bool PERM = false, AFTER_DRAIN = false;
    const float* src_lat; const float* src_ctx; float* dst_lat; float* dst_ctx; const float* modv; int ga_off; int pad;
    __device__ __forceinline__ void operator()(const f32x4 (&acc)[2][2][4][2], const Unit& u, int wr, int wc, int fr, int fq) const {
        asm volatile("" : "+v"(fr), "+v"(fq));
        const int b = u.pm / TPB, w = u.pm - b * TPB;
        const size_t base = (w == 0) ? (size_t)b * CTXL * D : ((size_t)b * SEQ + (size_t)(w - 1) * 256) * D;
        const float* s = ((w == 0) ? src_ctx : src_lat) + base; float* d = ((w == 0) ? dst_ctx : dst_lat) + base;
        const float* ga = modv + ((w == 0) ? 2 : b) * 6144 + ga_off;
        const int row0 = wr * 64 + fr, col0 = u.pn * BM + wc * 32 + 4 * fq;
        f32x4 gv[2][2];
#pragma unroll
        for (int bj = 0; bj < 2; ++bj)
#pragma unroll
            for (int n = 0; n < 2; ++n) gv[bj][n] = *(const f32x4*)(ga + col0 + bj * HALF + n * 16);
#pragma unroll
        for (int ai = 0; ai < 2; ++ai)
#pragma unroll
            for (int m = 0; m < 4; ++m) { const size_t off = (size_t)(row0 + ai * HALF + m * 16) * D + col0;
#pragma unroll
                for (int bj = 0; bj < 2; ++bj)
#pragma unroll
                    for (int n = 0; n < 2; ++n) *(f32x4*)(d + off + bj * HALF + n * 16) = *(const f32x4*)(s + off + bj * HALF + n * 16) + gv[bj][n] * acc[ai][bj][m][n]; }
    }
};
struct OutOrder : StaticOrder {
    int lat_only;
    __device__ __forceinline__ bool next(int i, Unit& u) const { if (!StaticOrder::next(i, u)) return false; if (lat_only) u.pm = (u.pm >> 5) * TPB + 1 + (u.pm & 31); return true; }
};
}


namespace pg8 {
struct MUnit { int pm, pn, nrows, lbase, e0, e1; };
__device__ __forceinline__ void build_tiles(PG8_LAS int* TT, const unsigned* cnt) {
    if (otid() == 0) { int off = 0;
        for (int bk = 0; bk < 24; ++bk) { const int c = (int)__hip_atomic_load(cnt + bk, __ATOMIC_RELAXED, __HIP_MEMORY_SCOPE_AGENT); const int nb = (c + 255) >> 8;
            for (int ti = 0; ti < nb; ++ti) { const int rem = c - ti * 256; TT[4 + 4 * off + 0] = bk; TT[4 + 4 * off + 1] = ti; TT[4 + 4 * off + 2] = rem < 256 ? rem : 256; TT[4 + 4 * off + 3] = 0; ++off; } }
        TT[0] = off; }
    __syncthreads();
}
template <int NPN  > struct MoeOrder {
    const PG8_LAS int* TT; int G, c;
    __device__ __forceinline__ bool next(int i, MUnit& u) const {
        const int L = i * G + c, tile = L / NPN; if (tile >= TT[0]) return false;
        const int bk = TT[4 + 4 * tile], ti = TT[4 + 4 * tile + 1];
        u.pm = tile; u.pn = L - tile * NPN; u.nrows = TT[4 + 4 * tile + 2]; u.lbase = bk * MT + ti * 256;
        const int g = bk / 6, pi = bk - g * 6; const int lo = pi < 3 ? 0 : (pi < 5 ? 1 : 2), hi = pi < 3 ? pi + 1 : (pi < 5 ? pi - 1 : 3);
        u.e0 = 4 * g + lo; u.e1 = 4 * g + hi; return true;
    }
};
struct Src1 {
    const bf16_t* XN; const bf16_t* WGU; const u32x4* LIST;
    __device__ __forceinline__ const char* a_base(const MUnit&) const { return (const char*)XN; }
    __device__ __forceinline__ void a_offsets(const MUnit& u, const int (&RA)[2], const int (&CA)[2], unsigned (&ao)[2][2]) const {
#pragma unroll
        for (int h = 0; h < 2; ++h)
#pragma unroll
            for (int i = 0; i < 2; ++i) { const int r = h * HALF + RA[i]; const unsigned row = r < u.nrows ? LIST[u.lbase + r].x : 0u; ao[h][i] = (row * (unsigned)D + (unsigned)CA[i]) * 2u; }
    }
    __device__ __forceinline__ const char* b_base(const MUnit& u, int seg) const { const int e = (u.pn >> 2) ? u.e1 : u.e0;
        return (const char*)(WGU + ((size_t)e * 1024 + (size_t)(u.pn & 3) * 256) * D) + (seg ? (size_t)(D / 2) * 2 : 0); }
    __device__ __forceinline__ void prefetch_rows(const MUnit& u, const int (&)[2], PG8_LAS unsigned char* rows, int wid) const {
        int t2 = otid(); asm volatile("" : "+v"(t2));
        int RA[2];
#pragma unroll
        for (int i = 0; i < 2; ++i) { int R, C; stage_rc(t2 * 16 + i * 8192, R, C); RA[i] = R; }
#pragma unroll
        for (int h = 0; h < 2; ++h)
#pragma unroll
            for (int i = 0; i < 2; ++i) { const int r = h * HALF + RA[i];
                __builtin_amdgcn_global_load_lds((const unsigned*)&LIST[u.lbase + r], (PG8_LAS unsigned*)(rows + ((h * 2 + i) * 8 + wid) * 256), 4, 0, 0); }
    }
    __device__ __forceinline__ void reload_offsets(const MUnit& u, const int (&)[2], const int (&)[2], const PG8_LAS unsigned char* rows, int wid, int lane, unsigned (&ao)[2][2]) const {
        int t2 = otid(); asm volatile("" : "+v"(t2));
        int RA[2], CA[2];
#pragma unroll
        for (int i = 0; i < 2; ++i) { int R, C; stage_rc(t2 * 16 + i * 8192, R, C); RA[i] = R; CA[i] = C; }
#pragma unroll
        for (int h = 0; h < 2; ++h)
#pragma unroll
            for (int i = 0; i < 2; ++i) { const int r = h * HALF + RA[i]; const unsigned v = *(const PG8_LAS unsigned*)(rows + ((h * 2 + i) * 8 + wid) * 256 + lane * 4);
                const unsigned row = r < u.nrows ? v : 0u; ao[h][i] = (row * (unsigned)D + (unsigned)CA[i]) * 2u; }
    }
};
struct Src2 {
    const bf16_t* ACT2; const bf16_t* WD;
    __device__ __forceinline__ const char* a_base(const MUnit& u) const { return (const char*)(ACT2 + (size_t)u.pm * 256 * 1024); }
    __device__ __forceinline__ void a_offsets(const MUnit&, const int (&RA)[2], const int (&CA)[2], unsigned (&ao)[2][2]) const {
#pragma unroll
        for (int h = 0; h < 2; ++h)
#pragma unroll
            for (int i = 0; i < 2; ++i) ao[h][i] = (unsigned)((h * HALF + RA[i]) * 1024 + CA[i]) * 2u;
    }
    __device__ __forceinline__ const char* b_base(const MUnit& u, int seg) const { const int e = seg ? u.e1 : u.e0; return (const char*)(WD + ((size_t)e * 1024 + (size_t)u.pn * 256) * DE); }
    __device__ __forceinline__ void prefetch_rows(const MUnit&, const int (&)[2], PG8_LAS unsigned char*, int) const {}
    __device__ __forceinline__ void reload_offsets(const MUnit&, const int (&)[2], const int (&)[2], const PG8_LAS unsigned char*, int, int, unsigned (&)[2][2]) const {}
};
struct EpiGateUp2 {
    static constexpr bool PERM = true;
    bf16_t* ACT2; const u32x4* LIST;
    __device__ __forceinline__ void operator()(const f32x4 (&acc)[2][2][4][2], const MUnit& u, int wr, int wc, int fr, int fq) const {
        asm volatile("" : "+v"(fr), "+v"(fq));
        const int slot = u.pn >> 2, colA = slot * DE + (u.pn & 3) * HALF + wc * 32 + 8 * fq;
        const unsigned* lw = (const unsigned*)(LIST + u.lbase + wr * 64 + fr) + 1 + slot;
#pragma unroll
        for (int ai = 0; ai < 2; ++ai) {
            unsigned wv[4];
#pragma unroll
            for (int m = 0; m < 4; ++m) wv[m] = lw[(ai * HALF + m * 16) * 4];
#pragma unroll
            for (int m = 0; m < 4; ++m) { const int r = ai * HALF + wr * 64 + m * 16 + fr;
                const bool valid = r < u.nrows; const float cw = valid ? __uint_as_float(wv[m]) : 0.f;
                const f32x4 g0 = acc[ai][0][m][0], g1 = acc[ai][0][m][1], u0 = acc[ai][1][m][0], u1 = acc[ai][1][m][1];
                u32x4 w;
                w.x = cvt_pk_bf16(silu(g0[0]) * u0[0] * cw, silu(g0[1]) * u0[1] * cw); w.y = cvt_pk_bf16(silu(g0[2]) * u0[2] * cw, silu(g0[3]) * u0[3] * cw);
                w.z = cvt_pk_bf16(silu(g1[0]) * u1[0] * cw, silu(g1[1]) * u1[1] * cw); w.w = cvt_pk_bf16(silu(g1[2]) * u1[2] * cw, silu(g1[3]) * u1[3] * cw);
                if (!valid) w = (u32x4){0u, 0u, 0u, 0u};
                *(u32x4*)(ACT2 + ((size_t)u.pm * 256 + r) * 1024 + colA) = w; }
            asm volatile("" ::: "memory"); }
    }
};
struct EpiMoeOut {
    static constexpr bool PERM = false;
    float* lat; float* ctx; const float* modv; const u32x4* LIST;
    __device__ __forceinline__ void operator()(const f32x4 (&acc)[2][2][4][2], const MUnit& u, int wr, int wc, int fr, int fq) const {
        asm volatile("" : "+v"(fr), "+v"(fq));
        const int col0 = u.pn * BM + wc * 32 + 4 * fq;
        const unsigned* lw = (const unsigned*)(LIST + u.lbase + wr * 64 + fr);
        unsigned rv[2][4];
#pragma unroll
        for (int ai = 0; ai < 2; ++ai)
#pragma unroll
            for (int m = 0; m < 4; ++m) rv[ai][m] = lw[(ai * HALF + m * 16) * 4];
#pragma unroll
        for (int ai = 0; ai < 2; ++ai)
#pragma unroll
            for (int m = 0; m < 4; ++m) { const int r = ai * HALF + wr * 64 + m * 16 + fr;
                if (r < u.nrows) { const int row = (int)rv[ai][m]; bool is_ctx; const size_t off = stream_off(row, is_ctx);
                    float* d = (is_ctx ? ctx : lat) + off + col0; const float* ga = modv + (is_ctx ? 2 : row / PB) * 6144 + 5120 + col0;
#pragma unroll
                    for (int bj = 0; bj < 2; ++bj)
#pragma unroll
                        for (int n = 0; n < 2; ++n) { f32x4* p = (f32x4*)(d + bj * HALF + n * 16); *p = *p + *(const f32x4*)(ga + bj * HALF + n * 16) * acc[ai][bj][m][n]; } } }
    }
};

template <class Epi, class Sched, class Src>
__device__ __forceinline__ void gemm_phase_x(PG8_LAS unsigned char* lds, PG8_LAS unsigned char* rows, const Sched& S, const Src& X, const Epi& E, const int KB, const int nt) {
    const int tid = otid(), wid = __builtin_amdgcn_readfirstlane(tid >> 6), lane = tid & 63, wr = wid >> 2, wc = wid & 3, fr = lane & 15, fq = lane >> 4;
    int RA[2], CA[2]; unsigned voffB[2];
#pragma unroll
    for (int i = 0; i < 2; ++i) { int R, C; stage_rc(tid * 16 + i * 8192, R, C); const int Rb = Epi::PERM ? ((R & ~31) + perm32(R & 31)) : R; RA[i] = R; CA[i] = C; voffB[i] = (unsigned)(Rb * KB + C) * 2u; }
    const size_t kstep = (size_t)(BK * 2);
    const size_t hstepB = (size_t)HALF * KB * 2;
    const int half = nt >> 1;
    const unsigned ldsw = (unsigned)wid * 1024u;
    const int aoff = lds_byte(wr * 64 + fr, fq * 8), boff = lds_byte(wc * 32 + fr, fq * 8);
#define PG8_SA(b, h) (((b) * 2 + (h)) * HTB)
#define PG8_SB(b, h) ((4 + (b) * 2 + (h)) * HTB)
#define PG8_STAGE_B(bufoff, gbase) do { _Pragma("unroll") for (int _i = 0; _i < 2; ++_i) \
        __builtin_amdgcn_global_load_lds((const unsigned*)((const char*)(gbase) + voffB[_i]), (PG8_LAS unsigned*)(lds + (bufoff) + ldsw + _i * 8192), 16, 0, 0); } while (0)
#define PG8_STAGE_A(bufoff, gbase, o0, o1) do { \
        __builtin_amdgcn_global_load_lds((const unsigned*)((const char*)(gbase) + (o0)), (PG8_LAS unsigned*)(lds + (bufoff) + ldsw), 16, 0, 0); \
        __builtin_amdgcn_global_load_lds((const unsigned*)((const char*)(gbase) + (o1)), (PG8_LAS unsigned*)(lds + (bufoff) + ldsw + 8192), 16, 0, 0); } while (0)
#define PG8_LDA(dst, b, h) do { _Pragma("unroll") for (int m = 0; m < 4; ++m) _Pragma("unroll") for (int k = 0; k < 2; ++k) dst[m][k] = *(const PG8_LAS bf16x8*)(lds + PG8_SA(b, h) + aoff + m * 2048 + k * 1024); } while (0)
#define PG8_LDB(dst, b, h) do { _Pragma("unroll") for (int n = 0; n < 2; ++n) _Pragma("unroll") for (int k = 0; k < 2; ++k) dst[n][k] = *(const PG8_LAS bf16x8*)(lds + PG8_SB(b, h) + boff + n * 2048 + k * 1024); } while (0)
#define PG8_MMA(ai, bj, At, Bt) do { __builtin_amdgcn_s_setprio(1); _Pragma("unroll") for (int m = 0; m < 4; ++m) _Pragma("unroll") for (int n = 0; n < 2; ++n) _Pragma("unroll") for (int k = 0; k < 2; ++k) \
        acc[ai][bj][m][n] = __builtin_amdgcn_mfma_f32_16x16x32_bf16(Bt[n][k], At[m][k], acc[ai][bj][m][n], 0, 0, 0); __builtin_amdgcn_s_setprio(0); } while (0)
#define PG8_WAIT_V(n) asm volatile("s_waitcnt vmcnt(" #n ")" ::: "memory")
#define PG8_WAIT_L(n) asm volatile("s_waitcnt lgkmcnt(" #n ")" ::: "memory")
#define PG8_BAR __builtin_amdgcn_s_barrier()
#define PG8_SCHED __builtin_amdgcn_sched_barrier(0)
    MUnit cur, nxt; int ui = 0;
    if (!S.next(0, cur)) return;
    f32x4 acc[2][2][4][2];
#pragma unroll
    for (int a = 0; a < 2; ++a)
#pragma unroll
        for (int b = 0; b < 2; ++b)
#pragma unroll
            for (int m = 0; m < 4; ++m)
#pragma unroll
                for (int n = 0; n < 2; ++n) acc[a][b][m][n] = (f32x4){0.f, 0.f, 0.f, 0.f};
    bf16x8 At[4][2], B0[2][2], B1[2][2];
    unsigned aoc[2][2];
    X.a_offsets(cur, RA, CA, aoc);
    const char* cAb = X.a_base(cur); const char* cB0 = X.b_base(cur, 0); const char* cB1 = X.b_base(cur, 1);
    PG8_STAGE_B(PG8_SB(0, 0), cB0); PG8_STAGE_B(PG8_SB(0, 1), cB0 + hstepB); PG8_STAGE_A(PG8_SA(0, 0), cAb, aoc[0][0], aoc[0][1]); PG8_STAGE_A(PG8_SA(0, 1), cAb, aoc[1][0], aoc[1][1]);
    if (wr == 1) PG8_BAR;
    PG8_WAIT_V(2); PG8_BAR;
    PG8_STAGE_B(PG8_SB(1, 0), cB0 + kstep); PG8_STAGE_A(PG8_SA(1, 0), cAb + kstep, aoc[0][0], aoc[0][1]); PG8_STAGE_B(PG8_SB(1, 1), cB0 + hstepB + kstep);
    PG8_WAIT_V(6); PG8_BAR;
    for (;;) {
        const bool has_next = S.next(ui + 1, nxt);
        const char* nAb = cAb; const char* nB0 = cB0; const char* nB1 = cB1;
        if (has_next) { X.prefetch_rows(nxt, RA, rows, wid); nAb = X.a_base(nxt); nB0 = X.b_base(nxt, 0); nB1 = X.b_base(nxt, 1); }
        for (int t = 0; t < nt; t += 2) {
            const bool last = (t == nt - 2);
            const char* a1 = cAb + (size_t)(t + 1) * kstep;
            const int kt2 = t + 2;
            const char* b2 = last ? nB0 : (kt2 < half ? cB0 + (size_t)kt2 * kstep : cB1 + (size_t)(kt2 - half) * kstep);
            const char* a2 = last ? nAb : cAb + (size_t)kt2 * kstep;
            const char* a3 = a2 + kstep; const char* b3 = b2 + kstep;
            PG8_LDB(B0, 0, 0); PG8_LDB(B1, 0, 1); PG8_SCHED; PG8_LDA(At, 0, 0); PG8_STAGE_A(PG8_SA(1, 1), a1, aoc[1][0], aoc[1][1]);
            if (last && has_next) X.reload_offsets(nxt, RA, CA, rows, wid, lane, aoc);
            PG8_WAIT_V(8); PG8_WAIT_L(0); PG8_BAR; PG8_MMA(0, 0, At, B0); PG8_MMA(0, 1, At, B1); PG8_BAR; PG8_SCHED;
            PG8_LDA(At, 0, 1); PG8_STAGE_B(PG8_SB(0, 0), b2); PG8_STAGE_B(PG8_SB(0, 1), b2 + hstepB); PG8_STAGE_A(PG8_SA(0, 0), a2, aoc[0][0], aoc[0][1]);
            PG8_WAIT_V(8); PG8_WAIT_L(0); PG8_BAR; PG8_MMA(1, 0, At, B0); PG8_MMA(1, 1, At, B1); PG8_BAR; PG8_SCHED;
            PG8_LDB(B0, 1, 0); PG8_LDB(B1, 1, 1); PG8_SCHED; PG8_LDA(At, 1, 0); PG8_STAGE_A(PG8_SA(0, 1), a2, aoc[1][0], aoc[1][1]);
            PG8_WAIT_V(8); PG8_WAIT_L(0); PG8_BAR; PG8_MMA(0, 0, At, B0); PG8_MMA(0, 1, At, B1); PG8_BAR; PG8_SCHED;
            PG8_LDA(At, 1, 1); PG8_STAGE_B(PG8_SB(1, 0), b3); PG8_STAGE_B(PG8_SB(1, 1), b3 + hstepB); PG8_STAGE_A(PG8_SA(1, 0), a3, aoc[0][0], aoc[0][1]);
            PG8_WAIT_V(8); PG8_WAIT_L(0); PG8_BAR; PG8_MMA(1, 0, At, B0); PG8_MMA(1, 1, At, B1); PG8_BAR; PG8_SCHED;
        }
        if (wr == 0) PG8_BAR;
        E(acc, cur, wr, wc, fr, fq);
        if (!has_next) break;
#pragma unroll
        for (int a = 0; a < 2; ++a)
#pragma unroll
            for (int b = 0; b < 2; ++b)
#pragma unroll
                for (int m = 0; m < 4; ++m)
#pragma unroll
                    for (int n = 0; n < 2; ++n) acc[a][b][m][n] = (f32x4){0.f, 0.f, 0.f, 0.f};
        cur = nxt; cAb = nAb; cB0 = nB0; cB1 = nB1; ++ui;
        if (wr == 1) PG8_BAR;
    }
    PG8_WAIT_V(0);
    PG8_BAR;
#undef PG8_SA
#undef PG8_SB
#undef PG8_STAGE_A
#undef PG8_STAGE_B
#undef PG8_LDA
#undef PG8_LDB
#undef PG8_MMA
#undef PG8_WAIT_V
#undef PG8_WAIT_L
#undef PG8_BAR
#undef PG8_SCHED
}
}

constexpr int TT_OFF = 132096;
constexpr int ROWS_OFF = 134144;

#define XB_TMO      128
#define XB_XCNT(j)  (256  + 64 * (j))
#define XB_XSUB(j)  (1280 + 64 * (j))
#define XB_XGEN(j)  (2304 + 64 * (j))
#define XB_TOP      3328
#define XB_TOPGEN   3392
#define XCD_BAR_WORDS 3456
#define XB_SPIN_CAP (1u << 18)

__device__ __forceinline__ unsigned xb_ld(unsigned* p)              { return __hip_atomic_load(p, __ATOMIC_RELAXED, __HIP_MEMORY_SCOPE_AGENT); }
__device__ __forceinline__ unsigned xb_add(unsigned* p, unsigned v) { return __hip_atomic_fetch_add(p, v, __ATOMIC_RELAXED, __HIP_MEMORY_SCOPE_AGENT); }
__device__ __forceinline__ unsigned xb_xcc_id() { return (unsigned)__builtin_amdgcn_s_getreg((3 << 11) | 20) & 0xFu; }
#define XB_SPIN(cond, bar) do { unsigned _sp = 0; while (cond) { __builtin_amdgcn_s_sleep(1); \
    if ((++_sp & 255u) == 0u) { if (xb_ld(&(bar)[XB_TMO])) break; if (_sp > XB_SPIN_CAP) { atomicAdd(&(bar)[XB_TMO], 1u); break; } } } } while (0)

struct XcdBarrier {
    unsigned* bar; unsigned x;
    volatile LAS unsigned* st;
};

__device__ __forceinline__ XcdBarrier xcd_barrier_post(unsigned* bar, volatile LAS unsigned* st) {
    XcdBarrier b; b.bar = bar; b.x = xb_xcc_id(); b.st = st;
    if (threadIdx.x == 0) (void)xb_add(&bar[XB_XCNT(b.x)], 1u);
    return b;
}
__device__ __forceinline__ void xcd_barrier_complete(unsigned* bar, unsigned x, unsigned& nloc, unsigned& nx) {
    const unsigned G = gridDim.x * gridDim.y * gridDim.z;
    unsigned sum, cnt, mine, sp = 0u;
    for (;;) {
        sum = 0u; cnt = 0u; mine = 0u;
#pragma unroll
        for (unsigned j = 0; j < 16; ++j) { const unsigned c = xb_ld(&bar[XB_XCNT(j)]); sum += c; cnt += (c > 0u) ? 1u : 0u; mine = (j == x) ? c : mine; }
        if (sum == G) break;
        __builtin_amdgcn_s_sleep(1);
        if ((++sp & 255u) == 0u) { if (xb_ld(&bar[XB_TMO])) break; if (sp > XB_SPIN_CAP) { atomicAdd(&bar[XB_TMO], 1u); break; } }
    }
    nloc = mine > 0u ? mine : 1u; nx = cnt > 0u ? cnt : 1u;
}

__device__ __forceinline__ void xcd_barrier(const XcdBarrier& b) {
    asm volatile("s_waitcnt vmcnt(0)" ::: "memory");
    __syncthreads();
    if (threadIdx.x == 0) {
        unsigned* bar = b.bar;
        __builtin_amdgcn_s_waitcnt(0);
        unsigned nloc = b.st[0], nx = b.st[1];
        if (nloc == 0u) { xcd_barrier_complete(bar, b.x, nloc, nx); b.st[0] = nloc; b.st[1] = nx; }
        const unsigned old = xb_add(&bar[XB_XSUB(b.x)], 1u);
        const unsigned gen = old / nloc;
        if (old + 1u == (gen + 1u) * nloc) {
            __builtin_amdgcn_fence(__ATOMIC_RELEASE, "agent");
            asm volatile("s_waitcnt vmcnt(0)" ::: "memory");
            const unsigned og = xb_add(&bar[XB_TOP], 1u);
            const unsigned tg = og / nx;
            if (og + 1u == (tg + 1u) * nx) xb_add(&bar[XB_TOPGEN], 1u);
            else XB_SPIN(xb_ld(&bar[XB_TOPGEN]) == tg, bar);
            __builtin_amdgcn_fence(__ATOMIC_ACQUIRE, "agent");
            xb_add(&bar[XB_XGEN(b.x)], 1u);
            asm volatile("s_waitcnt vmcnt(0)" ::: "memory");
        } else {
            XB_SPIN(xb_ld(&bar[XB_XGEN(b.x)]) == gen, bar);
            __builtin_amdgcn_fence(__ATOMIC_ACQUIRE, "agent");
            asm volatile("s_waitcnt vmcnt(0)" ::: "memory");
        }
    }
    __syncthreads();
}

constexpr int LDS_BYTES = 147456;
constexpr int LDSCTL_OFF = 131072, MISC_OFF = LDSCTL_OFF + 320;
constexpr int CW_BAR = 4096;
constexpr int NPHASE = 1 + 9 * DEPTH;
#ifndef MK_SPLIT
#define MK_SPLIT 0
#endif
struct Args {
    const float *x, *c, *ctx, *c_ctx, *w_mod, *b_mod, *norm1_g, *norm2_g, *w_in, *w_out, *hgrn_lb, *hgrn_norm_g, *pool_w, *pool_scale, *q_norm_g, *k_norm_g, *router_w, *router_b, *moe_gate, *moe_up, *moe_down;
    float* out; unsigned char* ws; int ph_lo, ph_hi;
};
typedef const __attribute__((address_space(4))) Args* KArgs;
__device__ __forceinline__ KArgs kargs() { KArgs p = (KArgs)__builtin_amdgcn_kernarg_segment_ptr(); asm volatile("" : "+s"(p)); return p; }
__global__ void __launch_bounds__(512, 2) mega_fwd(Args A_unused) {
    extern __shared__ __attribute__((aligned(16))) unsigned char lds[];
    for (int u = otid(); u < (LDS_BYTES - LDSCTL_OFF) / 4; u += 512) ((LAS unsigned*)((LAS unsigned char*)lds + LDSCTL_OFF))[u] = 0u;
    __syncthreads();
    XcdBarrier bar;
    { KArgs ap = kargs(); unsigned* CTL = (unsigned*)(ap->ws + WS_CTL); bar.bar = CTL + CW_BAR; bar.x = 0; bar.st = nullptr;
      if (!MK_SPLIT) bar = xcd_barrier_post(CTL + CW_BAR, (volatile LAS unsigned*)((LAS unsigned char*)lds + MISC_OFF) + 8); }
    int lo, hi; { KArgs ap = kargs(); lo = ap->ph_lo; hi = ap->ph_hi; }
#ifndef PHMASK
#define PHMASK 0x3ff
#endif
#define IN(k) (lo <= (k) && (k) < hi)
#define SEAM(k) do { if (!MK_SPLIT && IN((k) + 1)) xcd_barrier(bar); } while (0)
#define GCU const int G = (int)gridDim.x, cu = (int)blockIdx.x
#ifndef DUPMASK
#define DUPMASK 0
#endif
    LAS unsigned char* ldsl = (LAS unsigned char*)lds;
    if ((PHMASK & 0x200) && IN(0)) {
        _Pragma("unroll") for (int rep_ = 0; rep_ < ((((DUPMASK) & (0x200)) && true) ? 2 : 1); ++rep_) {
        KArgs ap = kargs(); unsigned char* ws = ap->ws; GCU;
        ProArgs pa; pa.c = ap->c; pa.c_ctx = ap->c_ctx; pa.w_mod = ap->w_mod; pa.b_mod = ap->b_mod; pa.hgrn_lb = ap->hgrn_lb; pa.qg = ap->q_norm_g; pa.kg = ap->k_norm_g; pa.w_in = ap->w_in; pa.w_out = ap->w_out; pa.pool_w = ap->pool_w;
        pa.gate = ap->moe_gate; pa.up = ap->moe_up; pa.down = ap->moe_down; pa.MODV = (float*)(ws + WS_MODV); pa.LBF = (float*)(ws + WS_LBF); pa.REF = (float*)(ws + WS_REF); pa.COS = (float*)(ws + WS_COS); pa.SIN = (float*)(ws + WS_SIN);
        pa.WIN = (bf16_t*)(ws + WS_WIN); pa.WOUT = (bf16_t*)(ws + WS_WOUT); pa.POOLWT = (bf16_t*)(ws + WS_POOLWT); pa.WGU = (bf16_t*)(ws + WS_WGU); pa.WD = (bf16_t*)(ws + WS_WD);
        prologue_phase(lds, pa, cu, G);
            if (rep_ + 1 < ((((DUPMASK) & (0x200)) && true) ? 2 : 1)) xcd_barrier(bar); }
        SEAM(0);
    }
    for (int l = 0; l < DEPTH; ++l) {
        const int pb = 1 + 9 * l;
        if ((PHMASK & 1) && IN(pb + 0)) {
        _Pragma("unroll") for (int rep_ = 0; rep_ < ((((DUPMASK) & (1)) && true) ? 2 : 1); ++rep_) {
            KArgs ap = kargs(); unsigned char* ws = ap->ws; GCU;
            const float* slat = (l == 0) ? ap->x : ap->out; const float* sctx = (l == 0) ? ap->ctx : (const float*)(ws + WS_XC);
            norm1_phase(cu, G, slat, sctx, ap->norm1_g + l * D, (const float*)(ws + WS_MODV) + (size_t)l * 3 * 6144, 0, (bf16_t*)(ws + WS_XN));
            if (rep_ + 1 < ((((DUPMASK) & (1)) && true) ? 2 : 1)) xcd_barrier(bar); }
            SEAM(pb + 0);
        }
        if ((PHMASK & 2) && IN(pb + 1)) {
        _Pragma("unroll") for (int rep_ = 0; rep_ < ((((DUPMASK) & (2)) && true) ? 2 : 1); ++rep_) {
            KArgs ap = kargs(); unsigned char* ws = ap->ws; GCU;
            pg8::Gemm g; g.A = (const bf16_t*)(ws + WS_XN); g.Bt = (const bf16_t*)(ws + WS_WIN) + (size_t)l * NIN * D; g.M = MT; g.N = NIN; g.K = D; g.pad = 0;
            pg8::StaticOrder S; S.init(MT, NIN, G, cu);
            pg8::EpiBf16<0> E; E.O = (bf16_t*)(ws + WS_PROJ); E.ldc = NIN; E.bias = nullptr; E.split_cols = 0; E.split_stride = 0; E.scale0 = 1.f;
            pg8::gemm_phase<pg8::EpiBf16<0>, pg8::StaticOrder, true, true>(ldsl, g, S, E);
            { KArgs aq = kargs(); if (l == 0) moe_filler(lds, aq->moe_gate, aq->moe_up, aq->moe_down, aq->ws, 0, 0, 5530, (MT / 256) * (NIN / 256), G, cu);
              else moe_filler(lds, aq->moe_gate, aq->moe_up, aq->moe_down, aq->ws, 1, 7986, MOE_ITEMS, (MT / 256) * (NIN / 256), G, cu); }
            if (rep_ + 1 < ((((DUPMASK) & (2)) && true) ? 2 : 1)) xcd_barrier(bar); }
            SEAM(pb + 1);
        }
        if ((PHMASK & 4) && IN(pb + 2)) {
        _Pragma("unroll") for (int rep_ = 0; rep_ < ((((DUPMASK) & (4)) && true) ? 2 : 1); ++rep_) {
            KArgs ap = kargs(); unsigned char* ws = ap->ws; GCU;
            const bf16_t* PROJ = (const bf16_t*)(ws + WS_PROJ);
            post_phase(cu, G, PROJ, ap->q_norm_g + l * 64, ap->k_norm_g + l * 64, (const float*)(ws + WS_COS), (const float*)(ws + WS_SIN), (bf16_t*)(ws + WS_QN), (bf16_t*)(ws + WS_KN));
            pool::pool_phase(lds, PROJ, (const bf16_t*)(ws + WS_POOLWT) + (size_t)l * 4 * 4096, ap->pool_scale + l * 256, (bf16_t*)(ws + WS_MIX), cu, G);
            hg::h1_phase(lds, PROJ, (const float*)(ws + WS_LBF) + l * 512, (bf16_t*)(ws + WS_UT), (float*)(ws + WS_DEC), cu, G);
            if (rep_ + 1 < ((((DUPMASK) & (4)) && true) ? 2 : 1)) xcd_barrier(bar); }
            SEAM(pb + 2);
        }
        if ((PHMASK & 8) && IN(pb + 3)) {
        _Pragma("unroll") for (int rep_ = 0; rep_ < ((((DUPMASK) & (8)) && true) ? 2 : 1); ++rep_) {
            KArgs ap = kargs(); unsigned char* ws = ap->ws; GCU; hg::h2_phase(lds, (const bf16_t*)(ws + WS_UT), (const float*)(ws + WS_DEC), (bf16_t*)(ws + WS_ST), cu, G);
            if (rep_ + 1 < ((((DUPMASK) & (8)) && true) ? 2 : 1)) xcd_barrier(bar); }
            SEAM(pb + 3);
        }
        if ((PHMASK & 16) && IN(pb + 4)) {
        _Pragma("unroll") for (int rep_ = 0; rep_ < ((((DUPMASK) & (16)) && true) ? 2 : 1); ++rep_) {
            { KArgs ap = kargs(); unsigned char* ws = ap->ws; GCU;
              attn_phase((char*)lds, (const bf16_t*)(ws + WS_QN), (const bf16_t*)(ws + WS_KN), (const bf16_t*)(ws + WS_PROJ), (bf16_t*)(ws + WS_MIX), ((const float*)(ws + WS_REF))[l * 64], vcu_of(cu, G), G, true); }
            { KArgs ap = kargs(); unsigned char* ws = ap->ws; GCU;
              hg::h3_phase(lds, (const bf16_t*)(ws + WS_PROJ), (const float*)(ws + WS_LBF) + l * 512, (const bf16_t*)(ws + WS_ST), ap->hgrn_norm_g + l * 64, (bf16_t*)(ws + WS_MIX), cu, G); }
            if (rep_ + 1 < ((((DUPMASK) & (16)) && true) ? 2 : 1)) xcd_barrier(bar); }
            SEAM(pb + 4);
        }
        if ((PHMASK & 32) && IN(pb + 5)) {
        _Pragma("unroll") for (int rep_ = 0; rep_ < ((((DUPMASK) & (32)) && (l == 0)) ? 2 : 1); ++rep_) {
            KArgs ap = kargs(); unsigned char* ws = ap->ws; GCU;
            pg8::Gemm g; g.A = (const bf16_t*)(ws + WS_MIX); g.Bt = (const bf16_t*)(ws + WS_WOUT) + (size_t)l * D * D; g.M = MT; g.N = D; g.K = D; g.pad = 0;
            pg8::OutOrder S; S.lat_only = (l == DEPTH - 1); S.init(S.lat_only ? BATCH * SEQ : MT, D, G, cu);
            pg8::EpiResid E; E.src_lat = (l == 0) ? ap->x : ap->out; E.src_ctx = (l == 0) ? ap->ctx : (const float*)(ws + WS_XC); E.dst_lat = ap->out; E.dst_ctx = (float*)(ws + WS_XC);
            E.modv = (const float*)(ws + WS_MODV) + (size_t)l * 3 * 6144; E.ga_off = 2048; E.pad = 0;
            pg8::gemm_phase<pg8::EpiResid, pg8::OutOrder, true, true>(ldsl, g, S, E);
            if (l == 0) { KArgs aq = kargs(); moe_filler(lds, aq->moe_gate, aq->moe_up, aq->moe_down, aq->ws, 0, 5530, MOE_ITEMS, (MT / 256) * (D / 256), G, cu); }
            if (rep_ + 1 < ((((DUPMASK) & (32)) && (l == 0)) ? 2 : 1)) xcd_barrier(bar); }
            SEAM(pb + 5);
        }
        if ((PHMASK & 64) && IN(pb + 6)) {
        _Pragma("unroll") for (int rep_ = 0; rep_ < ((((DUPMASK) & (64)) && true) ? 2 : 1); ++rep_) {
            KArgs ap = kargs(); unsigned char* ws = ap->ws; GCU;
            norm2_router_phase(lds, cu, G, ap->out, (const float*)(ws + WS_XC), ap->norm2_g + l * D, (const float*)(ws + WS_MODV) + (size_t)l * 3 * 6144, 3072, ap->router_w, ap->router_b, (bf16_t*)(ws + WS_XN),
                               (unsigned*)(ws + WS_CTL) + CW_CNT + 64 * l + 32 * rep_, (u32x4*)(ws + WS_LIST), l == 0 ? 1 : 0);
            if (rep_ + 1 < ((((DUPMASK) & (64)) && true) ? 2 : 1)) xcd_barrier(bar); }
            SEAM(pb + 6);
        }
        if ((PHMASK & 128) && IN(pb + 7)) {
        _Pragma("unroll") for (int rep_ = 0; rep_ < ((((DUPMASK) & (128)) && true) ? 2 : 1); ++rep_) {
            KArgs ap = kargs(); unsigned char* ws = ap->ws; GCU;
            LAS int* TT = (LAS int*)(ldsl + TT_OFF);
            pg8::build_tiles(TT, (const unsigned*)(ws + WS_CTL) + CW_CNT + 64 * l);
            pg8::MoeOrder<8> S; S.TT = TT; S.G = G; S.c = vcu_of(cu, G);
            pg8::Src1 X; X.XN = (const bf16_t*)(ws + WS_XN); X.WGU = (const bf16_t*)(ws + (l ? WS_WGU1 : WS_WGU)); X.LIST = (const u32x4*)(ws + WS_LIST); pg8::EpiGateUp2 E; E.ACT2 = (bf16_t*)(ws + WS_ACT2); E.LIST = X.LIST;
            pg8::gemm_phase_x(ldsl, ldsl + ROWS_OFF, S, X, E, D, D / 64);
            if (l == 0) { KArgs aq = kargs(); const int U = TT[0] * 8; moe_filler(lds, aq->moe_gate, aq->moe_up, aq->moe_down, aq->ws, 1, 0, 3686, U, G, vcu_of(cu, G)); }
            if (rep_ + 1 < ((((DUPMASK) & (128)) && true) ? 2 : 1)) xcd_barrier(bar); }
            SEAM(pb + 7);
        }
        if ((PHMASK & 256) && IN(pb + 8)) {
        _Pragma("unroll") for (int rep_ = 0; rep_ < ((((DUPMASK) & (256)) && true) ? 2 : 1); ++rep_) {
            KArgs ap = kargs(); unsigned char* ws = ap->ws; GCU;
            LAS int* TT = (LAS int*)(ldsl + TT_OFF);
            pg8::build_tiles(TT, (const unsigned*)(ws + WS_CTL) + CW_CNT + 64 * l);
            pg8::MoeOrder<4> S; S.TT = TT; S.G = G; S.c = vcu_of(cu, G);
            pg8::Src2 X; X.ACT2 = (const bf16_t*)(ws + WS_ACT2); X.WD = (const bf16_t*)(ws + (l ? WS_WD1 : WS_WD));
            pg8::EpiMoeOut E; E.lat = ap->out; E.ctx = (float*)(ws + WS_XC); E.modv = (const float*)(ws + WS_MODV) + (size_t)l * 3 * 6144; E.LIST = (const u32x4*)(ws + WS_LIST);
            pg8::gemm_phase_x(ldsl, ldsl + ROWS_OFF, S, X, E, DE, 1024 / 64);
            if (l == 0) { KArgs aq = kargs(); const int U = TT[0] * 4; moe_filler(lds, aq->moe_gate, aq->moe_up, aq->moe_down, aq->ws, 1, 3686, 7986, U, G, vcu_of(cu, G)); }
            if (rep_ + 1 < ((((DUPMASK) & (256)) && true) ? 2 : 1)) xcd_barrier(bar); }
            SEAM(pb + 8);
        }
    }
#undef IN
#undef SEAM
#undef GCU
}

extern "C" void kernel_launch(void* const* d_in, const int* in_sizes, int n_in, void* d_out, int out_size, void* d_ws, size_t ws_size, hipStream_t stream) {
    static int grid = 0;
    if (grid == 0) {
        if (n_in != 21 || in_sizes[0] != BATCH * SEQ * D || out_size != BATCH * SEQ * D || ws_size < WS_END) {
            fprintf(stderr, "kernel_launch: unexpected sizes: n_in %d in0 %d out %d ws %zu (need %zu)\n", n_in, n_in > 0 ? in_sizes[0] : -1, out_size, ws_size, (size_t)WS_END); grid = -1; return; }
        int dev = 0, cus = 0, per_cu = 0;
        if (hipGetDevice(&dev) != hipSuccess || hipDeviceGetAttribute(&cus, hipDeviceAttributeMultiprocessorCount, dev) != hipSuccess) { grid = -1; return; }
        if (hipFuncSetAttribute((const void*)mega_fwd, hipFuncAttributeMaxDynamicSharedMemorySize, LDS_BYTES) != hipSuccess) { fprintf(stderr, "kernel_launch: hipFuncSetAttribute failed\n"); grid = -1; return; }
        if (hipOccupancyMaxActiveBlocksPerMultiprocessor(&per_cu, (const void*)mega_fwd, 512, LDS_BYTES) != hipSuccess || per_cu < 1) fprintf(stderr, "kernel_launch: occupancy query reports %d\n", per_cu);
        (void)hipGetLastError();
        grid = cus;
    }
    if (grid < 0) return;
    if (hipMemsetAsync((char*)d_ws + WS_CTL, 0, 1 * MiB, stream) != hipSuccess) return;
    Args a; memset((void*)&a, 0, sizeof(a));
    a.x = (const float*)d_in[0]; a.c = (const float*)d_in[1]; a.ctx = (const float*)d_in[2]; a.c_ctx = (const float*)d_in[3]; a.w_mod = (const float*)d_in[4]; a.b_mod = (const float*)d_in[5];
    a.norm1_g = (const float*)d_in[6]; a.norm2_g = (const float*)d_in[7]; a.w_in = (const float*)d_in[8]; a.w_out = (const float*)d_in[9]; a.hgrn_lb = (const float*)d_in[10]; a.hgrn_norm_g = (const float*)d_in[11];
    a.pool_w = (const float*)d_in[12]; a.pool_scale = (const float*)d_in[13]; a.q_norm_g = (const float*)d_in[14]; a.k_norm_g = (const float*)d_in[15]; a.router_w = (const float*)d_in[16]; a.router_b = (const float*)d_in[17];
    a.moe_gate = (const float*)d_in[18]; a.moe_up = (const float*)d_in[19]; a.moe_down = (const float*)d_in[20];
    a.out = (float*)d_out; a.ws = (unsigned char*)d_ws;
#if MK_SPLIT
    for (int ph = 0; ph < NPHASE; ++ph) { a.ph_lo = ph; a.ph_hi = ph + 1; hipLaunchKernelGGL(mega_fwd, dim3(grid), dim3(512), LDS_BYTES, stream, a); }
#else
    a.ph_lo = 0; a.ph_hi = NPHASE; hipLaunchKernelGGL(mega_fwd, dim3(grid), dim3(512), LDS_BYTES, stream, a);
#endif
}
```

```cpp
#include <hip/hip_runtime.h>
#include <cstdio>
#include <cstdint>
#include <cstring>

namespace cfg {
constexpr int D = 1024, BATCH = 2, SEQ = 8192, CTXL = 256, DEPTH = 2;
constexpr int PB = SEQ + CTXL;
constexpr int MT = BATCH * PB;
constexpr int TPB = PB / 256;
constexpr int NIN = 2304;
constexpr int NE = 16, DE = 512;
constexpr int C_AQ = 0, C_AFF = 256, C_AFB = 512, C_AI = 768, C_AG = 1024, C_BP = 1280, C_CQ = 1536, C_CK = 2048, C_CV = 2176;
constexpr float EPS = 1e-6f;
constexpr float C2 = 0.125f * 1.4426950408889634f;
}

__device__ __forceinline__ int otid() { int t = threadIdx.x; asm volatile("" : "+v"(t)); return t; }

namespace pg8 {
#define PG8_LAS __attribute__((address_space(3)))
typedef unsigned short bf16_t;
typedef short bf16x8 __attribute__((ext_vector_type(8)));
typedef float f32x4 __attribute__((ext_vector_type(4)));
typedef unsigned u32x4 __attribute__((ext_vector_type(4)));
constexpr int BM = 256, BK = 64, HALF = 128, HTB = HALF * BK * 2  , STAGE_BYTES = 8 * HTB, NXCD = 8, WGM = 8;

__host__ __device__ __forceinline__ int lds_byte(int r, int c) { const int st = (r >> 4) * 2 + (c >> 5), rr = r & 15, cc = c & 31, ob = rr * 64 + cc * 2; return st * 1024 + (ob ^ (((ob >> 9) & 1) << 5)); }
__host__ __device__ __forceinline__ void stage_rc(int b, int& R, int& C) { const int st = b / 1024, sb = b % 1024, swz = sb ^ (((sb >> 9) & 1) << 5); R = (st >> 1) * 16 + swz / 64; C = (st & 1) * 32 + (swz % 64) / 2; }
__host__ __device__ __forceinline__ int perm32(int rho) { const int n = rho >> 4, i = rho & 15; return 8 * (i >> 2) + 4 * n + (i & 3); }

struct Unit { int pm, pn; };
struct Gemm { const bf16_t* A; const bf16_t* Bt; int M, N, K, pad; };

struct StaticOrder {
    int nM, nN, nwg, G, c;
    __host__ __device__ void init(int M, int N, int G_, int c_) { nM = M / BM; nN = N / BM; nwg = nM * nN; G = G_; c = c_; }
    __host__ __device__ bool next(int i, Unit& u) const {
        const long L = (long)i * G + c; if (L >= nwg) return false;
        int wgid = (int)L; { const int q = nwg / NXCD, r = nwg % NXCD, xcd = wgid % NXCD, off = wgid / NXCD; wgid = (xcd < r ? xcd * (q + 1) : r * (q + 1) + (xcd - r) * q) + off; }
        const int nig = WGM * nN, gid = wgid / nig, fm = gid * WGM, gsz = (nM - fm) < WGM ? (nM - fm) : WGM;
        u.pm = fm + ((wgid % nig) % gsz); u.pn = (wgid % nig) / gsz; return true;
    }
    __device__ __forceinline__ void a_ready(const Unit&) const {}
    __device__ __forceinline__ void done(const Unit&) const {}
};

__device__ __forceinline__ unsigned cvt_pk_bf16(float lo, float hi) { unsigned r; asm volatile("v_cvt_pk_bf16_f32 %0, %1, %2" : "=v"(r) : "v"(lo), "v"(hi)); return r; }
typedef float f32x2 __attribute__((ext_vector_type(2)));
__device__ __forceinline__ f32x2 gelu_pk(f32x2 v) {
    const f32x2 av = __builtin_elementwise_abs(v), d = av * 0.2316418882f + 1.0f;
    f32x2 t; t.x = __builtin_amdgcn_rcpf(d.x); t.y = __builtin_amdgcn_rcpf(d.y);
    f32x2 q = t * 0.5307027145f + (-0.7265760135f); q = q * t + 0.7107068705f; q = q * t + (-0.142248368f); q = q * t + 0.127414796f; q = q * t;
    const f32x2 s = (v * v) * (-0.72134752044f);
    f32x2 e; e.x = __builtin_amdgcn_exp2f(s.x); e.y = __builtin_amdgcn_exp2f(s.y);
    const f32x2 m = v * (q * e), r = v - m;
    f32x2 o; o.x = v.x < 0.f ? m.x : r.x; o.y = v.y < 0.f ? m.y : r.y; return o;
}

template <int ACT  > struct EpiBf16 {
    static constexpr bool PERM = true, AFTER_DRAIN = false; static_assert(ACT == 0 || ACT == 1, "EpiBf16: ACT is 0 (none) or 1 (gelu_pk)");
    bf16_t* O; int ldc; const float* bias; int split_cols; size_t split_stride; float scale0;
    __device__ __forceinline__ void operator()(const f32x4 (&acc)[2][2][4][2], const Unit& u, int wr, int wc, int fr, int fq) const {
        asm volatile("" : "+v"(fr), "+v"(fq));
        const int row0 = u.pm * BM + wr * 64 + fr; int colt = u.pn * BM; bf16_t* base = O;
        float sc = 1.f; if (split_cols) { const int t = colt / split_cols; base += (size_t)t * split_stride; colt -= t * split_cols; if (t == 0) sc = scale0; }
        const int col0 = colt + wc * 32 + 8 * fq, bcol0 = u.pn * BM + wc * 32 + 8 * fq;
        f32x4 bv[2][2];
#pragma unroll
        for (int bj = 0; bj < 2; ++bj)
#pragma unroll
            for (int n = 0; n < 2; ++n) bv[bj][n] = bias ? *(const f32x4*)(bias + bcol0 + bj * HALF + 4 * n) : (f32x4){0.f, 0.f, 0.f, 0.f};
#pragma unroll
        for (int ai = 0; ai < 2; ++ai)
#pragma unroll
            for (int m = 0; m < 4; ++m) { bf16_t* rowp = base + (size_t)(row0 + ai * HALF + m * 16) * ldc + col0;
#pragma unroll
                for (int bj = 0; bj < 2; ++bj) { f32x4 v0 = acc[ai][bj][m][0] + bv[bj][0], v1 = acc[ai][bj][m][1] + bv[bj][1];
                    if (ACT == 1) { f32x2 a = gelu_pk((f32x2){v0[0], v0[1]}), b = gelu_pk((f32x2){v0[2], v0[3]}), c = gelu_pk((f32x2){v1[0], v1[1]}), d = gelu_pk((f32x2){v1[2], v1[3]});
                        v0 = (f32x4){a.x, a.y, b.x, b.y}; v1 = (f32x4){c.x, c.y, d.x, d.y}; }
                    v0 = v0 * sc; v1 = v1 * sc; u32x4 w; w.x = cvt_pk_bf16(v0[0], v0[1]); w.y = cvt_pk_bf16(v0[2], v0[3]); w.z = cvt_pk_bf16(v1[0], v1[1]); w.w = cvt_pk_bf16(v1[2], v1[3]);
                    *(u32x4*)(rowp + bj * HALF) = w; } }
    }
};

template <class Epi, class Sched, bool ALIGN_EPI = false, bool SP2 = false>
__device__ __forceinline__ void gemm_phase(PG8_LAS unsigned char* lds, const Gemm g, const Sched& S, const Epi& E) {
    const int tid = otid(), wid = __builtin_amdgcn_readfirstlane(tid >> 6), lane = tid & 63, wr = wid >> 2, wc = wid & 3, fr = lane & 15, fq = lane >> 4;
    const int K = g.K, nt = K / BK;
    unsigned voffA[2], voffB[2];
#pragma unroll
    for (int i = 0; i < 2; ++i) { int R, C; stage_rc(tid * 16 + i * 8192, R, C); const int Rb = Epi::PERM ? ((R & ~31) + perm32(R & 31)) : R;
        voffA[i] = (unsigned)(R * K + C) * 2u; voffB[i] = (unsigned)(Rb * K + C) * 2u; }
    const size_t kstep = (size_t)(BK * 2);
    const size_t hstep = (size_t)HALF * K * 2;
    const size_t tstep = 2 * hstep;
    const unsigned ldsw = (unsigned)wid * 1024u;
    const int aoff = lds_byte(wr * 64 + fr, fq * 8), boff = lds_byte(wc * 32 + fr, fq * 8);
#define PG8_SA(b, h) (((b) * 2 + (h)) * HTB)
#define PG8_SB(b, h) ((4 + (b) * 2 + (h)) * HTB)
#define PG8_STAGE(bufoff, gbase, voff) do { _Pragma("unroll") for (int _i = 0; _i < 2; ++_i) \
        __builtin_amdgcn_global_load_lds((const unsigned*)((const char*)(gbase) + (voff)[_i]), (PG8_LAS unsigned*)(lds + (bufoff) + ldsw + _i * 8192), 16, 0, 0); } while (0)
#define PG8_LDA(dst, b, h) do { _Pragma("unroll") for (int m = 0; m < 4; ++m) _Pragma("unroll") for (int k = 0; k < 2; ++k) dst[m][k] = *(const PG8_LAS bf16x8*)(lds + PG8_SA(b, h) + aoff + m * 2048 + k * 1024); } while (0)
#define PG8_LDB(dst, b, h) do { _Pragma("unroll") for (int n = 0; n < 2; ++n) _Pragma("unroll") for (int k = 0; k < 2; ++k) dst[n][k] = *(const PG8_LAS bf16x8*)(lds + PG8_SB(b, h) + boff + n * 2048 + k * 1024); } while (0)
#define PG8_MMA(ai, bj, At, Bt) do { __builtin_amdgcn_s_setprio(1); _Pragma("unroll") for (int m = 0; m < 4; ++m) _Pragma("unroll") for (int n = 0; n < 2; ++n) _Pragma("unroll") for (int k = 0; k < 2; ++k) \
        acc[ai][bj][m][n] = __builtin_amdgcn_mfma_f32_16x16x32_bf16(Bt[n][k], At[m][k], acc[ai][bj][m][n], 0, 0, 0); __builtin_amdgcn_s_setprio(0); } while (0)
#define PG8_WAIT_V(n) asm volatile("s_waitcnt vmcnt(" #n ")" ::: "memory")
#define PG8_WAIT_L(n) asm volatile("s_waitcnt lgkmcnt(" #n ")" ::: "memory")
#define PG8_BAR __builtin_amdgcn_s_barrier()
#define PG8_SCHED __builtin_amdgcn_sched_barrier(0)
    Unit cur, nxt; int ui = 0;
    if (!S.next(0, cur)) return;
    f32x4 acc[2][2][4][2];
#pragma unroll
    for (int a = 0; a < 2; ++a)
#pragma unroll
        for (int b = 0; b < 2; ++b)
#pragma unroll
            for (int m = 0; m < 4; ++m)
#pragma unroll
                for (int n = 0; n < 2; ++n) acc[a][b][m][n] = (f32x4){0.f, 0.f, 0.f, 0.f};
    bf16x8 At[4][2], B0[2][2], B1[2][2];
    const char* cA = (const char*)g.A + (size_t)cur.pm * tstep; const char* cB = (const char*)g.Bt + (size_t)cur.pn * tstep;
    S.a_ready(cur);
    if constexpr (SP2) {
        PG8_STAGE(PG8_SB(0, 0), cB, voffB); PG8_STAGE(PG8_SB(0, 1), cB + hstep, voffB); PG8_STAGE(PG8_SA(0, 0), cA, voffA); PG8_STAGE(PG8_SA(0, 1), cA + hstep, voffA);
        if (wr == 1) PG8_BAR;
        PG8_WAIT_V(2); PG8_BAR;
        PG8_STAGE(PG8_SB(1, 0), cB + kstep, voffB); PG8_STAGE(PG8_SA(1, 0), cA + kstep, voffA); PG8_STAGE(PG8_SB(1, 1), cB + hstep + kstep, voffB);
        PG8_WAIT_V(6); PG8_BAR;
    } else {
        PG8_STAGE(PG8_SB(0, 0), cB, voffB); PG8_STAGE(PG8_SA(0, 0), cA, voffA); PG8_STAGE(PG8_SB(0, 1), cB + hstep, voffB); PG8_STAGE(PG8_SA(0, 1), cA + hstep, voffA);
        if (wr == 1) PG8_BAR;
        PG8_WAIT_V(4); PG8_BAR;
        PG8_STAGE(PG8_SB(1, 0), cB + kstep, voffB); PG8_STAGE(PG8_SA(1, 0), cA + kstep, voffA); PG8_STAGE(PG8_SB(1, 1), cB + hstep + kstep, voffB);
        PG8_WAIT_V(6); PG8_BAR;
    }
    for (;;) {
        const bool has_next = S.next(ui + 1, nxt);
        const char* nA = has_next ? (const char*)g.A + (size_t)nxt.pm * tstep : cA; const char* nB = has_next ? (const char*)g.Bt + (size_t)nxt.pn * tstep : cB;
        for (int t = 0; t < nt; t += 2) {
            const bool last = (t == nt - 2);
            const char* a1 = cA + (size_t)(t + 1) * kstep;
            const char* a2 = last ? nA : cA + (size_t)(t + 2) * kstep; const char* b2 = last ? nB : cB + (size_t)(t + 2) * kstep;
            const char* a3 = a2 + kstep; const char* b3 = b2 + kstep;
            if (last && has_next) S.a_ready(nxt);
            if constexpr (SP2) {
            PG8_LDB(B0, 0, 0); PG8_LDB(B1, 0, 1); PG8_SCHED; PG8_LDA(At, 0, 0); PG8_STAGE(PG8_SA(1, 1), a1 + hstep, voffA);
            PG8_WAIT_V(8); PG8_WAIT_L(0); PG8_BAR; PG8_MMA(0, 0, At, B0); PG8_MMA(0, 1, At, B1); PG8_BAR; PG8_SCHED;
            PG8_LDA(At, 0, 1); PG8_STAGE(PG8_SB(0, 0), b2, voffB); PG8_STAGE(PG8_SB(0, 1), b2 + hstep, voffB); PG8_STAGE(PG8_SA(0, 0), a2, voffA);
            PG8_WAIT_V(8); PG8_WAIT_L(0); PG8_BAR; PG8_MMA(1, 0, At, B0); PG8_MMA(1, 1, At, B1); PG8_BAR; PG8_SCHED;
            PG8_LDB(B0, 1, 0); PG8_LDB(B1, 1, 1); PG8_SCHED; PG8_LDA(At, 1, 0); PG8_STAGE(PG8_SA(0, 1), a2 + hstep, voffA);
            PG8_WAIT_V(8); PG8_WAIT_L(0); PG8_BAR; PG8_MMA(0, 0, At, B0); PG8_MMA(0, 1, At, B1); PG8_BAR; PG8_SCHED;
            PG8_LDA(At, 1, 1); PG8_STAGE(PG8_SB(1, 0), b3, voffB); PG8_STAGE(PG8_SB(1, 1), b3 + hstep, voffB); PG8_STAGE(PG8_SA(1, 0), a3, voffA);
            PG8_WAIT_V(8); PG8_WAIT_L(0); PG8_BAR; PG8_MMA(1, 0, At, B0); PG8_MMA(1, 1, At, B1); PG8_BAR; PG8_SCHED;
            } else {
            PG8_LDB(B0, 0, 0); PG8_SCHED; PG8_LDA(At, 0, 0); PG8_STAGE(PG8_SA(1, 1), a1 + hstep, voffA);
            PG8_WAIT_L(8); PG8_BAR; PG8_WAIT_L(0); PG8_MMA(0, 0, At, B0); PG8_BAR; PG8_SCHED;
            PG8_LDB(B1, 0, 1); PG8_STAGE(PG8_SB(0, 0), b2, voffB);
            PG8_BAR; PG8_WAIT_L(0); PG8_MMA(0, 1, At, B1); PG8_BAR;
            PG8_LDA(At, 0, 1); PG8_STAGE(PG8_SA(0, 0), a2, voffA);
            PG8_BAR; PG8_WAIT_L(0); PG8_MMA(1, 0, At, B0); PG8_BAR; PG8_SCHED;
            PG8_STAGE(PG8_SB(0, 1), b2 + hstep, voffB);
            PG8_WAIT_V(6); PG8_BAR; PG8_MMA(1, 1, At, B1); PG8_BAR;
            PG8_LDB(B0, 1, 0); PG8_SCHED; PG8_LDA(At, 1, 0); PG8_STAGE(PG8_SA(0, 1), a2 + hstep, voffA);
            PG8_WAIT_L(8); PG8_BAR; PG8_WAIT_L(0); PG8_MMA(0, 0, At, B0); PG8_BAR; PG8_SCHED;
            PG8_LDB(B1, 1, 1); PG8_STAGE(PG8_SB(1, 0), b3, voffB);
            PG8_BAR; PG8_WAIT_L(0); PG8_MMA(0, 1, At, B1); PG8_BAR;
            PG8_LDA(At, 1, 1); PG8_STAGE(PG8_SA(1, 0), a3, voffA);
            PG8_BAR; PG8_WAIT_L(0); PG8_MMA(1, 0, At, B0); PG8_BAR; PG8_SCHED;
            PG8_STAGE(PG8_SB(1, 1), b3 + hstep, voffB);
            PG8_WAIT_V(6); PG8_BAR; PG8_MMA(1, 1, At, B1); PG8_BAR;
            }
        }
        if constexpr (ALIGN_EPI) { if (wr == 0) PG8_BAR; }
        if constexpr (!Epi::AFTER_DRAIN) { E(acc, cur, wr, wc, fr, fq); S.done(cur); }
        if (!has_next) break;
#pragma unroll
        for (int a = 0; a < 2; ++a)
#pragma unroll
            for (int b = 0; b < 2; ++b)
#pragma unroll
                for (int m = 0; m < 4; ++m)
#pragma unroll
                    for (int n = 0; n < 2; ++n) acc[a][b][m][n] = (f32x4){0.f, 0.f, 0.f, 0.f};
        cur = nxt; cA = nA; cB = nB; ++ui;
        if constexpr (ALIGN_EPI) { if (wr == 1) PG8_BAR; }
    }
    PG8_WAIT_V(0);
    if constexpr (!ALIGN_EPI) { if (wr == 0) PG8_BAR; }
    PG8_BAR;
    if constexpr (Epi::AFTER_DRAIN) { E.fused(acc, cur, wr, wc, fr, fq, lds, wid, lane); S.done(cur); }
#undef PG8_SA
#undef PG8_SB
#undef PG8_STAGE
#undef PG8_LDA
#undef PG8_LDB
#undef PG8_MMA
#undef PG8_WAIT_V
#undef PG8_WAIT_L
#undef PG8_BAR
#undef PG8_SCHED
}
}

#include <hip/hip_bf16.h>
#include <cmath>
namespace attn_body {
using bf16=__hip_bfloat16;
using bf16x8=__attribute__((ext_vector_type(8)))short;
using s16x4=__attribute__((ext_vector_type(4)))short;
using f32x16=__attribute__((ext_vector_type(16)))float;
using u32x4=__attribute__((ext_vector_type(4)))unsigned;
constexpr int D=64,QP=512,KP=128,VP=2304,OP=1024;
constexpr int NW=8,QBLK=32,QB=QBLK*NW,KVBLK=64;
constexpr int ATTN_UNIT_ROWS=QB;
__device__ __forceinline__ int crow(int r,int hi){return (r&3)+8*(r>>2)+4*hi;}
#define SBAR() __builtin_amdgcn_sched_barrier(0)
constexpr int NSLOT=3, SLOTB=8192;
constexpr int LDS_K=0, LDS_V=NSLOT*SLOTB, LDS_WS=2*NSLOT*SLOTB, LDS_OST=LDS_WS+NW*64*4, LDS_BYTES=LDS_OST+NW*4096;
constexpr float C2=0.125f*1.4426950408889634f;
__device__ __forceinline__ void glds16(const void*gsrc,unsigned lds_dst){unsigned keep;
  asm volatile("s_mov_b32 %0, m0\n\ts_mov_b32 m0, %2\n\ts_nop 0\n\tglobal_load_lds_dwordx4 %1, off\n\ts_mov_b32 m0, %0":"=&s"(keep):"v"(gsrc),"s"(lds_dst):"memory");}
__device__ __forceinline__ float max3f(float a,float b,float c){float r;asm("v_max3_f32 %0, %1, %2, %3":"=v"(r):"v"(a),"v"(b),"v"(c));return r;}
__device__ __forceinline__ float max2f(float a,float b){float r;asm("v_max_f32_e32 %0, %1, %2":"=v"(r):"v"(a),"v"(b));return r;}
__device__ __forceinline__ float fadd_s(float a,float b){float r;asm("v_add_f32_e32 %0, %1, %2":"=v"(r):"v"(a),"v"(b));return r;}
__device__ __forceinline__ float fsub_s(float a,float b){float r;asm("v_sub_f32_e32 %0, %1, %2":"=v"(r):"v"(a),"v"(b));return r;}
typedef float f32x2_t __attribute__((ext_vector_type(2))); typedef __bf16 bf16x2_t __attribute__((ext_vector_type(2)));
__device__ __forceinline__ unsigned cvtpk_s(float lo,float hi){f32x2_t v={lo,hi};bf16x2_t b=__builtin_convertvector(v,bf16x2_t);return __builtin_bit_cast(unsigned,b);}
#define WAIT_BAR(N) asm volatile("s_waitcnt vmcnt(" #N ") lgkmcnt(0)\n\ts_barrier":::"memory")

__device__ __forceinline__ void qkt(f32x16&p0,f32x16&p1,const char*Kslot,const bf16x8*qr,const f32x16&negm,int r32,int hi){
  const char*kb=Kslot+hi*1024+r32*16;
  #pragma unroll
  for(int d0=0;d0<4;++d0){
    const bf16x8 b0=*reinterpret_cast<const bf16x8*>(kb+d0*2048);
    const bf16x8 b1=*reinterpret_cast<const bf16x8*>(kb+d0*2048+512);
    if(d0==0){p0=__builtin_amdgcn_mfma_f32_32x32x16_bf16(b0,qr[0],negm,0,0,0);p1=__builtin_amdgcn_mfma_f32_32x32x16_bf16(b1,qr[0],negm,0,0,0);}
    else{p0=__builtin_amdgcn_mfma_f32_32x32x16_bf16(b0,qr[d0],p0,0,0,0);p1=__builtin_amdgcn_mfma_f32_32x32x16_bf16(b1,qr[d0],p1,0,0,0);}}
}
typedef __attribute__((address_space(3))) const char* lds_cptr;
typedef short v4i16_t __attribute__((ext_vector_type(4)));
__device__ __forceinline__ void kload8(bf16x8*kf,lds_cptr kp){
  kf[0]=*(const __attribute__((address_space(3))) bf16x8*)(kp);      kf[1]=*(const __attribute__((address_space(3))) bf16x8*)(kp+512);
  kf[2]=*(const __attribute__((address_space(3))) bf16x8*)(kp+2048); kf[3]=*(const __attribute__((address_space(3))) bf16x8*)(kp+2560);
  kf[4]=*(const __attribute__((address_space(3))) bf16x8*)(kp+4096); kf[5]=*(const __attribute__((address_space(3))) bf16x8*)(kp+4608);
  kf[6]=*(const __attribute__((address_space(3))) bf16x8*)(kp+6144); kf[7]=*(const __attribute__((address_space(3))) bf16x8*)(kp+6656);
}
__device__ __forceinline__ void kload2(bf16x8*kf,lds_cptr kp,int j){ kf[2*j]=*(const __attribute__((address_space(3))) bf16x8*)(kp+j*2048); kf[2*j+1]=*(const __attribute__((address_space(3))) bf16x8*)(kp+j*2048+512); }
__device__ __forceinline__ s16x4 vtr(lds_cptr p){ return __builtin_bit_cast(s16x4,__builtin_amdgcn_ds_read_tr16_b64_v4i16((__attribute__((address_space(3))) v4i16_t*)p)); }
__device__ __forceinline__ float rowmax(const f32x16&p0,const f32x16&p1){
  float a=max3f(p0[0],p0[1],p1[0]),b=max3f(p0[2],p0[3],p1[1]);a=max3f(a,p1[2],p1[3]);
  #pragma unroll
  for(int r=4;r<16;r+=4){a=max3f(a,p0[r],p0[r+1]);b=max3f(b,p0[r+2],p0[r+3]);a=max3f(a,p1[r],p1[r+1]);b=max3f(b,p1[r+2],p1[r+3]);}
  const float m=max2f(a,b);
  auto rr=__builtin_amdgcn_permlane32_swap(__float_as_uint(m),__float_as_uint(m),false,false);
  return max2f(__uint_as_float(rr[0]),__uint_as_float(rr[1]));
}
__device__ __forceinline__ void pv(f32x16*o,int vb,bf16x8 pa0,bf16x8 pa1,bf16x8 pa2,bf16x8 pa3){
  #pragma unroll
  for(int d0=0;d0<2;++d0){s16x4 lo[4],hi[4];
    #pragma unroll
    for(int ks=0;ks<4;++ks){
      asm volatile("ds_read_b64_tr_b16 %0,%1 offset:%c2":"=&v"(lo[ks]):"v"(vb),"i"(d0*4096+ks*1024):"memory");
      asm volatile("ds_read_b64_tr_b16 %0,%1 offset:%c2":"=&v"(hi[ks]):"v"(vb),"i"(d0*4096+ks*1024+512):"memory");}
    asm volatile("s_waitcnt lgkmcnt(0)":::"memory");SBAR();
    #define PK(k) (bf16x8){lo[k][0],lo[k][1],lo[k][2],lo[k][3],hi[k][0],hi[k][1],hi[k][2],hi[k][3]}
    o[d0]=__builtin_amdgcn_mfma_f32_32x32x16_bf16(pa0,PK(0),o[d0],0,0,0);
    o[d0]=__builtin_amdgcn_mfma_f32_32x32x16_bf16(pa1,PK(1),o[d0],0,0,0);
    o[d0]=__builtin_amdgcn_mfma_f32_32x32x16_bf16(pa2,PK(2),o[d0],0,0,0);
    o[d0]=__builtin_amdgcn_mfma_f32_32x32x16_bf16(pa3,PK(3),o[d0],0,0,0);
    #undef PK
  }
}

#ifndef ATTN_STORE16
#define ATTN_STORE16(p,v) (*(u32x4*)(p)=(v))
#endif
__device__ __forceinline__ void attn_unit(const bf16*Qw0,const bf16*__restrict__ Kh,const bf16*__restrict__ Vh,bf16*Ow0,const int NT,const float neg_ref,char*shm){
  const int tid=otid(),lane=tid&63,r32=lane&31,hi=lane>>5; const int wid=__builtin_amdgcn_readfirstlane(tid>>6);
  const bf16*Qw=Qw0+(long)(wid*QBLK)*QP;
  const unsigned lds0=(unsigned)(uintptr_t)shm;
  float*wsf=(float*)(shm+LDS_WS)+wid*64;
  const bf16*ksrc=Kh+(long)lane*KP+wid*8;
  const bf16*vsrc=Vh+(long)(16*(wid&3)+(lane>>2))*VP+(wid>>2)*32+(lane&3)*8;
  const unsigned kdst=lds0+LDS_K+wid*1024, vdst=lds0+LDS_V+wid*1024;
  #define DMA_K(t,slot) glds16(ksrc+(long)(t)*KVBLK*KP,(unsigned)__builtin_amdgcn_readfirstlane(kdst+(slot)))
  #define DMA_V(t,slot) glds16(vsrc+(long)(t)*KVBLK*VP,(unsigned)__builtin_amdgcn_readfirstlane(vdst+(slot)))
  const int vb0=(int)(lds0+LDS_V)+((lane>>4)&1)*32+(lane&3)*8+(4*hi+((lane&15)>>2))*64;
  const char*Kbase=shm+LDS_K; bf16x8 kf[8];
  const lds_cptr shm3=(lds_cptr)shm; const lds_cptr kp0=shm3+LDS_K+hi*1024+r32*16; const lds_cptr vp0=shm3+LDS_V+((lane>>4)&1)*32+(lane&3)*8+(4*hi+((lane&15)>>2))*64;
  DMA_K(0,0);DMA_V(0,0);DMA_K(1,SLOTB);
  bf16x8 qr[4];
  #pragma unroll
  for(int d0=0;d0<4;++d0)qr[d0]=*reinterpret_cast<const bf16x8*>(&Qw[(long)r32*QP+d0*16+hi*8]);
  float l_reg=0.f;f32x16 o[2];o[0]=f32x16{};o[1]=f32x16{};f32x16 negm;
  #pragma unroll
  for(int r=0;r<16;++r)negm[r]=neg_ref;
  asm volatile("":"+v"(negm));
  f32x16 pA0,pA1,pB0,pB1;
  int sl_prev=0,sl_cur=0,sl_next=SLOTB;
  #define ROT() do{sl_prev=sl_cur;sl_cur=sl_next;sl_next=(sl_next==(NSLOT-1)*SLOTB)?0:sl_next+SLOTB;}while(0)
  DMA_K(2,2*SLOTB);
  WAIT_BAR(3);
  qkt(pA0,pA1,Kbase,qr,negm,r32,hi);asm volatile("s_nop 15\n\ts_nop 7":"+v"(pA0),"+v"(pA1));
  _Pragma("unroll") for(int r=0;r<16;++r)pA0[r]=__builtin_amdgcn_exp2f(pA0[r]);
  _Pragma("unroll") for(int r=0;r<16;++r)pA1[r]=__builtin_amdgcn_exp2f(pA1[r]);
  WAIT_BAR(0);
  DMA_K(3,0);DMA_V(1,SLOTB);
  ROT();
  kload8(kf,kp0+sl_cur);
  WAIT_BAR(2);
  s16x4 vlo[8],vhi[8]; u32x4 pw0,pw1,pw2,pw3;
  #define PKW(P,B) cvtpk_s(P[B],P[B+1])
  #define PAF(k) __builtin_bit_cast(bf16x8,pw##k)
  #define VFR(i) (bf16x8){vlo[i][0],vlo[i][1],vlo[i][2],vlo[i][3],vhi[i][0],vhi[i][1],vhi[i][2],vhi[i][3]}
  #define PIN(x) asm volatile("":"+v"(x))
  #define MX3(a,b,c) __builtin_fmaxf(__builtin_fmaxf((a),(b)),(c))
  #define GAPA(MF,A0,A1,A2,A3,W0,W1,PW) do{ MF; sacc+=A0; sacc+=A1; sacc+=A2; sacc+=A3; PIN(sacc); W0; W1; PIN(PW); SBAR(); }while(0)
  #define EX(v) __builtin_amdgcn_exp2f(v)
  #define GAPB(MF,X,B) do{ MF; X[B]=EX(X[B]); X[B+1]=EX(X[B+1]); X[B+2]=EX(X[B+2]); X[B+3]=EX(X[B+3]); PIN(X); SBAR(); }while(0)
  #define VRD(i) do{ vlo[i]=vtr(vp_+(((i)>>2)*4096+((i)&3)*1024)); vhi[i]=vtr(vp_+(((i)>>2)*4096+((i)&3)*1024+512)); }while(0)
  #define KRD(G,j) do{ if(G){ kload2(kf,kp0+sl_next,j); SBAR(); } }while(0)
  #define STEP(C0,C1,P0,P1,t,GK,GV,GL) do{ SBAR(); \
    const lds_cptr vp_=vp0+sl_prev; \
    VRD(0); SBAR(); float sacc=(P0[0]+P0[1]); \
    GAPA(C0=__builtin_amdgcn_mfma_f32_32x32x16_bf16(kf[0],qr[0],negm,0,0,0), P0[2],P0[3],P0[4],P0[5],     pw0[0]=PKW(P0,0), pw0[1]=PKW(P0,2), pw0); \
    VRD(4); SBAR(); GAPA(C1=__builtin_amdgcn_mfma_f32_32x32x16_bf16(kf[1],qr[0],negm,0,0,0), P0[6],P0[7],P0[8],P0[9],     pw0[2]=PKW(P0,4), pw0[3]=PKW(P0,6), pw0); \
    VRD(1); SBAR(); GAPA(C0=__builtin_amdgcn_mfma_f32_32x32x16_bf16(kf[2],qr[1],C0,0,0,0),   P0[10],P0[11],P0[12],P0[13], pw1[0]=PKW(P0,8), pw1[1]=PKW(P0,10), pw1); \
    VRD(5); SBAR(); GAPA(C1=__builtin_amdgcn_mfma_f32_32x32x16_bf16(kf[3],qr[1],C1,0,0,0),   P0[14],P0[15],P1[0],P1[1],   pw1[2]=PKW(P0,12),pw1[3]=PKW(P0,14), pw1); \
    VRD(2); SBAR(); GAPA(C0=__builtin_amdgcn_mfma_f32_32x32x16_bf16(kf[4],qr[2],C0,0,0,0),   P1[2],P1[3],P1[4],P1[5],     pw2[0]=PKW(P1,0), pw2[1]=PKW(P1,2), pw2); \
    VRD(6); SBAR(); GAPA(C1=__builtin_amdgcn_mfma_f32_32x32x16_bf16(kf[5],qr[2],C1,0,0,0),   P1[6],P1[7],P1[8],P1[9],     pw2[2]=PKW(P1,4), pw2[3]=PKW(P1,6), pw2); \
    VRD(3); SBAR(); GAPA(C0=__builtin_amdgcn_mfma_f32_32x32x16_bf16(kf[6],qr[3],C0,0,0,0),   P1[10],P1[11],P1[12],P1[13], pw3[0]=PKW(P1,8), pw3[1]=PKW(P1,10), pw3); \
    VRD(7); SBAR(); GAPA(C1=__builtin_amdgcn_mfma_f32_32x32x16_bf16(kf[7],qr[3],C1,0,0,0),   P1[14],P1[15],0.f,0.f,       pw3[2]=PKW(P1,12),pw3[3]=PKW(P1,14), pw3); \
    l_reg+=sacc; \
    if(GK){DMA_K((t)+3,sl_cur);} if(GV){DMA_V((t)+1,sl_next);} \
    SBAR(); \
    GAPB(o[0]=__builtin_amdgcn_mfma_f32_32x32x16_bf16(PAF(0),VFR(0),o[0],0,0,0), C0,0); \
    GAPB(o[1]=__builtin_amdgcn_mfma_f32_32x32x16_bf16(PAF(0),VFR(4),o[1],0,0,0), C0,4); \
    KRD(GL,0); GAPB(o[0]=__builtin_amdgcn_mfma_f32_32x32x16_bf16(PAF(1),VFR(1),o[0],0,0,0), C0,8); \
    KRD(GL,1); GAPB(o[1]=__builtin_amdgcn_mfma_f32_32x32x16_bf16(PAF(1),VFR(5),o[1],0,0,0), C0,12); \
    KRD(GL,2); GAPB(o[0]=__builtin_amdgcn_mfma_f32_32x32x16_bf16(PAF(2),VFR(2),o[0],0,0,0), C1,0); \
    KRD(GL,3); GAPB(o[1]=__builtin_amdgcn_mfma_f32_32x32x16_bf16(PAF(2),VFR(6),o[1],0,0,0), C1,4); \
    GAPB(o[0]=__builtin_amdgcn_mfma_f32_32x32x16_bf16(PAF(3),VFR(3),o[0],0,0,0), C1,8); \
    GAPB(o[1]=__builtin_amdgcn_mfma_f32_32x32x16_bf16(PAF(3),VFR(7),o[1],0,0,0), C1,12); \
    }while(0)
  int t=1;
  for(;t+5<NT;t+=2){
    STEP(pB0,pB1,pA0,pA1,t,true,true,true);     WAIT_BAR(2); ROT();
    STEP(pA0,pA1,pB0,pB1,t+1,true,true,true);   WAIT_BAR(2); ROT();
  }
  #define ENDW(tt) do{ if((tt)+3<NT){WAIT_BAR(2);} else if((tt)+2<NT){WAIT_BAR(1);} else {WAIT_BAR(0);} }while(0)
  for(;t+1<NT;t+=2){
    STEP(pB0,pB1,pA0,pA1,t,(t+3<NT),(t+1<NT),(t+1<NT));       ENDW(t);   ROT();
    STEP(pA0,pA1,pB0,pB1,t+1,(t+4<NT),(t+2<NT),(t+2<NT));     ENDW(t+1); ROT();
  }
  STEP(pB0,pB1,pA0,pA1,NT-1,false,false,false);
  { float sacc=pB0[0]+pB0[1]; _Pragma("unroll") for(int r=2;r<16;++r)sacc+=pB0[r]; _Pragma("unroll") for(int r=0;r<16;++r)sacc+=pB1[r]; l_reg+=sacc;
    pw0=(u32x4){PKW(pB0,0),PKW(pB0,2),PKW(pB0,4),PKW(pB0,6)};pw1=(u32x4){PKW(pB0,8),PKW(pB0,10),PKW(pB0,12),PKW(pB0,14)};pw2=(u32x4){PKW(pB1,0),PKW(pB1,2),PKW(pB1,4),PKW(pB1,6)};pw3=(u32x4){PKW(pB1,8),PKW(pB1,10),PKW(pB1,12),PKW(pB1,14)};
    SBAR(); pv(o,vb0+sl_cur,PAF(0),PAF(1),PAF(2),PAF(3)); }
  #undef PKW
  #undef PAF
  #undef VFR
  #undef PIN
  #undef MX3
  #undef GAPA
  #undef GAPB
  #undef EX
  #undef VRD
  #undef KRD
  #undef STEP
  #undef ENDW
  {auto rr=__builtin_amdgcn_permlane32_swap(__float_as_uint(l_reg),__float_as_uint(l_reg),false,false);l_reg=__uint_as_float(rr[0])+__uint_as_float(rr[1]);}
  if(hi==0)wsf[32+r32]=l_reg;asm volatile("s_waitcnt lgkmcnt(0)":::"memory");
  float rli[16];
  #pragma unroll
  for(int r=0;r<16;++r)rli[r]=__builtin_amdgcn_rcpf(wsf[32+crow(r,hi)]);
  bf16*Ow=Ow0+(long)(wid*QBLK)*OP;
  { bf16*stg=(bf16*)(shm+LDS_OST)+wid*2048;
    #pragma unroll
    for(int r=0;r<16;++r){const int orow=crow(r,hi);
      #pragma unroll
      for(int d0=0;d0<2;++d0)stg[orow*64+d0*32+r32]=__float2bfloat16(o[d0][r]*rli[r]);}
    asm volatile("s_waitcnt lgkmcnt(0)":::"memory");
    #pragma unroll
    for(int i=0;i<4;++i){const int row=i*8+(lane>>3),ch=lane&7; const u32x4 v=*(const u32x4*)(stg+row*64+ch*8); ATTN_STORE16(Ow+(long)row*OP+ch*8,v);} }
  asm volatile("s_waitcnt lgkmcnt(0)\n\ts_barrier":::"memory");
  #undef DMA_K
  #undef DMA_V
  #undef ROT
}
constexpr int ATTN_LDS_BYTES=LDS_BYTES;
#undef SBAR
#undef WAIT_BAR
}


using namespace cfg;
typedef unsigned short bf16_t;
typedef float f32x4 __attribute__((ext_vector_type(4)));
typedef unsigned u32x4 __attribute__((ext_vector_type(4)));
typedef unsigned u32x2 __attribute__((ext_vector_type(2)));

__device__ __forceinline__ float bf2f(unsigned v) { return __uint_as_float(v << 16); }
__device__ __forceinline__ float bflo(unsigned w) { return __uint_as_float(w << 16); }
__device__ __forceinline__ float bfhi(unsigned w) { return __uint_as_float(w & 0xffff0000u); }
__device__ __forceinline__ unsigned f2bf(float f) { unsigned u = __float_as_uint(f); return (u + 0x7fffu + ((u >> 16) & 1u)) >> 16; }
__device__ __forceinline__ unsigned pk2(float lo, float hi) { return f2bf(lo) | (f2bf(hi) << 16); }
__device__ __forceinline__ float sigm(float x) { return 1.f / (1.f + __expf(-x)); }
__device__ __forceinline__ float silu(float x) { return x / (1.f + __expf(-x)); }
template <int M> __device__ __forceinline__ float xsum(float v) {
    if constexpr (M < 32) return v + __uint_as_float((unsigned)__builtin_amdgcn_ds_swizzle((int)__float_as_uint(v), (M << 10) | 0x1f));
    else { auto rr = __builtin_amdgcn_permlane32_swap(__float_as_uint(v), __float_as_uint(v), false, false); return __uint_as_float(rr[0]) + __uint_as_float(rr[1]); }
}
__device__ __forceinline__ float wave_sum(float v) { v = xsum<1>(v); v = xsum<2>(v); v = xsum<4>(v); v = xsum<8>(v); v = xsum<16>(v); v = xsum<32>(v); return v; }
__device__ __forceinline__ size_t stream_off(int row, bool& is_ctx) { const int b = row / PB, p = row - b * PB; is_ctx = p < CTXL; return is_ctx ? ((size_t)b * CTXL + p) * D : ((size_t)b * SEQ + (p - CTXL)) * D; }

constexpr size_t MiB = 1u << 20;
constexpr size_t WS_CTL = 0;
constexpr size_t WS_MODV = 1 * MiB;
constexpr size_t WS_LBF = WS_MODV + 256 * 1024;
constexpr size_t WS_REF = WS_LBF + 8192;
constexpr size_t WS_POOLWT = WS_MODV + 512 * 1024;
constexpr size_t WS_COS = 2 * MiB, WS_SIN = 3 * MiB;
constexpr size_t WS_WIN = 4 * MiB;
constexpr size_t WS_WOUT = 13 * MiB;
constexpr size_t WS_WGU = 17 * MiB;
constexpr size_t WS_WD = 49 * MiB;
constexpr size_t WS_XC = 65 * MiB;
constexpr size_t WS_XN = 67 * MiB;
constexpr size_t WS_PROJ = 100 * MiB;
constexpr size_t WS_QN = 175 * MiB;
constexpr size_t WS_KN = 192 * MiB;
constexpr size_t WS_MIX = 197 * MiB;
constexpr size_t WS_UT = 230 * MiB;
constexpr size_t WS_ST = 247 * MiB;
constexpr size_t WS_DEC = 264 * MiB;
constexpr size_t WS_LIST = 265 * MiB;
constexpr size_t WS_ACT2 = WS_PROJ;
constexpr size_t WS_WGU1 = 272 * MiB;
constexpr size_t WS_WD1 = 304 * MiB;
constexpr size_t WS_END = 320 * MiB;
constexpr int CW_CNT = 1024;

__device__ const float ROPE_INV[16] = {1.0f, 0.5623413251903491f, 0.31622776601683794f, 0.1778279410038923f, 0.1f, 0.05623413251903491f, 0.03162277660168379f, 0.01778279410038923f,
                                       0.01f, 0.005623413251903491f, 0.0031622776601683794f, 0.0017782794100389228f, 0.001f, 0.0005623413251903491f, 0.00031622776601683794f, 0.00017782794100389227f};
__device__ __forceinline__ void sincos_d(double a, double& s, double& c) {
    const double k = rint(a * 0.63661977236758134308);
    double r = fma(-k, 1.57079632679489655800e+00, a);
    r = fma(-k, 6.12323399573676603587e-17, r);
    const double r2 = r * r;
    double sp = -7.6471637318198164759e-13;
    sp = fma(sp, r2, 1.6059043836821614599e-10);
    sp = fma(sp, r2, -2.5052108385441718775e-08);
    sp = fma(sp, r2, 2.7557319223985890653e-06);
    sp = fma(sp, r2, -1.9841269841269841270e-04);
    sp = fma(sp, r2, 8.3333333333333333333e-03);
    sp = fma(sp, r2, -1.6666666666666666667e-01);
    const double sr = fma(sp * r2, r, r);
    double cp = 4.7794773323873852974e-14;
    cp = fma(cp, r2, -1.1470745597729724714e-11);
    cp = fma(cp, r2, 2.0876756987868098979e-09);
    cp = fma(cp, r2, -2.7557319223985890653e-07);
    cp = fma(cp, r2, 2.4801587301587301587e-05);
    cp = fma(cp, r2, -1.3888888888888888889e-03);
    cp = fma(cp, r2, 4.1666666666666666667e-02);
    cp = fma(cp, r2, -0.5);
    const double cr = fma(cp, r2, 1.0);
    const int q = ((int)k) & 3;
    s = (q == 0) ? sr : (q == 1) ? cr : (q == 2) ? -sr : -cr;
    c = (q == 0) ? cr : (q == 1) ? -sr : (q == 2) ? -cr : sr;
}

__device__ __forceinline__ void transpose_items(const float* __restrict__ W, int K, int N, bf16_t* __restrict__ WT, int mode, int nbatch, size_t src_stride, size_t dst_stride, float* scr, int gw, int NGW, int lane, int it_lo = 0, int it_hi = 0x7fffffff) {
    const int nblk = N / 32, per = (K / 64) * nblk, nitems = per * nbatch;
    if (it_hi > nitems) it_hi = nitems;
    for (int it = it_lo + gw; it < it_hi; it += NGW) {
        const int bt = it / per, item = it - bt * per;
        const float* Wb = W + (size_t)bt * src_stride; bf16_t* WTb = WT + (size_t)bt * dst_stride;
        const int kb = item / nblk, nb = item - kb * nblk, k0 = 64 * kb, n0 = 32 * nb;
        f32x4 wv[8];
#pragma unroll
        for (int i = 0; i < 8; ++i) wv[i] = *(const f32x4*)(Wb + (size_t)(k0 + 8 * i + (lane >> 3)) * N + n0 + (lane & 7) * 4);
#pragma unroll
        for (int i = 0; i < 8; ++i) { float* s = scr + (8 * i + (lane >> 3)) * 33 + (lane & 7) * 4; s[0] = wv[i].x; s[1] = wv[i].y; s[2] = wv[i].z; s[3] = wv[i].w; }
        asm volatile("s_waitcnt lgkmcnt(0)" ::: "memory");
        const int rbase = (mode == 0) ? n0 : ((n0 >> 7) * 256 + (mode == 2 ? 128 : 0) + (n0 & 127));
        const int cch = lane & 7;
#pragma unroll
        for (int j = 0; j < 4; ++j) { const int n = (lane >> 3) + 8 * j; const float* s = scr + (8 * cch) * 33 + n;
            u32x4 o; o.x = pk2(s[0 * 33], s[1 * 33]); o.y = pk2(s[2 * 33], s[3 * 33]); o.z = pk2(s[4 * 33], s[5 * 33]); o.w = pk2(s[6 * 33], s[7 * 33]);
            *(u32x4*)(WTb + (size_t)(rbase + n) * K + k0 + 8 * cch) = o; }
        asm volatile("s_waitcnt lgkmcnt(0)" ::: "memory");
    }
}
constexpr int MOE_ITEMS = 3 * 4096;
__device__ __forceinline__ void moe_weight_copies(const float* gate, const float* up, const float* down, bf16_t* WGU, bf16_t* WD, float* scr, int gw, int NGW, int lane, int lo, int hi) {
    if (lo < 4096) transpose_items(gate, D, DE, WGU, 1, NE, (size_t)D * DE, (size_t)1024 * D, scr, gw, NGW, lane, lo, hi < 4096 ? hi : 4096);
    if (lo < 8192 && hi > 4096) transpose_items(up, D, DE, WGU, 2, NE, (size_t)D * DE, (size_t)1024 * D, scr, gw, NGW, lane, lo > 4096 ? lo - 4096 : 0, hi < 8192 ? hi - 4096 : 4096);
    if (hi > 8192) transpose_items(down, DE, D, WD, 0, NE, (size_t)DE * D, (size_t)D * DE, scr, gw, NGW, lane, lo > 8192 ? lo - 8192 : 0, hi - 8192);
}
__device__ __forceinline__ void moe_filler(unsigned char* lds, const float* gate, const float* up, const float* down, unsigned char* ws, int lw, int lo, int hi, int U, int G, int c) {
    const int rem = U % G; int rank = c, nr = G;
    if (rem != 0) { if (c < rem) return; rank = c - rem; nr = G - rem; }
    const int tid = otid(); float* scr = (float*)(lds + 16384) + (tid >> 6) * (64 * 33);
    moe_weight_copies(gate + (size_t)lw * NE * D * DE, up + (size_t)lw * NE * D * DE, down + (size_t)lw * NE * DE * D, (bf16_t*)(ws + (lw ? WS_WGU1 : WS_WGU)), (bf16_t*)(ws + (lw ? WS_WD1 : WS_WD)), scr, rank * 8 + (tid >> 6), nr * 8, tid & 63, lo, hi);
}
struct ProArgs { const float *c, *c_ctx, *w_mod, *b_mod, *hgrn_lb, *qg, *kg, *w_in, *w_out, *pool_w, *gate, *up, *down; float *MODV, *LBF, *REF, *COS, *SIN; bf16_t *WIN, *WOUT, *POOLWT, *WGU, *WD; };
__device__ __forceinline__ void prologue_phase(unsigned char* lds, const ProArgs& a, int cu, int G) {
    const int tid = otid(), lane = tid & 63, wave = tid >> 6;
    for (int gid = cu * 512 + tid; gid < SEQ * 32; gid += G * 512) {
        const int t = gid >> 5, j = gid & 31;
        const float pos = (float)(j < 16 ? (t >> 6) : (t & 63));
        const float ang = pos * ROPE_INV[j & 15];
        double s, c; sincos_d((double)ang, s, c);
        a.COS[gid] = (float)c; a.SIN[gid] = (float)s;
    }
    if (cu == 0) {
        for (int gid = tid; gid < 1024; gid += 512) {
            const int l = gid >> 9, r = gid & 511; float v = 0.f;
            if (l == 1) v = 1.f / (1.f + expf(a.hgrn_lb[r] - a.hgrn_lb[512 + r]));
            a.LBF[gid] = fmaxf(v, 1e-30f); }
        if (tid < DEPTH) {
            float mq = 0.f, mk = 0.f;
            for (int i = 0; i < 64; ++i) { mq = fmaxf(mq, fabsf(a.qg[tid * 64 + i])); mk = fmaxf(mk, fabsf(a.kg[tid * 64 + i])); }
            a.REF[tid * 64] = -(64.f * C2 * mq * mk * 1.02f + 0.5f); }
    }
    {
        float* act = (float*)lds;
        float* part = (float*)(lds + 12288);
        for (int item = cu; item < 2 * 96; item += G) {
            const int l = item / 96, n0 = (item - l * 96) * 64;
            for (int i = tid; i < 3072; i += 512) { const int r = i >> 10, k = i & 1023; const float v = r < 2 ? a.c[r * 1024 + k] : a.c_ctx[k]; act[i] = silu(v); }
            __syncthreads();
            const float* w = a.w_mod + ((size_t)l * 1024 + (size_t)wave * 128) * 6144 + n0 + lane;
            float a0 = 0.f, a1 = 0.f, a2 = 0.f;
#pragma unroll 32
            for (int k = 0; k < 128; ++k) { const float wv = w[(size_t)k * 6144]; const int kk = wave * 128 + k; a0 += act[kk] * wv; a1 += act[1024 + kk] * wv; a2 += act[2048 + kk] * wv; }
            part[(wave * 3 + 0) * 64 + lane] = a0; part[(wave * 3 + 1) * 64 + lane] = a1; part[(wave * 3 + 2) * 64 + lane] = a2;
            __syncthreads();
            if (tid < 192) { const int r = tid >> 6, nn = tid & 63; float s = 0.f;
#pragma unroll
                for (int q = 0; q < 8; ++q) s += part[(q * 3 + r) * 64 + nn];
                a.MODV[(l * 3 + r) * 6144 + n0 + nn] = s + a.b_mod[l * 6144 + n0 + nn]; }
            __syncthreads();
        }
    }
    {
        float* scr = (float*)(lds + 16384) + wave * (64 * 33);
        const int gw = cu * 8 + wave, NGW = G * 8;
        transpose_items(a.w_in, D, NIN, a.WIN, 0, DEPTH, (size_t)D * NIN, (size_t)NIN * D, scr, gw, NGW, lane);
        transpose_items(a.w_out, D, D, a.WOUT, 0, DEPTH, (size_t)D * D, (size_t)D * D, scr, gw, NGW, lane);
        transpose_items(a.pool_w, 64, 64, a.POOLWT, 0, DEPTH * 4, (size_t)64 * 64, (size_t)64 * 64, scr, gw, NGW, lane);
    }
    __syncthreads();
}

namespace pool {
typedef float f32x16 __attribute__((ext_vector_type(16)));
typedef short bf16x8 __attribute__((ext_vector_type(8)));
constexpr int P = 72, O_X = 0  , O_DM = 81920  , O_OUT = 0  , OP = 264;
__device__ __forceinline__ int crow(int r, int hi) { return (r & 3) + 8 * (r >> 2) + 4 * hi; }
__device__ __forceinline__ void pool_phase(unsigned char* lds, const bf16_t* __restrict__ PROJ, const bf16_t* __restrict__ WT  , const float* __restrict__ pscale, bf16_t* __restrict__ MIX, int cu, int G) {
    const int tid = otid(), lane = tid & 63, r32 = lane & 31, hi = lane >> 5, w = __builtin_amdgcn_readfirstlane(tid >> 6);
    float* X = (float*)(lds + O_X); bf16_t* OUT = (bf16_t*)(lds + O_OUT);
    for (int u = G - 1 - cu; u < MT / 64; u += G) {
        const int row0 = u * 64, b = row0 / PB, p0 = row0 - b * PB; const bool is_ctx = p0 < CTXL;
        const int seg0 = b * PB + (is_ctx ? 0 : CTXL), len = is_ctx ? CTXL : SEQ, t0 = is_ctx ? p0 : p0 - CTXL;
#pragma unroll
        for (int it = 0; it < 5; ++it) { const int piece = tid + it * 512, rr = piece >> 5, pc = piece & 31, t = t0 - 8 + rr;
            u32x4 v = {0u, 0u, 0u, 0u};
            if (t >= 0 && t < len) v = *(const u32x4*)(PROJ + (size_t)(seg0 + t) * NIN + C_BP + pc * 8);
            float* x = X + rr * 256 + pc * 8;
            *(f32x4*)x = (f32x4){bflo(v.x), bfhi(v.x), bflo(v.y), bfhi(v.y)}; *(f32x4*)(x + 4) = (f32x4){bflo(v.z), bfhi(v.z), bflo(v.w), bfhi(v.w)}; }
        __syncthreads();
        {
            const int c = tid & 255, th = tid >> 8, g = c >> 6, hw = 1 << g;
            bf16_t* dm = (bf16_t*)(lds + O_DM) + g * 64 * P + (c & 63);
            const float* xc = X + c;
            const int ta = th * 32;
            float s = 0.f;
            for (int q = ta - hw; q < ta + hw; ++q) s += xc[(q + 8) * 256];
#pragma unroll 8
            for (int tt = 0; tt < 32; ++tt) { const int t = ta + tt, tg = t0 + t;
                int lo = tg - hw; if (lo < 0) lo = 0; int hi2 = tg + hw; if (hi2 > len) hi2 = len;
                dm[t * P] = (bf16_t)f2bf(s / (float)(hi2 - lo) - xc[(t + 8) * 256]);
                s += xc[(t + hw + 8) * 256] - xc[(t - hw + 8) * 256]; }
        }
        __syncthreads();
        {
            const int g = w >> 1, tb = w & 1;
            const bf16_t* A = (const bf16_t*)(lds + O_DM) + g * 64 * P + (tb * 32 + r32) * P + hi * 8;
#pragma unroll
            for (int eb = 0; eb < 2; ++eb) {
                const bf16_t* Bp = WT + (size_t)g * 4096 + (eb * 32 + r32) * 64 + hi * 8;
                f32x16 acc = {};
#pragma unroll
                for (int ks = 0; ks < 4; ++ks) acc = __builtin_amdgcn_mfma_f32_32x32x16_bf16(*(const bf16x8*)(A + ks * 16), *(const bf16x8*)(Bp + ks * 16), acc, 0, 0, 0);
                const int e = g * 64 + eb * 32 + r32; const float sc = pscale[e];
#pragma unroll
                for (int r = 0; r < 16; ++r) OUT[(tb * 32 + crow(r, hi)) * OP + e] = (bf16_t)f2bf(acc[r] * sc);
            }
        }
        __syncthreads();
#pragma unroll
        for (int it = 0; it < 4; ++it) { const int piece = tid + it * 512, t = piece >> 5, pc = piece & 31;
            *(u32x4*)(MIX + (size_t)(row0 + t) * D + 256 + pc * 8) = *(const u32x4*)(OUT + t * OP + pc * 8); }
        __syncthreads();
    }
}
}

#ifndef LAS
#define LAS __attribute__((address_space(3)))
#endif
__device__ __forceinline__ void norm1_phase(int cu, int G, const float* __restrict__ lat, const float* __restrict__ cx, const float* __restrict__ g, const float* __restrict__ modv, int sh_off, bf16_t* __restrict__ XN) {
    const int lane = otid() & 63, gw = cu * 8 + (otid() >> 6), NGW = G * 8;
    for (int row0 = gw * 4; row0 < MT; row0 += NGW * 4) {
        bool is_ctx; const size_t off = stream_off(row0, is_ctx);
        const int r = is_ctx ? 2 : row0 / PB;
        const f32x4* xr = (const f32x4*)((is_ctx ? cx : lat) + off) + lane;
        f32x4 v[4][4]; float ss[4];
#pragma unroll
        for (int q = 0; q < 4; ++q) { ss[q] = 0.f;
#pragma unroll
            for (int j = 0; j < 4; ++j) v[q][j] = xr[q * 256 + 64 * j]; }
        const float* mv = modv + r * 6144 + sh_off;
        f32x4 gs[4], sh[4];
#pragma unroll
        for (int j = 0; j < 4; ++j) { const int col = 4 * lane + 256 * j; gs[j] = *(const f32x4*)(g + col) * (*(const f32x4*)(mv + 1024 + col) + 1.f); sh[j] = *(const f32x4*)(mv + col); }
#pragma unroll
        for (int q = 0; q < 4; ++q) {
#pragma unroll
            for (int j = 0; j < 4; ++j) ss[q] += (v[q][j].x * v[q][j].x + v[q][j].y * v[q][j].y) + (v[q][j].z * v[q][j].z + v[q][j].w * v[q][j].w);
            const float rstd = 1.f / sqrtf(wave_sum(ss[q]) * (1.f / D) + EPS);
#pragma unroll
            for (int j = 0; j < 4; ++j) { const f32x4 o = v[q][j] * rstd * gs[j] + sh[j];
                u32x2 w; w.x = pk2(o.x, o.y); w.y = pk2(o.z, o.w);
                *(u32x2*)(XN + (size_t)(row0 + q) * D + 4 * lane + 256 * j) = w; } }
    }
}

__device__ __forceinline__ void norm2_router_phase(unsigned char* lds, int cu, int G, const float* __restrict__ lat, const float* __restrict__ cx, const float* __restrict__ g, const float* __restrict__ modv, int sh_off,
                                                   const float* __restrict__ router_w, const float* __restrict__ router_b, bf16_t* __restrict__ XN, unsigned* __restrict__ cnt, u32x4* __restrict__ LIST, int route_ctx) {
    const int tid = otid(), lane = tid & 63, wave = tid >> 6, gw = cu * 8 + wave, NGW = G * 8;
    float* RW = (float*)lds;
    u32x4* ENT = (u32x4*)(lds + 65536) + wave * 64;
    LAS unsigned* BC = (LAS unsigned*)((LAS unsigned char*)lds + 65536 + 8192);
#pragma unroll
    for (int it = 0; it < 8; ++it) { const int p = tid + it * 512, col = p >> 2, q = p & 3; const f32x4 w4 = *(const f32x4*)(router_w + (size_t)col * 16 + 4 * q);
        RW[(4 * q + 0) * 1024 + col] = w4.x; RW[(4 * q + 1) * 1024 + col] = w4.y; RW[(4 * q + 2) * 1024 + col] = w4.z; RW[(4 * q + 3) * 1024 + col] = w4.w; }
    if (tid < 48) BC[tid] = 0u;
    __syncthreads();
    int nent = 0;
    f32x4 vn[4];
    { int row = gw < MT ? gw : 0; bool ic; const size_t off = stream_off(row, ic); const f32x4* xr = (const f32x4*)((ic ? cx : lat) + off) + lane;
#pragma unroll
      for (int j = 0; j < 4; ++j) vn[j] = xr[64 * j]; }
    for (int row = gw; row < MT; row += NGW) {
        f32x4 v[4];
#pragma unroll
        for (int j = 0; j < 4; ++j) v[j] = vn[j];
        { const int nr = row + NGW < MT ? row + NGW : row; bool ic; const size_t off = stream_off(nr, ic); const f32x4* xr = (const f32x4*)((ic ? cx : lat) + off) + lane;
#pragma unroll
          for (int j = 0; j < 4; ++j) vn[j] = xr[64 * j]; }
        bool is_ctx; (void)stream_off(row, is_ctx);
        if (is_ctx && !route_ctx) continue;
        const int r = is_ctx ? 2 : row / PB;
        float ss = 0.f;
#pragma unroll
        for (int j = 0; j < 4; ++j) ss += (v[j].x * v[j].x + v[j].y * v[j].y) + (v[j].z * v[j].z + v[j].w * v[j].w);
        const float rstd = 1.f / sqrtf(wave_sum(ss) * (1.f / D) + EPS);
        const float* mv = modv + r * 6144 + sh_off;
#pragma unroll
        for (int j = 0; j < 4; ++j) { const int col = 4 * lane + 256 * j;
            const f32x4 gg = *(const f32x4*)(g + col), sh = *(const f32x4*)(mv + col), sc = *(const f32x4*)(mv + 1024 + col);
            v[j] = v[j] * rstd * gg * (sc + 1.f) + sh;
            u32x2 w; w.x = pk2(v[j].x, v[j].y); w.y = pk2(v[j].z, v[j].w);
            *(u32x2*)(XN + (size_t)row * D + col) = w; }
        float sc_[16], sel[16];
#pragma unroll
        for (int e = 0; e < 16; ++e) { float a = 0.f;
#pragma unroll
            for (int j = 0; j < 4; ++j) { const f32x4 w4 = *(const f32x4*)(RW + e * 1024 + 256 * j + 4 * lane); a += (v[j].x * w4.x + v[j].y * w4.y) + (v[j].z * w4.z + v[j].w * w4.w); }
            a = wave_sum(a); sc_[e] = 1.f / (1.f + __expf(-a)); sel[e] = sc_[e] + router_b[e]; }
        float gs[4]; int gi1[4], gi2[4]; float gw1[4], gw2[4];
#pragma unroll
        for (int q = 0; q < 4; ++q) { float v1 = -INFINITY, v2 = -INFINITY; int i1 = 0, i2 = 0; float s1 = 0.f, s2 = 0.f;
#pragma unroll
            for (int k = 0; k < 4; ++k) { const float x = sel[4 * q + k], sx = sc_[4 * q + k];
                if (x > v1) { v2 = v1; i2 = i1; s2 = s1; v1 = x; i1 = 4 * q + k; s1 = sx; } else if (x > v2) { v2 = x; i2 = 4 * q + k; s2 = sx; } }
            gs[q] = v1 + v2; gi1[q] = i1; gi2[q] = i2; gw1[q] = s1; gw2[q] = s2; }
        float bv = gs[0]; int e0 = gi1[0], e1 = gi2[0]; float w0 = gw1[0], w1 = gw2[0];
#pragma unroll
        for (int q = 1; q < 4; ++q) if (gs[q] > bv) { bv = gs[q]; e0 = gi1[q]; e1 = gi2[q]; w0 = gw1[q]; w1 = gw2[q]; }
        const float ws = w0 + w1; w0 /= ws; w1 /= ws;
        {
            const int gq = e0 >> 2; int a = e0 & 3, c = e1 & 3; float wa = w0, wc = w1;
            if (a > c) { const int ti = a; a = c; c = ti; const float tf = wa; wa = wc; wc = tf; }
            const int pi = (a == 0) ? (c - 1) : (a == 1 ? c + 1 : 5);
            const int bk = gq * 6 + pi;
            if (lane == 0) { const unsigned loc = __hip_atomic_fetch_add(BC + bk, 1u, __ATOMIC_RELAXED, __HIP_MEMORY_SCOPE_WORKGROUP);
                u32x4 sv; sv.x = (unsigned)bk | (loc << 8); sv.y = (unsigned)row; sv.z = __float_as_uint(wa); sv.w = __float_as_uint(wc); ENT[nent] = sv; }
            ++nent; }
    }
    __syncthreads();
    if (tid < 24) { const unsigned n = BC[tid]; BC[24 + tid] = n ? __hip_atomic_fetch_add(cnt + tid, n, __ATOMIC_RELAXED, __HIP_MEMORY_SCOPE_AGENT) : 0u; }
    __syncthreads();
    if (lane < nent) { const u32x4 en = ENT[lane]; const unsigned bk = en.x & 255u, slot = BC[24 + bk] + (en.x >> 8);
        u32x4 sv; sv.x = en.y; sv.y = en.z; sv.z = en.w; sv.w = 0u; LIST[(size_t)bk * MT + slot] = sv; }
    __syncthreads();
}

__device__ __forceinline__ void post_phase(int cu, int G, const bf16_t* __restrict__ PROJ, const float* __restrict__ qg, const float* __restrict__ kg, const float* __restrict__ COS, const float* __restrict__ SIN,
                                              bf16_t* __restrict__ QN, bf16_t* __restrict__ KN) {
    const int lane = otid() & 63, gw = cu * 8 + (otid() >> 6), NGW = G * 8;
    const int d0 = (lane & 7) * 8, jk = lane & 31;
    float qgv[8];
#pragma unroll
    for (int i = 0; i < 8; ++i) qgv[i] = qg[d0 + i];
    const float kg0 = kg[2 * jk], kg1 = kg[2 * jk + 1];
    for (int row0 = gw * 4; row0 < MT; row0 += NGW * 4) {
        const int b = row0 / PB, p0 = row0 - b * PB; const bool is_ctx = p0 < CTXL; const int t0 = is_ctx ? 0 : p0 - CTXL;
        u32x4 wq[4]; unsigned wk[4]; f32x4 cq[4], sq[4]; float ck[4], sk[4];
#pragma unroll
        for (int q = 0; q < 4; ++q) { const bf16_t* pr = PROJ + (size_t)(row0 + q) * NIN;
            wq[q] = *(const u32x4*)(pr + C_CQ + lane * 8); wk[q] = *(const unsigned*)(pr + C_CK + lane * 2);
            const int t = is_ctx ? 0 : t0 + q;
            cq[q] = *(const f32x4*)(COS + t * 32 + (d0 >> 1)); sq[q] = *(const f32x4*)(SIN + t * 32 + (d0 >> 1)); ck[q] = COS[t * 32 + jk]; sk[q] = SIN[t * 32 + jk]; }
#pragma unroll
        for (int q = 0; q < 4; ++q) {
            {
                const u32x4 w = wq[q];
                float x[8] = {bflo(w.x), bfhi(w.x), bflo(w.y), bfhi(w.y), bflo(w.z), bfhi(w.z), bflo(w.w), bfhi(w.w)};
                float ss = 0.f;
#pragma unroll
                for (int i = 0; i < 8; ++i) ss += x[i] * x[i];
                ss = xsum<1>(ss); ss = xsum<2>(ss); ss = xsum<4>(ss);
                const float rstd = 1.f / sqrtf(ss * (1.f / 64.f) + EPS);
#pragma unroll
                for (int i = 0; i < 8; ++i) x[i] = x[i] * rstd * qgv[i];
                if (!is_ctx) {
#pragma unroll
                    for (int i = 0; i < 4; ++i) { const float cs = cq[q][i], sn = sq[q][i];
                        const float x1 = x[2 * i], x2 = x[2 * i + 1]; x[2 * i] = x1 * cs - x2 * sn; x[2 * i + 1] = x1 * sn + x2 * cs; } }
                u32x4 o; o.x = pk2(x[0] * C2, x[1] * C2); o.y = pk2(x[2] * C2, x[3] * C2); o.z = pk2(x[4] * C2, x[5] * C2); o.w = pk2(x[6] * C2, x[7] * C2);
                *(u32x4*)(QN + (size_t)(row0 + q) * 512 + lane * 8) = o;
            }
            {
                float x1 = bflo(wk[q]), x2 = bfhi(wk[q]);
                float ss = x1 * x1 + x2 * x2;
                ss = xsum<1>(ss); ss = xsum<2>(ss); ss = xsum<4>(ss); ss = xsum<8>(ss); ss = xsum<16>(ss);
                const float rstd = 1.f / sqrtf(ss * (1.f / 64.f) + EPS);
                x1 = x1 * rstd * kg0; x2 = x2 * rstd * kg1;
                if (!is_ctx) { const float cs = ck[q], sn = sk[q]; const float a = x1 * cs - x2 * sn, c = x1 * sn + x2 * cs; x1 = a; x2 = c; }
                *(unsigned*)(KN + (size_t)(row0 + q) * 128 + lane * 2) = pk2(x1, x2);
            }
        }
    }
}

namespace hg {
typedef float f32x16 __attribute__((ext_vector_type(16)));
typedef short bf16x8 __attribute__((ext_vector_type(8)));
typedef short s16x4 __attribute__((ext_vector_type(4)));
typedef float f32x2 __attribute__((ext_vector_type(2)));
constexpr int P = 72;
constexpr int O_ZB = 0, O_ZQ = 32768, O_VT = 40960, O_QH = 50176, O_QT = 68608, O_KH = 87040, O_ST = 105472, O_SSQ = 123904, O_OUT = 0  , O_TOT = 0, LDS_BYTES = 124416;
constexpr int MSZ = 64 * P * 2;
constexpr int NCH = PB / 64;
__device__ __forceinline__ int crow(int r, int hi) { return (r & 3) + 8 * (r >> 2) + 4 * hi; }
__device__ __forceinline__ unsigned cvtpk(float lo, float hi) { typedef __bf16 b2 __attribute__((ext_vector_type(2))); f32x2 v = {lo, hi}; b2 b = __builtin_convertvector(v, b2); return __builtin_bit_cast(unsigned, b); }
__device__ __forceinline__ float clampe(float e) { return fminf(fmaxf(e, -80.f), 80.f); }

struct StageRegs { u32x4 wf, wb, wv, wq; };
template <bool FULL> __device__ __forceinline__ void stage_load(StageRegs& s, const bf16_t* __restrict__ PROJ, int row0, int h) {
    const int tid = otid(), t = tid >> 3, pc = tid & 7;
    const bf16_t* pr = PROJ + (size_t)(row0 + t) * NIN + h * 64 + pc * 8;
    s.wf = *(const u32x4*)(pr + C_AFF); s.wb = *(const u32x4*)(pr + C_AFB); s.wv = *(const u32x4*)(pr + C_AI);
    if (FULL) s.wq = *(const u32x4*)(pr + C_AQ);
}
template <bool FULL> __device__ __forceinline__ void prep(unsigned char* lds, const bf16_t* __restrict__ PROJ, const float* __restrict__ LBFl, int row0, int h, StageRegs& sr, int nrow0, int nh) {
    const int tid = otid();
    float* ZB = (float*)(lds + O_ZB); bf16_t* ZQ = (bf16_t*)(lds + O_ZQ); bf16_t* VT = (bf16_t*)(lds + O_VT);
    {
        const int t = tid >> 3, pc = tid & 7;
        const u32x4 wf = sr.wf, wb = sr.wb, wv = sr.wv;
        float* zf = ZB + t * 64 + pc * 8; float* zb = ZB + 4096 + t * 64 + pc * 8;
        *(f32x4*)zf = (f32x4){bflo(wf.x), bfhi(wf.x), bflo(wf.y), bfhi(wf.y)}; *(f32x4*)(zf + 4) = (f32x4){bflo(wf.z), bfhi(wf.z), bflo(wf.w), bfhi(wf.w)};
        *(f32x4*)zb = (f32x4){bflo(wb.x), bfhi(wb.x), bflo(wb.y), bfhi(wb.y)}; *(f32x4*)(zb + 4) = (f32x4){bflo(wb.z), bfhi(wb.z), bflo(wb.w), bfhi(wb.w)};
        bf16_t* vt = VT + (pc * 8) * P + t;
        vt[0 * P] = (bf16_t)(wv.x & 0xffffu); vt[1 * P] = (bf16_t)(wv.x >> 16); vt[2 * P] = (bf16_t)(wv.y & 0xffffu); vt[3 * P] = (bf16_t)(wv.y >> 16);
        vt[4 * P] = (bf16_t)(wv.z & 0xffffu); vt[5 * P] = (bf16_t)(wv.z >> 16); vt[6 * P] = (bf16_t)(wv.w & 0xffffu); vt[7 * P] = (bf16_t)(wv.w >> 16);
        if (FULL) { const u32x4 wq = sr.wq; *(u32x4*)(ZQ + t * 64 + pc * 8) = wq; }
        if (nrow0 >= 0) stage_load<FULL>(sr, PROJ, nrow0, nh);
    }
    __syncthreads();
#pragma unroll
    for (int it = 0; it < 2; ++it) {
        const int item = tid + it * 512, dir = item >> 9, t = (item >> 3) & 63, i0 = (item & 7) * 8;
        float* zp = ZB + dir * 4096 + t * 64 + i0; const float* lp = LBFl + dir * 256 + h * 64 + i0;
        f32x4 za = *(const f32x4*)zp, zc = *(const f32x4*)(zp + 4); const f32x4 la = *(const f32x4*)lp, lc = *(const f32x4*)(lp + 4);
#pragma unroll
        for (int k = 0; k < 4; ++k) { za[k] = __logf(la[k] + (1.f - la[k]) / (1.f + __expf(-za[k]))); zc[k] = __logf(lc[k] + (1.f - lc[k]) / (1.f + __expf(-zc[k]))); }
        *(f32x4*)zp = za; *(f32x4*)(zp + 4) = zc;
    }
    __syncthreads();
    if (tid < 128) {
        const int dir = tid >> 6, i = tid & 63;
        float* zb = ZB + dir * 4096 + i; float acc = 0.f;
        if (dir == 0) {
#pragma unroll 16
            for (int t = 0; t < 64; ++t) { acc += zb[t * 64]; zb[t * 64] = acc; } }
        else {
#pragma unroll 16
            for (int t = 63; t >= 0; --t) { acc += zb[t * 64]; zb[t * 64] = acc; } }
    }
    __syncthreads();
#pragma unroll
    for (int it = 0; it < 2; ++it) {
        const int item = tid + it * 512, dir = item >> 9, t = (item >> 3) & 63, i0 = (item & 7) * 8;
        const float* B = ZB + dir * 4096;
        const int tp = dir == 0 ? t - 1 : t + 1; const bool edge = dir == 0 ? (t == 0) : (t == 63);
        const int tref = dir == 0 ? 31 : 32;
        float bc[8], bp[8], br[8];
        { const f32x4 a = *(const f32x4*)(B + t * 64 + i0), c = *(const f32x4*)(B + t * 64 + i0 + 4); bc[0] = a.x; bc[1] = a.y; bc[2] = a.z; bc[3] = a.w; bc[4] = c.x; bc[5] = c.y; bc[6] = c.z; bc[7] = c.w; }
        { const int tq = edge ? t : tp; const f32x4 a = *(const f32x4*)(B + tq * 64 + i0), c = *(const f32x4*)(B + tq * 64 + i0 + 4);
          bp[0] = a.x; bp[1] = a.y; bp[2] = a.z; bp[3] = a.w; bp[4] = c.x; bp[5] = c.y; bp[6] = c.z; bp[7] = c.w;
          if (edge) {
#pragma unroll
              for (int k = 0; k < 8; ++k) bp[k] = 0.f; } }
        { const f32x4 a = *(const f32x4*)(B + tref * 64 + i0), c = *(const f32x4*)(B + tref * 64 + i0 + 4); br[0] = a.x; br[1] = a.y; br[2] = a.z; br[3] = a.w; br[4] = c.x; br[5] = c.y; br[6] = c.z; br[7] = c.w; }
        float kh[8];
#pragma unroll
        for (int k = 0; k < 8; ++k) { const float kk = 1.f - __expf(bc[k] - bp[k]); kh[k] = kk * __expf(clampe(br[k] - bc[k])); }
        if (!FULL) {
            bf16_t* kt = (bf16_t*)(lds + O_KH + dir * MSZ) + i0 * P + t;
#pragma unroll
            for (int k = 0; k < 8; ++k) kt[k * P] = (bf16_t)f2bf(kh[k]);
        } else {
            u32x4 w; w.x = cvtpk(kh[0], kh[1]); w.y = cvtpk(kh[2], kh[3]); w.z = cvtpk(kh[4], kh[5]); w.w = cvtpk(kh[6], kh[7]);
            *(u32x4*)((bf16_t*)(lds + O_KH + dir * MSZ) + t * P + i0) = w;
            const u32x4 wq = *(const u32x4*)(ZQ + t * 64 + i0);
            float q[8] = {silu(bflo(wq.x)), silu(bfhi(wq.x)), silu(bflo(wq.y)), silu(bfhi(wq.y)), silu(bflo(wq.z)), silu(bfhi(wq.z)), silu(bflo(wq.w)), silu(bfhi(wq.w))};
            float qh[8], qt[8];
#pragma unroll
            for (int k = 0; k < 8; ++k) { qh[k] = q[k] * __expf(clampe(bc[k] - br[k])); qt[k] = q[k] * __expf(bc[k]); }
            w.x = cvtpk(qh[0], qh[1]); w.y = cvtpk(qh[2], qh[3]); w.z = cvtpk(qh[4], qh[5]); w.w = cvtpk(qh[6], qh[7]);
            *(u32x4*)((bf16_t*)(lds + O_QH + dir * MSZ) + t * P + i0) = w;
            w.x = cvtpk(qt[0], qt[1]); w.y = cvtpk(qt[2], qt[3]); w.z = cvtpk(qt[4], qt[5]); w.w = cvtpk(qt[6], qt[7]);
            *(u32x4*)((bf16_t*)(lds + O_QT + dir * MSZ) + t * P + i0) = w;
        }
    }
    __syncthreads();
}

__device__ __forceinline__ void h1_phase(unsigned char* lds, const bf16_t* __restrict__ PROJ, const float* __restrict__ LBFl, bf16_t* __restrict__ UT, float* __restrict__ DEC, int cu, int G) {
    const int tid = otid(), lane = tid & 63, r32 = lane & 31, hi = lane >> 5, w = __builtin_amdgcn_readfirstlane(tid >> 6);
    StageRegs sr;
    if (cu < BATCH * NCH * 4) { const int h = cu & 3, bc = cu >> 2, b = bc / NCH, cp = bc - b * NCH; stage_load<false>(sr, PROJ, b * PB + cp * 64, h); }
    for (int u = cu; u < BATCH * NCH * 4; u += G) {
        const int h = u & 3, bc = u >> 2, b = bc / NCH, cp = bc - b * NCH, row0 = b * PB + cp * 64;
        int nrow0 = -1, nh = 0; { const int un = u + G; if (un < BATCH * NCH * 4) { const int bcn = un >> 2, bn = bcn / NCH; nh = un & 3; nrow0 = bn * PB + (bcn - bn * NCH) * 64; } }
        prep<false>(lds, PROJ, LBFl, row0, h, sr, nrow0, nh);
        const float* ZB = (const float*)(lds + O_ZB);
        {
            const int dir = w >> 2, jb = (w >> 1) & 1, ib = w & 1;
            const bf16_t* VT = (const bf16_t*)(lds + O_VT) + (jb * 32 + r32) * P + hi * 8;
            const bf16_t* KT = (const bf16_t*)(lds + O_KH + dir * MSZ) + (ib * 32 + r32) * P + hi * 8;
            f32x16 acc = {};
#pragma unroll
            for (int ks = 0; ks < 4; ++ks) acc = __builtin_amdgcn_mfma_f32_32x32x16_bf16(*(const bf16x8*)(VT + ks * 16), *(const bf16x8*)(KT + ks * 16), acc, 0, 0, 0);
            const int i = ib * 32 + r32;
            const float btot = ZB[dir * 4096 + (dir == 0 ? 63 : 0) * 64 + i], bref = ZB[dir * 4096 + (dir == 0 ? 31 : 32) * 64 + i];
            const float sc = __expf(btot - bref);
            const int chain = (b * 4 + h) * 2 + dir;
            bf16_t* ut = UT + ((size_t)chain * NCH + cp) * 4096 + i;
#pragma unroll
            for (int r = 0; r < 16; ++r) ut[(jb * 32 + crow(r, hi)) * 64] = (bf16_t)f2bf(acc[r] * sc);
        }
        if (tid < 128) { const int dir = tid >> 6, i = tid & 63; const int chain = (b * 4 + h) * 2 + dir;
            DEC[((size_t)chain * NCH + cp) * 64 + i] = __expf(ZB[dir * 4096 + (dir == 0 ? 63 : 0) * 64 + i]); }
        __syncthreads();
    }
}

__device__ __forceinline__ void h2_phase(unsigned char* lds, const bf16_t* __restrict__ UT, const float* __restrict__ DEC, bf16_t* __restrict__ ST, int cu, int G) {
    const int tid = otid(), seg = tid >> 7, e = tid & 127, jl = e >> 5, i = (e & 31) * 2;
    f32x4* TOT = (f32x4*)(lds + O_TOT);
    for (int task = cu; task < 256; task += G) {
        const int chain = task >> 4, j = (task & 15) * 4 + jl, dir = chain & 1;
        const size_t cbase = (size_t)chain * NCH;
        float S0 = 0.f, S1 = 0.f, P0 = 1.f, P1 = 1.f;
#pragma unroll 11
        for (int kk = 0; kk < 33; ++kk) { const int k = seg * 33 + kk, cp = dir == 0 ? k : (k < 4 ? 3 - k : 135 - k);
            const unsigned u = *(const unsigned*)(UT + (cbase + cp) * 4096 + j * 64 + i); const f32x2 d = *(const f32x2*)(DEC + (cbase + cp) * 64 + i);
            S0 = d.x * S0 + bflo(u); S1 = d.y * S1 + bfhi(u); P0 *= d.x; P1 *= d.y; }
        TOT[seg * 128 + e] = (f32x4){S0, S1, P0, P1};
        __syncthreads();
        float s0 = 0.f, s1 = 0.f;
#pragma unroll
        for (int sp = 0; sp < 3; ++sp) if (sp < seg) { const f32x4 t = TOT[sp * 128 + e]; s0 = t.z * s0 + t.x; s1 = t.w * s1 + t.y; }
#pragma unroll 11
        for (int kk = 0; kk < 33; ++kk) { const int k = seg * 33 + kk, cp = dir == 0 ? k : (k < 4 ? 3 - k : 135 - k);
            const unsigned u = *(const unsigned*)(UT + (cbase + cp) * 4096 + j * 64 + i); const f32x2 d = *(const f32x2*)(DEC + (cbase + cp) * 64 + i);
            *(unsigned*)(ST + (cbase + cp) * 4096 + j * 64 + i) = pk2(s0, s1);
            s0 = d.x * s0 + bflo(u); s1 = d.y * s1 + bfhi(u); }
        __syncthreads();
    }
}

__device__ __forceinline__ void h3_phase(unsigned char* lds, const bf16_t* __restrict__ PROJ, const float* __restrict__ LBFl, const bf16_t* __restrict__ ST, const float* __restrict__ ng, bf16_t* __restrict__ MIX, int cu, int G) {
    const int tid = otid(), lane = tid & 63, r32 = lane & 31, hi = lane >> 5, w = __builtin_amdgcn_readfirstlane(tid >> 6);
    StageRegs sr; u32x4 sv0, sv1;
    const int u0 = G - 1 - cu;
    if (u0 < BATCH * NCH * 4) { const int h = u0 & 3, bc = u0 >> 2, b = bc / NCH, cp = bc - b * NCH; stage_load<true>(sr, PROJ, b * PB + cp * 64, h);
        const size_t so = ((size_t)((b * 4 + h) * 2) * NCH + cp) * 4096 + (tid >> 3) * 64 + (tid & 7) * 8; sv0 = *(const u32x4*)(ST + so); sv1 = *(const u32x4*)(ST + so + (size_t)NCH * 4096); }
    for (int u = u0; u < BATCH * NCH * 4; u += G) {
        const int h = u & 3, bc = u >> 2, b = bc / NCH, cp = bc - b * NCH, row0 = b * PB + cp * 64;
        int nrow0 = -1, nh = 0, nb = 0, ncp = 0; { const int un = u + G; if (un < BATCH * NCH * 4) { const int bcn = un >> 2; nb = bcn / NCH; ncp = bcn - nb * NCH; nh = un & 3; nrow0 = nb * PB + ncp * 64; } }
        { const int j = tid >> 3, ic = (tid & 7) * 8;
          *(u32x4*)((bf16_t*)(lds + O_ST) + j * P + ic) = sv0; *(u32x4*)((bf16_t*)(lds + O_ST + MSZ) + j * P + ic) = sv1;
          if (nrow0 >= 0) { const size_t so = ((size_t)((nb * 4 + nh) * 2) * NCH + ncp) * 4096 + j * 64 + ic; sv0 = *(const u32x4*)(ST + so); sv1 = *(const u32x4*)(ST + so + (size_t)NCH * 4096); } }
        prep<true>(lds, PROJ, LBFl, row0, h, sr, nrow0, nh);
        float* SSQ = (float*)(lds + O_SSQ); bf16_t* OUT = (bf16_t*)(lds + O_OUT);
        f32x16 ot = {};
        const int jb = (w >> 1) & 1, tb = w & 1;
        if (w < 4) {
            const bf16_t* VT = (const bf16_t*)(lds + O_VT) + (jb * 32 + r32) * P;
#pragma unroll
            for (int sb = 0; sb < 2; ++sb) {
                f32x16 xf = {}, xb = {};
                const bf16_t* QF = (const bf16_t*)(lds + O_QH) + (tb * 32 + r32) * P + hi * 8; const bf16_t* QB = QF + 64 * P;
                const bf16_t* KF = (const bf16_t*)(lds + O_KH) + (sb * 32 + r32) * P + hi * 8; const bf16_t* KB = KF + 64 * P;
                if (sb <= tb) {
#pragma unroll
                    for (int ks = 0; ks < 4; ++ks) xf = __builtin_amdgcn_mfma_f32_32x32x16_bf16(*(const bf16x8*)(KF + ks * 16), *(const bf16x8*)(QF + ks * 16), xf, 0, 0, 0); }
                if (sb >= tb) {
#pragma unroll
                    for (int ks = 0; ks < 4; ++ks) xb = __builtin_amdgcn_mfma_f32_32x32x16_bf16(*(const bf16x8*)(KB + ks * 16), *(const bf16x8*)(QB + ks * 16), xb, 0, 0, 0); }
                float x[16];
#pragma unroll
                for (int r = 0; r < 16; ++r) { const int s = crow(r, hi), t = r32;
                    const float vf = (sb < tb || (sb == tb && s <= t)) ? xf[r] : 0.f, vb = (sb > tb || (sb == tb && s >= t)) ? xb[r] : 0.f; x[r] = vf + vb; }
#pragma unroll
                for (int sp = 0; sp < 2; ++sp) {
                    u32x4 xw; xw.x = cvtpk(x[8 * sp + 0], x[8 * sp + 1]); xw.y = cvtpk(x[8 * sp + 2], x[8 * sp + 3]); xw.z = cvtpk(x[8 * sp + 4], x[8 * sp + 5]); xw.w = cvtpk(x[8 * sp + 6], x[8 * sp + 7]);
                    const s16x4 v0 = *(const s16x4*)(VT + sb * 32 + 16 * sp + 4 * hi), v1 = *(const s16x4*)(VT + sb * 32 + 16 * sp + 8 + 4 * hi);
                    const bf16x8 va = {v0[0], v0[1], v0[2], v0[3], v1[0], v1[1], v1[2], v1[3]};
                    ot = __builtin_amdgcn_mfma_f32_32x32x16_bf16(va, __builtin_bit_cast(bf16x8, xw), ot, 0, 0, 0); }
            }
#pragma unroll
            for (int dir = 0; dir < 2; ++dir) {
                const bf16_t* SA = (const bf16_t*)(lds + O_ST + dir * MSZ) + (jb * 32 + r32) * P + hi * 8; const bf16_t* QT = (const bf16_t*)(lds + O_QT + dir * MSZ) + (tb * 32 + r32) * P + hi * 8;
#pragma unroll
                for (int ks = 0; ks < 4; ++ks) ot = __builtin_amdgcn_mfma_f32_32x32x16_bf16(*(const bf16x8*)(SA + ks * 16), *(const bf16x8*)(QT + ks * 16), ot, 0, 0, 0); }
            float part = 0.f;
#pragma unroll
            for (int r = 0; r < 16; ++r) part += ot[r] * ot[r];
            part = xsum<32>(part);
            if (hi == 0) SSQ[jb * 64 + tb * 32 + r32] = part;
        }
        __syncthreads();
        if (w < 4) { const int t = tb * 32 + r32; const float rstd = 1.f / sqrtf((SSQ[t] + SSQ[64 + t]) * (1.f / 64.f) + EPS);
#pragma unroll
            for (int r = 0; r < 16; ++r) { const int j = jb * 32 + crow(r, hi); OUT[t * P + j] = (bf16_t)f2bf(ot[r] * rstd * ng[j]); } }
        __syncthreads();
        {
            const int t = tid >> 3, jc = (tid & 7) * 8;
            const u32x4 y = *(const u32x4*)(OUT + t * P + jc); const u32x4 g = *(const u32x4*)(PROJ + (size_t)(row0 + t) * NIN + C_AG + h * 64 + jc);
            u32x4 o; o.x = pk2(bflo(y.x) * silu(bflo(g.x)), bfhi(y.x) * silu(bfhi(g.x))); o.y = pk2(bflo(y.y) * silu(bflo(g.y)), bfhi(y.y) * silu(bfhi(g.y)));
            o.z = pk2(bflo(y.z) * silu(bflo(g.z)), bfhi(y.z) * silu(bfhi(g.z))); o.w = pk2(bflo(y.w) * silu(bflo(g.w)), bfhi(y.w) * silu(bfhi(g.w)));
            *(u32x4*)(MIX + (size_t)(row0 + t) * D + h * 64 + jc) = o;
        }
        __syncthreads();
    }
}
}
__device__ __forceinline__ int vcu_of(int bx, int G) { return (G % 8 == 0) ? (bx % 8) * (G / 8) + bx / 8 : bx; }
__device__ __forceinline__ void attn_phase(char* lds, const bf16_t* QN, const bf16_t* KN, const bf16_t* PROJ, bf16_t* MIX, float neg_ref, int vcu, int G, bool with_ctx) {
    using attn_body::bf16;
    const int upc = (512 + G - 1) / G;
    const int nun = upc + ((with_ctx && vcu < 16) ? 1 : 0);
    for (int i = 0; i < nun; ++i) {
        int b, h, nt; size_t q0;
        if (i < upc) { const int u = vcu * upc + i; if (u >= 512) continue; const int combo = u >> 7; b = combo >> 1; h = (combo & 1) * 4 + ((u >> 5) & 3); q0 = (size_t)b * PB + CTXL + (size_t)(u & 31) * 256; nt = PB / 64; }
        else { b = vcu >> 3; h = vcu & 7; q0 = (size_t)b * PB; nt = CTXL / 64; }
        const int kvh = h >> 2; const size_t k0 = (size_t)b * PB;
        attn_body::attn_unit((const bf16*)QN + q0 * 512 + h * 64, (const bf16*)KN + k0 * 128 + kvh * 64, (const bf16*)PROJ + k0 * NIN + C_CV + kvh * 64, (bf16*)MIX + q0 * 1024 + 512 + h * 64, nt, neg_ref, lds);
    }
}
namespace pg8 {
struct EpiResid {
    static constexpr bool PERM = false, AFTER_DRAIN = false;
    const float* src_lat; const float* src_ctx; float* dst_lat; float* dst_ctx; const float* modv; int ga_off; int pad;
    __device__ __forceinline__ void operator()(const f32x4 (&acc)[2][2][4][2], const Unit& u, int wr, int wc, int fr, int fq) const {
        asm volatile("" : "+v"(fr), "+v"(fq));
        const int b = u.pm / TPB, w = u.pm - b * TPB;
        const size_t base = (w == 0) ? (size_t)b * CTXL * D : ((size_t)b * SEQ + (size_t)(w - 1) * 256) * D;
        const float* s = ((w == 0) ? src_ctx : src_lat) + base; float* d = ((w == 0) ? dst_ctx : dst_lat) + base;
        const float* ga = modv + ((w == 0) ? 2 : b) * 6144 + ga_off;
        const int row0 = wr * 64 + fr, col0 = u.pn * BM + wc * 32 + 4 * fq;
        f32x4 gv[2][2];
#pragma unroll
        for (int bj = 0; bj < 2; ++bj)
#pragma unroll
            for (int n = 0; n < 2; ++n) gv[bj][n] = *(const f32x4*)(ga + col0 + bj * HALF + n * 16);
#pragma unroll
        for (int ai = 0; ai < 2; ++ai)
#pragma unroll
            for (int m = 0; m < 4; ++m) { const size_t off = (size_t)(row0 + ai * HALF + m * 16) * D + col0;
#pragma unroll
                for (int bj = 0; bj < 2; ++bj)
#pragma unroll
                    for (int n = 0; n < 2; ++n) *(f32x4*)(d + off + bj * HALF + n * 16) = *(const f32x4*)(s + off + bj * HALF + n * 16) + gv[bj][n] * acc[ai][bj][m][n]; }
    }
};
struct OutOrder : StaticOrder {
    int lat_only;
    __device__ __forceinline__ bool next(int i, Unit& u) const { if (!StaticOrder::next(i, u)) return false; if (lat_only) u.pm = (u.pm >> 5) * TPB + 1 + (u.pm & 31); return true; }
};
}


namespace pg8 {
struct MUnit { int pm, pn, nrows, lbase, e0, e1; };
__device__ __forceinline__ void build_tiles(PG8_LAS int* TT, const unsigned* cnt) {
    if (otid() == 0) { int off = 0;
        for (int bk = 0; bk < 24; ++bk) { const int c = (int)__hip_atomic_load(cnt + bk, __ATOMIC_RELAXED, __HIP_MEMORY_SCOPE_AGENT); const int nb = (c + 255) >> 8;
            for (int ti = 0; ti < nb; ++ti) { const int rem = c - ti * 256; TT[4 + 4 * off + 0] = bk; TT[4 + 4 * off + 1] = ti; TT[4 + 4 * off + 2] = rem < 256 ? rem : 256; TT[4 + 4 * off + 3] = 0; ++off; } }
        TT[0] = off; }
    __syncthreads();
}
template <int NPN  > struct MoeOrder {
    const PG8_LAS int* TT; int G, c;
    __device__ __forceinline__ bool next(int i, MUnit& u) const {
        const int L = i * G + c, tile = L / NPN; if (tile >= TT[0]) return false;
        const int bk = TT[4 + 4 * tile], ti = TT[4 + 4 * tile + 1];
        u.pm = tile; u.pn = L - tile * NPN; u.nrows = TT[4 + 4 * tile + 2]; u.lbase = bk * MT + ti * 256;
        const int g = bk / 6, pi = bk - g * 6; const int lo = pi < 3 ? 0 : (pi < 5 ? 1 : 2), hi = pi < 3 ? pi + 1 : (pi < 5 ? pi - 1 : 3);
        u.e0 = 4 * g + lo; u.e1 = 4 * g + hi; return true;
    }
};
struct Src1 {
    const bf16_t* XN; const bf16_t* WGU; const u32x4* LIST;
    __device__ __forceinline__ const char* a_base(const MUnit&) const { return (const char*)XN; }
    __device__ __forceinline__ void a_offsets(const MUnit& u, const int (&RA)[2], const int (&CA)[2], unsigned (&ao)[2][2]) const {
#pragma unroll
        for (int h = 0; h < 2; ++h)
#pragma unroll
            for (int i = 0; i < 2; ++i) { const int r = h * HALF + RA[i]; const unsigned row = r < u.nrows ? LIST[u.lbase + r].x : 0u; ao[h][i] = (row * (unsigned)D + (unsigned)CA[i]) * 2u; }
    }
    __device__ __forceinline__ const char* b_base(const MUnit& u, int seg) const { const int e = (u.pn >> 2) ? u.e1 : u.e0;
        return (const char*)(WGU + ((size_t)e * 1024 + (size_t)(u.pn & 3) * 256) * D) + (seg ? (size_t)(D / 2) * 2 : 0); }
    __device__ __forceinline__ void prefetch_rows(const MUnit& u, const int (&)[2], PG8_LAS unsigned char* rows, int wid) const {
        int t2 = otid(); asm volatile("" : "+v"(t2));
        int RA[2];
#pragma unroll
        for (int i = 0; i < 2; ++i) { int R, C; stage_rc(t2 * 16 + i * 8192, R, C); RA[i] = R; }
#pragma unroll
        for (int h = 0; h < 2; ++h)
#pragma unroll
            for (int i = 0; i < 2; ++i) { const int r = h * HALF + RA[i];
                __builtin_amdgcn_global_load_lds((const unsigned*)&LIST[u.lbase + r], (PG8_LAS unsigned*)(rows + ((h * 2 + i) * 8 + wid) * 256), 4, 0, 0); }
    }
    __device__ __forceinline__ void reload_offsets(const MUnit& u, const int (&)[2], const int (&)[2], const PG8_LAS unsigned char* rows, int wid, int lane, unsigned (&ao)[2][2]) const {
        int t2 = otid(); asm volatile("" : "+v"(t2));
        int RA[2], CA[2];
#pragma unroll
        for (int i = 0; i < 2; ++i) { int R, C; stage_rc(t2 * 16 + i * 8192, R, C); RA[i] = R; CA[i] = C; }
#pragma unroll
        for (int h = 0; h < 2; ++h)
#pragma unroll
            for (int i = 0; i < 2; ++i) { const int r = h * HALF + RA[i]; const unsigned v = *(const PG8_LAS unsigned*)(rows + ((h * 2 + i) * 8 + wid) * 256 + lane * 4);
                const unsigned row = r < u.nrows ? v : 0u; ao[h][i] = (row * (unsigned)D + (unsigned)CA[i]) * 2u; }
    }
};
struct Src2 {
    const bf16_t* ACT2; const bf16_t* WD;
    __device__ __forceinline__ const char* a_base(const MUnit& u) const { return (const char*)(ACT2 + (size_t)u.pm * 256 * 1024); }
    __device__ __forceinline__ void a_offsets(const MUnit&, const int (&RA)[2], const int (&CA)[2], unsigned (&ao)[2][2]) const {
#pragma unroll
        for (int h = 0; h < 2; ++h)
#pragma unroll
            for (int i = 0; i < 2; ++i) ao[h][i] = (unsigned)((h * HALF + RA[i]) * 1024 + CA[i]) * 2u;
    }
    __device__ __forceinline__ const char* b_base(const MUnit& u, int seg) const { const int e = seg ? u.e1 : u.e0; return (const char*)(WD + ((size_t)e * 1024 + (size_t)u.pn * 256) * DE); }
    __device__ __forceinline__ void prefetch_rows(const MUnit&, const int (&)[2], PG8_LAS unsigned char*, int) const {}
    __device__ __forceinline__ void reload_offsets(const MUnit&, const int (&)[2], const int (&)[2], const PG8_LAS unsigned char*, int, int, unsigned (&)[2][2]) const {}
};
struct EpiGateUp2 {
    static constexpr bool PERM = true;
    bf16_t* ACT2; const u32x4* LIST;
    __device__ __forceinline__ void operator()(const f32x4 (&acc)[2][2][4][2], const MUnit& u, int wr, int wc, int fr, int fq) const {
        asm volatile("" : "+v"(fr), "+v"(fq));
        const int slot = u.pn >> 2, colA = slot * DE + (u.pn & 3) * HALF + wc * 32 + 8 * fq;
        const unsigned* lw = (const unsigned*)(LIST + u.lbase + wr * 64 + fr) + 1 + slot;
#pragma unroll
        for (int ai = 0; ai < 2; ++ai) {
            unsigned wv[4];
#pragma unroll
            for (int m = 0; m < 4; ++m) wv[m] = lw[(ai * HALF + m * 16) * 4];
#pragma unroll
            for (int m = 0; m < 4; ++m) { const int r = ai * HALF + wr * 64 + m * 16 + fr;
                const bool valid = r < u.nrows; const float cw = valid ? __uint_as_float(wv[m]) : 0.f;
                const f32x4 g0 = acc[ai][0][m][0], g1 = acc[ai][0][m][1], u0 = acc[ai][1][m][0], u1 = acc[ai][1][m][1];
                u32x4 w;
                w.x = cvt_pk_bf16(silu(g0[0]) * u0[0] * cw, silu(g0[1]) * u0[1] * cw); w.y = cvt_pk_bf16(silu(g0[2]) * u0[2] * cw, silu(g0[3]) * u0[3] * cw);
                w.z = cvt_pk_bf16(silu(g1[0]) * u1[0] * cw, silu(g1[1]) * u1[1] * cw); w.w = cvt_pk_bf16(silu(g1[2]) * u1[2] * cw, silu(g1[3]) * u1[3] * cw);
                if (!valid) w = (u32x4){0u, 0u, 0u, 0u};
                *(u32x4*)(ACT2 + ((size_t)u.pm * 256 + r) * 1024 + colA) = w; }
            asm volatile("" ::: "memory"); }
    }
};
struct EpiMoeOut {
    static constexpr bool PERM = false;
    float* lat; float* ctx; const float* modv; const u32x4* LIST;
    __device__ __forceinline__ void operator()(const f32x4 (&acc)[2][2][4][2], const MUnit& u, int wr, int wc, int fr, int fq) const {
        asm volatile("" : "+v"(fr), "+v"(fq));
        const int col0 = u.pn * BM + wc * 32 + 4 * fq;
        const unsigned* lw = (const unsigned*)(LIST + u.lbase + wr * 64 + fr);
        unsigned rv[2][4];
#pragma unroll
        for (int ai = 0; ai < 2; ++ai)
#pragma unroll
            for (int m = 0; m < 4; ++m) rv[ai][m] = lw[(ai * HALF + m * 16) * 4];
#pragma unroll
        for (int ai = 0; ai < 2; ++ai)
#pragma unroll
            for (int m = 0; m < 4; ++m) { const int r = ai * HALF + wr * 64 + m * 16 + fr;
                if (r < u.nrows) { const int row = (int)rv[ai][m]; bool is_ctx; const size_t off = stream_off(row, is_ctx);
                    float* d = (is_ctx ? ctx : lat) + off + col0; const float* ga = modv + (is_ctx ? 2 : row / PB) * 6144 + 5120 + col0;
#pragma unroll
                    for (int bj = 0; bj < 2; ++bj)
#pragma unroll
                        for (int n = 0; n < 2; ++n) { f32x4* p = (f32x4*)(d + bj * HALF + n * 16); *p = *p + *(const f32x4*)(ga + bj * HALF + n * 16) * acc[ai][bj][m][n]; } } }
    }
};

template <class Epi, class Sched, class Src>
__device__ __forceinline__ void gemm_phase_x(PG8_LAS unsigned char* lds, PG8_LAS unsigned char* rows, const Sched& S, const Src& X, const Epi& E, const int KB, const int nt) {
    const int tid = otid(), wid = __builtin_amdgcn_readfirstlane(tid >> 6), lane = tid & 63, wr = wid >> 2, wc = wid & 3, fr = lane & 15, fq = lane >> 4;
    int RA[2], CA[2]; unsigned voffB[2];
#pragma unroll
    for (int i = 0; i < 2; ++i) { int R, C; stage_rc(tid * 16 + i * 8192, R, C); const int Rb = Epi::PERM ? ((R & ~31) + perm32(R & 31)) : R; RA[i] = R; CA[i] = C; voffB[i] = (unsigned)(Rb * KB + C) * 2u; }
    const size_t kstep = (size_t)(BK * 2);
    const size_t hstepB = (size_t)HALF * KB * 2;
    const int half = nt >> 1;
    const unsigned ldsw = (unsigned)wid * 1024u;
    const int aoff = lds_byte(wr * 64 + fr, fq * 8), boff = lds_byte(wc * 32 + fr, fq * 8);
#define PG8_SA(b, h) (((b) * 2 + (h)) * HTB)
#define PG8_SB(b, h) ((4 + (b) * 2 + (h)) * HTB)
#define PG8_STAGE_B(bufoff, gbase) do { _Pragma("unroll") for (int _i = 0; _i < 2; ++_i) \
        __builtin_amdgcn_global_load_lds((const unsigned*)((const char*)(gbase) + voffB[_i]), (PG8_LAS unsigned*)(lds + (bufoff) + ldsw + _i * 8192), 16, 0, 0); } while (0)
#define PG8_STAGE_A(bufoff, gbase, o0, o1) do { \
        __builtin_amdgcn_global_load_lds((const unsigned*)((const char*)(gbase) + (o0)), (PG8_LAS unsigned*)(lds + (bufoff) + ldsw), 16, 0, 0); \
        __builtin_amdgcn_global_load_lds((const unsigned*)((const char*)(gbase) + (o1)), (PG8_LAS unsigned*)(lds + (bufoff) + ldsw + 8192), 16, 0, 0); } while (0)
#define PG8_LDA(dst, b, h) do { _Pragma("unroll") for (int m = 0; m < 4; ++m) _Pragma("unroll") for (int k = 0; k < 2; ++k) dst[m][k] = *(const PG8_LAS bf16x8*)(lds + PG8_SA(b, h) + aoff + m * 2048 + k * 1024); } while (0)
#define PG8_LDB(dst, b, h) do { _Pragma("unroll") for (int n = 0; n < 2; ++n) _Pragma("unroll") for (int k = 0; k < 2; ++k) dst[n][k] = *(const PG8_LAS bf16x8*)(lds + PG8_SB(b, h) + boff + n * 2048 + k * 1024); } while (0)
#define PG8_MMA(ai, bj, At, Bt) do { __builtin_amdgcn_s_setprio(1); _Pragma("unroll") for (int m = 0; m < 4; ++m) _Pragma("unroll") for (int n = 0; n < 2; ++n) _Pragma("unroll") for (int k = 0; k < 2; ++k) \
        acc[ai][bj][m][n] = __builtin_amdgcn_mfma_f32_16x16x32_bf16(Bt[n][k], At[m][k], acc[ai][bj][m][n], 0, 0, 0); __builtin_amdgcn_s_setprio(0); } while (0)
#define PG8_WAIT_V(n) asm volatile("s_waitcnt vmcnt(" #n ")" ::: "memory")
#define PG8_WAIT_L(n) asm volatile("s_waitcnt lgkmcnt(" #n ")" ::: "memory")
#define PG8_BAR __builtin_amdgcn_s_barrier()
#define PG8_SCHED __builtin_amdgcn_sched_barrier(0)
    MUnit cur, nxt; int ui = 0;
    if (!S.next(0, cur)) return;
    f32x4 acc[2][2][4][2];
#pragma unroll
    for (int a = 0; a < 2; ++a)
#pragma unroll
        for (int b = 0; b < 2; ++b)
#pragma unroll
            for (int m = 0; m < 4; ++m)
#pragma unroll
                for (int n = 0; n < 2; ++n) acc[a][b][m][n] = (f32x4){0.f, 0.f, 0.f, 0.f};
    bf16x8 At[4][2], B0[2][2], B1[2][2];
    unsigned aoc[2][2];
    X.a_offsets(cur, RA, CA, aoc);
    const char* cAb = X.a_base(cur); const char* cB0 = X.b_base(cur, 0); const char* cB1 = X.b_base(cur, 1);
    PG8_STAGE_B(PG8_SB(0, 0), cB0); PG8_STAGE_B(PG8_SB(0, 1), cB0 + hstepB); PG8_STAGE_A(PG8_SA(0, 0), cAb, aoc[0][0], aoc[0][1]); PG8_STAGE_A(PG8_SA(0, 1), cAb, aoc[1][0], aoc[1][1]);
    if (wr == 1) PG8_BAR;
    PG8_WAIT_V(2); PG8_BAR;
    PG8_STAGE_B(PG8_SB(1, 0), cB0 + kstep); PG8_STAGE_A(PG8_SA(1, 0), cAb + kstep, aoc[0][0], aoc[0][1]); PG8_STAGE_B(PG8_SB(1, 1), cB0 + hstepB + kstep);
    PG8_WAIT_V(6); PG8_BAR;
    for (;;) {
        const bool has_next = S.next(ui + 1, nxt);
        const char* nAb = cAb; const char* nB0 = cB0; const char* nB1 = cB1;
        if (has_next) { X.prefetch_rows(nxt, RA, rows, wid); nAb = X.a_base(nxt); nB0 = X.b_base(nxt, 0); nB1 = X.b_base(nxt, 1); }
        for (int t = 0; t < nt; t += 2) {
            const bool last = (t == nt - 2);
            const char* a1 = cAb + (size_t)(t + 1) * kstep;
            const int kt2 = t + 2;
            const char* b2 = last ? nB0 : (kt2 < half ? cB0 + (size_t)kt2 * kstep : cB1 + (size_t)(kt2 - half) * kstep);
            const char* a2 = last ? nAb : cAb + (size_t)kt2 * kstep;
            const char* a3 = a2 + kstep; const char* b3 = b2 + kstep;
            PG8_LDB(B0, 0, 0); PG8_LDB(B1, 0, 1); PG8_SCHED; PG8_LDA(At, 0, 0); PG8_STAGE_A(PG8_SA(1, 1), a1, aoc[1][0], aoc[1][1]);
            if (last && has_next) X.reload_offsets(nxt, RA, CA, rows, wid, lane, aoc);
            PG8_WAIT_V(8); PG8_WAIT_L(0); PG8_BAR; PG8_MMA(0, 0, At, B0); PG8_MMA(0, 1, At, B1); PG8_BAR; PG8_SCHED;
            PG8_LDA(At, 0, 1); PG8_STAGE_B(PG8_SB(0, 0), b2); PG8_STAGE_B(PG8_SB(0, 1), b2 + hstepB); PG8_STAGE_A(PG8_SA(0, 0), a2, aoc[0][0], aoc[0][1]);
            PG8_WAIT_V(8); PG8_WAIT_L(0); PG8_BAR; PG8_MMA(1, 0, At, B0); PG8_MMA(1, 1, At, B1); PG8_BAR; PG8_SCHED;
            PG8_LDB(B0, 1, 0); PG8_LDB(B1, 1, 1); PG8_SCHED; PG8_LDA(At, 1, 0); PG8_STAGE_A(PG8_SA(0, 1), a2, aoc[1][0], aoc[1][1]);
            PG8_WAIT_V(8); PG8_WAIT_L(0); PG8_BAR; PG8_MMA(0, 0, At, B0); PG8_MMA(0, 1, At, B1); PG8_BAR; PG8_SCHED;
            PG8_LDA(At, 1, 1); PG8_STAGE_B(PG8_SB(1, 0), b3); PG8_STAGE_B(PG8_SB(1, 1), b3 + hstepB); PG8_STAGE_A(PG8_SA(1, 0), a3, aoc[0][0], aoc[0][1]);
            PG8_WAIT_V(8); PG8_WAIT_L(0); PG8_BAR; PG8_MMA(1, 0, At, B0); PG8_MMA(1, 1, At, B1); PG8_BAR; PG8_SCHED;
        }
        if (wr == 0) PG8_BAR;
        E(acc, cur, wr, wc, fr, fq);
        if (!has_next) break;
#pragma unroll
        for (int a = 0; a < 2; ++a)
#pragma unroll
            for (int b = 0; b < 2; ++b)
#pragma unroll
                for (int m = 0; m < 4; ++m)
#pragma unroll
                    for (int n = 0; n < 2; ++n) acc[a][b][m][n] = (f32x4){0.f, 0.f, 0.f, 0.f};
        cur = nxt; cAb = nAb; cB0 = nB0; cB1 = nB1; ++ui;
        if (wr == 1) PG8_BAR;
    }
    PG8_WAIT_V(0);
    PG8_BAR;
#undef PG8_SA
#undef PG8_SB
#undef PG8_STAGE_A
#undef PG8_STAGE_B
#undef PG8_LDA
#undef PG8_LDB
#undef PG8_MMA
#undef PG8_WAIT_V
#undef PG8_WAIT_L
#undef PG8_BAR
#undef PG8_SCHED
}
}

constexpr int TT_OFF = 132096;
constexpr int ROWS_OFF = 134144;

#define XB_TMO      128
#define XB_XCNT(j)  (256  + 64 * (j))
#define XB_XSUB(j)  (1280 + 64 * (j))
#define XB_XGEN(j)  (2304 + 64 * (j))
#define XB_TOP      3328
#define XB_TOPGEN   3392
#define XCD_BAR_WORDS 3456
#define XB_SPIN_CAP (1u << 18)

__device__ __forceinline__ unsigned xb_ld(unsigned* p)              { return __hip_atomic_load(p, __ATOMIC_RELAXED, __HIP_MEMORY_SCOPE_AGENT); }
__device__ __forceinline__ unsigned xb_add(unsigned* p, unsigned v) { return __hip_atomic_fetch_add(p, v, __ATOMIC_RELAXED, __HIP_MEMORY_SCOPE_AGENT); }
__device__ __forceinline__ unsigned xb_xcc_id() { return (unsigned)__builtin_amdgcn_s_getreg((3 << 11) | 20) & 0xFu; }
#define XB_SPIN(cond, bar) do { unsigned _sp = 0; while (cond) { __builtin_amdgcn_s_sleep(1); \
    if ((++_sp & 255u) == 0u) { if (xb_ld(&(bar)[XB_TMO])) break; if (_sp > XB_SPIN_CAP) { atomicAdd(&(bar)[XB_TMO], 1u); break; } } } } while (0)

struct XcdBarrier {
    unsigned* bar; unsigned x;
    volatile LAS unsigned* st;
};

__device__ __forceinline__ XcdBarrier xcd_barrier_post(unsigned* bar, volatile LAS unsigned* st) {
    XcdBarrier b; b.bar = bar; b.x = xb_xcc_id(); b.st = st;
    if (threadIdx.x == 0) (void)xb_add(&bar[XB_XCNT(b.x)], 1u);
    return b;
}
__device__ __forceinline__ void xcd_barrier_complete(unsigned* bar, unsigned x, unsigned& nloc, unsigned& nx) {
    const unsigned G = gridDim.x * gridDim.y * gridDim.z;
    unsigned sum, cnt, mine, sp = 0u;
    for (;;) {
        sum = 0u; cnt = 0u; mine = 0u;
#pragma unroll
        for (unsigned j = 0; j < 16; ++j) { const unsigned c = xb_ld(&bar[XB_XCNT(j)]); sum += c; cnt += (c > 0u) ? 1u : 0u; mine = (j == x) ? c : mine; }
        if (sum == G) break;
        __builtin_amdgcn_s_sleep(1);
        if ((++sp & 255u) == 0u) { if (xb_ld(&bar[XB_TMO])) break; if (sp > XB_SPIN_CAP) { atomicAdd(&bar[XB_TMO], 1u); break; } }
    }
    nloc = mine > 0u ? mine : 1u; nx = cnt > 0u ? cnt : 1u;
}

__device__ __forceinline__ void xcd_barrier(const XcdBarrier& b) {
    asm volatile("s_waitcnt vmcnt(0)" ::: "memory");
    __syncthreads();
    if (threadIdx.x == 0) {
        unsigned* bar = b.bar;
        __builtin_amdgcn_s_waitcnt(0);
        unsigned nloc = b.st[0], nx = b.st[1];
        if (nloc == 0u) { xcd_barrier_complete(bar, b.x, nloc, nx); b.st[0] = nloc; b.st[1] = nx; }
        const unsigned old = xb_add(&bar[XB_XSUB(b.x)], 1u);
        const unsigned gen = old / nloc;
        if (old + 1u == (gen + 1u) * nloc) {
            __builtin_amdgcn_fence(__ATOMIC_RELEASE, "agent");
            asm volatile("s_waitcnt vmcnt(0)" ::: "memory");
            const unsigned og = xb_add(&bar[XB_TOP], 1u);
            const unsigned tg = og / nx;
            if (og + 1u == (tg + 1u) * nx) xb_add(&bar[XB_TOPGEN], 1u);
            else XB_SPIN(xb_ld(&bar[XB_TOPGEN]) == tg, bar);
            __builtin_amdgcn_fence(__ATOMIC_ACQUIRE, "agent");
            xb_add(&bar[XB_XGEN(b.x)], 1u);
            asm volatile("s_waitcnt vmcnt(0)" ::: "memory");
        } else {
            XB_SPIN(xb_ld(&bar[XB_XGEN(b.x)]) == gen, bar);
            __builtin_amdgcn_fence(__ATOMIC_ACQUIRE, "agent");
            asm volatile("s_waitcnt vmcnt(0)" ::: "memory");
        }
    }
    __syncthreads();
}

constexpr int LDS_BYTES = 147456;
constexpr int LDSCTL_OFF = 131072, MISC_OFF = LDSCTL_OFF + 320;
constexpr int CW_BAR = 4096;
constexpr int NPHASE = 1 + 9 * DEPTH;
#ifndef MK_SPLIT
#define MK_SPLIT 0
#endif
struct Args {
    const float *x, *c, *ctx, *c_ctx, *w_mod, *b_mod, *norm1_g, *norm2_g, *w_in, *w_out, *hgrn_lb, *hgrn_norm_g, *pool_w, *pool_scale, *q_norm_g, *k_norm_g, *router_w, *router_b, *moe_gate, *moe_up, *moe_down;
    float* out; unsigned char* ws; int ph_lo, ph_hi;
};
typedef const __attribute__((address_space(4))) Args* KArgs;
__device__ __forceinline__ KArgs kargs() { KArgs p = (KArgs)__builtin_amdgcn_kernarg_segment_ptr(); asm volatile("" : "+s"(p)); return p; }
__global__ void __launch_bounds__(512, 2) mega_fwd(Args A_unused) {
    extern __shared__ __attribute__((aligned(16))) unsigned char lds[];
    for (int u = otid(); u < (LDS_BYTES - LDSCTL_OFF) / 4; u += 512) ((LAS unsigned*)((LAS unsigned char*)lds + LDSCTL_OFF))[u] = 0u;
    __syncthreads();
    XcdBarrier bar;
    { KArgs ap = kargs(); unsigned* CTL = (unsigned*)(ap->ws + WS_CTL); bar.bar = CTL + CW_BAR; bar.x = 0; bar.st = nullptr;
      if (!MK_SPLIT) bar = xcd_barrier_post(CTL + CW_BAR, (volatile LAS unsigned*)((LAS unsigned char*)lds + MISC_OFF) + 8); }
    int lo, hi; { KArgs ap = kargs(); lo = ap->ph_lo; hi = ap->ph_hi; }
#ifndef PHMASK
#define PHMASK 0x3ff
#endif
#define IN(k) (lo <= (k) && (k) < hi)
#define SEAM(k) do { if (!MK_SPLIT && IN((k) + 1)) xcd_barrier(bar); } while (0)
#define GCU const int G = (int)gridDim.x, cu = (int)blockIdx.x
#ifndef DUPMASK
#define DUPMASK 0
#endif
    LAS unsigned char* ldsl = (LAS unsigned char*)lds;
    if ((PHMASK & 0x200) && IN(0)) {
        _Pragma("unroll") for (int rep_ = 0; rep_ < ((((DUPMASK) & (0x200)) && true) ? 2 : 1); ++rep_) {
        KArgs ap = kargs(); unsigned char* ws = ap->ws; GCU;
        ProArgs pa; pa.c = ap->c; pa.c_ctx = ap->c_ctx; pa.w_mod = ap->w_mod; pa.b_mod = ap->b_mod; pa.hgrn_lb = ap->hgrn_lb; pa.qg = ap->q_norm_g; pa.kg = ap->k_norm_g; pa.w_in = ap->w_in; pa.w_out = ap->w_out; pa.pool_w = ap->pool_w;
        pa.gate = ap->moe_gate; pa.up = ap->moe_up; pa.down = ap->moe_down; pa.MODV = (float*)(ws + WS_MODV); pa.LBF = (float*)(ws + WS_LBF); pa.REF = (float*)(ws + WS_REF); pa.COS = (float*)(ws + WS_COS); pa.SIN = (float*)(ws + WS_SIN);
        pa.WIN = (bf16_t*)(ws + WS_WIN); pa.WOUT = (bf16_t*)(ws + WS_WOUT); pa.POOLWT = (bf16_t*)(ws + WS_POOLWT); pa.WGU = (bf16_t*)(ws + WS_WGU); pa.WD = (bf16_t*)(ws + WS_WD);
        prologue_phase(lds, pa, cu, G);
            if (rep_ + 1 < ((((DUPMASK) & (0x200)) && true) ? 2 : 1)) xcd_barrier(bar); }
        SEAM(0);
    }
    for (int l = 0; l < DEPTH; ++l) {
        const int pb = 1 + 9 * l;
        if ((PHMASK & 1) && IN(pb + 0)) {
        _Pragma("unroll") for (int rep_ = 0; rep_ < ((((DUPMASK) & (1)) && true) ? 2 : 1); ++rep_) {
            KArgs ap = kargs(); unsigned char* ws = ap->ws; GCU;
            const float* slat = (l == 0) ? ap->x : ap->out; const float* sctx = (l == 0) ? ap->ctx : (const float*)(ws + WS_XC);
            norm1_phase(cu, G, slat, sctx, ap->norm1_g + l * D, (const float*)(ws + WS_MODV) + (size_t)l * 3 * 6144, 0, (bf16_t*)(ws + WS_XN));
            if (rep_ + 1 < ((((DUPMASK) & (1)) && true) ? 2 : 1)) xcd_barrier(bar); }
            SEAM(pb + 0);
        }
        if ((PHMASK & 2) && IN(pb + 1)) {
        _Pragma("unroll") for (int rep_ = 0; rep_ < ((((DUPMASK) & (2)) && true) ? 2 : 1); ++rep_) {
            KArgs ap = kargs(); unsigned char* ws = ap->ws; GCU;
            pg8::Gemm g; g.A = (const bf16_t*)(ws + WS_XN); g.Bt = (const bf16_t*)(ws + WS_WIN) + (size_t)l * NIN * D; g.M = MT; g.N = NIN; g.K = D; g.pad = 0;
            pg8::StaticOrder S; S.init(MT, NIN, G, cu);
            pg8::EpiBf16<0> E; E.O = (bf16_t*)(ws + WS_PROJ); E.ldc = NIN; E.bias = nullptr; E.split_cols = 0; E.split_stride = 0; E.scale0 = 1.f;
            pg8::gemm_phase<pg8::EpiBf16<0>, pg8::StaticOrder, true, true>(ldsl, g, S, E);
            { KArgs aq = kargs(); if (l == 0) moe_filler(lds, aq->moe_gate, aq->moe_up, aq->moe_down, aq->ws, 0, 0, 5530, (MT / 256) * (NIN / 256), G, cu);
              else moe_filler(lds, aq->moe_gate, aq->moe_up, aq->moe_down, aq->ws, 1, 7986, MOE_ITEMS, (MT / 256) * (NIN / 256), G, cu); }
            if (rep_ + 1 < ((((DUPMASK) & (2)) && true) ? 2 : 1)) xcd_barrier(bar); }
            SEAM(pb + 1);
        }
        if ((PHMASK & 4) && IN(pb + 2)) {
        _Pragma("unroll") for (int rep_ = 0; rep_ < ((((DUPMASK) & (4)) && true) ? 2 : 1); ++rep_) {
            KArgs ap = kargs(); unsigned char* ws = ap->ws; GCU;
            const bf16_t* PROJ = (const bf16_t*)(ws + WS_PROJ);
            post_phase(cu, G, PROJ, ap->q_norm_g + l * 64, ap->k_norm_g + l * 64, (const float*)(ws + WS_COS), (const float*)(ws + WS_SIN), (bf16_t*)(ws + WS_QN), (bf16_t*)(ws + WS_KN));
            pool::pool_phase(lds, PROJ, (const bf16_t*)(ws + WS_POOLWT) + (size_t)l * 4 * 4096, ap->pool_scale + l * 256, (bf16_t*)(ws + WS_MIX), cu, G);
            hg::h1_phase(lds, PROJ, (const float*)(ws + WS_LBF) + l * 512, (bf16_t*)(ws + WS_UT), (float*)(ws + WS_DEC), cu, G);
            if (rep_ + 1 < ((((DUPMASK) & (4)) && true) ? 2 : 1)) xcd_barrier(bar); }
            SEAM(pb + 2);
        }
        if ((PHMASK & 8) && IN(pb + 3)) {
        _Pragma("unroll") for (int rep_ = 0; rep_ < ((((DUPMASK) & (8)) && true) ? 2 : 1); ++rep_) {
            KArgs ap = kargs(); unsigned char* ws = ap->ws; GCU; hg::h2_phase(lds, (const bf16_t*)(ws + WS_UT), (const float*)(ws + WS_DEC), (bf16_t*)(ws + WS_ST), cu, G);
            if (rep_ + 1 < ((((DUPMASK) & (8)) && true) ? 2 : 1)) xcd_barrier(bar); }
            SEAM(pb + 3);
        }
        if ((PHMASK & 16) && IN(pb + 4)) {
        _Pragma("unroll") for (int rep_ = 0; rep_ < ((((DUPMASK) & (16)) && true) ? 2 : 1); ++rep_) {
            { KArgs ap = kargs(); unsigned char* ws = ap->ws; GCU;
              attn_phase((char*)lds, (const bf16_t*)(ws + WS_QN), (const bf16_t*)(ws + WS_KN), (const bf16_t*)(ws + WS_PROJ), (bf16_t*)(ws + WS_MIX), ((const float*)(ws + WS_REF))[l * 64], vcu_of(cu, G), G, true); }
            { KArgs ap = kargs(); unsigned char* ws = ap->ws; GCU;
              hg::h3_phase(lds, (const bf16_t*)(ws + WS_PROJ), (const float*)(ws + WS_LBF) + l * 512, (const bf16_t*)(ws + WS_ST), ap->hgrn_norm_g + l * 64, (bf16_t*)(ws + WS_MIX), cu, G); }
            if (rep_ + 1 < ((((DUPMASK) & (16)) && true) ? 2 : 1)) xcd_barrier(bar); }
            SEAM(pb + 4);
        }
        if ((PHMASK & 32) && IN(pb + 5)) {
        _Pragma("unroll") for (int rep_ = 0; rep_ < ((((DUPMASK) & (32)) && (l == 0)) ? 2 : 1); ++rep_) {
            KArgs ap = kargs(); unsigned char* ws = ap->ws; GCU;
            pg8::Gemm g; g.A = (const bf16_t*)(ws + WS_MIX); g.Bt = (const bf16_t*)(ws + WS_WOUT) + (size_t)l * D * D; g.M = MT; g.N = D; g.K = D; g.pad = 0;
            pg8::OutOrder S; S.lat_only = (l == DEPTH - 1); S.init(S.lat_only ? BATCH * SEQ : MT, D, G, cu);
            pg8::EpiResid E; E.src_lat = (l == 0) ? ap->x : ap->out; E.src_ctx = (l == 0) ? ap->ctx : (const float*)(ws + WS_XC); E.dst_lat = ap->out; E.dst_ctx = (float*)(ws + WS_XC);
            E.modv = (const float*)(ws + WS_MODV) + (size_t)l * 3 * 6144; E.ga_off = 2048; E.pad = 0;
            pg8::gemm_phase<pg8::EpiResid, pg8::OutOrder, true, true>(ldsl, g, S, E);
            if (l == 0) { KArgs aq = kargs(); moe_filler(lds, aq->moe_gate, aq->moe_up, aq->moe_down, aq->ws, 0, 5530, MOE_ITEMS, (MT / 256) * (D / 256), G, cu); }
            if (rep_ + 1 < ((((DUPMASK) & (32)) && (l == 0)) ? 2 : 1)) xcd_barrier(bar); }
            SEAM(pb + 5);
        }
        if ((PHMASK & 64) && IN(pb + 6)) {
        _Pragma("unroll") for (int rep_ = 0; rep_ < ((((DUPMASK) & (64)) && true) ? 2 : 1); ++rep_) {
            KArgs ap = kargs(); unsigned char* ws = ap->ws; GCU;
            norm2_router_phase(lds, cu, G, ap->out, (const float*)(ws + WS_XC), ap->norm2_g + l * D, (const float*)(ws + WS_MODV) + (size_t)l * 3 * 6144, 3072, ap->router_w, ap->router_b, (bf16_t*)(ws + WS_XN),
                               (unsigned*)(ws + WS_CTL) + CW_CNT + 64 * l + 32 * rep_, (u32x4*)(ws + WS_LIST), l == 0 ? 1 : 0);
            if (rep_ + 1 < ((((DUPMASK) & (64)) && true) ? 2 : 1)) xcd_barrier(bar); }
            SEAM(pb + 6);
        }
        if ((PHMASK & 128) && IN(pb + 7)) {
        _Pragma("unroll") for (int rep_ = 0; rep_ < ((((DUPMASK) & (128)) && true) ? 2 : 1); ++rep_) {
            KArgs ap = kargs(); unsigned char* ws = ap->ws; GCU;
            LAS int* TT = (LAS int*)(ldsl + TT_OFF);
            pg8::build_tiles(TT, (const unsigned*)(ws + WS_CTL) + CW_CNT + 64 * l);
            pg8::MoeOrder<8> S; S.TT = TT; S.G = G; S.c = vcu_of(cu, G);
            pg8::Src1 X; X.XN = (const bf16_t*)(ws + WS_XN); X.WGU = (const bf16_t*)(ws + (l ? WS_WGU1 : WS_WGU)); X.LIST = (const u32x4*)(ws + WS_LIST); pg8::EpiGateUp2 E; E.ACT2 = (bf16_t*)(ws + WS_ACT2); E.LIST = X.LIST;
            pg8::gemm_phase_x(ldsl, ldsl + ROWS_OFF, S, X, E, D, D / 64);
            if (l == 0) { KArgs aq = kargs(); const int U = TT[0] * 8; moe_filler(lds, aq->moe_gate, aq->moe_up, aq->moe_down, aq->ws, 1, 0, 3686, U, G, vcu_of(cu, G)); }
            if (rep_ + 1 < ((((DUPMASK) & (128)) && true) ? 2 : 1)) xcd_barrier(bar); }
            SEAM(pb + 7);
        }
        if ((PHMASK & 256) && IN(pb + 8)) {
        _Pragma("unroll") for (int rep_ = 0; rep_ < ((((DUPMASK) & (256)) && true) ? 2 : 1); ++rep_) {
            KArgs ap = kargs(); unsigned char* ws = ap->ws; GCU;
            LAS int* TT = (LAS int*)(ldsl + TT_OFF);
            pg8::build_tiles(TT, (const unsigned*)(ws + WS_CTL) + CW_CNT + 64 * l);
            pg8::MoeOrder<4> S; S.TT = TT; S.G = G; S.c = vcu_of(cu, G);
            pg8::Src2 X; X.ACT2 = (const bf16_t*)(ws + WS_ACT2); X.WD = (const bf16_t*)(ws + (l ? WS_WD1 : WS_WD));
            pg8::EpiMoeOut E; E.lat = ap->out; E.ctx = (float*)(ws + WS_XC); E.modv = (const float*)(ws + WS_MODV) + (size_t)l * 3 * 6144; E.LIST = (const u32x4*)(ws + WS_LIST);
            pg8::gemm_phase_x(ldsl, ldsl + ROWS_OFF, S, X, E, DE, 1024 / 64);
            if (l == 0) { KArgs aq = kargs(); const int U = TT[0] * 4; moe_filler(lds, aq->moe_gate, aq->moe_up, aq->moe_down, aq->ws, 1, 3686, 7986, U, G, vcu_of(cu, G)); }
            if (rep_ + 1 < ((((DUPMASK) & (256)) && true) ? 2 : 1)) xcd_barrier(bar); }
            SEAM(pb + 8);
        }
    }
#undef IN
#undef SEAM
#undef GCU
}

extern "C" void kernel_launch(void* const* d_in, const int* in_sizes, int n_in, void* d_out, int out_size, void* d_ws, size_t ws_size, hipStream_t stream) {
    static int grid = 0;
    if (grid == 0) {
        if (n_in != 21 || in_sizes[0] != BATCH * SEQ * D || out_size != BATCH * SEQ * D || ws_size < WS_END) {
            fprintf(stderr, "kernel_launch: unexpected sizes: n_in %d in0 %d out %d ws %zu (need %zu)\n", n_in, n_in > 0 ? in_sizes[0] : -1, out_size, ws_size, (size_t)WS_END); grid = -1; return; }
        int dev = 0, cus = 0, per_cu = 0;
        if (hipGetDevice(&dev) != hipSuccess || hipDeviceGetAttribute(&cus, hipDeviceAttributeMultiprocessorCount, dev) != hipSuccess) { grid = -1; return; }
        if (hipFuncSetAttribute((const void*)mega_fwd, hipFuncAttributeMaxDynamicSharedMemorySize, LDS_BYTES) != hipSuccess) { fprintf(stderr, "kernel_launch: hipFuncSetAttribute failed\n"); grid = -1; return; }
        if (hipOccupancyMaxActiveBlocksPerMultiprocessor(&per_cu, (const void*)mega_fwd, 512, LDS_BYTES) != hipSuccess || per_cu < 1) fprintf(stderr, "kernel_launch: occupancy query reports %d\n", per_cu);
        (void)hipGetLastError();
        grid = cus;
    }
    if (grid < 0) return;
    if (hipMemsetAsync((char*)d_ws + WS_CTL, 0, 1 * MiB, stream) != hipSuccess) return;
    Args a; memset((void*)&a, 0, sizeof(a));
    a.x = (const float*)d_in[0]; a.c = (const float*)d_in[1]; a.ctx = (const float*)d_in[2]; a.c_ctx = (const float*)d_in[3]; a.w_mod = (const float*)d_in[4]; a.b_mod = (const float*)d_in[5];
    a.norm1_g = (const float*)d_in[6]; a.norm2_g = (const float*)d_in[7]; a.w_in = (const float*)d_in[8]; a.w_out = (const float*)d_in[9]; a.hgrn_lb = (const float*)d_in[10]; a.hgrn_norm_g = (const float*)d_in[11];
    a.pool_w = (const float*)d_in[12]; a.pool_scale = (const float*)d_in[13]; a.q_norm_g = (const float*)d_in[14]; a.k_norm_g = (const float*)d_in[15]; a.router_w = (const float*)d_in[16]; a.router_b = (const float*)d_in[17];
    a.moe_gate = (const float*)d_in[18]; a.moe_up = (const float*)d_in[19]; a.moe_down = (const float*)d_in[20];
    a.out = (float*)d_out; a.ws = (unsigned char*)d_ws;
#if MK_SPLIT
    for (int ph = 0; ph < NPHASE; ++ph) { a.ph_lo = ph; a.ph_hi = ph + 1; hipLaunchKernelGGL(mega_fwd, dim3(grid), dim3(512), LDS_BYTES, stream, a); }
#else
    a.ph_lo = 0; a.ph_hi = NPHASE; hipLaunchKernelGGL(mega_fwd, dim3(grid), dim3(512), LDS_BYTES, stream, a);
#endif
}
```

```cpp
#include <hip/hip_runtime.h>
#include <cstdio>
#include <cstdint>
#include <cstring>

namespace cfg {
constexpr int D = 1024, BATCH = 2, SEQ = 8192, CTXL = 256, DEPTH = 2;
constexpr int PB = SEQ + CTXL;
constexpr int MT = BATCH * PB;
constexpr int TPB = PB / 256;
constexpr int NIN = 2304;
constexpr int NE = 16, DE = 512;
constexpr int C_AQ = 0, C_AFF = 256, C_AFB = 512, C_AI = 768, C_AG = 1024, C_BP = 1280, C_CQ = 1536, C_CK = 2048, C_CV = 2176;
constexpr float EPS = 1e-6f;
constexpr float C2 = 0.125f * 1.4426950408889634f;
}

__device__ __forceinline__ int otid() { int t = threadIdx.x; asm volatile("" : "+v"(t)); return t; }

namespace pg8 {
#define PG8_LAS __attribute__((address_space(3)))
typedef unsigned short bf16_t;
typedef short bf16x8 __attribute__((ext_vector_type(8)));
typedef float f32x4 __attribute__((ext_vector_type(4)));
typedef unsigned u32x4 __attribute__((ext_vector_type(4)));
constexpr int BM = 256, BK = 64, HALF = 128, HTB = HALF * BK * 2  , STAGE_BYTES = 8 * HTB, NXCD = 8, WGM = 8;

__host__ __device__ __forceinline__ int lds_byte(int r, int c) { const int st = (r >> 4) * 2 + (c >> 5), rr = r & 15, cc = c & 31, ob = rr * 64 + cc * 2; return st * 1024 + (ob ^ (((ob >> 9) & 1) << 5)); }
__host__ __device__ __forceinline__ void stage_rc(int b, int& R, int& C) { const int st = b / 1024, sb = b % 1024, swz = sb ^ (((sb >> 9) & 1) << 5); R = (st >> 1) * 16 + swz / 64; C = (st & 1) * 32 + (swz % 64) / 2; }
__host__ __device__ __forceinline__ int perm32(int rho) { const int n = rho >> 4, i = rho & 15; return 8 * (i >> 2) + 4 * n + (i & 3); }

struct Unit { int pm, pn; };
struct Gemm { const bf16_t* A; const bf16_t* Bt; int M, N, K, pad; };

struct StaticOrder {
    int nM, nN, nwg, G, c;
    __host__ __device__ void init(int M, int N, int G_, int c_) { nM = M / BM; nN = N / BM; nwg = nM * nN; G = G_; c = c_; }
    __host__ __device__ bool next(int i, Unit& u) const {
        const long L = (long)i * G + c; if (L >= nwg) return false;
        int wgid = (int)L; { const int q = nwg / NXCD, r = nwg % NXCD, xcd = wgid % NXCD, off = wgid / NXCD; wgid = (xcd < r ? xcd * (q + 1) : r * (q + 1) + (xcd - r) * q) + off; }
        const int nig = WGM * nN, gid = wgid / nig, fm = gid * WGM, gsz = (nM - fm) < WGM ? (nM - fm) : WGM;
        u.pm = fm + ((wgid % nig) % gsz); u.pn = (wgid % nig) / gsz; return true;
    }
    __device__ __forceinline__ void a_ready(const Unit&) const {}
    __device__ __forceinline__ void done(const Unit&) const {}
};

__device__ __forceinline__ unsigned cvt_pk_bf16(float lo, float hi) { unsigned r; asm volatile("v_cvt_pk_bf16_f32 %0, %1, %2" : "=v"(r) : "v"(lo), "v"(hi)); return r; }
typedef float f32x2 __attribute__((ext_vector_type(2)));
__device__ __forceinline__ f32x2 gelu_pk(f32x2 v) {
    const f32x2 av = __builtin_elementwise_abs(v), d = av * 0.2316418882f + 1.0f;
    f32x2 t; t.x = __builtin_amdgcn_rcpf(d.x); t.y = __builtin_amdgcn_rcpf(d.y);
    f32x2 q = t * 0.5307027145f + (-0.7265760135f); q = q * t + 0.7107068705f; q = q * t + (-0.142248368f); q = q * t + 0.127414796f; q = q * t;
    const f32x2 s = (v * v) * (-0.72134752044f);
    f32x2 e; e.x = __builtin_amdgcn_exp2f(s.x); e.y = __builtin_amdgcn_exp2f(s.y);
    const f32x2 m = v * (q * e), r = v - m;
    f32x2 o; o.x = v.x < 0.f ? m.x : r.x; o.y = v.y < 0.f ? m.y : r.y; return o;
}

template <int ACT  > struct EpiBf16 {
    static constexpr bool PERM = true, AFTER_DRAIN = false; static_assert(ACT == 0 || ACT == 1, "EpiBf16: ACT is 0 (none) or 1 (gelu_pk)");
    bf16_t* O; int ldc; const float* bias; int split_cols; size_t split_stride; float scale0;
    __device__ __forceinline__ void operator()(const f32x4 (&acc)[2][2][4][2], const Unit& u, int wr, int wc, int fr, int fq) const {
        asm volatile("" : "+v"(fr), "+v"(fq));
        const int row0 = u.pm * BM + wr * 64 + fr; int colt = u.pn * BM; bf16_t* base = O;
        float sc = 1.f; if (split_cols) { const int t = colt / split_cols; base += (size_t)t * split_stride; colt -= t * split_cols; if (t == 0) sc = scale0; }
        const int col0 = colt + wc * 32 + 8 * fq, bcol0 = u.pn * BM + wc * 32 + 8 * fq;
        f32x4 bv[2][2];
#pragma unroll
        for (int bj = 0; bj < 2; ++bj)
#pragma unroll
            for (int n = 0; n < 2; ++n) bv[bj][n] = bias ? *(const f32x4*)(bias + bcol0 + bj * HALF + 4 * n) : (f32x4){0.f, 0.f, 0.f, 0.f};
#pragma unroll
        for (int ai = 0; ai < 2; ++ai)
#pragma unroll
            for (int m = 0; m < 4; ++m) { bf16_t* rowp = base + (size_t)(row0 + ai * HALF + m * 16) * ldc + col0;
#pragma unroll
                for (int bj = 0; bj < 2; ++bj) { f32x4 v0 = acc[ai][bj][m][0] + bv[bj][0], v1 = acc[ai][bj][m][1] + bv[bj][1];
                    if (ACT == 1) { f32x2 a = gelu_pk((f32x2){v0[0], v0[1]}), b = gelu_pk((f32x2){v0[2], v0[3]}), c = gelu_pk((f32x2){v1[0], v1[1]}), d = gelu_pk((f32x2){v1[2], v1[3]});
                        v0 = (f32x4){a.x, a.y, b.x, b.y}; v1 = (f32x4){c.x, c.y, d.x, d.y}; }
                    v0 = v0 * sc; v1 = v1 * sc; u32x4 w; w.x = cvt_pk_bf16(v0[0], v0[1]); w.y = cvt_pk_bf16(v0[2], v0[3]); w.z = cvt_pk_bf16(v1[0], v1[1]); w.w = cvt_pk_bf16(v1[2], v1[3]);
                    *(u32x4*)(rowp + bj * HALF) = w; } }
    }
};

template <class Epi, class Sched, bool ALIGN_EPI = false, bool SP2 = false>
__device__ __forceinline__ void gemm_phase(PG8_LAS unsigned char* lds, const Gemm g, const Sched& S, const Epi& E) {
    const int tid = otid(), wid = __builtin_amdgcn_readfirstlane(tid >> 6), lane = tid & 63, wr = wid >> 2, wc = wid & 3, fr = lane & 15, fq = lane >> 4;
    const int K = g.K, nt = K / BK;
    unsigned voffA[2], voffB[2];
#pragma unroll
    for (int i = 0; i < 2; ++i) { int R, C; stage_rc(tid * 16 + i * 8192, R, C); const int Rb = Epi::PERM ? ((R & ~31) + perm32(R & 31)) : R;
        voffA[i] = (unsigned)(R * K + C) * 2u; voffB[i] = (unsigned)(Rb * K + C) * 2u; }
    const size_t kstep = (size_t)(BK * 2);
    const size_t hstep = (size_t)HALF * K * 2;
    const size_t tstep = 2 * hstep;
    const unsigned ldsw = (unsigned)wid * 1024u;
    const int aoff = lds_byte(wr * 64 + fr, fq * 8), boff = lds_byte(wc * 32 + fr, fq * 8);
#define PG8_SA(b, h) (((b) * 2 + (h)) * HTB)
#define PG8_SB(b, h) ((4 + (b) * 2 + (h)) * HTB)
#define PG8_STAGE(bufoff, gbase, voff) do { _Pragma("unroll") for (int _i = 0; _i < 2; ++_i) \
        __builtin_amdgcn_global_load_lds((const unsigned*)((const char*)(gbase) + (voff)[_i]), (PG8_LAS unsigned*)(lds + (bufoff) + ldsw + _i * 8192), 16, 0, 0); } while (0)
#define PG8_LDA(dst, b, h) do { _Pragma("unroll") for (int m = 0; m < 4; ++m) _Pragma("unroll") for (int k = 0; k < 2; ++k) dst[m][k] = *(const PG8_LAS bf16x8*)(lds + PG8_SA(b, h) + aoff + m * 2048 + k * 1024); } while (0)
#define PG8_LDB(dst, b, h) do { _Pragma("unroll") for (int n = 0; n < 2; ++n) _Pragma("unroll") for (int k = 0; k < 2; ++k) dst[n][k] = *(const PG8_LAS bf16x8*)(lds + PG8_SB(b, h) + boff + n * 2048 + k * 1024); } while (0)
#define PG8_MMA(ai, bj, At, Bt) do { __builtin_amdgcn_s_setprio(1); _Pragma("unroll") for (int m = 0; m < 4; ++m) _Pragma("unroll") for (int n = 0; n < 2; ++n) _Pragma("unroll") for (int k = 0; k < 2; ++k) \
        acc[ai][bj][m][n] = __builtin_amdgcn_mfma_f32_16x16x32_bf16(Bt[n][k], At[m][k], acc[ai][bj][m][n], 0, 0, 0); __builtin_amdgcn_s_setprio(0); } while (0)
#define PG8_WAIT_V(n) asm volatile("s_waitcnt vmcnt(" #n ")" ::: "memory")
#define PG8_WAIT_L(n) asm volatile("s_waitcnt lgkmcnt(" #n ")" ::: "memory")
#define PG8_BAR __builtin_amdgcn_s_barrier()
#define PG8_SCHED __builtin_amdgcn_sched_barrier(0)
    Unit cur, nxt; int ui = 0;
    if (!S.next(0, cur)) return;
    f32x4 acc[2][2][4][2];
#pragma unroll
    for (int a = 0; a < 2; ++a)
#pragma unroll
        for (int b = 0; b < 2; ++b)
#pragma unroll
            for (int m = 0; m < 4; ++m)
#pragma unroll
                for (int n = 0; n < 2; ++n) acc[a][b][m][n] = (f32x4){0.f, 0.f, 0.f, 0.f};
    bf16x8 At[4][2], B0[2][2], B1[2][2];
    const char* cA = (const char*)g.A + (size_t)cur.pm * tstep; const char* cB = (const char*)g.Bt + (size_t)cur.pn * tstep;
    S.a_ready(cur);
    if constexpr (SP2) {
        PG8_STAGE(PG8_SB(0, 0), cB, voffB); PG8_STAGE(PG8_SB(0, 1), cB + hstep, voffB); PG8_STAGE(PG8_SA(0, 0), cA, voffA); PG8_STAGE(PG8_SA(0, 1), cA + hstep, voffA);
        if (wr == 1) PG8_BAR;
        PG8_WAIT_V(2); PG8_BAR;
        PG8_STAGE(PG8_SB(1, 0), cB + kstep, voffB); PG8_STAGE(PG8_SA(1, 0), cA + kstep, voffA); PG8_STAGE(PG8_SB(1, 1), cB + hstep + kstep, voffB);
        PG8_WAIT_V(6); PG8_BAR;
    } else {
        PG8_STAGE(PG8_SB(0, 0), cB, voffB); PG8_STAGE(PG8_SA(0, 0), cA, voffA); PG8_STAGE(PG8_SB(0, 1), cB + hstep, voffB); PG8_STAGE(PG8_SA(0, 1), cA + hstep, voffA);
        if (wr == 1) PG8_BAR;
        PG8_WAIT_V(4); PG8_BAR;
        PG8_STAGE(PG8_SB(1, 0), cB + kstep, voffB); PG8_STAGE(PG8_SA(1, 0), cA + kstep, voffA); PG8_STAGE(PG8_SB(1, 1), cB + hstep + kstep, voffB);
        PG8_WAIT_V(6); PG8_BAR;
    }
    for (;;) {
        const bool has_next = S.next(ui + 1, nxt);
        const char* nA = has_next ? (const char*)g.A + (size_t)nxt.pm * tstep : cA; const char* nB = has_next ? (const char*)g.Bt + (size_t)nxt.pn * tstep : cB;
        for (int t = 0; t < nt; t += 2) {
            const bool last = (t == nt - 2);
            const char* a1 = cA + (size_t)(t + 1) * kstep;
            const char* a2 = last ? nA : cA + (size_t)(t + 2) * kstep; const char* b2 = last ? nB : cB + (size_t)(t + 2) * kstep;
            const char* a3 = a2 + kstep; const char* b3 = b2 + kstep;
            if (last && has_next) S.a_ready(nxt);
            if constexpr (SP2) {
            PG8_LDB(B0, 0, 0); PG8_LDB(B1, 0, 1); PG8_SCHED; PG8_LDA(At, 0, 0); PG8_STAGE(PG8_SA(1, 1), a1 + hstep, voffA);
            PG8_WAIT_V(8); PG8_WAIT_L(0); PG8_BAR; PG8_MMA(0, 0, At, B0); PG8_MMA(0, 1, At, B1); PG8_BAR; PG8_SCHED;
            PG8_LDA(At, 0, 1); PG8_STAGE(PG8_SB(0, 0), b2, voffB); PG8_STAGE(PG8_SB(0, 1), b2 + hstep, voffB); PG8_STAGE(PG8_SA(0, 0), a2, voffA);
            PG8_WAIT_V(8); PG8_WAIT_L(0); PG8_BAR; PG8_MMA(1, 0, At, B0); PG8_MMA(1, 1, At, B1); PG8_BAR; PG8_SCHED;
            PG8_LDB(B0, 1, 0); PG8_LDB(B1, 1, 1); PG8_SCHED; PG8_LDA(At, 1, 0); PG8_STAGE(PG8_SA(0, 1), a2 + hstep, voffA);
            PG8_WAIT_V(8); PG8_WAIT_L(0); PG8_BAR; PG8_MMA(0, 0, At, B0); PG8_MMA(0, 1, At, B1); PG8_BAR; PG8_SCHED;
            PG8_LDA(At, 1, 1); PG8_STAGE(PG8_SB(1, 0), b3, voffB); PG8_STAGE(PG8_SB(1, 1), b3 + hstep, voffB); PG8_STAGE(PG8_SA(1, 0), a3, voffA);
            PG8_WAIT_V(8); PG8_WAIT_L(0); PG8_BAR; PG8_MMA(1, 0, At, B0); PG8_MMA(1, 1, At, B1); PG8_BAR; PG8_SCHED;
            } else {
            PG8_LDB(B0, 0, 0); PG8_SCHED; PG8_LDA(At, 0, 0); PG8_STAGE(PG8_SA(1, 1), a1 + hstep, voffA);
            PG8_WAIT_L(8); PG8_BAR; PG8_WAIT_L(0); PG8_MMA(0, 0, At, B0); PG8_BAR; PG8_SCHED;
            PG8_LDB(B1, 0, 1); PG8_STAGE(PG8_SB(0, 0), b2, voffB);
            PG8_BAR; PG8_WAIT_L(0); PG8_MMA(0, 1, At, B1); PG8_BAR;
            PG8_LDA(At, 0, 1); PG8_STAGE(PG8_SA(0, 0), a2, voffA);
            PG8_BAR; PG8_WAIT_L(0); PG8_MMA(1, 0, At, B0); PG8_BAR; PG8_SCHED;
            PG8_STAGE(PG8_SB(0, 1), b2 + hstep, voffB);
            PG8_WAIT_V(6); PG8_BAR; PG8_MMA(1, 1, At, B1); PG8_BAR;
            PG8_LDB(B0, 1, 0); PG8_SCHED; PG8_LDA(At, 1, 0); PG8_STAGE(PG8_SA(0, 1), a2 + hstep, voffA);
            PG8_WAIT_L(8); PG8_BAR; PG8_WAIT_L(0); PG8_MMA(0, 0, At, B0); PG8_BAR; PG8_SCHED;
            PG8_LDB(B1, 1, 1); PG8_STAGE(PG8_SB(1, 0), b3, voffB);
            PG8_BAR; PG8_WAIT_L(0); PG8_MMA(0, 1, At, B1); PG8_BAR;
            PG8_LDA(At, 1, 1); PG8_STAGE(PG8_SA(1, 0), a3, voffA);
            PG8_BAR; PG8_WAIT_L(0); PG8_MMA(1, 0, At, B0); PG8_BAR; PG8_SCHED;
            PG8_STAGE(PG8_SB(1, 1), b3 + hstep, voffB);
            PG8_WAIT_V(6); PG8_BAR; PG8_MMA(1, 1, At, B1); PG8_BAR;
            }
        }
        if constexpr (ALIGN_EPI) { if (wr == 0) PG8_BAR; }
        if constexpr (!Epi::AFTER_DRAIN) { E(acc, cur, wr, wc, fr, fq); S.done(cur); }
        if (!has_next) break;
#pragma unroll
        for (int a = 0; a < 2; ++a)
#pragma unroll
            for (int b = 0; b < 2; ++b)
#pragma unroll
                for (int m = 0; m < 4; ++m)
#pragma unroll
                    for (int n = 0; n < 2; ++n) acc[a][b][m][n] = (f32x4){0.f, 0.f, 0.f, 0.f};
        cur = nxt; cA = nA; cB = nB; ++ui;
        if constexpr (ALIGN_EPI) { if (wr == 1) PG8_BAR; }
    }
    PG8_WAIT_V(0);
    if constexpr (!ALIGN_EPI) { if (wr == 0) PG8_BAR; }
    PG8_BAR;
    if constexpr (Epi::AFTER_DRAIN) { E.fused(acc, cur, wr, wc, fr, fq, lds, wid, lane); S.done(cur); }
#undef PG8_SA
#undef PG8_SB
#undef PG8_STAGE
#undef PG8_LDA
#undef PG8_LDB
#undef PG8_MMA
#undef PG8_WAIT_V
#undef PG8_WAIT_L
#undef PG8_BAR
#undef PG8_SCHED
}
}

#include <hip/hip_bf16.h>
namespace attn8 {
using bf16 = __hip_bfloat16;
typedef int v8i __attribute__((ext_vector_type(8)));
typedef int v4i __attribute__((ext_vector_type(4)));
typedef float f32x16 __attribute__((ext_vector_type(16)));
typedef unsigned u32x4 __attribute__((ext_vector_type(4)));
constexpr int NSLOT = 4, SLOT = 4096, LDS_K = 0, LDS_V = NSLOT * SLOT, LDS_OST = 2 * NSLOT * SLOT, LDS_BYTES = LDS_OST + 8 * 4096;
constexpr int QP8 = 512, KP8 = 128, OP = 1024;
__device__ __forceinline__ int crow(int r, int hi) { return (r & 3) + 8 * (r >> 2) + 4 * hi; }
__device__ __forceinline__ void glds16(const void* gsrc, unsigned lds_dst) { unsigned keep;
    asm volatile("s_mov_b32 %0, m0\n\ts_mov_b32 m0, %2\n\ts_nop 0\n\tglobal_load_lds_dwordx4 %1, off\n\ts_mov_b32 m0, %0" : "=&s"(keep) : "v"(gsrc), "s"(lds_dst) : "memory"); }
typedef __attribute__((address_space(3))) const char* lds_cptr;
__device__ __forceinline__ v8i ld32(lds_cptr p0, lds_cptr p1) { const v4i a = *(const __attribute__((address_space(3))) v4i*)p0, b = *(const __attribute__((address_space(3))) v4i*)p1; return (v8i){a[0], a[1], a[2], a[3], b[0], b[1], b[2], b[3]}; }
#define A8_WAIT_BAR(N) asm volatile("s_waitcnt vmcnt(" #N ") lgkmcnt(0)\n\ts_barrier" ::: "memory")
#define A8_QK(kf) __builtin_amdgcn_mfma_scale_f32_32x32x64_f8f6f4(kf, qf, cinit, 0, 0, 0, 0, 0, 0)
#define A8_PV(vf, acc) __builtin_amdgcn_mfma_scale_f32_32x32x64_f8f6f4(pw, vf, acc, 1, 0, 0, 0, 0, 0)
__device__ __forceinline__ void attn_unit(const unsigned char* Qw0, const unsigned char* __restrict__ Kh, const unsigned char* __restrict__ Vh, bf16* Ow0, const int NT, const float neg_ref, char* shm) {
    const int tid = otid(), lane = tid & 63, r32 = lane & 31, hi = lane >> 5; const int wid = __builtin_amdgcn_readfirstlane(tid >> 6);
    const unsigned lds0 = (unsigned)(uintptr_t)shm;
    const bool kw = wid < 4;
    const unsigned char* dsrc = kw ? Kh + (long)lane * KP8 + wid * 16 : Vh + (wid - 4) * 1024 + lane * 16;
    const long dstep = kw ? 64 * KP8 : 4096;
    const unsigned ddst = lds0 + (kw ? LDS_K + wid * 1024 : LDS_V + (wid - 4) * 1024);
    const int dist = kw ? 3 : 2;
#define A8_DMA(tt) glds16(dsrc + (long)(tt) * dstep, (unsigned)__builtin_amdgcn_readfirstlane(ddst + (unsigned)(((tt) & 3) * SLOT)))
    A8_DMA(0); A8_DMA(1); if (kw) A8_DMA(2);
    const v8i qf = *(const v8i*)(Qw0 + (long)(wid * 32 + r32) * QP8 + hi * 32);
    const lds_cptr shm3 = (lds_cptr)shm;
    const lds_cptr kp = shm3 + LDS_K + (2 * hi * 64 + r32) * 16, vp = shm3 + LDS_V + (2 * hi * 64 + r32) * 16;
#define A8_RDK(slot) do { kf0 = ld32(kp + (slot), kp + (slot) + 1024); kf1 = ld32(kp + (slot) + 512, kp + (slot) + 512 + 1024); } while (0)
#define A8_RDV(slot) do { vf0 = ld32(vp + (slot), vp + (slot) + 1024); vf1 = ld32(vp + (slot) + 512, vp + (slot) + 512 + 1024); } while (0)
    f32x16 o0 = {}, o1 = {}, ls = {}, cinit;
#pragma unroll
    for (int r = 0; r < 16; ++r) cinit[r] = neg_ref;
    const v8i ones = {0x38383838, 0x38383838, 0x38383838, 0x38383838, 0x38383838, 0x38383838, 0x38383838, 0x38383838};
    asm volatile("s_waitcnt vmcnt(0) lgkmcnt(0)\n\ts_barrier" ::: "memory");
    v8i kf0, kf1, vf0, vf1, pw;
    f32x16 SA0, SA1, SB0, SB1;
    A8_RDK(0);
    SA0 = A8_QK(kf0); SA1 = A8_QK(kf1);
    A8_RDK(SLOT);
    if (dist < NT) A8_DMA(dist);
#pragma unroll
    for (int r = 0; r < 16; ++r) { SA0[r] = __builtin_amdgcn_exp2f(SA0[r]); SA1[r] = __builtin_amdgcn_exp2f(SA1[r]); }
    if (3 < NT) { A8_WAIT_BAR(1); } else { A8_WAIT_BAR(0); }
#define A8_PACK(P0, P1) do { \
        _Pragma("unroll") for (int i = 0; i < 4; ++i) { int w_ = 0; w_ = __builtin_amdgcn_cvt_pk_bf8_f32(P0[4 * i], P0[4 * i + 1], w_, false); w_ = __builtin_amdgcn_cvt_pk_bf8_f32(P0[4 * i + 2], P0[4 * i + 3], w_, true); pw[i] = w_; } \
        _Pragma("unroll") for (int i = 0; i < 4; ++i) { int w_ = 0; w_ = __builtin_amdgcn_cvt_pk_bf8_f32(P1[4 * i], P1[4 * i + 1], w_, false); w_ = __builtin_amdgcn_cvt_pk_bf8_f32(P1[4 * i + 2], P1[4 * i + 3], w_, true); pw[4 + i] = w_; } } while (0)
#define A8_STEP(N0, N1, P0, P1, t) do { \
        N0 = A8_QK(kf0); N1 = A8_QK(kf1); \
        A8_PACK(P0, P1); \
        A8_RDV((((t) - 1) & 3) * SLOT); \
        if ((t) + 1 < NT) A8_RDK((((t) + 1) & 3) * SLOT); \
        if ((t) + dist < NT) A8_DMA((t) + dist); \
        o0 = A8_PV(vf0, o0); o1 = A8_PV(vf1, o1); ls = A8_PV(ones, ls); \
        _Pragma("unroll") for (int r = 0; r < 16; ++r) { N0[r] = __builtin_amdgcn_exp2f(N0[r]); N1[r] = __builtin_amdgcn_exp2f(N1[r]); } \
        if ((t) + 3 < NT) { A8_WAIT_BAR(1); } else { A8_WAIT_BAR(0); } } while (0)
    int t = 1;
    for (; t + 1 < NT; t += 2) { A8_STEP(SB0, SB1, SA0, SA1, t); A8_STEP(SA0, SA1, SB0, SB1, t + 1); }
    A8_STEP(SB0, SB1, SA0, SA1, NT - 1);
    A8_PACK(SB0, SB1);
    A8_RDV(((NT - 1) & 3) * SLOT);
    o0 = A8_PV(vf0, o0); o1 = A8_PV(vf1, o1); ls = A8_PV(ones, ls);
    bf16* Ow = Ow0 + (long)(wid * 32) * OP;
    { bf16* stg = (bf16*)(shm + LDS_OST) + wid * 2048;
#pragma unroll
      for (int r = 0; r < 16; ++r) { const int orow = crow(r, hi); const float rl = __builtin_amdgcn_rcpf(ls[r]);
          stg[orow * 64 + r32] = __float2bfloat16(o0[r] * rl); stg[orow * 64 + 32 + r32] = __float2bfloat16(o1[r] * rl); }
      asm volatile("s_waitcnt lgkmcnt(0)" ::: "memory");
#pragma unroll
      for (int i = 0; i < 4; ++i) { const int row = i * 8 + (lane >> 3), ch = lane & 7; const u32x4 v = *(const u32x4*)(stg + row * 64 + ch * 8); *(u32x4*)(Ow + (long)row * OP + ch * 8) = v; } }
    asm volatile("s_waitcnt lgkmcnt(0)\n\ts_barrier" ::: "memory");
#undef A8_DMA
#undef A8_RDK
#undef A8_RDV
#undef A8_PACK
#undef A8_STEP
}
#undef A8_WAIT_BAR
#undef A8_QK
#undef A8_PV
}


using namespace cfg;
typedef unsigned short bf16_t;
typedef float f32x4 __attribute__((ext_vector_type(4)));
typedef unsigned u32x4 __attribute__((ext_vector_type(4)));
typedef unsigned u32x2 __attribute__((ext_vector_type(2)));

__device__ __forceinline__ float bf2f(unsigned v) { return __uint_as_float(v << 16); }
__device__ __forceinline__ float bflo(unsigned w) { return __uint_as_float(w << 16); }
__device__ __forceinline__ float bfhi(unsigned w) { return __uint_as_float(w & 0xffff0000u); }
__device__ __forceinline__ unsigned f2bf(float f) { unsigned u = __float_as_uint(f); return (u + 0x7fffu + ((u >> 16) & 1u)) >> 16; }
__device__ __forceinline__ unsigned pk2(float lo, float hi) { return f2bf(lo) | (f2bf(hi) << 16); }
__device__ __forceinline__ float sigm(float x) { return 1.f / (1.f + __expf(-x)); }
__device__ __forceinline__ float silu(float x) { return x / (1.f + __expf(-x)); }
template <int M> __device__ __forceinline__ float xsum(float v) {
    if constexpr (M < 32) return v + __uint_as_float((unsigned)__builtin_amdgcn_ds_swizzle((int)__float_as_uint(v), (M << 10) | 0x1f));
    else { auto rr = __builtin_amdgcn_permlane32_swap(__float_as_uint(v), __float_as_uint(v), false, false); return __uint_as_float(rr[0]) + __uint_as_float(rr[1]); }
}
__device__ __forceinline__ float wave_sum(float v) { v = xsum<1>(v); v = xsum<2>(v); v = xsum<4>(v); v = xsum<8>(v); v = xsum<16>(v); v = xsum<32>(v); return v; }
__device__ __forceinline__ size_t stream_off(int row, bool& is_ctx) { const int b = row / PB, p = row - b * PB; is_ctx = p < CTXL; return is_ctx ? ((size_t)b * CTXL + p) * D : ((size_t)b * SEQ + (p - CTXL)) * D; }

constexpr size_t MiB = 1u << 20;
constexpr size_t WS_CTL = 0;
constexpr size_t WS_MODV = 1 * MiB;
constexpr size_t WS_LBF = WS_MODV + 256 * 1024;
constexpr size_t WS_REF = WS_LBF + 8192;
constexpr size_t WS_POOLWT = WS_MODV + 512 * 1024;
constexpr size_t WS_COS = 2 * MiB, WS_SIN = 3 * MiB;
constexpr size_t WS_WIN = 4 * MiB;
constexpr size_t WS_WOUT = 13 * MiB;
constexpr size_t WS_WGU = 17 * MiB;
constexpr size_t WS_WD = 49 * MiB;
constexpr size_t WS_XC = 65 * MiB;
constexpr size_t WS_XN = 67 * MiB;
constexpr size_t WS_PROJ = 100 * MiB;
constexpr size_t WS_QN = 175 * MiB;
constexpr size_t WS_KN = 192 * MiB;
constexpr size_t WS_Q8 = WS_QN;
constexpr size_t WS_K8 = WS_QN + 9 * MiB;
constexpr size_t WS_VT8 = WS_QN + 12 * MiB;
constexpr size_t WS_MIX = 197 * MiB;
constexpr size_t WS_UT = 230 * MiB;
constexpr size_t WS_ST = 247 * MiB;
constexpr size_t WS_DEC = 264 * MiB;
constexpr size_t WS_LIST = 265 * MiB;
constexpr size_t WS_ACT2 = WS_PROJ;
constexpr size_t WS_WGU1 = 272 * MiB;
constexpr size_t WS_WD1 = 304 * MiB;
constexpr size_t WS_END = 320 * MiB;
constexpr int CW_CNT = 1024;

__device__ const float ROPE_INV[16] = {1.0f, 0.5623413251903491f, 0.31622776601683794f, 0.1778279410038923f, 0.1f, 0.05623413251903491f, 0.03162277660168379f, 0.01778279410038923f,
                                       0.01f, 0.005623413251903491f, 0.0031622776601683794f, 0.0017782794100389228f, 0.001f, 0.0005623413251903491f, 0.00031622776601683794f, 0.00017782794100389227f};
__device__ __forceinline__ void sincos_d(double a, double& s, double& c) {
    const double k = rint(a * 0.63661977236758134308);
    double r = fma(-k, 1.57079632679489655800e+00, a);
    r = fma(-k, 6.12323399573676603587e-17, r);
    const double r2 = r * r;
    double sp = -7.6471637318198164759e-13;
    sp = fma(sp, r2, 1.6059043836821614599e-10);
    sp = fma(sp, r2, -2.5052108385441718775e-08);
    sp = fma(sp, r2, 2.7557319223985890653e-06);
    sp = fma(sp, r2, -1.9841269841269841270e-04);
    sp = fma(sp, r2, 8.3333333333333333333e-03);
    sp = fma(sp, r2, -1.6666666666666666667e-01);
    const double sr = fma(sp * r2, r, r);
    double cp = 4.7794773323873852974e-14;
    cp = fma(cp, r2, -1.1470745597729724714e-11);
    cp = fma(cp, r2, 2.0876756987868098979e-09);
    cp = fma(cp, r2, -2.7557319223985890653e-07);
    cp = fma(cp, r2, 2.4801587301587301587e-05);
    cp = fma(cp, r2, -1.3888888888888888889e-03);
    cp = fma(cp, r2, 4.1666666666666666667e-02);
    cp = fma(cp, r2, -0.5);
    const double cr = fma(cp, r2, 1.0);
    const int q = ((int)k) & 3;
    s = (q == 0) ? sr : (q == 1) ? cr : (q == 2) ? -sr : -cr;
    c = (q == 0) ? cr : (q == 1) ? -sr : (q == 2) ? -cr : sr;
}

__device__ __forceinline__ void transpose_items(const float* __restrict__ W, int K, int N, bf16_t* __restrict__ WT, int mode, int nbatch, size_t src_stride, size_t dst_stride, float* scr, int gw, int NGW, int lane, int it_lo = 0, int it_hi = 0x7fffffff) {
    const int nblk = N / 32, per = (K / 64) * nblk, nitems = per * nbatch;
    if (it_hi > nitems) it_hi = nitems;
    for (int it = it_lo + gw; it < it_hi; it += NGW) {
        const int bt = it / per, item = it - bt * per;
        const float* Wb = W + (size_t)bt * src_stride; bf16_t* WTb = WT + (size_t)bt * dst_stride;
        const int kb = item / nblk, nb = item - kb * nblk, k0 = 64 * kb, n0 = 32 * nb;
        f32x4 wv[8];
#pragma unroll
        for (int i = 0; i < 8; ++i) wv[i] = *(const f32x4*)(Wb + (size_t)(k0 + 8 * i + (lane >> 3)) * N + n0 + (lane & 7) * 4);
#pragma unroll
        for (int i = 0; i < 8; ++i) { float* s = scr + (8 * i + (lane >> 3)) * 33 + (lane & 7) * 4; s[0] = wv[i].x; s[1] = wv[i].y; s[2] = wv[i].z; s[3] = wv[i].w; }
        asm volatile("s_waitcnt lgkmcnt(0)" ::: "memory");
        const int rbase = (mode == 0) ? n0 : ((n0 >> 7) * 256 + (mode == 2 ? 128 : 0) + (n0 & 127));
        const int cch = lane & 7;
#pragma unroll
        for (int j = 0; j < 4; ++j) { const int n = (lane >> 3) + 8 * j; const float* s = scr + (8 * cch) * 33 + n;
            u32x4 o; o.x = pk2(s[0 * 33], s[1 * 33]); o.y = pk2(s[2 * 33], s[3 * 33]); o.z = pk2(s[4 * 33], s[5 * 33]); o.w = pk2(s[6 * 33], s[7 * 33]);
            *(u32x4*)(WTb + (size_t)(rbase + n) * K + k0 + 8 * cch) = o; }
        asm volatile("s_waitcnt lgkmcnt(0)" ::: "memory");
    }
}
constexpr int MOE_ITEMS = 3 * 4096;
__device__ __forceinline__ void moe_weight_copies(const float* gate, const float* up, const float* down, bf16_t* WGU, bf16_t* WD, float* scr, int gw, int NGW, int lane, int lo, int hi) {
    if (lo < 4096) transpose_items(gate, D, DE, WGU, 1, NE, (size_t)D * DE, (size_t)1024 * D, scr, gw, NGW, lane, lo, hi < 4096 ? hi : 4096);
    if (lo < 8192 && hi > 4096) transpose_items(up, D, DE, WGU, 2, NE, (size_t)D * DE, (size_t)1024 * D, scr, gw, NGW, lane, lo > 4096 ? lo - 4096 : 0, hi < 8192 ? hi - 4096 : 4096);
    if (hi > 8192) transpose_items(down, DE, D, WD, 0, NE, (size_t)DE * D, (size_t)D * DE, scr, gw, NGW, lane, lo > 8192 ? lo - 8192 : 0, hi - 8192);
}
__device__ __forceinline__ void moe_filler(unsigned char* lds, const float* gate, const float* up, const float* down, unsigned char* ws, int lw, int lo, int hi, int U, int G, int c) {
    const int rem = U % G; int rank = c, nr = G;
    if (rem != 0) { if (c < rem) return; rank = c - rem; nr = G - rem; }
    const int tid = otid(); float* scr = (float*)(lds + 16384) + (tid >> 6) * (64 * 33);
    moe_weight_copies(gate + (size_t)lw * NE * D * DE, up + (size_t)lw * NE * D * DE, down + (size_t)lw * NE * DE * D, (bf16_t*)(ws + (lw ? WS_WGU1 : WS_WGU)), (bf16_t*)(ws + (lw ? WS_WD1 : WS_WD)), scr, rank * 8 + (tid >> 6), nr * 8, tid & 63, lo, hi);
}
struct ProArgs { const float *c, *c_ctx, *w_mod, *b_mod, *hgrn_lb, *qg, *kg, *w_in, *w_out, *pool_w, *gate, *up, *down; float *MODV, *LBF, *REF, *COS, *SIN; bf16_t *WIN, *WOUT, *POOLWT, *WGU, *WD; };
__device__ __forceinline__ void prologue_phase(unsigned char* lds, const ProArgs& a, int cu, int G) {
    const int tid = otid(), lane = tid & 63, wave = tid >> 6;
    for (int gid = cu * 512 + tid; gid < SEQ * 32; gid += G * 512) {
        const int t = gid >> 5, j = gid & 31;
        const float pos = (float)(j < 16 ? (t >> 6) : (t & 63));
        const float ang = pos * ROPE_INV[j & 15];
        double s, c; sincos_d((double)ang, s, c);
        a.COS[gid] = (float)c; a.SIN[gid] = (float)s;
    }
    if (cu == 0) {
        for (int gid = tid; gid < 1024; gid += 512) {
            const int l = gid >> 9, r = gid & 511; float v = 0.f;
            if (l == 1) v = 1.f / (1.f + expf(a.hgrn_lb[r] - a.hgrn_lb[512 + r]));
            a.LBF[gid] = fmaxf(v, 1e-30f); }
        if (tid < DEPTH) {
            float mq = 0.f, mk = 0.f;
            for (int i = 0; i < 64; ++i) { mq = fmaxf(mq, fabsf(a.qg[tid * 64 + i])); mk = fmaxf(mk, fabsf(a.kg[tid * 64 + i])); }
            a.REF[tid * 64] = -fmaxf(64.f * C2 * mq * mk * 1.13f + 0.5f - 15.5f, 0.f); }
    }
    {
        float* act = (float*)lds;
        float* part = (float*)(lds + 12288);
        for (int item = cu; item < 2 * 96; item += G) {
            const int l = item / 96, n0 = (item - l * 96) * 64;
            for (int i = tid; i < 3072; i += 512) { const int r = i >> 10, k = i & 1023; const float v = r < 2 ? a.c[r * 1024 + k] : a.c_ctx[k]; act[i] = silu(v); }
            __syncthreads();
            const float* w = a.w_mod + ((size_t)l * 1024 + (size_t)wave * 128) * 6144 + n0 + lane;
            float a0 = 0.f, a1 = 0.f, a2 = 0.f;
#pragma unroll 32
            for (int k = 0; k < 128; ++k) { const float wv = w[(size_t)k * 6144]; const int kk = wave * 128 + k; a0 += act[kk] * wv; a1 += act[1024 + kk] * wv; a2 += act[2048 + kk] * wv; }
            part[(wave * 3 + 0) * 64 + lane] = a0; part[(wave * 3 + 1) * 64 + lane] = a1; part[(wave * 3 + 2) * 64 + lane] = a2;
            __syncthreads();
            if (tid < 192) { const int r = tid >> 6, nn = tid & 63; float s = 0.f;
#pragma unroll
                for (int q = 0; q < 8; ++q) s += part[(q * 3 + r) * 64 + nn];
                a.MODV[(l * 3 + r) * 6144 + n0 + nn] = s + a.b_mod[l * 6144 + n0 + nn]; }
            __syncthreads();
        }
    }
    {
        float* scr = (float*)(lds + 16384) + wave * (64 * 33);
        const int gw = cu * 8 + wave, NGW = G * 8;
        transpose_items(a.w_in, D, NIN, a.WIN, 0, DEPTH, (size_t)D * NIN, (size_t)NIN * D, scr, gw, NGW, lane);
        transpose_items(a.w_out, D, D, a.WOUT, 0, DEPTH, (size_t)D * D, (size_t)D * D, scr, gw, NGW, lane);
        transpose_items(a.pool_w, 64, 64, a.POOLWT, 0, DEPTH * 4, (size_t)64 * 64, (size_t)64 * 64, scr, gw, NGW, lane);
    }
    __syncthreads();
}

namespace pool {
typedef float f32x16 __attribute__((ext_vector_type(16)));
typedef short bf16x8 __attribute__((ext_vector_type(8)));
constexpr int P = 72, O_X = 0  , O_DM = 81920  , O_OUT = 0  , OP = 264;
__device__ __forceinline__ int crow(int r, int hi) { return (r & 3) + 8 * (r >> 2) + 4 * hi; }
__device__ __forceinline__ void pool_phase(unsigned char* lds, const bf16_t* __restrict__ PROJ, const bf16_t* __restrict__ WT  , const float* __restrict__ pscale, bf16_t* __restrict__ MIX, int cu, int G) {
    const int tid = otid(), lane = tid & 63, r32 = lane & 31, hi = lane >> 5, w = __builtin_amdgcn_readfirstlane(tid >> 6);
    float* X = (float*)(lds + O_X); bf16_t* OUT = (bf16_t*)(lds + O_OUT);
    for (int u = G - 1 - cu; u < MT / 64; u += G) {
        const int row0 = u * 64, b = row0 / PB, p0 = row0 - b * PB; const bool is_ctx = p0 < CTXL;
        const int seg0 = b * PB + (is_ctx ? 0 : CTXL), len = is_ctx ? CTXL : SEQ, t0 = is_ctx ? p0 : p0 - CTXL;
#pragma unroll
        for (int it = 0; it < 5; ++it) { const int piece = tid + it * 512, rr = piece >> 5, pc = piece & 31, t = t0 - 8 + rr;
            u32x4 v = {0u, 0u, 0u, 0u};
            if (t >= 0 && t < len) v = *(const u32x4*)(PROJ + (size_t)(seg0 + t) * NIN + C_BP + pc * 8);
            float* x = X + rr * 256 + pc * 8;
            *(f32x4*)x = (f32x4){bflo(v.x), bfhi(v.x), bflo(v.y), bfhi(v.y)}; *(f32x4*)(x + 4) = (f32x4){bflo(v.z), bfhi(v.z), bflo(v.w), bfhi(v.w)}; }
        __syncthreads();
        {
            const int c = tid & 255, th = tid >> 8, g = c >> 6, hw = 1 << g;
            bf16_t* dm = (bf16_t*)(lds + O_DM) + g * 64 * P + (c & 63);
            const float* xc = X + c;
            const int ta = th * 32;
            float s = 0.f;
            for (int q = ta - hw; q < ta + hw; ++q) s += xc[(q + 8) * 256];
#pragma unroll 8
            for (int tt = 0; tt < 32; ++tt) { const int t = ta + tt, tg = t0 + t;
                int lo = tg - hw; if (lo < 0) lo = 0; int hi2 = tg + hw; if (hi2 > len) hi2 = len;
                dm[t * P] = (bf16_t)f2bf(s / (float)(hi2 - lo) - xc[(t + 8) * 256]);
                s += xc[(t + hw + 8) * 256] - xc[(t - hw + 8) * 256]; }
        }
        __syncthreads();
        {
            const int g = w >> 1, tb = w & 1;
            const bf16_t* A = (const bf16_t*)(lds + O_DM) + g * 64 * P + (tb * 32 + r32) * P + hi * 8;
#pragma unroll
            for (int eb = 0; eb < 2; ++eb) {
                const bf16_t* Bp = WT + (size_t)g * 4096 + (eb * 32 + r32) * 64 + hi * 8;
                f32x16 acc = {};
#pragma unroll
                for (int ks = 0; ks < 4; ++ks) acc = __builtin_amdgcn_mfma_f32_32x32x16_bf16(*(const bf16x8*)(A + ks * 16), *(const bf16x8*)(Bp + ks * 16), acc, 0, 0, 0);
                const int e = g * 64 + eb * 32 + r32; const float sc = pscale[e];
#pragma unroll
                for (int r = 0; r < 16; ++r) OUT[(tb * 32 + crow(r, hi)) * OP + e] = (bf16_t)f2bf(acc[r] * sc);
            }
        }
        __syncthreads();
#pragma unroll
        for (int it = 0; it < 4; ++it) { const int piece = tid + it * 512, t = piece >> 5, pc = piece & 31;
            *(u32x4*)(MIX + (size_t)(row0 + t) * D + 256 + pc * 8) = *(const u32x4*)(OUT + t * OP + pc * 8); }
        __syncthreads();
    }
}
}

#ifndef LAS
#define LAS __attribute__((address_space(3)))
#endif
__device__ __forceinline__ void norm1_phase(int cu, int G, const float* __restrict__ lat, const float* __restrict__ cx, const float* __restrict__ g, const float* __restrict__ modv, int sh_off, bf16_t* __restrict__ XN) {
    const int lane = otid() & 63, gw = cu * 8 + (otid() >> 6), NGW = G * 8;
    for (int row0 = gw * 4; row0 < MT; row0 += NGW * 4) {
        bool is_ctx; const size_t off = stream_off(row0, is_ctx);
        const int r = is_ctx ? 2 : row0 / PB;
        const f32x4* xr = (const f32x4*)((is_ctx ? cx : lat) + off) + lane;
        f32x4 v[4][4]; float ss[4];
#pragma unroll
        for (int q = 0; q < 4; ++q) { ss[q] = 0.f;
#pragma unroll
            for (int j = 0; j < 4; ++j) v[q][j] = xr[q * 256 + 64 * j]; }
        const float* mv = modv + r * 6144 + sh_off;
        f32x4 gs[4], sh[4];
#pragma unroll
        for (int j = 0; j < 4; ++j) { const int col = 4 * lane + 256 * j; gs[j] = *(const f32x4*)(g + col) * (*(const f32x4*)(mv + 1024 + col) + 1.f); sh[j] = *(const f32x4*)(mv + col); }
#pragma unroll
        for (int q = 0; q < 4; ++q) {
#pragma unroll
            for (int j = 0; j < 4; ++j) ss[q] += (v[q][j].x * v[q][j].x + v[q][j].y * v[q][j].y) + (v[q][j].z * v[q][j].z + v[q][j].w * v[q][j].w);
            const float rstd = 1.f / sqrtf(wave_sum(ss[q]) * (1.f / D) + EPS);
#pragma unroll
            for (int j = 0; j < 4; ++j) { const f32x4 o = v[q][j] * rstd * gs[j] + sh[j];
                u32x2 w; w.x = pk2(o.x, o.y); w.y = pk2(o.z, o.w);
                *(u32x2*)(XN + (size_t)(row0 + q) * D + 4 * lane + 256 * j) = w; } }
    }
}

__device__ __forceinline__ void norm2_router_phase(unsigned char* lds, int cu, int G, const float* __restrict__ lat, const float* __restrict__ cx, const float* __restrict__ g, const float* __restrict__ modv, int sh_off,
                                                   const float* __restrict__ router_w, const float* __restrict__ router_b, bf16_t* __restrict__ XN, unsigned* __restrict__ cnt, u32x4* __restrict__ LIST, int route_ctx) {
    const int tid = otid(), lane = tid & 63, wave = tid >> 6, gw = cu * 8 + wave, NGW = G * 8;
    float* RW = (float*)lds;
    u32x4* ENT = (u32x4*)(lds + 65536) + wave * 64;
    LAS unsigned* BC = (LAS unsigned*)((LAS unsigned char*)lds + 65536 + 8192);
#pragma unroll
    for (int it = 0; it < 8; ++it) { const int p = tid + it * 512, col = p >> 2, q = p & 3; const f32x4 w4 = *(const f32x4*)(router_w + (size_t)col * 16 + 4 * q);
        RW[(4 * q + 0) * 1024 + col] = w4.x; RW[(4 * q + 1) * 1024 + col] = w4.y; RW[(4 * q + 2) * 1024 + col] = w4.z; RW[(4 * q + 3) * 1024 + col] = w4.w; }
    if (tid < 48) BC[tid] = 0u;
    __syncthreads();
    int nent = 0;
    f32x4 vn[4];
    { int row = gw < MT ? gw : 0; bool ic; const size_t off = stream_off(row, ic); const f32x4* xr = (const f32x4*)((ic ? cx : lat) + off) + lane;
#pragma unroll
      for (int j = 0; j < 4; ++j) vn[j] = xr[64 * j]; }
    for (int row = gw; row < MT; row += NGW) {
        f32x4 v[4];
#pragma unroll
        for (int j = 0; j < 4; ++j) v[j] = vn[j];
        { const int nr = row + NGW < MT ? row + NGW : row; bool ic; const size_t off = stream_off(nr, ic); const f32x4* xr = (const f32x4*)((ic ? cx : lat) + off) + lane;
#pragma unroll
          for (int j = 0; j < 4; ++j) vn[j] = xr[64 * j]; }
        bool is_ctx; (void)stream_off(row, is_ctx);
        if (is_ctx && !route_ctx) continue;
        const int r = is_ctx ? 2 : row / PB;
        float ss = 0.f;
#pragma unroll
        for (int j = 0; j < 4; ++j) ss += (v[j].x * v[j].x + v[j].y * v[j].y) + (v[j].z * v[j].z + v[j].w * v[j].w);
        const float rstd = 1.f / sqrtf(wave_sum(ss) * (1.f / D) + EPS);
        const float* mv = modv + r * 6144 + sh_off;
#pragma unroll
        for (int j = 0; j < 4; ++j) { const int col = 4 * lane + 256 * j;
            const f32x4 gg = *(const f32x4*)(g + col), sh = *(const f32x4*)(mv + col), sc = *(const f32x4*)(mv + 1024 + col);
            v[j] = v[j] * rstd * gg * (sc + 1.f) + sh;
            u32x2 w; w.x = pk2(v[j].x, v[j].y); w.y = pk2(v[j].z, v[j].w);
            *(u32x2*)(XN + (size_t)row * D + col) = w; }
        float sc_[16], sel[16];
#pragma unroll
        for (int e = 0; e < 16; ++e) { float a = 0.f;
#pragma unroll
            for (int j = 0; j < 4; ++j) { const f32x4 w4 = *(const f32x4*)(RW + e * 1024 + 256 * j + 4 * lane); a += (v[j].x * w4.x + v[j].y * w4.y) + (v[j].z * w4.z + v[j].w * w4.w); }
            a = wave_sum(a); sc_[e] = 1.f / (1.f + __expf(-a)); sel[e] = sc_[e] + router_b[e]; }
        float gs[4]; int gi1[4], gi2[4]; float gw1[4], gw2[4];
#pragma unroll
        for (int q = 0; q < 4; ++q) { float v1 = -INFINITY, v2 = -INFINITY; int i1 = 0, i2 = 0; float s1 = 0.f, s2 = 0.f;
#pragma unroll
            for (int k = 0; k < 4; ++k) { const float x = sel[4 * q + k], sx = sc_[4 * q + k];
                if (x > v1) { v2 = v1; i2 = i1; s2 = s1; v1 = x; i1 = 4 * q + k; s1 = sx; } else if (x > v2) { v2 = x; i2 = 4 * q + k; s2 = sx; } }
            gs[q] = v1 + v2; gi1[q] = i1; gi2[q] = i2; gw1[q] = s1; gw2[q] = s2; }
        float bv = gs[0]; int e0 = gi1[0], e1 = gi2[0]; float w0 = gw1[0], w1 = gw2[0];
#pragma unroll
        for (int q = 1; q < 4; ++q) if (gs[q] > bv) { bv = gs[q]; e0 = gi1[q]; e1 = gi2[q]; w0 = gw1[q]; w1 = gw2[q]; }
        const float ws = w0 + w1; w0 /= ws; w1 /= ws;
        {
            const int gq = e0 >> 2; int a = e0 & 3, c = e1 & 3; float wa = w0, wc = w1;
            if (a > c) { const int ti = a; a = c; c = ti; const float tf = wa; wa = wc; wc = tf; }
            const int pi = (a == 0) ? (c - 1) : (a == 1 ? c + 1 : 5);
            const int bk = gq * 6 + pi;
            if (lane == 0) { const unsigned loc = __hip_atomic_fetch_add(BC + bk, 1u, __ATOMIC_RELAXED, __HIP_MEMORY_SCOPE_WORKGROUP);
                u32x4 sv; sv.x = (unsigned)bk | (loc << 8); sv.y = (unsigned)row; sv.z = __float_as_uint(wa); sv.w = __float_as_uint(wc); ENT[nent] = sv; }
            ++nent; }
    }
    __syncthreads();
    if (tid < 24) { const unsigned n = BC[tid]; BC[24 + tid] = n ? __hip_atomic_fetch_add(cnt + tid, n, __ATOMIC_RELAXED, __HIP_MEMORY_SCOPE_AGENT) : 0u; }
    __syncthreads();
    if (lane < nent) { const u32x4 en = ENT[lane]; const unsigned bk = en.x & 255u, slot = BC[24 + bk] + (en.x >> 8);
        u32x4 sv; sv.x = en.y; sv.y = en.z; sv.z = en.w; sv.w = 0u; LIST[(size_t)bk * MT + slot] = sv; }
    __syncthreads();
}

__device__ __forceinline__ void post_phase(int cu, int G, const bf16_t* __restrict__ PROJ, const float* __restrict__ qg, const float* __restrict__ kg, const float* __restrict__ COS, const float* __restrict__ SIN,
                                              unsigned char* __restrict__ Q8, unsigned char* __restrict__ K8, unsigned char* __restrict__ VT8) {
    const int lane = otid() & 63, gw = cu * 8 + (otid() >> 6), NGW = G * 8;
    const int d0 = (lane & 7) * 8, jk = lane & 31;
    float qgv[8];
#pragma unroll
    for (int i = 0; i < 8; ++i) qgv[i] = qg[d0 + i];
    const float kg0 = kg[2 * jk], kg1 = kg[2 * jk + 1];
    for (int row0 = gw * 4; row0 < MT; row0 += NGW * 4) {
        const int b = row0 / PB, p0 = row0 - b * PB; const bool is_ctx = p0 < CTXL; const int t0 = is_ctx ? 0 : p0 - CTXL;
        u32x4 wq[4]; unsigned wk[4], wv[4]; f32x4 cq[4], sq[4]; float ck[4], sk[4];
#pragma unroll
        for (int q = 0; q < 4; ++q) { const bf16_t* pr = PROJ + (size_t)(row0 + q) * NIN;
            wq[q] = *(const u32x4*)(pr + C_CQ + lane * 8); wk[q] = *(const unsigned*)(pr + C_CK + lane * 2); wv[q] = *(const unsigned*)(pr + C_CV + lane * 2);
            const int t = is_ctx ? 0 : t0 + q;
            cq[q] = *(const f32x4*)(COS + t * 32 + (d0 >> 1)); sq[q] = *(const f32x4*)(SIN + t * 32 + (d0 >> 1)); ck[q] = COS[t * 32 + jk]; sk[q] = SIN[t * 32 + jk]; }
#pragma unroll
        for (int q = 0; q < 4; ++q) {
            {
                const u32x4 w = wq[q];
                float x[8] = {bflo(w.x), bfhi(w.x), bflo(w.y), bfhi(w.y), bflo(w.z), bfhi(w.z), bflo(w.w), bfhi(w.w)};
                float ss = 0.f;
#pragma unroll
                for (int i = 0; i < 8; ++i) ss += x[i] * x[i];
                ss = xsum<1>(ss); ss = xsum<2>(ss); ss = xsum<4>(ss);
                const float rstd = 1.f / sqrtf(ss * (1.f / 64.f) + EPS);
#pragma unroll
                for (int i = 0; i < 8; ++i) x[i] = x[i] * rstd * qgv[i];
                if (!is_ctx) {
#pragma unroll
                    for (int i = 0; i < 4; ++i) { const float cs = cq[q][i], sn = sq[q][i];
                        const float x1 = x[2 * i], x2 = x[2 * i + 1]; x[2 * i] = x1 * cs - x2 * sn; x[2 * i + 1] = x1 * sn + x2 * cs; } }
                int o0 = 0, o1 = 0;
                o0 = __builtin_amdgcn_cvt_pk_fp8_f32(x[0] * C2, x[1] * C2, o0, false); o0 = __builtin_amdgcn_cvt_pk_fp8_f32(x[2] * C2, x[3] * C2, o0, true);
                o1 = __builtin_amdgcn_cvt_pk_fp8_f32(x[4] * C2, x[5] * C2, o1, false); o1 = __builtin_amdgcn_cvt_pk_fp8_f32(x[6] * C2, x[7] * C2, o1, true);
                u32x2 o; o.x = (unsigned)o0; o.y = (unsigned)o1;
                *(u32x2*)(Q8 + (size_t)(row0 + q) * 512 + lane * 8) = o;
            }
            {
                float x1 = bflo(wk[q]), x2 = bfhi(wk[q]);
                float ss = x1 * x1 + x2 * x2;
                ss = xsum<1>(ss); ss = xsum<2>(ss); ss = xsum<4>(ss); ss = xsum<8>(ss); ss = xsum<16>(ss);
                const float rstd = 1.f / sqrtf(ss * (1.f / 64.f) + EPS);
                x1 = x1 * rstd * kg0; x2 = x2 * rstd * kg1;
                if (!is_ctx) { const float cs = ck[q], sn = sk[q]; const float a = x1 * cs - x2 * sn, c = x1 * sn + x2 * cs; x1 = a; x2 = c; }
                const int w8 = __builtin_amdgcn_cvt_pk_fp8_f32(x1, x2, 0, false);
                *(unsigned short*)(K8 + (size_t)(row0 + q) * 128 + lane * 2) = (unsigned short)w8;
            }
            {
                const int p = p0 + q, tile = p >> 6, kvl = p & 63, c = kvl >> 5, w = kvl & 31, hh = (w >> 2) & 1, tp = (w & 3) + 4 * (w >> 3);
                const int w8 = __builtin_amdgcn_cvt_pk_fp8_f32(bflo(wv[q]), bfhi(wv[q]), 0, false);
                unsigned char* vb = VT8 + ((size_t)((b * 2 + (lane >> 5)) * (PB / 64) + tile)) * 4096 + (size_t)(((hh * 2 + c) * 64 + 2 * (lane & 31)) * 16 + tp);
                vb[0] = (unsigned char)(w8 & 0xff); vb[16] = (unsigned char)((w8 >> 8) & 0xff);
            }
        }
    }
}

namespace hg {
typedef float f32x16 __attribute__((ext_vector_type(16)));
typedef short bf16x8 __attribute__((ext_vector_type(8)));
typedef short s16x4 __attribute__((ext_vector_type(4)));
typedef float f32x2 __attribute__((ext_vector_type(2)));
constexpr int P = 72;
constexpr int O_ZB = 0, O_ZQ = 32768, O_VT = 40960, O_QH = 50176, O_QT = 68608, O_KH = 87040, O_ST = 105472, O_SSQ = 123904, O_OUT = 0  , O_TOT = 0, LDS_BYTES = 124416;
constexpr int MSZ = 64 * P * 2;
constexpr int NCH = PB / 64;
__device__ __forceinline__ int crow(int r, int hi) { return (r & 3) + 8 * (r >> 2) + 4 * hi; }
__device__ __forceinline__ unsigned cvtpk(float lo, float hi) { typedef __bf16 b2 __attribute__((ext_vector_type(2))); f32x2 v = {lo, hi}; b2 b = __builtin_convertvector(v, b2); return __builtin_bit_cast(unsigned, b); }
__device__ __forceinline__ float clampe(float e) { return fminf(fmaxf(e, -80.f), 80.f); }

struct StageRegs { u32x4 wf, wb, wv, wq; };
template <bool FULL> __device__ __forceinline__ void stage_load(StageRegs& s, const bf16_t* __restrict__ PROJ, int row0, int h) {
    const int tid = otid(), t = tid >> 3, pc = tid & 7;
    const bf16_t* pr = PROJ + (size_t)(row0 + t) * NIN + h * 64 + pc * 8;
    s.wf = *(const u32x4*)(pr + C_AFF); s.wb = *(const u32x4*)(pr + C_AFB); s.wv = *(const u32x4*)(pr + C_AI);
    if (FULL) s.wq = *(const u32x4*)(pr + C_AQ);
}
template <bool FULL> __device__ __forceinline__ void prep(unsigned char* lds, const bf16_t* __restrict__ PROJ, const float* __restrict__ LBFl, int row0, int h, StageRegs& sr, int nrow0, int nh) {
    const int tid = otid();
    float* ZB = (float*)(lds + O_ZB); bf16_t* ZQ = (bf16_t*)(lds + O_ZQ); bf16_t* VT = (bf16_t*)(lds + O_VT);
    {
        const int t = tid >> 3, pc = tid & 7;
        const u32x4 wf = sr.wf, wb = sr.wb, wv = sr.wv;
        float* zf = ZB + t * 64 + pc * 8; float* zb = ZB + 4096 + t * 64 + pc * 8;
        *(f32x4*)zf = (f32x4){bflo(wf.x), bfhi(wf.x), bflo(wf.y), bfhi(wf.y)}; *(f32x4*)(zf + 4) = (f32x4){bflo(wf.z), bfhi(wf.z), bflo(wf.w), bfhi(wf.w)};
        *(f32x4*)zb = (f32x4){bflo(wb.x), bfhi(wb.x), bflo(wb.y), bfhi(wb.y)}; *(f32x4*)(zb + 4) = (f32x4){bflo(wb.z), bfhi(wb.z), bflo(wb.w), bfhi(wb.w)};
        bf16_t* vt = VT + (pc * 8) * P + t;
        vt[0 * P] = (bf16_t)(wv.x & 0xffffu); vt[1 * P] = (bf16_t)(wv.x >> 16); vt[2 * P] = (bf16_t)(wv.y & 0xffffu); vt[3 * P] = (bf16_t)(wv.y >> 16);
        vt[4 * P] = (bf16_t)(wv.z & 0xffffu); vt[5 * P] = (bf16_t)(wv.z >> 16); vt[6 * P] = (bf16_t)(wv.w & 0xffffu); vt[7 * P] = (bf16_t)(wv.w >> 16);
        if (FULL) { const u32x4 wq = sr.wq; *(u32x4*)(ZQ + t * 64 + pc * 8) = wq; }
        if (nrow0 >= 0) stage_load<FULL>(sr, PROJ, nrow0, nh);
    }
    __syncthreads();
#pragma unroll
    for (int it = 0; it < 2; ++it) {
        const int item = tid + it * 512, dir = item >> 9, t = (item >> 3) & 63, i0 = (item & 7) * 8;
        float* zp = ZB + dir * 4096 + t * 64 + i0; const float* lp = LBFl + dir * 256 + h * 64 + i0;
        f32x4 za = *(const f32x4*)zp, zc = *(const f32x4*)(zp + 4); const f32x4 la = *(const f32x4*)lp, lc = *(const f32x4*)(lp + 4);
#pragma unroll
        for (int k = 0; k < 4; ++k) { za[k] = __logf(la[k] + (1.f - la[k]) / (1.f + __expf(-za[k]))); zc[k] = __logf(lc[k] + (1.f - lc[k]) / (1.f + __expf(-zc[k]))); }
        *(f32x4*)zp = za; *(f32x4*)(zp + 4) = zc;
    }
    __syncthreads();
    if (tid < 128) {
        const int dir = tid >> 6, i = tid & 63;
        float* zb = ZB + dir * 4096 + i; float acc = 0.f;
        if (dir == 0) {
#pragma unroll 16
            for (int t = 0; t < 64; ++t) { acc += zb[t * 64]; zb[t * 64] = acc; } }
        else {
#pragma unroll 16
            for (int t = 63; t >= 0; --t) { acc += zb[t * 64]; zb[t * 64] = acc; } }
    }
    __syncthreads();
#pragma unroll
    for (int it = 0; it < 2; ++it) {
        const int item = tid + it * 512, dir = item >> 9, t = (item >> 3) & 63, i0 = (item & 7) * 8;
        const float* B = ZB + dir * 4096;
        const int tp = dir == 0 ? t - 1 : t + 1; const bool edge = dir == 0 ? (t == 0) : (t == 63);
        const int tref = dir == 0 ? 31 : 32;
        float bc[8], bp[8], br[8];
        { const f32x4 a = *(const f32x4*)(B + t * 64 + i0), c = *(const f32x4*)(B + t * 64 + i0 + 4); bc[0] = a.x; bc[1] = a.y; bc[2] = a.z; bc[3] = a.w; bc[4] = c.x; bc[5] = c.y; bc[6] = c.z; bc[7] = c.w; }
        { const int tq = edge ? t : tp; const f32x4 a = *(const f32x4*)(B + tq * 64 + i0), c = *(const f32x4*)(B + tq * 64 + i0 + 4);
          bp[0] = a.x; bp[1] = a.y; bp[2] = a.z; bp[3] = a.w; bp[4] = c.x; bp[5] = c.y; bp[6] = c.z; bp[7] = c.w;
          if (edge) {
#pragma unroll
              for (int k = 0; k < 8; ++k) bp[k] = 0.f; } }
        { const f32x4 a = *(const f32x4*)(B + tref * 64 + i0), c = *(const f32x4*)(B + tref * 64 + i0 + 4); br[0] = a.x; br[1] = a.y; br[2] = a.z; br[3] = a.w; br[4] = c.x; br[5] = c.y; br[6] = c.z; br[7] = c.w; }
        float kh[8];
#pragma unroll
        for (int k = 0; k < 8; ++k) { const float kk = 1.f - __expf(bc[k] - bp[k]); kh[k] = kk * __expf(clampe(br[k] - bc[k])); }
        if (!FULL) {
            bf16_t* kt = (bf16_t*)(lds + O_KH + dir * MSZ) + i0 * P + t;
#pragma unroll
            for (int k = 0; k < 8; ++k) kt[k * P] = (bf16_t)f2bf(kh[k]);
        } else {
            u32x4 w; w.x = cvtpk(kh[0], kh[1]); w.y = cvtpk(kh[2], kh[3]); w.z = cvtpk(kh[4], kh[5]); w.w = cvtpk(kh[6], kh[7]);
            *(u32x4*)((bf16_t*)(lds + O_KH + dir * MSZ) + t * P + i0) = w;
            const u32x4 wq = *(const u32x4*)(ZQ + t * 64 + i0);
            float q[8] = {silu(bflo(wq.x)), silu(bfhi(wq.x)), silu(bflo(wq.y)), silu(bfhi(wq.y)), silu(bflo(wq.z)), silu(bfhi(wq.z)), silu(bflo(wq.w)), silu(bfhi(wq.w))};
            float qh[8], qt[8];
#pragma unroll
            for (int k = 0; k < 8; ++k) { qh[k] = q[k] * __expf(clampe(bc[k] - br[k])); qt[k] = q[k] * __expf(bc[k]); }
            w.x = cvtpk(qh[0], qh[1]); w.y = cvtpk(qh[2], qh[3]); w.z = cvtpk(qh[4], qh[5]); w.w = cvtpk(qh[6], qh[7]);
            *(u32x4*)((bf16_t*)(lds + O_QH + dir * MSZ) + t * P + i0) = w;
            w.x = cvtpk(qt[0], qt[1]); w.y = cvtpk(qt[2], qt[3]); w.z = cvtpk(qt[4], qt[5]); w.w = cvtpk(qt[6], qt[7]);
            *(u32x4*)((bf16_t*)(lds + O_QT + dir * MSZ) + t * P + i0) = w;
        }
    }
    __syncthreads();
}

__device__ __forceinline__ void h1_phase(unsigned char* lds, const bf16_t* __restrict__ PROJ, const float* __restrict__ LBFl, bf16_t* __restrict__ UT, float* __restrict__ DEC, int cu, int G) {
    const int tid = otid(), lane = tid & 63, r32 = lane & 31, hi = lane >> 5, w = __builtin_amdgcn_readfirstlane(tid >> 6);
    StageRegs sr;
    if (cu < BATCH * NCH * 4) { const int h = cu & 3, bc = cu >> 2, b = bc / NCH, cp = bc - b * NCH; stage_load<false>(sr, PROJ, b * PB + cp * 64, h); }
    for (int u = cu; u < BATCH * NCH * 4; u += G) {
        const int h = u & 3, bc = u >> 2, b = bc / NCH, cp = bc - b * NCH, row0 = b * PB + cp * 64;
        int nrow0 = -1, nh = 0; { const int un = u + G; if (un < BATCH * NCH * 4) { const int bcn = un >> 2, bn = bcn / NCH; nh = un & 3; nrow0 = bn * PB + (bcn - bn * NCH) * 64; } }
        prep<false>(lds, PROJ, LBFl, row0, h, sr, nrow0, nh);
        const float* ZB = (const float*)(lds + O_ZB);
        {
            const int dir = w >> 2, jb = (w >> 1) & 1, ib = w & 1;
            const bf16_t* VT = (const bf16_t*)(lds + O_VT) + (jb * 32 + r32) * P + hi * 8;
            const bf16_t* KT = (const bf16_t*)(lds + O_KH + dir * MSZ) + (ib * 32 + r32) * P + hi * 8;
            f32x16 acc = {};
#pragma unroll
            for (int ks = 0; ks < 4; ++ks) acc = __builtin_amdgcn_mfma_f32_32x32x16_bf16(*(const bf16x8*)(VT + ks * 16), *(const bf16x8*)(KT + ks * 16), acc, 0, 0, 0);
            const int i = ib * 32 + r32;
            const float btot = ZB[dir * 4096 + (dir == 0 ? 63 : 0) * 64 + i], bref = ZB[dir * 4096 + (dir == 0 ? 31 : 32) * 64 + i];
            const float sc = __expf(btot - bref);
            const int chain = (b * 4 + h) * 2 + dir;
            bf16_t* ut = UT + ((size_t)chain * NCH + cp) * 4096 + i;
#pragma unroll
            for (int r = 0; r < 16; ++r) ut[(jb * 32 + crow(r, hi)) * 64] = (bf16_t)f2bf(acc[r] * sc);
        }
        if (tid < 128) { const int dir = tid >> 6, i = tid & 63; const int chain = (b * 4 + h) * 2 + dir;
            DEC[((size_t)chain * NCH + cp) * 64 + i] = __expf(ZB[dir * 4096 + (dir == 0 ? 63 : 0) * 64 + i]); }
        __syncthreads();
    }
}

__device__ __forceinline__ void h2_phase(unsigned char* lds, const bf16_t* __restrict__ UT, const float* __restrict__ DEC, bf16_t* __restrict__ ST, int cu, int G) {
    const int tid = otid(), seg = tid >> 7, e = tid & 127, jl = e >> 5, i = (e & 31) * 2;
    f32x4* TOT = (f32x4*)(lds + O_TOT);
    for (int task = cu; task < 256; task += G) {
        const int chain = task >> 4, j = (task & 15) * 4 + jl, dir = chain & 1;
        const size_t cbase = (size_t)chain * NCH;
        float S0 = 0.f, S1 = 0.f, P0 = 1.f, P1 = 1.f;
#pragma unroll 11
        for (int kk = 0; kk < 33; ++kk) { const int k = seg * 33 + kk, cp = dir == 0 ? k : (k < 4 ? 3 - k : 135 - k);
            const unsigned u = *(const unsigned*)(UT + (cbase + cp) * 4096 + j * 64 + i); const f32x2 d = *(const f32x2*)(DEC + (cbase + cp) * 64 + i);
            S0 = d.x * S0 + bflo(u); S1 = d.y * S1 + bfhi(u); P0 *= d.x; P1 *= d.y; }
        TOT[seg * 128 + e] = (f32x4){S0, S1, P0, P1};
        __syncthreads();
        float s0 = 0.f, s1 = 0.f;
#pragma unroll
        for (int sp = 0; sp < 3; ++sp) if (sp < seg) { const f32x4 t = TOT[sp * 128 + e]; s0 = t.z * s0 + t.x; s1 = t.w * s1 + t.y; }
#pragma unroll 11
        for (int kk = 0; kk < 33; ++kk) { const int k = seg * 33 + kk, cp = dir == 0 ? k : (k < 4 ? 3 - k : 135 - k);
            const unsigned u = *(const unsigned*)(UT + (cbase + cp) * 4096 + j * 64 + i); const f32x2 d = *(const f32x2*)(DEC + (cbase + cp) * 64 + i);
            *(unsigned*)(ST + (cbase + cp) * 4096 + j * 64 + i) = pk2(s0, s1);
            s0 = d.x * s0 + bflo(u); s1 = d.y * s1 + bfhi(u); }
        __syncthreads();
    }
}

__device__ __forceinline__ void h3_phase(unsigned char* lds, const bf16_t* __restrict__ PROJ, const float* __restrict__ LBFl, const bf16_t* __restrict__ ST, const float* __restrict__ ng, bf16_t* __restrict__ MIX, int cu, int G) {
    const int tid = otid(), lane = tid & 63, r32 = lane & 31, hi = lane >> 5, w = __builtin_amdgcn_readfirstlane(tid >> 6);
    StageRegs sr; u32x4 sv0, sv1;
    const int u0 = G - 1 - cu;
    if (u0 < BATCH * NCH * 4) { const int h = u0 & 3, bc = u0 >> 2, b = bc / NCH, cp = bc - b * NCH; stage_load<true>(sr, PROJ, b * PB + cp * 64, h);
        const size_t so = ((size_t)((b * 4 + h) * 2) * NCH + cp) * 4096 + (tid >> 3) * 64 + (tid & 7) * 8; sv0 = *(const u32x4*)(ST + so); sv1 = *(const u32x4*)(ST + so + (size_t)NCH * 4096); }
    for (int u = u0; u < BATCH * NCH * 4; u += G) {
        const int h = u & 3, bc = u >> 2, b = bc / NCH, cp = bc - b * NCH, row0 = b * PB + cp * 64;
        int nrow0 = -1, nh = 0, nb = 0, ncp = 0; { const int un = u + G; if (un < BATCH * NCH * 4) { const int bcn = un >> 2; nb = bcn / NCH; ncp = bcn - nb * NCH; nh = un & 3; nrow0 = nb * PB + ncp * 64; } }
        { const int j = tid >> 3, ic = (tid & 7) * 8;
          *(u32x4*)((bf16_t*)(lds + O_ST) + j * P + ic) = sv0; *(u32x4*)((bf16_t*)(lds + O_ST + MSZ) + j * P + ic) = sv1;
          if (nrow0 >= 0) { const size_t so = ((size_t)((nb * 4 + nh) * 2) * NCH + ncp) * 4096 + j * 64 + ic; sv0 = *(const u32x4*)(ST + so); sv1 = *(const u32x4*)(ST + so + (size_t)NCH * 4096); } }
        prep<true>(lds, PROJ, LBFl, row0, h, sr, nrow0, nh);
        float* SSQ = (float*)(lds + O_SSQ); bf16_t* OUT = (bf16_t*)(lds + O_OUT);
        f32x16 ot = {};
        const int jb = (w >> 1) & 1, tb = w & 1;
        if (w < 4) {
            const bf16_t* VT = (const bf16_t*)(lds + O_VT) + (jb * 32 + r32) * P;
#pragma unroll
            for (int sb = 0; sb < 2; ++sb) {
                f32x16 xf = {}, xb = {};
                const bf16_t* QF = (const bf16_t*)(lds + O_QH) + (tb * 32 + r32) * P + hi * 8; const bf16_t* QB = QF + 64 * P;
                const bf16_t* KF = (const bf16_t*)(lds + O_KH) + (sb * 32 + r32) * P + hi * 8; const bf16_t* KB = KF + 64 * P;
                if (sb <= tb) {
#pragma unroll
                    for (int ks = 0; ks < 4; ++ks) xf = __builtin_amdgcn_mfma_f32_32x32x16_bf16(*(const bf16x8*)(KF + ks * 16), *(const bf16x8*)(QF + ks * 16), xf, 0, 0, 0); }
                if (sb >= tb) {
#pragma unroll
                    for (int ks = 0; ks < 4; ++ks) xb = __builtin_amdgcn_mfma_f32_32x32x16_bf16(*(const bf16x8*)(KB + ks * 16), *(const bf16x8*)(QB + ks * 16), xb, 0, 0, 0); }
                float x[16];
#pragma unroll
                for (int r = 0; r < 16; ++r) { const int s = crow(r, hi), t = r32;
                    const float vf = (sb < tb || (sb == tb && s <= t)) ? xf[r] : 0.f, vb = (sb > tb || (sb == tb && s >= t)) ? xb[r] : 0.f; x[r] = vf + vb; }
#pragma unroll
                for (int sp = 0; sp < 2; ++sp) {
                    u32x4 xw; xw.x = cvtpk(x[8 * sp + 0], x[8 * sp + 1]); xw.y = cvtpk(x[8 * sp + 2], x[8 * sp + 3]); xw.z = cvtpk(x[8 * sp + 4], x[8 * sp + 5]); xw.w = cvtpk(x[8 * sp + 6], x[8 * sp + 7]);
                    const s16x4 v0 = *(const s16x4*)(VT + sb * 32 + 16 * sp + 4 * hi), v1 = *(const s16x4*)(VT + sb * 32 + 16 * sp + 8 + 4 * hi);
                    const bf16x8 va = {v0[0], v0[1], v0[2], v0[3], v1[0], v1[1], v1[2], v1[3]};
                    ot = __builtin_amdgcn_mfma_f32_32x32x16_bf16(va, __builtin_bit_cast(bf16x8, xw), ot, 0, 0, 0); }
            }
#pragma unroll
            for (int dir = 0; dir < 2; ++dir) {
                const bf16_t* SA = (const bf16_t*)(lds + O_ST + dir * MSZ) + (jb * 32 + r32) * P + hi * 8; const bf16_t* QT = (const bf16_t*)(lds + O_QT + dir * MSZ) + (tb * 32 + r32) * P + hi * 8;
#pragma unroll
                for (int ks = 0; ks < 4; ++ks) ot = __builtin_amdgcn_mfma_f32_32x32x16_bf16(*(const bf16x8*)(SA + ks * 16), *(const bf16x8*)(QT + ks * 16), ot, 0, 0, 0); }
            float part = 0.f;
#pragma unroll
            for (int r = 0; r < 16; ++r) part += ot[r] * ot[r];
            part = xsum<32>(part);
            if (hi == 0) SSQ[jb * 64 + tb * 32 + r32] = part;
        }
        __syncthreads();
        if (w < 4) { const int t = tb * 32 + r32; const float rstd = 1.f / sqrtf((SSQ[t] + SSQ[64 + t]) * (1.f / 64.f) + EPS);
#pragma unroll
            for (int r = 0; r < 16; ++r) { const int j = jb * 32 + crow(r, hi); OUT[t * P + j] = (bf16_t)f2bf(ot[r] * rstd * ng[j]); } }
        __syncthreads();
        {
            const int t = tid >> 3, jc = (tid & 7) * 8;
            const u32x4 y = *(const u32x4*)(OUT + t * P + jc); const u32x4 g = *(const u32x4*)(PROJ + (size_t)(row0 + t) * NIN + C_AG + h * 64 + jc);
            u32x4 o; o.x = pk2(bflo(y.x) * silu(bflo(g.x)), bfhi(y.x) * silu(bfhi(g.x))); o.y = pk2(bflo(y.y) * silu(bflo(g.y)), bfhi(y.y) * silu(bfhi(g.y)));
            o.z = pk2(bflo(y.z) * silu(bflo(g.z)), bfhi(y.z) * silu(bfhi(g.z))); o.w = pk2(bflo(y.w) * silu(bflo(g.w)), bfhi(y.w) * silu(bfhi(g.w)));
            *(u32x4*)(MIX + (size_t)(row0 + t) * D + h * 64 + jc) = o;
        }
        __syncthreads();
    }
}
}
__device__ __forceinline__ int vcu_of(int bx, int G) { return (G % 8 == 0) ? (bx % 8) * (G / 8) + bx / 8 : bx; }
__device__ __forceinline__ void attn_phase(char* lds, const unsigned char* Q8, const unsigned char* K8, const unsigned char* VT8, bf16_t* MIX, float neg_ref, int vcu, int G, bool with_ctx) {
    using attn8::bf16;
    const int upc = (512 + G - 1) / G;
    const int nun = upc + ((with_ctx && vcu < 16) ? 1 : 0);
    for (int i = 0; i < nun; ++i) {
        int b, h, nt; size_t q0;
        if (i < upc) { const int u = vcu * upc + i; if (u >= 512) continue; const int combo = u >> 7; b = combo >> 1; h = (combo & 1) * 4 + ((u >> 5) & 3); q0 = (size_t)b * PB + CTXL + (size_t)(u & 31) * 256; nt = PB / 64; }
        else { b = vcu >> 3; h = vcu & 7; q0 = (size_t)b * PB; nt = CTXL / 64; }
        const int kvh = h >> 2; const size_t k0 = (size_t)b * PB;
        attn8::attn_unit(Q8 + q0 * 512 + h * 64, K8 + k0 * 128 + kvh * 64, VT8 + (size_t)((b * 2 + kvh) * (PB / 64)) * 4096, (bf16*)MIX + q0 * 1024 + 512 + h * 64, nt, neg_ref, lds);
    }
}

namespace pg8 {
struct EpiResid {
    static constexpr bool PERM = false, AFTER_DRAIN = false;
    const float* src_lat; const float* src_ctx; float* dst_lat; float* dst_ctx; const float* modv; int ga_off; int pad;
    __device__ __forceinline__ void operator()(const f32x4 (&acc)[2][2][4][2], const Unit& u, int wr, int wc, int fr, int fq) const {
        asm volatile("" : "+v"(fr), "+v"(fq));
        const int b = u.pm / TPB, w = u.pm - b * TPB;
        const size_t base = (w == 0) ? (size_t)b * CTXL * D : ((size_t)b * SEQ + (size_t)(w - 1) * 256) * D;
        const float* s = ((w == 0) ? src_ctx : src_lat) + base; float* d = ((w == 0) ? dst_ctx : dst_lat) + base;
        const float* ga = modv + ((w == 0) ? 2 : b) * 6144 + ga_off;
        const int row0 = wr * 64 + fr, col0 = u.pn * BM + wc * 32 + 4 * fq;
        f32x4 gv[2][2];
#pragma unroll
        for (int bj = 0; bj < 2; ++bj)
#pragma unroll
            for (int n = 0; n < 2; ++n) gv[bj][n] = *(const f32x4*)(ga + col0 + bj * HALF + n * 16);
#pragma unroll
        for (int ai = 0; ai < 2; ++ai)
#pragma unroll
            for (int m = 0; m < 4; ++m) { const size_t off = (size_t)(row0 + ai * HALF + m * 16) * D + col0;
#pragma unroll
                for (int bj = 0; bj < 2; ++bj)
#pragma unroll
                    for (int n = 0; n < 2; ++n) *(f32x4*)(d + off + bj * HALF + n * 16) = *(const f32x4*)(s + off + bj * HALF + n * 16) + gv[bj][n] * acc[ai][bj][m][n]; }
    }
};
struct OutOrder : StaticOrder {
    int lat_only;
    __device__ __forceinline__ bool next(int i, Unit& u) const { if (!StaticOrder::next(i, u)) return false; if (lat_only) u.pm = (u.pm >> 5) * TPB + 1 + (u.pm & 31); return true; }
};
}


namespace pg8 {
struct MUnit { int pm, pn, nrows, lbase, e0, e1; };
__device__ __forceinline__ void build_tiles(PG8_LAS int* TT, const unsigned* cnt) {
    if (otid() == 0) { int off = 0;
        for (int bk = 0; bk < 24; ++bk) { const int c = (int)__hip_atomic_load(cnt + bk, __ATOMIC_RELAXED, __HIP_MEMORY_SCOPE_AGENT); const int nb = (c + 255) >> 8;
            for (int ti = 0; ti < nb; ++ti) { const int rem = c - ti * 256; TT[4 + 4 * off + 0] = bk; TT[4 + 4 * off + 1] = ti; TT[4 + 4 * off + 2] = rem < 256 ? rem : 256; TT[4 + 4 * off + 3] = 0; ++off; } }
        TT[0] = off; }
    __syncthreads();
}
template <int NPN  > struct MoeOrder {
    const PG8_LAS int* TT; int G, c;
    __device__ __forceinline__ bool next(int i, MUnit& u) const {
        const int L = i * G + c, tile = L / NPN; if (tile >= TT[0]) return false;
        const int bk = TT[4 + 4 * tile], ti = TT[4 + 4 * tile + 1];
        u.pm = tile; u.pn = L - tile * NPN; u.nrows = TT[4 + 4 * tile + 2]; u.lbase = bk * MT + ti * 256;
        const int g = bk / 6, pi = bk - g * 6; const int lo = pi < 3 ? 0 : (pi < 5 ? 1 : 2), hi = pi < 3 ? pi + 1 : (pi < 5 ? pi - 1 : 3);
        u.e0 = 4 * g + lo; u.e1 = 4 * g + hi; return true;
    }
};
struct Src1 {
    const bf16_t* XN; const bf16_t* WGU; const u32x4* LIST;
    __device__ __forceinline__ const char* a_base(const MUnit&) const { return (const char*)XN; }
    __device__ __forceinline__ void a_offsets(const MUnit& u, const int (&RA)[2], const int (&CA)[2], unsigned (&ao)[2][2]) const {
#pragma unroll
        for (int h = 0; h < 2; ++h)
#pragma unroll
            for (int i = 0; i < 2; ++i) { const int r = h * HALF + RA[i]; const unsigned row = r < u.nrows ? LIST[u.lbase + r].x : 0u; ao[h][i] = (row * (unsigned)D + (unsigned)CA[i]) * 2u; }
    }
    __device__ __forceinline__ const char* b_base(const MUnit& u, int seg) const { const int e = (u.pn >> 2) ? u.e1 : u.e0;
        return (const char*)(WGU + ((size_t)e * 1024 + (size_t)(u.pn & 3) * 256) * D) + (seg ? (size_t)(D / 2) * 2 : 0); }
    __device__ __forceinline__ void prefetch_rows(const MUnit& u, const int (&)[2], PG8_LAS unsigned char* rows, int wid) const {
        int t2 = otid(); asm volatile("" : "+v"(t2));
        int RA[2];
#pragma unroll
        for (int i = 0; i < 2; ++i) { int R, C; stage_rc(t2 * 16 + i * 8192, R, C); RA[i] = R; }
#pragma unroll
        for (int h = 0; h < 2; ++h)
#pragma unroll
            for (int i = 0; i < 2; ++i) { const int r = h * HALF + RA[i];
                __builtin_amdgcn_global_load_lds((const unsigned*)&LIST[u.lbase + r], (PG8_LAS unsigned*)(rows + ((h * 2 + i) * 8 + wid) * 256), 4, 0, 0); }
    }
    __device__ __forceinline__ void reload_offsets(const MUnit& u, const int (&)[2], const int (&)[2], const PG8_LAS unsigned char* rows, int wid, int lane, unsigned (&ao)[2][2]) const {
        int t2 = otid(); asm volatile("" : "+v"(t2));
        int RA[2], CA[2];
#pragma unroll
        for (int i = 0; i < 2; ++i) { int R, C; stage_rc(t2 * 16 + i * 8192, R, C); RA[i] = R; CA[i] = C; }
#pragma unroll
        for (int h = 0; h < 2; ++h)
#pragma unroll
            for (int i = 0; i < 2; ++i) { const int r = h * HALF + RA[i]; const unsigned v = *(const PG8_LAS unsigned*)(rows + ((h * 2 + i) * 8 + wid) * 256 + lane * 4);
                const unsigned row = r < u.nrows ? v : 0u; ao[h][i] = (row * (unsigned)D + (unsigned)CA[i]) * 2u; }
    }
};
struct Src2 {
    const bf16_t* ACT2; const bf16_t* WD;
    __device__ __forceinline__ const char* a_base(const MUnit& u) const { return (const char*)(ACT2 + (size_t)u.pm * 256 * 1024); }
    __device__ __forceinline__ void a_offsets(const MUnit&, const int (&RA)[2], const int (&CA)[2], unsigned (&ao)[2][2]) const {
#pragma unroll
        for (int h = 0; h < 2; ++h)
#pragma unroll
            for (int i = 0; i < 2; ++i) ao[h][i] = (unsigned)((h * HALF + RA[i]) * 1024 + CA[i]) * 2u;
    }
    __device__ __forceinline__ const char* b_base(const MUnit& u, int seg) const { const int e = seg ? u.e1 : u.e0; return (const char*)(WD + ((size_t)e * 1024 + (size_t)u.pn * 256) * DE); }
    __device__ __forceinline__ void prefetch_rows(const MUnit&, const int (&)[2], PG8_LAS unsigned char*, int) const {}
    __device__ __forceinline__ void reload_offsets(const MUnit&, const int (&)[2], const int (&)[2], const PG8_LAS unsigned char*, int, int, unsigned (&)[2][2]) const {}
};
struct EpiGateUp2 {
    static constexpr bool PERM = true;
    bf16_t* ACT2; const u32x4* LIST;
    __device__ __forceinline__ void operator()(const f32x4 (&acc)[2][2][4][2], const MUnit& u, int wr, int wc, int fr, int fq) const {
        asm volatile("" : "+v"(fr), "+v"(fq));
        const int slot = u.pn >> 2, colA = slot * DE + (u.pn & 3) * HALF + wc * 32 + 8 * fq;
        const unsigned* lw = (const unsigned*)(LIST + u.lbase + wr * 64 + fr) + 1 + slot;
#pragma unroll
        for (int ai = 0; ai < 2; ++ai) {
            unsigned wv[4];
#pragma unroll
            for (int m = 0; m < 4; ++m) wv[m] = lw[(ai * HALF + m * 16) * 4];
#pragma unroll
            for (int m = 0; m < 4; ++m) { const int r = ai * HALF + wr * 64 + m * 16 + fr;
                const bool valid = r < u.nrows; const float cw = valid ? __uint_as_float(wv[m]) : 0.f;
                const f32x4 g0 = acc[ai][0][m][0], g1 = acc[ai][0][m][1], u0 = acc[ai][1][m][0], u1 = acc[ai][1][m][1];
                u32x4 w;
                w.x = cvt_pk_bf16(silu(g0[0]) * u0[0] * cw, silu(g0[1]) * u0[1] * cw); w.y = cvt_pk_bf16(silu(g0[2]) * u0[2] * cw, silu(g0[3]) * u0[3] * cw);
                w.z = cvt_pk_bf16(silu(g1[0]) * u1[0] * cw, silu(g1[1]) * u1[1] * cw); w.w = cvt_pk_bf16(silu(g1[2]) * u1[2] * cw, silu(g1[3]) * u1[3] * cw);
                if (!valid) w = (u32x4){0u, 0u, 0u, 0u};
                *(u32x4*)(ACT2 + ((size_t)u.pm * 256 + r) * 1024 + colA) = w; }
            asm volatile("" ::: "memory"); }
    }
};
struct EpiMoeOut {
    static constexpr bool PERM = false;
    float* lat; float* ctx; const float* modv; const u32x4* LIST;
    __device__ __forceinline__ void operator()(const f32x4 (&acc)[2][2][4][2], const MUnit& u, int wr, int wc, int fr, int fq) const {
        asm volatile("" : "+v"(fr), "+v"(fq));
        const int col0 = u.pn * BM + wc * 32 + 4 * fq;
        const unsigned* lw = (const unsigned*)(LIST + u.lbase + wr * 64 + fr);
        unsigned rv[2][4];
#pragma unroll
        for (int ai = 0; ai < 2; ++ai)
#pragma unroll
            for (int m = 0; m < 4; ++m) rv[ai][m] = lw[(ai * HALF + m * 16) * 4];
#pragma unroll
        for (int ai = 0; ai < 2; ++ai)
#pragma unroll
            for (int m = 0; m < 4; ++m) { const int r = ai * HALF + wr * 64 + m * 16 + fr;
                if (r < u.nrows) { const int row = (int)rv[ai][m]; bool is_ctx; const size_t off = stream_off(row, is_ctx);
                    float* d = (is_ctx ? ctx : lat) + off + col0; const float* ga = modv + (is_ctx ? 2 : row / PB) * 6144 + 5120 + col0;
#pragma unroll
                    for (int bj = 0; bj < 2; ++bj)
#pragma unroll
                        for (int n = 0; n < 2; ++n) { f32x4* p = (f32x4*)(d + bj * HALF + n * 16); *p = *p + *(const f32x4*)(ga + bj * HALF + n * 16) * acc[ai][bj][m][n]; } } }
    }
};

template <class Epi, class Sched, class Src>
__device__ __forceinline__ void gemm_phase_x(PG8_LAS unsigned char* lds, PG8_LAS unsigned char* rows, const Sched& S, const Src& X, const Epi& E, const int KB, const int nt) {
    const int tid = otid(), wid = __builtin_amdgcn_readfirstlane(tid >> 6), lane = tid & 63, wr = wid >> 2, wc = wid & 3, fr = lane & 15, fq = lane >> 4;
    int RA[2], CA[2]; unsigned voffB[2];
#pragma unroll
    for (int i = 0; i < 2; ++i) { int R, C; stage_rc(tid * 16 + i * 8192, R, C); const int Rb = Epi::PERM ? ((R & ~31) + perm32(R & 31)) : R; RA[i] = R; CA[i] = C; voffB[i] = (unsigned)(Rb * KB + C) * 2u; }
    const size_t kstep = (size_t)(BK * 2);
    const size_t hstepB = (size_t)HALF * KB * 2;
    const int half = nt >> 1;
    const unsigned ldsw = (unsigned)wid * 1024u;
    const int aoff = lds_byte(wr * 64 + fr, fq * 8), boff = lds_byte(wc * 32 + fr, fq * 8);
#define PG8_SA(b, h) (((b) * 2 + (h)) * HTB)
#define PG8_SB(b, h) ((4 + (b) * 2 + (h)) * HTB)
#define PG8_STAGE_B(bufoff, gbase) do { _Pragma("unroll") for (int _i = 0; _i < 2; ++_i) \
        __builtin_amdgcn_global_load_lds((const unsigned*)((const char*)(gbase) + voffB[_i]), (PG8_LAS unsigned*)(lds + (bufoff) + ldsw + _i * 8192), 16, 0, 0); } while (0)
#define PG8_STAGE_A(bufoff, gbase, o0, o1) do { \
        __builtin_amdgcn_global_load_lds((const unsigned*)((const char*)(gbase) + (o0)), (PG8_LAS unsigned*)(lds + (bufoff) + ldsw), 16, 0, 0); \
        __builtin_amdgcn_global_load_lds((const unsigned*)((const char*)(gbase) + (o1)), (PG8_LAS unsigned*)(lds + (bufoff) + ldsw + 8192), 16, 0, 0); } while (0)
#define PG8_LDA(dst, b, h) do { _Pragma("unroll") for (int m = 0; m < 4; ++m) _Pragma("unroll") for (int k = 0; k < 2; ++k) dst[m][k] = *(const PG8_LAS bf16x8*)(lds + PG8_SA(b, h) + aoff + m * 2048 + k * 1024); } while (0)
#define PG8_LDB(dst, b, h) do { _Pragma("unroll") for (int n = 0; n < 2; ++n) _Pragma("unroll") for (int k = 0; k < 2; ++k) dst[n][k] = *(const PG8_LAS bf16x8*)(lds + PG8_SB(b, h) + boff + n * 2048 + k * 1024); } while (0)
#define PG8_MMA(ai, bj, At, Bt) do { __builtin_amdgcn_s_setprio(1); _Pragma("unroll") for (int m = 0; m < 4; ++m) _Pragma("unroll") for (int n = 0; n < 2; ++n) _Pragma("unroll") for (int k = 0; k < 2; ++k) \
        acc[ai][bj][m][n] = __builtin_amdgcn_mfma_f32_16x16x32_bf16(Bt[n][k], At[m][k], acc[ai][bj][m][n], 0, 0, 0); __builtin_amdgcn_s_setprio(0); } while (0)
#define PG8_WAIT_V(n) asm volatile("s_waitcnt vmcnt(" #n ")" ::: "memory")
#define PG8_WAIT_L(n) asm volatile("s_waitcnt lgkmcnt(" #n ")" ::: "memory")
#define PG8_BAR __builtin_amdgcn_s_barrier()
#define PG8_SCHED __builtin_amdgcn_sched_barrier(0)
    MUnit cur, nxt; int ui = 0;
    if (!S.next(0, cur)) return;
    f32x4 acc[2][2][4][2];
#pragma unroll
    for (int a = 0; a < 2; ++a)
#pragma unroll
        for (int b = 0; b < 2; ++b)
#pragma unroll
            for (int m = 0; m < 4; ++m)
#pragma unroll
                for (int n = 0; n < 2; ++n) acc[a][b][m][n] = (f32x4){0.f, 0.f, 0.f, 0.f};
    bf16x8 At[4][2], B0[2][2], B1[2][2];
    unsigned aoc[2][2];
    X.a_offsets(cur, RA, CA, aoc);
    const char* cAb = X.a_base(cur); const char* cB0 = X.b_base(cur, 0); const char* cB1 = X.b_base(cur, 1);
    PG8_STAGE_B(PG8_SB(0, 0), cB0); PG8_STAGE_B(PG8_SB(0, 1), cB0 + hstepB); PG8_STAGE_A(PG8_SA(0, 0), cAb, aoc[0][0], aoc[0][1]); PG8_STAGE_A(PG8_SA(0, 1), cAb, aoc[1][0], aoc[1][1]);
    if (wr == 1) PG8_BAR;
    PG8_WAIT_V(2); PG8_BAR;
    PG8_STAGE_B(PG8_SB(1, 0), cB0 + kstep); PG8_STAGE_A(PG8_SA(1, 0), cAb + kstep, aoc[0][0], aoc[0][1]); PG8_STAGE_B(PG8_SB(1, 1), cB0 + hstepB + kstep);
    PG8_WAIT_V(6); PG8_BAR;
    for (;;) {
        const bool has_next = S.next(ui + 1, nxt);
        const char* nAb = cAb; const char* nB0 = cB0; const char* nB1 = cB1;
        if (has_next) { X.prefetch_rows(nxt, RA, rows, wid); nAb = X.a_base(nxt); nB0 = X.b_base(nxt, 0); nB1 = X.b_base(nxt, 1); }
        for (int t = 0; t < nt; t += 2) {
            const bool last = (t == nt - 2);
            const char* a1 = cAb + (size_t)(t + 1) * kstep;
            const int kt2 = t + 2;
            const char* b2 = last ? nB0 : (kt2 < half ? cB0 + (size_t)kt2 * kstep : cB1 + (size_t)(kt2 - half) * kstep);
            const char* a2 = last ? nAb : cAb + (size_t)kt2 * kstep;
            const char* a3 = a2 + kstep; const char* b3 = b2 + kstep;
            PG8_LDB(B0, 0, 0); PG8_LDB(B1, 0, 1); PG8_SCHED; PG8_LDA(At, 0, 0); PG8_STAGE_A(PG8_SA(1, 1), a1, aoc[1][0], aoc[1][1]);
            if (last && has_next) X.reload_offsets(nxt, RA, CA, rows, wid, lane, aoc);
            PG8_WAIT_V(8); PG8_WAIT_L(0); PG8_BAR; PG8_MMA(0, 0, At, B0); PG8_MMA(0, 1, At, B1); PG8_BAR; PG8_SCHED;
            PG8_LDA(At, 0, 1); PG8_STAGE_B(PG8_SB(0, 0), b2); PG8_STAGE_B(PG8_SB(0, 1), b2 + hstepB); PG8_STAGE_A(PG8_SA(0, 0), a2, aoc[0][0], aoc[0][1]);
            PG8_WAIT_V(8); PG8_WAIT_L(0); PG8_BAR; PG8_MMA(1, 0, At, B0); PG8_MMA(1, 1, At, B1); PG8_BAR; PG8_SCHED;
            PG8_LDB(B0, 1, 0); PG8_LDB(B1, 1, 1); PG8_SCHED; PG8_LDA(At, 1, 0); PG8_STAGE_A(PG8_SA(0, 1), a2, aoc[1][0], aoc[1][1]);
            PG8_WAIT_V(8); PG8_WAIT_L(0); PG8_BAR; PG8_MMA(0, 0, At, B0); PG8_MMA(0, 1, At, B1); PG8_BAR; PG8_SCHED;
            PG8_LDA(At, 1, 1); PG8_STAGE_B(PG8_SB(1, 0), b3); PG8_STAGE_B(PG8_SB(1, 1), b3 + hstepB); PG8_STAGE_A(PG8_SA(1, 0), a3, aoc[0][0], aoc[0][1]);
            PG8_WAIT_V(8); PG8_WAIT_L(0); PG8_BAR; PG8_MMA(1, 0, At, B0); PG8_MMA(1, 1, At, B1); PG8_BAR; PG8_SCHED;
        }
        if (wr == 0) PG8_BAR;
        E(acc, cur, wr, wc, fr, fq);
        if (!has_next) break;
#pragma unroll
        for (int a = 0; a < 2; ++a)
#pragma unroll
            for (int b = 0; b < 2; ++b)
#pragma unroll
                for (int m = 0; m < 4; ++m)
#pragma unroll
                    for (int n = 0; n < 2; ++n) acc[a][b][m][n] = (f32x4){0.f, 0.f, 0.f, 0.f};
        cur = nxt; cAb = nAb; cB0 = nB0; cB1 = nB1; ++ui;
        if (wr == 1) PG8_BAR;
    }
    PG8_WAIT_V(0);
    PG8_BAR;
#undef PG8_SA
#undef PG8_SB
#undef PG8_STAGE_A
#undef PG8_STAGE_B
#undef PG8_LDA
#undef PG8_LDB
#undef PG8_MMA
#undef PG8_WAIT_V
#undef PG8_WAIT_L
#undef PG8_BAR
#undef PG8_SCHED
}
}

constexpr int TT_OFF = 132096;
constexpr int ROWS_OFF = 134144;

#define XB_TMO      128
#define XB_XCNT(j)  (256  + 64 * (j))
#define XB_XSUB(j)  (1280 + 64 * (j))
#define XB_XGEN(j)  (2304 + 64 * (j))
#define XB_TOP      3328
#define XB_TOPGEN   3392
#define XCD_BAR_WORDS 3456
#define XB_SPIN_CAP (1u << 18)

__device__ __forceinline__ unsigned xb_ld(unsigned* p)              { return __hip_atomic_load(p, __ATOMIC_RELAXED, __HIP_MEMORY_SCOPE_AGENT); }
__device__ __forceinline__ unsigned xb_add(unsigned* p, unsigned v) { return __hip_atomic_fetch_add(p, v, __ATOMIC_RELAXED, __HIP_MEMORY_SCOPE_AGENT); }
__device__ __forceinline__ unsigned xb_xcc_id() { return (unsigned)__builtin_amdgcn_s_getreg((3 << 11) | 20) & 0xFu; }
#define XB_SPIN(cond, bar) do { unsigned _sp = 0; while (cond) { __builtin_amdgcn_s_sleep(1); \
    if ((++_sp & 255u) == 0u) { if (xb_ld(&(bar)[XB_TMO])) break; if (_sp > XB_SPIN_CAP) { atomicAdd(&(bar)[XB_TMO], 1u); break; } } } } while (0)

struct XcdBarrier {
    unsigned* bar; unsigned x;
    volatile LAS unsigned* st;
};

__device__ __forceinline__ XcdBarrier xcd_barrier_post(unsigned* bar, volatile LAS unsigned* st) {
    XcdBarrier b; b.bar = bar; b.x = xb_xcc_id(); b.st = st;
    if (threadIdx.x == 0) (void)xb_add(&bar[XB_XCNT(b.x)], 1u);
    return b;
}
__device__ __forceinline__ void xcd_barrier_complete(unsigned* bar, unsigned x, unsigned& nloc, unsigned& nx) {
    const unsigned G = gridDim.x * gridDim.y * gridDim.z;
    unsigned sum, cnt, mine, sp = 0u;
    for (;;) {
        sum = 0u; cnt = 0u; mine = 0u;
#pragma unroll
        for (unsigned j = 0; j < 16; ++j) { const unsigned c = xb_ld(&bar[XB_XCNT(j)]); sum += c; cnt += (c > 0u) ? 1u : 0u; mine = (j == x) ? c : mine; }
        if (sum == G) break;
        __builtin_amdgcn_s_sleep(1);
        if ((++sp & 255u) == 0u) { if (xb_ld(&bar[XB_TMO])) break; if (sp > XB_SPIN_CAP) { atomicAdd(&bar[XB_TMO], 1u); break; } }
    }
    nloc = mine > 0u ? mine : 1u; nx = cnt > 0u ? cnt : 1u;
}

__device__ __forceinline__ void xcd_barrier(const XcdBarrier& b) {
    asm volatile("s_waitcnt vmcnt(0)" ::: "memory");
    __syncthreads();
    if (threadIdx.x == 0) {
        unsigned* bar = b.bar;
        __builtin_amdgcn_s_waitcnt(0);
        unsigned nloc = b.st[0], nx = b.st[1];
        if (nloc == 0u) { xcd_barrier_complete(bar, b.x, nloc, nx); b.st[0] = nloc; b.st[1] = nx; }
        const unsigned old = xb_add(&bar[XB_XSUB(b.x)], 1u);
        const unsigned gen = old / nloc;
        if (old + 1u == (gen + 1u) * nloc) {
            __builtin_amdgcn_fence(__ATOMIC_RELEASE, "agent");
            asm volatile("s_waitcnt vmcnt(0)" ::: "memory");
            const unsigned og = xb_add(&bar[XB_TOP], 1u);
            const unsigned tg = og / nx;
            if (og + 1u == (tg + 1u) * nx) xb_add(&bar[XB_TOPGEN], 1u);
            else XB_SPIN(xb_ld(&bar[XB_TOPGEN]) == tg, bar);
            __builtin_amdgcn_fence(__ATOMIC_ACQUIRE, "agent");
            xb_add(&bar[XB_XGEN(b.x)], 1u);
            asm volatile("s_waitcnt vmcnt(0)" ::: "memory");
        } else {
            XB_SPIN(xb_ld(&bar[XB_XGEN(b.x)]) == gen, bar);
            __builtin_amdgcn_fence(__ATOMIC_ACQUIRE, "agent");
            asm volatile("s_waitcnt vmcnt(0)" ::: "memory");
        }
    }
    __syncthreads();
}

constexpr int LDS_BYTES = 147456;
constexpr int LDSCTL_OFF = 131072, MISC_OFF = LDSCTL_OFF + 320;
constexpr int CW_BAR = 4096;
constexpr int NPHASE = 1 + 9 * DEPTH;
#ifndef MK_SPLIT
#define MK_SPLIT 0
#endif
struct Args {
    const float *x, *c, *ctx, *c_ctx, *w_mod, *b_mod, *norm1_g, *norm2_g, *w_in, *w_out, *hgrn_lb, *hgrn_norm_g, *pool_w, *pool_scale, *q_norm_g, *k_norm_g, *router_w, *router_b, *moe_gate, *moe_up, *moe_down;
    float* out; unsigned char* ws; int ph_lo, ph_hi;
};
typedef const __attribute__((address_space(4))) Args* KArgs;
__device__ __forceinline__ KArgs kargs() { KArgs p = (KArgs)__builtin_amdgcn_kernarg_segment_ptr(); asm volatile("" : "+s"(p)); return p; }
__global__ void __launch_bounds__(512, 2) mega_fwd(Args A_unused) {
    extern __shared__ __attribute__((aligned(16))) unsigned char lds[];
    for (int u = otid(); u < (LDS_BYTES - LDSCTL_OFF) / 4; u += 512) ((LAS unsigned*)((LAS unsigned char*)lds + LDSCTL_OFF))[u] = 0u;
    __syncthreads();
    XcdBarrier bar;
    { KArgs ap = kargs(); unsigned* CTL = (unsigned*)(ap->ws + WS_CTL); bar.bar = CTL + CW_BAR; bar.x = 0; bar.st = nullptr;
      if (!MK_SPLIT) bar = xcd_barrier_post(CTL + CW_BAR, (volatile LAS unsigned*)((LAS unsigned char*)lds + MISC_OFF) + 8); }
    int lo, hi; { KArgs ap = kargs(); lo = ap->ph_lo; hi = ap->ph_hi; }
#ifndef PHMASK
#define PHMASK 0x3ff
#endif
#define IN(k) (lo <= (k) && (k) < hi)
#define SEAM(k) do { if (!MK_SPLIT && IN((k) + 1)) xcd_barrier(bar); } while (0)
#define GCU const int G = (int)gridDim.x, cu = (int)blockIdx.x
#ifndef DUPMASK
#define DUPMASK 0
#endif
    LAS unsigned char* ldsl = (LAS unsigned char*)lds;
    if ((PHMASK & 0x200) && IN(0)) {
        _Pragma("unroll") for (int rep_ = 0; rep_ < ((((DUPMASK) & (0x200)) && true) ? 2 : 1); ++rep_) {
        KArgs ap = kargs(); unsigned char* ws = ap->ws; GCU;
        ProArgs pa; pa.c = ap->c; pa.c_ctx = ap->c_ctx; pa.w_mod = ap->w_mod; pa.b_mod = ap->b_mod; pa.hgrn_lb = ap->hgrn_lb; pa.qg = ap->q_norm_g; pa.kg = ap->k_norm_g; pa.w_in = ap->w_in; pa.w_out = ap->w_out; pa.pool_w = ap->pool_w;
        pa.gate = ap->moe_gate; pa.up = ap->moe_up; pa.down = ap->moe_down; pa.MODV = (float*)(ws + WS_MODV); pa.LBF = (float*)(ws + WS_LBF); pa.REF = (float*)(ws + WS_REF); pa.COS = (float*)(ws + WS_COS); pa.SIN = (float*)(ws + WS_SIN);
        pa.WIN = (bf16_t*)(ws + WS_WIN); pa.WOUT = (bf16_t*)(ws + WS_WOUT); pa.POOLWT = (bf16_t*)(ws + WS_POOLWT); pa.WGU = (bf16_t*)(ws + WS_WGU); pa.WD = (bf16_t*)(ws + WS_WD);
        prologue_phase(lds, pa, cu, G);
            if (rep_ + 1 < ((((DUPMASK) & (0x200)) && true) ? 2 : 1)) xcd_barrier(bar); }
        SEAM(0);
    }
    for (int l = 0; l < DEPTH; ++l) {
        const int pb = 1 + 9 * l;
        if ((PHMASK & 1) && IN(pb + 0)) {
        _Pragma("unroll") for (int rep_ = 0; rep_ < ((((DUPMASK) & (1)) && true) ? 2 : 1); ++rep_) {
            KArgs ap = kargs(); unsigned char* ws = ap->ws; GCU;
            const float* slat = (l == 0) ? ap->x : ap->out; const float* sctx = (l == 0) ? ap->ctx : (const float*)(ws + WS_XC);
            norm1_phase(cu, G, slat, sctx, ap->norm1_g + l * D, (const float*)(ws + WS_MODV) + (size_t)l * 3 * 6144, 0, (bf16_t*)(ws + WS_XN));
            if (rep_ + 1 < ((((DUPMASK) & (1)) && true) ? 2 : 1)) xcd_barrier(bar); }
            SEAM(pb + 0);
        }
        if ((PHMASK & 2) && IN(pb + 1)) {
        _Pragma("unroll") for (int rep_ = 0; rep_ < ((((DUPMASK) & (2)) && true) ? 2 : 1); ++rep_) {
            KArgs ap = kargs(); unsigned char* ws = ap->ws; GCU;
            pg8::Gemm g; g.A = (const bf16_t*)(ws + WS_XN); g.Bt = (const bf16_t*)(ws + WS_WIN) + (size_t)l * NIN * D; g.M = MT; g.N = NIN; g.K = D; g.pad = 0;
            pg8::StaticOrder S; S.init(MT, NIN, G, cu);
            pg8::EpiBf16<0> E; E.O = (bf16_t*)(ws + WS_PROJ); E.ldc = NIN; E.bias = nullptr; E.split_cols = 0; E.split_stride = 0; E.scale0 = 1.f;
            pg8::gemm_phase<pg8::EpiBf16<0>, pg8::StaticOrder, true, true>(ldsl, g, S, E);
            { KArgs aq = kargs(); if (l == 0) moe_filler(lds, aq->moe_gate, aq->moe_up, aq->moe_down, aq->ws, 0, 0, 5530, (MT / 256) * (NIN / 256), G, cu);
              else moe_filler(lds, aq->moe_gate, aq->moe_up, aq->moe_down, aq->ws, 1, 7986, MOE_ITEMS, (MT / 256) * (NIN / 256), G, cu); }
            if (rep_ + 1 < ((((DUPMASK) & (2)) && true) ? 2 : 1)) xcd_barrier(bar); }
            SEAM(pb + 1);
        }
        if ((PHMASK & 4) && IN(pb + 2)) {
        _Pragma("unroll") for (int rep_ = 0; rep_ < ((((DUPMASK) & (4)) && true) ? 2 : 1); ++rep_) {
            KArgs ap = kargs(); unsigned char* ws = ap->ws; GCU;
            const bf16_t* PROJ = (const bf16_t*)(ws + WS_PROJ);
            post_phase(cu, G, PROJ, ap->q_norm_g + l * 64, ap->k_norm_g + l * 64, (const float*)(ws + WS_COS), (const float*)(ws + WS_SIN), ws + WS_Q8, ws + WS_K8, ws + WS_VT8);
            pool::pool_phase(lds, PROJ, (const bf16_t*)(ws + WS_POOLWT) + (size_t)l * 4 * 4096, ap->pool_scale + l * 256, (bf16_t*)(ws + WS_MIX), cu, G);
            hg::h1_phase(lds, PROJ, (const float*)(ws + WS_LBF) + l * 512, (bf16_t*)(ws + WS_UT), (float*)(ws + WS_DEC), cu, G);
            if (rep_ + 1 < ((((DUPMASK) & (4)) && true) ? 2 : 1)) xcd_barrier(bar); }
            SEAM(pb + 2);
        }
        if ((PHMASK & 8) && IN(pb + 3)) {
        _Pragma("unroll") for (int rep_ = 0; rep_ < ((((DUPMASK) & (8)) && true) ? 2 : 1); ++rep_) {
            KArgs ap = kargs(); unsigned char* ws = ap->ws; GCU; hg::h2_phase(lds, (const bf16_t*)(ws + WS_UT), (const float*)(ws + WS_DEC), (bf16_t*)(ws + WS_ST), cu, G);
            if (rep_ + 1 < ((((DUPMASK) & (8)) && true) ? 2 : 1)) xcd_barrier(bar); }
            SEAM(pb + 3);
        }
        if ((PHMASK & 16) && IN(pb + 4)) {
        _Pragma("unroll") for (int rep_ = 0; rep_ < ((((DUPMASK) & (16)) && true) ? 2 : 1); ++rep_) {
            { KArgs ap = kargs(); unsigned char* ws = ap->ws; GCU;
              attn_phase((char*)lds, ws + WS_Q8, ws + WS_K8, ws + WS_VT8, (bf16_t*)(ws + WS_MIX), ((const float*)(ws + WS_REF))[l * 64], vcu_of(cu, G), G, true); }
            { KArgs ap = kargs(); unsigned char* ws = ap->ws; GCU;
              hg::h3_phase(lds, (const bf16_t*)(ws + WS_PROJ), (const float*)(ws + WS_LBF) + l * 512, (const bf16_t*)(ws + WS_ST), ap->hgrn_norm_g + l * 64, (bf16_t*)(ws + WS_MIX), cu, G); }
            if (rep_ + 1 < ((((DUPMASK) & (16)) && true) ? 2 : 1)) xcd_barrier(bar); }
            SEAM(pb + 4);
        }
        if ((PHMASK & 32) && IN(pb + 5)) {
        _Pragma("unroll") for (int rep_ = 0; rep_ < ((((DUPMASK) & (32)) && (l == 0)) ? 2 : 1); ++rep_) {
            KArgs ap = kargs(); unsigned char* ws = ap->ws; GCU;
            pg8::Gemm g; g.A = (const bf16_t*)(ws + WS_MIX); g.Bt = (const bf16_t*)(ws + WS_WOUT) + (size_t)l * D * D; g.M = MT; g.N = D; g.K = D; g.pad = 0;
            pg8::OutOrder S; S.lat_only = (l == DEPTH - 1); S.init(S.lat_only ? BATCH * SEQ : MT, D, G, cu);
            pg8::EpiResid E; E.src_lat = (l == 0) ? ap->x : ap->out; E.src_ctx = (l == 0) ? ap->ctx : (const float*)(ws + WS_XC); E.dst_lat = ap->out; E.dst_ctx = (float*)(ws + WS_XC);
            E.modv = (const float*)(ws + WS_MODV) + (size_t)l * 3 * 6144; E.ga_off = 2048; E.pad = 0;
            pg8::gemm_phase<pg8::EpiResid, pg8::OutOrder, true, true>(ldsl, g, S, E);
            if (l == 0) { KArgs aq = kargs(); moe_filler(lds, aq->moe_gate, aq->moe_up, aq->moe_down, aq->ws, 0, 5530, MOE_ITEMS, (MT / 256) * (D / 256), G, cu); }
            if (rep_ + 1 < ((((DUPMASK) & (32)) && (l == 0)) ? 2 : 1)) xcd_barrier(bar); }
            SEAM(pb + 5);
        }
        if ((PHMASK & 64) && IN(pb + 6)) {
        _Pragma("unroll") for (int rep_ = 0; rep_ < ((((DUPMASK) & (64)) && true) ? 2 : 1); ++rep_) {
            KArgs ap = kargs(); unsigned char* ws = ap->ws; GCU;
            norm2_router_phase(lds, cu, G, ap->out, (const float*)(ws + WS_XC), ap->norm2_g + l * D, (const float*)(ws + WS_MODV) + (size_t)l * 3 * 6144, 3072, ap->router_w, ap->router_b, (bf16_t*)(ws + WS_XN),
                               (unsigned*)(ws + WS_CTL) + CW_CNT + 64 * l + 32 * rep_, (u32x4*)(ws + WS_LIST), l == 0 ? 1 : 0);
            if (rep_ + 1 < ((((DUPMASK) & (64)) && true) ? 2 : 1)) xcd_barrier(bar); }
            SEAM(pb + 6);
        }
        if ((PHMASK & 128) && IN(pb + 7)) {
        _Pragma("unroll") for (int rep_ = 0; rep_ < ((((DUPMASK) & (128)) && true) ? 2 : 1); ++rep_) {
            KArgs ap = kargs(); unsigned char* ws = ap->ws; GCU;
            LAS int* TT = (LAS int*)(ldsl + TT_OFF);
            pg8::build_tiles(TT, (const unsigned*)(ws + WS_CTL) + CW_CNT + 64 * l);
            pg8::MoeOrder<8> S; S.TT = TT; S.G = G; S.c = vcu_of(cu, G);
            pg8::Src1 X; X.XN = (const bf16_t*)(ws + WS_XN); X.WGU = (const bf16_t*)(ws + (l ? WS_WGU1 : WS_WGU)); X.LIST = (const u32x4*)(ws + WS_LIST); pg8::EpiGateUp2 E; E.ACT2 = (bf16_t*)(ws + WS_ACT2); E.LIST = X.LIST;
            pg8::gemm_phase_x(ldsl, ldsl + ROWS_OFF, S, X, E, D, D / 64);
            if (l == 0) { KArgs aq = kargs(); const int U = TT[0] * 8; moe_filler(lds, aq->moe_gate, aq->moe_up, aq->moe_down, aq->ws, 1, 0, 3686, U, G, vcu_of(cu, G)); }
            if (rep_ + 1 < ((((DUPMASK) & (128)) && true) ? 2 : 1)) xcd_barrier(bar); }
            SEAM(pb + 7);
        }
        if ((PHMASK & 256) && IN(pb + 8)) {
        _Pragma("unroll") for (int rep_ = 0; rep_ < ((((DUPMASK) & (256)) && true) ? 2 : 1); ++rep_) {
            KArgs ap = kargs(); unsigned char* ws = ap->ws; GCU;
            LAS int* TT = (LAS int*)(ldsl + TT_OFF);
            pg8::build_tiles(TT, (const unsigned*)(ws + WS_CTL) + CW_CNT + 64 * l);
            pg8::MoeOrder<4> S; S.TT = TT; S.G = G; S.c = vcu_of(cu, G);
            pg8::Src2 X; X.ACT2 = (const bf16_t*)(ws + WS_ACT2); X.WD = (const bf16_t*)(ws + (l ? WS_WD1 : WS_WD));
            pg8::EpiMoeOut E; E.lat = ap->out; E.ctx = (float*)(ws + WS_XC); E.modv = (const float*)(ws + WS_MODV) + (size_t)l * 3 * 6144; E.LIST = (const u32x4*)(ws + WS_LIST);
            pg8::gemm_phase_x(ldsl, ldsl + ROWS_OFF, S, X, E, DE, 1024 / 64);
            if (l == 0) { KArgs aq = kargs(); const int U = TT[0] * 4; moe_filler(lds, aq->moe_gate, aq->moe_up, aq->moe_down, aq->ws, 1, 3686, 7986, U, G, vcu_of(cu, G)); }
            if (rep_ + 1 < ((((DUPMASK) & (256)) && true) ? 2 : 1)) xcd_barrier(bar); }
            SEAM(pb + 8);
        }
    }
#undef IN
#undef SEAM
#undef GCU
}

extern "C" void kernel_launch(void* const* d_in, const int* in_sizes, int n_in, void* d_out, int out_size, void* d_ws, size_t ws_size, hipStream_t stream) {
    static int grid = 0;
    if (grid == 0) {
        if (n_in != 21 || in_sizes[0] != BATCH * SEQ * D || out_size != BATCH * SEQ * D || ws_size < WS_END) {
            fprintf(stderr, "kernel_launch: unexpected sizes: n_in %d in0 %d out %d ws %zu (need %zu)\n", n_in, n_in > 0 ? in_sizes[0] : -1, out_size, ws_size, (size_t)WS_END); grid = -1; return; }
        int dev = 0, cus = 0, per_cu = 0;
        if (hipGetDevice(&dev) != hipSuccess || hipDeviceGetAttribute(&cus, hipDeviceAttributeMultiprocessorCount, dev) != hipSuccess) { grid = -1; return; }
        if (hipFuncSetAttribute((const void*)mega_fwd, hipFuncAttributeMaxDynamicSharedMemorySize, LDS_BYTES) != hipSuccess) { fprintf(stderr, "kernel_launch: hipFuncSetAttribute failed\n"); grid = -1; return; }
        if (hipOccupancyMaxActiveBlocksPerMultiprocessor(&per_cu, (const void*)mega_fwd, 512, LDS_BYTES) != hipSuccess || per_cu < 1) fprintf(stderr, "kernel_launch: occupancy query reports %d\n", per_cu);
        (void)hipGetLastError();
        grid = cus;
    }
    if (grid < 0) return;
    if (hipMemsetAsync((char*)d_ws + WS_CTL, 0, 1 * MiB, stream) != hipSuccess) return;
    Args a; memset((void*)&a, 0, sizeof(a));
    a.x = (const float*)d_in[0]; a.c = (const float*)d_in[1]; a.ctx = (const float*)d_in[2]; a.c_ctx = (const float*)d_in[3]; a.w_mod = (const float*)d_in[4]; a.b_mod = (const float*)d_in[5];
    a.norm1_g = (const float*)d_in[6]; a.norm2_g = (const float*)d_in[7]; a.w_in = (const float*)d_in[8]; a.w_out = (const float*)d_in[9]; a.hgrn_lb = (const float*)d_in[10]; a.hgrn_norm_g = (const float*)d_in[11];
    a.pool_w = (const float*)d_in[12]; a.pool_scale = (const float*)d_in[13]; a.q_norm_g = (const float*)d_in[14]; a.k_norm_g = (const float*)d_in[15]; a.router_w = (const float*)d_in[16]; a.router_b = (const float*)d_in[17];
    a.moe_gate = (const float*)d_in[18]; a.moe_up = (const float*)d_in[19]; a.moe_down = (const float*)d_in[20];
    a.out = (float*)d_out; a.ws = (unsigned char*)d_ws;
#if MK_SPLIT
    for (int ph = 0; ph < NPHASE; ++ph) { a.ph_lo = ph; a.ph_hi = ph + 1; hipLaunchKernelGGL(mega_fwd, dim3(grid), dim3(512), LDS_BYTES, stream, a); }
#else
    a.ph_lo = 0; a.ph_hi = NPHASE; hipLaunchKernelGGL(mega_fwd, dim3(grid), dim3(512), LDS_BYTES, stream, a);
#endif
}
```

```cpp
#include <hip/hip_runtime.h>
#include <cstdio>
#include <cstdint>
#include <cstring>

namespace cfg {
constexpr int D = 1024, BATCH = 2, SEQ = 8192, CTXL = 256, DEPTH = 2;
constexpr int PB = SEQ + CTXL;
constexpr int MT = BATCH * PB;
constexpr int TPB = PB / 256;
constexpr int NIN = 2304;
constexpr int NE = 16, DE = 512;
constexpr int C_AQ = 0, C_AFF = 256, C_AFB = 512, C_AI = 768, C_AG = 1024, C_BP = 1280, C_CQ = 1536, C_CK = 2048, C_CV = 2176;
constexpr float EPS = 1e-6f;
constexpr float C2 = 0.125f * 1.4426950408889634f;
}

__device__ __forceinline__ int otid() { int t = threadIdx.x; asm volatile("" : "+v"(t)); return t; }

namespace pg8 {
#define PG8_LAS __attribute__((address_space(3)))
typedef unsigned short bf16_t;
typedef short bf16x8 __attribute__((ext_vector_type(8)));
typedef float f32x4 __attribute__((ext_vector_type(4)));
typedef unsigned u32x4 __attribute__((ext_vector_type(4)));
constexpr int BM = 256, BK = 64, HALF = 128, HTB = HALF * BK * 2  , STAGE_BYTES = 8 * HTB, NXCD = 8, WGM = 8;

__host__ __device__ __forceinline__ int lds_byte(int r, int c) { const int st = (r >> 4) * 2 + (c >> 5), rr = r & 15, cc = c & 31, ob = rr * 64 + cc * 2; return st * 1024 + (ob ^ (((ob >> 9) & 1) << 5)); }
__host__ __device__ __forceinline__ void stage_rc(int b, int& R, int& C) { const int st = b / 1024, sb = b % 1024, swz = sb ^ (((sb >> 9) & 1) << 5); R = (st >> 1) * 16 + swz / 64; C = (st & 1) * 32 + (swz % 64) / 2; }
__host__ __device__ __forceinline__ int perm32(int rho) { const int n = rho >> 4, i = rho & 15; return 8 * (i >> 2) + 4 * n + (i & 3); }

struct Unit { int pm, pn; };
struct Gemm { const bf16_t* A; const bf16_t* Bt; int M, N, K, pad; };

struct StaticOrder {
    int nM, nN, nwg, G, c;
    __host__ __device__ void init(int M, int N, int G_, int c_) { nM = M / BM; nN = N / BM; nwg = nM * nN; G = G_; c = c_; }
    __host__ __device__ bool next(int i, Unit& u) const {
        const long L = (long)i * G + c; if (L >= nwg) return false;
        int wgid = (int)L; { const int q = nwg / NXCD, r = nwg % NXCD, xcd = wgid % NXCD, off = wgid / NXCD; wgid = (xcd < r ? xcd * (q + 1) : r * (q + 1) + (xcd - r) * q) + off; }
        const int nig = WGM * nN, gid = wgid / nig, fm = gid * WGM, gsz = (nM - fm) < WGM ? (nM - fm) : WGM;
        u.pm = fm + ((wgid % nig) % gsz); u.pn = (wgid % nig) / gsz; return true;
    }
    __device__ __forceinline__ void a_ready(const Unit&) const {}
    __device__ __forceinline__ void done(const Unit&) const {}
};

__device__ __forceinline__ unsigned cvt_pk_bf16(float lo, float hi) { unsigned r; asm volatile("v_cvt_pk_bf16_f32 %0, %1, %2" : "=v"(r) : "v"(lo), "v"(hi)); return r; }
typedef float f32x2 __attribute__((ext_vector_type(2)));
__device__ __forceinline__ f32x2 gelu_pk(f32x2 v) {
    const f32x2 av = __builtin_elementwise_abs(v), d = av * 0.2316418882f + 1.0f;
    f32x2 t; t.x = __builtin_amdgcn_rcpf(d.x); t.y = __builtin_amdgcn_rcpf(d.y);
    f32x2 q = t * 0.5307027145f + (-0.7265760135f); q = q * t + 0.7107068705f; q = q * t + (-0.142248368f); q = q * t + 0.127414796f; q = q * t;
    const f32x2 s = (v * v) * (-0.72134752044f);
    f32x2 e; e.x = __builtin_amdgcn_exp2f(s.x); e.y = __builtin_amdgcn_exp2f(s.y);
    const f32x2 m = v * (q * e), r = v - m;
    f32x2 o; o.x = v.x < 0.f ? m.x : r.x; o.y = v.y < 0.f ? m.y : r.y; return o;
}

template <int ACT  > struct EpiBf16 {
    static constexpr bool PERM = true, AFTER_DRAIN = false; static_assert(ACT == 0 || ACT == 1, "EpiBf16: ACT is 0 (none) or 1 (gelu_pk)");
    bf16_t* O; int ldc; const float* bias; int split_cols; size_t split_stride; float scale0;
    __device__ __forceinline__ void operator()(const f32x4 (&acc)[2][2][4][2], const Unit& u, int wr, int wc, int fr, int fq) const {
        asm volatile("" : "+v"(fr), "+v"(fq));
        const int row0 = u.pm * BM + wr * 64 + fr; int colt = u.pn * BM; bf16_t* base = O;
        float sc = 1.f; if (split_cols) { const int t = colt / split_cols; base += (size_t)t * split_stride; colt -= t * split_cols; if (t == 0) sc = scale0; }
        const int col0 = colt + wc * 32 + 8 * fq, bcol0 = u.pn * BM + wc * 32 + 8 * fq;
        f32x4 bv[2][2];
#pragma unroll
        for (int bj = 0; bj < 2; ++bj)
#pragma unroll
            for (int n = 0; n < 2; ++n) bv[bj][n] = bias ? *(const f32x4*)(bias + bcol0 + bj * HALF + 4 * n) : (f32x4){0.f, 0.f, 0.f, 0.f};
#pragma unroll
        for (int ai = 0; ai < 2; ++ai)
#pragma unroll
            for (int m = 0; m < 4; ++m) { bf16_t* rowp = base + (size_t)(row0 + ai * HALF + m * 16) * ldc + col0;
#pragma unroll
                for (int bj = 0; bj < 2; ++bj) { f32x4 v0 = acc[ai][bj][m][0] + bv[bj][0], v1 = acc[ai][bj][m][1] + bv[bj][1];
                    if (ACT == 1) { f32x2 a = gelu_pk((f32x2){v0[0], v0[1]}), b = gelu_pk((f32x2){v0[2], v0[3]}), c = gelu_pk((f32x2){v1[0], v1[1]}), d = gelu_pk((f32x2){v1[2], v1[3]});
                        v0 = (f32x4){a.x, a.y, b.x, b.y}; v1 = (f32x4){c.x, c.y, d.x, d.y}; }
                    v0 = v0 * sc; v1 = v1 * sc; u32x4 w; w.x = cvt_pk_bf16(v0[0], v0[1]); w.y = cvt_pk_bf16(v0[2], v0[3]); w.z = cvt_pk_bf16(v1[0], v1[1]); w.w = cvt_pk_bf16(v1[2], v1[3]);
                    *(u32x4*)(rowp + bj * HALF) = w; } }
    }
};

template <class Epi, class Sched, bool ALIGN_EPI = false, bool SP2 = false>
__device__ __forceinline__ void gemm_phase(PG8_LAS unsigned char* lds, const Gemm g, const Sched& S, const Epi& E) {
    const int tid = otid(), wid = __builtin_amdgcn_readfirstlane(tid >> 6), lane = tid & 63, wr = wid >> 2, wc = wid & 3, fr = lane & 15, fq = lane >> 4;
    const int K = g.K, nt = K / BK;
    unsigned voffA[2], voffB[2];
#pragma unroll
    for (int i = 0; i < 2; ++i) { int R, C; stage_rc(tid * 16 + i * 8192, R, C); const int Rb = Epi::PERM ? ((R & ~31) + perm32(R & 31)) : R;
        voffA[i] = (unsigned)(R * K + C) * 2u; voffB[i] = (unsigned)(Rb * K + C) * 2u; }
    const size_t kstep = (size_t)(BK * 2);
    const size_t hstep = (size_t)HALF * K * 2;
    const size_t tstep = 2 * hstep;
    const unsigned ldsw = (unsigned)wid * 1024u;
    const int aoff = lds_byte(wr * 64 + fr, fq * 8), boff = lds_byte(wc * 32 + fr, fq * 8);
#define PG8_SA(b, h) (((b) * 2 + (h)) * HTB)
#define PG8_SB(b, h) ((4 + (b) * 2 + (h)) * HTB)
#define PG8_STAGE(bufoff, gbase, voff) do { _Pragma("unroll") for (int _i = 0; _i < 2; ++_i) \
        __builtin_amdgcn_global_load_lds((const unsigned*)((const char*)(gbase) + (voff)[_i]), (PG8_LAS unsigned*)(lds + (bufoff) + ldsw + _i * 8192), 16, 0, 0); } while (0)
#define PG8_LDA(dst, b, h) do { _Pragma("unroll") for (int m = 0; m < 4; ++m) _Pragma("unroll") for (int k = 0; k < 2; ++k) dst[m][k] = *(const PG8_LAS bf16x8*)(lds + PG8_SA(b, h) + aoff + m * 2048 + k * 1024); } while (0)
#define PG8_LDB(dst, b, h) do { _Pragma("unroll") for (int n = 0; n < 2; ++n) _Pragma("unroll") for (int k = 0; k < 2; ++k) dst[n][k] = *(const PG8_LAS bf16x8*)(lds + PG8_SB(b, h) + boff + n * 2048 + k * 1024); } while (0)
#define PG8_MMA(ai, bj, At, Bt) do { __builtin_amdgcn_s_setprio(1); _Pragma("unroll") for (int m = 0; m < 4; ++m) _Pragma("unroll") for (int n = 0; n < 2; ++n) _Pragma("unroll") for (int k = 0; k < 2; ++k) \
        acc[ai][bj][m][n] = __builtin_amdgcn_mfma_f32_16x16x32_bf16(Bt[n][k], At[m][k], acc[ai][bj][m][n], 0, 0, 0); __builtin_amdgcn_s_setprio(0); } while (0)
#define PG8_WAIT_V(n) asm volatile("s_waitcnt vmcnt(" #n ")" ::: "memory")
#define PG8_WAIT_L(n) asm volatile("s_waitcnt lgkmcnt(" #n ")" ::: "memory")
#define PG8_BAR __builtin_amdgcn_s_barrier()
#define PG8_SCHED __builtin_amdgcn_sched_barrier(0)
    Unit cur, nxt; int ui = 0;
    if (!S.next(0, cur)) return;
    f32x4 acc[2][2][4][2];
#pragma unroll
    for (int a = 0; a < 2; ++a)
#pragma unroll
        for (int b = 0; b < 2; ++b)
#pragma unroll
            for (int m = 0; m < 4; ++m)
#pragma unroll
                for (int n = 0; n < 2; ++n) acc[a][b][m][n] = (f32x4){0.f, 0.f, 0.f, 0.f};
    bf16x8 At[4][2], B0[2][2], B1[2][2];
    const char* cA = (const char*)g.A + (size_t)cur.pm * tstep; const char* cB = (const char*)g.Bt + (size_t)cur.pn * tstep;
    S.a_ready(cur);
    if constexpr (SP2) {
        PG8_STAGE(PG8_SB(0, 0), cB, voffB); PG8_STAGE(PG8_SB(0, 1), cB + hstep, voffB); PG8_STAGE(PG8_SA(0, 0), cA, voffA); PG8_STAGE(PG8_SA(0, 1), cA + hstep, voffA);
        if (wr == 1) PG8_BAR;
        PG8_WAIT_V(2); PG8_BAR;
        PG8_STAGE(PG8_SB(1, 0), cB + kstep, voffB); PG8_STAGE(PG8_SA(1, 0), cA + kstep, voffA); PG8_STAGE(PG8_SB(1, 1), cB + hstep + kstep, voffB);
        PG8_WAIT_V(6); PG8_BAR;
    } else {
        PG8_STAGE(PG8_SB(0, 0), cB, voffB); PG8_STAGE(PG8_SA(0, 0), cA, voffA); PG8_STAGE(PG8_SB(0, 1), cB + hstep, voffB); PG8_STAGE(PG8_SA(0, 1), cA + hstep, voffA);
        if (wr == 1) PG8_BAR;
        PG8_WAIT_V(4); PG8_BAR;
        PG8_STAGE(PG8_SB(1, 0), cB + kstep, voffB); PG8_STAGE(PG8_SA(1, 0), cA + kstep, voffA); PG8_STAGE(PG8_SB(1, 1), cB + hstep + kstep, voffB);
        PG8_WAIT_V(6); PG8_BAR;
    }
    for (;;) {
        const bool has_next = S.next(ui + 1, nxt);
        const char* nA = has_next ? (const char*)g.A + (size_t)nxt.pm * tstep : cA; const char* nB = has_next ? (const char*)g.Bt + (size_t)nxt.pn * tstep : cB;
        for (int t = 0; t < nt; t += 2) {
            const bool last = (t == nt - 2);
            const char* a1 = cA + (size_t)(t + 1) * kstep;
            const char* a2 = last ? nA : cA + (size_t)(t + 2) * kstep; const char* b2 = last ? nB : cB + (size_t)(t + 2) * kstep;
            const char* a3 = a2 + kstep; const char* b3 = b2 + kstep;
            if (last && has_next) S.a_ready(nxt);
            if constexpr (SP2) {
            PG8_LDB(B0, 0, 0); PG8_LDB(B1, 0, 1); PG8_SCHED; PG8_LDA(At, 0, 0); PG8_STAGE(PG8_SA(1, 1), a1 + hstep, voffA);
            PG8_WAIT_V(8); PG8_WAIT_L(0); PG8_BAR; PG8_MMA(0, 0, At, B0); PG8_MMA(0, 1, At, B1); PG8_BAR; PG8_SCHED;
            PG8_LDA(At, 0, 1); PG8_STAGE(PG8_SB(0, 0), b2, voffB); PG8_STAGE(PG8_SB(0, 1), b2 + hstep, voffB); PG8_STAGE(PG8_SA(0, 0), a2, voffA);
            PG8_WAIT_V(8); PG8_WAIT_L(0); PG8_BAR; PG8_MMA(1, 0, At, B0); PG8_MMA(1, 1, At, B1); PG8_BAR; PG8_SCHED;
            PG8_LDB(B0, 1, 0); PG8_LDB(B1, 1, 1); PG8_SCHED; PG8_LDA(At, 1, 0); PG8_STAGE(PG8_SA(0, 1), a2 + hstep, voffA);
            PG8_WAIT_V(8); PG8_WAIT_L(0); PG8_BAR; PG8_MMA(0, 0, At, B0); PG8_MMA(0, 1, At, B1); PG8_BAR; PG8_SCHED;
            PG8_LDA(At, 1, 1); PG8_STAGE(PG8_SB(1, 0), b3, voffB); PG8_STAGE(PG8_SB(1, 1), b3 + hstep, voffB); PG8_STAGE(PG8_SA(1, 0), a3, voffA);
            PG8_WAIT_V(8); PG8_WAIT_L(0); PG8_BAR; PG8_MMA(1, 0, At, B0); PG8_MMA(1, 1, At, B1); PG8_BAR; PG8_SCHED;
            } else {
            PG8_LDB(B0, 0, 0); PG8_SCHED; PG8_LDA(At, 0, 0); PG8_STAGE(PG8_SA(1, 1), a1 + hstep, voffA);
            PG8_WAIT_L(8); PG8_BAR; PG8_WAIT_L(0); PG8_MMA(0, 0, At, B0); PG8_BAR; PG8_SCHED;
            PG8_LDB(B1, 0, 1); PG8_STAGE(PG8_SB(0, 0), b2, voffB);
            PG8_BAR; PG8_WAIT_L(0); PG8_MMA(0, 1, At, B1); PG8_BAR;
            PG8_LDA(At, 0, 1); PG8_STAGE(PG8_SA(0, 0), a2, voffA);
            PG8_BAR; PG8_WAIT_L(0); PG8_MMA(1, 0, At, B0); PG8_BAR; PG8_SCHED;
            PG8_STAGE(PG8_SB(0, 1), b2 + hstep, voffB);
            PG8_WAIT_V(6); PG8_BAR; PG8_MMA(1, 1, At, B1); PG8_BAR;
            PG8_LDB(B0, 1, 0); PG8_SCHED; PG8_LDA(At, 1, 0); PG8_STAGE(PG8_SA(0, 1), a2 + hstep, voffA);
            PG8_WAIT_L(8); PG8_BAR; PG8_WAIT_L(0); PG8_MMA(0, 0, At, B0); PG8_BAR; PG8_SCHED;
            PG8_LDB(B1, 1, 1); PG8_STAGE(PG8_SB(1, 0), b3, voffB);
            PG8_BAR; PG8_WAIT_L(0); PG8_MMA(0, 1, At, B1); PG8_BAR;
            PG8_LDA(At, 1, 1); PG8_STAGE(PG8_SA(1, 0), a3, voffA);
            PG8_BAR; PG8_WAIT_L(0); PG8_MMA(1, 0, At, B0); PG8_BAR; PG8_SCHED;
            PG8_STAGE(PG8_SB(1, 1), b3 + hstep, voffB);
            PG8_WAIT_V(6); PG8_BAR; PG8_MMA(1, 1, At, B1); PG8_BAR;
            }
        }
        if constexpr (ALIGN_EPI) { if (wr == 0) PG8_BAR; }
        if constexpr (!Epi::AFTER_DRAIN) { E(acc, cur, wr, wc, fr, fq); S.done(cur); }
        if (!has_next) break;
#pragma unroll
        for (int a = 0; a < 2; ++a)
#pragma unroll
            for (int b = 0; b < 2; ++b)
#pragma unroll
                for (int m = 0; m < 4; ++m)
#pragma unroll
                    for (int n = 0; n < 2; ++n) acc[a][b][m][n] = (f32x4){0.f, 0.f, 0.f, 0.f};
        cur = nxt; cA = nA; cB = nB; ++ui;
        if constexpr (ALIGN_EPI) { if (wr == 1) PG8_BAR; }
    }
    PG8_WAIT_V(0);
    if constexpr (!ALIGN_EPI) { if (wr == 0) PG8_BAR; }
    PG8_BAR;
    if constexpr (Epi::AFTER_DRAIN) { E.fused(acc, cur, wr, wc, fr, fq, lds, wid, lane); S.done(cur); }
#undef PG8_SA
#undef PG8_SB
#undef PG8_STAGE
#undef PG8_LDA
#undef PG8_LDB
#undef PG8_MMA
#undef PG8_WAIT_V
#undef PG8_WAIT_L
#undef PG8_BAR
#undef PG8_SCHED
}
}

#include <hip/hip_bf16.h>
namespace attn8 {
using bf16 = __hip_bfloat16;
typedef int v8i __attribute__((ext_vector_type(8)));
typedef int v4i __attribute__((ext_vector_type(4)));
typedef float f32x16 __attribute__((ext_vector_type(16)));
typedef unsigned u32x4 __attribute__((ext_vector_type(4)));
constexpr int NSLOT = 8, SLOT = 4096, LDS_K = 0, LDS_V = NSLOT * SLOT, LDS_OST = 2 * NSLOT * SLOT, LDS_BYTES = LDS_OST + 8 * 4096;
constexpr int QP8 = 512, KP8 = 128, OP = 1024;
__device__ __forceinline__ int crow(int r, int hi) { return (r & 3) + 8 * (r >> 2) + 4 * hi; }
__device__ __forceinline__ void glds16(const void* gsrc, unsigned lds_dst) { unsigned keep;
    asm volatile("s_mov_b32 %0, m0\n\ts_mov_b32 m0, %2\n\ts_nop 0\n\tglobal_load_lds_dwordx4 %1, off\n\ts_mov_b32 m0, %0" : "=&s"(keep) : "v"(gsrc), "s"(lds_dst) : "memory"); }
typedef __attribute__((address_space(3))) const char* lds_cptr;
__device__ __forceinline__ v8i ld32(lds_cptr p0, lds_cptr p1) { const v4i a = *(const __attribute__((address_space(3))) v4i*)p0, b = *(const __attribute__((address_space(3))) v4i*)p1; return (v8i){a[0], a[1], a[2], a[3], b[0], b[1], b[2], b[3]}; }
#define A8_WAIT_BAR(N) asm volatile("s_waitcnt vmcnt(" #N ") lgkmcnt(0)\n\ts_barrier" ::: "memory")
#define A8_QK(kf) __builtin_amdgcn_mfma_scale_f32_32x32x64_f8f6f4(kf, qf, cinit, 0, 0, 0, 0, 0, 0)
#define A8_PV(vf, acc) __builtin_amdgcn_mfma_scale_f32_32x32x64_f8f6f4(pw, vf, acc, 1, 0, 0, 0, 0, 0)
__device__ __forceinline__ void attn_unit(const unsigned char* Qw0, const unsigned char* __restrict__ Kh, const unsigned char* __restrict__ Vh, bf16* Ow0, const int NT, const float neg_ref, char* shm) {
    const int tid = otid(), lane = tid & 63, r32 = lane & 31, hi = lane >> 5; const int wid = __builtin_amdgcn_readfirstlane(tid >> 6);
    const unsigned lds0 = (unsigned)(uintptr_t)shm;
    const bool kw = wid < 4;
    const unsigned char* dsrc = kw ? Kh + (long)lane * KP8 + wid * 16 : Vh + (wid - 4) * 1024 + lane * 16;
    const long dstep = kw ? 64 * KP8 : 4096;
    const unsigned ddst = lds0 + (kw ? LDS_K + wid * 1024 : LDS_V + (wid - 4) * 1024);
    const int dist = kw ? 6 : 5;
#define A8_DMA(tt) glds16(dsrc + (long)(tt) * dstep, (unsigned)__builtin_amdgcn_readfirstlane(ddst + (unsigned)(((tt) & 7) * SLOT)))
    const v8i qf = *(const v8i*)(Qw0 + (long)(wid * 32 + r32) * QP8 + hi * 32);
    asm volatile("" :: "v"(qf));
    A8_DMA(0); A8_DMA(1); A8_DMA(2); A8_DMA(3); if (4 < NT) A8_DMA(4); if (kw && 5 < NT) A8_DMA(5);
    const lds_cptr shm3 = (lds_cptr)shm;
    const lds_cptr kp = shm3 + LDS_K + (2 * hi * 64 + r32) * 16, vp = shm3 + LDS_V + (2 * hi * 64 + r32) * 16;
#define A8_RDK(slot) do { kf0 = ld32(kp + (slot), kp + (slot) + 1024); kf1 = ld32(kp + (slot) + 512, kp + (slot) + 512 + 1024); } while (0)
#define A8_RDV(slot) do { vf0 = ld32(vp + (slot), vp + (slot) + 1024); vf1 = ld32(vp + (slot) + 512, vp + (slot) + 512 + 1024); } while (0)
    f32x16 o0 = {}, o1 = {}, ls = {}, cinit;
#pragma unroll
    for (int r = 0; r < 16; ++r) cinit[r] = neg_ref;
    const v8i ones = {0x38383838, 0x38383838, 0x38383838, 0x38383838, 0x38383838, 0x38383838, 0x38383838, 0x38383838};
    asm volatile("s_waitcnt vmcnt(0) lgkmcnt(0)\n\ts_barrier" ::: "memory");
    v8i kf0, kf1, kg0, kg1, vf0, vf1, pw;
    f32x16 SA0, SA1, SB0, SB1;
    A8_RDK(0);
    SA0 = A8_QK(kf0); SA1 = A8_QK(kf1);
    A8_RDK(SLOT);
    if (dist < NT) A8_DMA(dist);
#pragma unroll
    for (int r = 0; r < 16; ++r) { SA0[r] = __builtin_amdgcn_exp2f(SA0[r]); SA1[r] = __builtin_amdgcn_exp2f(SA1[r]); }
    asm volatile("" : "+v"(SA0), "+v"(SA1));
    if (6 < NT) { A8_WAIT_BAR(4); } else { A8_WAIT_BAR(0); }
#define A8_PACKH(P, o) do { \
        _Pragma("unroll") for (int i = 0; i < 4; ++i) { int w_ = 0; w_ = __builtin_amdgcn_cvt_pk_bf8_f32(P[4 * i], P[4 * i + 1], w_, false); w_ = __builtin_amdgcn_cvt_pk_bf8_f32(P[4 * i + 2], P[4 * i + 3], w_, true); pw[(o) + i] = w_; } } while (0)
#define A8_PACK(P0, P1) do { A8_PACKH(P0, 0); A8_PACKH(P1, 4); } while (0)
#define A8_EXP(X, lo, hi_) do { _Pragma("unroll") for (int r = (lo); r < (hi_); ++r) X[r] = __builtin_amdgcn_exp2f(X[r]); } while (0)
#define A8_SB() __builtin_amdgcn_sched_barrier(0)
#define A8_STEP(N0, N1, P0, P1, t, KC0, KC1, KN0, KN1) do { \
        A8_SB(); \
        A8_RDV((((t) - 1) & 7) * SLOT); \
        A8_SB(); \
        N0 = A8_QK(KC0); A8_PACKH(P0, 0); A8_SB(); \
        N1 = A8_QK(KC1); A8_PACKH(P1, 4); asm volatile("" : "+v"(pw)); A8_SB(); \
        if ((t) + 1 < NT) { KN0 = ld32(kp + ((((t) + 1) & 7) * SLOT), kp + ((((t) + 1) & 7) * SLOT) + 1024); KN1 = ld32(kp + ((((t) + 1) & 7) * SLOT) + 512, kp + ((((t) + 1) & 7) * SLOT) + 512 + 1024); } \
        if ((t) + dist < NT) A8_DMA((t) + dist); \
        A8_SB(); \
        o0 = A8_PV(vf0, o0); A8_EXP(N0, 0, 11); A8_SB(); \
        o1 = A8_PV(vf1, o1); A8_EXP(N0, 11, 16); A8_EXP(N1, 0, 6); A8_SB(); \
        ls = A8_PV(ones, ls); A8_EXP(N1, 6, 16); asm volatile("" : "+v"(N0), "+v"(N1)); A8_SB(); \
        if ((t) + 6 < NT) { A8_WAIT_BAR(4); } else { A8_WAIT_BAR(0); } } while (0)
    int t = 1;
    for (; t + 1 < NT; t += 2) { A8_STEP(SB0, SB1, SA0, SA1, t, kf0, kf1, kg0, kg1); A8_STEP(SA0, SA1, SB0, SB1, t + 1, kg0, kg1, kf0, kf1); }
    A8_STEP(SB0, SB1, SA0, SA1, NT - 1, kf0, kf1, kg0, kg1);
    A8_PACK(SB0, SB1);
    A8_RDV(((NT - 1) & 7) * SLOT);
    o0 = A8_PV(vf0, o0); o1 = A8_PV(vf1, o1); ls = A8_PV(ones, ls);
    bf16* Ow = Ow0 + (long)(wid * 32) * OP;
    { bf16* stg = (bf16*)(shm + LDS_OST) + wid * 2048;
#pragma unroll
      for (int r = 0; r < 16; ++r) { const int orow = crow(r, hi); const float rl = __builtin_amdgcn_rcpf(ls[r]);
          stg[orow * 64 + r32] = __float2bfloat16(o0[r] * rl); stg[orow * 64 + 32 + r32] = __float2bfloat16(o1[r] * rl); }
      asm volatile("s_waitcnt lgkmcnt(0)" ::: "memory");
#pragma unroll
      for (int i = 0; i < 4; ++i) { const int row = i * 8 + (lane >> 3), ch = lane & 7; const u32x4 v = *(const u32x4*)(stg + row * 64 + ch * 8); *(u32x4*)(Ow + (long)row * OP + ch * 8) = v; } }
    asm volatile("s_waitcnt lgkmcnt(0)\n\ts_barrier" ::: "memory");
#undef A8_DMA
#undef A8_RDK
#undef A8_RDV
#undef A8_PACK
#undef A8_PACKH
#undef A8_EXP
#undef A8_SB
#undef A8_STEP
}
#undef A8_WAIT_BAR
#undef A8_QK
#undef A8_PV
}


using namespace cfg;
typedef unsigned short bf16_t;
typedef float f32x4 __attribute__((ext_vector_type(4)));
typedef unsigned u32x4 __attribute__((ext_vector_type(4)));
typedef unsigned u32x2 __attribute__((ext_vector_type(2)));

__device__ __forceinline__ float bf2f(unsigned v) { return __uint_as_float(v << 16); }
__device__ __forceinline__ float bflo(unsigned w) { return __uint_as_float(w << 16); }
__device__ __forceinline__ float bfhi(unsigned w) { return __uint_as_float(w & 0xffff0000u); }
__device__ __forceinline__ unsigned f2bf(float f) { unsigned u = __float_as_uint(f); return (u + 0x7fffu + ((u >> 16) & 1u)) >> 16; }
__device__ __forceinline__ unsigned pk2(float lo, float hi) { return f2bf(lo) | (f2bf(hi) << 16); }
__device__ __forceinline__ float sigm(float x) { return 1.f / (1.f + __expf(-x)); }
__device__ __forceinline__ float silu(float x) { return x / (1.f + __expf(-x)); }
template <int M> __device__ __forceinline__ float xsum(float v) {
    if constexpr (M < 32) return v + __uint_as_float((unsigned)__builtin_amdgcn_ds_swizzle((int)__float_as_uint(v), (M << 10) | 0x1f));
    else { auto rr = __builtin_amdgcn_permlane32_swap(__float_as_uint(v), __float_as_uint(v), false, false); return __uint_as_float(rr[0]) + __uint_as_float(rr[1]); }
}
__device__ __forceinline__ float wave_sum(float v) { v = xsum<1>(v); v = xsum<2>(v); v = xsum<4>(v); v = xsum<8>(v); v = xsum<16>(v); v = xsum<32>(v); return v; }
__device__ __forceinline__ size_t stream_off(int row, bool& is_ctx) { const int b = row / PB, p = row - b * PB; is_ctx = p < CTXL; return is_ctx ? ((size_t)b * CTXL + p) * D : ((size_t)b * SEQ + (p - CTXL)) * D; }

constexpr size_t MiB = 1u << 20;
constexpr size_t WS_CTL = 0;
constexpr size_t WS_MODV = 1 * MiB;
constexpr size_t WS_LBF = WS_MODV + 256 * 1024;
constexpr size_t WS_REF = WS_LBF + 8192;
constexpr size_t WS_POOLWT = WS_MODV + 512 * 1024;
constexpr size_t WS_COS = 2 * MiB, WS_SIN = 3 * MiB;
constexpr size_t WS_WIN = 4 * MiB;
constexpr size_t WS_WOUT = 13 * MiB;
constexpr size_t WS_WGU = 17 * MiB;
constexpr size_t WS_WD = 49 * MiB;
constexpr size_t WS_XC = 65 * MiB;
constexpr size_t WS_XN = 67 * MiB;
constexpr size_t WS_PROJ = 100 * MiB;
constexpr size_t WS_QN = 175 * MiB;
constexpr size_t WS_KN = 192 * MiB;
constexpr size_t WS_Q8 = WS_QN;
constexpr size_t WS_K8 = WS_QN + 9 * MiB;
constexpr size_t WS_VT8 = WS_QN + 12 * MiB;
constexpr size_t WS_MIX = 197 * MiB;
constexpr size_t WS_UT = 230 * MiB;
constexpr size_t WS_ST = 247 * MiB;
constexpr size_t WS_DEC = 264 * MiB;
constexpr size_t WS_LIST = 265 * MiB;
constexpr size_t WS_ACT2 = WS_PROJ;
constexpr size_t WS_WGU1 = 272 * MiB;
constexpr size_t WS_WD1 = 304 * MiB;
constexpr size_t WS_END = 320 * MiB;
constexpr int CW_CNT = 1024;

__device__ const float ROPE_INV[16] = {1.0f, 0.5623413251903491f, 0.31622776601683794f, 0.1778279410038923f, 0.1f, 0.05623413251903491f, 0.03162277660168379f, 0.01778279410038923f,
                                       0.01f, 0.005623413251903491f, 0.0031622776601683794f, 0.0017782794100389228f, 0.001f, 0.0005623413251903491f, 0.00031622776601683794f, 0.00017782794100389227f};
__device__ __forceinline__ void sincos_d(double a, double& s, double& c) {
    const double k = rint(a * 0.63661977236758134308);
    double r = fma(-k, 1.57079632679489655800e+00, a);
    r = fma(-k, 6.12323399573676603587e-17, r);
    const double r2 = r * r;
    double sp = -7.6471637318198164759e-13;
    sp = fma(sp, r2, 1.6059043836821614599e-10);
    sp = fma(sp, r2, -2.5052108385441718775e-08);
    sp = fma(sp, r2, 2.7557319223985890653e-06);
    sp = fma(sp, r2, -1.9841269841269841270e-04);
    sp = fma(sp, r2, 8.3333333333333333333e-03);
    sp = fma(sp, r2, -1.6666666666666666667e-01);
    const double sr = fma(sp * r2, r, r);
    double cp = 4.7794773323873852974e-14;
    cp = fma(cp, r2, -1.1470745597729724714e-11);
    cp = fma(cp, r2, 2.0876756987868098979e-09);
    cp = fma(cp, r2, -2.7557319223985890653e-07);
    cp = fma(cp, r2, 2.4801587301587301587e-05);
    cp = fma(cp, r2, -1.3888888888888888889e-03);
    cp = fma(cp, r2, 4.1666666666666666667e-02);
    cp = fma(cp, r2, -0.5);
    const double cr = fma(cp, r2, 1.0);
    const int q = ((int)k) & 3;
    s = (q == 0) ? sr : (q == 1) ? cr : (q == 2) ? -sr : -cr;
    c = (q == 0) ? cr : (q == 1) ? -sr : (q == 2) ? -cr : sr;
}

__device__ __forceinline__ void transpose_items(const float* __restrict__ W, int K, int N, bf16_t* __restrict__ WT, int mode, int nbatch, size_t src_stride, size_t dst_stride, float* scr, int gw, int NGW, int lane, int it_lo = 0, int it_hi = 0x7fffffff) {
    const int nblk = N / 32, per = (K / 64) * nblk, nitems = per * nbatch;
    if (it_hi > nitems) it_hi = nitems;
    for (int it = it_lo + gw; it < it_hi; it += NGW) {
        const int bt = it / per, item = it - bt * per;
        const float* Wb = W + (size_t)bt * src_stride; bf16_t* WTb = WT + (size_t)bt * dst_stride;
        const int kb = item / nblk, nb = item - kb * nblk, k0 = 64 * kb, n0 = 32 * nb;
        f32x4 wv[8];
#pragma unroll
        for (int i = 0; i < 8; ++i) wv[i] = *(const f32x4*)(Wb + (size_t)(k0 + 8 * i + (lane >> 3)) * N + n0 + (lane & 7) * 4);
#pragma unroll
        for (int i = 0; i < 8; ++i) { float* s = scr + (8 * i + (lane >> 3)) * 33 + (lane & 7) * 4; s[0] = wv[i].x; s[1] = wv[i].y; s[2] = wv[i].z; s[3] = wv[i].w; }
        asm volatile("s_waitcnt lgkmcnt(0)" ::: "memory");
        const int rbase = (mode == 0) ? n0 : ((n0 >> 7) * 256 + (mode == 2 ? 128 : 0) + (n0 & 127));
        const int cch = lane & 7;
#pragma unroll
        for (int j = 0; j < 4; ++j) { const int n = (lane >> 3) + 8 * j; const float* s = scr + (8 * cch) * 33 + n;
            u32x4 o; o.x = pk2(s[0 * 33], s[1 * 33]); o.y = pk2(s[2 * 33], s[3 * 33]); o.z = pk2(s[4 * 33], s[5 * 33]); o.w = pk2(s[6 * 33], s[7 * 33]);
            *(u32x4*)(WTb + (size_t)(rbase + n) * K + k0 + 8 * cch) = o; }
        asm volatile("s_waitcnt lgkmcnt(0)" ::: "memory");
    }
}
constexpr int MOE_ITEMS = 3 * 4096;
__device__ __forceinline__ void moe_weight_copies(const float* gate, const float* up, const float* down, bf16_t* WGU, bf16_t* WD, float* scr, int gw, int NGW, int lane, int lo, int hi) {
    if (lo < 4096) transpose_items(gate, D, DE, WGU, 1, NE, (size_t)D * DE, (size_t)1024 * D, scr, gw, NGW, lane, lo, hi < 4096 ? hi : 4096);
    if (lo < 8192 && hi > 4096) transpose_items(up, D, DE, WGU, 2, NE, (size_t)D * DE, (size_t)1024 * D, scr, gw, NGW, lane, lo > 4096 ? lo - 4096 : 0, hi < 8192 ? hi - 4096 : 4096);
    if (hi > 8192) transpose_items(down, DE, D, WD, 0, NE, (size_t)DE * D, (size_t)D * DE, scr, gw, NGW, lane, lo > 8192 ? lo - 8192 : 0, hi - 8192);
}
__device__ __forceinline__ void moe_filler(unsigned char* lds, const float* gate, const float* up, const float* down, unsigned char* ws, int lw, int lo, int hi, int U, int G, int c) {
    const int rem = U % G; int rank = c, nr = G;
    if (rem != 0) { if (c < rem) return; rank = c - rem; nr = G - rem; }
    const int tid = otid(); float* scr = (float*)(lds + 16384) + (tid >> 6) * (64 * 33);
    moe_weight_copies(gate + (size_t)lw * NE * D * DE, up + (size_t)lw * NE * D * DE, down + (size_t)lw * NE * DE * D, (bf16_t*)(ws + (lw ? WS_WGU1 : WS_WGU)), (bf16_t*)(ws + (lw ? WS_WD1 : WS_WD)), scr, rank * 8 + (tid >> 6), nr * 8, tid & 63, lo, hi);
}
struct ProArgs { const float *c, *c_ctx, *w_mod, *b_mod, *hgrn_lb, *qg, *kg, *w_in, *w_out, *pool_w, *gate, *up, *down; float *MODV, *LBF, *REF, *COS, *SIN; bf16_t *WIN, *WOUT, *POOLWT, *WGU, *WD; };
__device__ __forceinline__ void prologue_phase(unsigned char* lds, const ProArgs& a, int cu, int G) {
    const int tid = otid(), lane = tid & 63, wave = tid >> 6;
    for (int gid = cu * 512 + tid; gid < SEQ * 32; gid += G * 512) {
        const int t = gid >> 5, j = gid & 31;
        const float pos = (float)(j < 16 ? (t >> 6) : (t & 63));
        const float ang = pos * ROPE_INV[j & 15];
        double s, c; sincos_d((double)ang, s, c);
        a.COS[gid] = (float)c; a.SIN[gid] = (float)s;
    }
    if (cu == 0) {
        for (int gid = tid; gid < 1024; gid += 512) {
            const int l = gid >> 9, r = gid & 511; float v = 0.f;
            if (l == 1) v = 1.f / (1.f + expf(a.hgrn_lb[r] - a.hgrn_lb[512 + r]));
            a.LBF[gid] = fmaxf(v, 1e-30f); }
        if (tid < DEPTH) {
            float mq = 0.f, mk = 0.f;
            for (int i = 0; i < 64; ++i) { mq = fmaxf(mq, fabsf(a.qg[tid * 64 + i])); mk = fmaxf(mk, fabsf(a.kg[tid * 64 + i])); }
            a.REF[tid * 64] = -fmaxf(64.f * C2 * mq * mk * 1.13f + 0.5f - 15.5f, 0.f); }
    }
    {
        float* act = (float*)lds;
        float* part = (float*)(lds + 12288);
        for (int item = cu; item < 2 * 96; item += G) {
            const int l = item / 96, n0 = (item - l * 96) * 64;
            for (int i = tid; i < 3072; i += 512) { const int r = i >> 10, k = i & 1023; const float v = r < 2 ? a.c[r * 1024 + k] : a.c_ctx[k]; act[i] = silu(v); }
            __syncthreads();
            const float* w = a.w_mod + ((size_t)l * 1024 + (size_t)wave * 128) * 6144 + n0 + lane;
            float a0 = 0.f, a1 = 0.f, a2 = 0.f;
#pragma unroll 32
            for (int k = 0; k < 128; ++k) { const float wv = w[(size_t)k * 6144]; const int kk = wave * 128 + k; a0 += act[kk] * wv; a1 += act[1024 + kk] * wv; a2 += act[2048 + kk] * wv; }
            part[(wave * 3 + 0) * 64 + lane] = a0; part[(wave * 3 + 1) * 64 + lane] = a1; part[(wave * 3 + 2) * 64 + lane] = a2;
            __syncthreads();
            if (tid < 192) { const int r = tid >> 6, nn = tid & 63; float s = 0.f;
#pragma unroll
                for (int q = 0; q < 8; ++q) s += part[(q * 3 + r) * 64 + nn];
                a.MODV[(l * 3 + r) * 6144 + n0 + nn] = s + a.b_mod[l * 6144 + n0 + nn]; }
            __syncthreads();
        }
    }
    {
        float* scr = (float*)(lds + 16384) + wave * (64 * 33);
        const int gw = cu * 8 + wave, NGW = G * 8;
        transpose_items(a.w_in, D, NIN, a.WIN, 0, DEPTH, (size_t)D * NIN, (size_t)NIN * D, scr, gw, NGW, lane);
        transpose_items(a.w_out, D, D, a.WOUT, 0, DEPTH, (size_t)D * D, (size_t)D * D, scr, gw, NGW, lane);
        transpose_items(a.pool_w, 64, 64, a.POOLWT, 0, DEPTH * 4, (size_t)64 * 64, (size_t)64 * 64, scr, gw, NGW, lane);
    }
    __syncthreads();
}

namespace pool {
typedef float f32x16 __attribute__((ext_vector_type(16)));
typedef short bf16x8 __attribute__((ext_vector_type(8)));
constexpr int P = 72, O_X = 0  , O_DM = 81920  , O_OUT = 0  , OP = 264;
__device__ __forceinline__ int crow(int r, int hi) { return (r & 3) + 8 * (r >> 2) + 4 * hi; }
__device__ __forceinline__ void pool_phase(unsigned char* lds, const bf16_t* __restrict__ PROJ, const bf16_t* __restrict__ WT  , const float* __restrict__ pscale, bf16_t* __restrict__ MIX, int cu, int G) {
    const int tid = otid(), lane = tid & 63, r32 = lane & 31, hi = lane >> 5, w = __builtin_amdgcn_readfirstlane(tid >> 6);
    float* X = (float*)(lds + O_X); bf16_t* OUT = (bf16_t*)(lds + O_OUT);
    for (int u = G - 1 - cu; u < MT / 64; u += G) {
        const int row0 = u * 64, b = row0 / PB, p0 = row0 - b * PB; const bool is_ctx = p0 < CTXL;
        const int seg0 = b * PB + (is_ctx ? 0 : CTXL), len = is_ctx ? CTXL : SEQ, t0 = is_ctx ? p0 : p0 - CTXL;
#pragma unroll
        for (int it = 0; it < 5; ++it) { const int piece = tid + it * 512, rr = piece >> 5, pc = piece & 31, t = t0 - 8 + rr;
            u32x4 v = {0u, 0u, 0u, 0u};
            if (t >= 0 && t < len) v = *(const u32x4*)(PROJ + (size_t)(seg0 + t) * NIN + C_BP + pc * 8);
            float* x = X + rr * 256 + pc * 8;
            *(f32x4*)x = (f32x4){bflo(v.x), bfhi(v.x), bflo(v.y), bfhi(v.y)}; *(f32x4*)(x + 4) = (f32x4){bflo(v.z), bfhi(v.z), bflo(v.w), bfhi(v.w)}; }
        __syncthreads();
        {
            const int c = tid & 255, th = tid >> 8, g = c >> 6, hw = 1 << g;
            bf16_t* dm = (bf16_t*)(lds + O_DM) + g * 64 * P + (c & 63);
            const float* xc = X + c;
            const int ta = th * 32;
            float s = 0.f;
            for (int q = ta - hw; q < ta + hw; ++q) s += xc[(q + 8) * 256];
#pragma unroll 8
            for (int tt = 0; tt < 32; ++tt) { const int t = ta + tt, tg = t0 + t;
                int lo = tg - hw; if (lo < 0) lo = 0; int hi2 = tg + hw; if (hi2 > len) hi2 = len;
                dm[t * P] = (bf16_t)f2bf(s / (float)(hi2 - lo) - xc[(t + 8) * 256]);
                s += xc[(t + hw + 8) * 256] - xc[(t - hw + 8) * 256]; }
        }
        __syncthreads();
        {
            const int g = w >> 1, tb = w & 1;
            const bf16_t* A = (const bf16_t*)(lds + O_DM) + g * 64 * P + (tb * 32 + r32) * P + hi * 8;
#pragma unroll
            for (int eb = 0; eb < 2; ++eb) {
                const bf16_t* Bp = WT + (size_t)g * 4096 + (eb * 32 + r32) * 64 + hi * 8;
                f32x16 acc = {};
#pragma unroll
                for (int ks = 0; ks < 4; ++ks) acc = __builtin_amdgcn_mfma_f32_32x32x16_bf16(*(const bf16x8*)(A + ks * 16), *(const bf16x8*)(Bp + ks * 16), acc, 0, 0, 0);
                const int e = g * 64 + eb * 32 + r32; const float sc = pscale[e];
#pragma unroll
                for (int r = 0; r < 16; ++r) OUT[(tb * 32 + crow(r, hi)) * OP + e] = (bf16_t)f2bf(acc[r] * sc);
            }
        }
        __syncthreads();
#pragma unroll
        for (int it = 0; it < 4; ++it) { const int piece = tid + it * 512, t = piece >> 5, pc = piece & 31;
            *(u32x4*)(MIX + (size_t)(row0 + t) * D + 256 + pc * 8) = *(const u32x4*)(OUT + t * OP + pc * 8); }
        __syncthreads();
    }
}
}

#ifndef LAS
#define LAS __attribute__((address_space(3)))
#endif
__device__ __forceinline__ void norm1_phase(int cu, int G, const float* __restrict__ lat, const float* __restrict__ cx, const float* __restrict__ g, const float* __restrict__ modv, int sh_off, bf16_t* __restrict__ XN) {
    const int lane = otid() & 63, gw = cu * 8 + (otid() >> 6), NGW = G * 8;
    for (int row0 = gw * 4; row0 < MT; row0 += NGW * 4) {
        bool is_ctx; const size_t off = stream_off(row0, is_ctx);
        const int r = is_ctx ? 2 : row0 / PB;
        const f32x4* xr = (const f32x4*)((is_ctx ? cx : lat) + off) + lane;
        f32x4 v[4][4]; float ss[4];
#pragma unroll
        for (int q = 0; q < 4; ++q) { ss[q] = 0.f;
#pragma unroll
            for (int j = 0; j < 4; ++j) v[q][j] = xr[q * 256 + 64 * j]; }
        const float* mv = modv + r * 6144 + sh_off;
        f32x4 gs[4], sh[4];
#pragma unroll
        for (int j = 0; j < 4; ++j) { const int col = 4 * lane + 256 * j; gs[j] = *(const f32x4*)(g + col) * (*(const f32x4*)(mv + 1024 + col) + 1.f); sh[j] = *(const f32x4*)(mv + col); }
#pragma unroll
        for (int q = 0; q < 4; ++q) {
#pragma unroll
            for (int j = 0; j < 4; ++j) ss[q] += (v[q][j].x * v[q][j].x + v[q][j].y * v[q][j].y) + (v[q][j].z * v[q][j].z + v[q][j].w * v[q][j].w);
            const float rstd = 1.f / sqrtf(wave_sum(ss[q]) * (1.f / D) + EPS);
#pragma unroll
            for (int j = 0; j < 4; ++j) { const f32x4 o = v[q][j] * rstd * gs[j] + sh[j];
                u32x2 w; w.x = pk2(o.x, o.y); w.y = pk2(o.z, o.w);
                *(u32x2*)(XN + (size_t)(row0 + q) * D + 4 * lane + 256 * j) = w; } }
    }
}

__device__ __forceinline__ void norm2_router_phase(unsigned char* lds, int cu, int G, const float* __restrict__ lat, const float* __restrict__ cx, const float* __restrict__ g, const float* __restrict__ modv, int sh_off,
                                                   const float* __restrict__ router_w, const float* __restrict__ router_b, bf16_t* __restrict__ XN, unsigned* __restrict__ cnt, u32x4* __restrict__ LIST, int route_ctx) {
    const int tid = otid(), lane = tid & 63, wave = tid >> 6, gw = cu * 8 + wave, NGW = G * 8;
    float* RW = (float*)lds;
    u32x4* ENT = (u32x4*)(lds + 65536) + wave * 64;
    LAS unsigned* BC = (LAS unsigned*)((LAS unsigned char*)lds + 65536 + 8192);
#pragma unroll
    for (int it = 0; it < 8; ++it) { const int p = tid + it * 512, col = p >> 2, q = p & 3; const f32x4 w4 = *(const f32x4*)(router_w + (size_t)col * 16 + 4 * q);
        RW[(4 * q + 0) * 1024 + col] = w4.x; RW[(4 * q + 1) * 1024 + col] = w4.y; RW[(4 * q + 2) * 1024 + col] = w4.z; RW[(4 * q + 3) * 1024 + col] = w4.w; }
    if (tid < 48) BC[tid] = 0u;
    __syncthreads();
    int nent = 0;
    f32x4 vn[4];
    { int row = gw < MT ? gw : 0; bool ic; const size_t off = stream_off(row, ic); const f32x4* xr = (const f32x4*)((ic ? cx : lat) + off) + lane;
#pragma unroll
      for (int j = 0; j < 4; ++j) vn[j] = xr[64 * j]; }
    for (int row = gw; row < MT; row += NGW) {
        f32x4 v[4];
#pragma unroll
        for (int j = 0; j < 4; ++j) v[j] = vn[j];
        { const int nr = row + NGW < MT ? row + NGW : row; bool ic; const size_t off = stream_off(nr, ic); const f32x4* xr = (const f32x4*)((ic ? cx : lat) + off) + lane;
#pragma unroll
          for (int j = 0; j < 4; ++j) vn[j] = xr[64 * j]; }
        bool is_ctx; (void)stream_off(row, is_ctx);
        if (is_ctx && !route_ctx) continue;
        const int r = is_ctx ? 2 : row / PB;
        float ss = 0.f;
#pragma unroll
        for (int j = 0; j < 4; ++j) ss += (v[j].x * v[j].x + v[j].y * v[j].y) + (v[j].z * v[j].z + v[j].w * v[j].w);
        const float rstd = 1.f / sqrtf(wave_sum(ss) * (1.f / D) + EPS);
        const float* mv = modv + r * 6144 + sh_off;
#pragma unroll
        for (int j = 0; j < 4; ++j) { const int col = 4 * lane + 256 * j;
            const f32x4 gg = *(const f32x4*)(g + col), sh = *(const f32x4*)(mv + col), sc = *(const f32x4*)(mv + 1024 + col);
            v[j] = v[j] * rstd * gg * (sc + 1.f) + sh;
            u32x2 w; w.x = pk2(v[j].x, v[j].y); w.y = pk2(v[j].z, v[j].w);
            *(u32x2*)(XN + (size_t)row * D + col) = w; }
        float sc_[16], sel[16];
#pragma unroll
        for (int e = 0; e < 16; ++e) { float a = 0.f;
#pragma unroll
            for (int j = 0; j < 4; ++j) { const f32x4 w4 = *(const f32x4*)(RW + e * 1024 + 256 * j + 4 * lane); a += (v[j].x * w4.x + v[j].y * w4.y) + (v[j].z * w4.z + v[j].w * w4.w); }
            a = wave_sum(a); sc_[e] = 1.f / (1.f + __expf(-a)); sel[e] = sc_[e] + router_b[e]; }
        float gs[4]; int gi1[4], gi2[4]; float gw1[4], gw2[4];
#pragma unroll
        for (int q = 0; q < 4; ++q) { float v1 = -INFINITY, v2 = -INFINITY; int i1 = 0, i2 = 0; float s1 = 0.f, s2 = 0.f;
#pragma unroll
            for (int k = 0; k < 4; ++k) { const float x = sel[4 * q + k], sx = sc_[4 * q + k];
                if (x > v1) { v2 = v1; i2 = i1; s2 = s1; v1 = x; i1 = 4 * q + k; s1 = sx; } else if (x > v2) { v2 = x; i2 = 4 * q + k; s2 = sx; } }
            gs[q] = v1 + v2; gi1[q] = i1; gi2[q] = i2; gw1[q] = s1; gw2[q] = s2; }
        float bv = gs[0]; int e0 = gi1[0], e1 = gi2[0]; float w0 = gw1[0], w1 = gw2[0];
#pragma unroll
        for (int q = 1; q < 4; ++q) if (gs[q] > bv) { bv = gs[q]; e0 = gi1[q]; e1 = gi2[q]; w0 = gw1[q]; w1 = gw2[q]; }
        const float ws = w0 + w1; w0 /= ws; w1 /= ws;
        {
            const int gq = e0 >> 2; int a = e0 & 3, c = e1 & 3; float wa = w0, wc = w1;
            if (a > c) { const int ti = a; a = c; c = ti; const float tf = wa; wa = wc; wc = tf; }
            const int pi = (a == 0) ? (c - 1) : (a == 1 ? c + 1 : 5);
            const int bk = gq * 6 + pi;
            if (lane == 0) { const unsigned loc = __hip_atomic_fetch_add(BC + bk, 1u, __ATOMIC_RELAXED, __HIP_MEMORY_SCOPE_WORKGROUP);
                u32x4 sv; sv.x = (unsigned)bk | (loc << 8); sv.y = (unsigned)row; sv.z = __float_as_uint(wa); sv.w = __float_as_uint(wc); ENT[nent] = sv; }
            ++nent; }
    }
    __syncthreads();
    if (tid < 24) { const unsigned n = BC[tid]; BC[24 + tid] = n ? __hip_atomic_fetch_add(cnt + tid, n, __ATOMIC_RELAXED, __HIP_MEMORY_SCOPE_AGENT) : 0u; }
    __syncthreads();
    if (lane < nent) { const u32x4 en = ENT[lane]; const unsigned bk = en.x & 255u, slot = BC[24 + bk] + (en.x >> 8);
        u32x4 sv; sv.x = en.y; sv.y = en.z; sv.z = en.w; sv.w = 0u; LIST[(size_t)bk * MT + slot] = sv; }
    __syncthreads();
}

__device__ __forceinline__ void post_phase(int cu, int G, const bf16_t* __restrict__ PROJ, const float* __restrict__ qg, const float* __restrict__ kg, const float* __restrict__ COS, const float* __restrict__ SIN,
                                              unsigned char* __restrict__ Q8, unsigned char* __restrict__ K8, unsigned char* __restrict__ VT8) {
    const int lane = otid() & 63, gw = cu * 8 + (otid() >> 6), NGW = G * 8;
    const int d0 = (lane & 7) * 8, jk = lane & 31;
    float qgv[8];
#pragma unroll
    for (int i = 0; i < 8; ++i) qgv[i] = qg[d0 + i];
    const float kg0 = kg[2 * jk], kg1 = kg[2 * jk + 1];
    for (int row0 = gw * 4; row0 < MT; row0 += NGW * 4) {
        const int b = row0 / PB, p0 = row0 - b * PB; const bool is_ctx = p0 < CTXL; const int t0 = is_ctx ? 0 : p0 - CTXL;
        u32x4 wq[4]; unsigned wk[4], wv[4]; f32x4 cq[4], sq[4]; float ck[4], sk[4];
#pragma unroll
        for (int q = 0; q < 4; ++q) { const bf16_t* pr = PROJ + (size_t)(row0 + q) * NIN;
            wq[q] = *(const u32x4*)(pr + C_CQ + lane * 8); wk[q] = *(const unsigned*)(pr + C_CK + lane * 2); wv[q] = *(const unsigned*)(pr + C_CV + lane * 2);
            const int t = is_ctx ? 0 : t0 + q;
            cq[q] = *(const f32x4*)(COS + t * 32 + (d0 >> 1)); sq[q] = *(const f32x4*)(SIN + t * 32 + (d0 >> 1)); ck[q] = COS[t * 32 + jk]; sk[q] = SIN[t * 32 + jk]; }
#pragma unroll
        for (int q = 0; q < 4; ++q) {
            {
                const u32x4 w = wq[q];
                float x[8] = {bflo(w.x), bfhi(w.x), bflo(w.y), bfhi(w.y), bflo(w.z), bfhi(w.z), bflo(w.w), bfhi(w.w)};
                float ss = 0.f;
#pragma unroll
                for (int i = 0; i < 8; ++i) ss += x[i] * x[i];
                ss = xsum<1>(ss); ss = xsum<2>(ss); ss = xsum<4>(ss);
                const float rstd = 1.f / sqrtf(ss * (1.f / 64.f) + EPS);
#pragma unroll
                for (int i = 0; i < 8; ++i) x[i] = x[i] * rstd * qgv[i];
                if (!is_ctx) {
#pragma unroll
                    for (int i = 0; i < 4; ++i) { const float cs = cq[q][i], sn = sq[q][i];
                        const float x1 = x[2 * i], x2 = x[2 * i + 1]; x[2 * i] = x1 * cs - x2 * sn; x[2 * i + 1] = x1 * sn + x2 * cs; } }
                int o0 = 0, o1 = 0;
                o0 = __builtin_amdgcn_cvt_pk_fp8_f32(x[0] * C2, x[1] * C2, o0, false); o0 = __builtin_amdgcn_cvt_pk_fp8_f32(x[2] * C2, x[3] * C2, o0, true);
                o1 = __builtin_amdgcn_cvt_pk_fp8_f32(x[4] * C2, x[5] * C2, o1, false); o1 = __builtin_amdgcn_cvt_pk_fp8_f32(x[6] * C2, x[7] * C2, o1, true);
                u32x2 o; o.x = (unsigned)o0; o.y = (unsigned)o1;
                *(u32x2*)(Q8 + (size_t)(row0 + q) * 512 + lane * 8) = o;
            }
            {
                float x1 = bflo(wk[q]), x2 = bfhi(wk[q]);
                float ss = x1 * x1 + x2 * x2;
                ss = xsum<1>(ss); ss = xsum<2>(ss); ss = xsum<4>(ss); ss = xsum<8>(ss); ss = xsum<16>(ss);
                const float rstd = 1.f / sqrtf(ss * (1.f / 64.f) + EPS);
                x1 = x1 * rstd * kg0; x2 = x2 * rstd * kg1;
                if (!is_ctx) { const float cs = ck[q], sn = sk[q]; const float a = x1 * cs - x2 * sn, c = x1 * sn + x2 * cs; x1 = a; x2 = c; }
                const int w8 = __builtin_amdgcn_cvt_pk_fp8_f32(x1, x2, 0, false);
                *(unsigned short*)(K8 + (size_t)(row0 + q) * 128 + lane * 2) = (unsigned short)w8;
            }
            {
                const int p = p0 + q, tile = p >> 6, kvl = p & 63, c = kvl >> 5, w = kvl & 31, hh = (w >> 2) & 1, tp = (w & 3) + 4 * (w >> 3);
                const int w8 = __builtin_amdgcn_cvt_pk_fp8_f32(bflo(wv[q]), bfhi(wv[q]), 0, false);
                unsigned char* vb = VT8 + ((size_t)((b * 2 + (lane >> 5)) * (PB / 64) + tile)) * 4096 + (size_t)(((hh * 2 + c) * 64 + 2 * (lane & 31)) * 16 + tp);
                vb[0] = (unsigned char)(w8 & 0xff); vb[16] = (unsigned char)((w8 >> 8) & 0xff);
            }
        }
    }
}

namespace hg {
typedef float f32x16 __attribute__((ext_vector_type(16)));
typedef short bf16x8 __attribute__((ext_vector_type(8)));
typedef short s16x4 __attribute__((ext_vector_type(4)));
typedef float f32x2 __attribute__((ext_vector_type(2)));
constexpr int P = 72;
constexpr int O_ZB = 0, O_ZQ = 32768, O_VT = 40960, O_QH = 50176, O_QT = 68608, O_KH = 87040, O_ST = 105472, O_SSQ = 123904, O_OUT = 0  , O_TOT = 0, LDS_BYTES = 124416;
constexpr int MSZ = 64 * P * 2;
constexpr int NCH = PB / 64;
__device__ __forceinline__ int crow(int r, int hi) { return (r & 3) + 8 * (r >> 2) + 4 * hi; }
__device__ __forceinline__ unsigned cvtpk(float lo, float hi) { typedef __bf16 b2 __attribute__((ext_vector_type(2))); f32x2 v = {lo, hi}; b2 b = __builtin_convertvector(v, b2); return __builtin_bit_cast(unsigned, b); }
__device__ __forceinline__ float clampe(float e) { return fminf(fmaxf(e, -80.f), 80.f); }

struct StageRegs { u32x4 wf, wb, wv, wq; };
template <bool FULL> __device__ __forceinline__ void stage_load(StageRegs& s, const bf16_t* __restrict__ PROJ, int row0, int h) {
    const int tid = otid(), t = tid >> 3, pc = tid & 7;
    const bf16_t* pr = PROJ + (size_t)(row0 + t) * NIN + h * 64 + pc * 8;
    s.wf = *(const u32x4*)(pr + C_AFF); s.wb = *(const u32x4*)(pr + C_AFB); s.wv = *(const u32x4*)(pr + C_AI);
    if (FULL) s.wq = *(const u32x4*)(pr + C_AQ);
}
template <bool FULL> __device__ __forceinline__ void prep(unsigned char* lds, const bf16_t* __restrict__ PROJ, const float* __restrict__ LBFl, int row0, int h, StageRegs& sr, int nrow0, int nh) {
    const int tid = otid();
    float* ZB = (float*)(lds + O_ZB); bf16_t* ZQ = (bf16_t*)(lds + O_ZQ); bf16_t* VT = (bf16_t*)(lds + O_VT);
    {
        const int t = tid >> 3, pc = tid & 7;
        const u32x4 wf = sr.wf, wb = sr.wb, wv = sr.wv;
        float* zf = ZB + t * 64 + pc * 8; float* zb = ZB + 4096 + t * 64 + pc * 8;
        *(f32x4*)zf = (f32x4){bflo(wf.x), bfhi(wf.x), bflo(wf.y), bfhi(wf.y)}; *(f32x4*)(zf + 4) = (f32x4){bflo(wf.z), bfhi(wf.z), bflo(wf.w), bfhi(wf.w)};
        *(f32x4*)zb = (f32x4){bflo(wb.x), bfhi(wb.x), bflo(wb.y), bfhi(wb.y)}; *(f32x4*)(zb + 4) = (f32x4){bflo(wb.z), bfhi(wb.z), bflo(wb.w), bfhi(wb.w)};
        bf16_t* vt = VT + (pc * 8) * P + t;
        vt[0 * P] = (bf16_t)(wv.x & 0xffffu); vt[1 * P] = (bf16_t)(wv.x >> 16); vt[2 * P] = (bf16_t)(wv.y & 0xffffu); vt[3 * P] = (bf16_t)(wv.y >> 16);
        vt[4 * P] = (bf16_t)(wv.z & 0xffffu); vt[5 * P] = (bf16_t)(wv.z >> 16); vt[6 * P] = (bf16_t)(wv.w & 0xffffu); vt[7 * P] = (bf16_t)(wv.w >> 16);
        if (FULL) { const u32x4 wq = sr.wq; *(u32x4*)(ZQ + t * 64 + pc * 8) = wq; }
        if (nrow0 >= 0) stage_load<FULL>(sr, PROJ, nrow0, nh);
    }
    __syncthreads();
#pragma unroll
    for (int it = 0; it < 2; ++it) {
        const int item = tid + it * 512, dir = item >> 9, t = (item >> 3) & 63, i0 = (item & 7) * 8;
        float* zp = ZB + dir * 4096 + t * 64 + i0; const float* lp = LBFl + dir * 256 + h * 64 + i0;
        f32x4 za = *(const f32x4*)zp, zc = *(const f32x4*)(zp + 4); const f32x4 la = *(const f32x4*)lp, lc = *(const f32x4*)(lp + 4);
#pragma unroll
        for (int k = 0; k < 4; ++k) { za[k] = __logf(la[k] + (1.f - la[k]) / (1.f + __expf(-za[k]))); zc[k] = __logf(lc[k] + (1.f - lc[k]) / (1.f + __expf(-zc[k]))); }
        *(f32x4*)zp = za; *(f32x4*)(zp + 4) = zc;
    }
    __syncthreads();
    if (tid < 128) {
        const int dir = tid >> 6, i = tid & 63;
        float* zb = ZB + dir * 4096 + i; float acc = 0.f;
        if (dir == 0) {
#pragma unroll 16
            for (int t = 0; t < 64; ++t) { acc += zb[t * 64]; zb[t * 64] = acc; } }
        else {
#pragma unroll 16
            for (int t = 63; t >= 0; --t) { acc += zb[t * 64]; zb[t * 64] = acc; } }
    }
    __syncthreads();
#pragma unroll
    for (int it = 0; it < 2; ++it) {
        const int item = tid + it * 512, dir = item >> 9, t = (item >> 3) & 63, i0 = (item & 7) * 8;
        const float* B = ZB + dir * 4096;
        const int tp = dir == 0 ? t - 1 : t + 1; const bool edge = dir == 0 ? (t == 0) : (t == 63);
        const int tref = dir == 0 ? 31 : 32;
        float bc[8], bp[8], br[8];
        { const f32x4 a = *(const f32x4*)(B + t * 64 + i0), c = *(const f32x4*)(B + t * 64 + i0 + 4); bc[0] = a.x; bc[1] = a.y; bc[2] = a.z; bc[3] = a.w; bc[4] = c.x; bc[5] = c.y; bc[6] = c.z; bc[7] = c.w; }
        { const int tq = edge ? t : tp; const f32x4 a = *(const f32x4*)(B + tq * 64 + i0), c = *(const f32x4*)(B + tq * 64 + i0 + 4);
          bp[0] = a.x; bp[1] = a.y; bp[2] = a.z; bp[3] = a.w; bp[4] = c.x; bp[5] = c.y; bp[6] = c.z; bp[7] = c.w;
          if (edge) {
#pragma unroll
              for (int k = 0; k < 8; ++k) bp[k] = 0.f; } }
        { const f32x4 a = *(const f32x4*)(B + tref * 64 + i0), c = *(const f32x4*)(B + tref * 64 + i0 + 4); br[0] = a.x; br[1] = a.y; br[2] = a.z; br[3] = a.w; br[4] = c.x; br[5] = c.y; br[6] = c.z; br[7] = c.w; }
        float kh[8];
#pragma unroll
        for (int k = 0; k < 8; ++k) { const float kk = 1.f - __expf(bc[k] - bp[k]); kh[k] = kk * __expf(clampe(br[k] - bc[k])); }
        if (!FULL) {
            bf16_t* kt = (bf16_t*)(lds + O_KH + dir * MSZ) + i0 * P + t;
#pragma unroll
            for (int k = 0; k < 8; ++k) kt[k * P] = (bf16_t)f2bf(kh[k]);
        } else {
            u32x4 w; w.x = cvtpk(kh[0], kh[1]); w.y = cvtpk(kh[2], kh[3]); w.z = cvtpk(kh[4], kh[5]); w.w = cvtpk(kh[6], kh[7]);
            *(u32x4*)((bf16_t*)(lds + O_KH + dir * MSZ) + t * P + i0) = w;
            const u32x4 wq = *(const u32x4*)(ZQ + t * 64 + i0);
            float q[8] = {silu(bflo(wq.x)), silu(bfhi(wq.x)), silu(bflo(wq.y)), silu(bfhi(wq.y)), silu(bflo(wq.z)), silu(bfhi(wq.z)), silu(bflo(wq.w)), silu(bfhi(wq.w))};
            float qh[8], qt[8];
#pragma unroll
            for (int k = 0; k < 8; ++k) { qh[k] = q[k] * __expf(clampe(bc[k] - br[k])); qt[k] = q[k] * __expf(bc[k]); }
            w.x = cvtpk(qh[0], qh[1]); w.y = cvtpk(qh[2], qh[3]); w.z = cvtpk(qh[4], qh[5]); w.w = cvtpk(qh[6], qh[7]);
            *(u32x4*)((bf16_t*)(lds + O_QH + dir * MSZ) + t * P + i0) = w;
            w.x = cvtpk(qt[0], qt[1]); w.y = cvtpk(qt[2], qt[3]); w.z = cvtpk(qt[4], qt[5]); w.w = cvtpk(qt[6], qt[7]);
            *(u32x4*)((bf16_t*)(lds + O_QT + dir * MSZ) + t * P + i0) = w;
        }
    }
    __syncthreads();
}

__device__ __forceinline__ void h1_phase(unsigned char* lds, const bf16_t* __restrict__ PROJ, const float* __restrict__ LBFl, bf16_t* __restrict__ UT, float* __restrict__ DEC, int cu, int G) {
    const int tid = otid(), lane = tid & 63, r32 = lane & 31, hi = lane >> 5, w = __builtin_amdgcn_readfirstlane(tid >> 6);
    StageRegs sr;
    if (cu < BATCH * NCH * 4) { const int h = cu & 3, bc = cu >> 2, b = bc / NCH, cp = bc - b * NCH; stage_load<false>(sr, PROJ, b * PB + cp * 64, h); }
    for (int u = cu; u < BATCH * NCH * 4; u += G) {
        const int h = u & 3, bc = u >> 2, b = bc / NCH, cp = bc - b * NCH, row0 = b * PB + cp * 64;
        int nrow0 = -1, nh = 0; { const int un = u + G; if (un < BATCH * NCH * 4) { const int bcn = un >> 2, bn = bcn / NCH; nh = un & 3; nrow0 = bn * PB + (bcn - bn * NCH) * 64; } }
        prep<false>(lds, PROJ, LBFl, row0, h, sr, nrow0, nh);
        const float* ZB = (const float*)(lds + O_ZB);
        {
            const int dir = w >> 2, jb = (w >> 1) & 1, ib = w & 1;
            const bf16_t* VT = (const bf16_t*)(lds + O_VT) + (jb * 32 + r32) * P + hi * 8;
            const bf16_t* KT = (const bf16_t*)(lds + O_KH + dir * MSZ) + (ib * 32 + r32) * P + hi * 8;
            f32x16 acc = {};
#pragma unroll
            for (int ks = 0; ks < 4; ++ks) acc = __builtin_amdgcn_mfma_f32_32x32x16_bf16(*(const bf16x8*)(VT + ks * 16), *(const bf16x8*)(KT + ks * 16), acc, 0, 0, 0);
            const int i = ib * 32 + r32;
            const float btot = ZB[dir * 4096 + (dir == 0 ? 63 : 0) * 64 + i], bref = ZB[dir * 4096 + (dir == 0 ? 31 : 32) * 64 + i];
            const float sc = __expf(btot - bref);
            const int chain = (b * 4 + h) * 2 + dir;
            bf16_t* ut = UT + ((size_t)chain * NCH + cp) * 4096 + i;
#pragma unroll
            for (int r = 0; r < 16; ++r) ut[(jb * 32 + crow(r, hi)) * 64] = (bf16_t)f2bf(acc[r] * sc);
        }
        if (tid < 128) { const int dir = tid >> 6, i = tid & 63; const int chain = (b * 4 + h) * 2 + dir;
            DEC[((size_t)chain * NCH + cp) * 64 + i] = __expf(ZB[dir * 4096 + (dir == 0 ? 63 : 0) * 64 + i]); }
        __syncthreads();
    }
}

__device__ __forceinline__ void h2_phase(unsigned char* lds, const bf16_t* __restrict__ UT, const float* __restrict__ DEC, bf16_t* __restrict__ ST, int cu, int G) {
    const int tid = otid(), seg = tid >> 7, e = tid & 127, jl = e >> 5, i = (e & 31) * 2;
    f32x4* TOT = (f32x4*)(lds + O_TOT);
    for (int task = cu; task < 256; task += G) {
        const int chain = task >> 4, j = (task & 15) * 4 + jl, dir = chain & 1;
        const size_t cbase = (size_t)chain * NCH;
        float S0 = 0.f, S1 = 0.f, P0 = 1.f, P1 = 1.f;
#pragma unroll 11
        for (int kk = 0; kk < 33; ++kk) { const int k = seg * 33 + kk, cp = dir == 0 ? k : (k < 4 ? 3 - k : 135 - k);
            const unsigned u = *(const unsigned*)(UT + (cbase + cp) * 4096 + j * 64 + i); const f32x2 d = *(const f32x2*)(DEC + (cbase + cp) * 64 + i);
            S0 = d.x * S0 + bflo(u); S1 = d.y * S1 + bfhi(u); P0 *= d.x; P1 *= d.y; }
        TOT[seg * 128 + e] = (f32x4){S0, S1, P0, P1};
        __syncthreads();
        float s0 = 0.f, s1 = 0.f;
#pragma unroll
        for (int sp = 0; sp < 3; ++sp) if (sp < seg) { const f32x4 t = TOT[sp * 128 + e]; s0 = t.z * s0 + t.x; s1 = t.w * s1 + t.y; }
#pragma unroll 11
        for (int kk = 0; kk < 33; ++kk) { const int k = seg * 33 + kk, cp = dir == 0 ? k : (k < 4 ? 3 - k : 135 - k);
            const unsigned u = *(const unsigned*)(UT + (cbase + cp) * 4096 + j * 64 + i); const f32x2 d = *(const f32x2*)(DEC + (cbase + cp) * 64 + i);
            *(unsigned*)(ST + (cbase + cp) * 4096 + j * 64 + i) = pk2(s0, s1);
            s0 = d.x * s0 + bflo(u); s1 = d.y * s1 + bfhi(u); }
        __syncthreads();
    }
}

__device__ __forceinline__ void h3_phase(unsigned char* lds, const bf16_t* __restrict__ PROJ, const float* __restrict__ LBFl, const bf16_t* __restrict__ ST, const float* __restrict__ ng, bf16_t* __restrict__ MIX, int cu, int G) {
    const int tid = otid(), lane = tid & 63, r32 = lane & 31, hi = lane >> 5, w = __builtin_amdgcn_readfirstlane(tid >> 6);
    StageRegs sr; u32x4 sv0, sv1;
    const int u0 = G - 1 - cu;
    if (u0 < BATCH * NCH * 4) { const int h = u0 & 3, bc = u0 >> 2, b = bc / NCH, cp = bc - b * NCH; stage_load<true>(sr, PROJ, b * PB + cp * 64, h);
        const size_t so = ((size_t)((b * 4 + h) * 2) * NCH + cp) * 4096 + (tid >> 3) * 64 + (tid & 7) * 8; sv0 = *(const u32x4*)(ST + so); sv1 = *(const u32x4*)(ST + so + (size_t)NCH * 4096); }
    for (int u = u0; u < BATCH * NCH * 4; u += G) {
        const int h = u & 3, bc = u >> 2, b = bc / NCH, cp = bc - b * NCH, row0 = b * PB + cp * 64;
        int nrow0 = -1, nh = 0, nb = 0, ncp = 0; { const int un = u + G; if (un < BATCH * NCH * 4) { const int bcn = un >> 2; nb = bcn / NCH; ncp = bcn - nb * NCH; nh = un & 3; nrow0 = nb * PB + ncp * 64; } }
        { const int j = tid >> 3, ic = (tid & 7) * 8;
          *(u32x4*)((bf16_t*)(lds + O_ST) + j * P + ic) = sv0; *(u32x4*)((bf16_t*)(lds + O_ST + MSZ) + j * P + ic) = sv1;
          if (nrow0 >= 0) { const size_t so = ((size_t)((nb * 4 + nh) * 2) * NCH + ncp) * 4096 + j * 64 + ic; sv0 = *(const u32x4*)(ST + so); sv1 = *(const u32x4*)(ST + so + (size_t)NCH * 4096); } }
        prep<true>(lds, PROJ, LBFl, row0, h, sr, nrow0, nh);
        float* SSQ = (float*)(lds + O_SSQ); bf16_t* OUT = (bf16_t*)(lds + O_OUT);
        f32x16 ot = {};
        const int jb = (w >> 1) & 1, tb = w & 1;
        if (w < 4) {
            const bf16_t* VT = (const bf16_t*)(lds + O_VT) + (jb * 32 + r32) * P;
#pragma unroll
            for (int sb = 0; sb < 2; ++sb) {
                f32x16 xf = {}, xb = {};
                const bf16_t* QF = (const bf16_t*)(lds + O_QH) + (tb * 32 + r32) * P + hi * 8; const bf16_t* QB = QF + 64 * P;
                const bf16_t* KF = (const bf16_t*)(lds + O_KH) + (sb * 32 + r32) * P + hi * 8; const bf16_t* KB = KF + 64 * P;
                if (sb <= tb) {
#pragma unroll
                    for (int ks = 0; ks < 4; ++ks) xf = __builtin_amdgcn_mfma_f32_32x32x16_bf16(*(const bf16x8*)(KF + ks * 16), *(const bf16x8*)(QF + ks * 16), xf, 0, 0, 0); }
                if (sb >= tb) {
#pragma unroll
                    for (int ks = 0; ks < 4; ++ks) xb = __builtin_amdgcn_mfma_f32_32x32x16_bf16(*(const bf16x8*)(KB + ks * 16), *(const bf16x8*)(QB + ks * 16), xb, 0, 0, 0); }
                float x[16];
#pragma unroll
                for (int r = 0; r < 16; ++r) { const int s = crow(r, hi), t = r32;
                    const float vf = (sb < tb || (sb == tb && s <= t)) ? xf[r] : 0.f, vb = (sb > tb || (sb == tb && s >= t)) ? xb[r] : 0.f; x[r] = vf + vb; }
#pragma unroll
                for (int sp = 0; sp < 2; ++sp) {
                    u32x4 xw; xw.x = cvtpk(x[8 * sp + 0], x[8 * sp + 1]); xw.y = cvtpk(x[8 * sp + 2], x[8 * sp + 3]); xw.z = cvtpk(x[8 * sp + 4], x[8 * sp + 5]); xw.w = cvtpk(x[8 * sp + 6], x[8 * sp + 7]);
                    const s16x4 v0 = *(const s16x4*)(VT + sb * 32 + 16 * sp + 4 * hi), v1 = *(const s16x4*)(VT + sb * 32 + 16 * sp + 8 + 4 * hi);
                    const bf16x8 va = {v0[0], v0[1], v0[2], v0[3], v1[0], v1[1], v1[2], v1[3]};
                    ot = __builtin_amdgcn_mfma_f32_32x32x16_bf16(va, __builtin_bit_cast(bf16x8, xw), ot, 0, 0, 0); }
            }
#pragma unroll
            for (int dir = 0; dir < 2; ++dir) {
                const bf16_t* SA = (const bf16_t*)(lds + O_ST + dir * MSZ) + (jb * 32 + r32) * P + hi * 8; const bf16_t* QT = (const bf16_t*)(lds + O_QT + dir * MSZ) + (tb * 32 + r32) * P + hi * 8;
#pragma unroll
                for (int ks = 0; ks < 4; ++ks) ot = __builtin_amdgcn_mfma_f32_32x32x16_bf16(*(const bf16x8*)(SA + ks * 16), *(const bf16x8*)(QT + ks * 16), ot, 0, 0, 0); }
            float part = 0.f;
#pragma unroll
            for (int r = 0; r < 16; ++r) part += ot[r] * ot[r];
            part = xsum<32>(part);
            if (hi == 0) SSQ[jb * 64 + tb * 32 + r32] = part;
        }
        __syncthreads();
        if (w < 4) { const int t = tb * 32 + r32; const float rstd = 1.f / sqrtf((SSQ[t] + SSQ[64 + t]) * (1.f / 64.f) + EPS);
#pragma unroll
            for (int r = 0; r < 16; ++r) { const int j = jb * 32 + crow(r, hi); OUT[t * P + j] = (bf16_t)f2bf(ot[r] * rstd * ng[j]); } }
        __syncthreads();
        {
            const int t = tid >> 3, jc = (tid & 7) * 8;
            const u32x4 y = *(const u32x4*)(OUT + t * P + jc); const u32x4 g = *(const u32x4*)(PROJ + (size_t)(row0 + t) * NIN + C_AG + h * 64 + jc);
            u32x4 o; o.x = pk2(bflo(y.x) * silu(bflo(g.x)), bfhi(y.x) * silu(bfhi(g.x))); o.y = pk2(bflo(y.y) * silu(bflo(g.y)), bfhi(y.y) * silu(bfhi(g.y)));
            o.z = pk2(bflo(y.z) * silu(bflo(g.z)), bfhi(y.z) * silu(bfhi(g.z))); o.w = pk2(bflo(y.w) * silu(bflo(g.w)), bfhi(y.w) * silu(bfhi(g.w)));
            *(u32x4*)(MIX + (size_t)(row0 + t) * D + h * 64 + jc) = o;
        }
        __syncthreads();
    }
}
}
__device__ __forceinline__ int vcu_of(int bx, int G) { return (G % 8 == 0) ? (bx % 8) * (G / 8) + bx / 8 : bx; }
__device__ __forceinline__ void attn_phase(char* lds, const unsigned char* Q8, const unsigned char* K8, const unsigned char* VT8, bf16_t* MIX, float neg_ref, int vcu, int G, bool with_ctx) {
    using attn8::bf16;
    const int upc = (512 + G - 1) / G;
    const int nun = upc + ((with_ctx && vcu < 16) ? 1 : 0);
    for (int i = 0; i < nun; ++i) {
        int b, h, nt; size_t q0;
        if (i < upc) { const int u = vcu * upc + i; if (u >= 512) continue; const int combo = u >> 7; b = combo >> 1; h = (combo & 1) * 4 + ((u >> 5) & 3); q0 = (size_t)b * PB + CTXL + (size_t)(u & 31) * 256; nt = PB / 64; }
        else { b = vcu >> 3; h = vcu & 7; q0 = (size_t)b * PB; nt = CTXL / 64; }
        const int kvh = h >> 2; const size_t k0 = (size_t)b * PB;
        attn8::attn_unit(Q8 + q0 * 512 + h * 64, K8 + k0 * 128 + kvh * 64, VT8 + (size_t)((b * 2 + kvh) * (PB / 64)) * 4096, (bf16*)MIX + q0 * 1024 + 512 + h * 64, nt, neg_ref, lds);
    }
}

namespace pg8 {
struct EpiResid {
    static constexpr bool PERM = false, AFTER_DRAIN = false;
    const float* src_lat; const float* src_ctx; float* dst_lat; float* dst_ctx; const float* modv; int ga_off; int pad;
    __device__ __forceinline__ void operator()(const f32x4 (&acc)[2][2][4][2], const Unit& u, int wr, int wc, int fr, int fq) const {
        asm volatile("" : "+v"(fr), "+v"(fq));
        const int b = u.pm / TPB, w = u.pm - b * TPB;
        const size_t base = (w == 0) ? (size_t)b * CTXL * D : ((size_t)b * SEQ + (size_t)(w - 1) * 256) * D;
        const float* s = ((w == 0) ? src_ctx : src_lat) + base; float* d = ((w == 0) ? dst_ctx : dst_lat) + base;
        const float* ga = modv + ((w == 0) ? 2 : b) * 6144 + ga_off;
        const int row0 = wr * 64 + fr, col0 = u.pn * BM + wc * 32 + 4 * fq;
        f32x4 gv[2][2];
#pragma unroll
        for (int bj = 0; bj < 2; ++bj)
#pragma unroll
            for (int n = 0; n < 2; ++n) gv[bj][n] = *(const f32x4*)(ga + col0 + bj * HALF + n * 16);
#pragma unroll
        for (int ai = 0; ai < 2; ++ai)
#pragma unroll
            for (int m = 0; m < 4; ++m) { const size_t off = (size_t)(row0 + ai * HALF + m * 16) * D + col0;
#pragma unroll
                for (int bj = 0; bj < 2; ++bj)
#pragma unroll
                    for (int n = 0; n < 2; ++n) *(f32x4*)(d + off + bj * HALF + n * 16) = *(const f32x4*)(s + off + bj * HALF + n * 16) + gv[bj][n] * acc[ai][bj][m][n]; }
    }
};
struct OutOrder : StaticOrder {
    int lat_only;
    __device__ __forceinline__ bool next(int i, Unit& u) const { if (!StaticOrder::next(i, u)) return false; if (lat_only) u.pm = (u.pm >> 5) * TPB + 1 + (u.pm & 31); return true; }
};
}


namespace pg8 {
struct MUnit { int pm, pn, nrows, lbase, e0, e1; };
__device__ __forceinline__ void build_tiles(PG8_LAS int* TT, const unsigned* cnt) {
    if (otid() == 0) { int off = 0;
        for (int bk = 0; bk < 24; ++bk) { const int c = (int)__hip_atomic_load(cnt + bk, __ATOMIC_RELAXED, __HIP_MEMORY_SCOPE_AGENT); const int nb = (c + 255) >> 8;
            for (int ti = 0; ti < nb; ++ti) { const int rem = c - ti * 256; TT[4 + 4 * off + 0] = bk; TT[4 + 4 * off + 1] = ti; TT[4 + 4 * off + 2] = rem < 256 ? rem : 256; TT[4 + 4 * off + 3] = 0; ++off; } }
        TT[0] = off; }
    __syncthreads();
}
template <int NPN  > struct MoeOrder {
    const PG8_LAS int* TT; int G, c;
    __device__ __forceinline__ bool next(int i, MUnit& u) const {
        const int L = i * G + c, tile = L / NPN; if (tile >= TT[0]) return false;
        const int bk = TT[4 + 4 * tile], ti = TT[4 + 4 * tile + 1];
        u.pm = tile; u.pn = L - tile * NPN; u.nrows = TT[4 + 4 * tile + 2]; u.lbase = bk * MT + ti * 256;
        const int g = bk / 6, pi = bk - g * 6; const int lo = pi < 3 ? 0 : (pi < 5 ? 1 : 2), hi = pi < 3 ? pi + 1 : (pi < 5 ? pi - 1 : 3);
        u.e0 = 4 * g + lo; u.e1 = 4 * g + hi; return true;
    }
};
struct Src1 {
    const bf16_t* XN; const bf16_t* WGU; const u32x4* LIST;
    __device__ __forceinline__ const char* a_base(const MUnit&) const { return (const char*)XN; }
    __device__ __forceinline__ void a_offsets(const MUnit& u, const int (&RA)[2], const int (&CA)[2], unsigned (&ao)[2][2]) const {
#pragma unroll
        for (int h = 0; h < 2; ++h)
#pragma unroll
            for (int i = 0; i < 2; ++i) { const int r = h * HALF + RA[i]; const unsigned row = r < u.nrows ? LIST[u.lbase + r].x : 0u; ao[h][i] = (row * (unsigned)D + (unsigned)CA[i]) * 2u; }
    }
    __device__ __forceinline__ const char* b_base(const MUnit& u, int seg) const { const int e = (u.pn >> 2) ? u.e1 : u.e0;
        return (const char*)(WGU + ((size_t)e * 1024 + (size_t)(u.pn & 3) * 256) * D) + (seg ? (size_t)(D / 2) * 2 : 0); }
    __device__ __forceinline__ void prefetch_rows(const MUnit& u, const int (&)[2], PG8_LAS unsigned char* rows, int wid) const {
        int t2 = otid(); asm volatile("" : "+v"(t2));
        int RA[2];
#pragma unroll
        for (int i = 0; i < 2; ++i) { int R, C; stage_rc(t2 * 16 + i * 8192, R, C); RA[i] = R; }
#pragma unroll
        for (int h = 0; h < 2; ++h)
#pragma unroll
            for (int i = 0; i < 2; ++i) { const int r = h * HALF + RA[i];
                __builtin_amdgcn_global_load_lds((const unsigned*)&LIST[u.lbase + r], (PG8_LAS unsigned*)(rows + ((h * 2 + i) * 8 + wid) * 256), 4, 0, 0); }
    }
    __device__ __forceinline__ void reload_offsets(const MUnit& u, const int (&)[2], const int (&)[2], const PG8_LAS unsigned char* rows, int wid, int lane, unsigned (&ao)[2][2]) const {
        int t2 = otid(); asm volatile("" : "+v"(t2));
        int RA[2], CA[2];
#pragma unroll
        for (int i = 0; i < 2; ++i) { int R, C; stage_rc(t2 * 16 + i * 8192, R, C); RA[i] = R; CA[i] = C; }
#pragma unroll
        for (int h = 0; h < 2; ++h)
#pragma unroll
            for (int i = 0; i < 2; ++i) { const int r = h * HALF + RA[i]; const unsigned v = *(const PG8_LAS unsigned*)(rows + ((h * 2 + i) * 8 + wid) * 256 + lane * 4);
                const unsigned row = r < u.nrows ? v : 0u; ao[h][i] = (row * (unsigned)D + (unsigned)CA[i]) * 2u; }
    }
};
struct Src2 {
    const bf16_t* ACT2; const bf16_t* WD;
    __device__ __forceinline__ const char* a_base(const MUnit& u) const { return (const char*)(ACT2 + (size_t)u.pm * 256 * 1024); }
    __device__ __forceinline__ void a_offsets(const MUnit&, const int (&RA)[2], const int (&CA)[2], unsigned (&ao)[2][2]) const {
#pragma unroll
        for (int h = 0; h < 2; ++h)
#pragma unroll
            for (int i = 0; i < 2; ++i) ao[h][i] = (unsigned)((h * HALF + RA[i]) * 1024 + CA[i]) * 2u;
    }
    __device__ __forceinline__ const char* b_base(const MUnit& u, int seg) const { const int e = seg ? u.e1 : u.e0; return (const char*)(WD + ((size_t)e * 1024 + (size_t)u.pn * 256) * DE); }
    __device__ __forceinline__ void prefetch_rows(const MUnit&, const int (&)[2], PG8_LAS unsigned char*, int) const {}
    __device__ __forceinline__ void reload_offsets(const MUnit&, const int (&)[2], const int (&)[2], const PG8_LAS unsigned char*, int, int, unsigned (&)[2][2]) const {}
};
struct EpiGateUp2 {
    static constexpr bool PERM = true;
    bf16_t* ACT2; const u32x4* LIST;
    __device__ __forceinline__ void operator()(const f32x4 (&acc)[2][2][4][2], const MUnit& u, int wr, int wc, int fr, int fq) const {
        asm volatile("" : "+v"(fr), "+v"(fq));
        const int slot = u.pn >> 2, colA = slot * DE + (u.pn & 3) * HALF + wc * 32 + 8 * fq;
        const unsigned* lw = (const unsigned*)(LIST + u.lbase + wr * 64 + fr) + 1 + slot;
#pragma unroll
        for (int ai = 0; ai < 2; ++ai) {
            unsigned wv[4];
#pragma unroll
            for (int m = 0; m < 4; ++m) wv[m] = lw[(ai * HALF + m * 16) * 4];
#pragma unroll
            for (int m = 0; m < 4; ++m) { const int r = ai * HALF + wr * 64 + m * 16 + fr;
                const bool valid = r < u.nrows; const float cw = valid ? __uint_as_float(wv[m]) : 0.f;
                const f32x4 g0 = acc[ai][0][m][0], g1 = acc[ai][0][m][1], u0 = acc[ai][1][m][0], u1 = acc[ai][1][m][1];
                u32x4 w;
                w.x = cvt_pk_bf16(silu(g0[0]) * u0[0] * cw, silu(g0[1]) * u0[1] * cw); w.y = cvt_pk_bf16(silu(g0[2]) * u0[2] * cw, silu(g0[3]) * u0[3] * cw);
                w.z = cvt_pk_bf16(silu(g1[0]) * u1[0] * cw, silu(g1[1]) * u1[1] * cw); w.w = cvt_pk_bf16(silu(g1[2]) * u1[2] * cw, silu(g1[3]) * u1[3] * cw);
                if (!valid) w = (u32x4){0u, 0u, 0u, 0u};
                *(u32x4*)(ACT2 + ((size_t)u.pm * 256 + r) * 1024 + colA) = w; }
            asm volatile("" ::: "memory"); }
    }
};
struct EpiMoeOut {
    static constexpr bool PERM = false;
    float* lat; float* ctx; const float* modv; const u32x4* LIST;
    __device__ __forceinline__ void operator()(const f32x4 (&acc)[2][2][4][2], const MUnit& u, int wr, int wc, int fr, int fq) const {
        asm volatile("" : "+v"(fr), "+v"(fq));
        const int col0 = u.pn * BM + wc * 32 + 4 * fq;
        const unsigned* lw = (const unsigned*)(LIST + u.lbase + wr * 64 + fr);
        unsigned rv[2][4];
#pragma unroll
        for (int ai = 0; ai < 2; ++ai)
#pragma unroll
            for (int m = 0; m < 4; ++m) rv[ai][m] = lw[(ai * HALF + m * 16) * 4];
#pragma unroll
        for (int ai = 0; ai < 2; ++ai)
#pragma unroll
            for (int m = 0; m < 4; ++m) { const int r = ai * HALF + wr * 64 + m * 16 + fr;
                if (r < u.nrows) { const int row = (int)rv[ai][m]; bool is_ctx; const size_t off = stream_off(row, is_ctx);
                    float* d = (is_ctx ? ctx : lat) + off + col0; const float* ga = modv + (is_ctx ? 2 : row / PB) * 6144 + 5120 + col0;
#pragma unroll
                    for (int bj = 0; bj < 2; ++bj)
#pragma unroll
                        for (int n = 0; n < 2; ++n) { f32x4* p = (f32x4*)(d + bj * HALF + n * 16); *p = *p + *(const f32x4*)(ga + bj * HALF + n * 16) * acc[ai][bj][m][n]; } } }
    }
};

template <class Epi, class Sched, class Src>
__device__ __forceinline__ void gemm_phase_x(PG8_LAS unsigned char* lds, PG8_LAS unsigned char* rows, const Sched& S, const Src& X, const Epi& E, const int KB, const int nt) {
    const int tid = otid(), wid = __builtin_amdgcn_readfirstlane(tid >> 6), lane = tid & 63, wr = wid >> 2, wc = wid & 3, fr = lane & 15, fq = lane >> 4;
    int RA[2], CA[2]; unsigned voffB[2];
#pragma unroll
    for (int i = 0; i < 2; ++i) { int R, C; stage_rc(tid * 16 + i * 8192, R, C); const int Rb = Epi::PERM ? ((R & ~31) + perm32(R & 31)) : R; RA[i] = R; CA[i] = C; voffB[i] = (unsigned)(Rb * KB + C) * 2u; }
    const size_t kstep = (size_t)(BK * 2);
    const size_t hstepB = (size_t)HALF * KB * 2;
    const int half = nt >> 1;
    const unsigned ldsw = (unsigned)wid * 1024u;
    const int aoff = lds_byte(wr * 64 + fr, fq * 8), boff = lds_byte(wc * 32 + fr, fq * 8);
#define PG8_SA(b, h) (((b) * 2 + (h)) * HTB)
#define PG8_SB(b, h) ((4 + (b) * 2 + (h)) * HTB)
#define PG8_STAGE_B(bufoff, gbase) do { _Pragma("unroll") for (int _i = 0; _i < 2; ++_i) \
        __builtin_amdgcn_global_load_lds((const unsigned*)((const char*)(gbase) + voffB[_i]), (PG8_LAS unsigned*)(lds + (bufoff) + ldsw + _i * 8192), 16, 0, 0); } while (0)
#define PG8_STAGE_A(bufoff, gbase, o0, o1) do { \
        __builtin_amdgcn_global_load_lds((const unsigned*)((const char*)(gbase) + (o0)), (PG8_LAS unsigned*)(lds + (bufoff) + ldsw), 16, 0, 0); \
        __builtin_amdgcn_global_load_lds((const unsigned*)((const char*)(gbase) + (o1)), (PG8_LAS unsigned*)(lds + (bufoff) + ldsw + 8192), 16, 0, 0); } while (0)
#define PG8_LDA(dst, b, h) do { _Pragma("unroll") for (int m = 0; m < 4; ++m) _Pragma("unroll") for (int k = 0; k < 2; ++k) dst[m][k] = *(const PG8_LAS bf16x8*)(lds + PG8_SA(b, h) + aoff + m * 2048 + k * 1024); } while (0)
#define PG8_LDB(dst, b, h) do { _Pragma("unroll") for (int n = 0; n < 2; ++n) _Pragma("unroll") for (int k = 0; k < 2; ++k) dst[n][k] = *(const PG8_LAS bf16x8*)(lds + PG8_SB(b, h) + boff + n * 2048 + k * 1024); } while (0)
#define PG8_MMA(ai, bj, At, Bt) do { __builtin_amdgcn_s_setprio(1); _Pragma("unroll") for (int m = 0; m < 4; ++m) _Pragma("unroll") for (int n = 0; n < 2; ++n) _Pragma("unroll") for (int k = 0; k < 2; ++k) \
        acc[ai][bj][m][n] = __builtin_amdgcn_mfma_f32_16x16x32_bf16(Bt[n][k], At[m][k], acc[ai][bj][m][n], 0, 0, 0); __builtin_amdgcn_s_setprio(0); } while (0)
#define PG8_WAIT_V(n) asm volatile("s_waitcnt vmcnt(" #n ")" ::: "memory")
#define PG8_WAIT_L(n) asm volatile("s_waitcnt lgkmcnt(" #n ")" ::: "memory")
#define PG8_BAR __builtin_amdgcn_s_barrier()
#define PG8_SCHED __builtin_amdgcn_sched_barrier(0)
    MUnit cur, nxt; int ui = 0;
    if (!S.next(0, cur)) return;
    f32x4 acc[2][2][4][2];
#pragma unroll
    for (int a = 0; a < 2; ++a)
#pragma unroll
        for (int b = 0; b < 2; ++b)
#pragma unroll
            for (int m = 0; m < 4; ++m)
#pragma unroll
                for (int n = 0; n < 2; ++n) acc[a][b][m][n] = (f32x4){0.f, 0.f, 0.f, 0.f};
    bf16x8 At[4][2], B0[2][2], B1[2][2];
    unsigned aoc[2][2];
    X.a_offsets(cur, RA, CA, aoc);
    const char* cAb = X.a_base(cur); const char* cB0 = X.b_base(cur, 0); const char* cB1 = X.b_base(cur, 1);
    PG8_STAGE_B(PG8_SB(0, 0), cB0); PG8_STAGE_B(PG8_SB(0, 1), cB0 + hstepB); PG8_STAGE_A(PG8_SA(0, 0), cAb, aoc[0][0], aoc[0][1]); PG8_STAGE_A(PG8_SA(0, 1), cAb, aoc[1][0], aoc[1][1]);
    if (wr == 1) PG8_BAR;
    PG8_WAIT_V(2); PG8_BAR;
    PG8_STAGE_B(PG8_SB(1, 0), cB0 + kstep); PG8_STAGE_A(PG8_SA(1, 0), cAb + kstep, aoc[0][0], aoc[0][1]); PG8_STAGE_B(PG8_SB(1, 1), cB0 + hstepB + kstep);
    PG8_WAIT_V(6); PG8_BAR;
    for (;;) {
        const bool has_next = S.next(ui + 1, nxt);
        const char* nAb = cAb; const char* nB0 = cB0; const char* nB1 = cB1;
        if (has_next) { X.prefetch_rows(nxt, RA, rows, wid); nAb = X.a_base(nxt); nB0 = X.b_base(nxt, 0); nB1 = X.b_base(nxt, 1); }
        for (int t = 0; t < nt; t += 2) {
            const bool last = (t == nt - 2);
            const char* a1 = cAb + (size_t)(t + 1) * kstep;
            const int kt2 = t + 2;
            const char* b2 = last ? nB0 : (kt2 < half ? cB0 + (size_t)kt2 * kstep : cB1 + (size_t)(kt2 - half) * kstep);
            const char* a2 = last ? nAb : cAb + (size_t)kt2 * kstep;
            const char* a3 = a2 + kstep; const char* b3 = b2 + kstep;
            PG8_LDB(B0, 0, 0); PG8_LDB(B1, 0, 1); PG8_SCHED; PG8_LDA(At, 0, 0); PG8_STAGE_A(PG8_SA(1, 1), a1, aoc[1][0], aoc[1][1]);
            if (last && has_next) X.reload_offsets(nxt, RA, CA, rows, wid, lane, aoc);
            PG8_WAIT_V(8); PG8_WAIT_L(0); PG8_BAR; PG8_MMA(0, 0, At, B0); PG8_MMA(0, 1, At, B1); PG8_BAR; PG8_SCHED;
            PG8_LDA(At, 0, 1); PG8_STAGE_B(PG8_SB(0, 0), b2); PG8_STAGE_B(PG8_SB(0, 1), b2 + hstepB); PG8_STAGE_A(PG8_SA(0, 0), a2, aoc[0][0], aoc[0][1]);
            PG8_WAIT_V(8); PG8_WAIT_L(0); PG8_BAR; PG8_MMA(1, 0, At, B0); PG8_MMA(1, 1, At, B1); PG8_BAR; PG8_SCHED;
            PG8_LDB(B0, 1, 0); PG8_LDB(B1, 1, 1); PG8_SCHED; PG8_LDA(At, 1, 0); PG8_STAGE_A(PG8_SA(0, 1), a2, aoc[1][0], aoc[1][1]);
            PG8_WAIT_V(8); PG8_WAIT_L(0); PG8_BAR; PG8_MMA(0, 0, At, B0); PG8_MMA(0, 1, At, B1); PG8_BAR; PG8_SCHED;
            PG8_LDA(At, 1, 1); PG8_STAGE_B(PG8_SB(1, 0), b3); PG8_STAGE_B(PG8_SB(1, 1), b3 + hstepB); PG8_STAGE_A(PG8_SA(1, 0), a3, aoc[0][0], aoc[0][1]);
            PG8_WAIT_V(8); PG8_WAIT_L(0); PG8_BAR; PG8_MMA(1, 0, At, B0); PG8_MMA(1, 1, At, B1); PG8_BAR; PG8_SCHED;
        }
        if (wr == 0) PG8_BAR;
        E(acc, cur, wr, wc, fr, fq);
        if (!has_next) break;
#pragma unroll
        for (int a = 0; a < 2; ++a)
#pragma unroll
            for (int b = 0; b < 2; ++b)
#pragma unroll
                for (int m = 0; m < 4; ++m)
#pragma unroll
                    for (int n = 0; n < 2; ++n) acc[a][b][m][n] = (f32x4){0.f, 0.f, 0.f, 0.f};
        cur = nxt; cAb = nAb; cB0 = nB0; cB1 = nB1; ++ui;
        if (wr == 1) PG8_BAR;
    }
    PG8_WAIT_V(0);
    PG8_BAR;
#undef PG8_SA
#undef PG8_SB
#undef PG8_STAGE_A
#undef PG8_STAGE_B
#undef PG8_LDA
#undef PG8_LDB
#undef PG8_MMA
#undef PG8_WAIT_V
#undef PG8_WAIT_L
#undef PG8_BAR
#undef PG8_SCHED
}
}

constexpr int TT_OFF = 132096;
constexpr int ROWS_OFF = 134144;

#define XB_TMO      128
#define XB_XCNT(j)  (256  + 64 * (j))
#define XB_XSUB(j)  (1280 + 64 * (j))
#define XB_XGEN(j)  (2304 + 64 * (j))
#define XB_TOP      3328
#define XB_TOPGEN   3392
#define XCD_BAR_WORDS 3456
#define XB_SPIN_CAP (1u << 18)

__device__ __forceinline__ unsigned xb_ld(unsigned* p)              { return __hip_atomic_load(p, __ATOMIC_RELAXED, __HIP_MEMORY_SCOPE_AGENT); }
__device__ __forceinline__ unsigned xb_add(unsigned* p, unsigned v) { return __hip_atomic_fetch_add(p, v, __ATOMIC_RELAXED, __HIP_MEMORY_SCOPE_AGENT); }
__device__ __forceinline__ unsigned xb_xcc_id() { return (unsigned)__builtin_amdgcn_s_getreg((3 << 11) | 20) & 0xFu; }
#define XB_SPIN(cond, bar) do { unsigned _sp = 0; while (cond) { __builtin_amdgcn_s_sleep(1); \
    if ((++_sp & 255u) == 0u) { if (xb_ld(&(bar)[XB_TMO])) break; if (_sp > XB_SPIN_CAP) { atomicAdd(&(bar)[XB_TMO], 1u); break; } } } } while (0)

struct XcdBarrier {
    unsigned* bar; unsigned x;
    volatile LAS unsigned* st;
};

__device__ __forceinline__ XcdBarrier xcd_barrier_post(unsigned* bar, volatile LAS unsigned* st) {
    XcdBarrier b; b.bar = bar; b.x = xb_xcc_id(); b.st = st;
    if (threadIdx.x == 0) (void)xb_add(&bar[XB_XCNT(b.x)], 1u);
    return b;
}
__device__ __forceinline__ void xcd_barrier_complete(unsigned* bar, unsigned x, unsigned& nloc, unsigned& nx) {
    const unsigned G = gridDim.x * gridDim.y * gridDim.z;
    unsigned sum, cnt, mine, sp = 0u;
    for (;;) {
        sum = 0u; cnt = 0u; mine = 0u;
#pragma unroll
        for (unsigned j = 0; j < 16; ++j) { const unsigned c = xb_ld(&bar[XB_XCNT(j)]); sum += c; cnt += (c > 0u) ? 1u : 0u; mine = (j == x) ? c : mine; }
        if (sum == G) break;
        __builtin_amdgcn_s_sleep(1);
        if ((++sp & 255u) == 0u) { if (xb_ld(&bar[XB_TMO])) break; if (sp > XB_SPIN_CAP) { atomicAdd(&bar[XB_TMO], 1u); break; } }
    }
    nloc = mine > 0u ? mine : 1u; nx = cnt > 0u ? cnt : 1u;
}

__device__ __forceinline__ void xcd_barrier(const XcdBarrier& b) {
    asm volatile("s_waitcnt vmcnt(0)" ::: "memory");
    __syncthreads();
    if (threadIdx.x == 0) {
        unsigned* bar = b.bar;
        __builtin_amdgcn_s_waitcnt(0);
        unsigned nloc = b.st[0], nx = b.st[1];
        if (nloc == 0u) { xcd_barrier_complete(bar, b.x, nloc, nx); b.st[0] = nloc; b.st[1] = nx; }
        const unsigned old = xb_add(&bar[XB_XSUB(b.x)], 1u);
        const unsigned gen = old / nloc;
        if (old + 1u == (gen + 1u) * nloc) {
            __builtin_amdgcn_fence(__ATOMIC_RELEASE, "agent");
            asm volatile("s_waitcnt vmcnt(0)" ::: "memory");
            const unsigned og = xb_add(&bar[XB_TOP], 1u);
            const unsigned tg = og / nx;
            if (og + 1u == (tg + 1u) * nx) xb_add(&bar[XB_TOPGEN], 1u);
            else XB_SPIN(xb_ld(&bar[XB_TOPGEN]) == tg, bar);
            __builtin_amdgcn_fence(__ATOMIC_ACQUIRE, "agent");
            xb_add(&bar[XB_XGEN(b.x)], 1u);
            asm volatile("s_waitcnt vmcnt(0)" ::: "memory");
        } else {
            XB_SPIN(xb_ld(&bar[XB_XGEN(b.x)]) == gen, bar);
            __builtin_amdgcn_fence(__ATOMIC_ACQUIRE, "agent");
            asm volatile("s_waitcnt vmcnt(0)" ::: "memory");
        }
    }
    __syncthreads();
}

constexpr int LDS_BYTES = 147456;
constexpr int LDSCTL_OFF = 131072, MISC_OFF = LDSCTL_OFF + 320;
constexpr int CW_BAR = 4096;
constexpr int NPHASE = 1 + 9 * DEPTH;
#ifndef MK_SPLIT
#define MK_SPLIT 0
#endif
struct Args {
    const float *x, *c, *ctx, *c_ctx, *w_mod, *b_mod, *norm1_g, *norm2_g, *w_in, *w_out, *hgrn_lb, *hgrn_norm_g, *pool_w, *pool_scale, *q_norm_g, *k_norm_g, *router_w, *router_b, *moe_gate, *moe_up, *moe_down;
    float* out; unsigned char* ws; int ph_lo, ph_hi;
};
typedef const __attribute__((address_space(4))) Args* KArgs;
__device__ __forceinline__ KArgs kargs() { KArgs p = (KArgs)__builtin_amdgcn_kernarg_segment_ptr(); asm volatile("" : "+s"(p)); return p; }
__global__ void __launch_bounds__(512, 2) mega_fwd(Args A_unused) {
    extern __shared__ __attribute__((aligned(16))) unsigned char lds[];
    for (int u = otid(); u < (LDS_BYTES - LDSCTL_OFF) / 4; u += 512) ((LAS unsigned*)((LAS unsigned char*)lds + LDSCTL_OFF))[u] = 0u;
    __syncthreads();
    XcdBarrier bar;
    { KArgs ap = kargs(); unsigned* CTL = (unsigned*)(ap->ws + WS_CTL); bar.bar = CTL + CW_BAR; bar.x = 0; bar.st = nullptr;
      if (!MK_SPLIT) bar = xcd_barrier_post(CTL + CW_BAR, (volatile LAS unsigned*)((LAS unsigned char*)lds + MISC_OFF) + 8); }
    int lo, hi; { KArgs ap = kargs(); lo = ap->ph_lo; hi = ap->ph_hi; }
#ifndef PHMASK
#define PHMASK 0x3ff
#endif
#define IN(k) (lo <= (k) && (k) < hi)
#define SEAM(k) do { if (!MK_SPLIT && IN((k) + 1)) xcd_barrier(bar); } while (0)
#define GCU const int G = (int)gridDim.x, cu = (int)blockIdx.x
#ifndef DUPMASK
#define DUPMASK 0
#endif
    LAS unsigned char* ldsl = (LAS unsigned char*)lds;
    if ((PHMASK & 0x200) && IN(0)) {
        _Pragma("unroll") for (int rep_ = 0; rep_ < ((((DUPMASK) & (0x200)) && true) ? 2 : 1); ++rep_) {
        KArgs ap = kargs(); unsigned char* ws = ap->ws; GCU;
        ProArgs pa; pa.c = ap->c; pa.c_ctx = ap->c_ctx; pa.w_mod = ap->w_mod; pa.b_mod = ap->b_mod; pa.hgrn_lb = ap->hgrn_lb; pa.qg = ap->q_norm_g; pa.kg = ap->k_norm_g; pa.w_in = ap->w_in; pa.w_out = ap->w_out; pa.pool_w = ap->pool_w;
        pa.gate = ap->moe_gate; pa.up = ap->moe_up; pa.down = ap->moe_down; pa.MODV = (float*)(ws + WS_MODV); pa.LBF = (float*)(ws + WS_LBF); pa.REF = (float*)(ws + WS_REF); pa.COS = (float*)(ws + WS_COS); pa.SIN = (float*)(ws + WS_SIN);
        pa.WIN = (bf16_t*)(ws + WS_WIN); pa.WOUT = (bf16_t*)(ws + WS_WOUT); pa.POOLWT = (bf16_t*)(ws + WS_POOLWT); pa.WGU = (bf16_t*)(ws + WS_WGU); pa.WD = (bf16_t*)(ws + WS_WD);
        prologue_phase(lds, pa, cu, G);
            if (rep_ + 1 < ((((DUPMASK) & (0x200)) && true) ? 2 : 1)) xcd_barrier(bar); }
        SEAM(0);
    }
    for (int l = 0; l < DEPTH; ++l) {
        const int pb = 1 + 9 * l;
        if ((PHMASK & 1) && IN(pb + 0)) {
        _Pragma("unroll") for (int rep_ = 0; rep_ < ((((DUPMASK) & (1)) && true) ? 2 : 1); ++rep_) {
            KArgs ap = kargs(); unsigned char* ws = ap->ws; GCU;
            const float* slat = (l == 0) ? ap->x : ap->out; const float* sctx = (l == 0) ? ap->ctx : (const float*)(ws + WS_XC);
            norm1_phase(cu, G, slat, sctx, ap->norm1_g + l * D, (const float*)(ws + WS_MODV) + (size_t)l * 3 * 6144, 0, (bf16_t*)(ws + WS_XN));
            if (rep_ + 1 < ((((DUPMASK) & (1)) && true) ? 2 : 1)) xcd_barrier(bar); }
            SEAM(pb + 0);
        }
        if ((PHMASK & 2) && IN(pb + 1)) {
        _Pragma("unroll") for (int rep_ = 0; rep_ < ((((DUPMASK) & (2)) && true) ? 2 : 1); ++rep_) {
            KArgs ap = kargs(); unsigned char* ws = ap->ws; GCU;
            pg8::Gemm g; g.A = (const bf16_t*)(ws + WS_XN); g.Bt = (const bf16_t*)(ws + WS_WIN) + (size_t)l * NIN * D; g.M = MT; g.N = NIN; g.K = D; g.pad = 0;
            pg8::StaticOrder S; S.init(MT, NIN, G, cu);
            pg8::EpiBf16<0> E; E.O = (bf16_t*)(ws + WS_PROJ); E.ldc = NIN; E.bias = nullptr; E.split_cols = 0; E.split_stride = 0; E.scale0 = 1.f;
            pg8::gemm_phase<pg8::EpiBf16<0>, pg8::StaticOrder, true, true>(ldsl, g, S, E);
            { KArgs aq = kargs(); if (l == 0) moe_filler(lds, aq->moe_gate, aq->moe_up, aq->moe_down, aq->ws, 0, 0, 5530, (MT / 256) * (NIN / 256), G, cu);
              else moe_filler(lds, aq->moe_gate, aq->moe_up, aq->moe_down, aq->ws, 1, 7986, MOE_ITEMS, (MT / 256) * (NIN / 256), G, cu); }
            if (rep_ + 1 < ((((DUPMASK) & (2)) && true) ? 2 : 1)) xcd_barrier(bar); }
            SEAM(pb + 1);
        }
        if ((PHMASK & 4) && IN(pb + 2)) {
        _Pragma("unroll") for (int rep_ = 0; rep_ < ((((DUPMASK) & (4)) && true) ? 2 : 1); ++rep_) {
            KArgs ap = kargs(); unsigned char* ws = ap->ws; GCU;
            const bf16_t* PROJ = (const bf16_t*)(ws + WS_PROJ);
            post_phase(cu, G, PROJ, ap->q_norm_g + l * 64, ap->k_norm_g + l * 64, (const float*)(ws + WS_COS), (const float*)(ws + WS_SIN), ws + WS_Q8, ws + WS_K8, ws + WS_VT8);
            pool::pool_phase(lds, PROJ, (const bf16_t*)(ws + WS_POOLWT) + (size_t)l * 4 * 4096, ap->pool_scale + l * 256, (bf16_t*)(ws + WS_MIX), cu, G);
            hg::h1_phase(lds, PROJ, (const float*)(ws + WS_LBF) + l * 512, (bf16_t*)(ws + WS_UT), (float*)(ws + WS_DEC), cu, G);
            if (rep_ + 1 < ((((DUPMASK) & (4)) && true) ? 2 : 1)) xcd_barrier(bar); }
            SEAM(pb + 2);
        }
        if ((PHMASK & 8) && IN(pb + 3)) {
        _Pragma("unroll") for (int rep_ = 0; rep_ < ((((DUPMASK) & (8)) && true) ? 2 : 1); ++rep_) {
            KArgs ap = kargs(); unsigned char* ws = ap->ws; GCU; hg::h2_phase(lds, (const bf16_t*)(ws + WS_UT), (const float*)(ws + WS_DEC), (bf16_t*)(ws + WS_ST), cu, G);
            if (rep_ + 1 < ((((DUPMASK) & (8)) && true) ? 2 : 1)) xcd_barrier(bar); }
            SEAM(pb + 3);
        }
        if ((PHMASK & 16) && IN(pb + 4)) {
        _Pragma("unroll") for (int rep_ = 0; rep_ < ((((DUPMASK) & (16)) && true) ? 2 : 1); ++rep_) {
            { KArgs ap = kargs(); unsigned char* ws = ap->ws; GCU;
              attn_phase((char*)lds, ws + WS_Q8, ws + WS_K8, ws + WS_VT8, (bf16_t*)(ws + WS_MIX), ((const float*)(ws + WS_REF))[l * 64], vcu_of(cu, G), G, true); }
            { KArgs ap = kargs(); unsigned char* ws = ap->ws; GCU;
              hg::h3_phase(lds, (const bf16_t*)(ws + WS_PROJ), (const float*)(ws + WS_LBF) + l * 512, (const bf16_t*)(ws + WS_ST), ap->hgrn_norm_g + l * 64, (bf16_t*)(ws + WS_MIX), cu, G); }
            if (rep_ + 1 < ((((DUPMASK) & (16)) && true) ? 2 : 1)) xcd_barrier(bar); }
            SEAM(pb + 4);
        }
        if ((PHMASK & 32) && IN(pb + 5)) {
        _Pragma("unroll") for (int rep_ = 0; rep_ < ((((DUPMASK) & (32)) && (l == 0)) ? 2 : 1); ++rep_) {
            KArgs ap = kargs(); unsigned char* ws = ap->ws; GCU;
            pg8::Gemm g; g.A = (const bf16_t*)(ws + WS_MIX); g.Bt = (const bf16_t*)(ws + WS_WOUT) + (size_t)l * D * D; g.M = MT; g.N = D; g.K = D; g.pad = 0;
            pg8::OutOrder S; S.lat_only = (l == DEPTH - 1); S.init(S.lat_only ? BATCH * SEQ : MT, D, G, cu);
            pg8::EpiResid E; E.src_lat = (l == 0) ? ap->x : ap->out; E.src_ctx = (l == 0) ? ap->ctx : (const float*)(ws + WS_XC); E.dst_lat = ap->out; E.dst_ctx = (float*)(ws + WS_XC);
            E.modv = (const float*)(ws + WS_MODV) + (size_t)l * 3 * 6144; E.ga_off = 2048; E.pad = 0;
            pg8::gemm_phase<pg8::EpiResid, pg8::OutOrder, true, true>(ldsl, g, S, E);
            if (l == 0) { KArgs aq = kargs(); moe_filler(lds, aq->moe_gate, aq->moe_up, aq->moe_down, aq->ws, 0, 5530, MOE_ITEMS, (MT / 256) * (D / 256), G, cu); }
            if (rep_ + 1 < ((((DUPMASK) & (32)) && (l == 0)) ? 2 : 1)) xcd_barrier(bar); }
            SEAM(pb + 5);
        }
        if ((PHMASK & 64) && IN(pb + 6)) {
        _Pragma("unroll") for (int rep_ = 0; rep_ < ((((DUPMASK) & (64)) && true) ? 2 : 1); ++rep_) {
            KArgs ap = kargs(); unsigned char* ws = ap->ws; GCU;
            norm2_router_phase(lds, cu, G, ap->out, (const float*)(ws + WS_XC), ap->norm2_g + l * D, (const float*)(ws + WS_MODV) + (size_t)l * 3 * 6144, 3072, ap->router_w, ap->router_b, (bf16_t*)(ws + WS_XN),
                               (unsigned*)(ws + WS_CTL) + CW_CNT + 64 * l + 32 * rep_, (u32x4*)(ws + WS_LIST), l == 0 ? 1 : 0);
            if (rep_ + 1 < ((((DUPMASK) & (64)) && true) ? 2 : 1)) xcd_barrier(bar); }
            SEAM(pb + 6);
        }
        if ((PHMASK & 128) && IN(pb + 7)) {
        _Pragma("unroll") for (int rep_ = 0; rep_ < ((((DUPMASK) & (128)) && true) ? 2 : 1); ++rep_) {
            KArgs ap = kargs(); unsigned char* ws = ap->ws; GCU;
            LAS int* TT = (LAS int*)(ldsl + TT_OFF);
            pg8::build_tiles(TT, (const unsigned*)(ws + WS_CTL) + CW_CNT + 64 * l);
            pg8::MoeOrder<8> S; S.TT = TT; S.G = G; S.c = vcu_of(cu, G);
            pg8::Src1 X; X.XN = (const bf16_t*)(ws + WS_XN); X.WGU = (const bf16_t*)(ws + (l ? WS_WGU1 : WS_WGU)); X.LIST = (const u32x4*)(ws + WS_LIST); pg8::EpiGateUp2 E; E.ACT2 = (bf16_t*)(ws + WS_ACT2); E.LIST = X.LIST;
            pg8::gemm_phase_x(ldsl, ldsl + ROWS_OFF, S, X, E, D, D / 64);
            if (l == 0) { KArgs aq = kargs(); const int U = TT[0] * 8; moe_filler(lds, aq->moe_gate, aq->moe_up, aq->moe_down, aq->ws, 1, 0, 3686, U, G, vcu_of(cu, G)); }
            if (rep_ + 1 < ((((DUPMASK) & (128)) && true) ? 2 : 1)) xcd_barrier(bar); }
            SEAM(pb + 7);
        }
        if ((PHMASK & 256) && IN(pb + 8)) {
        _Pragma("unroll") for (int rep_ = 0; rep_ < ((((DUPMASK) & (256)) && true) ? 2 : 1); ++rep_) {
            KArgs ap = kargs(); unsigned char* ws = ap->ws; GCU;
            LAS int* TT = (LAS int*)(ldsl + TT_OFF);
            pg8::build_tiles(TT, (const unsigned*)(ws + WS_CTL) + CW_CNT + 64 * l);
            pg8::MoeOrder<4> S; S.TT = TT; S.G = G; S.c = vcu_of(cu, G);
            pg8::Src2 X; X.ACT2 = (const bf16_t*)(ws + WS_ACT2); X.WD = (const bf16_t*)(ws + (l ? WS_WD1 : WS_WD));
            pg8::EpiMoeOut E; E.lat = ap->out; E.ctx = (float*)(ws + WS_XC); E.modv = (const float*)(ws + WS_MODV) + (size_t)l * 3 * 6144; E.LIST = (const u32x4*)(ws + WS_LIST);
            pg8::gemm_phase_x(ldsl, ldsl + ROWS_OFF, S, X, E, DE, 1024 / 64);
            if (l == 0) { KArgs aq = kargs(); const int U = TT[0] * 4; moe_filler(lds, aq->moe_gate, aq->moe_up, aq->moe_down, aq->ws, 1, 3686, 7986, U, G, vcu_of(cu, G)); }
            if (rep_ + 1 < ((((DUPMASK) & (256)) && true) ? 2 : 1)) xcd_barrier(bar); }
            SEAM(pb + 8);
        }
    }
#undef IN
#undef SEAM
#undef GCU
}

extern "C" void kernel_launch(void* const* d_in, const int* in_sizes, int n_in, void* d_out, int out_size, void* d_ws, size_t ws_size, hipStream_t stream) {
    static int grid = 0;
    if (grid == 0) {
        if (n_in != 21 || in_sizes[0] != BATCH * SEQ * D || out_size != BATCH * SEQ * D || ws_size < WS_END) {
            fprintf(stderr, "kernel_launch: unexpected sizes: n_in %d in0 %d out %d ws %zu (need %zu)\n", n_in, n_in > 0 ? in_sizes[0] : -1, out_size, ws_size, (size_t)WS_END); grid = -1; return; }
        int dev = 0, cus = 0, per_cu = 0;
        if (hipGetDevice(&dev) != hipSuccess || hipDeviceGetAttribute(&cus, hipDeviceAttributeMultiprocessorCount, dev) != hipSuccess) { grid = -1; return; }
        if (hipFuncSetAttribute((const void*)mega_fwd, hipFuncAttributeMaxDynamicSharedMemorySize, LDS_BYTES) != hipSuccess) { fprintf(stderr, "kernel_launch: hipFuncSetAttribute failed\n"); grid = -1; return; }
        if (hipOccupancyMaxActiveBlocksPerMultiprocessor(&per_cu, (const void*)mega_fwd, 512, LDS_BYTES) != hipSuccess || per_cu < 1) fprintf(stderr, "kernel_launch: occupancy query reports %d\n", per_cu);
        (void)hipGetLastError();
        grid = cus;
    }
    if (grid < 0) return;
    if (hipMemsetAsync((char*)d_ws + WS_CTL, 0, 1 * MiB, stream) != hipSuccess) return;
    Args a; memset((void*)&a, 0, sizeof(a));
    a.x = (const float*)d_in[0]; a.c = (const float*)d_in[1]; a.ctx = (const float*)d_in[2]; a.c_ctx = (const float*)d_in[3]; a.w_mod = (const float*)d_in[4]; a.b_mod = (const float*)d_in[5];
    a.norm1_g = (const float*)d_in[6]; a.norm2_g = (const float*)d_in[7]; a.w_in = (const float*)d_in[8]; a.w_out = (const float*)d_in[9]; a.hgrn_lb = (const float*)d_in[10]; a.hgrn_norm_g = (const float*)d_in[11];
    a.pool_w = (const float*)d_in[12]; a.pool_scale = (const float*)d_in[13]; a.q_norm_g = (const float*)d_in[14]; a.k_norm_g = (const float*)d_in[15]; a.router_w = (const float*)d_in[16]; a.router_b = (const float*)d_in[17];
    a.moe_gate = (const float*)d_in[18]; a.moe_up = (const float*)d_in[19]; a.moe_down = (const float*)d_in[20];
    a.out = (float*)d_out; a.ws = (unsigned char*)d_ws;
#if MK_SPLIT
    for (int ph = 0; ph < NPHASE; ++ph) { a.ph_lo = ph; a.ph_hi = ph + 1; hipLaunchKernelGGL(mega_fwd, dim3(grid), dim3(512), LDS_BYTES, stream, a); }
#else
    a.ph_lo = 0; a.ph_hi = NPHASE; hipLaunchKernelGGL(mega_fwd, dim3(grid), dim3(512), LDS_BYTES, stream, a);
#endif
}
```

```cpp
#include <hip/hip_runtime.h>
#include <cstdio>
#include <cstdint>
#include <cstring>

namespace cfg {
constexpr int D = 1024, BATCH = 2, SEQ = 8192, CTXL = 256, DEPTH = 2;
constexpr int PB = SEQ + CTXL;
constexpr int MT = BATCH * PB;
constexpr int TPB = PB / 256;
constexpr int NIN = 2304;
constexpr int NE = 16, DE = 512;
constexpr int C_AQ = 0, C_AFF = 256, C_AFB = 512, C_AI = 768, C_AG = 1024, C_BP = 1280, C_CQ = 1536, C_CK = 2048, C_CV = 2176;
constexpr float EPS = 1e-6f;
constexpr float C2 = 0.125f * 1.4426950408889634f;
}

__device__ __forceinline__ int otid() { int t = threadIdx.x; asm volatile("" : "+v"(t)); return t; }

namespace pg8 {
#define PG8_LAS __attribute__((address_space(3)))
typedef unsigned short bf16_t;
typedef short bf16x8 __attribute__((ext_vector_type(8)));
typedef float f32x4 __attribute__((ext_vector_type(4)));
typedef unsigned u32x4 __attribute__((ext_vector_type(4)));
constexpr int BM = 256, BK = 64, HALF = 128, HTB = HALF * BK * 2  , STAGE_BYTES = 8 * HTB, NXCD = 8, WGM = 8;

__host__ __device__ __forceinline__ int lds_byte(int r, int c) { const int st = (r >> 4) * 2 + (c >> 5), rr = r & 15, cc = c & 31, ob = rr * 64 + cc * 2; return st * 1024 + (ob ^ (((ob >> 9) & 1) << 5)); }
__host__ __device__ __forceinline__ void stage_rc(int b, int& R, int& C) { const int st = b / 1024, sb = b % 1024, swz = sb ^ (((sb >> 9) & 1) << 5); R = (st >> 1) * 16 + swz / 64; C = (st & 1) * 32 + (swz % 64) / 2; }
__host__ __device__ __forceinline__ int perm32(int rho) { const int n = rho >> 4, i = rho & 15; return 8 * (i >> 2) + 4 * n + (i & 3); }

struct Unit { int pm, pn; };
struct Gemm { const bf16_t* A; const bf16_t* Bt; int M, N, K, pad; };

struct StaticOrder {
    int nM, nN, nwg, G, c;
    __host__ __device__ void init(int M, int N, int G_, int c_) { nM = M / BM; nN = N / BM; nwg = nM * nN; G = G_; c = c_; }
    __host__ __device__ bool next(int i, Unit& u) const {
        const long L = (long)i * G + c; if (L >= nwg) return false;
        int wgid = (int)L; { const int q = nwg / NXCD, r = nwg % NXCD, xcd = wgid % NXCD, off = wgid / NXCD; wgid = (xcd < r ? xcd * (q + 1) : r * (q + 1) + (xcd - r) * q) + off; }
        const int nig = WGM * nN, gid = wgid / nig, fm = gid * WGM, gsz = (nM - fm) < WGM ? (nM - fm) : WGM;
        u.pm = fm + ((wgid % nig) % gsz); u.pn = (wgid % nig) / gsz; return true;
    }
    __device__ __forceinline__ void a_ready(const Unit&) const {}
    __device__ __forceinline__ void done(const Unit&) const {}
};

__device__ __forceinline__ unsigned cvt_pk_bf16(float lo, float hi) { unsigned r; asm volatile("v_cvt_pk_bf16_f32 %0, %1, %2" : "=v"(r) : "v"(lo), "v"(hi)); return r; }
typedef float f32x2 __attribute__((ext_vector_type(2)));
__device__ __forceinline__ f32x2 gelu_pk(f32x2 v) {
    const f32x2 av = __builtin_elementwise_abs(v), d = av * 0.2316418882f + 1.0f;
    f32x2 t; t.x = __builtin_amdgcn_rcpf(d.x); t.y = __builtin_amdgcn_rcpf(d.y);
    f32x2 q = t * 0.5307027145f + (-0.7265760135f); q = q * t + 0.7107068705f; q = q * t + (-0.142248368f); q = q * t + 0.127414796f; q = q * t;
    const f32x2 s = (v * v) * (-0.72134752044f);
    f32x2 e; e.x = __builtin_amdgcn_exp2f(s.x); e.y = __builtin_amdgcn_exp2f(s.y);
    const f32x2 m = v * (q * e), r = v - m;
    f32x2 o; o.x = v.x < 0.f ? m.x : r.x; o.y = v.y < 0.f ? m.y : r.y; return o;
}

template <int ACT  > struct EpiBf16 {
    static constexpr bool PERM = true, AFTER_DRAIN = false; static_assert(ACT == 0 || ACT == 1, "EpiBf16: ACT is 0 (none) or 1 (gelu_pk)");
    bf16_t* O; int ldc; const float* bias; int split_cols; size_t split_stride; float scale0;
    __device__ __forceinline__ void operator()(const f32x4 (&acc)[2][2][4][2], const Unit& u, int wr, int wc, int fr, int fq) const {
        asm volatile("" : "+v"(fr), "+v"(fq));
        const int row0 = u.pm * BM + wr * 64 + fr; int colt = u.pn * BM; bf16_t* base = O;
        float sc = 1.f; if (split_cols) { const int t = colt / split_cols; base += (size_t)t * split_stride; colt -= t * split_cols; if (t == 0) sc = scale0; }
        const int col0 = colt + wc * 32 + 8 * fq, bcol0 = u.pn * BM + wc * 32 + 8 * fq;
        f32x4 bv[2][2];
#pragma unroll
        for (int bj = 0; bj < 2; ++bj)
#pragma unroll
            for (int n = 0; n < 2; ++n) bv[bj][n] = bias ? *(const f32x4*)(bias + bcol0 + bj * HALF + 4 * n) : (f32x4){0.f, 0.f, 0.f, 0.f};
#pragma unroll
        for (int ai = 0; ai < 2; ++ai)
#pragma unroll
            for (int m = 0; m < 4; ++m) { bf16_t* rowp = base + (size_t)(row0 + ai * HALF + m * 16) * ldc + col0;
#pragma unroll
                for (int bj = 0; bj < 2; ++bj) { f32x4 v0 = acc[ai][bj][m][0] + bv[bj][0], v1 = acc[ai][bj][m][1] + bv[bj][1];
                    if (ACT == 1) { f32x2 a = gelu_pk((f32x2){v0[0], v0[1]}), b = gelu_pk((f32x2){v0[2], v0[3]}), c = gelu_pk((f32x2){v1[0], v1[1]}), d = gelu_pk((f32x2){v1[2], v1[3]});
                        v0 = (f32x4){a.x, a.y, b.x, b.y}; v1 = (f32x4){c.x, c.y, d.x, d.y}; }
                    v0 = v0 * sc; v1 = v1 * sc; u32x4 w; w.x = cvt_pk_bf16(v0[0], v0[1]); w.y = cvt_pk_bf16(v0[2], v0[3]); w.z = cvt_pk_bf16(v1[0], v1[1]); w.w = cvt_pk_bf16(v1[2], v1[3]);
                    *(u32x4*)(rowp + bj * HALF) = w; } }
    }
};

template <class Epi, class Sched, bool ALIGN_EPI = false, bool SP2 = false>
__device__ __forceinline__ void gemm_phase(PG8_LAS unsigned char* lds, const Gemm g, const Sched& S, const Epi& E) {
    const int tid = otid(), wid = __builtin_amdgcn_readfirstlane(tid >> 6), lane = tid & 63, wr = wid >> 2, wc = wid & 3, fr = lane & 15, fq = lane >> 4;
    const int K = g.K, nt = K / BK;
    unsigned voffA[2], voffB[2];
#pragma unroll
    for (int i = 0; i < 2; ++i) { int R, C; stage_rc(tid * 16 + i * 8192, R, C); const int Rb = Epi::PERM ? ((R & ~31) + perm32(R & 31)) : R;
        voffA[i] = (unsigned)(R * K + C) * 2u; voffB[i] = (unsigned)(Rb * K + C) * 2u; }
    const size_t kstep = (size_t)(BK * 2);
    const size_t hstep = (size_t)HALF * K * 2;
    const size_t tstep = 2 * hstep;
    const unsigned ldsw = (unsigned)wid * 1024u;
    const int aoff = lds_byte(wr * 64 + fr, fq * 8), boff = lds_byte(wc * 32 + fr, fq * 8);
#define PG8_SA(b, h) (((b) * 2 + (h)) * HTB)
#define PG8_SB(b, h) ((4 + (b) * 2 + (h)) * HTB)
#define PG8_STAGE(bufoff, gbase, voff) do { _Pragma("unroll") for (int _i = 0; _i < 2; ++_i) \
        __builtin_amdgcn_global_load_lds((const unsigned*)((const char*)(gbase) + (voff)[_i]), (PG8_LAS unsigned*)(lds + (bufoff) + ldsw + _i * 8192), 16, 0, 0); } while (0)
#define PG8_LDA(dst, b, h) do { _Pragma("unroll") for (int m = 0; m < 4; ++m) _Pragma("unroll") for (int k = 0; k < 2; ++k) dst[m][k] = *(const PG8_LAS bf16x8*)(lds + PG8_SA(b, h) + aoff + m * 2048 + k * 1024); } while (0)
#define PG8_LDB(dst, b, h) do { _Pragma("unroll") for (int n = 0; n < 2; ++n) _Pragma("unroll") for (int k = 0; k < 2; ++k) dst[n][k] = *(const PG8_LAS bf16x8*)(lds + PG8_SB(b, h) + boff + n * 2048 + k * 1024); } while (0)
#define PG8_MMA(ai, bj, At, Bt) do { __builtin_amdgcn_s_setprio(1); _Pragma("unroll") for (int m = 0; m < 4; ++m) _Pragma("unroll") for (int n = 0; n < 2; ++n) _Pragma("unroll") for (int k = 0; k < 2; ++k) \
        acc[ai][bj][m][n] = __builtin_amdgcn_mfma_f32_16x16x32_bf16(Bt[n][k], At[m][k], acc[ai][bj][m][n], 0, 0, 0); __builtin_amdgcn_s_setprio(0); } while (0)
#define PG8_WAIT_V(n) asm volatile("s_waitcnt vmcnt(" #n ")" ::: "memory")
#define PG8_WAIT_L(n) asm volatile("s_waitcnt lgkmcnt(" #n ")" ::: "memory")
#define PG8_BAR __builtin_amdgcn_s_barrier()
#define PG8_SCHED __builtin_amdgcn_sched_barrier(0)
    Unit cur, nxt; int ui = 0;
    if (!S.next(0, cur)) return;
    f32x4 acc[2][2][4][2];
#pragma unroll
    for (int a = 0; a < 2; ++a)
#pragma unroll
        for (int b = 0; b < 2; ++b)
#pragma unroll
            for (int m = 0; m < 4; ++m)
#pragma unroll
                for (int n = 0; n < 2; ++n) acc[a][b][m][n] = (f32x4){0.f, 0.f, 0.f, 0.f};
    bf16x8 At[4][2], B0[2][2], B1[2][2];
    const char* cA = (const char*)g.A + (size_t)cur.pm * tstep; const char* cB = (const char*)g.Bt + (size_t)cur.pn * tstep;
    S.a_ready(cur);
    if constexpr (SP2) {
        PG8_STAGE(PG8_SB(0, 0), cB, voffB); PG8_STAGE(PG8_SB(0, 1), cB + hstep, voffB); PG8_STAGE(PG8_SA(0, 0), cA, voffA); PG8_STAGE(PG8_SA(0, 1), cA + hstep, voffA);
        if (wr == 1) PG8_BAR;
        PG8_WAIT_V(2); PG8_BAR;
        PG8_STAGE(PG8_SB(1, 0), cB + kstep, voffB); PG8_STAGE(PG8_SA(1, 0), cA + kstep, voffA); PG8_STAGE(PG8_SB(1, 1), cB + hstep + kstep, voffB);
        PG8_WAIT_V(6); PG8_BAR;
    } else {
        PG8_STAGE(PG8_SB(0, 0), cB, voffB); PG8_STAGE(PG8_SA(0, 0), cA, voffA); PG8_STAGE(PG8_SB(0, 1), cB + hstep, voffB); PG8_STAGE(PG8_SA(0, 1), cA + hstep, voffA);
        if (wr == 1) PG8_BAR;
        PG8_WAIT_V(4); PG8_BAR;
        PG8_STAGE(PG8_SB(1, 0), cB + kstep, voffB); PG8_STAGE(PG8_SA(1, 0), cA + kstep, voffA); PG8_STAGE(PG8_SB(1, 1), cB + hstep + kstep, voffB);
        PG8_WAIT_V(6); PG8_BAR;
    }
    for (;;) {
        const bool has_next = S.next(ui + 1, nxt);
        const char* nA = has_next ? (const char*)g.A + (size_t)nxt.pm * tstep : cA; const char* nB = has_next ? (const char*)g.Bt + (size_t)nxt.pn * tstep : cB;
        for (int t = 0; t < nt; t += 2) {
            const bool last = (t == nt - 2);
            const char* a1 = cA + (size_t)(t + 1) * kstep;
            const char* a2 = last ? nA : cA + (size_t)(t + 2) * kstep; const char* b2 = last ? nB : cB + (size_t)(t + 2) * kstep;
            const char* a3 = a2 + kstep; const char* b3 = b2 + kstep;
            if (last && has_next) S.a_ready(nxt);
            if constexpr (SP2) {
            PG8_LDB(B0, 0, 0); PG8_LDB(B1, 0, 1); PG8_SCHED; PG8_LDA(At, 0, 0); PG8_STAGE(PG8_SA(1, 1), a1 + hstep, voffA);
            PG8_WAIT_V(8); PG8_WAIT_L(0); PG8_BAR; PG8_MMA(0, 0, At, B0); PG8_MMA(0, 1, At, B1); PG8_BAR; PG8_SCHED;
            PG8_LDA(At, 0, 1); PG8_STAGE(PG8_SB(0, 0), b2, voffB); PG8_STAGE(PG8_SB(0, 1), b2 + hstep, voffB); PG8_STAGE(PG8_SA(0, 0), a2, voffA);
            PG8_WAIT_V(8); PG8_WAIT_L(0); PG8_BAR; PG8_MMA(1, 0, At, B0); PG8_MMA(1, 1, At, B1); PG8_BAR; PG8_SCHED;
            PG8_LDB(B0, 1, 0); PG8_LDB(B1, 1, 1); PG8_SCHED; PG8_LDA(At, 1, 0); PG8_STAGE(PG8_SA(0, 1), a2 + hstep, voffA);
            PG8_WAIT_V(8); PG8_WAIT_L(0); PG8_BAR; PG8_MMA(0, 0, At, B0); PG8_MMA(0, 1, At, B1); PG8_BAR; PG8_SCHED;
            PG8_LDA(At, 1, 1); PG8_STAGE(PG8_SB(1, 0), b3, voffB); PG8_STAGE(PG8_SB(1, 1), b3 + hstep, voffB); PG8_STAGE(PG8_SA(1, 0), a3, voffA);
            PG8_WAIT_V(8); PG8_WAIT_L(0); PG8_BAR; PG8_MMA(1, 0, At, B0); PG8_MMA(1, 1, At, B1); PG8_BAR; PG8_SCHED;
            } else {
            PG8_LDB(B0, 0, 0); PG8_SCHED; PG8_LDA(At, 0, 0); PG8_STAGE(PG8_SA(1, 1), a1 + hstep, voffA);
            PG8_WAIT_L(8); PG8_BAR; PG8_WAIT_L(0); PG8_MMA(0, 0, At, B0); PG8_BAR; PG8_SCHED;
            PG8_LDB(B1, 0, 1); PG8_STAGE(PG8_SB(0, 0), b2, voffB);
            PG8_BAR; PG8_WAIT_L(0); PG8_MMA(0, 1, At, B1); PG8_BAR;
            PG8_LDA(At, 0, 1); PG8_STAGE(PG8_SA(0, 0), a2, voffA);
            PG8_BAR; PG8_WAIT_L(0); PG8_MMA(1, 0, At, B0); PG8_BAR; PG8_SCHED;
            PG8_STAGE(PG8_SB(0, 1), b2 + hstep, voffB);
            PG8_WAIT_V(6); PG8_BAR; PG8_MMA(1, 1, At, B1); PG8_BAR;
            PG8_LDB(B0, 1, 0); PG8_SCHED; PG8_LDA(At, 1, 0); PG8_STAGE(PG8_SA(0, 1), a2 + hstep, voffA);
            PG8_WAIT_L(8); PG8_BAR; PG8_WAIT_L(0); PG8_MMA(0, 0, At, B0); PG8_BAR; PG8_SCHED;
            PG8_LDB(B1, 1, 1); PG8_STAGE(PG8_SB(1, 0), b3, voffB);
            PG8_BAR; PG8_WAIT_L(0); PG8_MMA(0, 1, At, B1); PG8_BAR;
            PG8_LDA(At, 1, 1); PG8_STAGE(PG8_SA(1, 0), a3, voffA);
            PG8_BAR; PG8_WAIT_L(0); PG8_MMA(1, 0, At, B0); PG8_BAR; PG8_SCHED;
            PG8_STAGE(PG8_SB(1, 1), b3 + hstep, voffB);
            PG8_WAIT_V(6); PG8_BAR; PG8_MMA(1, 1, At, B1); PG8_BAR;
            }
        }
        if constexpr (ALIGN_EPI) { if (wr == 0) PG8_BAR; }
        if constexpr (!Epi::AFTER_DRAIN) { E(acc, cur, wr, wc, fr, fq); S.done(cur); }
        if (!has_next) break;
#pragma unroll
        for (int a = 0; a < 2; ++a)
#pragma unroll
            for (int b = 0; b < 2; ++b)
#pragma unroll
                for (int m = 0; m < 4; ++m)
#pragma unroll
                    for (int n = 0; n < 2; ++n) acc[a][b][m][n] = (f32x4){0.f, 0.f, 0.f, 0.f};
        cur = nxt; cA = nA; cB = nB; ++ui;
        if constexpr (ALIGN_EPI) { if (wr == 1) PG8_BAR; }
    }
    PG8_WAIT_V(0);
    if constexpr (!ALIGN_EPI) { if (wr == 0) PG8_BAR; }
    PG8_BAR;
    if constexpr (Epi::AFTER_DRAIN) { E.fused(acc, cur, wr, wc, fr, fq, lds, wid, lane); S.done(cur); }
#undef PG8_SA
#undef PG8_SB
#undef PG8_STAGE
#undef PG8_LDA
#undef PG8_LDB
#undef PG8_MMA
#undef PG8_WAIT_V
#undef PG8_WAIT_L
#undef PG8_BAR
#undef PG8_SCHED
}
}

#include <hip/hip_bf16.h>
namespace attn8 {
using bf16 = __hip_bfloat16;
typedef int v8i __attribute__((ext_vector_type(8)));
typedef int v4i __attribute__((ext_vector_type(4)));
typedef float f32x16 __attribute__((ext_vector_type(16)));
typedef unsigned u32x4 __attribute__((ext_vector_type(4)));
constexpr int NSLOT = 8, SLOT = 4096, LDS_K = 0, LDS_V = NSLOT * SLOT, LDS_OST = 2 * NSLOT * SLOT, LDS_BYTES = LDS_OST + 8 * 4096;
constexpr int QP8 = 512, KP8 = 128, OP = 1024;
__device__ __forceinline__ int crow(int r, int hi) { return (r & 3) + 8 * (r >> 2) + 4 * hi; }
__device__ __forceinline__ void glds16(const void* gsrc, unsigned lds_dst) { unsigned keep;
    asm volatile("s_mov_b32 %0, m0\n\ts_mov_b32 m0, %2\n\ts_nop 0\n\tglobal_load_lds_dwordx4 %1, off\n\ts_mov_b32 m0, %0" : "=&s"(keep) : "v"(gsrc), "s"(lds_dst) : "memory"); }
typedef __attribute__((address_space(3))) const char* lds_cptr;
__device__ __forceinline__ v8i ld32(lds_cptr p0, lds_cptr p1) { const v4i a = *(const __attribute__((address_space(3))) v4i*)p0, b = *(const __attribute__((address_space(3))) v4i*)p1; return (v8i){a[0], a[1], a[2], a[3], b[0], b[1], b[2], b[3]}; }
#define A8_WAIT_BAR(N) asm volatile("s_waitcnt vmcnt(" #N ") lgkmcnt(0)\n\ts_barrier" ::: "memory")
#define A8_QK(kf) __builtin_amdgcn_mfma_scale_f32_32x32x64_f8f6f4(kf, qf, cinit, 0, 0, 0, 0, 0, 0)
#define A8_PV(vf, acc) __builtin_amdgcn_mfma_scale_f32_32x32x64_f8f6f4(pw, vf, acc, 1, 0, 0, 0, 0, 0)
__device__ __forceinline__ void attn_unit(const unsigned char* Qw0, const unsigned char* __restrict__ Kh, const unsigned char* __restrict__ Vh, bf16* Ow0, const int NT, const float neg_ref, char* shm) {
    const int tid = otid(), lane = tid & 63, r32 = lane & 31, hi = lane >> 5; const int wid = __builtin_amdgcn_readfirstlane(tid >> 6);
    const unsigned lds0 = (unsigned)(uintptr_t)shm;
    const bool kw = wid < 4;
    const unsigned char* dsrc = kw ? Kh + (long)lane * KP8 + wid * 16 : Vh + (wid - 4) * 1024 + lane * 16;
    const long dstep = kw ? 64 * KP8 : 4096;
    const unsigned ddst = lds0 + (kw ? LDS_K + wid * 1024 : LDS_V + (wid - 4) * 1024);
    const int dist = kw ? 6 : 5;
#define A8_DMA(tt) glds16(dsrc + (long)(tt) * dstep, (unsigned)__builtin_amdgcn_readfirstlane(ddst + (unsigned)(((tt) & 7) * SLOT)))
    const v8i qf = *(const v8i*)(Qw0 + (long)(wid * 32 + r32) * QP8 + hi * 32);
    asm volatile("" :: "v"(qf));
    A8_DMA(0); A8_DMA(1); A8_DMA(2); A8_DMA(3); if (4 < NT) A8_DMA(4); if (kw && 5 < NT) A8_DMA(5);
    const lds_cptr shm3 = (lds_cptr)shm;
    const lds_cptr kp = shm3 + LDS_K + (2 * hi * 64 + r32) * 16, vp = shm3 + LDS_V + (2 * hi * 64 + r32) * 16;
#define A8_RDK(slot) do { kf0 = ld32(kp + (slot), kp + (slot) + 1024); kf1 = ld32(kp + (slot) + 512, kp + (slot) + 512 + 1024); } while (0)
#define A8_RDV(slot) do { vf0 = ld32(vp + (slot), vp + (slot) + 1024); vf1 = ld32(vp + (slot) + 512, vp + (slot) + 512 + 1024); } while (0)
    f32x16 o0 = {}, o1 = {}, ls = {}, cinit;
#pragma unroll
    for (int r = 0; r < 16; ++r) cinit[r] = neg_ref;
    const v8i ones = {0x38383838, 0x38383838, 0x38383838, 0x38383838, 0x38383838, 0x38383838, 0x38383838, 0x38383838};
    asm volatile("s_waitcnt vmcnt(0) lgkmcnt(0)\n\ts_barrier" ::: "memory");
    v8i kf0, kf1, kg0, kg1, vf0, vf1, pwA, pwB;
    f32x16 N0, N1;
#define A8_BYTES(N, PW, o) do { \
        _Pragma("unroll") for (int i = 0; i < 4; ++i) { unsigned w_ = 0u; w_ = __builtin_amdgcn_cvt_pk_u8_f32(N[4 * i], 0, w_); w_ = __builtin_amdgcn_cvt_pk_u8_f32(N[4 * i + 1], 1, w_); \
            w_ = __builtin_amdgcn_cvt_pk_u8_f32(N[4 * i + 2], 2, w_); w_ = __builtin_amdgcn_cvt_pk_u8_f32(N[4 * i + 3], 3, w_); PW[(o) + i] = (int)w_; } } while (0)
#define A8_SB() __builtin_amdgcn_sched_barrier(0)
#define A8_PVP(PW, vf, acc) __builtin_amdgcn_mfma_scale_f32_32x32x64_f8f6f4(PW, vf, acc, 1, 0, 0, 0, 0, 0)
    A8_RDK(0);
    N0 = A8_QK(kf0); N1 = A8_QK(kf1);
    A8_RDK(SLOT);
    if (dist < NT) A8_DMA(dist);
    A8_BYTES(N0, pwA, 0); A8_BYTES(N1, pwA, 4); asm volatile("" : "+v"(pwA));
    if (6 < NT) { A8_WAIT_BAR(4); } else { A8_WAIT_BAR(0); }
#define A8_STEP(PP, PN, t, KC0, KC1, KN0, KN1) do { \
        A8_SB(); \
        A8_RDV((((t) - 1) & 7) * SLOT); \
        A8_SB(); \
        N0 = A8_QK(KC0); N1 = A8_QK(KC1); \
        A8_SB(); \
        if ((t) + 1 < NT) { KN0 = ld32(kp + ((((t) + 1) & 7) * SLOT), kp + ((((t) + 1) & 7) * SLOT) + 1024); KN1 = ld32(kp + ((((t) + 1) & 7) * SLOT) + 512, kp + ((((t) + 1) & 7) * SLOT) + 512 + 1024); } \
        if ((t) + dist < NT) A8_DMA((t) + dist); \
        A8_SB(); \
        o0 = A8_PVP(PP, vf0, o0); A8_BYTES(N0, PN, 0); A8_SB(); \
        o1 = A8_PVP(PP, vf1, o1); A8_BYTES(N1, PN, 4); asm volatile("" : "+v"(PN)); A8_SB(); \
        ls = A8_PVP(PP, ones, ls); A8_SB(); \
        if ((t) + 6 < NT) { A8_WAIT_BAR(4); } else { A8_WAIT_BAR(0); } } while (0)
    int t = 1;
    for (; t + 1 < NT; t += 2) { A8_STEP(pwA, pwB, t, kf0, kf1, kg0, kg1); A8_STEP(pwB, pwA, t + 1, kg0, kg1, kf0, kf1); }
    A8_STEP(pwA, pwB, NT - 1, kf0, kf1, kg0, kg1);
    A8_RDV(((NT - 1) & 7) * SLOT);
    o0 = A8_PVP(pwB, vf0, o0); o1 = A8_PVP(pwB, vf1, o1); ls = A8_PVP(pwB, ones, ls);
    bf16* Ow = Ow0 + (long)(wid * 32) * OP;
    { bf16* stg = (bf16*)(shm + LDS_OST) + wid * 2048;
#pragma unroll
      for (int r = 0; r < 16; ++r) { const int orow = crow(r, hi); const float rl = __builtin_amdgcn_rcpf(ls[r]);
          stg[orow * 64 + r32] = __float2bfloat16(o0[r] * rl); stg[orow * 64 + 32 + r32] = __float2bfloat16(o1[r] * rl); }
      asm volatile("s_waitcnt lgkmcnt(0)" ::: "memory");
#pragma unroll
      for (int i = 0; i < 4; ++i) { const int row = i * 8 + (lane >> 3), ch = lane & 7; const u32x4 v = *(const u32x4*)(stg + row * 64 + ch * 8); *(u32x4*)(Ow + (long)row * OP + ch * 8) = v; } }
    asm volatile("s_waitcnt lgkmcnt(0)\n\ts_barrier" ::: "memory");
#undef A8_DMA
#undef A8_RDK
#undef A8_RDV
#undef A8_BYTES
#undef A8_SB
#undef A8_PVP
#undef A8_STEP
}
#undef A8_WAIT_BAR
#undef A8_QK
#undef A8_PV
}


using namespace cfg;
typedef unsigned short bf16_t;
typedef float f32x4 __attribute__((ext_vector_type(4)));
typedef unsigned u32x4 __attribute__((ext_vector_type(4)));
typedef unsigned u32x2 __attribute__((ext_vector_type(2)));

__device__ __forceinline__ float bf2f(unsigned v) { return __uint_as_float(v << 16); }
__device__ __forceinline__ float bflo(unsigned w) { return __uint_as_float(w << 16); }
__device__ __forceinline__ float bfhi(unsigned w) { return __uint_as_float(w & 0xffff0000u); }
__device__ __forceinline__ unsigned f2bf(float f) { unsigned u = __float_as_uint(f); return (u + 0x7fffu + ((u >> 16) & 1u)) >> 16; }
__device__ __forceinline__ unsigned pk2(float lo, float hi) { return f2bf(lo) | (f2bf(hi) << 16); }
__device__ __forceinline__ float sigm(float x) { return 1.f / (1.f + __expf(-x)); }
__device__ __forceinline__ float silu(float x) { return x / (1.f + __expf(-x)); }
template <int M> __device__ __forceinline__ float xsum(float v) {
    if constexpr (M < 32) return v + __uint_as_float((unsigned)__builtin_amdgcn_ds_swizzle((int)__float_as_uint(v), (M << 10) | 0x1f));
    else { auto rr = __builtin_amdgcn_permlane32_swap(__float_as_uint(v), __float_as_uint(v), false, false); return __uint_as_float(rr[0]) + __uint_as_float(rr[1]); }
}
__device__ __forceinline__ float wave_sum(float v) { v = xsum<1>(v); v = xsum<2>(v); v = xsum<4>(v); v = xsum<8>(v); v = xsum<16>(v); v = xsum<32>(v); return v; }
__device__ __forceinline__ size_t stream_off(int row, bool& is_ctx) { const int b = row / PB, p = row - b * PB; is_ctx = p < CTXL; return is_ctx ? ((size_t)b * CTXL + p) * D : ((size_t)b * SEQ + (p - CTXL)) * D; }

constexpr size_t MiB = 1u << 20;
constexpr size_t WS_CTL = 0;
constexpr size_t WS_MODV = 1 * MiB;
constexpr size_t WS_LBF = WS_MODV + 256 * 1024;
constexpr size_t WS_REF = WS_LBF + 8192;
constexpr size_t WS_POOLWT = WS_MODV + 512 * 1024;
constexpr size_t WS_COS = 2 * MiB, WS_SIN = 3 * MiB;
constexpr size_t WS_WIN = 4 * MiB;
constexpr size_t WS_WOUT = 13 * MiB;
constexpr size_t WS_WGU = 17 * MiB;
constexpr size_t WS_WD = 49 * MiB;
constexpr size_t WS_XC = 65 * MiB;
constexpr size_t WS_XN = 67 * MiB;
constexpr size_t WS_PROJ = 100 * MiB;
constexpr size_t WS_QN = 175 * MiB;
constexpr size_t WS_KN = 192 * MiB;
constexpr size_t WS_Q8 = WS_QN;
constexpr size_t WS_K8 = WS_QN + 9 * MiB;
constexpr size_t WS_VT8 = WS_QN + 12 * MiB;
constexpr size_t WS_MIX = 197 * MiB;
constexpr size_t WS_UT = 230 * MiB;
constexpr size_t WS_ST = 247 * MiB;
constexpr size_t WS_DEC = 264 * MiB;
constexpr size_t WS_LIST = 265 * MiB;
constexpr size_t WS_ACT2 = WS_PROJ;
constexpr size_t WS_WGU1 = 272 * MiB;
constexpr size_t WS_WD1 = 304 * MiB;
constexpr size_t WS_END = 320 * MiB;
constexpr int CW_CNT = 1024;

__device__ const float ROPE_INV[16] = {1.0f, 0.5623413251903491f, 0.31622776601683794f, 0.1778279410038923f, 0.1f, 0.05623413251903491f, 0.03162277660168379f, 0.01778279410038923f,
                                       0.01f, 0.005623413251903491f, 0.0031622776601683794f, 0.0017782794100389228f, 0.001f, 0.0005623413251903491f, 0.00031622776601683794f, 0.00017782794100389227f};
__device__ __forceinline__ void sincos_d(double a, double& s, double& c) {
    const double k = rint(a * 0.63661977236758134308);
    double r = fma(-k, 1.57079632679489655800e+00, a);
    r = fma(-k, 6.12323399573676603587e-17, r);
    const double r2 = r * r;
    double sp = -7.6471637318198164759e-13;
    sp = fma(sp, r2, 1.6059043836821614599e-10);
    sp = fma(sp, r2, -2.5052108385441718775e-08);
    sp = fma(sp, r2, 2.7557319223985890653e-06);
    sp = fma(sp, r2, -1.9841269841269841270e-04);
    sp = fma(sp, r2, 8.3333333333333333333e-03);
    sp = fma(sp, r2, -1.6666666666666666667e-01);
    const double sr = fma(sp * r2, r, r);
    double cp = 4.7794773323873852974e-14;
    cp = fma(cp, r2, -1.1470745597729724714e-11);
    cp = fma(cp, r2, 2.0876756987868098979e-09);
    cp = fma(cp, r2, -2.7557319223985890653e-07);
    cp = fma(cp, r2, 2.4801587301587301587e-05);
    cp = fma(cp, r2, -1.3888888888888888889e-03);
    cp = fma(cp, r2, 4.1666666666666666667e-02);
    cp = fma(cp, r2, -0.5);
    const double cr = fma(cp, r2, 1.0);
    const int q = ((int)k) & 3;
    s = (q == 0) ? sr : (q == 1) ? cr : (q == 2) ? -sr : -cr;
    c = (q == 0) ? cr : (q == 1) ? -sr : (q == 2) ? -cr : sr;
}

__device__ __forceinline__ void transpose_items(const float* __restrict__ W, int K, int N, bf16_t* __restrict__ WT, int mode, int nbatch, size_t src_stride, size_t dst_stride, float* scr, int gw, int NGW, int lane, int it_lo = 0, int it_hi = 0x7fffffff) {
    const int nblk = N / 32, per = (K / 64) * nblk, nitems = per * nbatch;
    if (it_hi > nitems) it_hi = nitems;
    for (int it = it_lo + gw; it < it_hi; it += NGW) {
        const int bt = it / per, item = it - bt * per;
        const float* Wb = W + (size_t)bt * src_stride; bf16_t* WTb = WT + (size_t)bt * dst_stride;
        const int kb = item / nblk, nb = item - kb * nblk, k0 = 64 * kb, n0 = 32 * nb;
        f32x4 wv[8];
#pragma unroll
        for (int i = 0; i < 8; ++i) wv[i] = *(const f32x4*)(Wb + (size_t)(k0 + 8 * i + (lane >> 3)) * N + n0 + (lane & 7) * 4);
#pragma unroll
        for (int i = 0; i < 8; ++i) { float* s = scr + (8 * i + (lane >> 3)) * 33 + (lane & 7) * 4; s[0] = wv[i].x; s[1] = wv[i].y; s[2] = wv[i].z; s[3] = wv[i].w; }
        asm volatile("s_waitcnt lgkmcnt(0)" ::: "memory");
        const int rbase = (mode == 0) ? n0 : ((n0 >> 7) * 256 + (mode == 2 ? 128 : 0) + (n0 & 127));
        const int cch = lane & 7;
#pragma unroll
        for (int j = 0; j < 4; ++j) { const int n = (lane >> 3) + 8 * j; const float* s = scr + (8 * cch) * 33 + n;
            u32x4 o; o.x = pk2(s[0 * 33], s[1 * 33]); o.y = pk2(s[2 * 33], s[3 * 33]); o.z = pk2(s[4 * 33], s[5 * 33]); o.w = pk2(s[6 * 33], s[7 * 33]);
            *(u32x4*)(WTb + (size_t)(rbase + n) * K + k0 + 8 * cch) = o; }
        asm volatile("s_waitcnt lgkmcnt(0)" ::: "memory");
    }
}
constexpr int MOE_ITEMS = 3 * 4096;
__device__ __forceinline__ void moe_weight_copies(const float* gate, const float* up, const float* down, bf16_t* WGU, bf16_t* WD, float* scr, int gw, int NGW, int lane, int lo, int hi) {
    if (lo < 4096) transpose_items(gate, D, DE, WGU, 1, NE, (size_t)D * DE, (size_t)1024 * D, scr, gw, NGW, lane, lo, hi < 4096 ? hi : 4096);
    if (lo < 8192 && hi > 4096) transpose_items(up, D, DE, WGU, 2, NE, (size_t)D * DE, (size_t)1024 * D, scr, gw, NGW, lane, lo > 4096 ? lo - 4096 : 0, hi < 8192 ? hi - 4096 : 4096);
    if (hi > 8192) transpose_items(down, DE, D, WD, 0, NE, (size_t)DE * D, (size_t)D * DE, scr, gw, NGW, lane, lo > 8192 ? lo - 8192 : 0, hi - 8192);
}
__device__ __forceinline__ void moe_filler(unsigned char* lds, const float* gate, const float* up, const float* down, unsigned char* ws, int lw, int lo, int hi, int U, int G, int c) {
    const int rem = U % G; int rank = c, nr = G;
    if (rem != 0) { if (c < rem) return; rank = c - rem; nr = G - rem; }
    const int tid = otid(); float* scr = (float*)(lds + 16384) + (tid >> 6) * (64 * 33);
    moe_weight_copies(gate + (size_t)lw * NE * D * DE, up + (size_t)lw * NE * D * DE, down + (size_t)lw * NE * DE * D, (bf16_t*)(ws + (lw ? WS_WGU1 : WS_WGU)), (bf16_t*)(ws + (lw ? WS_WD1 : WS_WD)), scr, rank * 8 + (tid >> 6), nr * 8, tid & 63, lo, hi);
}
struct ProArgs { const float *c, *c_ctx, *w_mod, *b_mod, *hgrn_lb, *qg, *kg, *w_in, *w_out, *pool_w, *gate, *up, *down; float *MODV, *LBF, *REF, *COS, *SIN; bf16_t *WIN, *WOUT, *POOLWT, *WGU, *WD; };
__device__ __forceinline__ void prologue_phase(unsigned char* lds, const ProArgs& a, int cu, int G) {
    const int tid = otid(), lane = tid & 63, wave = tid >> 6;
    for (int gid = cu * 512 + tid; gid < SEQ * 32; gid += G * 512) {
        const int t = gid >> 5, j = gid & 31;
        const float pos = (float)(j < 16 ? (t >> 6) : (t & 63));
        const float ang = pos * ROPE_INV[j & 15];
        double s, c; sincos_d((double)ang, s, c);
        a.COS[gid] = (float)c; a.SIN[gid] = (float)s;
    }
    if (cu == 0) {
        for (int gid = tid; gid < 1024; gid += 512) {
            const int l = gid >> 9, r = gid & 511; float v = 0.f;
            if (l == 1) v = 1.f / (1.f + expf(a.hgrn_lb[r] - a.hgrn_lb[512 + r]));
            a.LBF[gid] = fmaxf(v, 1e-30f); }
        if (tid < DEPTH) {
            float mq = 0.f, mk = 0.f;
            for (int i = 0; i < 64; ++i) { mq = fmaxf(mq, fabsf(a.qg[tid * 64 + i])); mk = fmaxf(mk, fabsf(a.kg[tid * 64 + i])); }
            a.REF[tid * 64] = 60.f - 4.f * fmaxf(64.f * C2 * mq * mk * 1.13f + 0.5f - 15.5f, 0.f); }
    }
    {
        float* act = (float*)lds;
        float* part = (float*)(lds + 12288);
        for (int item = cu; item < 2 * 96; item += G) {
            const int l = item / 96, n0 = (item - l * 96) * 64;
            for (int i = tid; i < 3072; i += 512) { const int r = i >> 10, k = i & 1023; const float v = r < 2 ? a.c[r * 1024 + k] : a.c_ctx[k]; act[i] = silu(v); }
            __syncthreads();
            const float* w = a.w_mod + ((size_t)l * 1024 + (size_t)wave * 128) * 6144 + n0 + lane;
            float a0 = 0.f, a1 = 0.f, a2 = 0.f;
#pragma unroll 32
            for (int k = 0; k < 128; ++k) { const float wv = w[(size_t)k * 6144]; const int kk = wave * 128 + k; a0 += act[kk] * wv; a1 += act[1024 + kk] * wv; a2 += act[2048 + kk] * wv; }
            part[(wave * 3 + 0) * 64 + lane] = a0; part[(wave * 3 + 1) * 64 + lane] = a1; part[(wave * 3 + 2) * 64 + lane] = a2;
            __syncthreads();
            if (tid < 192) { const int r = tid >> 6, nn = tid & 63; float s = 0.f;
#pragma unroll
                for (int q = 0; q < 8; ++q) s += part[(q * 3 + r) * 64 + nn];
                a.MODV[(l * 3 + r) * 6144 + n0 + nn] = s + a.b_mod[l * 6144 + n0 + nn]; }
            __syncthreads();
        }
    }
    {
        float* scr = (float*)(lds + 16384) + wave * (64 * 33);
        const int gw = cu * 8 + wave, NGW = G * 8;
        transpose_items(a.w_in, D, NIN, a.WIN, 0, DEPTH, (size_t)D * NIN, (size_t)NIN * D, scr, gw, NGW, lane);
        transpose_items(a.w_out, D, D, a.WOUT, 0, DEPTH, (size_t)D * D, (size_t)D * D, scr, gw, NGW, lane);
        transpose_items(a.pool_w, 64, 64, a.POOLWT, 0, DEPTH * 4, (size_t)64 * 64, (size_t)64 * 64, scr, gw, NGW, lane);
    }
    __syncthreads();
}

namespace pool {
typedef float f32x16 __attribute__((ext_vector_type(16)));
typedef short bf16x8 __attribute__((ext_vector_type(8)));
constexpr int P = 72, O_X = 0  , O_DM = 81920  , O_OUT = 0  , OP = 264;
__device__ __forceinline__ int crow(int r, int hi) { return (r & 3) + 8 * (r >> 2) + 4 * hi; }
__device__ __forceinline__ void pool_phase(unsigned char* lds, const bf16_t* __restrict__ PROJ, const bf16_t* __restrict__ WT  , const float* __restrict__ pscale, bf16_t* __restrict__ MIX, int cu, int G) {
    const int tid = otid(), lane = tid & 63, r32 = lane & 31, hi = lane >> 5, w = __builtin_amdgcn_readfirstlane(tid >> 6);
    float* X = (float*)(lds + O_X); bf16_t* OUT = (bf16_t*)(lds + O_OUT);
    for (int u = G - 1 - cu; u < MT / 64; u += G) {
        const int row0 = u * 64, b = row0 / PB, p0 = row0 - b * PB; const bool is_ctx = p0 < CTXL;
        const int seg0 = b * PB + (is_ctx ? 0 : CTXL), len = is_ctx ? CTXL : SEQ, t0 = is_ctx ? p0 : p0 - CTXL;
#pragma unroll
        for (int it = 0; it < 5; ++it) { const int piece = tid + it * 512, rr = piece >> 5, pc = piece & 31, t = t0 - 8 + rr;
            u32x4 v = {0u, 0u, 0u, 0u};
            if (t >= 0 && t < len) v = *(const u32x4*)(PROJ + (size_t)(seg0 + t) * NIN + C_BP + pc * 8);
            float* x = X + rr * 256 + pc * 8;
            *(f32x4*)x = (f32x4){bflo(v.x), bfhi(v.x), bflo(v.y), bfhi(v.y)}; *(f32x4*)(x + 4) = (f32x4){bflo(v.z), bfhi(v.z), bflo(v.w), bfhi(v.w)}; }
        __syncthreads();
        {
            const int c = tid & 255, th = tid >> 8, g = c >> 6, hw = 1 << g;
            bf16_t* dm = (bf16_t*)(lds + O_DM) + g * 64 * P + (c & 63);
            const float* xc = X + c;
            const int ta = th * 32;
            float s = 0.f;
            for (int q = ta - hw; q < ta + hw; ++q) s += xc[(q + 8) * 256];
#pragma unroll 8
            for (int tt = 0; tt < 32; ++tt) { const int t = ta + tt, tg = t0 + t;
                int lo = tg - hw; if (lo < 0) lo = 0; int hi2 = tg + hw; if (hi2 > len) hi2 = len;
                dm[t * P] = (bf16_t)f2bf(s / (float)(hi2 - lo) - xc[(t + 8) * 256]);
                s += xc[(t + hw + 8) * 256] - xc[(t - hw + 8) * 256]; }
        }
        __syncthreads();
        {
            const int g = w >> 1, tb = w & 1;
            const bf16_t* A = (const bf16_t*)(lds + O_DM) + g * 64 * P + (tb * 32 + r32) * P + hi * 8;
#pragma unroll
            for (int eb = 0; eb < 2; ++eb) {
                const bf16_t* Bp = WT + (size_t)g * 4096 + (eb * 32 + r32) * 64 + hi * 8;
                f32x16 acc = {};
#pragma unroll
                for (int ks = 0; ks < 4; ++ks) acc = __builtin_amdgcn_mfma_f32_32x32x16_bf16(*(const bf16x8*)(A + ks * 16), *(const bf16x8*)(Bp + ks * 16), acc, 0, 0, 0);
                const int e = g * 64 + eb * 32 + r32; const float sc = pscale[e];
#pragma unroll
                for (int r = 0; r < 16; ++r) OUT[(tb * 32 + crow(r, hi)) * OP + e] = (bf16_t)f2bf(acc[r] * sc);
            }
        }
        __syncthreads();
#pragma unroll
        for (int it = 0; it < 4; ++it) { const int piece = tid + it * 512, t = piece >> 5, pc = piece & 31;
            *(u32x4*)(MIX + (size_t)(row0 + t) * D + 256 + pc * 8) = *(const u32x4*)(OUT + t * OP + pc * 8); }
        __syncthreads();
    }
}
}

#ifndef LAS
#define LAS __attribute__((address_space(3)))
#endif
__device__ __forceinline__ void norm1_phase(int cu, int G, const float* __restrict__ lat, const float* __restrict__ cx, const float* __restrict__ g, const float* __restrict__ modv, int sh_off, bf16_t* __restrict__ XN) {
    const int lane = otid() & 63, gw = cu * 8 + (otid() >> 6), NGW = G * 8;
    for (int row0 = gw * 4; row0 < MT; row0 += NGW * 4) {
        bool is_ctx; const size_t off = stream_off(row0, is_ctx);
        const int r = is_ctx ? 2 : row0 / PB;
        const f32x4* xr = (const f32x4*)((is_ctx ? cx : lat) + off) + lane;
        f32x4 v[4][4]; float ss[4];
#pragma unroll
        for (int q = 0; q < 4; ++q) { ss[q] = 0.f;
#pragma unroll
            for (int j = 0; j < 4; ++j) v[q][j] = xr[q * 256 + 64 * j]; }
        const float* mv = modv + r * 6144 + sh_off;
        f32x4 gs[4], sh[4];
#pragma unroll
        for (int j = 0; j < 4; ++j) { const int col = 4 * lane + 256 * j; gs[j] = *(const f32x4*)(g + col) * (*(const f32x4*)(mv + 1024 + col) + 1.f); sh[j] = *(const f32x4*)(mv + col); }
#pragma unroll
        for (int q = 0; q < 4; ++q) {
#pragma unroll
            for (int j = 0; j < 4; ++j) ss[q] += (v[q][j].x * v[q][j].x + v[q][j].y * v[q][j].y) + (v[q][j].z * v[q][j].z + v[q][j].w * v[q][j].w);
            const float rstd = 1.f / sqrtf(wave_sum(ss[q]) * (1.f / D) + EPS);
#pragma unroll
            for (int j = 0; j < 4; ++j) { const f32x4 o = v[q][j] * rstd * gs[j] + sh[j];
                u32x2 w; w.x = pk2(o.x, o.y); w.y = pk2(o.z, o.w);
                *(u32x2*)(XN + (size_t)(row0 + q) * D + 4 * lane + 256 * j) = w; } }
    }
}

__device__ __forceinline__ void norm2_router_phase(unsigned char* lds, int cu, int G, const float* __restrict__ lat, const float* __restrict__ cx, const float* __restrict__ g, const float* __restrict__ modv, int sh_off,
                                                   const float* __restrict__ router_w, const float* __restrict__ router_b, bf16_t* __restrict__ XN, unsigned* __restrict__ cnt, u32x4* __restrict__ LIST, int route_ctx) {
    const int tid = otid(), lane = tid & 63, wave = tid >> 6, gw = cu * 8 + wave, NGW = G * 8;
    float* RW = (float*)lds;
    u32x4* ENT = (u32x4*)(lds + 65536) + wave * 64;
    LAS unsigned* BC = (LAS unsigned*)((LAS unsigned char*)lds + 65536 + 8192);
#pragma unroll
    for (int it = 0; it < 8; ++it) { const int p = tid + it * 512, col = p >> 2, q = p & 3; const f32x4 w4 = *(const f32x4*)(router_w + (size_t)col * 16 + 4 * q);
        RW[(4 * q + 0) * 1024 + col] = w4.x; RW[(4 * q + 1) * 1024 + col] = w4.y; RW[(4 * q + 2) * 1024 + col] = w4.z; RW[(4 * q + 3) * 1024 + col] = w4.w; }
    if (tid < 48) BC[tid] = 0u;
    __syncthreads();
    int nent = 0;
    f32x4 vn[4];
    { int row = gw < MT ? gw : 0; bool ic; const size_t off = stream_off(row, ic); const f32x4* xr = (const f32x4*)((ic ? cx : lat) + off) + lane;
#pragma unroll
      for (int j = 0; j < 4; ++j) vn[j] = xr[64 * j]; }
    for (int row = gw; row < MT; row += NGW) {
        f32x4 v[4];
#pragma unroll
        for (int j = 0; j < 4; ++j) v[j] = vn[j];
        { const int nr = row + NGW < MT ? row + NGW : row; bool ic; const size_t off = stream_off(nr, ic); const f32x4* xr = (const f32x4*)((ic ? cx : lat) + off) + lane;
#pragma unroll
          for (int j = 0; j < 4; ++j) vn[j] = xr[64 * j]; }
        bool is_ctx; (void)stream_off(row, is_ctx);
        if (is_ctx && !route_ctx) continue;
        const int r = is_ctx ? 2 : row / PB;
        float ss = 0.f;
#pragma unroll
        for (int j = 0; j < 4; ++j) ss += (v[j].x * v[j].x + v[j].y * v[j].y) + (v[j].z * v[j].z + v[j].w * v[j].w);
        const float rstd = 1.f / sqrtf(wave_sum(ss) * (1.f / D) + EPS);
        const float* mv = modv + r * 6144 + sh_off;
#pragma unroll
        for (int j = 0; j < 4; ++j) { const int col = 4 * lane + 256 * j;
            const f32x4 gg = *(const f32x4*)(g + col), sh = *(const f32x4*)(mv + col), sc = *(const f32x4*)(mv + 1024 + col);
            v[j] = v[j] * rstd * gg * (sc + 1.f) + sh;
            u32x2 w; w.x = pk2(v[j].x, v[j].y); w.y = pk2(v[j].z, v[j].w);
            *(u32x2*)(XN + (size_t)row * D + col) = w; }
        float sc_[16], sel[16];
#pragma unroll
        for (int e = 0; e < 16; ++e) { float a = 0.f;
#pragma unroll
            for (int j = 0; j < 4; ++j) { const f32x4 w4 = *(const f32x4*)(RW + e * 1024 + 256 * j + 4 * lane); a += (v[j].x * w4.x + v[j].y * w4.y) + (v[j].z * w4.z + v[j].w * w4.w); }
            a = wave_sum(a); sc_[e] = 1.f / (1.f + __expf(-a)); sel[e] = sc_[e] + router_b[e]; }
        float gs[4]; int gi1[4], gi2[4]; float gw1[4], gw2[4];
#pragma unroll
        for (int q = 0; q < 4; ++q) { float v1 = -INFINITY, v2 = -INFINITY; int i1 = 0, i2 = 0; float s1 = 0.f, s2 = 0.f;
#pragma unroll
            for (int k = 0; k < 4; ++k) { const float x = sel[4 * q + k], sx = sc_[4 * q + k];
                if (x > v1) { v2 = v1; i2 = i1; s2 = s1; v1 = x; i1 = 4 * q + k; s1 = sx; } else if (x > v2) { v2 = x; i2 = 4 * q + k; s2 = sx; } }
            gs[q] = v1 + v2; gi1[q] = i1; gi2[q] = i2; gw1[q] = s1; gw2[q] = s2; }
        float bv = gs[0]; int e0 = gi1[0], e1 = gi2[0]; float w0 = gw1[0], w1 = gw2[0];
#pragma unroll
        for (int q = 1; q < 4; ++q) if (gs[q] > bv) { bv = gs[q]; e0 = gi1[q]; e1 = gi2[q]; w0 = gw1[q]; w1 = gw2[q]; }
        const float ws = w0 + w1; w0 /= ws; w1 /= ws;
        {
            const int gq = e0 >> 2; int a = e0 & 3, c = e1 & 3; float wa = w0, wc = w1;
            if (a > c) { const int ti = a; a = c; c = ti; const float tf = wa; wa = wc; wc = tf; }
            const int pi = (a == 0) ? (c - 1) : (a == 1 ? c + 1 : 5);
            const int bk = gq * 6 + pi;
            if (lane == 0) { const unsigned loc = __hip_atomic_fetch_add(BC + bk, 1u, __ATOMIC_RELAXED, __HIP_MEMORY_SCOPE_WORKGROUP);
                u32x4 sv; sv.x = (unsigned)bk | (loc << 8); sv.y = (unsigned)row; sv.z = __float_as_uint(wa); sv.w = __float_as_uint(wc); ENT[nent] = sv; }
            ++nent; }
    }
    __syncthreads();
    if (tid < 24) { const unsigned n = BC[tid]; BC[24 + tid] = n ? __hip_atomic_fetch_add(cnt + tid, n, __ATOMIC_RELAXED, __HIP_MEMORY_SCOPE_AGENT) : 0u; }
    __syncthreads();
    if (lane < nent) { const u32x4 en = ENT[lane]; const unsigned bk = en.x & 255u, slot = BC[24 + bk] + (en.x >> 8);
        u32x4 sv; sv.x = en.y; sv.y = en.z; sv.z = en.w; sv.w = 0u; LIST[(size_t)bk * MT + slot] = sv; }
    __syncthreads();
}

__device__ __forceinline__ void post_phase(int cu, int G, const bf16_t* __restrict__ PROJ, const float* __restrict__ qg, const float* __restrict__ kg, const float* __restrict__ COS, const float* __restrict__ SIN,
                                              unsigned char* __restrict__ Q8, unsigned char* __restrict__ K8, unsigned char* __restrict__ VT8) {
    const int lane = otid() & 63, gw = cu * 8 + (otid() >> 6), NGW = G * 8;
    const int d0 = (lane & 7) * 8, jk = lane & 31;
    float qgv[8];
#pragma unroll
    for (int i = 0; i < 8; ++i) qgv[i] = qg[d0 + i];
    const float kg0 = kg[2 * jk], kg1 = kg[2 * jk + 1];
    for (int row0 = gw * 4; row0 < MT; row0 += NGW * 4) {
        const int b = row0 / PB, p0 = row0 - b * PB; const bool is_ctx = p0 < CTXL; const int t0 = is_ctx ? 0 : p0 - CTXL;
        u32x4 wq[4]; unsigned wk[4], wv[4]; f32x4 cq[4], sq[4]; float ck[4], sk[4];
#pragma unroll
        for (int q = 0; q < 4; ++q) { const bf16_t* pr = PROJ + (size_t)(row0 + q) * NIN;
            wq[q] = *(const u32x4*)(pr + C_CQ + lane * 8); wk[q] = *(const unsigned*)(pr + C_CK + lane * 2); wv[q] = *(const unsigned*)(pr + C_CV + lane * 2);
            const int t = is_ctx ? 0 : t0 + q;
            cq[q] = *(const f32x4*)(COS + t * 32 + (d0 >> 1)); sq[q] = *(const f32x4*)(SIN + t * 32 + (d0 >> 1)); ck[q] = COS[t * 32 + jk]; sk[q] = SIN[t * 32 + jk]; }
#pragma unroll
        for (int q = 0; q < 4; ++q) {
            {
                const u32x4 w = wq[q];
                float x[8] = {bflo(w.x), bfhi(w.x), bflo(w.y), bfhi(w.y), bflo(w.z), bfhi(w.z), bflo(w.w), bfhi(w.w)};
                float ss = 0.f;
#pragma unroll
                for (int i = 0; i < 8; ++i) ss += x[i] * x[i];
                ss = xsum<1>(ss); ss = xsum<2>(ss); ss = xsum<4>(ss);
                const float rstd = 1.f / sqrtf(ss * (1.f / 64.f) + EPS);
#pragma unroll
                for (int i = 0; i < 8; ++i) x[i] = x[i] * rstd * qgv[i];
                if (!is_ctx) {
#pragma unroll
                    for (int i = 0; i < 4; ++i) { const float cs = cq[q][i], sn = sq[q][i];
                        const float x1 = x[2 * i], x2 = x[2 * i + 1]; x[2 * i] = x1 * cs - x2 * sn; x[2 * i + 1] = x1 * sn + x2 * cs; } }
                int o0 = 0, o1 = 0;
                o0 = __builtin_amdgcn_cvt_pk_fp8_f32(x[0] * (4.f * C2), x[1] * (4.f * C2), o0, false); o0 = __builtin_amdgcn_cvt_pk_fp8_f32(x[2] * (4.f * C2), x[3] * (4.f * C2), o0, true);
                o1 = __builtin_amdgcn_cvt_pk_fp8_f32(x[4] * (4.f * C2), x[5] * (4.f * C2), o1, false); o1 = __builtin_amdgcn_cvt_pk_fp8_f32(x[6] * (4.f * C2), x[7] * (4.f * C2), o1, true);
                u32x2 o; o.x = (unsigned)o0; o.y = (unsigned)o1;
                *(u32x2*)(Q8 + (size_t)(row0 + q) * 512 + lane * 8) = o;
            }
            {
                float x1 = bflo(wk[q]), x2 = bfhi(wk[q]);
                float ss = x1 * x1 + x2 * x2;
                ss = xsum<1>(ss); ss = xsum<2>(ss); ss = xsum<4>(ss); ss = xsum<8>(ss); ss = xsum<16>(ss);
                const float rstd = 1.f / sqrtf(ss * (1.f / 64.f) + EPS);
                x1 = x1 * rstd * kg0; x2 = x2 * rstd * kg1;
                if (!is_ctx) { const float cs = ck[q], sn = sk[q]; const float a = x1 * cs - x2 * sn, c = x1 * sn + x2 * cs; x1 = a; x2 = c; }
                const int w8 = __builtin_amdgcn_cvt_pk_fp8_f32(x1, x2, 0, false);
                *(unsigned short*)(K8 + (size_t)(row0 + q) * 128 + lane * 2) = (unsigned short)w8;
            }
            {
                const int p = p0 + q, tile = p >> 6, kvl = p & 63, c = kvl >> 5, w = kvl & 31, hh = (w >> 2) & 1, tp = (w & 3) + 4 * (w >> 3);
                const int w8 = __builtin_amdgcn_cvt_pk_fp8_f32(bflo(wv[q]), bfhi(wv[q]), 0, false);
                unsigned char* vb = VT8 + ((size_t)((b * 2 + (lane >> 5)) * (PB / 64) + tile)) * 4096 + (size_t)(((hh * 2 + c) * 64 + 2 * (lane & 31)) * 16 + tp);
                vb[0] = (unsigned char)(w8 & 0xff); vb[16] = (unsigned char)((w8 >> 8) & 0xff);
            }
        }
    }
}

namespace hg {
typedef float f32x16 __attribute__((ext_vector_type(16)));
typedef short bf16x8 __attribute__((ext_vector_type(8)));
typedef short s16x4 __attribute__((ext_vector_type(4)));
typedef float f32x2 __attribute__((ext_vector_type(2)));
constexpr int P = 72;
constexpr int O_ZB = 0, O_ZQ = 32768, O_VT = 40960, O_QH = 50176, O_QT = 68608, O_KH = 87040, O_ST = 105472, O_SSQ = 123904, O_OUT = 0  , O_TOT = 0, LDS_BYTES = 124416;
constexpr int MSZ = 64 * P * 2;
constexpr int NCH = PB / 64;
__device__ __forceinline__ int crow(int r, int hi) { return (r & 3) + 8 * (r >> 2) + 4 * hi; }
__device__ __forceinline__ unsigned cvtpk(float lo, float hi) { typedef __bf16 b2 __attribute__((ext_vector_type(2))); f32x2 v = {lo, hi}; b2 b = __builtin_convertvector(v, b2); return __builtin_bit_cast(unsigned, b); }
__device__ __forceinline__ float clampe(float e) { return fminf(fmaxf(e, -80.f), 80.f); }

struct StageRegs { u32x4 wf, wb, wv, wq; };
template <bool FULL> __device__ __forceinline__ void stage_load(StageRegs& s, const bf16_t* __restrict__ PROJ, int row0, int h) {
    const int tid = otid(), t = tid >> 3, pc = tid & 7;
    const bf16_t* pr = PROJ + (size_t)(row0 + t) * NIN + h * 64 + pc * 8;
    s.wf = *(const u32x4*)(pr + C_AFF); s.wb = *(const u32x4*)(pr + C_AFB); s.wv = *(const u32x4*)(pr + C_AI);
    if (FULL) s.wq = *(const u32x4*)(pr + C_AQ);
}
template <bool FULL> __device__ __forceinline__ void prep(unsigned char* lds, const bf16_t* __restrict__ PROJ, const float* __restrict__ LBFl, int row0, int h, StageRegs& sr, int nrow0, int nh) {
    const int tid = otid();
    float* ZB = (float*)(lds + O_ZB); bf16_t* ZQ = (bf16_t*)(lds + O_ZQ); bf16_t* VT = (bf16_t*)(lds + O_VT);
    {
        const int t = tid >> 3, pc = tid & 7;
        const u32x4 wf = sr.wf, wb = sr.wb, wv = sr.wv;
        float* zf = ZB + t * 64 + pc * 8; float* zb = ZB + 4096 + t * 64 + pc * 8;
        *(f32x4*)zf = (f32x4){bflo(wf.x), bfhi(wf.x), bflo(wf.y), bfhi(wf.y)}; *(f32x4*)(zf + 4) = (f32x4){bflo(wf.z), bfhi(wf.z), bflo(wf.w), bfhi(wf.w)};
        *(f32x4*)zb = (f32x4){bflo(wb.x), bfhi(wb.x), bflo(wb.y), bfhi(wb.y)}; *(f32x4*)(zb + 4) = (f32x4){bflo(wb.z), bfhi(wb.z), bflo(wb.w), bfhi(wb.w)};
        bf16_t* vt = VT + (pc * 8) * P + t;
        vt[0 * P] = (bf16_t)(wv.x & 0xffffu); vt[1 * P] = (bf16_t)(wv.x >> 16); vt[2 * P] = (bf16_t)(wv.y & 0xffffu); vt[3 * P] = (bf16_t)(wv.y >> 16);
        vt[4 * P] = (bf16_t)(wv.z & 0xffffu); vt[5 * P] = (bf16_t)(wv.z >> 16); vt[6 * P] = (bf16_t)(wv.w & 0xffffu); vt[7 * P] = (bf16_t)(wv.w >> 16);
        if (FULL) { const u32x4 wq = sr.wq; *(u32x4*)(ZQ + t * 64 + pc * 8) = wq; }
        if (nrow0 >= 0) stage_load<FULL>(sr, PROJ, nrow0, nh);
    }
    __syncthreads();
#pragma unroll
    for (int it = 0; it < 2; ++it) {
        const int item = tid + it * 512, dir = item >> 9, t = (item >> 3) & 63, i0 = (item & 7) * 8;
        float* zp = ZB + dir * 4096 + t * 64 + i0; const float* lp = LBFl + dir * 256 + h * 64 + i0;
        f32x4 za = *(const f32x4*)zp, zc = *(const f32x4*)(zp + 4); const f32x4 la = *(const f32x4*)lp, lc = *(const f32x4*)(lp + 4);
#pragma unroll
        for (int k = 0; k < 4; ++k) { za[k] = __logf(la[k] + (1.f - la[k]) / (1.f + __expf(-za[k]))); zc[k] = __logf(lc[k] + (1.f - lc[k]) / (1.f + __expf(-zc[k]))); }
        *(f32x4*)zp = za; *(f32x4*)(zp + 4) = zc;
    }
    __syncthreads();
    if (tid < 128) {
        const int dir = tid >> 6, i = tid & 63;
        float* zb = ZB + dir * 4096 + i; float acc = 0.f;
        if (dir == 0) {
#pragma unroll 16
            for (int t = 0; t < 64; ++t) { acc += zb[t * 64]; zb[t * 64] = acc; } }
        else {
#pragma unroll 16
            for (int t = 63; t >= 0; --t) { acc += zb[t * 64]; zb[t * 64] = acc; } }
    }
    __syncthreads();
#pragma unroll
    for (int it = 0; it < 2; ++it) {
        const int item = tid + it * 512, dir = item >> 9, t = (item >> 3) & 63, i0 = (item & 7) * 8;
        const float* B = ZB + dir * 4096;
        const int tp = dir == 0 ? t - 1 : t + 1; const bool edge = dir == 0 ? (t == 0) : (t == 63);
        const int tref = dir == 0 ? 31 : 32;
        float bc[8], bp[8], br[8];
        { const f32x4 a = *(const f32x4*)(B + t * 64 + i0), c = *(const f32x4*)(B + t * 64 + i0 + 4); bc[0] = a.x; bc[1] = a.y; bc[2] = a.z; bc[3] = a.w; bc[4] = c.x; bc[5] = c.y; bc[6] = c.z; bc[7] = c.w; }
        { const int tq = edge ? t : tp; const f32x4 a = *(const f32x4*)(B + tq * 64 + i0), c = *(const f32x4*)(B + tq * 64 + i0 + 4);
          bp[0] = a.x; bp[1] = a.y; bp[2] = a.z; bp[3] = a.w; bp[4] = c.x; bp[5] = c.y; bp[6] = c.z; bp[7] = c.w;
          if (edge) {
#pragma unroll
              for (int k = 0; k < 8; ++k) bp[k] = 0.f; } }
        { const f32x4 a = *(const f32x4*)(B + tref * 64 + i0), c = *(const f32x4*)(B + tref * 64 + i0 + 4); br[0] = a.x; br[1] = a.y; br[2] = a.z; br[3] = a.w; br[4] = c.x; br[5] = c.y; br[6] = c.z; br[7] = c.w; }
        float kh[8];
#pragma unroll
        for (int k = 0; k < 8; ++k) { const float kk = 1.f - __expf(bc[k] - bp[k]); kh[k] = kk * __expf(clampe(br[k] - bc[k])); }
        if (!FULL) {
            bf16_t* kt = (bf16_t*)(lds + O_KH + dir * MSZ) + i0 * P + t;
#pragma unroll
            for (int k = 0; k < 8; ++k) kt[k * P] = (bf16_t)f2bf(kh[k]);
        } else {
            u32x4 w; w.x = cvtpk(kh[0], kh[1]); w.y = cvtpk(kh[2], kh[3]); w.z = cvtpk(kh[4], kh[5]); w.w = cvtpk(kh[6], kh[7]);
            *(u32x4*)((bf16_t*)(lds + O_KH + dir * MSZ) + t * P + i0) = w;
            const u32x4 wq = *(const u32x4*)(ZQ + t * 64 + i0);
            float q[8] = {silu(bflo(wq.x)), silu(bfhi(wq.x)), silu(bflo(wq.y)), silu(bfhi(wq.y)), silu(bflo(wq.z)), silu(bfhi(wq.z)), silu(bflo(wq.w)), silu(bfhi(wq.w))};
            float qh[8], qt[8];
#pragma unroll
            for (int k = 0; k < 8; ++k) { qh[k] = q[k] * __expf(clampe(bc[k] - br[k])); qt[k] = q[k] * __expf(bc[k]); }
            w.x = cvtpk(qh[0], qh[1]); w.y = cvtpk(qh[2], qh[3]); w.z = cvtpk(qh[4], qh[5]); w.w = cvtpk(qh[6], qh[7]);
            *(u32x4*)((bf16_t*)(lds + O_QH + dir * MSZ) + t * P + i0) = w;
            w.x = cvtpk(qt[0], qt[1]); w.y = cvtpk(qt[2], qt[3]); w.z = cvtpk(qt[4], qt[5]); w.w = cvtpk(qt[6], qt[7]);
            *(u32x4*)((bf16_t*)(lds + O_QT + dir * MSZ) + t * P + i0) = w;
        }
    }
    __syncthreads();
}

__device__ __forceinline__ void h1_phase(unsigned char* lds, const bf16_t* __restrict__ PROJ, const float* __restrict__ LBFl, bf16_t* __restrict__ UT, float* __restrict__ DEC, int cu, int G) {
    const int tid = otid(), lane = tid & 63, r32 = lane & 31, hi = lane >> 5, w = __builtin_amdgcn_readfirstlane(tid >> 6);
    StageRegs sr;
    if (cu < BATCH * NCH * 4) { const int h = cu & 3, bc = cu >> 2, b = bc / NCH, cp = bc - b * NCH; stage_load<false>(sr, PROJ, b * PB + cp * 64, h); }
    for (int u = cu; u < BATCH * NCH * 4; u += G) {
        const int h = u & 3, bc = u >> 2, b = bc / NCH, cp = bc - b * NCH, row0 = b * PB + cp * 64;
        int nrow0 = -1, nh = 0; { const int un = u + G; if (un < BATCH * NCH * 4) { const int bcn = un >> 2, bn = bcn / NCH; nh = un & 3; nrow0 = bn * PB + (bcn - bn * NCH) * 64; } }
        prep<false>(lds, PROJ, LBFl, row0, h, sr, nrow0, nh);
        const float* ZB = (const float*)(lds + O_ZB);
        {
            const int dir = w >> 2, jb = (w >> 1) & 1, ib = w & 1;
            const bf16_t* VT = (const bf16_t*)(lds + O_VT) + (jb * 32 + r32) * P + hi * 8;
            const bf16_t* KT = (const bf16_t*)(lds + O_KH + dir * MSZ) + (ib * 32 + r32) * P + hi * 8;
            f32x16 acc = {};
#pragma unroll
            for (int ks = 0; ks < 4; ++ks) acc = __builtin_amdgcn_mfma_f32_32x32x16_bf16(*(const bf16x8*)(VT + ks * 16), *(const bf16x8*)(KT + ks * 16), acc, 0, 0, 0);
            const int i = ib * 32 + r32;
            const float btot = ZB[dir * 4096 + (dir == 0 ? 63 : 0) * 64 + i], bref = ZB[dir * 4096 + (dir == 0 ? 31 : 32) * 64 + i];
            const float sc = __expf(btot - bref);
            const int chain = (b * 4 + h) * 2 + dir;
            bf16_t* ut = UT + ((size_t)chain * NCH + cp) * 4096 + i;
#pragma unroll
            for (int r = 0; r < 16; ++r) ut[(jb * 32 + crow(r, hi)) * 64] = (bf16_t)f2bf(acc[r] * sc);
        }
        if (tid < 128) { const int dir = tid >> 6, i = tid & 63; const int chain = (b * 4 + h) * 2 + dir;
            DEC[((size_t)chain * NCH + cp) * 64 + i] = __expf(ZB[dir * 4096 + (dir == 0 ? 63 : 0) * 64 + i]); }
        __syncthreads();
    }
}

__device__ __forceinline__ void h2_phase(unsigned char* lds, const bf16_t* __restrict__ UT, const float* __restrict__ DEC, bf16_t* __restrict__ ST, int cu, int G) {
    const int tid = otid(), seg = tid >> 7, e = tid & 127, jl = e >> 5, i = (e & 31) * 2;
    f32x4* TOT = (f32x4*)(lds + O_TOT);
    for (int task = cu; task < 256; task += G) {
        const int chain = task >> 4, j = (task & 15) * 4 + jl, dir = chain & 1;
        const size_t cbase = (size_t)chain * NCH;
        float S0 = 0.f, S1 = 0.f, P0 = 1.f, P1 = 1.f;
#pragma unroll 11
        for (int kk = 0; kk < 33; ++kk) { const int k = seg * 33 + kk, cp = dir == 0 ? k : (k < 4 ? 3 - k : 135 - k);
            const unsigned u = *(const unsigned*)(UT + (cbase + cp) * 4096 + j * 64 + i); const f32x2 d = *(const f32x2*)(DEC + (cbase + cp) * 64 + i);
            S0 = d.x * S0 + bflo(u); S1 = d.y * S1 + bfhi(u); P0 *= d.x; P1 *= d.y; }
        TOT[seg * 128 + e] = (f32x4){S0, S1, P0, P1};
        __syncthreads();
        float s0 = 0.f, s1 = 0.f;
#pragma unroll
        for (int sp = 0; sp < 3; ++sp) if (sp < seg) { const f32x4 t = TOT[sp * 128 + e]; s0 = t.z * s0 + t.x; s1 = t.w * s1 + t.y; }
#pragma unroll 11
        for (int kk = 0; kk < 33; ++kk) { const int k = seg * 33 + kk, cp = dir == 0 ? k : (k < 4 ? 3 - k : 135 - k);
            const unsigned u = *(const unsigned*)(UT + (cbase + cp) * 4096 + j * 64 + i); const f32x2 d = *(const f32x2*)(DEC + (cbase + cp) * 64 + i);
            *(unsigned*)(ST + (cbase + cp) * 4096 + j * 64 + i) = pk2(s0, s1);
            s0 = d.x * s0 + bflo(u); s1 = d.y * s1 + bfhi(u); }
        __syncthreads();
    }
}

__device__ __forceinline__ void h3_phase(unsigned char* lds, const bf16_t* __restrict__ PROJ, const float* __restrict__ LBFl, const bf16_t* __restrict__ ST, const float* __restrict__ ng, bf16_t* __restrict__ MIX, int cu, int G) {
    const int tid = otid(), lane = tid & 63, r32 = lane & 31, hi = lane >> 5, w = __builtin_amdgcn_readfirstlane(tid >> 6);
    StageRegs sr; u32x4 sv0, sv1;
    const int u0 = G - 1 - cu;
    if (u0 < BATCH * NCH * 4) { const int h = u0 & 3, bc = u0 >> 2, b = bc / NCH, cp = bc - b * NCH; stage_load<true>(sr, PROJ, b * PB + cp * 64, h);
        const size_t so = ((size_t)((b * 4 + h) * 2) * NCH + cp) * 4096 + (tid >> 3) * 64 + (tid & 7) * 8; sv0 = *(const u32x4*)(ST + so); sv1 = *(const u32x4*)(ST + so + (size_t)NCH * 4096); }
    for (int u = u0; u < BATCH * NCH * 4; u += G) {
        const int h = u & 3, bc = u >> 2, b = bc / NCH, cp = bc - b * NCH, row0 = b * PB + cp * 64;
        int nrow0 = -1, nh = 0, nb = 0, ncp = 0; { const int un = u + G; if (un < BATCH * NCH * 4) { const int bcn = un >> 2; nb = bcn / NCH; ncp = bcn - nb * NCH; nh = un & 3; nrow0 = nb * PB + ncp * 64; } }
        { const int j = tid >> 3, ic = (tid & 7) * 8;
          *(u32x4*)((bf16_t*)(lds + O_ST) + j * P + ic) = sv0; *(u32x4*)((bf16_t*)(lds + O_ST + MSZ) + j * P + ic) = sv1;
          if (nrow0 >= 0) { const size_t so = ((size_t)((nb * 4 + nh) * 2) * NCH + ncp) * 4096 + j * 64 + ic; sv0 = *(const u32x4*)(ST + so); sv1 = *(const u32x4*)(ST + so + (size_t)NCH * 4096); } }
        prep<true>(lds, PROJ, LBFl, row0, h, sr, nrow0, nh);
        float* SSQ = (float*)(lds + O_SSQ); bf16_t* OUT = (bf16_t*)(lds + O_OUT);
        f32x16 ot = {};
        const int jb = (w >> 1) & 1, tb = w & 1;
        if (w < 4) {
            const bf16_t* VT = (const bf16_t*)(lds + O_VT) + (jb * 32 + r32) * P;
#pragma unroll
            for (int sb = 0; sb < 2; ++sb) {
                f32x16 xf = {}, xb = {};
                const bf16_t* QF = (const bf16_t*)(lds + O_QH) + (tb * 32 + r32) * P + hi * 8; const bf16_t* QB = QF + 64 * P;
                const bf16_t* KF = (const bf16_t*)(lds + O_KH) + (sb * 32 + r32) * P + hi * 8; const bf16_t* KB = KF + 64 * P;
                if (sb <= tb) {
#pragma unroll
                    for (int ks = 0; ks < 4; ++ks) xf = __builtin_amdgcn_mfma_f32_32x32x16_bf16(*(const bf16x8*)(KF + ks * 16), *(const bf16x8*)(QF + ks * 16), xf, 0, 0, 0); }
                if (sb >= tb) {
#pragma unroll
                    for (int ks = 0; ks < 4; ++ks) xb = __builtin_amdgcn_mfma_f32_32x32x16_bf16(*(const bf16x8*)(KB + ks * 16), *(const bf16x8*)(QB + ks * 16), xb, 0, 0, 0); }
                float x[16];
#pragma unroll
                for (int r = 0; r < 16; ++r) { const int s = crow(r, hi), t = r32;
                    const float vf = (sb < tb || (sb == tb && s <= t)) ? xf[r] : 0.f, vb = (sb > tb || (sb == tb && s >= t)) ? xb[r] : 0.f; x[r] = vf + vb; }
#pragma unroll
                for (int sp = 0; sp < 2; ++sp) {
                    u32x4 xw; xw.x = cvtpk(x[8 * sp + 0], x[8 * sp + 1]); xw.y = cvtpk(x[8 * sp + 2], x[8 * sp + 3]); xw.z = cvtpk(x[8 * sp + 4], x[8 * sp + 5]); xw.w = cvtpk(x[8 * sp + 6], x[8 * sp + 7]);
                    const s16x4 v0 = *(const s16x4*)(VT + sb * 32 + 16 * sp + 4 * hi), v1 = *(const s16x4*)(VT + sb * 32 + 16 * sp + 8 + 4 * hi);
                    const bf16x8 va = {v0[0], v0[1], v0[2], v0[3], v1[0], v1[1], v1[2], v1[3]};
                    ot = __builtin_amdgcn_mfma_f32_32x32x16_bf16(va, __builtin_bit_cast(bf16x8, xw), ot, 0, 0, 0); }
            }
#pragma unroll
            for (int dir = 0; dir < 2; ++dir) {
                const bf16_t* SA = (const bf16_t*)(lds + O_ST + dir * MSZ) + (jb * 32 + r32) * P + hi * 8; const bf16_t* QT = (const bf16_t*)(lds + O_QT + dir * MSZ) + (tb * 32 + r32) * P + hi * 8;
#pragma unroll
                for (int ks = 0; ks < 4; ++ks) ot = __builtin_amdgcn_mfma_f32_32x32x16_bf16(*(const bf16x8*)(SA + ks * 16), *(const bf16x8*)(QT + ks * 16), ot, 0, 0, 0); }
            float part = 0.f;
#pragma unroll
            for (int r = 0; r < 16; ++r) part += ot[r] * ot[r];
            part = xsum<32>(part);
            if (hi == 0) SSQ[jb * 64 + tb * 32 + r32] = part;
        }
        __syncthreads();
        if (w < 4) { const int t = tb * 32 + r32; const float rstd = 1.f / sqrtf((SSQ[t] + SSQ[64 + t]) * (1.f / 64.f) + EPS);
#pragma unroll
            for (int r = 0; r < 16; ++r) { const int j = jb * 32 + crow(r, hi); OUT[t * P + j] = (bf16_t)f2bf(ot[r] * rstd * ng[j]); } }
        __syncthreads();
        {
            const int t = tid >> 3, jc = (tid & 7) * 8;
            const u32x4 y = *(const u32x4*)(OUT + t * P + jc); const u32x4 g = *(const u32x4*)(PROJ + (size_t)(row0 + t) * NIN + C_AG + h * 64 + jc);
            u32x4 o; o.x = pk2(bflo(y.x) * silu(bflo(g.x)), bfhi(y.x) * silu(bfhi(g.x))); o.y = pk2(bflo(y.y) * silu(bflo(g.y)), bfhi(y.y) * silu(bfhi(g.y)));
            o.z = pk2(bflo(y.z) * silu(bflo(g.z)), bfhi(y.z) * silu(bfhi(g.z))); o.w = pk2(bflo(y.w) * silu(bflo(g.w)), bfhi(y.w) * silu(bfhi(g.w)));
            *(u32x4*)(MIX + (size_t)(row0 + t) * D + h * 64 + jc) = o;
        }
        __syncthreads();
    }
}
}
__device__ __forceinline__ int vcu_of(int bx, int G) { return (G % 8 == 0) ? (bx % 8) * (G / 8) + bx / 8 : bx; }
__device__ __forceinline__ void attn_phase(char* lds, const unsigned char* Q8, const unsigned char* K8, const unsigned char* VT8, bf16_t* MIX, float neg_ref, int vcu, int G, bool with_ctx) {
    using attn8::bf16;
    const int upc = (512 + G - 1) / G;
    const int nun = upc + ((with_ctx && vcu < 16) ? 1 : 0);
    for (int i = 0; i < nun; ++i) {
        int b, h, nt; size_t q0;
        if (i < upc) { const int u = vcu * upc + i; if (u >= 512) continue; const int combo = u >> 7; b = combo >> 1; h = (combo & 1) * 4 + ((u >> 5) & 3); q0 = (size_t)b * PB + CTXL + (size_t)(u & 31) * 256; nt = PB / 64; }
        else { b = vcu >> 3; h = vcu & 7; q0 = (size_t)b * PB; nt = CTXL / 64; }
        const int kvh = h >> 2; const size_t k0 = (size_t)b * PB;
        attn8::attn_unit(Q8 + q0 * 512 + h * 64, K8 + k0 * 128 + kvh * 64, VT8 + (size_t)((b * 2 + kvh) * (PB / 64)) * 4096, (bf16*)MIX + q0 * 1024 + 512 + h * 64, nt, neg_ref, lds);
    }
}

namespace pg8 {
struct EpiResid {
    static constexpr bool PERM = false, AFTER_DRAIN = false;
    const float* src_lat; const float* src_ctx; float* dst_lat; float* dst_ctx; const float* modv; int ga_off; int pad;
    __device__ __forceinline__ void operator()(const f32x4 (&acc)[2][2][4][2], const Unit& u, int wr, int wc, int fr, int fq) const {
        asm volatile("" : "+v"(fr), "+v"(fq));
        const int b = u.pm / TPB, w = u.pm - b * TPB;
        const size_t base = (w == 0) ? (size_t)b * CTXL * D : ((size_t)b * SEQ + (size_t)(w - 1) * 256) * D;
        const float* s = ((w == 0) ? src_ctx : src_lat) + base; float* d = ((w == 0) ? dst_ctx : dst_lat) + base;
        const float* ga = modv + ((w == 0) ? 2 : b) * 6144 + ga_off;
        const int row0 = wr * 64 + fr, col0 = u.pn * BM + wc * 32 + 4 * fq;
        f32x4 gv[2][2];
#pragma unroll
        for (int bj = 0; bj < 2; ++bj)
#pragma unroll
            for (int n = 0; n < 2; ++n) gv[bj][n] = *(const f32x4*)(ga + col0 + bj * HALF + n * 16);
#pragma unroll
        for (int ai = 0; ai < 2; ++ai)
#pragma unroll
            for (int m = 0; m < 4; ++m) { const size_t off = (size_t)(row0 + ai * HALF + m * 16) * D + col0;
#pragma unroll
                for (int bj = 0; bj < 2; ++bj)
#pragma unroll
                    for (int n = 0; n < 2; ++n) *(f32x4*)(d + off + bj * HALF + n * 16) = *(const f32x4*)(s + off + bj * HALF + n * 16) + gv[bj][n] * acc[ai][bj][m][n]; }
    }
};
struct OutOrder : StaticOrder {
    int lat_only;
    __device__ __forceinline__ bool next(int i, Unit& u) const { if (!StaticOrder::next(i, u)) return false; if (lat_only) u.pm = (u.pm >> 5) * TPB + 1 + (u.pm & 31); return true; }
};
}


namespace pg8 {
struct MUnit { int pm, pn, nrows, lbase, e0, e1; };
__device__ __forceinline__ void build_tiles(PG8_LAS int* TT, const unsigned* cnt) {
    if (otid() == 0) { int off = 0;
        for (int bk = 0; bk < 24; ++bk) { const int c = (int)__hip_atomic_load(cnt + bk, __ATOMIC_RELAXED, __HIP_MEMORY_SCOPE_AGENT); const int nb = (c + 255) >> 8;
            for (int ti = 0; ti < nb; ++ti) { const int rem = c - ti * 256; TT[4 + 4 * off + 0] = bk; TT[4 + 4 * off + 1] = ti; TT[4 + 4 * off + 2] = rem < 256 ? rem : 256; TT[4 + 4 * off + 3] = 0; ++off; } }
        TT[0] = off; }
    __syncthreads();
}
template <int NPN  > struct MoeOrder {
    const PG8_LAS int* TT; int G, c;
    __device__ __forceinline__ bool next(int i, MUnit& u) const {
        const int L = i * G + c, tile = L / NPN; if (tile >= TT[0]) return false;
        const int bk = TT[4 + 4 * tile], ti = TT[4 + 4 * tile + 1];
        u.pm = tile; u.pn = L - tile * NPN; u.nrows = TT[4 + 4 * tile + 2]; u.lbase = bk * MT + ti * 256;
        const int g = bk / 6, pi = bk - g * 6; const int lo = pi < 3 ? 0 : (pi < 5 ? 1 : 2), hi = pi < 3 ? pi + 1 : (pi < 5 ? pi - 1 : 3);
        u.e0 = 4 * g + lo; u.e1 = 4 * g + hi; return true;
    }
};
struct Src1 {
    const bf16_t* XN; const bf16_t* WGU; const u32x4* LIST;
    __device__ __forceinline__ const char* a_base(const MUnit&) const { return (const char*)XN; }
    __device__ __forceinline__ void a_offsets(const MUnit& u, const int (&RA)[2], const int (&CA)[2], unsigned (&ao)[2][2]) const {
#pragma unroll
        for (int h = 0; h < 2; ++h)
#pragma unroll
            for (int i = 0; i < 2; ++i) { const int r = h * HALF + RA[i]; const unsigned row = r < u.nrows ? LIST[u.lbase + r].x : 0u; ao[h][i] = (row * (unsigned)D + (unsigned)CA[i]) * 2u; }
    }
    __device__ __forceinline__ const char* b_base(const MUnit& u, int seg) const { const int e = (u.pn >> 2) ? u.e1 : u.e0;
        return (const char*)(WGU + ((size_t)e * 1024 + (size_t)(u.pn & 3) * 256) * D) + (seg ? (size_t)(D / 2) * 2 : 0); }
    __device__ __forceinline__ void prefetch_rows(const MUnit& u, const int (&)[2], PG8_LAS unsigned char* rows, int wid) const {
        int t2 = otid(); asm volatile("" : "+v"(t2));
        int RA[2];
#pragma unroll
        for (int i = 0; i < 2; ++i) { int R, C; stage_rc(t2 * 16 + i * 8192, R, C); RA[i] = R; }
#pragma unroll
        for (int h = 0; h < 2; ++h)
#pragma unroll
            for (int i = 0; i < 2; ++i) { const int r = h * HALF + RA[i];
                __builtin_amdgcn_global_load_lds((const unsigned*)&LIST[u.lbase + r], (PG8_LAS unsigned*)(rows + ((h * 2 + i) * 8 + wid) * 256), 4, 0, 0); }
    }
    __device__ __forceinline__ void reload_offsets(const MUnit& u, const int (&)[2], const int (&)[2], const PG8_LAS unsigned char* rows, int wid, int lane, unsigned (&ao)[2][2]) const {
        int t2 = otid(); asm volatile("" : "+v"(t2));
        int RA[2], CA[2];
#pragma unroll
        for (int i = 0; i < 2; ++i) { int R, C; stage_rc(t2 * 16 + i * 8192, R, C); RA[i] = R; CA[i] = C; }
#pragma unroll
        for (int h = 0; h < 2; ++h)
#pragma unroll
            for (int i = 0; i < 2; ++i) { const int r = h * HALF + RA[i]; const unsigned v = *(const PG8_LAS unsigned*)(rows + ((h * 2 + i) * 8 + wid) * 256 + lane * 4);
                const unsigned row = r < u.nrows ? v : 0u; ao[h][i] = (row * (unsigned)D + (unsigned)CA[i]) * 2u; }
    }
};
struct Src2 {
    const bf16_t* ACT2; const bf16_t* WD;
    __device__ __forceinline__ const char* a_base(const MUnit& u) const { return (const char*)(ACT2 + (size_t)u.pm * 256 * 1024); }
    __device__ __forceinline__ void a_offsets(const MUnit&, const int (&RA)[2], const int (&CA)[2], unsigned (&ao)[2][2]) const {
#pragma unroll
        for (int h = 0; h < 2; ++h)
#pragma unroll
            for (int i = 0; i < 2; ++i) ao[h][i] = (unsigned)((h * HALF + RA[i]) * 1024 + CA[i]) * 2u;
    }
    __device__ __forceinline__ const char* b_base(const MUnit& u, int seg) const { const int e = seg ? u.e1 : u.e0; return (const char*)(WD + ((size_t)e * 1024 + (size_t)u.pn * 256) * DE); }
    __device__ __forceinline__ void prefetch_rows(const MUnit&, const int (&)[2], PG8_LAS unsigned char*, int) const {}
    __device__ __forceinline__ void reload_offsets(const MUnit&, const int (&)[2], const int (&)[2], const PG8_LAS unsigned char*, int, int, unsigned (&)[2][2]) const {}
};
struct EpiGateUp2 {
    static constexpr bool PERM = true;
    bf16_t* ACT2; const u32x4* LIST;
    __device__ __forceinline__ void operator()(const f32x4 (&acc)[2][2][4][2], const MUnit& u, int wr, int wc, int fr, int fq) const {
        asm volatile("" : "+v"(fr), "+v"(fq));
        const int slot = u.pn >> 2, colA = slot * DE + (u.pn & 3) * HALF + wc * 32 + 8 * fq;
        const unsigned* lw = (const unsigned*)(LIST + u.lbase + wr * 64 + fr) + 1 + slot;
#pragma unroll
        for (int ai = 0; ai < 2; ++ai) {
            unsigned wv[4];
#pragma unroll
            for (int m = 0; m < 4; ++m) wv[m] = lw[(ai * HALF + m * 16) * 4];
#pragma unroll
            for (int m = 0; m < 4; ++m) { const int r = ai * HALF + wr * 64 + m * 16 + fr;
                const bool valid = r < u.nrows; const float cw = valid ? __uint_as_float(wv[m]) : 0.f;
                const f32x4 g0 = acc[ai][0][m][0], g1 = acc[ai][0][m][1], u0 = acc[ai][1][m][0], u1 = acc[ai][1][m][1];
                u32x4 w;
                w.x = cvt_pk_bf16(silu(g0[0]) * u0[0] * cw, silu(g0[1]) * u0[1] * cw); w.y = cvt_pk_bf16(silu(g0[2]) * u0[2] * cw, silu(g0[3]) * u0[3] * cw);
                w.z = cvt_pk_bf16(silu(g1[0]) * u1[0] * cw, silu(g1[1]) * u1[1] * cw); w.w = cvt_pk_bf16(silu(g1[2]) * u1[2] * cw, silu(g1[3]) * u1[3] * cw);
                if (!valid) w = (u32x4){0u, 0u, 0u, 0u};
                *(u32x4*)(ACT2 + ((size_t)u.pm * 256 + r) * 1024 + colA) = w; }
            asm volatile("" ::: "memory"); }
    }
};
struct EpiMoeOut {
    static constexpr bool PERM = false;
    float* lat; float* ctx; const float* modv; const u32x4* LIST;
    __device__ __forceinline__ void operator()(const f32x4 (&acc)[2][2][4][2], const MUnit& u, int wr, int wc, int fr, int fq) const {
        asm volatile("" : "+v"(fr), "+v"(fq));
        const int col0 = u.pn * BM + wc * 32 + 4 * fq;
        const unsigned* lw = (const unsigned*)(LIST + u.lbase + wr * 64 + fr);
        unsigned rv[2][4];
#pragma unroll
        for (int ai = 0; ai < 2; ++ai)
#pragma unroll
            for (int m = 0; m < 4; ++m) rv[ai][m] = lw[(ai * HALF + m * 16) * 4];
#pragma unroll
        for (int ai = 0; ai < 2; ++ai)
#pragma unroll
            for (int m = 0; m < 4; ++m) { const int r = ai * HALF + wr * 64 + m * 16 + fr;
                if (r < u.nrows) { const int row = (int)rv[ai][m]; bool is_ctx; const size_t off = stream_off(row, is_ctx);
                    float* d = (is_ctx ? ctx : lat) + off + col0; const float* ga = modv + (is_ctx ? 2 : row / PB) * 6144 + 5120 + col0;
#pragma unroll
                    for (int bj = 0; bj < 2; ++bj)
#pragma unroll
                        for (int n = 0; n < 2; ++n) { f32x4* p = (f32x4*)(d + bj * HALF + n * 16); *p = *p + *(const f32x4*)(ga + bj * HALF + n * 16) * acc[ai][bj][m][n]; } } }
    }
};

template <class Epi, class Sched, class Src>
__device__ __forceinline__ void gemm_phase_x(PG8_LAS unsigned char* lds, PG8_LAS unsigned char* rows, const Sched& S, const Src& X, const Epi& E, const int KB, const int nt) {
    const int tid = otid(), wid = __builtin_amdgcn_readfirstlane(tid >> 6), lane = tid & 63, wr = wid >> 2, wc = wid & 3, fr = lane & 15, fq = lane >> 4;
    int RA[2], CA[2]; unsigned voffB[2];
#pragma unroll
    for (int i = 0; i < 2; ++i) { int R, C; stage_rc(tid * 16 + i * 8192, R, C); const int Rb = Epi::PERM ? ((R & ~31) + perm32(R & 31)) : R; RA[i] = R; CA[i] = C; voffB[i] = (unsigned)(Rb * KB + C) * 2u; }
    const size_t kstep = (size_t)(BK * 2);
    const size_t hstepB = (size_t)HALF * KB * 2;
    const int half = nt >> 1;
    const unsigned ldsw = (unsigned)wid * 1024u;
    const int aoff = lds_byte(wr * 64 + fr, fq * 8), boff = lds_byte(wc * 32 + fr, fq * 8);
#define PG8_SA(b, h) (((b) * 2 + (h)) * HTB)
#define PG8_SB(b, h) ((4 + (b) * 2 + (h)) * HTB)
#define PG8_STAGE_B(bufoff, gbase) do { _Pragma("unroll") for (int _i = 0; _i < 2; ++_i) \
        __builtin_amdgcn_global_load_lds((const unsigned*)((const char*)(gbase) + voffB[_i]), (PG8_LAS unsigned*)(lds + (bufoff) + ldsw + _i * 8192), 16, 0, 0); } while (0)
#define PG8_STAGE_A(bufoff, gbase, o0, o1) do { \
        __builtin_amdgcn_global_load_lds((const unsigned*)((const char*)(gbase) + (o0)), (PG8_LAS unsigned*)(lds + (bufoff) + ldsw), 16, 0, 0); \
        __builtin_amdgcn_global_load_lds((const unsigned*)((const char*)(gbase) + (o1)), (PG8_LAS unsigned*)(lds + (bufoff) + ldsw + 8192), 16, 0, 0); } while (0)
#define PG8_LDA(dst, b, h) do { _Pragma("unroll") for (int m = 0; m < 4; ++m) _Pragma("unroll") for (int k = 0; k < 2; ++k) dst[m][k] = *(const PG8_LAS bf16x8*)(lds + PG8_SA(b, h) + aoff + m * 2048 + k * 1024); } while (0)
#define PG8_LDB(dst, b, h) do { _Pragma("unroll") for (int n = 0; n < 2; ++n) _Pragma("unroll") for (int k = 0; k < 2; ++k) dst[n][k] = *(const PG8_LAS bf16x8*)(lds + PG8_SB(b, h) + boff + n * 2048 + k * 1024); } while (0)
#define PG8_MMA(ai, bj, At, Bt) do { __builtin_amdgcn_s_setprio(1); _Pragma("unroll") for (int m = 0; m < 4; ++m) _Pragma("unroll") for (int n = 0; n < 2; ++n) _Pragma("unroll") for (int k = 0; k < 2; ++k) \
        acc[ai][bj][m][n] = __builtin_amdgcn_mfma_f32_16x16x32_bf16(Bt[n][k], At[m][k], acc[ai][bj][m][n], 0, 0, 0); __builtin_amdgcn_s_setprio(0); } while (0)
#define PG8_WAIT_V(n) asm volatile("s_waitcnt vmcnt(" #n ")" ::: "memory")
#define PG8_WAIT_L(n) asm volatile("s_waitcnt lgkmcnt(" #n ")" ::: "memory")
#define PG8_BAR __builtin_amdgcn_s_barrier()
#define PG8_SCHED __builtin_amdgcn_sched_barrier(0)
    MUnit cur, nxt; int ui = 0;
    if (!S.next(0, cur)) return;
    f32x4 acc[2][2][4][2];
#pragma unroll
    for (int a = 0; a < 2; ++a)
#pragma unroll
        for (int b = 0; b < 2; ++b)
#pragma unroll
            for (int m = 0; m < 4; ++m)
#pragma unroll
                for (int n = 0; n < 2; ++n) acc[a][b][m][n] = (f32x4){0.f, 0.f, 0.f, 0.f};
    bf16x8 At[4][2], B0[2][2], B1[2][2];
    unsigned aoc[2][2];
    X.a_offsets(cur, RA, CA, aoc);
    const char* cAb = X.a_base(cur); const char* cB0 = X.b_base(cur, 0); const char* cB1 = X.b_base(cur, 1);
    PG8_STAGE_B(PG8_SB(0, 0), cB0); PG8_STAGE_B(PG8_SB(0, 1), cB0 + hstepB); PG8_STAGE_A(PG8_SA(0, 0), cAb, aoc[0][0], aoc[0][1]); PG8_STAGE_A(PG8_SA(0, 1), cAb, aoc[1][0], aoc[1][1]);
    if (wr == 1) PG8_BAR;
    PG8_WAIT_V(2); PG8_BAR;
    PG8_STAGE_B(PG8_SB(1, 0), cB0 + kstep); PG8_STAGE_A(PG8_SA(1, 0), cAb + kstep, aoc[0][0], aoc[0][1]); PG8_STAGE_B(PG8_SB(1, 1), cB0 + hstepB + kstep);
    PG8_WAIT_V(6); PG8_BAR;
    for (;;) {
        const bool has_next = S.next(ui + 1, nxt);
        const char* nAb = cAb; const char* nB0 = cB0; const char* nB1 = cB1;
        if (has_next) { X.prefetch_rows(nxt, RA, rows, wid); nAb = X.a_base(nxt); nB0 = X.b_base(nxt, 0); nB1 = X.b_base(nxt, 1); }
        for (int t = 0; t < nt; t += 2) {
            const bool last = (t == nt - 2);
            const char* a1 = cAb + (size_t)(t + 1) * kstep;
            const int kt2 = t + 2;
            const char* b2 = last ? nB0 : (kt2 < half ? cB0 + (size_t)kt2 * kstep : cB1 + (size_t)(kt2 - half) * kstep);
            const char* a2 = last ? nAb : cAb + (size_t)kt2 * kstep;
            const char* a3 = a2 + kstep; const char* b3 = b2 + kstep;
            PG8_LDB(B0, 0, 0); PG8_LDB(B1, 0, 1); PG8_SCHED; PG8_LDA(At, 0, 0); PG8_STAGE_A(PG8_SA(1, 1), a1, aoc[1][0], aoc[1][1]);
            if (last && has_next) X.reload_offsets(nxt, RA, CA, rows, wid, lane, aoc);
            PG8_WAIT_V(8); PG8_WAIT_L(0); PG8_BAR; PG8_MMA(0, 0, At, B0); PG8_MMA(0, 1, At, B1); PG8_BAR; PG8_SCHED;
            PG8_LDA(At, 0, 1); PG8_STAGE_B(PG8_SB(0, 0), b2); PG8_STAGE_B(PG8_SB(0, 1), b2 + hstepB); PG8_STAGE_A(PG8_SA(0, 0), a2, aoc[0][0], aoc[0][1]);
            PG8_WAIT_V(8); PG8_WAIT_L(0); PG8_BAR; PG8_MMA(1, 0, At, B0); PG8_MMA(1, 1, At, B1); PG8_BAR; PG8_SCHED;
            PG8_LDB(B0, 1, 0); PG8_LDB(B1, 1, 1); PG8_SCHED; PG8_LDA(At, 1, 0); PG8_STAGE_A(PG8_SA(0, 1), a2, aoc[1][0], aoc[1][1]);
            PG8_WAIT_V(8); PG8_WAIT_L(0); PG8_BAR; PG8_MMA(0, 0, At, B0); PG8_MMA(0, 1, At, B1); PG8_BAR; PG8_SCHED;
            PG8_LDA(At, 1, 1); PG8_STAGE_B(PG8_SB(1, 0), b3); PG8_STAGE_B(PG8_SB(1, 1), b3 + hstepB); PG8_STAGE_A(PG8_SA(1, 0), a3, aoc[0][0], aoc[0][1]);
            PG8_WAIT_V(8); PG8_WAIT_L(0); PG8_BAR; PG8_MMA(1, 0, At, B0); PG8_MMA(1, 1, At, B1); PG8_BAR; PG8_SCHED;
        }
        if (wr == 0) PG8_BAR;
        E(acc, cur, wr, wc, fr, fq);
        if (!has_next) break;
#pragma unroll
        for (int a = 0; a < 2; ++a)
#pragma unroll
            for (int b = 0; b < 2; ++b)
#pragma unroll
                for (int m = 0; m < 4; ++m)
#pragma unroll
                    for (int n = 0; n < 2; ++n) acc[a][b][m][n] = (f32x4){0.f, 0.f, 0.f, 0.f};
        cur = nxt; cAb = nAb; cB0 = nB0; cB1 = nB1; ++ui;
        if (wr == 1) PG8_BAR;
    }
    PG8_WAIT_V(0);
    PG8_BAR;
#undef PG8_SA
#undef PG8_SB
#undef PG8_STAGE_A
#undef PG8_STAGE_B
#undef PG8_LDA
#undef PG8_LDB
#undef PG8_MMA
#undef PG8_WAIT_V
#undef PG8_WAIT_L
#undef PG8_BAR
#undef PG8_SCHED
}
}

constexpr int TT_OFF = 132096;
constexpr int ROWS_OFF = 134144;

#define XB_TMO      128
#define XB_XCNT(j)  (256  + 64 * (j))
#define XB_XSUB(j)  (1280 + 64 * (j))
#define XB_XGEN(j)  (2304 + 64 * (j))
#define XB_TOP      3328
#define XB_TOPGEN   3392
#define XCD_BAR_WORDS 3456
#define XB_SPIN_CAP (1u << 18)

__device__ __forceinline__ unsigned xb_ld(unsigned* p)              { return __hip_atomic_load(p, __ATOMIC_RELAXED, __HIP_MEMORY_SCOPE_AGENT); }
__device__ __forceinline__ unsigned xb_add(unsigned* p, unsigned v) { return __hip_atomic_fetch_add(p, v, __ATOMIC_RELAXED, __HIP_MEMORY_SCOPE_AGENT); }
__device__ __forceinline__ unsigned xb_xcc_id() { return (unsigned)__builtin_amdgcn_s_getreg((3 << 11) | 20) & 0xFu; }
#define XB_SPIN(cond, bar) do { unsigned _sp = 0; while (cond) { __builtin_amdgcn_s_sleep(1); \
    if ((++_sp & 255u) == 0u) { if (xb_ld(&(bar)[XB_TMO])) break; if (_sp > XB_SPIN_CAP) { atomicAdd(&(bar)[XB_TMO], 1u); break; } } } } while (0)

struct XcdBarrier {
    unsigned* bar; unsigned x;
    volatile LAS unsigned* st;
};

__device__ __forceinline__ XcdBarrier xcd_barrier_post(unsigned* bar, volatile LAS unsigned* st) {
    XcdBarrier b; b.bar = bar; b.x = xb_xcc_id(); b.st = st;
    if (threadIdx.x == 0) (void)xb_add(&bar[XB_XCNT(b.x)], 1u);
    return b;
}
__device__ __forceinline__ void xcd_barrier_complete(unsigned* bar, unsigned x, unsigned& nloc, unsigned& nx) {
    const unsigned G = gridDim.x * gridDim.y * gridDim.z;
    unsigned sum, cnt, mine, sp = 0u;
    for (;;) {
        sum = 0u; cnt = 0u; mine = 0u;
#pragma unroll
        for (unsigned j = 0; j < 16; ++j) { const unsigned c = xb_ld(&bar[XB_XCNT(j)]); sum += c; cnt += (c > 0u) ? 1u : 0u; mine = (j == x) ? c : mine; }
        if (sum == G) break;
        __builtin_amdgcn_s_sleep(1);
        if ((++sp & 255u) == 0u) { if (xb_ld(&bar[XB_TMO])) break; if (sp > XB_SPIN_CAP) { atomicAdd(&bar[XB_TMO], 1u); break; } }
    }
    nloc = mine > 0u ? mine : 1u; nx = cnt > 0u ? cnt : 1u;
}

__device__ __forceinline__ void xcd_barrier(const XcdBarrier& b) {
    asm volatile("s_waitcnt vmcnt(0)" ::: "memory");
    __syncthreads();
    if (threadIdx.x == 0) {
        unsigned* bar = b.bar;
        __builtin_amdgcn_s_waitcnt(0);
        unsigned nloc = b.st[0], nx = b.st[1];
        if (nloc == 0u) { xcd_barrier_complete(bar, b.x, nloc, nx); b.st[0] = nloc; b.st[1] = nx; }
        const unsigned old = xb_add(&bar[XB_XSUB(b.x)], 1u);
        const unsigned gen = old / nloc;
        if (old + 1u == (gen + 1u) * nloc) {
            __builtin_amdgcn_fence(__ATOMIC_RELEASE, "agent");
            asm volatile("s_waitcnt vmcnt(0)" ::: "memory");
            const unsigned og = xb_add(&bar[XB_TOP], 1u);
            const unsigned tg = og / nx;
            if (og + 1u == (tg + 1u) * nx) xb_add(&bar[XB_TOPGEN], 1u);
            else XB_SPIN(xb_ld(&bar[XB_TOPGEN]) == tg, bar);
            __builtin_amdgcn_fence(__ATOMIC_ACQUIRE, "agent");
            xb_add(&bar[XB_XGEN(b.x)], 1u);
            asm volatile("s_waitcnt vmcnt(0)" ::: "memory");
        } else {
            XB_SPIN(xb_ld(&bar[XB_XGEN(b.x)]) == gen, bar);
            __builtin_amdgcn_fence(__ATOMIC_ACQUIRE, "agent");
            asm volatile("s_waitcnt vmcnt(0)" ::: "memory");
        }
    }
    __syncthreads();
}

constexpr int LDS_BYTES = 147456;
constexpr int LDSCTL_OFF = 131072, MISC_OFF = LDSCTL_OFF + 320;
constexpr int CW_BAR = 4096;
constexpr int NPHASE = 1 + 9 * DEPTH;
#ifndef MK_SPLIT
#define MK_SPLIT 0
#endif
struct Args {
    const float *x, *c, *ctx, *c_ctx, *w_mod, *b_mod, *norm1_g, *norm2_g, *w_in, *w_out, *hgrn_lb, *hgrn_norm_g, *pool_w, *pool_scale, *q_norm_g, *k_norm_g, *router_w, *router_b, *moe_gate, *moe_up, *moe_down;
    float* out; unsigned char* ws; int ph_lo, ph_hi;
};
typedef const __attribute__((address_space(4))) Args* KArgs;
__device__ __forceinline__ KArgs kargs() { KArgs p = (KArgs)__builtin_amdgcn_kernarg_segment_ptr(); asm volatile("" : "+s"(p)); return p; }
__global__ void __launch_bounds__(512, 2) mega_fwd(Args A_unused) {
    extern __shared__ __attribute__((aligned(16))) unsigned char lds[];
    for (int u = otid(); u < (LDS_BYTES - LDSCTL_OFF) / 4; u += 512) ((LAS unsigned*)((LAS unsigned char*)lds + LDSCTL_OFF))[u] = 0u;
    __syncthreads();
    XcdBarrier bar;
    { KArgs ap = kargs(); unsigned* CTL = (unsigned*)(ap->ws + WS_CTL); bar.bar = CTL + CW_BAR; bar.x = 0; bar.st = nullptr;
      if (!MK_SPLIT) bar = xcd_barrier_post(CTL + CW_BAR, (volatile LAS unsigned*)((LAS unsigned char*)lds + MISC_OFF) + 8); }
    int lo, hi; { KArgs ap = kargs(); lo = ap->ph_lo; hi = ap->ph_hi; }
#ifndef PHMASK
#define PHMASK 0x3ff
#endif
#define IN(k) (lo <= (k) && (k) < hi)
#define SEAM(k) do { if (!MK_SPLIT && IN((k) + 1)) xcd_barrier(bar); } while (0)
#define GCU const int G = (int)gridDim.x, cu = (int)blockIdx.x
#ifndef DUPMASK
#define DUPMASK 0
#endif
    LAS unsigned char* ldsl = (LAS unsigned char*)lds;
    if ((PHMASK & 0x200) && IN(0)) {
        _Pragma("unroll") for (int rep_ = 0; rep_ < ((((DUPMASK) & (0x200)) && true) ? 2 : 1); ++rep_) {
        KArgs ap = kargs(); unsigned char* ws = ap->ws; GCU;
        ProArgs pa; pa.c = ap->c; pa.c_ctx = ap->c_ctx; pa.w_mod = ap->w_mod; pa.b_mod = ap->b_mod; pa.hgrn_lb = ap->hgrn_lb; pa.qg = ap->q_norm_g; pa.kg = ap->k_norm_g; pa.w_in = ap->w_in; pa.w_out = ap->w_out; pa.pool_w = ap->pool_w;
        pa.gate = ap->moe_gate; pa.up = ap->moe_up; pa.down = ap->moe_down; pa.MODV = (float*)(ws + WS_MODV); pa.LBF = (float*)(ws + WS_LBF); pa.REF = (float*)(ws + WS_REF); pa.COS = (float*)(ws + WS_COS); pa.SIN = (float*)(ws + WS_SIN);
        pa.WIN = (bf16_t*)(ws + WS_WIN); pa.WOUT = (bf16_t*)(ws + WS_WOUT); pa.POOLWT = (bf16_t*)(ws + WS_POOLWT); pa.WGU = (bf16_t*)(ws + WS_WGU); pa.WD = (bf16_t*)(ws + WS_WD);
        prologue_phase(lds, pa, cu, G);
            if (rep_ + 1 < ((((DUPMASK) & (0x200)) && true) ? 2 : 1)) xcd_barrier(bar); }
        SEAM(0);
    }
    for (int l = 0; l < DEPTH; ++l) {
        const int pb = 1 + 9 * l;
        if ((PHMASK & 1) && IN(pb + 0)) {
        _Pragma("unroll") for (int rep_ = 0; rep_ < ((((DUPMASK) & (1)) && true) ? 2 : 1); ++rep_) {
            KArgs ap = kargs(); unsigned char* ws = ap->ws; GCU;
            const float* slat = (l == 0) ? ap->x : ap->out; const float* sctx = (l == 0) ? ap->ctx : (const float*)(ws + WS_XC);
            norm1_phase(cu, G, slat, sctx, ap->norm1_g + l * D, (const float*)(ws + WS_MODV) + (size_t)l * 3 * 6144, 0, (bf16_t*)(ws + WS_XN));
            if (rep_ + 1 < ((((DUPMASK) & (1)) && true) ? 2 : 1)) xcd_barrier(bar); }
            SEAM(pb + 0);
        }
        if ((PHMASK & 2) && IN(pb + 1)) {
        _Pragma("unroll") for (int rep_ = 0; rep_ < ((((DUPMASK) & (2)) && true) ? 2 : 1); ++rep_) {
            KArgs ap = kargs(); unsigned char* ws = ap->ws; GCU;
            pg8::Gemm g; g.A = (const bf16_t*)(ws + WS_XN); g.Bt = (const bf16_t*)(ws + WS_WIN) + (size_t)l * NIN * D; g.M = MT; g.N = NIN; g.K = D; g.pad = 0;
            pg8::StaticOrder S; S.init(MT, NIN, G, cu);
            pg8::EpiBf16<0> E; E.O = (bf16_t*)(ws + WS_PROJ); E.ldc = NIN; E.bias = nullptr; E.split_cols = 0; E.split_stride = 0; E.scale0 = 1.f;
            pg8::gemm_phase<pg8::EpiBf16<0>, pg8::StaticOrder, true, true>(ldsl, g, S, E);
            { KArgs aq = kargs(); if (l == 0) moe_filler(lds, aq->moe_gate, aq->moe_up, aq->moe_down, aq->ws, 0, 0, 5530, (MT / 256) * (NIN / 256), G, cu);
              else moe_filler(lds, aq->moe_gate, aq->moe_up, aq->moe_down, aq->ws, 1, 7986, MOE_ITEMS, (MT / 256) * (NIN / 256), G, cu); }
            if (rep_ + 1 < ((((DUPMASK) & (2)) && true) ? 2 : 1)) xcd_barrier(bar); }
            SEAM(pb + 1);
        }
        if ((PHMASK & 4) && IN(pb + 2)) {
        _Pragma("unroll") for (int rep_ = 0; rep_ < ((((DUPMASK) & (4)) && true) ? 2 : 1); ++rep_) {
            KArgs ap = kargs(); unsigned char* ws = ap->ws; GCU;
            const bf16_t* PROJ = (const bf16_t*)(ws + WS_PROJ);
            post_phase(cu, G, PROJ, ap->q_norm_g + l * 64, ap->k_norm_g + l * 64, (const float*)(ws + WS_COS), (const float*)(ws + WS_SIN), ws + WS_Q8, ws + WS_K8, ws + WS_VT8);
            pool::pool_phase(lds, PROJ, (const bf16_t*)(ws + WS_POOLWT) + (size_t)l * 4 * 4096, ap->pool_scale + l * 256, (bf16_t*)(ws + WS_MIX), cu, G);
            hg::h1_phase(lds, PROJ, (const float*)(ws + WS_LBF) + l * 512, (bf16_t*)(ws + WS_UT), (float*)(ws + WS_DEC), cu, G);
            if (rep_ + 1 < ((((DUPMASK) & (4)) && true) ? 2 : 1)) xcd_barrier(bar); }
            SEAM(pb + 2);
        }
        if ((PHMASK & 8) && IN(pb + 3)) {
        _Pragma("unroll") for (int rep_ = 0; rep_ < ((((DUPMASK) & (8)) && true) ? 2 : 1); ++rep_) {
            KArgs ap = kargs(); unsigned char* ws = ap->ws; GCU; hg::h2_phase(lds, (const bf16_t*)(ws + WS_UT), (const float*)(ws + WS_DEC), (bf16_t*)(ws + WS_ST), cu, G);
            if (rep_ + 1 < ((((DUPMASK) & (8)) && true) ? 2 : 1)) xcd_barrier(bar); }
            SEAM(pb + 3);
        }
        if ((PHMASK & 16) && IN(pb + 4)) {
        _Pragma("unroll") for (int rep_ = 0; rep_ < ((((DUPMASK) & (16)) && true) ? 2 : 1); ++rep_) {
            { KArgs ap = kargs(); unsigned char* ws = ap->ws; GCU;
              attn_phase((char*)lds, ws + WS_Q8, ws + WS_K8, ws + WS_VT8, (bf16_t*)(ws + WS_MIX), ((const float*)(ws + WS_REF))[l * 64], vcu_of(cu, G), G, true); }
            { KArgs ap = kargs(); unsigned char* ws = ap->ws; GCU;
              hg::h3_phase(lds, (const bf16_t*)(ws + WS_PROJ), (const float*)(ws + WS_LBF) + l * 512, (const bf16_t*)(ws + WS_ST), ap->hgrn_norm_g + l * 64, (bf16_t*)(ws + WS_MIX), cu, G); }
            if (rep_ + 1 < ((((DUPMASK) & (16)) && true) ? 2 : 1)) xcd_barrier(bar); }
            SEAM(pb + 4);
        }
        if ((PHMASK & 32) && IN(pb + 5)) {
        _Pragma("unroll") for (int rep_ = 0; rep_ < ((((DUPMASK) & (32)) && (l == 0)) ? 2 : 1); ++rep_) {
            KArgs ap = kargs(); unsigned char* ws = ap->ws; GCU;
            pg8::Gemm g; g.A = (const bf16_t*)(ws + WS_MIX); g.Bt = (const bf16_t*)(ws + WS_WOUT) + (size_t)l * D * D; g.M = MT; g.N = D; g.K = D; g.pad = 0;
            pg8::OutOrder S; S.lat_only = (l == DEPTH - 1); S.init(S.lat_only ? BATCH * SEQ : MT, D, G, cu);
            pg8::EpiResid E; E.src_lat = (l == 0) ? ap->x : ap->out; E.src_ctx = (l == 0) ? ap->ctx : (const float*)(ws + WS_XC); E.dst_lat = ap->out; E.dst_ctx = (float*)(ws + WS_XC);
            E.modv = (const float*)(ws + WS_MODV) + (size_t)l * 3 * 6144; E.ga_off = 2048; E.pad = 0;
            pg8::gemm_phase<pg8::EpiResid, pg8::OutOrder, true, true>(ldsl, g, S, E);
            if (l == 0) { KArgs aq = kargs(); moe_filler(lds, aq->moe_gate, aq->moe_up, aq->moe_down, aq->ws, 0, 5530, MOE_ITEMS, (MT / 256) * (D / 256), G, cu); }
            if (rep_ + 1 < ((((DUPMASK) & (32)) && (l == 0)) ? 2 : 1)) xcd_barrier(bar); }
            SEAM(pb + 5);
        }
        if ((PHMASK & 64) && IN(pb + 6)) {
        _Pragma("unroll") for (int rep_ = 0; rep_ < ((((DUPMASK) & (64)) && true) ? 2 : 1); ++rep_) {
            KArgs ap = kargs(); unsigned char* ws = ap->ws; GCU;
            norm2_router_phase(lds, cu, G, ap->out, (const float*)(ws + WS_XC), ap->norm2_g + l * D, (const float*)(ws + WS_MODV) + (size_t)l * 3 * 6144, 3072, ap->router_w, ap->router_b, (bf16_t*)(ws + WS_XN),
                               (unsigned*)(ws + WS_CTL) + CW_CNT + 64 * l + 32 * rep_, (u32x4*)(ws + WS_LIST), l == 0 ? 1 : 0);
            if (rep_ + 1 < ((((DUPMASK) & (64)) && true) ? 2 : 1)) xcd_barrier(bar); }
            SEAM(pb + 6);
        }
        if ((PHMASK & 128) && IN(pb + 7)) {
        _Pragma("unroll") for (int rep_ = 0; rep_ < ((((DUPMASK) & (128)) && true) ? 2 : 1); ++rep_) {
            KArgs ap = kargs(); unsigned char* ws = ap->ws; GCU;
            LAS int* TT = (LAS int*)(ldsl + TT_OFF);
            pg8::build_tiles(TT, (const unsigned*)(ws + WS_CTL) + CW_CNT + 64 * l);
            pg8::MoeOrder<8> S; S.TT = TT; S.G = G; S.c = vcu_of(cu, G);
            pg8::Src1 X; X.XN = (const bf16_t*)(ws + WS_XN); X.WGU = (const bf16_t*)(ws + (l ? WS_WGU1 : WS_WGU)); X.LIST = (const u32x4*)(ws + WS_LIST); pg8::EpiGateUp2 E; E.ACT2 = (bf16_t*)(ws + WS_ACT2); E.LIST = X.LIST;
            pg8::gemm_phase_x(ldsl, ldsl + ROWS_OFF, S, X, E, D, D / 64);
            if (l == 0) { KArgs aq = kargs(); const int U = TT[0] * 8; moe_filler(lds, aq->moe_gate, aq->moe_up, aq->moe_down, aq->ws, 1, 0, 3686, U, G, vcu_of(cu, G)); }
            if (rep_ + 1 < ((((DUPMASK) & (128)) && true) ? 2 : 1)) xcd_barrier(bar); }
            SEAM(pb + 7);
        }
        if ((PHMASK & 256) && IN(pb + 8)) {
        _Pragma("unroll") for (int rep_ = 0; rep_ < ((((DUPMASK) & (256)) && true) ? 2 : 1); ++rep_) {
            KArgs ap = kargs(); unsigned char* ws = ap->ws; GCU;
            LAS int* TT = (LAS int*)(ldsl + TT_OFF);
            pg8::build_tiles(TT, (const unsigned*)(ws + WS_CTL) + CW_CNT + 64 * l);
            pg8::MoeOrder<4> S; S.TT = TT; S.G = G; S.c = vcu_of(cu, G);
            pg8::Src2 X; X.ACT2 = (const bf16_t*)(ws + WS_ACT2); X.WD = (const bf16_t*)(ws + (l ? WS_WD1 : WS_WD));
            pg8::EpiMoeOut E; E.lat = ap->out; E.ctx = (float*)(ws + WS_XC); E.modv = (const float*)(ws + WS_MODV) + (size_t)l * 3 * 6144; E.LIST = (const u32x4*)(ws + WS_LIST);
            pg8::gemm_phase_x(ldsl, ldsl + ROWS_OFF, S, X, E, DE, 1024 / 64);
            if (l == 0) { KArgs aq = kargs(); const int U = TT[0] * 4; moe_filler(lds, aq->moe_gate, aq->moe_up, aq->moe_down, aq->ws, 1, 3686, 7986, U, G, vcu_of(cu, G)); }
            if (rep_ + 1 < ((((DUPMASK) & (256)) && true) ? 2 : 1)) xcd_barrier(bar); }
            SEAM(pb + 8);
        }
    }
#undef IN
#undef SEAM
#undef GCU
}

extern "C" void kernel_launch(void* const* d_in, const int* in_sizes, int n_in, void* d_out, int out_size, void* d_ws, size_t ws_size, hipStream_t stream) {
    static int grid = 0;
    if (grid == 0) {
        if (n_in != 21 || in_sizes[0] != BATCH * SEQ * D || out_size != BATCH * SEQ * D || ws_size < WS_END) {
            fprintf(stderr, "kernel_launch: unexpected sizes: n_in %d in0 %d out %d ws %zu (need %zu)\n", n_in, n_in > 0 ? in_sizes[0] : -1, out_size, ws_size, (size_t)WS_END); grid = -1; return; }
        int dev = 0, cus = 0, per_cu = 0;
        if (hipGetDevice(&dev) != hipSuccess || hipDeviceGetAttribute(&cus, hipDeviceAttributeMultiprocessorCount, dev) != hipSuccess) { grid = -1; return; }
        if (hipFuncSetAttribute((const void*)mega_fwd, hipFuncAttributeMaxDynamicSharedMemorySize, LDS_BYTES) != hipSuccess) { fprintf(stderr, "kernel_launch: hipFuncSetAttribute failed\n"); grid = -1; return; }
        if (hipOccupancyMaxActiveBlocksPerMultiprocessor(&per_cu, (const void*)mega_fwd, 512, LDS_BYTES) != hipSuccess || per_cu < 1) fprintf(stderr, "kernel_launch: occupancy query reports %d\n", per_cu);
        (void)hipGetLastError();
        grid = cus;
    }
    if (grid < 0) return;
    if (hipMemsetAsync((char*)d_ws + WS_CTL, 0, 1 * MiB, stream) != hipSuccess) return;
    Args a; memset((void*)&a, 0, sizeof(a));
    a.x = (const float*)d_in[0]; a.c = (const float*)d_in[1]; a.ctx = (const float*)d_in[2]; a.c_ctx = (const float*)d_in[3]; a.w_mod = (const float*)d_in[4]; a.b_mod = (const float*)d_in[5];
    a.norm1_g = (const float*)d_in[6]; a.norm2_g = (const float*)d_in[7]; a.w_in = (const float*)d_in[8]; a.w_out = (const float*)d_in[9]; a.hgrn_lb = (const float*)d_in[10]; a.hgrn_norm_g = (const float*)d_in[11];
    a.pool_w = (const float*)d_in[12]; a.pool_scale = (const float*)d_in[13]; a.q_norm_g = (const float*)d_in[14]; a.k_norm_g = (const float*)d_in[15]; a.router_w = (const float*)d_in[16]; a.router_b = (const float*)d_in[17];
    a.moe_gate = (const float*)d_in[18]; a.moe_up = (const float*)d_in[19]; a.moe_down = (const float*)d_in[20];
    a.out = (float*)d_out; a.ws = (unsigned char*)d_ws;
#if MK_SPLIT
    for (int ph = 0; ph < NPHASE; ++ph) { a.ph_lo = ph; a.ph_hi = ph + 1; hipLaunchKernelGGL(mega_fwd, dim3(grid), dim3(512), LDS_BYTES, stream, a); }
#else
    a.ph_lo = 0; a.ph_hi = NPHASE; hipLaunchKernelGGL(mega_fwd, dim3(grid), dim3(512), LDS_BYTES, stream, a);
#endif
}
```
